# Optimizing an MI355X kernel written in HIP

```python
import jax, jax.numpy as jnp
from jax import lax
import numpy as np

D_MODEL = 1024
BATCH = 8
SEQ = 2048
DEPTH = 1

CHUNK = 64
EPS = 1e-6
REC_WIDTH = D_MODEL // 2
REC_HEADS = 8
REC_HEAD_DIM = REC_WIDTH // REC_HEADS
CONV_WIDTH = 4
LRU_C = 8.0
ATT_HEAD_DIM = 64
ATT_HEADS = (D_MODEL // 2) // ATT_HEAD_DIM
ATT_WIDTH = ATT_HEADS * ATT_HEAD_DIM
LEFT_CHUNKS = 8
BAND = (LEFT_CHUNKS + 1) * CHUNK
MAX_REL = 128
MIX_WIDTH = REC_WIDTH + ATT_WIDTH
IN_WIDTH = 2 * REC_WIDTH + 3 * ATT_WIDTH
N_GROUPS = 4
EXPERTS_PER_GROUP = 4
N_EXPERTS = N_GROUPS * EXPERTS_PER_GROUP
TOP_K = 2
D_FF_EXPERT = D_MODEL // 2
DISPATCH_BLOCK = 128

kernel_name = 'hybrid_rglru_chunkattn_hiermoe'


def rms_norm(x, g):
    x32 = x.astype(jnp.float32)
    y = x32 * lax.rsqrt(jnp.mean(x32 * x32, axis=-1, keepdims=True) + EPS)
    return (y * g.astype(jnp.float32)).astype(x.dtype)


def rg_lru_group(u, gate, conv_w, conv_b, w_a, b_a, w_x, b_x, lam):
    B, S, _ = u.shape
    up = jnp.pad(u, ((0, 0), (CONV_WIDTH - 1, 0), (0, 0)))
    uc = conv_b
    for j in range(CONV_WIDTH):
        uc = uc + up[:, j:j + S] * conv_w[j]
    ub = uc.reshape(B, S, REC_HEADS, REC_HEAD_DIM)
    r = jax.nn.sigmoid(jnp.einsum('bshi,hij->bshj', ub, w_a) + b_a).reshape(B, S, REC_WIDTH)
    i = jax.nn.sigmoid(jnp.einsum('bshi,hij->bshj', ub, w_x) + b_x).reshape(B, S, REC_WIDTH)
    log_a = -LRU_C * r.astype(jnp.float32) * jax.nn.softplus(-lam.astype(jnp.float32))
    a = jnp.exp(log_a)
    bx = jnp.sqrt(-jnp.expm1(2.0 * log_a)) * (i * uc).astype(jnp.float32)

    def combine(left, right):
        a1, b1 = left
        a2, b2 = right
        return a1 * a2, a2 * b1 + b2

    _, h = lax.associative_scan(combine, (a, bx), axis=1)
    return h.astype(u.dtype) * jax.nn.gelu(gate)


def chunk_attention_group(q, k, v, rel_bias):
    B, S, _ = q.shape
    NC = S // CHUNK
    qc = q.reshape(B, NC, CHUNK, ATT_HEADS, ATT_HEAD_DIM) * (ATT_HEAD_DIM ** -0.5)
    pad = LEFT_CHUNKS * CHUNK

    def band(t):
        tc = jnp.pad(t.reshape(B, S, ATT_HEADS, ATT_HEAD_DIM), ((0, 0), (pad, 0), (0, 0), (0, 0)))
        tc = tc.reshape(B, NC + LEFT_CHUNKS, CHUNK, ATT_HEADS, ATT_HEAD_DIM)
        return jnp.concatenate([tc[:, j:j + NC] for j in range(LEFT_CHUNKS + 1)], axis=2)

    kb = band(k)
    vb = band(v)
    q_off = jnp.arange(CHUNK)
    k_off = jnp.arange(BAND)
    rel = jnp.clip(pad + q_off[:, None] - k_off[None, :], -MAX_REL, MAX_REL) + MAX_REL
    bias = rel_bias.astype(jnp.float32)[:, rel]
    key_pos = (jnp.arange(NC)[:, None] - LEFT_CHUNKS) * CHUNK + k_off[None, :]
    mask = jnp.where(key_pos >= 0, 0.0, -1e30).astype(jnp.float32)
    s = jnp.einsum('bcqhd,bckhd->bchqk', qc, kb, preferred_element_type=jnp.float32)
    s = s + bias[None, None] + mask[None, :, None, None, :]
    p = jax.nn.softmax(s, axis=-1).astype(v.dtype)
    o = jnp.einsum('bchqk,bckhd->bcqhd', p, vb)
    return o.reshape(B, S, ATT_WIDTH)


def hierarchical_moe(xn, w_group, b_group, w_router, b_router, w_e_gate, w_e_up, w_e_down):
    B, S, D = xn.shape
    T = B * S
    xt = xn.reshape(T, D)
    x32 = xt.astype(jnp.float32)
    group_logits = x32 @ w_group.astype(jnp.float32) + b_group.astype(jnp.float32)
    group_probs = jax.nn.softmax(group_logits, axis=-1)
    g = jnp.argmax(group_logits, axis=-1)
    p_g = jnp.take_along_axis(group_probs, g[:, None], axis=1)
    exp_logits = (x32 @ w_router.astype(jnp.float32) + b_router.astype(jnp.float32))
    exp_logits = exp_logits.reshape(T, N_GROUPS, EXPERTS_PER_GROUP)
    sel = jnp.take_along_axis(exp_logits, g[:, None, None], axis=1)[:, 0]
    top_v, top_i = lax.top_k(sel, TOP_K)
    weights = p_g * jax.nn.softmax(top_v, axis=-1)
    expert_id = g[:, None] * EXPERTS_PER_GROUP + top_i

    TK = T * TOP_K
    flat_e = expert_id.reshape(TK)
    flat_tok = jnp.repeat(jnp.arange(T), TOP_K)
    flat_w = weights.reshape(TK)
    order = jnp.argsort(flat_e)
    e_sorted = flat_e[order]
    tok_sorted = flat_tok[order]
    w_sorted = flat_w[order]
    counts = jnp.bincount(flat_e, length=N_EXPERTS)
    padded = (counts + DISPATCH_BLOCK - 1) // DISPATCH_BLOCK * DISPATCH_BLOCK
    start = jnp.cumsum(counts) - counts
    pend = jnp.cumsum(padded)
    pstart = pend - padded
    dest = pstart[e_sorted] + (jnp.arange(TK) - start[e_sorted])
    n_pad = ((TK + DISPATCH_BLOCK - 1) // DISPATCH_BLOCK + N_EXPERTS) * DISPATCH_BLOCK
    n_blocks = n_pad // DISPATCH_BLOCK
    x_buf = jnp.zeros((n_pad, D), xt.dtype).at[dest].set(xt[tok_sorted])
    block_e = jnp.clip(jnp.searchsorted(pend, jnp.arange(n_blocks) * DISPATCH_BLOCK, side='right'),
                       0, N_EXPERTS - 1)

    def expert_block(args):
        xb, e = args
        hid = jax.nn.silu(xb @ w_e_gate[e]) * (xb @ w_e_up[e])
        return hid @ w_e_down[e]

    y_buf = lax.map(expert_block, (x_buf.reshape(n_blocks, DISPATCH_BLOCK, D), block_e))
    y = y_buf.reshape(n_pad, D)[dest] * w_sorted[:, None].astype(xt.dtype)
    out = jax.ops.segment_sum(y, tok_sorted, num_segments=T)
    return out.reshape(B, S, D)


def setup_inputs(seed: int = 0) -> dict:
    key = jax.random.key(seed)
    ks = jax.random.split(key, 24)
    f32 = jnp.float32

    def nrm(k, shape, scale):
        return jax.random.normal(k, shape, f32) * scale

    a_base = jax.random.uniform(ks[9], (DEPTH, REC_WIDTH), f32, 0.9, 0.999)
    s = a_base ** (1.0 / LRU_C)
    lru_lambda = jnp.log(s) - jnp.log1p(-s)
    return {
        'x': nrm(ks[0], (BATCH, SEQ, D_MODEL), 1.0),
        'norm1_g': 1.0 + nrm(ks[1], (DEPTH, D_MODEL), 0.02),
        'w_in': nrm(ks[2], (DEPTH, D_MODEL, IN_WIDTH), D_MODEL ** -0.5),
        'conv_w': nrm(ks[3], (DEPTH, CONV_WIDTH, REC_WIDTH), CONV_WIDTH ** -0.5),
        'conv_b': nrm(ks[4], (DEPTH, REC_WIDTH), 0.02),
        'w_rg_a': nrm(ks[5], (DEPTH, REC_HEADS, REC_HEAD_DIM, REC_HEAD_DIM), REC_HEAD_DIM ** -0.5),
        'b_rg_a': nrm(ks[6], (DEPTH, REC_HEADS, REC_HEAD_DIM), 0.02),
        'w_rg_x': nrm(ks[7], (DEPTH, REC_HEADS, REC_HEAD_DIM, REC_HEAD_DIM), REC_HEAD_DIM ** -0.5),
        'b_rg_x': nrm(ks[8], (DEPTH, REC_HEADS, REC_HEAD_DIM), 0.02),
        'lru_lambda': lru_lambda,
        'rel_bias': nrm(ks[10], (DEPTH, ATT_HEADS, 2 * MAX_REL + 1), 0.2),
        'g_rec_out': 1.0 + nrm(ks[11], (DEPTH, REC_WIDTH), 0.02),
        'g_att_out': 1.0 + nrm(ks[12], (DEPTH, ATT_WIDTH), 0.02),
        'w_out': nrm(ks[13], (DEPTH, MIX_WIDTH, D_MODEL), MIX_WIDTH ** -0.5),
        'norm2_g': 1.0 + nrm(ks[14], (DEPTH, D_MODEL), 0.02),
        'w_group': nrm(ks[15], (DEPTH, D_MODEL, N_GROUPS), D_MODEL ** -0.5),
        'b_group': nrm(ks[16], (DEPTH, N_GROUPS), 0.01),
        'w_router': nrm(ks[17], (DEPTH, D_MODEL, N_EXPERTS), D_MODEL ** -0.5),
        'b_router': nrm(ks[18], (DEPTH, N_EXPERTS), 0.01),
        'w_e_gate': nrm(ks[19], (DEPTH, N_EXPERTS, D_MODEL, D_FF_EXPERT), D_MODEL ** -0.5),
        'w_e_up': nrm(ks[20], (DEPTH, N_EXPERTS, D_MODEL, D_FF_EXPERT), D_MODEL ** -0.5),
        'w_e_down': nrm(ks[21], (DEPTH, N_EXPERTS, D_FF_EXPERT, D_MODEL), D_FF_EXPERT ** -0.5),
        'final_g': 1.0 + nrm(ks[22], (D_MODEL,), 0.02),
    }


def reference(x, norm1_g, w_in, conv_w, conv_b, w_rg_a, b_rg_a, w_rg_x, b_rg_x, lru_lambda,
              rel_bias, g_rec_out, g_att_out, w_out, norm2_g, w_group, b_group, w_router,
              b_router, w_e_gate, w_e_up, w_e_down, final_g):
    splits = [REC_WIDTH, 2 * REC_WIDTH, 2 * REC_WIDTH + ATT_WIDTH, 2 * REC_WIDTH + 2 * ATT_WIDTH]
    h = x
    for l in range(DEPTH):
        xn = rms_norm(h, norm1_g[l])
        z = xn @ w_in[l]
        u, gate, q, k, v = jnp.split(z, splits, axis=-1)
        y_rec = rg_lru_group(u, gate, conv_w[l], conv_b[l], w_rg_a[l], b_rg_a[l],
                             w_rg_x[l], b_rg_x[l], lru_lambda[l])
        y_att = chunk_attention_group(q, k, v, rel_bias[l])
        mix = jnp.concatenate([rms_norm(y_rec, g_rec_out[l]), rms_norm(y_att, g_att_out[l])], axis=-1)
        h = h + mix @ w_out[l]
        h = h + hierarchical_moe(rms_norm(h, norm2_g[l]), w_group[l], b_group[l], w_router[l],
                                 b_router[l], w_e_gate[l], w_e_up[l], w_e_down[l])
    return rms_norm(h, final_g)
```

```cpp
#include <hip/hip_runtime.h>
#include <hip/hip_cooperative_groups.h>
#include <cstdio>
#include <cstdint>
namespace cg = cooperative_groups;

#ifndef ONE_LAUNCH
#define ONE_LAUNCH 0
#endif

constexpr int D = 1024, NB = 8, S = 2048, T = NB * S;
constexpr int RW = 512, RHD = 64;
constexpr int AHD = 64, CHUNK = 64, LEFT = 8, BAND = 576, MAXREL = 128;
constexpr int INW = 2560;
constexpr int NE = 16, DFF = 512;
constexpr float EPS = 1e-6f;
constexpr int NTHR = 512;

struct Params {
    const float *x, *norm1_g, *w_in, *conv_w, *conv_b, *w_rg_a, *b_rg_a, *w_rg_x, *b_rg_x, *lru_lambda, *rel_bias,
        *g_rec_out, *g_att_out, *w_out, *norm2_g, *w_group, *b_group, *w_router, *b_router, *w_e_gate, *w_e_up, *w_e_down, *final_g;
    float* out;
    float* r1;
    float* r2;
    int* route_e;
    float* route_w;
};

__device__ __forceinline__ float wave_sum(float v) {
#pragma unroll
    for (int o = 32; o > 0; o >>= 1) v += __shfl_xor(v, o);
    return v;
}
__device__ __forceinline__ float sigmoidf_(float x) { return 1.0f / (1.0f + expf(-x)); }
__device__ __forceinline__ float gelu_tanh(float x) { return 0.5f * x * (1.0f + tanhf(0.7978845608028654f * (x + 0.044715f * x * x * x))); }

__device__ void ph_rmsnorm(const float* src, int lds_, int c0, int n, const float* g, float* dst, int ldd) {
    const int lane = threadIdx.x & 63, wv = threadIdx.x >> 6, nw = blockDim.x >> 6;
    for (int t = blockIdx.x * nw + wv; t < T; t += gridDim.x * nw) {
        const float* row = src + (size_t)t * lds_ + c0;
        float ss = 0.f;
        for (int i = lane; i < n; i += 64) { float v = row[i]; ss += v * v; }
        ss = wave_sum(ss);
        const float r = rsqrtf(ss / (float)n + EPS);
        float* drow = dst + (size_t)t * ldd + c0;
        for (int i = lane; i < n; i += 64) drow[i] = row[i] * r * g[i];
    }
}

__device__ void ph_gemm_f32(const float* A, const float* Bm, const float* res, float* C, int M, int N, int K, float* lds) {
    float* As = lds;
    float* Bs = lds + 16 * 132;
    const int tid = threadIdx.x, ty = tid >> 4, tx = tid & 15;
    const int ntm = M / 128, ntn = N / 64;
    for (int tile = blockIdx.x; tile < ntm * ntn; tile += gridDim.x) {
        const int tm = tile / ntn, tn = tile % ntn;
        float acc[4][4];
#pragma unroll
        for (int i = 0; i < 4; ++i)
#pragma unroll
            for (int j = 0; j < 4; ++j) acc[i][j] = 0.f;
        for (int k0 = 0; k0 < K; k0 += 16) {
            {
                const int r = tid >> 2, kq = (tid & 3) * 4;
                const float4 v = *(const float4*)(A + (size_t)(tm * 128 + r) * K + k0 + kq);
                As[(kq + 0) * 132 + r] = v.x; As[(kq + 1) * 132 + r] = v.y; As[(kq + 2) * 132 + r] = v.z; As[(kq + 3) * 132 + r] = v.w;
            }
            if (tid < 256) {
                const int kr = tid >> 4, c4 = (tid & 15) * 4;
                *(float4*)&Bs[kr * 68 + c4] = *(const float4*)(Bm + (size_t)(k0 + kr) * N + tn * 64 + c4);
            }
            __syncthreads();
#pragma unroll
            for (int kk = 0; kk < 16; ++kk) {
                const float4 a = *(const float4*)&As[kk * 132 + ty * 4];
                const float4 b = *(const float4*)&Bs[kk * 68 + tx * 4];
                const float av[4] = {a.x, a.y, a.z, a.w}, bv[4] = {b.x, b.y, b.z, b.w};
#pragma unroll
                for (int i = 0; i < 4; ++i)
#pragma unroll
                    for (int j = 0; j < 4; ++j) acc[i][j] += av[i] * bv[j];
            }
            __syncthreads();
        }
#pragma unroll
        for (int i = 0; i < 4; ++i) {
            const size_t off = (size_t)(tm * 128 + ty * 4 + i) * N + tn * 64 + tx * 4;
            float4 o = make_float4(acc[i][0], acc[i][1], acc[i][2], acc[i][3]);
            if (res) { const float4 rr = *(const float4*)(res + off); o.x += rr.x; o.y += rr.y; o.z += rr.z; o.w += rr.w; }
            *(float4*)(C + off) = o;
        }
    }
}

__device__ void ph_rglru_gates(const Params& p, const float* z, float* a_out, float* bx_out, float* lds) {
    float* uc_s = lds;
    const int c = threadIdx.x;
    const int h = c >> 6, j = c & 63;
    const float sp = log1pf(expf(-p.lru_lambda[c]));
    for (int t = blockIdx.x; t < T; t += gridDim.x) {
        const int s = t % S;
        float uc = p.conv_b[c];
#pragma unroll
        for (int jj = 0; jj < 4; ++jj) { const int sp_ = s - 3 + jj; if (sp_ >= 0) uc += z[(size_t)(t - 3 + jj) * INW + c] * p.conv_w[jj * RW + c]; }
        __syncthreads();
        uc_s[c] = uc;
        __syncthreads();
        float ra = p.b_rg_a[c], ri = p.b_rg_x[c];
        const float* wa = p.w_rg_a + (size_t)h * RHD * RHD + j;
        const float* wx = p.w_rg_x + (size_t)h * RHD * RHD + j;
        for (int i = 0; i < RHD; ++i) { const float u = uc_s[h * 64 + i]; ra += u * wa[i * RHD]; ri += u * wx[i * RHD]; }
        const float r = sigmoidf_(ra), ig = sigmoidf_(ri);
        const float log_a = -8.0f * r * sp;
        a_out[(size_t)t * RW + c] = expf(log_a);
        bx_out[(size_t)t * RW + c] = sqrtf(-expm1f(2.0f * log_a)) * (ig * uc);
    }
}

__device__ void ph_scan(const float* a_in, const float* bx_in, const float* z, float* mix) {
    const int gid = blockIdx.x * blockDim.x + threadIdx.x;
    if (gid >= NB * RW) return;
    const int b = gid / RW, c = gid % RW;
    float h = 0.f;
#pragma unroll 4
    for (int s = 0; s < S; ++s) {
        const size_t t = (size_t)b * S + s;
        h = a_in[t * RW + c] * h + bx_in[t * RW + c];
        mix[t * D + c] = h * gelu_tanh(z[t * INW + 512 + c]);
    }
}

__device__ void ph_attn_naive(const Params& p, const float* z, float* mix) {
    const int tid = threadIdx.x, hd = tid >> 6, qi = tid & 63;
    for (int item = blockIdx.x; item < NB * (S / CHUNK); item += gridDim.x) {
        const int b = item / (S / CHUNK), c = item % (S / CHUNK);
        const size_t tq = (size_t)b * S + c * CHUNK + qi;
        float q[64], o[64];
#pragma unroll
        for (int d = 0; d < 64; ++d) { q[d] = z[tq * INW + 1024 + hd * 64 + d] * 0.125f; o[d] = 0.f; }
        float m = -3.0e38f, l = 0.f;
        const int k_begin = (c >= LEFT) ? 0 : (LEFT - c) * CHUNK;
        for (int kk = k_begin; kk < BAND; ++kk) {
            const size_t tk = (size_t)b * S + (c - LEFT) * CHUNK + kk;
            const float* kp = z + tk * INW + 1536 + hd * 64;
            const float* vp = z + tk * INW + 2048 + hd * 64;
            float sc = 0.f;
#pragma unroll
            for (int d = 0; d < 64; ++d) sc += q[d] * kp[d];
            int rel = LEFT * CHUNK + qi - kk;
            rel = rel < -MAXREL ? -MAXREL : (rel > MAXREL ? MAXREL : rel);
            sc += p.rel_bias[hd * (2 * MAXREL + 1) + rel + MAXREL];
            const float mn = fmaxf(m, sc), alpha = expf(m - mn), pe = expf(sc - mn);
            l = l * alpha + pe;
#pragma unroll
            for (int d = 0; d < 64; ++d) o[d] = o[d] * alpha + pe * vp[d];
            m = mn;
        }
        const float inv = 1.0f / l;
#pragma unroll
        for (int d = 0; d < 64; ++d) mix[tq * D + 512 + hd * 64 + d] = o[d] * inv;
    }
}

__device__ void ph_router(const Params& p, const float* h, float* xn2) {
    const int lane = threadIdx.x & 63, wv = threadIdx.x >> 6, nw = blockDim.x >> 6;
    for (int t = blockIdx.x * nw + wv; t < T; t += gridDim.x * nw) {
        const float* row = h + (size_t)t * D;
        float v[16]; float ss = 0.f;
#pragma unroll
        for (int i = 0; i < 16; ++i) { v[i] = row[lane + 64 * i]; ss += v[i] * v[i]; }
        ss = wave_sum(ss);
        const float r = rsqrtf(ss / (float)D + EPS);
#pragma unroll
        for (int i = 0; i < 16; ++i) { v[i] = v[i] * r * p.norm2_g[lane + 64 * i]; xn2[(size_t)t * D + lane + 64 * i] = v[i]; }
        float lg[4], le[16];
#pragma unroll
        for (int g = 0; g < 4; ++g) { float a = 0.f;
#pragma unroll
            for (int i = 0; i < 16; ++i) a += v[i] * p.w_group[(lane + 64 * i) * 4 + g];
            lg[g] = wave_sum(a) + p.b_group[g]; }
#pragma unroll
        for (int e = 0; e < 16; ++e) { float a = 0.f;
#pragma unroll
            for (int i = 0; i < 16; ++i) a += v[i] * p.w_router[(lane + 64 * i) * 16 + e];
            le[e] = wave_sum(a) + p.b_router[e]; }
        if (lane == 0) {
            int g = 0; float best = lg[0];
#pragma unroll
            for (int i = 1; i < 4; ++i) if (lg[i] > best) { best = lg[i]; g = i; }
            float den = 0.f;
#pragma unroll
            for (int i = 0; i < 4; ++i) den += expf(lg[i] - best);
            const float pg = 1.0f / den;
            float sel[4];
#pragma unroll
            for (int i = 0; i < 4; ++i) { float s_ = le[i]; if (g == 1) s_ = le[4 + i]; if (g == 2) s_ = le[8 + i]; if (g == 3) s_ = le[12 + i]; sel[i] = s_; }
            int i1 = 0; float v1 = sel[0];
#pragma unroll
            for (int i = 1; i < 4; ++i) if (sel[i] > v1) { v1 = sel[i]; i1 = i; }
            int i2 = -1; float v2 = -3.0e38f;
#pragma unroll
            for (int i = 0; i < 4; ++i) if (i != i1 && sel[i] > v2) { v2 = sel[i]; i2 = i; }
            const float e2 = expf(v2 - v1);
            const float w1 = pg / (1.0f + e2), w2 = pg * e2 / (1.0f + e2);
            p.route_e[t * 2 + 0] = g * 4 + i1; p.route_e[t * 2 + 1] = g * 4 + i2;
            p.route_w[t * 2 + 0] = w1; p.route_w[t * 2 + 1] = w2;
        }
    }
}

__device__ void ph_moe_naive(const Params& p, const float* h, const float* xn2, float* out, float* lds) {
    float* xs = lds;
    float* hs = lds + 1024;
    float* red = lds + 1536;
    const int tid = threadIdx.x;
    for (int t = blockIdx.x; t < T; t += gridDim.x) {
        __syncthreads();
        xs[tid] = xn2[(size_t)t * D + tid]; xs[tid + 512] = xn2[(size_t)t * D + tid + 512];
        __syncthreads();
        float o0 = h[(size_t)t * D + tid], o1 = h[(size_t)t * D + tid + 512];
        for (int k = 0; k < 2; ++k) {
            const int e = p.route_e[t * 2 + k]; const float w = p.route_w[t * 2 + k];
            const float* wg = p.w_e_gate + (size_t)e * D * DFF + tid;
            const float* wu = p.w_e_up + (size_t)e * D * DFF + tid;
            float ag = 0.f, au = 0.f;
#pragma unroll 8
            for (int i = 0; i < D; ++i) { const float xv = xs[i]; ag += xv * wg[(size_t)i * DFF]; au += xv * wu[(size_t)i * DFF]; }
            __syncthreads();
            hs[tid] = ag * sigmoidf_(ag) * au;
            __syncthreads();
            const float* wd = p.w_e_down + (size_t)e * DFF * D;
            float y0 = 0.f, y1 = 0.f;
#pragma unroll 8
            for (int jx = 0; jx < DFF; ++jx) { const float hv = hs[jx]; y0 += hv * wd[(size_t)jx * D + tid]; y1 += hv * wd[(size_t)jx * D + tid + 512]; }
            o0 += w * y0; o1 += w * y1;
        }
        float ss = wave_sum(o0 * o0 + o1 * o1);
        if ((tid & 63) == 0) red[tid >> 6] = ss;
        __syncthreads();
        float tot = 0.f;
#pragma unroll
        for (int i = 0; i < 8; ++i) tot += red[i];
        const float r = rsqrtf(tot / (float)D + EPS);
        out[(size_t)t * D + tid] = o0 * r * p.final_g[tid];
        out[(size_t)t * D + tid + 512] = o1 * r * p.final_g[tid + 512];
    }
}

template <int PH>
__global__ void __launch_bounds__(NTHR) k_phase(Params p) {
    __shared__ float lds[4096];
    float* xn = p.r1; float* z = p.r2; float* a_ = p.r1; float* bx_ = p.r1 + (size_t)T * RW; float* mix = p.out; float* h = p.r1; float* xn2 = p.r2;
    if (PH == 0) ph_rmsnorm(p.x, D, 0, D, p.norm1_g, xn, D);
    if (PH == 1) ph_gemm_f32(xn, p.w_in, nullptr, z, T, INW, D, lds);
    if (PH == 2) ph_rglru_gates(p, z, a_, bx_, lds);
    if (PH == 3) ph_scan(a_, bx_, z, mix);
    if (PH == 4) ph_attn_naive(p, z, mix);
    if (PH == 5) { ph_rmsnorm(mix, D, 0, 512, p.g_rec_out, mix, D); ph_rmsnorm(mix, D, 512, 512, p.g_att_out, mix, D); }
    if (PH == 6) ph_gemm_f32(mix, p.w_out, p.x, h, T, D, D, lds);
    if (PH == 7) ph_router(p, h, xn2);
    if (PH == 8) ph_moe_naive(p, h, xn2, p.out, lds);
}

extern "C" void kernel_launch(void* const* d_in, const int* in_sizes, int n_in, void* d_out, int out_size, void* d_ws, size_t ws_size, hipStream_t stream) {
    Params p{};
    const float** f = (const float**)&p;
    for (int i = 0; i < 23; ++i) f[i] = (const float*)d_in[i];
    p.out = (float*)d_out;
    char* ws = (char*)d_ws;
    p.r1 = (float*)ws; ws += (size_t)T * D * 4;
    p.r2 = (float*)ws; ws += (size_t)T * INW * 4;
    p.route_e = (int*)ws; ws += (size_t)T * 2 * 4;
    p.route_w = (float*)ws; ws += (size_t)T * 2 * 4;
    const int G = 2048;
    k_phase<0><<<G, NTHR, 0, stream>>>(p);
    k_phase<1><<<G, NTHR, 0, stream>>>(p);
    k_phase<2><<<G, NTHR, 0, stream>>>(p);
    k_phase<3><<<8, NTHR, 0, stream>>>(p);
    k_phase<4><<<256, NTHR, 0, stream>>>(p);
    k_phase<5><<<G, NTHR, 0, stream>>>(p);
    k_phase<6><<<G, NTHR, 0, stream>>>(p);
    k_phase<7><<<G, NTHR, 0, stream>>>(p);
    k_phase<8><<<G, NTHR, 0, stream>>>(p);
}
```

```cpp
#include <hip/hip_runtime.h>
#include <hip/hip_cooperative_groups.h>
#include <cstdio>
#include <cstdint>
namespace cg = cooperative_groups;

#ifndef ONE_LAUNCH
#define ONE_LAUNCH 0
#endif

constexpr int D = 1024, NB = 8, S = 2048, T = NB * S;
constexpr int RW = 512, RHD = 64;
constexpr int AHD = 64, CHUNK = 64, LEFT = 8, BAND = 576, MAXREL = 128;
constexpr int INW = 2560;
constexpr int NE = 16, DFF = 512;
constexpr float EPS = 1e-6f;
constexpr int NTHR = 512;

struct Params {
    const float *x, *norm1_g, *w_in, *conv_w, *conv_b, *w_rg_a, *b_rg_a, *w_rg_x, *b_rg_x, *lru_lambda, *rel_bias,
        *g_rec_out, *g_att_out, *w_out, *norm2_g, *w_group, *b_group, *w_router, *b_router, *w_e_gate, *w_e_up, *w_e_down, *final_g;
    float* out;
    float* r1;
    float* r2;
    int* route_e;
    float* route_w;
};

__device__ __forceinline__ float wave_sum(float v) {
#pragma unroll
    for (int o = 32; o > 0; o >>= 1) v += __shfl_xor(v, o);
    return v;
}
__device__ __forceinline__ float sigmoidf_(float x) { return 1.0f / (1.0f + expf(-x)); }
__device__ __forceinline__ float gelu_tanh(float x) { return 0.5f * x * (1.0f + tanhf(0.7978845608028654f * (x + 0.044715f * x * x * x))); }

__device__ void ph_rmsnorm(const float* src, int lds_, int c0, int n, const float* g, float* dst, int ldd) {
    const int lane = threadIdx.x & 63, wv = threadIdx.x >> 6, nw = blockDim.x >> 6;
    for (int t = blockIdx.x * nw + wv; t < T; t += gridDim.x * nw) {
        const float* row = src + (size_t)t * lds_ + c0;
        float ss = 0.f;
        for (int i = lane; i < n; i += 64) { float v = row[i]; ss += v * v; }
        ss = wave_sum(ss);
        const float r = rsqrtf(ss / (float)n + EPS);
        float* drow = dst + (size_t)t * ldd + c0;
        for (int i = lane; i < n; i += 64) drow[i] = row[i] * r * g[i];
    }
}

__device__ void ph_gemm_f32(const float* A, const float* Bm, const float* res, float* C, int M, int N, int K, float* lds) {
    float* As = lds;
    float* Bs = lds + 16 * 132;
    const int tid = threadIdx.x, ty = tid >> 4, tx = tid & 15;
    const int ntm = M / 128, ntn = N / 64;
    for (int tile = blockIdx.x; tile < ntm * ntn; tile += gridDim.x) {
        const int tm = tile / ntn, tn = tile % ntn;
        float acc[4][4];
#pragma unroll
        for (int i = 0; i < 4; ++i)
#pragma unroll
            for (int j = 0; j < 4; ++j) acc[i][j] = 0.f;
        for (int k0 = 0; k0 < K; k0 += 16) {
            {
                const int r = tid >> 2, kq = (tid & 3) * 4;
                const float4 v = *(const float4*)(A + (size_t)(tm * 128 + r) * K + k0 + kq);
                As[(kq + 0) * 132 + r] = v.x; As[(kq + 1) * 132 + r] = v.y; As[(kq + 2) * 132 + r] = v.z; As[(kq + 3) * 132 + r] = v.w;
            }
            if (tid < 256) {
                const int kr = tid >> 4, c4 = (tid & 15) * 4;
                *(float4*)&Bs[kr * 68 + c4] = *(const float4*)(Bm + (size_t)(k0 + kr) * N + tn * 64 + c4);
            }
            __syncthreads();
#pragma unroll 4
            for (int kk = 0; kk < 16; ++kk) {
                const float4 a = *(const float4*)&As[kk * 132 + ty * 4];
                const float4 b = *(const float4*)&Bs[kk * 68 + tx * 4];
                const float av[4] = {a.x, a.y, a.z, a.w}, bv[4] = {b.x, b.y, b.z, b.w};
#pragma unroll
                for (int i = 0; i < 4; ++i)
#pragma unroll
                    for (int j = 0; j < 4; ++j) acc[i][j] += av[i] * bv[j];
            }
            __syncthreads();
        }
#pragma unroll
        for (int i = 0; i < 4; ++i) {
            const size_t off = (size_t)(tm * 128 + ty * 4 + i) * N + tn * 64 + tx * 4;
            float4 o = make_float4(acc[i][0], acc[i][1], acc[i][2], acc[i][3]);
            if (res) { const float4 rr = *(const float4*)(res + off); o.x += rr.x; o.y += rr.y; o.z += rr.z; o.w += rr.w; }
            *(float4*)(C + off) = o;
        }
    }
}

__device__ void ph_rglru_gates(const Params& p, const float* z, float* a_out, float* bx_out, float* lds) {
    float* uc_s = lds;
    const int c = threadIdx.x;
    const int h = c >> 6, j = c & 63;
    const float sp = log1pf(expf(-p.lru_lambda[c]));
    for (int t = blockIdx.x; t < T; t += gridDim.x) {
        const int s = t % S;
        float uc = p.conv_b[c];
#pragma unroll
        for (int jj = 0; jj < 4; ++jj) { const int sp_ = s - 3 + jj; if (sp_ >= 0) uc += z[(size_t)(t - 3 + jj) * INW + c] * p.conv_w[jj * RW + c]; }
        __syncthreads();
        uc_s[c] = uc;
        __syncthreads();
        float ra = p.b_rg_a[c], ri = p.b_rg_x[c];
        const float* wa = p.w_rg_a + (size_t)h * RHD * RHD + j;
        const float* wx = p.w_rg_x + (size_t)h * RHD * RHD + j;
#pragma unroll 4
        for (int i = 0; i < RHD; ++i) { const float u = uc_s[h * 64 + i]; ra += u * wa[i * RHD]; ri += u * wx[i * RHD]; }
        const float r = sigmoidf_(ra), ig = sigmoidf_(ri);
        const float log_a = -8.0f * r * sp;
        a_out[(size_t)t * RW + c] = expf(log_a);
        bx_out[(size_t)t * RW + c] = sqrtf(-expm1f(2.0f * log_a)) * (ig * uc);
    }
}

__device__ void ph_scan(const float* a_in, const float* bx_in, const float* z, float* mix) {
    const int gid = blockIdx.x * blockDim.x + threadIdx.x;
    if (gid >= NB * RW) return;
    const int b = gid / RW, c = gid % RW;
    float h = 0.f;
#pragma unroll 4
    for (int s = 0; s < S; ++s) {
        const size_t t = (size_t)b * S + s;
        h = a_in[t * RW + c] * h + bx_in[t * RW + c];
        mix[t * D + c] = h * gelu_tanh(z[t * INW + 512 + c]);
    }
}

__device__ void ph_attn_naive(const Params& p, const float* z, float* mix) {
    const int tid = threadIdx.x, hd = tid >> 6, qi = tid & 63;
    for (int item = blockIdx.x; item < NB * (S / CHUNK); item += gridDim.x) {
        const int b = item / (S / CHUNK), c = item % (S / CHUNK);
        const size_t tq = (size_t)b * S + c * CHUNK + qi;
        float q[64], o[64];
#pragma unroll
        for (int d = 0; d < 64; ++d) { q[d] = z[tq * INW + 1024 + hd * 64 + d] * 0.125f; o[d] = 0.f; }
        float m = -3.0e38f, l = 0.f;
        const int k_begin = (c >= LEFT) ? 0 : (LEFT - c) * CHUNK;
        for (int kk = k_begin; kk < BAND; ++kk) {
            const size_t tk = (size_t)b * S + (c - LEFT) * CHUNK + kk;
            const float* kp = z + tk * INW + 1536 + hd * 64;
            const float* vp = z + tk * INW + 2048 + hd * 64;
            float sc = 0.f;
#pragma unroll
            for (int d = 0; d < 64; ++d) sc += q[d] * kp[d];
            int rel = LEFT * CHUNK + qi - kk;
            rel = rel < -MAXREL ? -MAXREL : (rel > MAXREL ? MAXREL : rel);
            sc += p.rel_bias[hd * (2 * MAXREL + 1) + rel + MAXREL];
            const float mn = fmaxf(m, sc), alpha = expf(m - mn), pe = expf(sc - mn);
            l = l * alpha + pe;
#pragma unroll
            for (int d = 0; d < 64; ++d) o[d] = o[d] * alpha + pe * vp[d];
            m = mn;
        }
        const float inv = 1.0f / l;
#pragma unroll
        for (int d = 0; d < 64; ++d) mix[tq * D + 512 + hd * 64 + d] = o[d] * inv;
    }
}

__device__ void ph_router(const Params& p, const float* h, float* xn2) {
    const int lane = threadIdx.x & 63, wv = threadIdx.x >> 6, nw = blockDim.x >> 6;
    for (int t = blockIdx.x * nw + wv; t < T; t += gridDim.x * nw) {
        const float* row = h + (size_t)t * D;
        float v[16]; float ss = 0.f;
#pragma unroll
        for (int i = 0; i < 16; ++i) { v[i] = row[lane + 64 * i]; ss += v[i] * v[i]; }
        ss = wave_sum(ss);
        const float r = rsqrtf(ss / (float)D + EPS);
#pragma unroll
        for (int i = 0; i < 16; ++i) { v[i] = v[i] * r * p.norm2_g[lane + 64 * i]; xn2[(size_t)t * D + lane + 64 * i] = v[i]; }
        float lg[4], le[16];
#pragma unroll
        for (int g = 0; g < 4; ++g) lg[g] = 0.f;
#pragma unroll
        for (int e = 0; e < 16; ++e) le[e] = 0.f;
#pragma unroll
        for (int i = 0; i < 16; ++i) {
            const int k = lane + 64 * i;
            const float4 wg = *(const float4*)(p.w_group + (size_t)k * 4);
            lg[0] += v[i] * wg.x; lg[1] += v[i] * wg.y; lg[2] += v[i] * wg.z; lg[3] += v[i] * wg.w;
#pragma unroll
            for (int e4 = 0; e4 < 4; ++e4) {
                const float4 wr = *(const float4*)(p.w_router + (size_t)k * 16 + e4 * 4);
                le[e4 * 4 + 0] += v[i] * wr.x; le[e4 * 4 + 1] += v[i] * wr.y; le[e4 * 4 + 2] += v[i] * wr.z; le[e4 * 4 + 3] += v[i] * wr.w;
            }
        }
#pragma unroll
        for (int g = 0; g < 4; ++g) lg[g] = wave_sum(lg[g]) + p.b_group[g];
#pragma unroll
        for (int e = 0; e < 16; ++e) le[e] = wave_sum(le[e]) + p.b_router[e];
        float mine = 0.f;
#pragma unroll
        for (int e = 0; e < 16; ++e) mine = (lane == e) ? le[e] : mine;
        int g = 0; float best = lg[0];
#pragma unroll
        for (int i = 1; i < 4; ++i) if (lg[i] > best) { best = lg[i]; g = i; }
        float sel[4];
#pragma unroll
        for (int i = 0; i < 4; ++i) sel[i] = __shfl(mine, g * 4 + i);
        if (lane == 0) {
            float den = 0.f;
#pragma unroll
            for (int i = 0; i < 4; ++i) den += expf(lg[i] - best);
            const float pg = 1.0f / den;
            int i1 = 0; float v1 = sel[0];
#pragma unroll
            for (int i = 1; i < 4; ++i) if (sel[i] > v1) { v1 = sel[i]; i1 = i; }
            int i2 = -1; float v2 = -3.0e38f;
#pragma unroll
            for (int i = 0; i < 4; ++i) if (i != i1 && sel[i] > v2) { v2 = sel[i]; i2 = i; }
            const float e2 = expf(v2 - v1);
            const float w1 = pg / (1.0f + e2), w2 = pg * e2 / (1.0f + e2);
            p.route_e[t * 2 + 0] = g * 4 + i1; p.route_e[t * 2 + 1] = g * 4 + i2;
            p.route_w[t * 2 + 0] = w1; p.route_w[t * 2 + 1] = w2;
        }
    }
}

__device__ void ph_moe_naive(const Params& p, const float* h, const float* xn2, float* out, float* lds) {
    float* xs = lds;
    float* hs = lds + 1024;
    float* red = lds + 1536;
    const int tid = threadIdx.x;
    for (int t = blockIdx.x; t < T; t += gridDim.x) {
        __syncthreads();
        xs[tid] = xn2[(size_t)t * D + tid]; xs[tid + 512] = xn2[(size_t)t * D + tid + 512];
        __syncthreads();
        float o0 = h[(size_t)t * D + tid], o1 = h[(size_t)t * D + tid + 512];
        for (int k = 0; k < 2; ++k) {
            const int e = p.route_e[t * 2 + k]; const float w = p.route_w[t * 2 + k];
            const float* wg = p.w_e_gate + (size_t)e * D * DFF + tid;
            const float* wu = p.w_e_up + (size_t)e * D * DFF + tid;
            float ag = 0.f, au = 0.f;
#pragma unroll 8
            for (int i = 0; i < D; ++i) { const float xv = xs[i]; ag += xv * wg[(size_t)i * DFF]; au += xv * wu[(size_t)i * DFF]; }
            __syncthreads();
            hs[tid] = ag * sigmoidf_(ag) * au;
            __syncthreads();
            const float* wd = p.w_e_down + (size_t)e * DFF * D;
            float y0 = 0.f, y1 = 0.f;
#pragma unroll 8
            for (int jx = 0; jx < DFF; ++jx) { const float hv = hs[jx]; y0 += hv * wd[(size_t)jx * D + tid]; y1 += hv * wd[(size_t)jx * D + tid + 512]; }
            o0 += w * y0; o1 += w * y1;
        }
        float ss = wave_sum(o0 * o0 + o1 * o1);
        if ((tid & 63) == 0) red[tid >> 6] = ss;
        __syncthreads();
        float tot = 0.f;
#pragma unroll
        for (int i = 0; i < 8; ++i) tot += red[i];
        const float r = rsqrtf(tot / (float)D + EPS);
        out[(size_t)t * D + tid] = o0 * r * p.final_g[tid];
        out[(size_t)t * D + tid + 512] = o1 * r * p.final_g[tid + 512];
    }
}

__global__ void __launch_bounds__(NTHR) k_mega(Params p) {
    __shared__ float lds[4096];
    cg::grid_group grid = cg::this_grid();
    float* xn = p.r1; float* z = p.r2; float* a_ = p.r1; float* bx_ = p.r1 + (size_t)T * RW; float* mix = p.out; float* h = p.r1; float* xn2 = p.r2;
    ph_rmsnorm(p.x, D, 0, D, p.norm1_g, xn, D);
    grid.sync();
    ph_gemm_f32(xn, p.w_in, nullptr, z, T, INW, D, lds);
    grid.sync();
    ph_rglru_gates(p, z, a_, bx_, lds);
    ph_attn_naive(p, z, mix);
    grid.sync();
    ph_scan(a_, bx_, z, mix);
    grid.sync();
    ph_rmsnorm(mix, D, 0, 512, p.g_rec_out, mix, D); ph_rmsnorm(mix, D, 512, 512, p.g_att_out, mix, D);
    grid.sync();
    ph_gemm_f32(mix, p.w_out, p.x, h, T, D, D, lds);
    grid.sync();
    ph_router(p, h, xn2);
    grid.sync();
    ph_moe_naive(p, h, xn2, p.out, lds);
}

extern "C" void kernel_launch(void* const* d_in, const int* in_sizes, int n_in, void* d_out, int out_size, void* d_ws, size_t ws_size, hipStream_t stream) {
    Params p{};
    const float** f = (const float**)&p;
    for (int i = 0; i < 23; ++i) f[i] = (const float*)d_in[i];
    p.out = (float*)d_out;
    char* ws = (char*)d_ws;
    p.r1 = (float*)ws; ws += (size_t)T * D * 4;
    p.r2 = (float*)ws; ws += (size_t)T * INW * 4;
    p.route_e = (int*)ws; ws += (size_t)T * 2 * 4;
    p.route_w = (float*)ws; ws += (size_t)T * 2 * 4;
    static int grid_blocks = 0;
    if (!grid_blocks) {
        int dev = 0, cus = 0, per_cu = 0;
        hipGetDevice(&dev);
        hipDeviceGetAttribute(&cus, hipDeviceAttributeMultiprocessorCount, dev);
        hipOccupancyMaxActiveBlocksPerMultiprocessor(&per_cu, k_mega, NTHR, 0);
        if (per_cu > 2) per_cu = 2;
        grid_blocks = cus * per_cu;
    }
    void* args[] = {&p};
    hipError_t e = hipLaunchCooperativeKernel((void*)k_mega, dim3(grid_blocks), dim3(NTHR), args, 0, stream);
    if (e != hipSuccess) fprintf(stderr, "cooperative launch failed: %s (grid %d)\n", hipGetErrorString(e), grid_blocks);
}
```

```cpp
#include <hip/hip_runtime.h>
#include <hip/hip_cooperative_groups.h>
#include <cstdio>
#include <cstdint>
namespace cg = cooperative_groups;

#define LAS __attribute__((address_space(3)))
typedef unsigned short bf16_t;
typedef short bf16x8 __attribute__((ext_vector_type(8)));
typedef float f32x4 __attribute__((ext_vector_type(4)));
typedef float f32x2 __attribute__((ext_vector_type(2)));
typedef unsigned u32x4 __attribute__((ext_vector_type(4)));
typedef unsigned u32x2 __attribute__((ext_vector_type(2)));

constexpr int D = 1024, NB = 8, S = 2048, T = NB * S;
constexpr int RW = 512, RHD = 64;
constexpr int CHUNK = 64, LEFT = 8, BAND = 576, MAXREL = 128;
constexpr int INW = 2560;
constexpr int NE = 16, DFF = 512;
constexpr float EPS = 1e-6f;
constexpr int NTHR = 512, NWAVES = 8;
constexpr int SSQW = 24;

constexpr size_t MiB = 1u << 20;
constexpr size_t WS_CTL = 0, CTL_BYTES = 1 * MiB;
constexpr size_t WS_WIN = 1 * MiB;
constexpr size_t WS_WOUT = 6 * MiB;
constexpr size_t WS_WGU = 8 * MiB;
constexpr size_t WS_WD = 40 * MiB;
constexpr size_t WS_XB = 56 * MiB;
constexpr size_t WS_Z = 88 * MiB;
constexpr size_t WS_MIX = 168 * MiB;
constexpr size_t WS_HID = 200 * MiB;
constexpr size_t WS_SSQ = 236 * MiB;
constexpr size_t WS_LIST = 238 * MiB;
constexpr size_t WS_ROUTE = 240 * MiB;
constexpr size_t WS_END = 241 * MiB;

struct Params {
    const float *x, *norm1_g, *w_in, *conv_w, *conv_b, *w_rg_a, *b_rg_a, *w_rg_x, *b_rg_x, *lru_lambda, *rel_bias,
        *g_rec_out, *g_att_out, *w_out, *norm2_g, *w_group, *b_group, *w_router, *b_router, *w_e_gate, *w_e_up, *w_e_down, *final_g;
    float* out;
    unsigned char* ws;
};

__device__ __forceinline__ float wave_sum(float v) {
#pragma unroll
    for (int o = 32; o > 0; o >>= 1) v += __shfl_xor(v, o);
    return v;
}
__device__ __forceinline__ float sigmoidf_(float x) { return 1.0f / (1.0f + expf(-x)); }
__device__ __forceinline__ float gelu_tanh(float x) { return 0.5f * x * (1.0f + tanhf(0.7978845608028654f * (x + 0.044715f * x * x * x))); }
__device__ __forceinline__ unsigned f2bf(float f) { unsigned u = __builtin_bit_cast(unsigned, f); return (u + 0x7fffu + ((u >> 16) & 1u)) >> 16; }
__device__ __forceinline__ unsigned pk2(float lo, float hi) { return f2bf(lo) | (f2bf(hi) << 16); }
__device__ __forceinline__ float bf2f(bf16_t b) { return __builtin_bit_cast(float, ((unsigned)b) << 16); }
__device__ __forceinline__ unsigned cvt_pk_bf16(float lo, float hi) { unsigned r; asm volatile("v_cvt_pk_bf16_f32 %0, %1, %2" : "=v"(r) : "v"(lo), "v"(hi)); return r; }
#define LDS_WAIT() asm volatile("s_waitcnt lgkmcnt(0)" ::: "memory")

namespace pg8 {
constexpr int BM = 256, BK = 64, HALF = 128, HTB = HALF * BK * 2, STAGE_BYTES = 8 * HTB, NXCD = 8, WGM = 8;
__device__ __forceinline__ int lds_byte(int r, int c) { const int st = (r >> 4) * 2 + (c >> 5), rr = r & 15, cc = c & 31, ob = rr * 64 + cc * 2; return st * 1024 + (ob ^ (((ob >> 9) & 1) << 5)); }
__device__ __forceinline__ void stage_rc(int b, int& R, int& C) { const int st = b / 1024, sb = b % 1024, swz = sb ^ (((sb >> 9) & 1) << 5); R = (st >> 1) * 16 + swz / 64; C = (st & 1) * 32 + (swz % 64) / 2; }
__device__ __forceinline__ int perm32(int rho) { const int n = rho >> 4, i = rho & 15; return 8 * (i >> 2) + 4 * n + (i & 3); }

struct Unit { int pm, pn, e, rows; };

struct DenseOrder {
    const bf16_t* A; const bf16_t* Bt; int K; int nM, nN, nwg, G, c;
    __device__ void init(const bf16_t* A_, const bf16_t* Bt_, int M, int N, int K_, int G_, int c_) { A = A_; Bt = Bt_; K = K_; nM = M / BM; nN = N / BM; nwg = nM * nN; G = G_; c = c_; }
    __device__ __forceinline__ bool next(int i, Unit& u) const {
        const long L = (long)i * G + c; if (L >= nwg) return false;
        int wgid = (int)L; { const int q = nwg / NXCD, r = nwg % NXCD, xcd = wgid % NXCD, off = wgid / NXCD; wgid = (xcd < r ? xcd * (q + 1) : r * (q + 1) + (xcd - r) * q) + off; }
        const int nig = WGM * nN, gid = wgid / nig, fm = gid * WGM, gsz = (nM - fm) < WGM ? (nM - fm) : WGM;
        u.pm = fm + ((wgid % nig) % gsz); u.pn = (wgid % nig) / gsz; u.e = 0; u.rows = BM; return true;
    }
    __device__ __forceinline__ void addr(const Unit& u, const int (&RA)[2], const int (&CA)[2], const char*& aBase, const char*& bBase, unsigned (&va)[2][2]) const {
        aBase = (const char*)A; bBase = (const char*)Bt + (size_t)u.pn * BM * K * 2;
#pragma unroll
        for (int h = 0; h < 2; ++h)
#pragma unroll
            for (int i = 0; i < 2; ++i) va[h][i] = (unsigned)(((size_t)(u.pm * BM + h * HALF + RA[i]) * K + CA[i]) * 2);
    }
};

template <class Epi, class Sched>
__device__ __forceinline__ void gemm_phase(LAS unsigned char* lds, const int K, const Sched& S, const Epi& E) {
    int tid_ = threadIdx.x; asm volatile("" : "+v"(tid_));
    const int tid = tid_, wid = __builtin_amdgcn_readfirstlane(tid >> 6), lane = tid & 63, wr = wid >> 2, wc = wid & 3, fr = lane & 15, fq = lane >> 4;
    const int nt = K / BK;
    int RA[2], CA[2]; unsigned voffB[2];
#pragma unroll
    for (int i = 0; i < 2; ++i) { int R, C; stage_rc(tid * 16 + i * 8192, R, C); RA[i] = R; CA[i] = C; const int Rb = Epi::PERM ? ((R & ~31) + perm32(R & 31)) : R; voffB[i] = (unsigned)(Rb * K + C) * 2u; }
    const size_t kstep = (size_t)(BK * 2);
    const size_t hstepB = (size_t)HALF * K * 2;
    const unsigned ldsw = (unsigned)wid * 1024u;
    const int aoff = lds_byte(wr * 64 + fr, fq * 8), boff = lds_byte(wc * 32 + fr, fq * 8);
#define PG8_SA(b, h) (((b) * 2 + (h)) * HTB)
#define PG8_SB(b, h) ((4 + (b) * 2 + (h)) * HTB)
#define PG8_STAGE_B(bufoff, gbase) do { _Pragma("unroll") for (int _i = 0; _i < 2; ++_i) \
        __builtin_amdgcn_global_load_lds((const unsigned*)((const char*)(gbase) + voffB[_i]), (LAS unsigned*)(lds + (bufoff) + ldsw + _i * 8192), 16, 0, 0); } while (0)
#define PG8_STAGE_A(bufoff, gbase, v0, v1) do { \
        __builtin_amdgcn_global_load_lds((const unsigned*)((const char*)(gbase) + (v0)), (LAS unsigned*)(lds + (bufoff) + ldsw), 16, 0, 0); \
        __builtin_amdgcn_global_load_lds((const unsigned*)((const char*)(gbase) + (v1)), (LAS unsigned*)(lds + (bufoff) + ldsw + 8192), 16, 0, 0); } while (0)
#define PG8_LDA(dst, b, h) do { _Pragma("unroll") for (int m = 0; m < 4; ++m) _Pragma("unroll") for (int k = 0; k < 2; ++k) dst[m][k] = *(const LAS bf16x8*)(lds + PG8_SA(b, h) + aoff + m * 2048 + k * 1024); } while (0)
#define PG8_LDB(dst, b, h) do { _Pragma("unroll") for (int n = 0; n < 2; ++n) _Pragma("unroll") for (int k = 0; k < 2; ++k) dst[n][k] = *(const LAS bf16x8*)(lds + PG8_SB(b, h) + boff + n * 2048 + k * 1024); } while (0)
#define PG8_MMA(ai, bj, At, Bt) do { __builtin_amdgcn_s_setprio(1); _Pragma("unroll") for (int m = 0; m < 4; ++m) _Pragma("unroll") for (int n = 0; n < 2; ++n) _Pragma("unroll") for (int k = 0; k < 2; ++k) \
        acc[ai][bj][m][n] = __builtin_amdgcn_mfma_f32_16x16x32_bf16(Bt[n][k], At[m][k], acc[ai][bj][m][n], 0, 0, 0); __builtin_amdgcn_s_setprio(0); } while (0)
#define PG8_WAIT_V(n) asm volatile("s_waitcnt vmcnt(" #n ")" ::: "memory")
#define PG8_WAIT_L(n) asm volatile("s_waitcnt lgkmcnt(" #n ")" ::: "memory")
#define PG8_BAR __builtin_amdgcn_s_barrier()
#define PG8_SCHED __builtin_amdgcn_sched_barrier(0)
    Unit cur, nxt; int ui = 0;
    if (!S.next(0, cur)) return;
    f32x4 acc[2][2][4][2];
#pragma unroll
    for (int a = 0; a < 2; ++a)
#pragma unroll
        for (int b = 0; b < 2; ++b)
#pragma unroll
            for (int m = 0; m < 4; ++m)
#pragma unroll
                for (int n = 0; n < 2; ++n) acc[a][b][m][n] = (f32x4){0.f, 0.f, 0.f, 0.f};
    bf16x8 At[4][2], B0[2][2], B1[2][2];
    const char *cA, *cB, *nA, *nB; unsigned cva[2][2], nva[2][2];
    S.addr(cur, RA, CA, cA, cB, cva);
    E.prepare(cur, ui, lds);
    PG8_STAGE_B(PG8_SB(0, 0), cB); PG8_STAGE_A(PG8_SA(0, 0), cA, cva[0][0], cva[0][1]); PG8_STAGE_B(PG8_SB(0, 1), cB + hstepB); PG8_STAGE_A(PG8_SA(0, 1), cA, cva[1][0], cva[1][1]);
    if (wr == 1) PG8_BAR;
    PG8_WAIT_V(4); PG8_BAR;
    PG8_STAGE_B(PG8_SB(1, 0), cB + kstep); PG8_STAGE_A(PG8_SA(1, 0), cA + kstep, cva[0][0], cva[0][1]); PG8_STAGE_B(PG8_SB(1, 1), cB + hstepB + kstep);
    PG8_WAIT_V(6); PG8_BAR;
    for (;;) {
        const bool has_next = S.next(ui + 1, nxt);
        if (has_next) { S.addr(nxt, RA, CA, nA, nB, nva); }
        else { nA = cA; nB = cB;
#pragma unroll
            for (int h = 0; h < 2; ++h)
#pragma unroll
                for (int i = 0; i < 2; ++i) nva[h][i] = cva[h][i]; }
        for (int t = 0; t < nt; t += 2) {
            const bool last = (t == nt - 2);
            if (Epi::MIDSCALE && t == nt / 2) E.midscale(acc, wr, fr, ui, lds);
            const char* a1 = cA + (size_t)(t + 1) * kstep;
            const char* a2 = last ? nA : cA + (size_t)(t + 2) * kstep; const char* b2 = last ? nB : cB + (size_t)(t + 2) * kstep;
            const char* a3 = a2 + kstep; const char* b3 = b2 + kstep;
            const unsigned x00 = last ? nva[0][0] : cva[0][0], x01 = last ? nva[0][1] : cva[0][1], x10 = last ? nva[1][0] : cva[1][0], x11 = last ? nva[1][1] : cva[1][1];
            if (last && has_next) E.prepare(nxt, ui + 1, lds);
            PG8_LDB(B0, 0, 0); PG8_SCHED; PG8_LDA(At, 0, 0); PG8_STAGE_A(PG8_SA(1, 1), a1, cva[1][0], cva[1][1]);
            PG8_WAIT_L(8); PG8_BAR; PG8_WAIT_L(0); PG8_MMA(0, 0, At, B0); PG8_BAR; PG8_SCHED;
            PG8_LDB(B1, 0, 1); PG8_STAGE_B(PG8_SB(0, 0), b2);
            PG8_BAR; PG8_WAIT_L(0); PG8_MMA(0, 1, At, B1); PG8_BAR;
            PG8_LDA(At, 0, 1); PG8_STAGE_A(PG8_SA(0, 0), a2, x00, x01);
            PG8_BAR; PG8_WAIT_L(0); PG8_MMA(1, 0, At, B0); PG8_BAR; PG8_SCHED;
            PG8_STAGE_B(PG8_SB(0, 1), b2 + hstepB);
            PG8_WAIT_V(6); PG8_BAR; PG8_MMA(1, 1, At, B1); PG8_BAR;
            PG8_LDB(B0, 1, 0); PG8_SCHED; PG8_LDA(At, 1, 0); PG8_STAGE_A(PG8_SA(0, 1), a2, x10, x11);
            PG8_WAIT_L(8); PG8_BAR; PG8_WAIT_L(0); PG8_MMA(0, 0, At, B0); PG8_BAR; PG8_SCHED;
            PG8_LDB(B1, 1, 1); PG8_STAGE_B(PG8_SB(1, 0), b3);
            PG8_BAR; PG8_WAIT_L(0); PG8_MMA(0, 1, At, B1); PG8_BAR;
            PG8_LDA(At, 1, 1); PG8_STAGE_A(PG8_SA(1, 0), a3, x00, x01);
            PG8_BAR; PG8_WAIT_L(0); PG8_MMA(1, 0, At, B0); PG8_BAR; PG8_SCHED;
            PG8_STAGE_B(PG8_SB(1, 1), b3 + hstepB);
            PG8_WAIT_V(6); PG8_BAR; PG8_MMA(1, 1, At, B1); PG8_BAR;
        }
        E(acc, cur, wr, wc, fr, fq, ui, lds);
        if (!has_next) break;
#pragma unroll
        for (int a = 0; a < 2; ++a)
#pragma unroll
            for (int b = 0; b < 2; ++b)
#pragma unroll
                for (int m = 0; m < 4; ++m)
#pragma unroll
                    for (int n = 0; n < 2; ++n) acc[a][b][m][n] = (f32x4){0.f, 0.f, 0.f, 0.f};
        cur = nxt; cA = nA; cB = nB; ++ui;
#pragma unroll
        for (int h = 0; h < 2; ++h)
#pragma unroll
            for (int i = 0; i < 2; ++i) cva[h][i] = nva[h][i];
    }
    PG8_WAIT_V(0);
    if (wr == 0) PG8_BAR;
    PG8_BAR;
#undef PG8_SA
#undef PG8_SB
#undef PG8_STAGE_A
#undef PG8_STAGE_B
#undef PG8_LDA
#undef PG8_LDB
#undef PG8_MMA
#undef PG8_WAIT_V
#undef PG8_WAIT_L
#undef PG8_BAR
#undef PG8_SCHED
}

struct EpiZ {
    static constexpr bool PERM = true, MIDSCALE = false;
    bf16_t* O; int ldc;
    __device__ __forceinline__ void prepare(const Unit&, int, LAS unsigned char*) const {}
    __device__ __forceinline__ void midscale(f32x4 (&)[2][2][4][2], int, int, int, LAS unsigned char*) const {}
    __device__ __forceinline__ void operator()(const f32x4 (&acc)[2][2][4][2], const Unit& u, int wr, int wc, int fr, int fq, int, LAS unsigned char*) const {
        const int row0 = u.pm * BM + wr * 64 + fr, col0 = u.pn * BM + wc * 32 + 8 * fq;
#pragma unroll
        for (int ai = 0; ai < 2; ++ai)
#pragma unroll
            for (int m = 0; m < 4; ++m) { bf16_t* rowp = O + (size_t)(row0 + ai * HALF + m * 16) * ldc + col0;
#pragma unroll
                for (int bj = 0; bj < 2; ++bj) { const f32x4 v0 = acc[ai][bj][m][0], v1 = acc[ai][bj][m][1];
                    u32x4 w; w.x = cvt_pk_bf16(v0[0], v0[1]); w.y = cvt_pk_bf16(v0[2], v0[3]); w.z = cvt_pk_bf16(v1[0], v1[1]); w.w = cvt_pk_bf16(v1[2], v1[3]);
                    *(u32x4*)(rowp + bj * HALF) = w; } }
    }
};
struct EpiH {
    static constexpr bool PERM = false, MIDSCALE = true;
    const float* ssq; const float* x; float* h; int tab_off;
    __device__ __forceinline__ void prepare(const Unit& u, int ui, LAS unsigned char* lds) const {
        LAS f32x2* tab = (LAS f32x2*)(lds + tab_off) + (ui & 1) * 256;
        if (threadIdx.x < 256) {
            const float* sp = ssq + (size_t)(u.pm * BM + threadIdx.x) * SSQW; float sa = 0.f, sb = 0.f;
#pragma unroll
            for (int i = 0; i < 4; ++i) { const f32x4 v = *(const f32x4*)(sp + 4 * i); sa += (v[0] + v[1]) + (v[2] + v[3]); }
#pragma unroll
            for (int i = 4; i < 6; ++i) { const f32x4 v = *(const f32x4*)(sp + 4 * i); sb += (v[0] + v[1]) + (v[2] + v[3]); }
            const float ra = rsqrtf(sa * (1.0f / 512.0f) + EPS), rb = rsqrtf(sb * (1.0f / 512.0f) + EPS);
            tab[threadIdx.x] = (f32x2){ra / rb, rb};
        }
    }
    __device__ __forceinline__ void midscale(f32x4 (&acc)[2][2][4][2], int wr, int fr, int ui, LAS unsigned char* lds) const {
        const LAS f32x2* tab = (const LAS f32x2*)(lds + tab_off) + (ui & 1) * 256;
#pragma unroll
        for (int ai = 0; ai < 2; ++ai)
#pragma unroll
            for (int m = 0; m < 4; ++m) { const float s = tab[ai * HALF + wr * 64 + m * 16 + fr].x;
#pragma unroll
                for (int bj = 0; bj < 2; ++bj)
#pragma unroll
                    for (int n = 0; n < 2; ++n) acc[ai][bj][m][n] = acc[ai][bj][m][n] * s; }
    }
    __device__ __forceinline__ void operator()(const f32x4 (&acc)[2][2][4][2], const Unit& u, int wr, int wc, int fr, int fq, int ui, LAS unsigned char* lds) const {
        const LAS f32x2* tab = (const LAS f32x2*)(lds + tab_off) + (ui & 1) * 256;
        const int row0 = u.pm * BM + wr * 64 + fr, col0 = u.pn * BM + wc * 32 + 4 * fq;
#pragma unroll
        for (int ai = 0; ai < 2; ++ai)
#pragma unroll
            for (int m = 0; m < 4; ++m) { const float s = tab[ai * HALF + wr * 64 + m * 16 + fr].y; const size_t ro = (size_t)(row0 + ai * HALF + m * 16) * D + col0;
#pragma unroll
                for (int bj = 0; bj < 2; ++bj)
#pragma unroll
                    for (int n = 0; n < 2; ++n) { const f32x4 xv = *(const f32x4*)(x + ro + bj * HALF + n * 16); *(f32x4*)(h + ro + bj * HALF + n * 16) = xv + acc[ai][bj][m][n] * s; } }
    }
};

template <int MODE>
struct MoeOrder {
    const bf16_t* A; const bf16_t* Bt; const int* tok_list; const LAS int* meta; int K, G, c, ntiles;
    __device__ __forceinline__ bool next(int i, Unit& u) const {
        const int L = i * G + c; if (L >= ntiles * 4) return false;
        const int mt = L >> 2; int e = 0;
#pragma unroll
        for (int j = 1; j < NE; ++j) e += (mt >= meta[j]) ? 1 : 0;
        u.pm = mt; u.pn = L & 3; u.e = e; u.rows = meta[32 + e] - (mt - meta[e]) * BM; return true;
    }
    __device__ __forceinline__ void addr(const Unit& u, const int (&RA)[2], const int (&CA)[2], const char*& aBase, const char*& bBase, unsigned (&va)[2][2]) const {
        aBase = (const char*)A; bBase = (const char*)Bt + ((size_t)u.e * D + (size_t)u.pn * BM) * K * 2;
        const int slot0 = (u.pm - meta[u.e]) * BM;
#pragma unroll
        for (int h = 0; h < 2; ++h)
#pragma unroll
            for (int i = 0; i < 2; ++i) {
                const int r = h * HALF + RA[i];
                if (MODE == 0) { int tok = 0; if (r < u.rows) tok = tok_list[u.e * T + slot0 + r] >> 1; va[h][i] = (unsigned)(((size_t)tok * K + CA[i]) * 2); }
                else va[h][i] = (unsigned)(((size_t)(u.pm * BM + r) * K + CA[i]) * 2);
            }
    }
};
struct EpiHid {
    static constexpr bool PERM = true, MIDSCALE = false;
    bf16_t* hid;
    __device__ __forceinline__ void prepare(const Unit&, int, LAS unsigned char*) const {}
    __device__ __forceinline__ void midscale(f32x4 (&)[2][2][4][2], int, int, int, LAS unsigned char*) const {}
    __device__ __forceinline__ void operator()(const f32x4 (&acc)[2][2][4][2], const Unit& u, int wr, int wc, int fr, int fq, int, LAS unsigned char*) const {
        const int row0 = u.pm * BM + wr * 64 + fr, j0 = u.pn * 128 + wc * 16 + 4 * fq;
#pragma unroll
        for (int ai = 0; ai < 2; ++ai)
#pragma unroll
            for (int m = 0; m < 4; ++m) { bf16_t* rowp = hid + (size_t)(row0 + ai * HALF + m * 16) * DFF + j0;
#pragma unroll
                for (int bj = 0; bj < 2; ++bj) { const f32x4 g = acc[ai][bj][m][0], up = acc[ai][bj][m][1]; float hv[4];
#pragma unroll
                    for (int q = 0; q < 4; ++q) hv[q] = g[q] * up[q] * __builtin_amdgcn_rcpf(1.0f + __expf(-g[q]));
                    *(u32x2*)(rowp + bj * 64) = (u32x2){cvt_pk_bf16(hv[0], hv[1]), cvt_pk_bf16(hv[2], hv[3])}; } }
    }
};
struct EpiY {
    static constexpr bool PERM = true, MIDSCALE = false;
    bf16_t* y2; const int* tok_list; const float* w_list; const LAS int* meta;
    __device__ __forceinline__ void prepare(const Unit&, int, LAS unsigned char*) const {}
    __device__ __forceinline__ void midscale(f32x4 (&)[2][2][4][2], int, int, int, LAS unsigned char*) const {}
    __device__ __forceinline__ void operator()(const f32x4 (&acc)[2][2][4][2], const Unit& u, int wr, int wc, int fr, int fq, int, LAS unsigned char*) const {
        const int slot0 = (u.pm - meta[u.e]) * BM, col0 = u.pn * BM + wc * 32 + 8 * fq;
#pragma unroll
        for (int ai = 0; ai < 2; ++ai)
#pragma unroll
            for (int m = 0; m < 4; ++m) { const int r = ai * HALF + wr * 64 + m * 16 + fr;
                if (r < u.rows) { const int dst = tok_list[u.e * T + slot0 + r]; const float w = w_list[u.e * T + slot0 + r]; bf16_t* rowp = y2 + (size_t)dst * D + col0;
#pragma unroll
                    for (int bj = 0; bj < 2; ++bj) { const f32x4 v0 = acc[ai][bj][m][0] * w, v1 = acc[ai][bj][m][1] * w;
                        u32x4 o; o.x = cvt_pk_bf16(v0[0], v0[1]); o.y = cvt_pk_bf16(v0[2], v0[3]); o.z = cvt_pk_bf16(v1[0], v1[1]); o.w = cvt_pk_bf16(v1[2], v1[3]);
                        *(u32x4*)(rowp + bj * HALF) = o; } } }
    }
};
}

struct RowId { int off; __device__ __forceinline__ int operator()(int n) const { return off + n; } };
struct RowGU { int up; __device__ __forceinline__ int operator()(int j) const { return (j >> 2) * 8 + (j & 3) + 4 * up; } };

template <bool HASG, class RowMap>
__device__ __forceinline__ void p0_transpose_item(const float* W, int K, int N, const float* gk, int gsplit, const float* gk2, bf16_t* WT, RowMap rm, LAS float* scr, int item, int lane) {
    const int nblk = N / 32, kb = item / nblk, nb = item % nblk, k0 = 64 * kb, n0 = 32 * nb;
    const float* gp = HASG ? ((k0 < gsplit) ? gk + k0 : gk2 + (k0 - gsplit)) : nullptr;
#pragma unroll 8
    for (int i = 0; i < 32; ++i) { const int kk = 2 * i + (lane >> 5);
        float v = W[(size_t)(k0 + kk) * N + n0 + (lane & 31)]; if (HASG) v *= gp[kk];
        scr[kk * 33 + (lane & 31)] = v; }
    LDS_WAIT(); asm volatile("" ::: "memory");
    const int c = lane & 7;
#pragma unroll
    for (int j = 0; j < 4; ++j) { const int n = (lane >> 3) + 8 * j; const LAS float* s = scr + (8 * c) * 33 + n;
        u32x4 o; o.x = pk2(s[0 * 33], s[1 * 33]); o.y = pk2(s[2 * 33], s[3 * 33]); o.z = pk2(s[4 * 33], s[5 * 33]); o.w = pk2(s[6 * 33], s[7 * 33]);
        *(u32x4*)(WT + (size_t)rm(n0 + n) * K + k0 + 8 * c) = o; }
    LDS_WAIT(); asm volatile("" ::: "memory");
}

__device__ __forceinline__ void ph_prologue(const Params& p, LAS unsigned char* lds, int vcu, int G) {
    const int lane = threadIdx.x & 63, wave = threadIdx.x >> 6;
    LAS float* scr = (LAS float*)(lds + wave * 16384);
    const int gw = vcu * NWAVES + wave, NGW = G * NWAVES;
    bf16_t* win_t = (bf16_t*)(p.ws + WS_WIN); bf16_t* wout_t = (bf16_t*)(p.ws + WS_WOUT); bf16_t* xb = (bf16_t*)(p.ws + WS_XB);
    bf16_t* wgu_t = (bf16_t*)(p.ws + WS_WGU); bf16_t* wd_t = (bf16_t*)(p.ws + WS_WD);
    constexpr int I_IN = (D / 64) * (INW / 32), I_OUT = (D / 64) * (D / 32), I_G = (D / 64) * (DFF / 32), I_D = (DFF / 64) * (D / 32), I_E = 2 * I_G + I_D;
    for (int it = gw; it < I_IN + I_OUT + NE * I_E; it += NGW) {
        if (it < I_IN) p0_transpose_item<true>(p.w_in, D, INW, p.norm1_g, D, p.norm1_g, win_t, RowId{0}, scr, it, lane);
        else if (it < I_IN + I_OUT) p0_transpose_item<true>(p.w_out, D, D, p.g_rec_out, 512, p.g_att_out, wout_t, RowId{0}, scr, it - I_IN, lane);
        else {
            const int r = it - I_IN - I_OUT, e = r / I_E, q = r % I_E;
            if (q < I_G) p0_transpose_item<true>(p.w_e_gate + (size_t)e * D * DFF, D, DFF, p.norm2_g, D, p.norm2_g, wgu_t + (size_t)e * D * D, RowGU{0}, scr, q, lane);
            else if (q < 2 * I_G) p0_transpose_item<true>(p.w_e_up + (size_t)e * D * DFF, D, DFF, p.norm2_g, D, p.norm2_g, wgu_t + (size_t)e * D * D, RowGU{1}, scr, q - I_G, lane);
            else p0_transpose_item<false>(p.w_e_down + (size_t)e * DFF * D, DFF, D, nullptr, 0, nullptr, wd_t + (size_t)e * D * DFF, RowId{0}, scr, q - 2 * I_G, lane);
        }
    }
    for (int t = gw; t < T; t += NGW) {
        const f32x4* xr = (const f32x4*)(p.x + (size_t)t * D) + lane;
        f32x4 v[4]; float ss = 0.f;
#pragma unroll
        for (int j = 0; j < 4; ++j) { v[j] = xr[64 * j]; ss += (v[j][0] * v[j][0] + v[j][1] * v[j][1]) + (v[j][2] * v[j][2] + v[j][3] * v[j][3]); }
        const float r = rsqrtf(wave_sum(ss) * (1.0f / D) + EPS);
        u32x2* o8 = (u32x2*)(xb + (size_t)t * D) + lane;
#pragma unroll
        for (int j = 0; j < 4; ++j) o8[64 * j] = (u32x2){pk2(v[j][0] * r, v[j][1] * r), pk2(v[j][2] * r, v[j][3] * r)};
    }
}

__device__ void ph_rglru_gates(const Params& p, const bf16_t* z, float* a_out, float* bx_out, float* uc_s) {
    const int c = threadIdx.x;
    const int h = c >> 6, j = c & 63;
    const float sp = log1pf(expf(-p.lru_lambda[c]));
    for (int t = blockIdx.x; t < T; t += gridDim.x) {
        const int s = t % S;
        float uc = p.conv_b[c];
#pragma unroll
        for (int jj = 0; jj < 4; ++jj) { const int sp_ = s - 3 + jj; if (sp_ >= 0) uc += bf2f(z[(size_t)(t - 3 + jj) * INW + c]) * p.conv_w[jj * RW + c]; }
        __syncthreads();
        uc_s[c] = uc;
        __syncthreads();
        float ra = p.b_rg_a[c], ri = p.b_rg_x[c];
        const float* wa = p.w_rg_a + (size_t)h * RHD * RHD + j;
        const float* wx = p.w_rg_x + (size_t)h * RHD * RHD + j;
#pragma unroll 4
        for (int i = 0; i < RHD; ++i) { const float u = uc_s[h * 64 + i]; ra += u * wa[i * RHD]; ri += u * wx[i * RHD]; }
        const float r = sigmoidf_(ra), ig = sigmoidf_(ri);
        const float log_a = -8.0f * r * sp;
        a_out[(size_t)t * RW + c] = expf(log_a);
        bx_out[(size_t)t * RW + c] = sqrtf(-expm1f(2.0f * log_a)) * (ig * uc);
    }
}
__device__ void ph_scan(const float* a_in, const float* bx_in, const bf16_t* z, bf16_t* mix) {
    const int gid = blockIdx.x * blockDim.x + threadIdx.x;
    if (gid >= NB * RW) return;
    const int b = gid / RW, c = gid % RW;
    float h = 0.f;
#pragma unroll 4
    for (int s = 0; s < S; ++s) {
        const size_t t = (size_t)b * S + s;
        h = a_in[t * RW + c] * h + bx_in[t * RW + c];
        mix[t * D + c] = (bf16_t)f2bf(h * gelu_tanh(bf2f(z[t * INW + 512 + c])));
    }
}
__device__ void ph_attn_naive(const Params& p, const bf16_t* z, bf16_t* mix) {
    const int tid = threadIdx.x, hd = tid >> 6, qi = tid & 63;
    for (int item = blockIdx.x; item < NB * (S / CHUNK); item += gridDim.x) {
        const int b = item / (S / CHUNK), c = item % (S / CHUNK);
        const size_t tq = (size_t)b * S + c * CHUNK + qi;
        float q[64], o[64];
#pragma unroll
        for (int d = 0; d < 64; ++d) { q[d] = bf2f(z[tq * INW + 1024 + hd * 64 + d]) * 0.125f; o[d] = 0.f; }
        float m = -3.0e38f, l = 0.f;
        const int k_begin = (c >= LEFT) ? 0 : (LEFT - c) * CHUNK;
        for (int kk = k_begin; kk < BAND; ++kk) {
            const size_t tk = (size_t)b * S + (c - LEFT) * CHUNK + kk;
            const bf16_t* kp = z + tk * INW + 1536 + hd * 64;
            const bf16_t* vp = z + tk * INW + 2048 + hd * 64;
            float sc = 0.f;
#pragma unroll
            for (int d = 0; d < 64; ++d) sc += q[d] * bf2f(kp[d]);
            int rel = LEFT * CHUNK + qi - kk;
            rel = rel < -MAXREL ? -MAXREL : (rel > MAXREL ? MAXREL : rel);
            sc += p.rel_bias[hd * (2 * MAXREL + 1) + rel + MAXREL];
            const float mn = fmaxf(m, sc), alpha = expf(m - mn), pe = expf(sc - mn);
            l = l * alpha + pe;
#pragma unroll
            for (int d = 0; d < 64; ++d) o[d] = o[d] * alpha + pe * bf2f(vp[d]);
            m = mn;
        }
        const float inv = 1.0f / l;
#pragma unroll
        for (int d = 0; d < 64; ++d) mix[tq * D + 512 + hd * 64 + d] = (bf16_t)f2bf(o[d] * inv);
    }
}
__device__ void ph_ssq(const bf16_t* mix, float* ssq) {
    const int lane = threadIdx.x & 63, wv = threadIdx.x >> 6, nw = blockDim.x >> 6;
    for (int t = blockIdx.x * nw + wv; t < T; t += gridDim.x * nw) {
        float sa = 0.f, sb = 0.f;
        for (int i = lane; i < 512; i += 64) { const float a = bf2f(mix[(size_t)t * D + i]), b = bf2f(mix[(size_t)t * D + 512 + i]); sa += a * a; sb += b * b; }
        sa = wave_sum(sa); sb = wave_sum(sb);
        if (lane < SSQW) ssq[(size_t)t * SSQW + lane] = (lane == 0) ? sa : ((lane == 16) ? sb : 0.f);
    }
}
__device__ void ph_router(const Params& p, const float* h, bf16_t* xn2b, int* route_e, float* route_w) {
    const int lane = threadIdx.x & 63, wv = threadIdx.x >> 6, nw = blockDim.x >> 6;
    for (int t = blockIdx.x * nw + wv; t < T; t += gridDim.x * nw) {
        const float* row = h + (size_t)t * D;
        float v[16]; float ss = 0.f;
#pragma unroll
        for (int i = 0; i < 16; ++i) { v[i] = row[lane + 64 * i]; ss += v[i] * v[i]; }
        ss = wave_sum(ss);
        const float r = rsqrtf(ss / (float)D + EPS);
#pragma unroll
        for (int i = 0; i < 16; ++i) { xn2b[(size_t)t * D + lane + 64 * i] = (bf16_t)f2bf(v[i] * r); v[i] = v[i] * r * p.norm2_g[lane + 64 * i]; }
        float lg[4], le[16];
#pragma unroll
        for (int g = 0; g < 4; ++g) lg[g] = 0.f;
#pragma unroll
        for (int e = 0; e < 16; ++e) le[e] = 0.f;
#pragma unroll
        for (int i = 0; i < 16; ++i) {
            const int k = lane + 64 * i;
            const float4 wg = *(const float4*)(p.w_group + (size_t)k * 4);
            lg[0] += v[i] * wg.x; lg[1] += v[i] * wg.y; lg[2] += v[i] * wg.z; lg[3] += v[i] * wg.w;
#pragma unroll
            for (int e4 = 0; e4 < 4; ++e4) {
                const float4 wr = *(const float4*)(p.w_router + (size_t)k * 16 + e4 * 4);
                le[e4 * 4 + 0] += v[i] * wr.x; le[e4 * 4 + 1] += v[i] * wr.y; le[e4 * 4 + 2] += v[i] * wr.z; le[e4 * 4 + 3] += v[i] * wr.w;
            }
        }
#pragma unroll
        for (int g = 0; g < 4; ++g) lg[g] = wave_sum(lg[g]) + p.b_group[g];
#pragma unroll
        for (int e = 0; e < 16; ++e) le[e] = wave_sum(le[e]) + p.b_router[e];
        float mine = 0.f;
#pragma unroll
        for (int e = 0; e < 16; ++e) mine = (lane == e) ? le[e] : mine;
        int g = 0; float best = lg[0];
#pragma unroll
        for (int i = 1; i < 4; ++i) if (lg[i] > best) { best = lg[i]; g = i; }
        float sel[4];
#pragma unroll
        for (int i = 0; i < 4; ++i) sel[i] = __shfl(mine, g * 4 + i);
        if (lane == 0) {
            float den = 0.f;
#pragma unroll
            for (int i = 0; i < 4; ++i) den += expf(lg[i] - best);
            const float pg = 1.0f / den;
            int i1 = 0; float v1 = sel[0];
#pragma unroll
            for (int i = 1; i < 4; ++i) if (sel[i] > v1) { v1 = sel[i]; i1 = i; }
            int i2 = -1; float v2 = -3.0e38f;
#pragma unroll
            for (int i = 0; i < 4; ++i) if (i != i1 && sel[i] > v2) { v2 = sel[i]; i2 = i; }
            const float e2 = expf(v2 - v1);
            const float w1 = pg / (1.0f + e2), w2 = pg * e2 / (1.0f + e2);
            route_e[t * 2 + 0] = g * 4 + i1; route_e[t * 2 + 1] = g * 4 + i2;
            route_w[t * 2 + 0] = w1; route_w[t * 2 + 1] = w2;
        }
    }
}
__device__ void ph_moe_naive(const Params& p, const float* h, const bf16_t* xn2b, const int* route_e, const float* route_w, float* out, float* lds) {
    float* xs = lds;
    float* hs = lds + 1024;
    float* red = lds + 1536;
    const int tid = threadIdx.x;
    for (int t = blockIdx.x; t < T; t += gridDim.x) {
        __syncthreads();
        xs[tid] = bf2f(xn2b[(size_t)t * D + tid]) * p.norm2_g[tid]; xs[tid + 512] = bf2f(xn2b[(size_t)t * D + tid + 512]) * p.norm2_g[tid + 512];
        __syncthreads();
        float o0 = h[(size_t)t * D + tid], o1 = h[(size_t)t * D + tid + 512];
        for (int k = 0; k < 2; ++k) {
            const int e = route_e[t * 2 + k]; const float w = route_w[t * 2 + k];
            const float* wg = p.w_e_gate + (size_t)e * D * DFF + tid;
            const float* wu = p.w_e_up + (size_t)e * D * DFF + tid;
            float ag = 0.f, au = 0.f;
#pragma unroll 8
            for (int i = 0; i < D; ++i) { const float xv = xs[i]; ag += xv * wg[(size_t)i * DFF]; au += xv * wu[(size_t)i * DFF]; }
            __syncthreads();
            hs[tid] = ag * sigmoidf_(ag) * au;
            __syncthreads();
            const float* wd = p.w_e_down + (size_t)e * DFF * D;
            float y0 = 0.f, y1 = 0.f;
#pragma unroll 8
            for (int jx = 0; jx < DFF; ++jx) { const float hv = hs[jx]; y0 += hv * wd[(size_t)jx * D + tid]; y1 += hv * wd[(size_t)jx * D + tid + 512]; }
            o0 += w * y0; o1 += w * y1;
        }
        float ss = wave_sum(o0 * o0 + o1 * o1);
        if ((tid & 63) == 0) red[tid >> 6] = ss;
        __syncthreads();
        float tot = 0.f;
#pragma unroll
        for (int i = 0; i < 8; ++i) tot += red[i];
        const float r = rsqrtf(tot / (float)D + EPS);
        out[(size_t)t * D + tid] = o0 * r * p.final_g[tid];
        out[(size_t)t * D + tid + 512] = o1 * r * p.final_g[tid + 512];
    }
}


__device__ void ph_router2(const Params& p, const float* h, bf16_t* xn2b, int* gcount, int* tok_list, float* w_list, LAS int* L) {
    const int lane = threadIdx.x & 63, wv = threadIdx.x >> 6, tid = threadIdx.x;
    LAS int* lcnt = L; LAS int* lbase = L + 16; LAS int* rec_e = L + 32; LAS int* rec_s = L + 160; LAS float* rec_w = (LAS float*)(L + 288);
    for (int grp = blockIdx.x; grp < T / 64; grp += gridDim.x) {
        if (tid < 16) lcnt[tid] = 0;
        __syncthreads();
        for (int tl = wv * 8; tl < wv * 8 + 8; ++tl) {
            const int t = grp * 64 + tl;
            const f32x4* hr = (const f32x4*)(h + (size_t)t * D) + lane;
            f32x4 v[4]; float ss = 0.f;
#pragma unroll
            for (int j = 0; j < 4; ++j) { v[j] = hr[64 * j]; ss += (v[j][0] * v[j][0] + v[j][1] * v[j][1]) + (v[j][2] * v[j][2] + v[j][3] * v[j][3]); }
            const float r = rsqrtf(wave_sum(ss) * (1.0f / D) + EPS);
            u32x2* o8 = (u32x2*)(xn2b + (size_t)t * D) + lane;
            float lg[4], le[16];
#pragma unroll
            for (int g = 0; g < 4; ++g) lg[g] = 0.f;
#pragma unroll
            for (int e = 0; e < 16; ++e) le[e] = 0.f;
#pragma unroll
            for (int j = 0; j < 4; ++j) {
                v[j] = v[j] * r;
                o8[64 * j] = (u32x2){pk2(v[j][0], v[j][1]), pk2(v[j][2], v[j][3])};
                const f32x4 g2 = *((const f32x4*)p.norm2_g + lane + 64 * j);
                v[j] = v[j] * g2;
#pragma unroll
                for (int q = 0; q < 4; ++q) {
                    const int k = 4 * lane + 256 * j + q; const float xv = v[j][q];
                    const f32x4 wg = *(const f32x4*)(p.w_group + (size_t)k * 4);
                    lg[0] += xv * wg[0]; lg[1] += xv * wg[1]; lg[2] += xv * wg[2]; lg[3] += xv * wg[3];
#pragma unroll
                    for (int e4 = 0; e4 < 4; ++e4) { const f32x4 wr = *(const f32x4*)(p.w_router + (size_t)k * 16 + e4 * 4);
                        le[e4 * 4 + 0] += xv * wr[0]; le[e4 * 4 + 1] += xv * wr[1]; le[e4 * 4 + 2] += xv * wr[2]; le[e4 * 4 + 3] += xv * wr[3]; }
                }
            }
#pragma unroll
            for (int g = 0; g < 4; ++g) lg[g] = wave_sum(lg[g]) + p.b_group[g];
#pragma unroll
            for (int e = 0; e < 16; ++e) le[e] = wave_sum(le[e]) + p.b_router[e];
            float mine = 0.f;
#pragma unroll
            for (int e = 0; e < 16; ++e) mine = (lane == e) ? le[e] : mine;
            int g = 0; float best = lg[0];
#pragma unroll
            for (int i = 1; i < 4; ++i) if (lg[i] > best) { best = lg[i]; g = i; }
            float sel[4];
#pragma unroll
            for (int i = 0; i < 4; ++i) sel[i] = __shfl(mine, g * 4 + i);
            if (lane == 0) {
                float den = 0.f;
#pragma unroll
                for (int i = 0; i < 4; ++i) den += expf(lg[i] - best);
                const float pg = 1.0f / den;
                int i1 = 0; float v1 = sel[0];
#pragma unroll
                for (int i = 1; i < 4; ++i) if (sel[i] > v1) { v1 = sel[i]; i1 = i; }
                int i2 = -1; float v2 = -3.0e38f;
#pragma unroll
                for (int i = 0; i < 4; ++i) if (i != i1 && sel[i] > v2) { v2 = sel[i]; i2 = i; }
                const float e2 = expf(v2 - v1);
                const float w1 = pg / (1.0f + e2), w2 = pg * e2 / (1.0f + e2);
                const int ea = g * 4 + i1, eb = g * 4 + i2;
                const int sa = __hip_atomic_fetch_add(lcnt + ea, 1, __ATOMIC_RELAXED, __HIP_MEMORY_SCOPE_WORKGROUP);
                const int sb = __hip_atomic_fetch_add(lcnt + eb, 1, __ATOMIC_RELAXED, __HIP_MEMORY_SCOPE_WORKGROUP);
                rec_e[tl * 2] = ea; rec_s[tl * 2] = sa; rec_w[tl * 2] = w1;
                rec_e[tl * 2 + 1] = eb; rec_s[tl * 2 + 1] = sb; rec_w[tl * 2 + 1] = w2;
            }
        }
        __syncthreads();
        if (tid < 16) lbase[tid] = __hip_atomic_fetch_add(gcount + tid, lcnt[tid], __ATOMIC_RELAXED, __HIP_MEMORY_SCOPE_AGENT);
        __syncthreads();
        if (tid < 128) { const int e = rec_e[tid]; const int pos = lbase[e] + rec_s[tid]; tok_list[e * T + pos] = grp * 128 + tid; w_list[e * T + pos] = rec_w[tid]; }
        __syncthreads();
    }
}
__device__ void ph_final(const Params& p, const float* h, const bf16_t* y2, float* out) {
    const int lane = threadIdx.x & 63, wv = threadIdx.x >> 6, nw = blockDim.x >> 6;
    for (int t = blockIdx.x * nw + wv; t < T; t += gridDim.x * nw) {
        const f32x4* hr = (const f32x4*)(h + (size_t)t * D) + lane;
        const u32x2* y0 = (const u32x2*)(y2 + (size_t)(2 * t) * D) + lane; const u32x2* y1 = (const u32x2*)(y2 + (size_t)(2 * t + 1) * D) + lane;
        f32x4 v[4]; float ss = 0.f;
#pragma unroll
        for (int j = 0; j < 4; ++j) { const f32x4 hv = hr[64 * j]; const u32x2 a = y0[64 * j], b = y1[64 * j];
            v[j][0] = hv[0] + __builtin_bit_cast(float, a[0] << 16) + __builtin_bit_cast(float, b[0] << 16);
            v[j][1] = hv[1] + __builtin_bit_cast(float, a[0] & 0xffff0000u) + __builtin_bit_cast(float, b[0] & 0xffff0000u);
            v[j][2] = hv[2] + __builtin_bit_cast(float, a[1] << 16) + __builtin_bit_cast(float, b[1] << 16);
            v[j][3] = hv[3] + __builtin_bit_cast(float, a[1] & 0xffff0000u) + __builtin_bit_cast(float, b[1] & 0xffff0000u);
            ss += (v[j][0] * v[j][0] + v[j][1] * v[j][1]) + (v[j][2] * v[j][2] + v[j][3] * v[j][3]); }
        const float r = rsqrtf(wave_sum(ss) * (1.0f / D) + EPS);
        f32x4* orow = (f32x4*)(out + (size_t)t * D) + lane;
#pragma unroll
        for (int j = 0; j < 4; ++j) { const f32x4 gf = *((const f32x4*)p.final_g + lane + 64 * j); orow[64 * j] = v[j] * r * gf; }
    }
}

constexpr int RING_BYTES = 131072, TAB_OFF = RING_BYTES, META_OFF = RING_BYTES + 4096, LDS_BYTES = 147456;

__global__ void __launch_bounds__(NTHR) k_mega(Params p) {
    extern __shared__ __attribute__((aligned(16))) unsigned char lds_raw[];
    LAS unsigned char* lds = (LAS unsigned char*)lds_raw;
    cg::grid_group grid = cg::this_grid();
    const int G = gridDim.x; const int bx = blockIdx.x;
    const int vcu = (G % 8 == 0) ? (bx % 8) * (G / 8) + bx / 8 : bx;
    bf16_t* win_t = (bf16_t*)(p.ws + WS_WIN); bf16_t* wout_t = (bf16_t*)(p.ws + WS_WOUT);
    bf16_t* xb = (bf16_t*)(p.ws + WS_XB); bf16_t* zb = (bf16_t*)(p.ws + WS_Z); bf16_t* mixb = (bf16_t*)(p.ws + WS_MIX);
    float* ssq = (float*)(p.ws + WS_SSQ);
    float* a_ = (float*)(p.ws + WS_XB); float* bx_ = (float*)(p.ws + WS_HID);
    bf16_t* xn2b = (bf16_t*)(p.ws + WS_XB);
    int* route_e = (int*)(p.ws + WS_ROUTE); float* route_w = (float*)(p.ws + WS_ROUTE + (size_t)T * 2 * 4);
    float* h = p.out;

    ph_prologue(p, lds, vcu, G);
    grid.sync();
    {
        pg8::DenseOrder So; So.init(xb, win_t, T, INW, D, G, bx);
        pg8::EpiZ E{zb, INW};
        pg8::gemm_phase(lds, D, So, E);
    }
    grid.sync();
    ph_rglru_gates(p, zb, a_, bx_, (float*)lds_raw);
    ph_attn_naive(p, zb, mixb);
    grid.sync();
    ph_scan(a_, bx_, zb, mixb);
    grid.sync();
    ph_ssq(mixb, ssq);
    grid.sync();
    {
        pg8::DenseOrder So; So.init(mixb, wout_t, T, D, D, G, bx);
        pg8::EpiH E{ssq, p.x, h, TAB_OFF};
        pg8::gemm_phase(lds, D, So, E);
    }
    grid.sync();
    int* gcount = (int*)(p.ws + WS_CTL + 4096); int* tok_list = (int*)(p.ws + WS_LIST); float* w_list = (float*)(p.ws + WS_LIST + MiB);
    bf16_t* wgu_t = (bf16_t*)(p.ws + WS_WGU); bf16_t* wd_t = (bf16_t*)(p.ws + WS_WD); bf16_t* hid = (bf16_t*)(p.ws + WS_HID); bf16_t* y2 = (bf16_t*)(p.ws + WS_Z);
    ph_router2(p, h, xn2b, gcount, tok_list, w_list, (LAS int*)lds);
    grid.sync();
    LAS int* meta = (LAS int*)(lds + META_OFF);
    if (threadIdx.x == 0) { int base = 0; for (int e = 0; e < NE; ++e) { const int cnt = gcount[e]; meta[e] = base; meta[32 + e] = cnt; base += (cnt + 255) >> 8; } meta[16] = base; }
    __syncthreads();
    const int ntiles = meta[16];
    {
        pg8::MoeOrder<0> So{xn2b, wgu_t, tok_list, meta, D, G, bx, ntiles};
        pg8::EpiHid E{hid};
        pg8::gemm_phase(lds, D, So, E);
    }
    grid.sync();
    {
        pg8::MoeOrder<1> So{hid, wd_t, tok_list, meta, DFF, G, bx, ntiles};
        pg8::EpiY E{y2, tok_list, w_list, meta};
        pg8::gemm_phase(lds, DFF, So, E);
    }
    grid.sync();
    ph_final(p, h, y2, p.out);
}

extern "C" void kernel_launch(void* const* d_in, const int* in_sizes, int n_in, void* d_out, int out_size, void* d_ws, size_t ws_size, hipStream_t stream) {
    static int grid_blocks = 0;
    if (!grid_blocks) {
        if (ws_size < WS_END) { fprintf(stderr, "kernel_launch: workspace too small (%zu < %zu)\n", ws_size, (size_t)WS_END); grid_blocks = -1; return; }
        int dev = 0, cus = 0, per_cu = 0;
        (void)hipGetDevice(&dev);
        (void)hipDeviceGetAttribute(&cus, hipDeviceAttributeMultiprocessorCount, dev);
        (void)hipFuncSetAttribute((const void*)k_mega, hipFuncAttributeMaxDynamicSharedMemorySize, LDS_BYTES);
        (void)hipOccupancyMaxActiveBlocksPerMultiprocessor(&per_cu, (const void*)k_mega, NTHR, LDS_BYTES);
        if (per_cu < 1) { fprintf(stderr, "kernel_launch: occupancy query says %d blocks per CU\n", per_cu); per_cu = 1; }
        grid_blocks = cus;
    }
    if (grid_blocks < 0) return;
    Params p{};
    const float** f = (const float**)&p;
    for (int i = 0; i < 23; ++i) f[i] = (const float*)d_in[i];
    p.out = (float*)d_out;
    p.ws = (unsigned char*)d_ws;
    (void)hipMemsetAsync((char*)d_ws + WS_CTL, 0, CTL_BYTES, stream);
    void* args[] = {&p};
    hipError_t e = hipLaunchCooperativeKernel((void*)k_mega, dim3(grid_blocks), dim3(NTHR), args, LDS_BYTES, stream);
    if (e != hipSuccess) fprintf(stderr, "cooperative launch failed: %s (grid %d)\n", hipGetErrorString(e), grid_blocks);
}
```

```cpp
#include <hip/hip_runtime.h>
#include <hip/hip_cooperative_groups.h>
#include <cstdio>
#include <cstdint>
namespace cg = cooperative_groups;

#define LAS __attribute__((address_space(3)))
typedef unsigned short bf16_t;
typedef short bf16x8 __attribute__((ext_vector_type(8)));
typedef float f32x4 __attribute__((ext_vector_type(4)));
typedef float f32x2 __attribute__((ext_vector_type(2)));
typedef unsigned u32x4 __attribute__((ext_vector_type(4)));
typedef unsigned u32x2 __attribute__((ext_vector_type(2)));

constexpr int D = 1024, NB = 8, S = 2048, T = NB * S;
constexpr int RW = 512, RHD = 64;
constexpr int CHUNK = 64, LEFT = 8, BAND = 576, MAXREL = 128;
constexpr int INW = 2560;
constexpr int NE = 16, DFF = 512;
constexpr float EPS = 1e-6f;
constexpr int NTHR = 512, NWAVES = 8;
constexpr int SSQW = 24;

constexpr size_t MiB = 1u << 20;
constexpr size_t WS_CTL = 0, CTL_BYTES = 1 * MiB;
constexpr size_t WS_WIN = 1 * MiB;
constexpr size_t WS_WOUT = 6 * MiB;
constexpr size_t WS_WGU = 8 * MiB;
constexpr size_t WS_WD = 40 * MiB;
constexpr size_t WS_XB = 56 * MiB;
constexpr size_t WS_Z = 88 * MiB;
constexpr size_t WS_MIX = 168 * MiB;
constexpr size_t WS_HID = 200 * MiB;
constexpr size_t WS_SSQ = 236 * MiB;
constexpr size_t WS_LIST = 238 * MiB;
constexpr size_t WS_ROUTE = 240 * MiB;
constexpr size_t WS_END = 241 * MiB;

constexpr int RING_BYTES = 131072, TAB_OFF = RING_BYTES, META_OFF = RING_BYTES + 4096, LDS_BYTES = 147456;

struct Params {
    const float *x, *norm1_g, *w_in, *conv_w, *conv_b, *w_rg_a, *b_rg_a, *w_rg_x, *b_rg_x, *lru_lambda, *rel_bias,
        *g_rec_out, *g_att_out, *w_out, *norm2_g, *w_group, *b_group, *w_router, *b_router, *w_e_gate, *w_e_up, *w_e_down, *final_g;
    float* out;
    unsigned char* ws;
};

__device__ __forceinline__ float wave_sum(float v) {
#pragma unroll
    for (int o = 32; o > 0; o >>= 1) v += __shfl_xor(v, o);
    return v;
}
__device__ __forceinline__ float sigmoidf_(float x) { return 1.0f / (1.0f + expf(-x)); }
__device__ __forceinline__ float gelu_tanh(float x) { return 0.5f * x * (1.0f + tanhf(0.7978845608028654f * (x + 0.044715f * x * x * x))); }
__device__ __forceinline__ unsigned f2bf(float f) { unsigned u = __builtin_bit_cast(unsigned, f); return (u + 0x7fffu + ((u >> 16) & 1u)) >> 16; }
__device__ __forceinline__ unsigned pk2(float lo, float hi) { return f2bf(lo) | (f2bf(hi) << 16); }
__device__ __forceinline__ float bf2f(bf16_t b) { return __builtin_bit_cast(float, ((unsigned)b) << 16); }
__device__ __forceinline__ unsigned cvt_pk_bf16(float lo, float hi) { unsigned r; asm volatile("v_cvt_pk_bf16_f32 %0, %1, %2" : "=v"(r) : "v"(lo), "v"(hi)); return r; }
#define LDS_WAIT() asm volatile("s_waitcnt lgkmcnt(0)" ::: "memory")
__device__ __forceinline__ int opaque_tid() { int t = threadIdx.x; asm volatile("" : "+v"(t)); return t; }

namespace pg8 {
constexpr int BM = 256, BK = 64, HALF = 128, HTB = HALF * BK * 2, STAGE_BYTES = 8 * HTB, NXCD = 8, WGM = 8;
__device__ __forceinline__ int lds_byte(int r, int c) { const int st = (r >> 4) * 2 + (c >> 5), rr = r & 15, cc = c & 31, ob = rr * 64 + cc * 2; return st * 1024 + (ob ^ (((ob >> 9) & 1) << 5)); }
__device__ __forceinline__ void stage_rc(int b, int& R, int& C) { const int st = b / 1024, sb = b % 1024, swz = sb ^ (((sb >> 9) & 1) << 5); R = (st >> 1) * 16 + swz / 64; C = (st & 1) * 32 + (swz % 64) / 2; }
__device__ __forceinline__ int perm32(int rho) { const int n = rho >> 4, i = rho & 15; return 8 * (i >> 2) + 4 * n + (i & 3); }

struct Unit { int pm, pn, e, rows; };

struct DenseOrder {
    const bf16_t* A; const bf16_t* Bt; int K; int nM, nN, nwg, G, c;
    __device__ void init(const bf16_t* A_, const bf16_t* Bt_, int M, int N, int K_, int G_, int c_) { A = A_; Bt = Bt_; K = K_; nM = M / BM; nN = N / BM; nwg = nM * nN; G = G_; c = c_; }
    __device__ __forceinline__ bool next(int i, Unit& u) const {
        const long L = (long)i * G + c; if (L >= nwg) return false;
        int wgid = (int)L; { const int q = nwg / NXCD, r = nwg % NXCD, xcd = wgid % NXCD, off = wgid / NXCD; wgid = (xcd < r ? xcd * (q + 1) : r * (q + 1) + (xcd - r) * q) + off; }
        const int nig = WGM * nN, gid = wgid / nig, fm = gid * WGM, gsz = (nM - fm) < WGM ? (nM - fm) : WGM;
        u.pm = fm + ((wgid % nig) % gsz); u.pn = (wgid % nig) / gsz; u.e = 0; u.rows = BM; return true;
    }
    __device__ __forceinline__ void addr(const Unit& u, const int (&RA)[2], const int (&CA)[2], const char*& aBase, const char*& bBase, unsigned (&va)[2][2]) const {
        aBase = (const char*)A; bBase = (const char*)Bt + (size_t)u.pn * BM * K * 2;
#pragma unroll
        for (int h = 0; h < 2; ++h)
#pragma unroll
            for (int i = 0; i < 2; ++i) va[h][i] = (unsigned)(((size_t)(u.pm * BM + h * HALF + RA[i]) * K + CA[i]) * 2);
    }
};

template <class Epi, class Sched>
__device__ __forceinline__ void gemm_phase(LAS unsigned char* lds, const int K, const Sched& S, const Epi& E) {
    int tid_ = threadIdx.x; asm volatile("" : "+v"(tid_));
    const int tid = tid_, wid = __builtin_amdgcn_readfirstlane(tid >> 6), lane = tid & 63, wr = wid >> 2, wc = wid & 3, fr = lane & 15, fq = lane >> 4;
    const int nt = K / BK;
    int RA[2], CA[2]; unsigned voffB[2];
#pragma unroll
    for (int i = 0; i < 2; ++i) { int R, C; stage_rc(tid * 16 + i * 8192, R, C); RA[i] = R; CA[i] = C; const int Rb = Epi::PERM ? ((R & ~31) + perm32(R & 31)) : R; voffB[i] = (unsigned)(Rb * K + C) * 2u; }
    const size_t kstep = (size_t)(BK * 2);
    const size_t hstepB = (size_t)HALF * K * 2;
    const unsigned ldsw = (unsigned)wid * 1024u;
    const int aoff = lds_byte(wr * 64 + fr, fq * 8), boff = lds_byte(wc * 32 + fr, fq * 8);
#define PG8_SA(b, h) (((b) * 2 + (h)) * HTB)
#define PG8_SB(b, h) ((4 + (b) * 2 + (h)) * HTB)
#define PG8_STAGE_B(bufoff, gbase) do { _Pragma("unroll") for (int _i = 0; _i < 2; ++_i) \
        __builtin_amdgcn_global_load_lds((const unsigned*)((const char*)(gbase) + voffB[_i]), (LAS unsigned*)(lds + (bufoff) + ldsw + _i * 8192), 16, 0, 0); } while (0)
#define PG8_STAGE_A(bufoff, gbase, v0, v1) do { \
        __builtin_amdgcn_global_load_lds((const unsigned*)((const char*)(gbase) + (v0)), (LAS unsigned*)(lds + (bufoff) + ldsw), 16, 0, 0); \
        __builtin_amdgcn_global_load_lds((const unsigned*)((const char*)(gbase) + (v1)), (LAS unsigned*)(lds + (bufoff) + ldsw + 8192), 16, 0, 0); } while (0)
#define PG8_LDA(dst, b, h) do { _Pragma("unroll") for (int m = 0; m < 4; ++m) _Pragma("unroll") for (int k = 0; k < 2; ++k) dst[m][k] = *(const LAS bf16x8*)(lds + PG8_SA(b, h) + aoff + m * 2048 + k * 1024); } while (0)
#define PG8_LDB(dst, b, h) do { _Pragma("unroll") for (int n = 0; n < 2; ++n) _Pragma("unroll") for (int k = 0; k < 2; ++k) dst[n][k] = *(const LAS bf16x8*)(lds + PG8_SB(b, h) + boff + n * 2048 + k * 1024); } while (0)
#define PG8_MMA(ai, bj, At, Bt) do { __builtin_amdgcn_s_setprio(1); _Pragma("unroll") for (int m = 0; m < 4; ++m) _Pragma("unroll") for (int n = 0; n < 2; ++n) _Pragma("unroll") for (int k = 0; k < 2; ++k) \
        acc[ai][bj][m][n] = __builtin_amdgcn_mfma_f32_16x16x32_bf16(Bt[n][k], At[m][k], acc[ai][bj][m][n], 0, 0, 0); __builtin_amdgcn_s_setprio(0); } while (0)
#define PG8_WAIT_V(n) asm volatile("s_waitcnt vmcnt(" #n ")" ::: "memory")
#define PG8_WAIT_L(n) asm volatile("s_waitcnt lgkmcnt(" #n ")" ::: "memory")
#define PG8_BAR __builtin_amdgcn_s_barrier()
#define PG8_SCHED __builtin_amdgcn_sched_barrier(0)
    Unit cur, nxt; int ui = 0;
    if (!S.next(0, cur)) return;
    f32x4 acc[2][2][4][2];
#pragma unroll
    for (int a = 0; a < 2; ++a)
#pragma unroll
        for (int b = 0; b < 2; ++b)
#pragma unroll
            for (int m = 0; m < 4; ++m)
#pragma unroll
                for (int n = 0; n < 2; ++n) acc[a][b][m][n] = (f32x4){0.f, 0.f, 0.f, 0.f};
    bf16x8 At[4][2], B0[2][2], B1[2][2];
    const char *cA, *cB, *nA, *nB; unsigned cva[2][2], nva[2][2];
    S.addr(cur, RA, CA, cA, cB, cva);
    E.prepare(cur, ui, lds);
    PG8_STAGE_B(PG8_SB(0, 0), cB); PG8_STAGE_A(PG8_SA(0, 0), cA, cva[0][0], cva[0][1]); PG8_STAGE_B(PG8_SB(0, 1), cB + hstepB); PG8_STAGE_A(PG8_SA(0, 1), cA, cva[1][0], cva[1][1]);
    if (wr == 1) PG8_BAR;
    PG8_WAIT_V(4); PG8_BAR;
    PG8_STAGE_B(PG8_SB(1, 0), cB + kstep); PG8_STAGE_A(PG8_SA(1, 0), cA + kstep, cva[0][0], cva[0][1]); PG8_STAGE_B(PG8_SB(1, 1), cB + hstepB + kstep);
    PG8_WAIT_V(6); PG8_BAR;
    for (;;) {
        const bool has_next = S.next(ui + 1, nxt);
        if (has_next) { S.addr(nxt, RA, CA, nA, nB, nva); }
        else { nA = cA; nB = cB;
#pragma unroll
            for (int h = 0; h < 2; ++h)
#pragma unroll
                for (int i = 0; i < 2; ++i) nva[h][i] = cva[h][i]; }
        for (int t = 0; t < nt; t += 2) {
            const bool last = (t == nt - 2);
            if (Epi::MIDSCALE && t == nt / 2) E.midscale(acc, wr, fr, ui, lds);
            const char* a1 = cA + (size_t)(t + 1) * kstep;
            const char* a2 = last ? nA : cA + (size_t)(t + 2) * kstep; const char* b2 = last ? nB : cB + (size_t)(t + 2) * kstep;
            const char* a3 = a2 + kstep; const char* b3 = b2 + kstep;
            const unsigned x00 = last ? nva[0][0] : cva[0][0], x01 = last ? nva[0][1] : cva[0][1], x10 = last ? nva[1][0] : cva[1][0], x11 = last ? nva[1][1] : cva[1][1];
            if (last && has_next) E.prepare(nxt, ui + 1, lds);
            PG8_LDB(B0, 0, 0); PG8_SCHED; PG8_LDA(At, 0, 0); PG8_STAGE_A(PG8_SA(1, 1), a1, cva[1][0], cva[1][1]);
            PG8_WAIT_L(8); PG8_BAR; PG8_WAIT_L(0); PG8_MMA(0, 0, At, B0); PG8_BAR; PG8_SCHED;
            PG8_LDB(B1, 0, 1); PG8_STAGE_B(PG8_SB(0, 0), b2);
            PG8_BAR; PG8_WAIT_L(0); PG8_MMA(0, 1, At, B1); PG8_BAR;
            PG8_LDA(At, 0, 1); PG8_STAGE_A(PG8_SA(0, 0), a2, x00, x01);
            PG8_BAR; PG8_WAIT_L(0); PG8_MMA(1, 0, At, B0); PG8_BAR; PG8_SCHED;
            PG8_STAGE_B(PG8_SB(0, 1), b2 + hstepB);
            PG8_WAIT_V(6); PG8_BAR; PG8_MMA(1, 1, At, B1); PG8_BAR;
            PG8_LDB(B0, 1, 0); PG8_SCHED; PG8_LDA(At, 1, 0); PG8_STAGE_A(PG8_SA(0, 1), a2, x10, x11);
            PG8_WAIT_L(8); PG8_BAR; PG8_WAIT_L(0); PG8_MMA(0, 0, At, B0); PG8_BAR; PG8_SCHED;
            PG8_LDB(B1, 1, 1); PG8_STAGE_B(PG8_SB(1, 0), b3);
            PG8_BAR; PG8_WAIT_L(0); PG8_MMA(0, 1, At, B1); PG8_BAR;
            PG8_LDA(At, 1, 1); PG8_STAGE_A(PG8_SA(1, 0), a3, x00, x01);
            PG8_BAR; PG8_WAIT_L(0); PG8_MMA(1, 0, At, B0); PG8_BAR; PG8_SCHED;
            PG8_STAGE_B(PG8_SB(1, 1), b3 + hstepB);
            PG8_WAIT_V(6); PG8_BAR; PG8_MMA(1, 1, At, B1); PG8_BAR;
        }
        E(acc, cur, wr, wc, fr, fq, ui, lds);
        if (!has_next) break;
#pragma unroll
        for (int a = 0; a < 2; ++a)
#pragma unroll
            for (int b = 0; b < 2; ++b)
#pragma unroll
                for (int m = 0; m < 4; ++m)
#pragma unroll
                    for (int n = 0; n < 2; ++n) acc[a][b][m][n] = (f32x4){0.f, 0.f, 0.f, 0.f};
        cur = nxt; cA = nA; cB = nB; ++ui;
#pragma unroll
        for (int h = 0; h < 2; ++h)
#pragma unroll
            for (int i = 0; i < 2; ++i) cva[h][i] = nva[h][i];
    }
    PG8_WAIT_V(0);
    if (wr == 0) PG8_BAR;
    PG8_BAR;
#undef PG8_SA
#undef PG8_SB
#undef PG8_STAGE_A
#undef PG8_STAGE_B
#undef PG8_LDA
#undef PG8_LDB
#undef PG8_MMA
#undef PG8_WAIT_V
#undef PG8_WAIT_L
#undef PG8_BAR
#undef PG8_SCHED
}

struct EpiZ {
    static constexpr bool PERM = true, MIDSCALE = false;
    bf16_t* O; int ldc;
    __device__ __forceinline__ void prepare(const Unit&, int, LAS unsigned char*) const {}
    __device__ __forceinline__ void midscale(f32x4 (&)[2][2][4][2], int, int, int, LAS unsigned char*) const {}
    __device__ __forceinline__ void operator()(const f32x4 (&acc)[2][2][4][2], const Unit& u, int wr, int wc, int fr, int fq, int, LAS unsigned char*) const {
        const int row0 = u.pm * BM + wr * 64 + fr, col0 = u.pn * BM + wc * 32 + 8 * fq;
#pragma unroll
        for (int ai = 0; ai < 2; ++ai)
#pragma unroll
            for (int m = 0; m < 4; ++m) { bf16_t* rowp = O + (size_t)(row0 + ai * HALF + m * 16) * ldc + col0;
#pragma unroll
                for (int bj = 0; bj < 2; ++bj) { const f32x4 v0 = acc[ai][bj][m][0], v1 = acc[ai][bj][m][1];
                    u32x4 w; w.x = cvt_pk_bf16(v0[0], v0[1]); w.y = cvt_pk_bf16(v0[2], v0[3]); w.z = cvt_pk_bf16(v1[0], v1[1]); w.w = cvt_pk_bf16(v1[2], v1[3]);
                    *(u32x4*)(rowp + bj * HALF) = w; } }
    }
};
struct EpiH {
    static constexpr bool PERM = false, MIDSCALE = true;
    const float* ssq; const float* x; float* h; int tab_off;
    __device__ __forceinline__ void prepare(const Unit& u, int ui, LAS unsigned char* lds) const {
        LAS f32x2* tab = (LAS f32x2*)(lds + tab_off) + (ui & 1) * 256;
        if (threadIdx.x < 256) {
            const float* sp = ssq + (size_t)(u.pm * BM + threadIdx.x) * SSQW; float sa = 0.f, sb = 0.f;
#pragma unroll
            for (int i = 0; i < 4; ++i) { const f32x4 v = *(const f32x4*)(sp + 4 * i); sa += (v[0] + v[1]) + (v[2] + v[3]); }
#pragma unroll
            for (int i = 4; i < 6; ++i) { const f32x4 v = *(const f32x4*)(sp + 4 * i); sb += (v[0] + v[1]) + (v[2] + v[3]); }
            const float ra = rsqrtf(sa * (1.0f / 512.0f) + EPS), rb = rsqrtf(sb * (1.0f / 512.0f) + EPS);
            tab[threadIdx.x] = (f32x2){ra / rb, rb};
        }
    }
    __device__ __forceinline__ void midscale(f32x4 (&acc)[2][2][4][2], int wr, int fr, int ui, LAS unsigned char* lds) const {
        const LAS f32x2* tab = (const LAS f32x2*)(lds + tab_off) + (ui & 1) * 256;
#pragma unroll
        for (int ai = 0; ai < 2; ++ai)
#pragma unroll
            for (int m = 0; m < 4; ++m) { const float s = tab[ai * HALF + wr * 64 + m * 16 + fr].x;
#pragma unroll
                for (int bj = 0; bj < 2; ++bj)
#pragma unroll
                    for (int n = 0; n < 2; ++n) acc[ai][bj][m][n] = acc[ai][bj][m][n] * s; }
    }
    __device__ __forceinline__ void operator()(const f32x4 (&acc)[2][2][4][2], const Unit& u, int wr, int wc, int fr, int fq, int ui, LAS unsigned char* lds) const {
        const LAS f32x2* tab = (const LAS f32x2*)(lds + tab_off) + (ui & 1) * 256;
        const int row0 = u.pm * BM + wr * 64 + fr, col0 = u.pn * BM + wc * 32 + 4 * fq;
#pragma unroll
        for (int ai = 0; ai < 2; ++ai)
#pragma unroll
            for (int m = 0; m < 4; ++m) { const float s = tab[ai * HALF + wr * 64 + m * 16 + fr].y; const size_t ro = (size_t)(row0 + ai * HALF + m * 16) * D + col0;
#pragma unroll
                for (int bj = 0; bj < 2; ++bj)
#pragma unroll
                    for (int n = 0; n < 2; ++n) { const f32x4 xv = *(const f32x4*)(x + ro + bj * HALF + n * 16); *(f32x4*)(h + ro + bj * HALF + n * 16) = xv + acc[ai][bj][m][n] * s; } }
    }
};

template <int MODE>
struct MoeOrder {
    const bf16_t* A; const bf16_t* Bt; const int* tok_list; const LAS int* meta; int K, G, c, ntiles;
    __device__ __forceinline__ bool next(int i, Unit& u) const {
        const int L = i * G + c; if (L >= ntiles * 4) return false;
        const int mt = L >> 2; int e = 0;
#pragma unroll
        for (int j = 1; j < NE; ++j) e += (mt >= meta[j]) ? 1 : 0;
        u.pm = mt; u.pn = L & 3; u.e = e; u.rows = meta[32 + e] - (mt - meta[e]) * BM; return true;
    }
    __device__ __forceinline__ void addr(const Unit& u, const int (&RA)[2], const int (&CA)[2], const char*& aBase, const char*& bBase, unsigned (&va)[2][2]) const {
        aBase = (const char*)A; bBase = (const char*)Bt + ((size_t)u.e * D + (size_t)u.pn * BM) * K * 2;
        const int slot0 = (u.pm - meta[u.e]) * BM;
#pragma unroll
        for (int h = 0; h < 2; ++h)
#pragma unroll
            for (int i = 0; i < 2; ++i) {
                const int r = h * HALF + RA[i];
                if (MODE == 0) { int tok = 0; if (r < u.rows) tok = tok_list[u.e * T + slot0 + r] >> 1; va[h][i] = (unsigned)(((size_t)tok * K + CA[i]) * 2); }
                else va[h][i] = (unsigned)(((size_t)(u.pm * BM + r) * K + CA[i]) * 2);
            }
    }
};
struct EpiHid {
    static constexpr bool PERM = true, MIDSCALE = false;
    bf16_t* hid;
    __device__ __forceinline__ void prepare(const Unit&, int, LAS unsigned char*) const {}
    __device__ __forceinline__ void midscale(f32x4 (&)[2][2][4][2], int, int, int, LAS unsigned char*) const {}
    __device__ __forceinline__ void operator()(const f32x4 (&acc)[2][2][4][2], const Unit& u, int wr, int wc, int fr, int fq, int, LAS unsigned char*) const {
        const int row0 = u.pm * BM + wr * 64 + fr, j0 = u.pn * 128 + wc * 16 + 4 * fq;
#pragma unroll
        for (int ai = 0; ai < 2; ++ai)
#pragma unroll
            for (int m = 0; m < 4; ++m) { bf16_t* rowp = hid + (size_t)(row0 + ai * HALF + m * 16) * DFF + j0;
#pragma unroll
                for (int bj = 0; bj < 2; ++bj) { const f32x4 g = acc[ai][bj][m][0], up = acc[ai][bj][m][1]; float hv[4];
#pragma unroll
                    for (int q = 0; q < 4; ++q) hv[q] = g[q] * up[q] * __builtin_amdgcn_rcpf(1.0f + __expf(-g[q]));
                    *(u32x2*)(rowp + bj * 64) = (u32x2){cvt_pk_bf16(hv[0], hv[1]), cvt_pk_bf16(hv[2], hv[3])}; } }
    }
};
struct EpiY {
    static constexpr bool PERM = true, MIDSCALE = false;
    bf16_t* y2; const int* tok_list; const float* w_list; const LAS int* meta;
    __device__ __forceinline__ void prepare(const Unit&, int, LAS unsigned char*) const {}
    __device__ __forceinline__ void midscale(f32x4 (&)[2][2][4][2], int, int, int, LAS unsigned char*) const {}
    __device__ __forceinline__ void operator()(const f32x4 (&acc)[2][2][4][2], const Unit& u, int wr, int wc, int fr, int fq, int, LAS unsigned char*) const {
        const int slot0 = (u.pm - meta[u.e]) * BM, col0 = u.pn * BM + wc * 32 + 8 * fq;
#pragma unroll
        for (int ai = 0; ai < 2; ++ai)
#pragma unroll
            for (int m = 0; m < 4; ++m) { const int r = ai * HALF + wr * 64 + m * 16 + fr;
                if (r < u.rows) { const int dst = tok_list[u.e * T + slot0 + r]; const float w = w_list[u.e * T + slot0 + r]; bf16_t* rowp = y2 + (size_t)dst * D + col0;
#pragma unroll
                    for (int bj = 0; bj < 2; ++bj) { const f32x4 v0 = acc[ai][bj][m][0] * w, v1 = acc[ai][bj][m][1] * w;
                        u32x4 o; o.x = cvt_pk_bf16(v0[0], v0[1]); o.y = cvt_pk_bf16(v0[2], v0[3]); o.z = cvt_pk_bf16(v1[0], v1[1]); o.w = cvt_pk_bf16(v1[2], v1[3]);
                        *(u32x4*)(rowp + bj * HALF) = o; } } }
    }
};
}

struct RowId { int off; __device__ __forceinline__ int operator()(int n) const { return off + n; } };
struct RowGU { int up; __device__ __forceinline__ int operator()(int j) const { return (j >> 2) * 8 + (j & 3) + 4 * up; } };

template <bool HASG, class RowMap>
__device__ __forceinline__ void p0_transpose_item(const float* W, int K, int N, const float* gk, int gsplit, const float* gk2, bf16_t* WT, RowMap rm, LAS float* scr, int item, int lane) {
    const int nblk = N / 32, kb = item / nblk, nb = item % nblk, k0 = 64 * kb, n0 = 32 * nb;
    const float* gp = HASG ? ((k0 < gsplit) ? gk + k0 : gk2 + (k0 - gsplit)) : nullptr;
#pragma unroll 8
    for (int i = 0; i < 32; ++i) { const int kk = 2 * i + (lane >> 5);
        float v = W[(size_t)(k0 + kk) * N + n0 + (lane & 31)]; if (HASG) v *= gp[kk];
        scr[kk * 33 + (lane & 31)] = v; }
    LDS_WAIT(); asm volatile("" ::: "memory");
    const int c = lane & 7;
#pragma unroll
    for (int j = 0; j < 4; ++j) { const int n = (lane >> 3) + 8 * j; const LAS float* s = scr + (8 * c) * 33 + n;
        u32x4 o; o.x = pk2(s[0 * 33], s[1 * 33]); o.y = pk2(s[2 * 33], s[3 * 33]); o.z = pk2(s[4 * 33], s[5 * 33]); o.w = pk2(s[6 * 33], s[7 * 33]);
        *(u32x4*)(WT + (size_t)rm(n0 + n) * K + k0 + 8 * c) = o; }
    LDS_WAIT(); asm volatile("" ::: "memory");
}

__device__ __forceinline__ void ph_prologue(const Params& p, LAS unsigned char* lds, int vcu, int G) {
    const int tid = opaque_tid(), lane = tid & 63, wave = tid >> 6;
    LAS float* scr = (LAS float*)(lds + wave * 16384);
    const int gw = vcu * NWAVES + wave, NGW = G * NWAVES;
    bf16_t* win_t = (bf16_t*)(p.ws + WS_WIN); bf16_t* wout_t = (bf16_t*)(p.ws + WS_WOUT); bf16_t* xb = (bf16_t*)(p.ws + WS_XB);
    bf16_t* wgu_t = (bf16_t*)(p.ws + WS_WGU); bf16_t* wd_t = (bf16_t*)(p.ws + WS_WD);
    constexpr int I_IN = (D / 64) * (INW / 32), I_OUT = (D / 64) * (D / 32), I_G = (D / 64) * (DFF / 32), I_D = (DFF / 64) * (D / 32), I_E = 2 * I_G + I_D;
    for (int it = gw; it < I_IN + I_OUT + NE * I_E; it += NGW) {
        if (it < I_IN) p0_transpose_item<true>(p.w_in, D, INW, p.norm1_g, D, p.norm1_g, win_t, RowId{0}, scr, it, lane);
        else if (it < I_IN + I_OUT) p0_transpose_item<true>(p.w_out, D, D, p.g_rec_out, 512, p.g_att_out, wout_t, RowId{0}, scr, it - I_IN, lane);
        else {
            const int r = it - I_IN - I_OUT, e = r / I_E, q = r % I_E;
            if (q < I_G) p0_transpose_item<true>(p.w_e_gate + (size_t)e * D * DFF, D, DFF, p.norm2_g, D, p.norm2_g, wgu_t + (size_t)e * D * D, RowGU{0}, scr, q, lane);
            else if (q < 2 * I_G) p0_transpose_item<true>(p.w_e_up + (size_t)e * D * DFF, D, DFF, p.norm2_g, D, p.norm2_g, wgu_t + (size_t)e * D * D, RowGU{1}, scr, q - I_G, lane);
            else p0_transpose_item<false>(p.w_e_down + (size_t)e * DFF * D, DFF, D, nullptr, 0, nullptr, wd_t + (size_t)e * D * DFF, RowId{0}, scr, q - 2 * I_G, lane);
        }
    }
    for (int t = gw; t < T; t += NGW) {
        const f32x4* xr = (const f32x4*)(p.x + (size_t)t * D) + lane;
        f32x4 v[4]; float ss = 0.f;
#pragma unroll
        for (int j = 0; j < 4; ++j) { v[j] = xr[64 * j]; ss += (v[j][0] * v[j][0] + v[j][1] * v[j][1]) + (v[j][2] * v[j][2] + v[j][3] * v[j][3]); }
        const float r = rsqrtf(wave_sum(ss) * (1.0f / D) + EPS);
        u32x2* o8 = (u32x2*)(xb + (size_t)t * D) + lane;
#pragma unroll
        for (int j = 0; j < 4; ++j) o8[64 * j] = (u32x2){pk2(v[j][0] * r, v[j][1] * r), pk2(v[j][2] * r, v[j][3] * r)};
    }
}

__device__ void ph_rglru_gates(const Params& p, const bf16_t* z, float* a_out, float* bx_out, float* uc_s) {
    const int c = threadIdx.x;
    const int h = c >> 6, j = c & 63;
    const float sp = log1pf(expf(-p.lru_lambda[c]));
    for (int t = blockIdx.x; t < T; t += gridDim.x) {
        const int s = t % S;
        float uc = p.conv_b[c];
#pragma unroll
        for (int jj = 0; jj < 4; ++jj) { const int sp_ = s - 3 + jj; if (sp_ >= 0) uc += bf2f(z[(size_t)(t - 3 + jj) * INW + c]) * p.conv_w[jj * RW + c]; }
        __syncthreads();
        uc_s[c] = uc;
        __syncthreads();
        float ra = p.b_rg_a[c], ri = p.b_rg_x[c];
        const float* wa = p.w_rg_a + (size_t)h * RHD * RHD + j;
        const float* wx = p.w_rg_x + (size_t)h * RHD * RHD + j;
#pragma unroll 4
        for (int i = 0; i < RHD; ++i) { const float u = uc_s[h * 64 + i]; ra += u * wa[i * RHD]; ri += u * wx[i * RHD]; }
        const float r = sigmoidf_(ra), ig = sigmoidf_(ri);
        const float log_a = -8.0f * r * sp;
        a_out[(size_t)t * RW + c] = expf(log_a);
        bx_out[(size_t)t * RW + c] = sqrtf(-expm1f(2.0f * log_a)) * (ig * uc);
    }
}
__device__ void ph_scan(const float* a_in, const float* bx_in, const bf16_t* z, bf16_t* mix) {
    const int gid = blockIdx.x * blockDim.x + threadIdx.x;
    if (gid >= NB * RW) return;
    const int b = gid / RW, c = gid % RW;
    float h = 0.f;
#pragma unroll 4
    for (int s = 0; s < S; ++s) {
        const size_t t = (size_t)b * S + s;
        h = a_in[t * RW + c] * h + bx_in[t * RW + c];
        mix[t * D + c] = (bf16_t)f2bf(h * gelu_tanh(bf2f(z[t * INW + 512 + c])));
    }
}
__device__ void ph_attn_naive(const Params& p, const bf16_t* z, bf16_t* mix) {
    const int tid = threadIdx.x, hd = tid >> 6, qi = tid & 63;
    for (int item = blockIdx.x; item < NB * (S / CHUNK); item += gridDim.x) {
        const int b = item / (S / CHUNK), c = item % (S / CHUNK);
        const size_t tq = (size_t)b * S + c * CHUNK + qi;
        float q[64], o[64];
#pragma unroll
        for (int d = 0; d < 64; ++d) { q[d] = bf2f(z[tq * INW + 1024 + hd * 64 + d]) * 0.125f; o[d] = 0.f; }
        float m = -3.0e38f, l = 0.f;
        const int k_begin = (c >= LEFT) ? 0 : (LEFT - c) * CHUNK;
        for (int kk = k_begin; kk < BAND; ++kk) {
            const size_t tk = (size_t)b * S + (c - LEFT) * CHUNK + kk;
            const bf16_t* kp = z + tk * INW + 1536 + hd * 64;
            const bf16_t* vp = z + tk * INW + 2048 + hd * 64;
            float sc = 0.f;
#pragma unroll
            for (int d = 0; d < 64; ++d) sc += q[d] * bf2f(kp[d]);
            int rel = LEFT * CHUNK + qi - kk;
            rel = rel < -MAXREL ? -MAXREL : (rel > MAXREL ? MAXREL : rel);
            sc += p.rel_bias[hd * (2 * MAXREL + 1) + rel + MAXREL];
            const float mn = fmaxf(m, sc), alpha = expf(m - mn), pe = expf(sc - mn);
            l = l * alpha + pe;
#pragma unroll
            for (int d = 0; d < 64; ++d) o[d] = o[d] * alpha + pe * bf2f(vp[d]);
            m = mn;
        }
        const float inv = 1.0f / l;
#pragma unroll
        for (int d = 0; d < 64; ++d) mix[tq * D + 512 + hd * 64 + d] = (bf16_t)f2bf(o[d] * inv);
    }
}
__device__ void ph_ssq(const bf16_t* mix, float* ssq) {
    const int lane = threadIdx.x & 63, wv = threadIdx.x >> 6, nw = blockDim.x >> 6;
    for (int t = blockIdx.x * nw + wv; t < T; t += gridDim.x * nw) {
        float sa = 0.f, sb = 0.f;
        for (int i = lane; i < 512; i += 64) { const float a = bf2f(mix[(size_t)t * D + i]), b = bf2f(mix[(size_t)t * D + 512 + i]); sa += a * a; sb += b * b; }
        sa = wave_sum(sa); sb = wave_sum(sb);
        if (lane < 16) ssq[(size_t)t * SSQW + lane] = (lane == 0) ? sa : 0.f;
    }
}
__device__ void ph_router(const Params& p, const float* h, bf16_t* xn2b, int* route_e, float* route_w) {
    const int lane = threadIdx.x & 63, wv = threadIdx.x >> 6, nw = blockDim.x >> 6;
    for (int t = blockIdx.x * nw + wv; t < T; t += gridDim.x * nw) {
        const float* row = h + (size_t)t * D;
        float v[16]; float ss = 0.f;
#pragma unroll
        for (int i = 0; i < 16; ++i) { v[i] = row[lane + 64 * i]; ss += v[i] * v[i]; }
        ss = wave_sum(ss);
        const float r = rsqrtf(ss / (float)D + EPS);
#pragma unroll
        for (int i = 0; i < 16; ++i) { xn2b[(size_t)t * D + lane + 64 * i] = (bf16_t)f2bf(v[i] * r); v[i] = v[i] * r * p.norm2_g[lane + 64 * i]; }
        float lg[4], le[16];
#pragma unroll
        for (int g = 0; g < 4; ++g) lg[g] = 0.f;
#pragma unroll
        for (int e = 0; e < 16; ++e) le[e] = 0.f;
#pragma unroll
        for (int i = 0; i < 16; ++i) {
            const int k = lane + 64 * i;
            const float4 wg = *(const float4*)(p.w_group + (size_t)k * 4);
            lg[0] += v[i] * wg.x; lg[1] += v[i] * wg.y; lg[2] += v[i] * wg.z; lg[3] += v[i] * wg.w;
#pragma unroll
            for (int e4 = 0; e4 < 4; ++e4) {
                const float4 wr = *(const float4*)(p.w_router + (size_t)k * 16 + e4 * 4);
                le[e4 * 4 + 0] += v[i] * wr.x; le[e4 * 4 + 1] += v[i] * wr.y; le[e4 * 4 + 2] += v[i] * wr.z; le[e4 * 4 + 3] += v[i] * wr.w;
            }
        }
#pragma unroll
        for (int g = 0; g < 4; ++g) lg[g] = wave_sum(lg[g]) + p.b_group[g];
#pragma unroll
        for (int e = 0; e < 16; ++e) le[e] = wave_sum(le[e]) + p.b_router[e];
        float mine = 0.f;
#pragma unroll
        for (int e = 0; e < 16; ++e) mine = (lane == e) ? le[e] : mine;
        int g = 0; float best = lg[0];
#pragma unroll
        for (int i = 1; i < 4; ++i) if (lg[i] > best) { best = lg[i]; g = i; }
        float sel[4];
#pragma unroll
        for (int i = 0; i < 4; ++i) sel[i] = __shfl(mine, g * 4 + i);
        if (lane == 0) {
            float den = 0.f;
#pragma unroll
            for (int i = 0; i < 4; ++i) den += expf(lg[i] - best);
            const float pg = 1.0f / den;
            int i1 = 0; float v1 = sel[0];
#pragma unroll
            for (int i = 1; i < 4; ++i) if (sel[i] > v1) { v1 = sel[i]; i1 = i; }
            int i2 = -1; float v2 = -3.0e38f;
#pragma unroll
            for (int i = 0; i < 4; ++i) if (i != i1 && sel[i] > v2) { v2 = sel[i]; i2 = i; }
            const float e2 = expf(v2 - v1);
            const float w1 = pg / (1.0f + e2), w2 = pg * e2 / (1.0f + e2);
            route_e[t * 2 + 0] = g * 4 + i1; route_e[t * 2 + 1] = g * 4 + i2;
            route_w[t * 2 + 0] = w1; route_w[t * 2 + 1] = w2;
        }
    }
}
__device__ void ph_moe_naive(const Params& p, const float* h, const bf16_t* xn2b, const int* route_e, const float* route_w, float* out, float* lds) {
    float* xs = lds;
    float* hs = lds + 1024;
    float* red = lds + 1536;
    const int tid = threadIdx.x;
    for (int t = blockIdx.x; t < T; t += gridDim.x) {
        __syncthreads();
        xs[tid] = bf2f(xn2b[(size_t)t * D + tid]) * p.norm2_g[tid]; xs[tid + 512] = bf2f(xn2b[(size_t)t * D + tid + 512]) * p.norm2_g[tid + 512];
        __syncthreads();
        float o0 = h[(size_t)t * D + tid], o1 = h[(size_t)t * D + tid + 512];
        for (int k = 0; k < 2; ++k) {
            const int e = route_e[t * 2 + k]; const float w = route_w[t * 2 + k];
            const float* wg = p.w_e_gate + (size_t)e * D * DFF + tid;
            const float* wu = p.w_e_up + (size_t)e * D * DFF + tid;
            float ag = 0.f, au = 0.f;
#pragma unroll 8
            for (int i = 0; i < D; ++i) { const float xv = xs[i]; ag += xv * wg[(size_t)i * DFF]; au += xv * wu[(size_t)i * DFF]; }
            __syncthreads();
            hs[tid] = ag * sigmoidf_(ag) * au;
            __syncthreads();
            const float* wd = p.w_e_down + (size_t)e * DFF * D;
            float y0 = 0.f, y1 = 0.f;
#pragma unroll 8
            for (int jx = 0; jx < DFF; ++jx) { const float hv = hs[jx]; y0 += hv * wd[(size_t)jx * D + tid]; y1 += hv * wd[(size_t)jx * D + tid + 512]; }
            o0 += w * y0; o1 += w * y1;
        }
        float ss = wave_sum(o0 * o0 + o1 * o1);
        if ((tid & 63) == 0) red[tid >> 6] = ss;
        __syncthreads();
        float tot = 0.f;
#pragma unroll
        for (int i = 0; i < 8; ++i) tot += red[i];
        const float r = rsqrtf(tot / (float)D + EPS);
        out[(size_t)t * D + tid] = o0 * r * p.final_g[tid];
        out[(size_t)t * D + tid + 512] = o1 * r * p.final_g[tid + 512];
    }
}


typedef float f32x16 __attribute__((ext_vector_type(16)));
typedef short v4i16_t __attribute__((ext_vector_type(4)));
typedef __bf16 bf16x2_t __attribute__((ext_vector_type(2)));
#define MFMA32(a, b, c) __builtin_amdgcn_mfma_f32_32x32x16_bf16((a), (b), (c), 0, 0, 0)
__device__ __forceinline__ unsigned cvtpk_s(float lo, float hi) { f32x2 v = {lo, hi}; bf16x2_t b = __builtin_convertvector(v, bf16x2_t); return __builtin_bit_cast(unsigned, b); }
__device__ __forceinline__ int crow(int r, int hh) { return (r & 3) + 8 * (r >> 2) + 4 * hh; }
__device__ __forceinline__ bf16x8 pack8(const f32x16& x, int s) {
    u32x4 w; w.x = cvtpk_s(x[8 * s + 0], x[8 * s + 1]); w.y = cvtpk_s(x[8 * s + 2], x[8 * s + 3]); w.z = cvtpk_s(x[8 * s + 4], x[8 * s + 5]); w.w = cvtpk_s(x[8 * s + 6], x[8 * s + 7]);
    return __builtin_bit_cast(bf16x8, w);
}
__device__ __forceinline__ v4i16_t vtr(LAS const unsigned char* p) { return __builtin_amdgcn_ds_read_tr16_b64_v4i16((LAS v4i16_t*)p); }
constexpr float LOG2E = 1.4426950408889634f;

struct AttnCtx { LAS float* btab; LAS unsigned char* vbase; int lane, h, q32, hh, vb, vw; float bconst; unsigned kl, vl; };
__device__ __forceinline__ AttnCtx attn_setup(const Params& p, LAS unsigned char* lds, int tab_off) {
    int tid_ = threadIdx.x; asm volatile("" : "+v"(tid_));
    AttnCtx A; const int tid = tid_; A.lane = tid & 63; A.h = __builtin_amdgcn_readfirstlane(tid >> 6); A.q32 = A.lane & 31; A.hh = A.lane >> 5;
    A.btab = (LAS float*)(lds + tab_off) + A.h * 260;
    for (int i = A.lane; i < 2 * MAXREL + 1; i += 64) A.btab[i] = p.rel_bias[A.h * (2 * MAXREL + 1) + i] * LOG2E;
    LDS_WAIT(); asm volatile("" ::: "memory");
    A.vbase = lds + A.h * 16384;
    A.vb = ((A.lane >> 4) & 1) * 32 + (A.lane & 3) * 8 + (4 * A.hh + ((A.lane & 15) >> 2)) * 128;
    A.vw = (A.lane >> 3) * 128 + (A.lane & 7) * 16;
    A.bconst = A.btab[2 * MAXREL];
    A.kl = (unsigned)((A.q32 * INW + 8 * A.hh) * 2);
    A.vl = (unsigned)(((A.lane >> 3) * INW + (A.lane & 7) * 8) * 2) + 1024u;
    return A;
}
__device__ __forceinline__ void attn_item(const AttnCtx& A, const bf16_t* z, bf16_t* mixb, float* ssq, int b, int c, int qh) {
    const int lane = A.lane, h = A.h, q32 = A.q32, hh = A.hh, vb = A.vb, vw = A.vw; LAS float* btab = A.btab; LAS unsigned char* vbase = A.vbase;
    const float bconst = A.bconst, QS = 0.125f * LOG2E; const unsigned kl = A.kl, vl = A.vl;
    {
        const int j0 = (c >= LEFT) ? 0 : LEFT - c;
        const char* kband = (const char*)z + (((long)b * S + (long)(c - LEFT) * CHUNK) * INW + 1536 + h * 64) * 2;
        {
            const int qi = qh * 32 + q32;
            const size_t tq = (size_t)b * S + c * CHUNK + qi;
            bf16x8 qf[4];
#pragma unroll
            for (int s = 0; s < 4; ++s) { const u32x4 raw = *(const u32x4*)(z + tq * INW + 1024 + h * 64 + 16 * s + 8 * hh); u32x4 w;
#pragma unroll
                for (int e = 0; e < 4; ++e) w[e] = cvtpk_s(__builtin_bit_cast(float, raw[e] << 16) * QS, __builtin_bit_cast(float, raw[e] & 0xffff0000u) * QS);
                qf[s] = __builtin_bit_cast(bf16x8, w); }
            f32x16 o0, o1;
#pragma unroll
            for (int r = 0; r < 16; ++r) { o0[r] = 0.f; o1[r] = 0.f; }
            float m_run = -1.0e30f, l_run = 0.f;
            bf16x8 kf[8]; u32x4 vr[8];
            {
                const char* tb = kband + (long)(64 * j0) * INW * 2;
#pragma unroll
                for (int kb = 0; kb < 2; ++kb)
#pragma unroll
                    for (int s = 0; s < 4; ++s) kf[kb * 4 + s] = *(const bf16x8*)(tb + (kl + (unsigned)(kb * 32 * INW * 2 + s * 32)));
#pragma unroll
                for (int i = 0; i < 8; ++i) vr[i] = *(const u32x4*)(tb + (vl + (unsigned)(i * 8 * INW * 2)));
#pragma unroll
                for (int i = 0; i < 8; ++i) *(LAS u32x4*)(vbase + (j0 & 1) * 8192 + i * 1024 + vw) = vr[i];
            }
#pragma unroll 1
            for (int j = j0; j <= LEFT; ++j) {
                f32x16 p0, p1;
                if (j <= 5) {
#pragma unroll
                    for (int r = 0; r < 16; ++r) { p0[r] = bconst; p1[r] = bconst; }
                } else {
                    const int base = LEFT * CHUNK + qi - 64 * j + MAXREL;
#pragma unroll
                    for (int r = 0; r < 16; ++r) { const int i0 = base - crow(r, hh), i1 = i0 - 32;
                        p0[r] = btab[i0 > 2 * MAXREL ? 2 * MAXREL : i0]; p1[r] = btab[i1 > 2 * MAXREL ? 2 * MAXREL : i1]; }
                }
#pragma unroll
                for (int s = 0; s < 4; ++s) { p0 = MFMA32(kf[s], qf[s], p0); p1 = MFMA32(kf[4 + s], qf[s], p1); }
                if (j < LEFT) {
                    const char* tb = kband + (long)(64 * (j + 1)) * INW * 2;
#pragma unroll
                    for (int kb = 0; kb < 2; ++kb)
#pragma unroll
                        for (int s = 0; s < 4; ++s) kf[kb * 4 + s] = *(const bf16x8*)(tb + (kl + (unsigned)(kb * 32 * INW * 2 + s * 32)));
#pragma unroll
                    for (int i = 0; i < 8; ++i) vr[i] = *(const u32x4*)(tb + (vl + (unsigned)(i * 8 * INW * 2)));
                }
                float mt = fmaxf(p0[0], p1[0]);
#pragma unroll
                for (int r = 1; r < 16; ++r) mt = fmaxf(mt, fmaxf(p0[r], p1[r]));
                mt = fmaxf(mt, __shfl_xor(mt, 32));
                const float m_new = fmaxf(m_run, mt), alpha = __builtin_amdgcn_exp2f(m_run - m_new);
                m_run = m_new;
                float ls = 0.f;
#pragma unroll
                for (int r = 0; r < 16; ++r) { p0[r] = __builtin_amdgcn_exp2f(p0[r] - m_new); p1[r] = __builtin_amdgcn_exp2f(p1[r] - m_new); ls += p0[r] + p1[r]; o0[r] *= alpha; o1[r] *= alpha; }
                l_run = l_run * alpha + ls;
                const bf16x8 pf0 = pack8(p0, 0), pf1 = pack8(p0, 1), pf2 = pack8(p1, 0), pf3 = pack8(p1, 1);
                LAS const unsigned char* vcur = vbase + (j & 1) * 8192 + vb;
#pragma unroll
                for (int db = 0; db < 2; ++db) {
                    v4i16_t lo[4], hi[4];
#pragma unroll
                    for (int ks = 0; ks < 4; ++ks) { lo[ks] = vtr(vcur + ks * 2048 + db * 64); hi[ks] = vtr(vcur + ks * 2048 + 1024 + db * 64); }
#define VF(k) (bf16x8){lo[k][0], lo[k][1], lo[k][2], lo[k][3], hi[k][0], hi[k][1], hi[k][2], hi[k][3]}
                    if (db == 0) { o0 = MFMA32(VF(0), pf0, o0); o0 = MFMA32(VF(1), pf1, o0); o0 = MFMA32(VF(2), pf2, o0); o0 = MFMA32(VF(3), pf3, o0); }
                    else         { o1 = MFMA32(VF(0), pf0, o1); o1 = MFMA32(VF(1), pf1, o1); o1 = MFMA32(VF(2), pf2, o1); o1 = MFMA32(VF(3), pf3, o1); }
#undef VF
                }
                if (j < LEFT) {
#pragma unroll
                    for (int i = 0; i < 8; ++i) *(LAS u32x4*)(vbase + ((j + 1) & 1) * 8192 + i * 1024 + vw) = vr[i];
                }
            }
            const float lt = l_run + __shfl_xor(l_run, 32), inv = 1.0f / lt;
            float ss = 0.f;
            bf16_t* orow = mixb + tq * D + 512 + h * 64 + 4 * hh;
#pragma unroll
            for (int g = 0; g < 4; ++g) {
                const float a0 = o0[4 * g] * inv, a1 = o0[4 * g + 1] * inv, a2 = o0[4 * g + 2] * inv, a3 = o0[4 * g + 3] * inv;
                const float c0 = o1[4 * g] * inv, c1 = o1[4 * g + 1] * inv, c2 = o1[4 * g + 2] * inv, c3 = o1[4 * g + 3] * inv;
                ss += (a0 * a0 + a1 * a1) + (a2 * a2 + a3 * a3) + (c0 * c0 + c1 * c1) + (c2 * c2 + c3 * c3);
                *(u32x2*)(orow + 8 * g) = (u32x2){cvtpk_s(a0, a1), cvtpk_s(a2, a3)};
                *(u32x2*)(orow + 32 + 8 * g) = (u32x2){cvtpk_s(c0, c1), cvtpk_s(c2, c3)};
            }
            ss += __shfl_xor(ss, 32);
            if (hh == 0) ssq[tq * SSQW + 16 + h] = ss;
        }
    }
}


constexpr int RG_WT = 0, RG_IMG = 18432, RG_UCF = 36864, RG_AS = 70144, RG_SEG = 103424, RG_HP = 111616, RG_ROWB = 144, RG_FS = 65;
__device__ __forceinline__ float fast_sigmoid(float x) { return __builtin_amdgcn_rcpf(1.0f + __expf(-x)); }
__device__ __forceinline__ void rglru_item(const Params& p, const bf16_t* z, bf16_t* mixb, float* ssq, LAS unsigned char* lds, int b, int hb) {
    int tid_ = threadIdx.x; asm volatile("" : "+v"(tid_));
    const int tid = tid_, lane = tid & 63, w = __builtin_amdgcn_readfirstlane(tid >> 6), ch = lane, c16 = lane & 15, tg = lane >> 4;
    LAS float* ucf = (LAS float*)(lds + RG_UCF); LAS float* as_ = (LAS float*)(lds + RG_AS); LAS f32x2* seg = (LAS f32x2*)(lds + RG_SEG); LAS float* hp = (LAS float*)(lds + RG_HP);
    for (int idx = tid; idx < 64 * 128; idx += NTHR) { const int k = idx >> 7, n = idx & 127;
        const float v = (n < 64) ? p.w_rg_a[(hb * 64 + k) * 64 + n] : p.w_rg_x[(hb * 64 + k) * 64 + n - 64];
        *(LAS bf16_t*)(lds + RG_WT + n * RG_ROWB + k * 2) = (bf16_t)f2bf(v); }
    if (tid < 64) hp[tid] = 0.f;
    const int gch = hb * 64 + ch;
    const float cw0 = p.conv_w[gch], cw1 = p.conv_w[RW + gch], cw2 = p.conv_w[2 * RW + gch], cw3 = p.conv_w[3 * RW + gch], cb = p.conv_b[gch];
    float ba[4], bxb[4], sp8[4];
#pragma unroll
    for (int nb = 0; nb < 4; ++nb) { const int c = hb * 64 + 16 * nb + c16; ba[nb] = p.b_rg_a[c]; bxb[nb] = p.b_rg_x[c]; sp8[nb] = -8.0f * log1pf(expf(-p.lru_lambda[c])); }
    __syncthreads();
    const bf16_t* ucol = z + (size_t)b * S * INW + gch;
    bf16_t un[19], gn[16];
#pragma unroll
    for (int i = 0; i < 19; ++i) { const int s = 16 * w - 3 + i; un[i] = (s >= 0) ? ucol[(long)s * INW] : (bf16_t)0; }
#pragma unroll
    for (int i = 0; i < 16; ++i) gn[i] = ucol[(long)(16 * w + i) * INW + 512];
#pragma unroll 1
    for (int blk = 0; blk < S / 128; ++blk) {
        const int par = blk & 1, t0 = blk * 128 + 16 * w;
        float uv[19], gv[16];
#pragma unroll
        for (int i = 0; i < 19; ++i) uv[i] = bf2f(un[i]);
#pragma unroll
        for (int i = 0; i < 16; ++i) gv[i] = bf2f(gn[i]);
        if (blk + 1 < S / 128) {
#pragma unroll
            for (int i = 0; i < 19; ++i) un[i] = ucol[(long)(t0 + 128 - 3 + i) * INW];
#pragma unroll
            for (int i = 0; i < 16; ++i) gn[i] = ucol[(long)(t0 + 128 + i) * INW + 512];
        }
#pragma unroll
        for (int i = 0; i < 16; ++i) { const float uc = cb + cw0 * uv[i] + cw1 * uv[i + 1] + cw2 * uv[i + 2] + cw3 * uv[i + 3];
            *(LAS bf16_t*)(lds + RG_IMG + (16 * w + i) * RG_ROWB + ch * 2) = (bf16_t)f2bf(uc); ucf[(16 * w + i) * RG_FS + ch] = uc; }
        LDS_WAIT(); asm volatile("" ::: "memory");
        const bf16x8 a0 = *(const LAS bf16x8*)(lds + RG_IMG + (16 * w + c16) * RG_ROWB + tg * 16), a1 = *(const LAS bf16x8*)(lds + RG_IMG + (16 * w + c16) * RG_ROWB + tg * 16 + 64);
        f32x4 acc[8];
#pragma unroll
        for (int nb = 0; nb < 8; ++nb) { const bf16x8 b0 = *(const LAS bf16x8*)(lds + RG_WT + (16 * nb + c16) * RG_ROWB + tg * 16), b1 = *(const LAS bf16x8*)(lds + RG_WT + (16 * nb + c16) * RG_ROWB + tg * 16 + 64);
            acc[nb] = __builtin_amdgcn_mfma_f32_16x16x32_bf16(a0, b0, (f32x4){0.f, 0.f, 0.f, 0.f}, 0, 0, 0);
            acc[nb] = __builtin_amdgcn_mfma_f32_16x16x32_bf16(a1, b1, acc[nb], 0, 0, 0); }
#pragma unroll
        for (int nb = 0; nb < 4; ++nb)
#pragma unroll
            for (int rg_ = 0; rg_ < 4; ++rg_) { const int o = (16 * w + 4 * tg + rg_) * RG_FS + 16 * nb + c16;
                const float r = fast_sigmoid(acc[nb][rg_] + ba[nb]), ig = fast_sigmoid(acc[nb + 4][rg_] + bxb[nb]);
                const float la = r * sp8[nb], x2 = 2.0f * la;
                const float om = (x2 > -0.06f) ? -x2 * (1.0f + x2 * (0.5f + x2 * (0.16666667f + x2 * 0.041666668f))) : 1.0f - __expf(x2);
                const float ucv = ucf[o];
                as_[o] = __expf(la); ucf[o] = sqrtf(om) * (ig * ucv); }
        LDS_WAIT(); asm volatile("" ::: "memory");
        float av[16], bv[16]; float H = 0.f, P = 1.f;
#pragma unroll
        for (int i = 0; i < 16; ++i) { av[i] = as_[(16 * w + i) * RG_FS + ch]; bv[i] = ucf[(16 * w + i) * RG_FS + ch]; }
#pragma unroll
        for (int i = 0; i < 16; ++i) { H = av[i] * H + bv[i]; P *= av[i]; }
        seg[(par * 8 + w) * 64 + ch] = (f32x2){P, H};
        __syncthreads();
        float hcur = hp[par * 64 + ch];
        for (int s = 0; s < w; ++s) { const f32x2 sv = seg[(par * 8 + s) * 64 + ch]; hcur = sv.x * hcur + sv.y; }
        bf16_t* orow = mixb + ((size_t)b * S + t0) * D + gch;
#pragma unroll
        for (int i = 0; i < 16; ++i) { hcur = av[i] * hcur + bv[i];
            const float g = gv[i], u2 = 1.5957691216057308f * (g + 0.044715f * g * g * g);
            const float y = hcur * g * fast_sigmoid(u2);
            orow[(size_t)i * D] = (bf16_t)f2bf(y); as_[(16 * w + i) * RG_FS + ch] = y * y; }
        if (w == 7) hp[(par ^ 1) * 64 + ch] = hcur;
        LDS_WAIT(); asm volatile("" ::: "memory");
        {
            float ssum = 0.f;
#pragma unroll
            for (int c = 0; c < 16; ++c) ssum += as_[(16 * w + c16) * RG_FS + 16 * tg + c];
            ssum += __shfl_xor(ssum, 16); ssum += __shfl_xor(ssum, 32);
            if (tg == 0) *(f32x2*)(ssq + ((size_t)b * S + t0 + c16) * SSQW + 2 * hb) = (f32x2){ssum, 0.f};
        }
    }
}

__device__ void ph_router2(const Params& p, const float* h, bf16_t* xn2b, int* gcount, int* tok_list, float* w_list, LAS int* L) {
    const int tid = opaque_tid(), lane = tid & 63, wv = tid >> 6;
    LAS int* lcnt = L; LAS int* lbase = L + 16; LAS int* rec_e = L + 32; LAS int* rec_s = L + 160; LAS float* rec_w = (LAS float*)(L + 288);
    for (int grp = blockIdx.x; grp < T / 64; grp += gridDim.x) {
        if (tid < 16) lcnt[tid] = 0;
        __syncthreads();
        for (int tl = wv * 8; tl < wv * 8 + 8; ++tl) {
            const int t = grp * 64 + tl;
            const f32x4* hr = (const f32x4*)(h + (size_t)t * D) + lane;
            f32x4 v[4]; float ss = 0.f;
#pragma unroll
            for (int j = 0; j < 4; ++j) { v[j] = hr[64 * j]; ss += (v[j][0] * v[j][0] + v[j][1] * v[j][1]) + (v[j][2] * v[j][2] + v[j][3] * v[j][3]); }
            const float r = rsqrtf(wave_sum(ss) * (1.0f / D) + EPS);
            u32x2* o8 = (u32x2*)(xn2b + (size_t)t * D) + lane;
            float lg[4], le[16];
#pragma unroll
            for (int g = 0; g < 4; ++g) lg[g] = 0.f;
#pragma unroll
            for (int e = 0; e < 16; ++e) le[e] = 0.f;
#pragma unroll
            for (int j = 0; j < 4; ++j) {
                v[j] = v[j] * r;
                o8[64 * j] = (u32x2){pk2(v[j][0], v[j][1]), pk2(v[j][2], v[j][3])};
                const f32x4 g2 = *((const f32x4*)p.norm2_g + lane + 64 * j);
                v[j] = v[j] * g2;
#pragma unroll
                for (int q = 0; q < 4; ++q) {
                    const int k = 4 * lane + 256 * j + q; const float xv = v[j][q];
                    const f32x4 wg = *(const f32x4*)(p.w_group + (size_t)k * 4);
                    lg[0] += xv * wg[0]; lg[1] += xv * wg[1]; lg[2] += xv * wg[2]; lg[3] += xv * wg[3];
#pragma unroll
                    for (int e4 = 0; e4 < 4; ++e4) { const f32x4 wr = *(const f32x4*)(p.w_router + (size_t)k * 16 + e4 * 4);
                        le[e4 * 4 + 0] += xv * wr[0]; le[e4 * 4 + 1] += xv * wr[1]; le[e4 * 4 + 2] += xv * wr[2]; le[e4 * 4 + 3] += xv * wr[3]; }
                }
            }
#pragma unroll
            for (int g = 0; g < 4; ++g) lg[g] = wave_sum(lg[g]) + p.b_group[g];
#pragma unroll
            for (int e = 0; e < 16; ++e) le[e] = wave_sum(le[e]) + p.b_router[e];
            float mine = 0.f;
#pragma unroll
            for (int e = 0; e < 16; ++e) mine = (lane == e) ? le[e] : mine;
            int g = 0; float best = lg[0];
#pragma unroll
            for (int i = 1; i < 4; ++i) if (lg[i] > best) { best = lg[i]; g = i; }
            float sel[4];
#pragma unroll
            for (int i = 0; i < 4; ++i) sel[i] = __shfl(mine, g * 4 + i);
            if (lane == 0) {
                float den = 0.f;
#pragma unroll
                for (int i = 0; i < 4; ++i) den += expf(lg[i] - best);
                const float pg = 1.0f / den;
                int i1 = 0; float v1 = sel[0];
#pragma unroll
                for (int i = 1; i < 4; ++i) if (sel[i] > v1) { v1 = sel[i]; i1 = i; }
                int i2 = -1; float v2 = -3.0e38f;
#pragma unroll
                for (int i = 0; i < 4; ++i) if (i != i1 && sel[i] > v2) { v2 = sel[i]; i2 = i; }
                const float e2 = expf(v2 - v1);
                const float w1 = pg / (1.0f + e2), w2 = pg * e2 / (1.0f + e2);
                const int ea = g * 4 + i1, eb = g * 4 + i2;
                const int sa = __hip_atomic_fetch_add(lcnt + ea, 1, __ATOMIC_RELAXED, __HIP_MEMORY_SCOPE_WORKGROUP);
                const int sb = __hip_atomic_fetch_add(lcnt + eb, 1, __ATOMIC_RELAXED, __HIP_MEMORY_SCOPE_WORKGROUP);
                rec_e[tl * 2] = ea; rec_s[tl * 2] = sa; rec_w[tl * 2] = w1;
                rec_e[tl * 2 + 1] = eb; rec_s[tl * 2 + 1] = sb; rec_w[tl * 2 + 1] = w2;
            }
        }
        __syncthreads();
        if (tid < 16) lbase[tid] = __hip_atomic_fetch_add(gcount + tid, lcnt[tid], __ATOMIC_RELAXED, __HIP_MEMORY_SCOPE_AGENT);
        __syncthreads();
        if (tid < 128) { const int e = rec_e[tid]; const int pos = lbase[e] + rec_s[tid]; tok_list[e * T + pos] = grp * 128 + tid; w_list[e * T + pos] = rec_w[tid]; }
        __syncthreads();
    }
}
__device__ void ph_final(const Params& p, const float* h, const bf16_t* y2, float* out) {
    const int tid = opaque_tid(), lane = tid & 63, wv = tid >> 6, nw = NWAVES;
    for (int t = blockIdx.x * nw + wv; t < T; t += gridDim.x * nw) {
        const f32x4* hr = (const f32x4*)(h + (size_t)t * D) + lane;
        const u32x2* y0 = (const u32x2*)(y2 + (size_t)(2 * t) * D) + lane; const u32x2* y1 = (const u32x2*)(y2 + (size_t)(2 * t + 1) * D) + lane;
        f32x4 v[4]; float ss = 0.f;
#pragma unroll
        for (int j = 0; j < 4; ++j) { const f32x4 hv = hr[64 * j]; const u32x2 a = y0[64 * j], b = y1[64 * j];
            v[j][0] = hv[0] + __builtin_bit_cast(float, a[0] << 16) + __builtin_bit_cast(float, b[0] << 16);
            v[j][1] = hv[1] + __builtin_bit_cast(float, a[0] & 0xffff0000u) + __builtin_bit_cast(float, b[0] & 0xffff0000u);
            v[j][2] = hv[2] + __builtin_bit_cast(float, a[1] << 16) + __builtin_bit_cast(float, b[1] << 16);
            v[j][3] = hv[3] + __builtin_bit_cast(float, a[1] & 0xffff0000u) + __builtin_bit_cast(float, b[1] & 0xffff0000u);
            ss += (v[j][0] * v[j][0] + v[j][1] * v[j][1]) + (v[j][2] * v[j][2] + v[j][3] * v[j][3]); }
        const float r = rsqrtf(wave_sum(ss) * (1.0f / D) + EPS);
        f32x4* orow = (f32x4*)(out + (size_t)t * D) + lane;
#pragma unroll
        for (int j = 0; j < 4; ++j) { const f32x4 gf = *((const f32x4*)p.final_g + lane + 64 * j); orow[64 * j] = v[j] * r * gf; }
    }
}


__device__ __forceinline__ void ph_mixers(const Params& p, const bf16_t* z, bf16_t* mixb, float* ssq, LAS unsigned char* lds, unsigned* qctr) {
    const AttnCtx A = attn_setup(p, lds, TAB_OFF);
    volatile LAS int* qword = (volatile LAS int*)(lds + TAB_OFF + 12288);
    constexpr int NQ = NB, QITEMS = 8 + 64;
    for (int qq = 0; qq < NQ; ++qq) {
        const int q = (blockIdx.x + qq) % NQ;
        for (;;) {
            __syncthreads();
            if (threadIdx.x == 0) *qword = (int)__hip_atomic_fetch_add(qctr + 64 * q, 1u, __ATOMIC_RELAXED, __HIP_MEMORY_SCOPE_AGENT);
            __syncthreads();
            const int idx = *qword;
            if (idx >= QITEMS) break;
            if (idx < 8) rglru_item(p, z, mixb, ssq, lds, q, idx);
            else { const int a = idx - 8; attn_item(A, z, mixb, ssq, q, 31 - (a >> 1), a & 1); }
        }
    }
}


__global__ void __launch_bounds__(NTHR) k_mega(Params p) {
    extern __shared__ __attribute__((aligned(16))) unsigned char lds_raw[];
    LAS unsigned char* lds = (LAS unsigned char*)lds_raw;
    cg::grid_group grid = cg::this_grid();
    const int G = gridDim.x; const int bx = blockIdx.x;
    const int vcu = (G % 8 == 0) ? (bx % 8) * (G / 8) + bx / 8 : bx;
    bf16_t* win_t = (bf16_t*)(p.ws + WS_WIN); bf16_t* wout_t = (bf16_t*)(p.ws + WS_WOUT);
    bf16_t* xb = (bf16_t*)(p.ws + WS_XB); bf16_t* zb = (bf16_t*)(p.ws + WS_Z); bf16_t* mixb = (bf16_t*)(p.ws + WS_MIX);
    float* ssq = (float*)(p.ws + WS_SSQ);
    float* a_ = (float*)(p.ws + WS_XB); float* bx_ = (float*)(p.ws + WS_HID);
    bf16_t* xn2b = (bf16_t*)(p.ws + WS_XB);
    int* route_e = (int*)(p.ws + WS_ROUTE); float* route_w = (float*)(p.ws + WS_ROUTE + (size_t)T * 2 * 4);
    float* h = p.out;

    ph_prologue(p, lds, vcu, G);
    grid.sync();
    {
        pg8::DenseOrder So; So.init(xb, win_t, T, INW, D, G, bx);
        pg8::EpiZ E{zb, INW};
        pg8::gemm_phase(lds, D, So, E);
    }
    grid.sync();
    ph_mixers(p, zb, mixb, ssq, lds, (unsigned*)(p.ws + WS_CTL + 8192));
    grid.sync();
    {
        pg8::DenseOrder So; So.init(mixb, wout_t, T, D, D, G, bx);
        pg8::EpiH E{ssq, p.x, h, TAB_OFF};
        pg8::gemm_phase(lds, D, So, E);
    }
    grid.sync();
    int* gcount = (int*)(p.ws + WS_CTL + 4096); int* tok_list = (int*)(p.ws + WS_LIST); float* w_list = (float*)(p.ws + WS_LIST + MiB);
    bf16_t* wgu_t = (bf16_t*)(p.ws + WS_WGU); bf16_t* wd_t = (bf16_t*)(p.ws + WS_WD); bf16_t* hid = (bf16_t*)(p.ws + WS_HID); bf16_t* y2 = (bf16_t*)(p.ws + WS_Z);
    ph_router2(p, h, xn2b, gcount, tok_list, w_list, (LAS int*)lds);
    grid.sync();
    LAS int* meta = (LAS int*)(lds + META_OFF);
    if (threadIdx.x == 0) { int base = 0; for (int e = 0; e < NE; ++e) { const int cnt = gcount[e]; meta[e] = base; meta[32 + e] = cnt; base += (cnt + 255) >> 8; } meta[16] = base; }
    __syncthreads();
    const int ntiles = meta[16];
    {
        pg8::MoeOrder<0> So{xn2b, wgu_t, tok_list, meta, D, G, bx, ntiles};
        pg8::EpiHid E{hid};
        pg8::gemm_phase(lds, D, So, E);
    }
    grid.sync();
    {
        pg8::MoeOrder<1> So{hid, wd_t, tok_list, meta, DFF, G, bx, ntiles};
        pg8::EpiY E{y2, tok_list, w_list, meta};
        pg8::gemm_phase(lds, DFF, So, E);
    }
    grid.sync();
    ph_final(p, h, y2, p.out);
}

extern "C" void kernel_launch(void* const* d_in, const int* in_sizes, int n_in, void* d_out, int out_size, void* d_ws, size_t ws_size, hipStream_t stream) {
    static int grid_blocks = 0;
    if (!grid_blocks) {
        if (ws_size < WS_END) { fprintf(stderr, "kernel_launch: workspace too small (%zu < %zu)\n", ws_size, (size_t)WS_END); grid_blocks = -1; return; }
        int dev = 0, cus = 0, per_cu = 0;
        (void)hipGetDevice(&dev);
        (void)hipDeviceGetAttribute(&cus, hipDeviceAttributeMultiprocessorCount, dev);
        (void)hipFuncSetAttribute((const void*)k_mega, hipFuncAttributeMaxDynamicSharedMemorySize, LDS_BYTES);
        (void)hipOccupancyMaxActiveBlocksPerMultiprocessor(&per_cu, (const void*)k_mega, NTHR, LDS_BYTES);
        if (per_cu < 1) { fprintf(stderr, "kernel_launch: occupancy query says %d blocks per CU\n", per_cu); per_cu = 1; }
        grid_blocks = cus;
    }
    if (grid_blocks < 0) return;
    Params p{};
    const float** f = (const float**)&p;
    for (int i = 0; i < 23; ++i) f[i] = (const float*)d_in[i];
    p.out = (float*)d_out;
    p.ws = (unsigned char*)d_ws;
    (void)hipMemsetAsync((char*)d_ws + WS_CTL, 0, CTL_BYTES, stream);
    void* args[] = {&p};
    hipError_t e = hipLaunchCooperativeKernel((void*)k_mega, dim3(grid_blocks), dim3(NTHR), args, LDS_BYTES, stream);
    if (e != hipSuccess) fprintf(stderr, "cooperative launch failed: %s (grid %d)\n", hipGetErrorString(e), grid_blocks);
}
```

```cpp
#include <hip/hip_runtime.h>
#include <hip/hip_cooperative_groups.h>
#include <cstdio>
#include <cstdint>
namespace cg = cooperative_groups;

#define LAS __attribute__((address_space(3)))
typedef unsigned short bf16_t;
typedef short bf16x8 __attribute__((ext_vector_type(8)));
typedef float f32x4 __attribute__((ext_vector_type(4)));
typedef float f32x2 __attribute__((ext_vector_type(2)));
typedef unsigned u32x4 __attribute__((ext_vector_type(4)));
typedef unsigned u32x2 __attribute__((ext_vector_type(2)));

constexpr int D = 1024, NB = 8, S = 2048, T = NB * S;
constexpr int RW = 512, RHD = 64;
constexpr int CHUNK = 64, LEFT = 8, BAND = 576, MAXREL = 128;
constexpr int INW = 2560;
constexpr int NE = 16, DFF = 512;
constexpr float EPS = 1e-6f;
constexpr int NTHR = 512, NWAVES = 8;
constexpr int SSQW = 24;

constexpr size_t MiB = 1u << 20;
constexpr size_t WS_CTL = 0, CTL_BYTES = 1 * MiB;
constexpr size_t WS_WIN = 1 * MiB;
constexpr size_t WS_WOUT = 6 * MiB;
constexpr size_t WS_WGU = 8 * MiB;
constexpr size_t WS_WD = 40 * MiB;
constexpr size_t WS_XB = 56 * MiB;
constexpr size_t WS_Z = 88 * MiB;
constexpr size_t WS_MIX = 168 * MiB;
constexpr size_t WS_HID = 200 * MiB;
constexpr size_t WS_SSQ = 236 * MiB;
constexpr size_t WS_LIST = 238 * MiB;
constexpr size_t WS_ROUTE = 240 * MiB;
constexpr size_t WS_END = 241 * MiB;

constexpr int RING_BYTES = 131072, TAB_OFF = RING_BYTES, META_OFF = RING_BYTES + 4096, MISC_OFF = RING_BYTES + 15360, LDS_BYTES = 147456;

struct Params {
    const float *x, *norm1_g, *w_in, *conv_w, *conv_b, *w_rg_a, *b_rg_a, *w_rg_x, *b_rg_x, *lru_lambda, *rel_bias,
        *g_rec_out, *g_att_out, *w_out, *norm2_g, *w_group, *b_group, *w_router, *b_router, *w_e_gate, *w_e_up, *w_e_down, *final_g;
    float* out;
    unsigned char* ws;
};

__device__ __forceinline__ float wave_sum(float v) {
#pragma unroll
    for (int o = 32; o > 0; o >>= 1) v += __shfl_xor(v, o);
    return v;
}
__device__ __forceinline__ float sigmoidf_(float x) { return 1.0f / (1.0f + expf(-x)); }
__device__ __forceinline__ float gelu_tanh(float x) { return 0.5f * x * (1.0f + tanhf(0.7978845608028654f * (x + 0.044715f * x * x * x))); }
__device__ __forceinline__ unsigned f2bf(float f) { unsigned u = __builtin_bit_cast(unsigned, f); return (u + 0x7fffu + ((u >> 16) & 1u)) >> 16; }
__device__ __forceinline__ unsigned pk2(float lo, float hi) { return f2bf(lo) | (f2bf(hi) << 16); }
__device__ __forceinline__ float bf2f(bf16_t b) { return __builtin_bit_cast(float, ((unsigned)b) << 16); }
__device__ __forceinline__ unsigned cvt_pk_bf16(float lo, float hi) { unsigned r; asm volatile("v_cvt_pk_bf16_f32 %0, %1, %2" : "=v"(r) : "v"(lo), "v"(hi)); return r; }
#define LDS_WAIT() asm volatile("s_waitcnt lgkmcnt(0)" ::: "memory")
__device__ __forceinline__ int opaque_tid() { int t = threadIdx.x; asm volatile("" : "+v"(t)); return t; }

namespace pg8 {
constexpr int BM = 256, BK = 64, HALF = 128, HTB = HALF * BK * 2, STAGE_BYTES = 8 * HTB, NXCD = 8, WGM = 8;
__device__ __forceinline__ int lds_byte(int r, int c) { const int st = (r >> 4) * 2 + (c >> 5), rr = r & 15, cc = c & 31, ob = rr * 64 + cc * 2; return st * 1024 + (ob ^ (((ob >> 9) & 1) << 5)); }
__device__ __forceinline__ void stage_rc(int b, int& R, int& C) { const int st = b / 1024, sb = b % 1024, swz = sb ^ (((sb >> 9) & 1) << 5); R = (st >> 1) * 16 + swz / 64; C = (st & 1) * 32 + (swz % 64) / 2; }
__device__ __forceinline__ int perm32(int rho) { const int n = rho >> 4, i = rho & 15; return 8 * (i >> 2) + 4 * n + (i & 3); }

struct Unit { int pm, pn, e, rows; };

struct DenseOrder {
    const bf16_t* A; const bf16_t* Bt; int K; int nM, nN, nwg, G, c;
    __device__ void init(const bf16_t* A_, const bf16_t* Bt_, int M, int N, int K_, int G_, int c_) { A = A_; Bt = Bt_; K = K_; nM = M / BM; nN = N / BM; nwg = nM * nN; G = G_; c = c_; }
    __device__ __forceinline__ bool next(int i, Unit& u) const {
        const long L = (long)i * G + c; if (L >= nwg) return false;
        int wgid = (int)L; { const int q = nwg / NXCD, r = nwg % NXCD, xcd = wgid % NXCD, off = wgid / NXCD; wgid = (xcd < r ? xcd * (q + 1) : r * (q + 1) + (xcd - r) * q) + off; }
        const int nig = WGM * nN, gid = wgid / nig, fm = gid * WGM, gsz = (nM - fm) < WGM ? (nM - fm) : WGM;
        u.pm = fm + ((wgid % nig) % gsz); u.pn = (wgid % nig) / gsz; u.e = 0; u.rows = BM; return true;
    }
    __device__ __forceinline__ void addr(const Unit& u, const int (&RA)[2], const int (&CA)[2], const char*& aBase, const char*& bBase, unsigned (&va)[2][2]) const {
        aBase = (const char*)A; bBase = (const char*)Bt + (size_t)u.pn * BM * K * 2;
#pragma unroll
        for (int h = 0; h < 2; ++h)
#pragma unroll
            for (int i = 0; i < 2; ++i) va[h][i] = (unsigned)(((size_t)(u.pm * BM + h * HALF + RA[i]) * K + CA[i]) * 2);
    }
};

template <class Epi, class Sched>
__device__ __forceinline__ void gemm_phase(LAS unsigned char* lds, const int K, const Sched& S, const Epi& E) {
    int tid_ = threadIdx.x; asm volatile("" : "+v"(tid_));
    const int tid = tid_, wid = __builtin_amdgcn_readfirstlane(tid >> 6), lane = tid & 63, wr = wid >> 2, wc = wid & 3, fr = lane & 15, fq = lane >> 4;
    const int nt = K / BK;
    int RA[2], CA[2]; unsigned voffB[2];
#pragma unroll
    for (int i = 0; i < 2; ++i) { int R, C; stage_rc(tid * 16 + i * 8192, R, C); RA[i] = R; CA[i] = C; const int Rb = Epi::PERM ? ((R & ~31) + perm32(R & 31)) : R; voffB[i] = (unsigned)(Rb * K + C) * 2u; }
    const size_t kstep = (size_t)(BK * 2);
    const size_t hstepB = (size_t)HALF * K * 2;
    const unsigned ldsw = (unsigned)wid * 1024u;
    const int aoff = lds_byte(wr * 64 + fr, fq * 8), boff = lds_byte(wc * 32 + fr, fq * 8);
#define PG8_SA(b, h) (((b) * 2 + (h)) * HTB)
#define PG8_SB(b, h) ((4 + (b) * 2 + (h)) * HTB)
#define PG8_STAGE_B(bufoff, gbase) do { _Pragma("unroll") for (int _i = 0; _i < 2; ++_i) \
        __builtin_amdgcn_global_load_lds((const unsigned*)((const char*)(gbase) + voffB[_i]), (LAS unsigned*)(lds + (bufoff) + ldsw + _i * 8192), 16, 0, 0); } while (0)
#define PG8_STAGE_A(bufoff, gbase, v0, v1) do { \
        __builtin_amdgcn_global_load_lds((const unsigned*)((const char*)(gbase) + (v0)), (LAS unsigned*)(lds + (bufoff) + ldsw), 16, 0, 0); \
        __builtin_amdgcn_global_load_lds((const unsigned*)((const char*)(gbase) + (v1)), (LAS unsigned*)(lds + (bufoff) + ldsw + 8192), 16, 0, 0); } while (0)
#define PG8_LDA(dst, b, h) do { _Pragma("unroll") for (int m = 0; m < 4; ++m) _Pragma("unroll") for (int k = 0; k < 2; ++k) dst[m][k] = *(const LAS bf16x8*)(lds + PG8_SA(b, h) + aoff + m * 2048 + k * 1024); } while (0)
#define PG8_LDB(dst, b, h) do { _Pragma("unroll") for (int n = 0; n < 2; ++n) _Pragma("unroll") for (int k = 0; k < 2; ++k) dst[n][k] = *(const LAS bf16x8*)(lds + PG8_SB(b, h) + boff + n * 2048 + k * 1024); } while (0)
#define PG8_MMA(ai, bj, At, Bt) do { __builtin_amdgcn_s_setprio(1); _Pragma("unroll") for (int m = 0; m < 4; ++m) _Pragma("unroll") for (int n = 0; n < 2; ++n) _Pragma("unroll") for (int k = 0; k < 2; ++k) \
        acc[ai][bj][m][n] = __builtin_amdgcn_mfma_f32_16x16x32_bf16(Bt[n][k], At[m][k], acc[ai][bj][m][n], 0, 0, 0); __builtin_amdgcn_s_setprio(0); } while (0)
#define PG8_WAIT_V(n) asm volatile("s_waitcnt vmcnt(" #n ")" ::: "memory")
#define PG8_WAIT_L(n) asm volatile("s_waitcnt lgkmcnt(" #n ")" ::: "memory")
#define PG8_BAR __builtin_amdgcn_s_barrier()
#define PG8_SCHED __builtin_amdgcn_sched_barrier(0)
    Unit cur, nxt; int ui = 0;
    if (!S.next(0, cur)) return;
    f32x4 acc[2][2][4][2];
#pragma unroll
    for (int a = 0; a < 2; ++a)
#pragma unroll
        for (int b = 0; b < 2; ++b)
#pragma unroll
            for (int m = 0; m < 4; ++m)
#pragma unroll
                for (int n = 0; n < 2; ++n) acc[a][b][m][n] = (f32x4){0.f, 0.f, 0.f, 0.f};
    bf16x8 At[4][2], B0[2][2], B1[2][2];
    const char *cA, *cB, *nA, *nB; unsigned cva[2][2], nva[2][2];
    S.addr(cur, RA, CA, cA, cB, cva);
    E.prepare(cur, ui, lds);
    PG8_STAGE_B(PG8_SB(0, 0), cB); PG8_STAGE_A(PG8_SA(0, 0), cA, cva[0][0], cva[0][1]); PG8_STAGE_B(PG8_SB(0, 1), cB + hstepB); PG8_STAGE_A(PG8_SA(0, 1), cA, cva[1][0], cva[1][1]);
    if (wr == 1) PG8_BAR;
    PG8_WAIT_V(4); PG8_BAR;
    PG8_STAGE_B(PG8_SB(1, 0), cB + kstep); PG8_STAGE_A(PG8_SA(1, 0), cA + kstep, cva[0][0], cva[0][1]); PG8_STAGE_B(PG8_SB(1, 1), cB + hstepB + kstep);
    PG8_WAIT_V(6); PG8_BAR;
    for (;;) {
        const bool has_next = S.next(ui + 1, nxt);
        if (has_next) { S.addr(nxt, RA, CA, nA, nB, nva); }
        else { nA = cA; nB = cB;
#pragma unroll
            for (int h = 0; h < 2; ++h)
#pragma unroll
                for (int i = 0; i < 2; ++i) nva[h][i] = cva[h][i]; }
        for (int t = 0; t < nt; t += 2) {
            const bool last = (t == nt - 2);
            if (Epi::MIDSCALE && t == nt / 2) E.midscale(acc, wr, fr, ui, lds);
            const char* a1 = cA + (size_t)(t + 1) * kstep;
            const char* a2 = last ? nA : cA + (size_t)(t + 2) * kstep; const char* b2 = last ? nB : cB + (size_t)(t + 2) * kstep;
            const char* a3 = a2 + kstep; const char* b3 = b2 + kstep;
            const unsigned x00 = last ? nva[0][0] : cva[0][0], x01 = last ? nva[0][1] : cva[0][1], x10 = last ? nva[1][0] : cva[1][0], x11 = last ? nva[1][1] : cva[1][1];
            if (last && has_next) E.prepare(nxt, ui + 1, lds);
            PG8_LDB(B0, 0, 0); PG8_SCHED; PG8_LDA(At, 0, 0); PG8_STAGE_A(PG8_SA(1, 1), a1, cva[1][0], cva[1][1]);
            PG8_WAIT_L(8); PG8_BAR; PG8_WAIT_L(0); PG8_MMA(0, 0, At, B0); PG8_BAR; PG8_SCHED;
            PG8_LDB(B1, 0, 1); PG8_STAGE_B(PG8_SB(0, 0), b2);
            PG8_BAR; PG8_WAIT_L(0); PG8_MMA(0, 1, At, B1); PG8_BAR;
            PG8_LDA(At, 0, 1); PG8_STAGE_A(PG8_SA(0, 0), a2, x00, x01);
            PG8_BAR; PG8_WAIT_L(0); PG8_MMA(1, 0, At, B0); PG8_BAR; PG8_SCHED;
            PG8_STAGE_B(PG8_SB(0, 1), b2 + hstepB);
            PG8_WAIT_V(6); PG8_BAR; PG8_MMA(1, 1, At, B1); PG8_BAR;
            PG8_LDB(B0, 1, 0); PG8_SCHED; PG8_LDA(At, 1, 0); PG8_STAGE_A(PG8_SA(0, 1), a2, x10, x11);
            PG8_WAIT_L(8); PG8_BAR; PG8_WAIT_L(0); PG8_MMA(0, 0, At, B0); PG8_BAR; PG8_SCHED;
            PG8_LDB(B1, 1, 1); PG8_STAGE_B(PG8_SB(1, 0), b3);
            PG8_BAR; PG8_WAIT_L(0); PG8_MMA(0, 1, At, B1); PG8_BAR;
            PG8_LDA(At, 1, 1); PG8_STAGE_A(PG8_SA(1, 0), a3, x00, x01);
            PG8_BAR; PG8_WAIT_L(0); PG8_MMA(1, 0, At, B0); PG8_BAR; PG8_SCHED;
            PG8_STAGE_B(PG8_SB(1, 1), b3 + hstepB);
            PG8_WAIT_V(6); PG8_BAR; PG8_MMA(1, 1, At, B1); PG8_BAR;
        }
        E(acc, cur, wr, wc, fr, fq, ui, lds);
        if (!has_next) break;
#pragma unroll
        for (int a = 0; a < 2; ++a)
#pragma unroll
            for (int b = 0; b < 2; ++b)
#pragma unroll
                for (int m = 0; m < 4; ++m)
#pragma unroll
                    for (int n = 0; n < 2; ++n) acc[a][b][m][n] = (f32x4){0.f, 0.f, 0.f, 0.f};
        cur = nxt; cA = nA; cB = nB; ++ui;
#pragma unroll
        for (int h = 0; h < 2; ++h)
#pragma unroll
            for (int i = 0; i < 2; ++i) cva[h][i] = nva[h][i];
    }
    PG8_WAIT_V(0);
    if (wr == 0) PG8_BAR;
    PG8_BAR;
#undef PG8_SA
#undef PG8_SB
#undef PG8_STAGE_A
#undef PG8_STAGE_B
#undef PG8_LDA
#undef PG8_LDB
#undef PG8_MMA
#undef PG8_WAIT_V
#undef PG8_WAIT_L
#undef PG8_BAR
#undef PG8_SCHED
}

struct EpiZ {
    static constexpr bool PERM = true, MIDSCALE = false;
    bf16_t* O; int ldc;
    __device__ __forceinline__ void prepare(const Unit&, int, LAS unsigned char*) const {}
    __device__ __forceinline__ void midscale(f32x4 (&)[2][2][4][2], int, int, int, LAS unsigned char*) const {}
    __device__ __forceinline__ void operator()(const f32x4 (&acc)[2][2][4][2], const Unit& u, int wr, int wc, int fr, int fq, int, LAS unsigned char*) const {
        const int row0 = u.pm * BM + wr * 64 + fr, col0 = u.pn * BM + wc * 32 + 8 * fq;
#pragma unroll
        for (int ai = 0; ai < 2; ++ai)
#pragma unroll
            for (int m = 0; m < 4; ++m) { bf16_t* rowp = O + (size_t)(row0 + ai * HALF + m * 16) * ldc + col0;
#pragma unroll
                for (int bj = 0; bj < 2; ++bj) { const f32x4 v0 = acc[ai][bj][m][0], v1 = acc[ai][bj][m][1];
                    u32x4 w; w.x = cvt_pk_bf16(v0[0], v0[1]); w.y = cvt_pk_bf16(v0[2], v0[3]); w.z = cvt_pk_bf16(v1[0], v1[1]); w.w = cvt_pk_bf16(v1[2], v1[3]);
                    *(u32x4*)(rowp + bj * HALF) = w; } }
    }
};
struct EpiH {
    static constexpr bool PERM = false, MIDSCALE = true;
    const float* ssq; const float* x; float* h; int tab_off;
    __device__ __forceinline__ void prepare(const Unit& u, int ui, LAS unsigned char* lds) const {
        LAS f32x2* tab = (LAS f32x2*)(lds + tab_off) + (ui & 1) * 256;
        if (threadIdx.x < 256) {
            const float* sp = ssq + (size_t)(u.pm * BM + threadIdx.x) * SSQW; float sa = 0.f, sb = 0.f;
#pragma unroll
            for (int i = 0; i < 4; ++i) { const f32x4 v = *(const f32x4*)(sp + 4 * i); sa += (v[0] + v[1]) + (v[2] + v[3]); }
#pragma unroll
            for (int i = 4; i < 6; ++i) { const f32x4 v = *(const f32x4*)(sp + 4 * i); sb += (v[0] + v[1]) + (v[2] + v[3]); }
            const float ra = rsqrtf(sa * (1.0f / 512.0f) + EPS), rb = rsqrtf(sb * (1.0f / 512.0f) + EPS);
            tab[threadIdx.x] = (f32x2){ra / rb, rb};
        }
    }
    __device__ __forceinline__ void midscale(f32x4 (&acc)[2][2][4][2], int wr, int fr, int ui, LAS unsigned char* lds) const {
        const LAS f32x2* tab = (const LAS f32x2*)(lds + tab_off) + (ui & 1) * 256;
#pragma unroll
        for (int ai = 0; ai < 2; ++ai)
#pragma unroll
            for (int m = 0; m < 4; ++m) { const float s = tab[ai * HALF + wr * 64 + m * 16 + fr].x;
#pragma unroll
                for (int bj = 0; bj < 2; ++bj)
#pragma unroll
                    for (int n = 0; n < 2; ++n) acc[ai][bj][m][n] = acc[ai][bj][m][n] * s; }
    }
    __device__ __forceinline__ void operator()(const f32x4 (&acc)[2][2][4][2], const Unit& u, int wr, int wc, int fr, int fq, int ui, LAS unsigned char* lds) const {
        const LAS f32x2* tab = (const LAS f32x2*)(lds + tab_off) + (ui & 1) * 256;
        const int row0 = u.pm * BM + wr * 64 + fr, col0 = u.pn * BM + wc * 32 + 4 * fq;
#pragma unroll
        for (int ai = 0; ai < 2; ++ai)
#pragma unroll
            for (int m = 0; m < 4; ++m) { const float s = tab[ai * HALF + wr * 64 + m * 16 + fr].y; const size_t ro = (size_t)(row0 + ai * HALF + m * 16) * D + col0;
#pragma unroll
                for (int bj = 0; bj < 2; ++bj)
#pragma unroll
                    for (int n = 0; n < 2; ++n) { const f32x4 xv = *(const f32x4*)(x + ro + bj * HALF + n * 16); *(f32x4*)(h + ro + bj * HALF + n * 16) = xv + acc[ai][bj][m][n] * s; } }
    }
};

template <int MODE>
struct MoeOrder {
    const bf16_t* A; const bf16_t* Bt; const int* tok_list; const LAS int* meta; int K, G, c, ntiles;
    __device__ __forceinline__ bool next(int i, Unit& u) const {
        const int L = i * G + c; if (L >= ntiles * 4) return false;
        const int mt = L >> 2; int e = 0;
#pragma unroll
        for (int j = 1; j < NE; ++j) e += (mt >= meta[j]) ? 1 : 0;
        u.pm = mt; u.pn = L & 3; u.e = e; u.rows = meta[32 + e] - (mt - meta[e]) * BM; return true;
    }
    __device__ __forceinline__ void addr(const Unit& u, const int (&RA)[2], const int (&CA)[2], const char*& aBase, const char*& bBase, unsigned (&va)[2][2]) const {
        aBase = (const char*)A; bBase = (const char*)Bt + ((size_t)u.e * D + (size_t)u.pn * BM) * K * 2;
        const int slot0 = (u.pm - meta[u.e]) * BM;
#pragma unroll
        for (int h = 0; h < 2; ++h)
#pragma unroll
            for (int i = 0; i < 2; ++i) {
                const int r = h * HALF + RA[i];
                if (MODE == 0) { int tok = 0; if (r < u.rows) tok = tok_list[u.e * T + slot0 + r] >> 1; va[h][i] = (unsigned)(((size_t)tok * K + CA[i]) * 2); }
                else va[h][i] = (unsigned)(((size_t)(u.pm * BM + r) * K + CA[i]) * 2);
            }
    }
};
struct EpiHid {
    static constexpr bool PERM = true, MIDSCALE = false;
    bf16_t* hid;
    __device__ __forceinline__ void prepare(const Unit&, int, LAS unsigned char*) const {}
    __device__ __forceinline__ void midscale(f32x4 (&)[2][2][4][2], int, int, int, LAS unsigned char*) const {}
    __device__ __forceinline__ void operator()(const f32x4 (&acc)[2][2][4][2], const Unit& u, int wr, int wc, int fr, int fq, int, LAS unsigned char*) const {
        const int row0 = u.pm * BM + wr * 64 + fr, j0 = u.pn * 128 + wc * 16 + 4 * fq;
#pragma unroll
        for (int ai = 0; ai < 2; ++ai)
#pragma unroll
            for (int m = 0; m < 4; ++m) { bf16_t* rowp = hid + (size_t)(row0 + ai * HALF + m * 16) * DFF + j0;
#pragma unroll
                for (int bj = 0; bj < 2; ++bj) { const f32x4 g = acc[ai][bj][m][0], up = acc[ai][bj][m][1]; float hv[4];
#pragma unroll
                    for (int q = 0; q < 4; ++q) hv[q] = g[q] * up[q] * __builtin_amdgcn_rcpf(1.0f + __expf(-g[q]));
                    *(u32x2*)(rowp + bj * 64) = (u32x2){cvt_pk_bf16(hv[0], hv[1]), cvt_pk_bf16(hv[2], hv[3])}; } }
    }
};
struct EpiY {
    static constexpr bool PERM = true, MIDSCALE = false;
    bf16_t* y2; const int* tok_list; const float* w_list; const LAS int* meta;
    __device__ __forceinline__ void prepare(const Unit&, int, LAS unsigned char*) const {}
    __device__ __forceinline__ void midscale(f32x4 (&)[2][2][4][2], int, int, int, LAS unsigned char*) const {}
    __device__ __forceinline__ void operator()(const f32x4 (&acc)[2][2][4][2], const Unit& u, int wr, int wc, int fr, int fq, int, LAS unsigned char*) const {
        const int slot0 = (u.pm - meta[u.e]) * BM, col0 = u.pn * BM + wc * 32 + 8 * fq;
#pragma unroll
        for (int ai = 0; ai < 2; ++ai)
#pragma unroll
            for (int m = 0; m < 4; ++m) { const int r = ai * HALF + wr * 64 + m * 16 + fr;
                if (r < u.rows) { const int dst = tok_list[u.e * T + slot0 + r]; const float w = w_list[u.e * T + slot0 + r]; bf16_t* rowp = y2 + (size_t)dst * D + col0;
#pragma unroll
                    for (int bj = 0; bj < 2; ++bj) { const f32x4 v0 = acc[ai][bj][m][0] * w, v1 = acc[ai][bj][m][1] * w;
                        u32x4 o; o.x = cvt_pk_bf16(v0[0], v0[1]); o.y = cvt_pk_bf16(v0[2], v0[3]); o.z = cvt_pk_bf16(v1[0], v1[1]); o.w = cvt_pk_bf16(v1[2], v1[3]);
                        *(u32x4*)(rowp + bj * HALF) = o; } } }
    }
};
}

struct RowId { int off; __device__ __forceinline__ int operator()(int n) const { return off + n; } };
struct RowGU { int up; __device__ __forceinline__ int operator()(int j) const { return (j >> 2) * 8 + (j & 3) + 4 * up; } };

template <bool HASG, class RowMap>
__device__ __forceinline__ void p0_transpose_item(const float* W, int K, int N, const float* gk, int gsplit, const float* gk2, bf16_t* WT, RowMap rm, LAS float* scr, int item, int lane) {
    const int nblk = N / 32, kb = item / nblk, nb = item % nblk, k0 = 64 * kb, n0 = 32 * nb;
    const float* gp = HASG ? ((k0 < gsplit) ? gk + k0 : gk2 + (k0 - gsplit)) : nullptr;
#pragma unroll 8
    for (int i = 0; i < 32; ++i) { const int kk = 2 * i + (lane >> 5);
        float v = W[(size_t)(k0 + kk) * N + n0 + (lane & 31)]; if (HASG) v *= gp[kk];
        scr[kk * 33 + (lane & 31)] = v; }
    LDS_WAIT(); asm volatile("" ::: "memory");
    const int c = lane & 7;
#pragma unroll
    for (int j = 0; j < 4; ++j) { const int n = (lane >> 3) + 8 * j; const LAS float* s = scr + (8 * c) * 33 + n;
        u32x4 o; o.x = pk2(s[0 * 33], s[1 * 33]); o.y = pk2(s[2 * 33], s[3 * 33]); o.z = pk2(s[4 * 33], s[5 * 33]); o.w = pk2(s[6 * 33], s[7 * 33]);
        *(u32x4*)(WT + (size_t)rm(n0 + n) * K + k0 + 8 * c) = o; }
    LDS_WAIT(); asm volatile("" ::: "memory");
}

__device__ __forceinline__ void ph_prologue(const Params& p, LAS unsigned char* lds, int vcu, int G) {
    const int tid = opaque_tid(), lane = tid & 63, wave = tid >> 6;
    LAS float* scr = (LAS float*)(lds + wave * 16384);
    const int gw = vcu * NWAVES + wave, NGW = G * NWAVES;
    bf16_t* win_t = (bf16_t*)(p.ws + WS_WIN); bf16_t* wout_t = (bf16_t*)(p.ws + WS_WOUT); bf16_t* xb = (bf16_t*)(p.ws + WS_XB);
    bf16_t* wgu_t = (bf16_t*)(p.ws + WS_WGU); bf16_t* wd_t = (bf16_t*)(p.ws + WS_WD);
    constexpr int I_IN = (D / 64) * (INW / 32), I_OUT = (D / 64) * (D / 32), I_G = (D / 64) * (DFF / 32), I_D = (DFF / 64) * (D / 32), I_E = 2 * I_G + I_D;
    for (int it = gw; it < I_IN + I_OUT + NE * I_E; it += NGW) {
        if (it < I_IN) p0_transpose_item<true>(p.w_in, D, INW, p.norm1_g, D, p.norm1_g, win_t, RowId{0}, scr, it, lane);
        else if (it < I_IN + I_OUT) p0_transpose_item<true>(p.w_out, D, D, p.g_rec_out, 512, p.g_att_out, wout_t, RowId{0}, scr, it - I_IN, lane);
        else {
            const int r = it - I_IN - I_OUT, e = r / I_E, q = r % I_E;
            if (q < I_G) p0_transpose_item<true>(p.w_e_gate + (size_t)e * D * DFF, D, DFF, p.norm2_g, D, p.norm2_g, wgu_t + (size_t)e * D * D, RowGU{0}, scr, q, lane);
            else if (q < 2 * I_G) p0_transpose_item<true>(p.w_e_up + (size_t)e * D * DFF, D, DFF, p.norm2_g, D, p.norm2_g, wgu_t + (size_t)e * D * D, RowGU{1}, scr, q - I_G, lane);
            else p0_transpose_item<false>(p.w_e_down + (size_t)e * DFF * D, DFF, D, nullptr, 0, nullptr, wd_t + (size_t)e * D * DFF, RowId{0}, scr, q - 2 * I_G, lane);
        }
    }
    for (int t = gw; t < T; t += NGW) {
        const f32x4* xr = (const f32x4*)(p.x + (size_t)t * D) + lane;
        f32x4 v[4]; float ss = 0.f;
#pragma unroll
        for (int j = 0; j < 4; ++j) { v[j] = xr[64 * j]; ss += (v[j][0] * v[j][0] + v[j][1] * v[j][1]) + (v[j][2] * v[j][2] + v[j][3] * v[j][3]); }
        const float r = rsqrtf(wave_sum(ss) * (1.0f / D) + EPS);
        u32x2* o8 = (u32x2*)(xb + (size_t)t * D) + lane;
#pragma unroll
        for (int j = 0; j < 4; ++j) o8[64 * j] = (u32x2){pk2(v[j][0] * r, v[j][1] * r), pk2(v[j][2] * r, v[j][3] * r)};
    }
}

__device__ void ph_rglru_gates(const Params& p, const bf16_t* z, float* a_out, float* bx_out, float* uc_s) {
    const int c = threadIdx.x;
    const int h = c >> 6, j = c & 63;
    const float sp = log1pf(expf(-p.lru_lambda[c]));
    for (int t = blockIdx.x; t < T; t += gridDim.x) {
        const int s = t % S;
        float uc = p.conv_b[c];
#pragma unroll
        for (int jj = 0; jj < 4; ++jj) { const int sp_ = s - 3 + jj; if (sp_ >= 0) uc += bf2f(z[(size_t)(t - 3 + jj) * INW + c]) * p.conv_w[jj * RW + c]; }
        __syncthreads();
        uc_s[c] = uc;
        __syncthreads();
        float ra = p.b_rg_a[c], ri = p.b_rg_x[c];
        const float* wa = p.w_rg_a + (size_t)h * RHD * RHD + j;
        const float* wx = p.w_rg_x + (size_t)h * RHD * RHD + j;
#pragma unroll 4
        for (int i = 0; i < RHD; ++i) { const float u = uc_s[h * 64 + i]; ra += u * wa[i * RHD]; ri += u * wx[i * RHD]; }
        const float r = sigmoidf_(ra), ig = sigmoidf_(ri);
        const float log_a = -8.0f * r * sp;
        a_out[(size_t)t * RW + c] = expf(log_a);
        bx_out[(size_t)t * RW + c] = sqrtf(-expm1f(2.0f * log_a)) * (ig * uc);
    }
}
__device__ void ph_scan(const float* a_in, const float* bx_in, const bf16_t* z, bf16_t* mix) {
    const int gid = blockIdx.x * blockDim.x + threadIdx.x;
    if (gid >= NB * RW) return;
    const int b = gid / RW, c = gid % RW;
    float h = 0.f;
#pragma unroll 4
    for (int s = 0; s < S; ++s) {
        const size_t t = (size_t)b * S + s;
        h = a_in[t * RW + c] * h + bx_in[t * RW + c];
        mix[t * D + c] = (bf16_t)f2bf(h * gelu_tanh(bf2f(z[t * INW + 512 + c])));
    }
}
__device__ void ph_attn_naive(const Params& p, const bf16_t* z, bf16_t* mix) {
    const int tid = threadIdx.x, hd = tid >> 6, qi = tid & 63;
    for (int item = blockIdx.x; item < NB * (S / CHUNK); item += gridDim.x) {
        const int b = item / (S / CHUNK), c = item % (S / CHUNK);
        const size_t tq = (size_t)b * S + c * CHUNK + qi;
        float q[64], o[64];
#pragma unroll
        for (int d = 0; d < 64; ++d) { q[d] = bf2f(z[tq * INW + 1024 + hd * 64 + d]) * 0.125f; o[d] = 0.f; }
        float m = -3.0e38f, l = 0.f;
        const int k_begin = (c >= LEFT) ? 0 : (LEFT - c) * CHUNK;
        for (int kk = k_begin; kk < BAND; ++kk) {
            const size_t tk = (size_t)b * S + (c - LEFT) * CHUNK + kk;
            const bf16_t* kp = z + tk * INW + 1536 + hd * 64;
            const bf16_t* vp = z + tk * INW + 2048 + hd * 64;
            float sc = 0.f;
#pragma unroll
            for (int d = 0; d < 64; ++d) sc += q[d] * bf2f(kp[d]);
            int rel = LEFT * CHUNK + qi - kk;
            rel = rel < -MAXREL ? -MAXREL : (rel > MAXREL ? MAXREL : rel);
            sc += p.rel_bias[hd * (2 * MAXREL + 1) + rel + MAXREL];
            const float mn = fmaxf(m, sc), alpha = expf(m - mn), pe = expf(sc - mn);
            l = l * alpha + pe;
#pragma unroll
            for (int d = 0; d < 64; ++d) o[d] = o[d] * alpha + pe * bf2f(vp[d]);
            m = mn;
        }
        const float inv = 1.0f / l;
#pragma unroll
        for (int d = 0; d < 64; ++d) mix[tq * D + 512 + hd * 64 + d] = (bf16_t)f2bf(o[d] * inv);
    }
}
__device__ void ph_ssq(const bf16_t* mix, float* ssq) {
    const int lane = threadIdx.x & 63, wv = threadIdx.x >> 6, nw = blockDim.x >> 6;
    for (int t = blockIdx.x * nw + wv; t < T; t += gridDim.x * nw) {
        float sa = 0.f, sb = 0.f;
        for (int i = lane; i < 512; i += 64) { const float a = bf2f(mix[(size_t)t * D + i]), b = bf2f(mix[(size_t)t * D + 512 + i]); sa += a * a; sb += b * b; }
        sa = wave_sum(sa); sb = wave_sum(sb);
        if (lane < 16) ssq[(size_t)t * SSQW + lane] = (lane == 0) ? sa : 0.f;
    }
}
__device__ void ph_router(const Params& p, const float* h, bf16_t* xn2b, int* route_e, float* route_w) {
    const int lane = threadIdx.x & 63, wv = threadIdx.x >> 6, nw = blockDim.x >> 6;
    for (int t = blockIdx.x * nw + wv; t < T; t += gridDim.x * nw) {
        const float* row = h + (size_t)t * D;
        float v[16]; float ss = 0.f;
#pragma unroll
        for (int i = 0; i < 16; ++i) { v[i] = row[lane + 64 * i]; ss += v[i] * v[i]; }
        ss = wave_sum(ss);
        const float r = rsqrtf(ss / (float)D + EPS);
#pragma unroll
        for (int i = 0; i < 16; ++i) { xn2b[(size_t)t * D + lane + 64 * i] = (bf16_t)f2bf(v[i] * r); v[i] = v[i] * r * p.norm2_g[lane + 64 * i]; }
        float lg[4], le[16];
#pragma unroll
        for (int g = 0; g < 4; ++g) lg[g] = 0.f;
#pragma unroll
        for (int e = 0; e < 16; ++e) le[e] = 0.f;
#pragma unroll
        for (int i = 0; i < 16; ++i) {
            const int k = lane + 64 * i;
            const float4 wg = *(const float4*)(p.w_group + (size_t)k * 4);
            lg[0] += v[i] * wg.x; lg[1] += v[i] * wg.y; lg[2] += v[i] * wg.z; lg[3] += v[i] * wg.w;
#pragma unroll
            for (int e4 = 0; e4 < 4; ++e4) {
                const float4 wr = *(const float4*)(p.w_router + (size_t)k * 16 + e4 * 4);
                le[e4 * 4 + 0] += v[i] * wr.x; le[e4 * 4 + 1] += v[i] * wr.y; le[e4 * 4 + 2] += v[i] * wr.z; le[e4 * 4 + 3] += v[i] * wr.w;
            }
        }
#pragma unroll
        for (int g = 0; g < 4; ++g) lg[g] = wave_sum(lg[g]) + p.b_group[g];
#pragma unroll
        for (int e = 0; e < 16; ++e) le[e] = wave_sum(le[e]) + p.b_router[e];
        float mine = 0.f;
#pragma unroll
        for (int e = 0; e < 16; ++e) mine = (lane == e) ? le[e] : mine;
        int g = 0; float best = lg[0];
#pragma unroll
        for (int i = 1; i < 4; ++i) if (lg[i] > best) { best = lg[i]; g = i; }
        float sel[4];
#pragma unroll
        for (int i = 0; i < 4; ++i) sel[i] = __shfl(mine, g * 4 + i);
        if (lane == 0) {
            float den = 0.f;
#pragma unroll
            for (int i = 0; i < 4; ++i) den += expf(lg[i] - best);
            const float pg = 1.0f / den;
            int i1 = 0; float v1 = sel[0];
#pragma unroll
            for (int i = 1; i < 4; ++i) if (sel[i] > v1) { v1 = sel[i]; i1 = i; }
            int i2 = -1; float v2 = -3.0e38f;
#pragma unroll
            for (int i = 0; i < 4; ++i) if (i != i1 && sel[i] > v2) { v2 = sel[i]; i2 = i; }
            const float e2 = expf(v2 - v1);
            const float w1 = pg / (1.0f + e2), w2 = pg * e2 / (1.0f + e2);
            route_e[t * 2 + 0] = g * 4 + i1; route_e[t * 2 + 1] = g * 4 + i2;
            route_w[t * 2 + 0] = w1; route_w[t * 2 + 1] = w2;
        }
    }
}
__device__ void ph_moe_naive(const Params& p, const float* h, const bf16_t* xn2b, const int* route_e, const float* route_w, float* out, float* lds) {
    float* xs = lds;
    float* hs = lds + 1024;
    float* red = lds + 1536;
    const int tid = threadIdx.x;
    for (int t = blockIdx.x; t < T; t += gridDim.x) {
        __syncthreads();
        xs[tid] = bf2f(xn2b[(size_t)t * D + tid]) * p.norm2_g[tid]; xs[tid + 512] = bf2f(xn2b[(size_t)t * D + tid + 512]) * p.norm2_g[tid + 512];
        __syncthreads();
        float o0 = h[(size_t)t * D + tid], o1 = h[(size_t)t * D + tid + 512];
        for (int k = 0; k < 2; ++k) {
            const int e = route_e[t * 2 + k]; const float w = route_w[t * 2 + k];
            const float* wg = p.w_e_gate + (size_t)e * D * DFF + tid;
            const float* wu = p.w_e_up + (size_t)e * D * DFF + tid;
            float ag = 0.f, au = 0.f;
#pragma unroll 8
            for (int i = 0; i < D; ++i) { const float xv = xs[i]; ag += xv * wg[(size_t)i * DFF]; au += xv * wu[(size_t)i * DFF]; }
            __syncthreads();
            hs[tid] = ag * sigmoidf_(ag) * au;
            __syncthreads();
            const float* wd = p.w_e_down + (size_t)e * DFF * D;
            float y0 = 0.f, y1 = 0.f;
#pragma unroll 8
            for (int jx = 0; jx < DFF; ++jx) { const float hv = hs[jx]; y0 += hv * wd[(size_t)jx * D + tid]; y1 += hv * wd[(size_t)jx * D + tid + 512]; }
            o0 += w * y0; o1 += w * y1;
        }
        float ss = wave_sum(o0 * o0 + o1 * o1);
        if ((tid & 63) == 0) red[tid >> 6] = ss;
        __syncthreads();
        float tot = 0.f;
#pragma unroll
        for (int i = 0; i < 8; ++i) tot += red[i];
        const float r = rsqrtf(tot / (float)D + EPS);
        out[(size_t)t * D + tid] = o0 * r * p.final_g[tid];
        out[(size_t)t * D + tid + 512] = o1 * r * p.final_g[tid + 512];
    }
}


typedef float f32x16 __attribute__((ext_vector_type(16)));
typedef short v4i16_t __attribute__((ext_vector_type(4)));
typedef __bf16 bf16x2_t __attribute__((ext_vector_type(2)));
#define MFMA32(a, b, c) __builtin_amdgcn_mfma_f32_32x32x16_bf16((a), (b), (c), 0, 0, 0)
__device__ __forceinline__ unsigned cvtpk_s(float lo, float hi) { f32x2 v = {lo, hi}; bf16x2_t b = __builtin_convertvector(v, bf16x2_t); return __builtin_bit_cast(unsigned, b); }
__device__ __forceinline__ int crow(int r, int hh) { return (r & 3) + 8 * (r >> 2) + 4 * hh; }
__device__ __forceinline__ bf16x8 pack8(const f32x16& x, int s) {
    u32x4 w; w.x = cvtpk_s(x[8 * s + 0], x[8 * s + 1]); w.y = cvtpk_s(x[8 * s + 2], x[8 * s + 3]); w.z = cvtpk_s(x[8 * s + 4], x[8 * s + 5]); w.w = cvtpk_s(x[8 * s + 6], x[8 * s + 7]);
    return __builtin_bit_cast(bf16x8, w);
}
__device__ __forceinline__ v4i16_t vtr(LAS const unsigned char* p) { return __builtin_amdgcn_ds_read_tr16_b64_v4i16((LAS v4i16_t*)p); }
constexpr float LOG2E = 1.4426950408889634f;

struct AttnCtx { LAS float* btab; LAS unsigned char* vbase; int lane, h, q32, hh, vb, vw; float bconst; unsigned kl, vl; };
__device__ __forceinline__ AttnCtx attn_setup(const Params& p, LAS unsigned char* lds, int tab_off) {
    int tid_ = threadIdx.x; asm volatile("" : "+v"(tid_));
    AttnCtx A; const int tid = tid_; A.lane = tid & 63; A.h = __builtin_amdgcn_readfirstlane(tid >> 6); A.q32 = A.lane & 31; A.hh = A.lane >> 5;
    A.btab = (LAS float*)(lds + tab_off) + A.h * 260;
    for (int i = A.lane; i < 2 * MAXREL + 1; i += 64) A.btab[i] = p.rel_bias[A.h * (2 * MAXREL + 1) + i] * LOG2E;
    LDS_WAIT(); asm volatile("" ::: "memory");
    A.vbase = lds + A.h * 16384;
    A.vb = ((A.lane >> 4) & 1) * 32 + (A.lane & 3) * 8 + (4 * A.hh + ((A.lane & 15) >> 2)) * 128;
    A.vw = (A.lane >> 3) * 128 + (A.lane & 7) * 16;
    A.bconst = A.btab[2 * MAXREL];
    A.kl = (unsigned)((A.q32 * INW + 8 * A.hh) * 2);
    A.vl = (unsigned)(((A.lane >> 3) * INW + (A.lane & 7) * 8) * 2) + 1024u;
    return A;
}
__device__ __forceinline__ void attn_item(const AttnCtx& A, const bf16_t* z, bf16_t* mixb, float* ssq, int b, int c, int qh) {
    const int lane = A.lane, h = A.h, q32 = A.q32, hh = A.hh, vb = A.vb, vw = A.vw; LAS float* btab = A.btab; LAS unsigned char* vbase = A.vbase;
    const float bconst = A.bconst, QS = 0.125f * LOG2E; const unsigned kl = A.kl, vl = A.vl;
    {
        const int j0 = (c >= LEFT) ? 0 : LEFT - c;
        const char* kband = (const char*)z + (((long)b * S + (long)(c - LEFT) * CHUNK) * INW + 1536 + h * 64) * 2;
        {
            const int qi = qh * 32 + q32;
            const size_t tq = (size_t)b * S + c * CHUNK + qi;
            bf16x8 qf[4];
#pragma unroll
            for (int s = 0; s < 4; ++s) { const u32x4 raw = *(const u32x4*)(z + tq * INW + 1024 + h * 64 + 16 * s + 8 * hh); u32x4 w;
#pragma unroll
                for (int e = 0; e < 4; ++e) w[e] = cvtpk_s(__builtin_bit_cast(float, raw[e] << 16) * QS, __builtin_bit_cast(float, raw[e] & 0xffff0000u) * QS);
                qf[s] = __builtin_bit_cast(bf16x8, w); }
            f32x16 o0, o1;
#pragma unroll
            for (int r = 0; r < 16; ++r) { o0[r] = 0.f; o1[r] = 0.f; }
            float m_run = -1.0e30f, l_run = 0.f;
            bf16x8 kf[8]; u32x4 vr[8];
            {
                const char* tb = kband + (long)(64 * j0) * INW * 2;
#pragma unroll
                for (int kb = 0; kb < 2; ++kb)
#pragma unroll
                    for (int s = 0; s < 4; ++s) kf[kb * 4 + s] = *(const bf16x8*)(tb + (kl + (unsigned)(kb * 32 * INW * 2 + s * 32)));
#pragma unroll
                for (int i = 0; i < 8; ++i) vr[i] = *(const u32x4*)(tb + (vl + (unsigned)(i * 8 * INW * 2)));
#pragma unroll
                for (int i = 0; i < 8; ++i) *(LAS u32x4*)(vbase + (j0 & 1) * 8192 + i * 1024 + vw) = vr[i];
            }
#pragma unroll 1
            for (int j = j0; j <= LEFT; ++j) {
                f32x16 p0, p1;
                if (j <= 5) {
#pragma unroll
                    for (int r = 0; r < 16; ++r) { p0[r] = bconst; p1[r] = bconst; }
                } else {
                    const int base = LEFT * CHUNK + qi - 64 * j + MAXREL;
#pragma unroll
                    for (int r = 0; r < 16; ++r) { const int i0 = base - crow(r, hh), i1 = i0 - 32;
                        p0[r] = btab[i0 > 2 * MAXREL ? 2 * MAXREL : i0]; p1[r] = btab[i1 > 2 * MAXREL ? 2 * MAXREL : i1]; }
                }
#pragma unroll
                for (int s = 0; s < 4; ++s) { p0 = MFMA32(kf[s], qf[s], p0); p1 = MFMA32(kf[4 + s], qf[s], p1); }
                if (j < LEFT) {
                    const char* tb = kband + (long)(64 * (j + 1)) * INW * 2;
#pragma unroll
                    for (int kb = 0; kb < 2; ++kb)
#pragma unroll
                        for (int s = 0; s < 4; ++s) kf[kb * 4 + s] = *(const bf16x8*)(tb + (kl + (unsigned)(kb * 32 * INW * 2 + s * 32)));
#pragma unroll
                    for (int i = 0; i < 8; ++i) vr[i] = *(const u32x4*)(tb + (vl + (unsigned)(i * 8 * INW * 2)));
                }
                float mt = fmaxf(p0[0], p1[0]);
#pragma unroll
                for (int r = 1; r < 16; ++r) mt = fmaxf(mt, fmaxf(p0[r], p1[r]));
                mt = fmaxf(mt, __shfl_xor(mt, 32));
                const float m_new = fmaxf(m_run, mt), alpha = __builtin_amdgcn_exp2f(m_run - m_new);
                m_run = m_new;
                float ls = 0.f;
#pragma unroll
                for (int r = 0; r < 16; ++r) { p0[r] = __builtin_amdgcn_exp2f(p0[r] - m_new); p1[r] = __builtin_amdgcn_exp2f(p1[r] - m_new); ls += p0[r] + p1[r]; o0[r] *= alpha; o1[r] *= alpha; }
                l_run = l_run * alpha + ls;
                const bf16x8 pf0 = pack8(p0, 0), pf1 = pack8(p0, 1), pf2 = pack8(p1, 0), pf3 = pack8(p1, 1);
                LAS const unsigned char* vcur = vbase + (j & 1) * 8192 + vb;
#pragma unroll
                for (int db = 0; db < 2; ++db) {
                    v4i16_t lo[4], hi[4];
#pragma unroll
                    for (int ks = 0; ks < 4; ++ks) { lo[ks] = vtr(vcur + ks * 2048 + db * 64); hi[ks] = vtr(vcur + ks * 2048 + 1024 + db * 64); }
#define VF(k) (bf16x8){lo[k][0], lo[k][1], lo[k][2], lo[k][3], hi[k][0], hi[k][1], hi[k][2], hi[k][3]}
                    if (db == 0) { o0 = MFMA32(VF(0), pf0, o0); o0 = MFMA32(VF(1), pf1, o0); o0 = MFMA32(VF(2), pf2, o0); o0 = MFMA32(VF(3), pf3, o0); }
                    else         { o1 = MFMA32(VF(0), pf0, o1); o1 = MFMA32(VF(1), pf1, o1); o1 = MFMA32(VF(2), pf2, o1); o1 = MFMA32(VF(3), pf3, o1); }
#undef VF
                }
                if (j < LEFT) {
#pragma unroll
                    for (int i = 0; i < 8; ++i) *(LAS u32x4*)(vbase + ((j + 1) & 1) * 8192 + i * 1024 + vw) = vr[i];
                }
            }
            const float lt = l_run + __shfl_xor(l_run, 32), inv = 1.0f / lt;
            float ss = 0.f;
            bf16_t* orow = mixb + tq * D + 512 + h * 64 + 4 * hh;
#pragma unroll
            for (int g = 0; g < 4; ++g) {
                const float a0 = o0[4 * g] * inv, a1 = o0[4 * g + 1] * inv, a2 = o0[4 * g + 2] * inv, a3 = o0[4 * g + 3] * inv;
                const float c0 = o1[4 * g] * inv, c1 = o1[4 * g + 1] * inv, c2 = o1[4 * g + 2] * inv, c3 = o1[4 * g + 3] * inv;
                ss += (a0 * a0 + a1 * a1) + (a2 * a2 + a3 * a3) + (c0 * c0 + c1 * c1) + (c2 * c2 + c3 * c3);
                *(u32x2*)(orow + 8 * g) = (u32x2){cvtpk_s(a0, a1), cvtpk_s(a2, a3)};
                *(u32x2*)(orow + 32 + 8 * g) = (u32x2){cvtpk_s(c0, c1), cvtpk_s(c2, c3)};
            }
            ss += __shfl_xor(ss, 32);
            if (hh == 0) ssq[tq * SSQW + 16 + h] = ss;
        }
    }
}


constexpr int RG_WT = 0, RG_IMG = 18432, RG_UCF = 36864, RG_AS = 70144, RG_SEG = 103424, RG_HP = 111616, RG_ROWB = 144, RG_FS = 65;
__device__ __forceinline__ float fast_sigmoid(float x) { return __builtin_amdgcn_rcpf(1.0f + __expf(-x)); }
__device__ __forceinline__ void rglru_item(const Params& p, const bf16_t* z, bf16_t* mixb, float* ssq, LAS unsigned char* lds, int b, int hb) {
    int tid_ = threadIdx.x; asm volatile("" : "+v"(tid_));
    const int tid = tid_, lane = tid & 63, w = __builtin_amdgcn_readfirstlane(tid >> 6), ch = lane, c16 = lane & 15, tg = lane >> 4;
    LAS float* ucf = (LAS float*)(lds + RG_UCF); LAS float* as_ = (LAS float*)(lds + RG_AS); LAS f32x2* seg = (LAS f32x2*)(lds + RG_SEG); LAS float* hp = (LAS float*)(lds + RG_HP);
    for (int idx = tid; idx < 64 * 128; idx += NTHR) { const int k = idx >> 7, n = idx & 127;
        const float v = (n < 64) ? p.w_rg_a[(hb * 64 + k) * 64 + n] : p.w_rg_x[(hb * 64 + k) * 64 + n - 64];
        *(LAS bf16_t*)(lds + RG_WT + n * RG_ROWB + k * 2) = (bf16_t)f2bf(v); }
    if (tid < 64) hp[tid] = 0.f;
    const int gch = hb * 64 + ch;
    const float cw0 = p.conv_w[gch], cw1 = p.conv_w[RW + gch], cw2 = p.conv_w[2 * RW + gch], cw3 = p.conv_w[3 * RW + gch], cb = p.conv_b[gch];
    float ba[4], bxb[4], sp8[4];
#pragma unroll
    for (int nb = 0; nb < 4; ++nb) { const int c = hb * 64 + 16 * nb + c16; ba[nb] = p.b_rg_a[c]; bxb[nb] = p.b_rg_x[c]; sp8[nb] = -8.0f * log1pf(expf(-p.lru_lambda[c])); }
    __syncthreads();
    const bf16_t* ucol = z + (size_t)b * S * INW + gch;
    bf16_t un[19], gn[16];
#pragma unroll
    for (int i = 0; i < 19; ++i) { const int s = 16 * w - 3 + i; un[i] = (s >= 0) ? ucol[(long)s * INW] : (bf16_t)0; }
#pragma unroll
    for (int i = 0; i < 16; ++i) gn[i] = ucol[(long)(16 * w + i) * INW + 512];
#pragma unroll 1
    for (int blk = 0; blk < S / 128; ++blk) {
        const int par = blk & 1, t0 = blk * 128 + 16 * w;
        float uv[19], gv[16];
#pragma unroll
        for (int i = 0; i < 19; ++i) uv[i] = bf2f(un[i]);
#pragma unroll
        for (int i = 0; i < 16; ++i) gv[i] = bf2f(gn[i]);
        if (blk + 1 < S / 128) {
#pragma unroll
            for (int i = 0; i < 19; ++i) un[i] = ucol[(long)(t0 + 128 - 3 + i) * INW];
#pragma unroll
            for (int i = 0; i < 16; ++i) gn[i] = ucol[(long)(t0 + 128 + i) * INW + 512];
        }
#pragma unroll
        for (int i = 0; i < 16; ++i) { const float uc = cb + cw0 * uv[i] + cw1 * uv[i + 1] + cw2 * uv[i + 2] + cw3 * uv[i + 3];
            *(LAS bf16_t*)(lds + RG_IMG + (16 * w + i) * RG_ROWB + ch * 2) = (bf16_t)f2bf(uc); ucf[(16 * w + i) * RG_FS + ch] = uc; }
        LDS_WAIT(); asm volatile("" ::: "memory");
        const bf16x8 a0 = *(const LAS bf16x8*)(lds + RG_IMG + (16 * w + c16) * RG_ROWB + tg * 16), a1 = *(const LAS bf16x8*)(lds + RG_IMG + (16 * w + c16) * RG_ROWB + tg * 16 + 64);
        f32x4 acc[8];
#pragma unroll
        for (int nb = 0; nb < 8; ++nb) { const bf16x8 b0 = *(const LAS bf16x8*)(lds + RG_WT + (16 * nb + c16) * RG_ROWB + tg * 16), b1 = *(const LAS bf16x8*)(lds + RG_WT + (16 * nb + c16) * RG_ROWB + tg * 16 + 64);
            acc[nb] = __builtin_amdgcn_mfma_f32_16x16x32_bf16(a0, b0, (f32x4){0.f, 0.f, 0.f, 0.f}, 0, 0, 0);
            acc[nb] = __builtin_amdgcn_mfma_f32_16x16x32_bf16(a1, b1, acc[nb], 0, 0, 0); }
#pragma unroll
        for (int nb = 0; nb < 4; ++nb)
#pragma unroll
            for (int rg_ = 0; rg_ < 4; ++rg_) { const int o = (16 * w + 4 * tg + rg_) * RG_FS + 16 * nb + c16;
                const float r = fast_sigmoid(acc[nb][rg_] + ba[nb]), ig = fast_sigmoid(acc[nb + 4][rg_] + bxb[nb]);
                const float la = r * sp8[nb], x2 = 2.0f * la;
                const float om = (x2 > -0.06f) ? -x2 * (1.0f + x2 * (0.5f + x2 * (0.16666667f + x2 * 0.041666668f))) : 1.0f - __expf(x2);
                const float ucv = ucf[o];
                as_[o] = __expf(la); ucf[o] = sqrtf(om) * (ig * ucv); }
        LDS_WAIT(); asm volatile("" ::: "memory");
        float av[16], bv[16]; float H = 0.f, P = 1.f;
#pragma unroll
        for (int i = 0; i < 16; ++i) { av[i] = as_[(16 * w + i) * RG_FS + ch]; bv[i] = ucf[(16 * w + i) * RG_FS + ch]; }
#pragma unroll
        for (int i = 0; i < 16; ++i) { H = av[i] * H + bv[i]; P *= av[i]; }
        seg[(par * 8 + w) * 64 + ch] = (f32x2){P, H};
        __syncthreads();
        float hcur = hp[par * 64 + ch];
        for (int s = 0; s < w; ++s) { const f32x2 sv = seg[(par * 8 + s) * 64 + ch]; hcur = sv.x * hcur + sv.y; }
        bf16_t* orow = mixb + ((size_t)b * S + t0) * D + gch;
#pragma unroll
        for (int i = 0; i < 16; ++i) { hcur = av[i] * hcur + bv[i];
            const float g = gv[i], u2 = 1.5957691216057308f * (g + 0.044715f * g * g * g);
            const float y = hcur * g * fast_sigmoid(u2);
            orow[(size_t)i * D] = (bf16_t)f2bf(y); as_[(16 * w + i) * RG_FS + ch] = y * y; }
        if (w == 7) hp[(par ^ 1) * 64 + ch] = hcur;
        LDS_WAIT(); asm volatile("" ::: "memory");
        {
            float ssum = 0.f;
#pragma unroll
            for (int c = 0; c < 16; ++c) ssum += as_[(16 * w + c16) * RG_FS + 16 * tg + c];
            ssum += __shfl_xor(ssum, 16); ssum += __shfl_xor(ssum, 32);
            if (tg == 0) *(f32x2*)(ssq + ((size_t)b * S + t0 + c16) * SSQW + 2 * hb) = (f32x2){ssum, 0.f};
        }
    }
}

__device__ void ph_router2(const Params& p, const float* h, bf16_t* xn2b, int* gcount, int* tok_list, float* w_list, LAS int* L) {
    const int tid = opaque_tid(), lane = tid & 63, wv = tid >> 6;
    LAS int* lcnt = L; LAS int* lbase = L + 16; LAS int* rec_e = L + 32; LAS int* rec_s = L + 160; LAS float* rec_w = (LAS float*)(L + 288);
    for (int grp = blockIdx.x; grp < T / 64; grp += gridDim.x) {
        if (tid < 16) lcnt[tid] = 0;
        __syncthreads();
        for (int tl = wv * 8; tl < wv * 8 + 8; ++tl) {
            const int t = grp * 64 + tl;
            const f32x4* hr = (const f32x4*)(h + (size_t)t * D) + lane;
            f32x4 v[4]; float ss = 0.f;
#pragma unroll
            for (int j = 0; j < 4; ++j) { v[j] = hr[64 * j]; ss += (v[j][0] * v[j][0] + v[j][1] * v[j][1]) + (v[j][2] * v[j][2] + v[j][3] * v[j][3]); }
            const float r = rsqrtf(wave_sum(ss) * (1.0f / D) + EPS);
            u32x2* o8 = (u32x2*)(xn2b + (size_t)t * D) + lane;
            float lg[4], le[16];
#pragma unroll
            for (int g = 0; g < 4; ++g) lg[g] = 0.f;
#pragma unroll
            for (int e = 0; e < 16; ++e) le[e] = 0.f;
#pragma unroll
            for (int j = 0; j < 4; ++j) {
                v[j] = v[j] * r;
                o8[64 * j] = (u32x2){pk2(v[j][0], v[j][1]), pk2(v[j][2], v[j][3])};
                const f32x4 g2 = *((const f32x4*)p.norm2_g + lane + 64 * j);
                v[j] = v[j] * g2;
#pragma unroll
                for (int q = 0; q < 4; ++q) {
                    const int k = 4 * lane + 256 * j + q; const float xv = v[j][q];
                    const f32x4 wg = *(const f32x4*)(p.w_group + (size_t)k * 4);
                    lg[0] += xv * wg[0]; lg[1] += xv * wg[1]; lg[2] += xv * wg[2]; lg[3] += xv * wg[3];
#pragma unroll
                    for (int e4 = 0; e4 < 4; ++e4) { const f32x4 wr = *(const f32x4*)(p.w_router + (size_t)k * 16 + e4 * 4);
                        le[e4 * 4 + 0] += xv * wr[0]; le[e4 * 4 + 1] += xv * wr[1]; le[e4 * 4 + 2] += xv * wr[2]; le[e4 * 4 + 3] += xv * wr[3]; }
                }
            }
#pragma unroll
            for (int g = 0; g < 4; ++g) lg[g] = wave_sum(lg[g]) + p.b_group[g];
#pragma unroll
            for (int e = 0; e < 16; ++e) le[e] = wave_sum(le[e]) + p.b_router[e];
            float mine = 0.f;
#pragma unroll
            for (int e = 0; e < 16; ++e) mine = (lane == e) ? le[e] : mine;
            int g = 0; float best = lg[0];
#pragma unroll
            for (int i = 1; i < 4; ++i) if (lg[i] > best) { best = lg[i]; g = i; }
            float sel[4];
#pragma unroll
            for (int i = 0; i < 4; ++i) sel[i] = __shfl(mine, g * 4 + i);
            if (lane == 0) {
                float den = 0.f;
#pragma unroll
                for (int i = 0; i < 4; ++i) den += expf(lg[i] - best);
                const float pg = 1.0f / den;
                int i1 = 0; float v1 = sel[0];
#pragma unroll
                for (int i = 1; i < 4; ++i) if (sel[i] > v1) { v1 = sel[i]; i1 = i; }
                int i2 = -1; float v2 = -3.0e38f;
#pragma unroll
                for (int i = 0; i < 4; ++i) if (i != i1 && sel[i] > v2) { v2 = sel[i]; i2 = i; }
                const float e2 = expf(v2 - v1);
                const float w1 = pg / (1.0f + e2), w2 = pg * e2 / (1.0f + e2);
                const int ea = g * 4 + i1, eb = g * 4 + i2;
                const int sa = __hip_atomic_fetch_add(lcnt + ea, 1, __ATOMIC_RELAXED, __HIP_MEMORY_SCOPE_WORKGROUP);
                const int sb = __hip_atomic_fetch_add(lcnt + eb, 1, __ATOMIC_RELAXED, __HIP_MEMORY_SCOPE_WORKGROUP);
                rec_e[tl * 2] = ea; rec_s[tl * 2] = sa; rec_w[tl * 2] = w1;
                rec_e[tl * 2 + 1] = eb; rec_s[tl * 2 + 1] = sb; rec_w[tl * 2 + 1] = w2;
            }
        }
        __syncthreads();
        if (tid < 16) lbase[tid] = __hip_atomic_fetch_add(gcount + tid, lcnt[tid], __ATOMIC_RELAXED, __HIP_MEMORY_SCOPE_AGENT);
        __syncthreads();
        if (tid < 128) { const int e = rec_e[tid]; const int pos = lbase[e] + rec_s[tid]; tok_list[e * T + pos] = grp * 128 + tid; w_list[e * T + pos] = rec_w[tid]; }
        __syncthreads();
    }
}
__device__ void ph_final(const Params& p, const float* h, const bf16_t* y2, float* out) {
    const int tid = opaque_tid(), lane = tid & 63, wv = tid >> 6, nw = NWAVES;
    for (int t = blockIdx.x * nw + wv; t < T; t += gridDim.x * nw) {
        const f32x4* hr = (const f32x4*)(h + (size_t)t * D) + lane;
        const u32x2* y0 = (const u32x2*)(y2 + (size_t)(2 * t) * D) + lane; const u32x2* y1 = (const u32x2*)(y2 + (size_t)(2 * t + 1) * D) + lane;
        f32x4 v[4]; float ss = 0.f;
#pragma unroll
        for (int j = 0; j < 4; ++j) { const f32x4 hv = hr[64 * j]; const u32x2 a = y0[64 * j], b = y1[64 * j];
            v[j][0] = hv[0] + __builtin_bit_cast(float, a[0] << 16) + __builtin_bit_cast(float, b[0] << 16);
            v[j][1] = hv[1] + __builtin_bit_cast(float, a[0] & 0xffff0000u) + __builtin_bit_cast(float, b[0] & 0xffff0000u);
            v[j][2] = hv[2] + __builtin_bit_cast(float, a[1] << 16) + __builtin_bit_cast(float, b[1] << 16);
            v[j][3] = hv[3] + __builtin_bit_cast(float, a[1] & 0xffff0000u) + __builtin_bit_cast(float, b[1] & 0xffff0000u);
            ss += (v[j][0] * v[j][0] + v[j][1] * v[j][1]) + (v[j][2] * v[j][2] + v[j][3] * v[j][3]); }
        const float r = rsqrtf(wave_sum(ss) * (1.0f / D) + EPS);
        f32x4* orow = (f32x4*)(out + (size_t)t * D) + lane;
#pragma unroll
        for (int j = 0; j < 4; ++j) { const f32x4 gf = *((const f32x4*)p.final_g + lane + 64 * j); orow[64 * j] = v[j] * r * gf; }
    }
}


__device__ __forceinline__ void ph_mixers(const Params& p, const bf16_t* z, bf16_t* mixb, float* ssq, LAS unsigned char* lds, unsigned* qctr) {
    const AttnCtx A = attn_setup(p, lds, TAB_OFF);
    volatile LAS int* qword = (volatile LAS int*)(lds + TAB_OFF + 12288);
    constexpr int NQ = NB, QITEMS = 8 + 64;
    for (int qq = 0; qq < NQ; ++qq) {
        const int q = (blockIdx.x + qq) % NQ;
        for (;;) {
            __syncthreads();
            if (threadIdx.x == 0) *qword = (int)__hip_atomic_fetch_add(qctr + 64 * q, 1u, __ATOMIC_RELAXED, __HIP_MEMORY_SCOPE_AGENT);
            __syncthreads();
            const int idx = *qword;
            if (idx >= QITEMS) break;
            if (idx < 8) rglru_item(p, z, mixb, ssq, lds, q, idx);
            else { const int a = idx - 8; attn_item(A, z, mixb, ssq, q, 31 - (a >> 1), a & 1); }
        }
    }
}


#define XB_TMO      128
#define XB_XCNT(j)  (256  + 64 * (j))
#define XB_XSUB(j)  (1280 + 64 * (j))
#define XB_XGEN(j)  (2304 + 64 * (j))
#define XB_TOP      3328
#define XB_TOPGEN   3392
#define XCD_BAR_WORDS 3456
#define XB_SPIN_CAP (1u << 18)
__device__ __forceinline__ unsigned xb_ld(unsigned* p)              { return __hip_atomic_load(p, __ATOMIC_RELAXED, __HIP_MEMORY_SCOPE_AGENT); }
__device__ __forceinline__ unsigned xb_add(unsigned* p, unsigned v) { return __hip_atomic_fetch_add(p, v, __ATOMIC_RELAXED, __HIP_MEMORY_SCOPE_AGENT); }
__device__ __forceinline__ unsigned xb_xcc_id() { return (unsigned)__builtin_amdgcn_s_getreg((3 << 11) | 20) & 0xFu; }
#define XB_SPIN(cond, bar) do { unsigned _sp = 0; while (cond) { __builtin_amdgcn_s_sleep(1); \
    if ((++_sp & 255u) == 0u) { if (xb_ld(&(bar)[XB_TMO])) break; if (_sp > XB_SPIN_CAP) { atomicAdd(&(bar)[XB_TMO], 1u); break; } } } } while (0)
struct XcdBarrier { unsigned* bar; unsigned x; volatile LAS unsigned* st; };
__device__ __forceinline__ XcdBarrier xcd_barrier_post(unsigned* bar, volatile LAS unsigned* st) {
    XcdBarrier b; b.bar = bar; b.x = xb_xcc_id(); b.st = st;
    if (threadIdx.x == 0) (void)xb_add(&bar[XB_XCNT(b.x)], 1u);
    return b;
}
__device__ __forceinline__ void xcd_barrier_complete(unsigned* bar, unsigned x, unsigned& nloc, unsigned& nx) {
    const unsigned G = gridDim.x * gridDim.y * gridDim.z;
    unsigned sum, cnt, mine, sp = 0u;
    for (;;) {
        sum = 0u; cnt = 0u; mine = 0u;
#pragma unroll
        for (unsigned j = 0; j < 16; ++j) { const unsigned c = xb_ld(&bar[XB_XCNT(j)]); sum += c; cnt += (c > 0u) ? 1u : 0u; mine = (j == x) ? c : mine; }
        if (sum == G) break;
        __builtin_amdgcn_s_sleep(1);
        if ((++sp & 255u) == 0u) { if (xb_ld(&bar[XB_TMO])) break; if (sp > XB_SPIN_CAP) { atomicAdd(&bar[XB_TMO], 1u); break; } }
    }
    nloc = mine > 0u ? mine : 1u; nx = cnt > 0u ? cnt : 1u;
}
__device__ __forceinline__ void xcd_barrier(const XcdBarrier& b) {
    asm volatile("s_waitcnt vmcnt(0)" ::: "memory");
    __syncthreads();
    if (threadIdx.x == 0) {
        unsigned* bar = b.bar;
        __builtin_amdgcn_s_waitcnt(0);
        unsigned nloc = b.st[0], nx = b.st[1];
        if (nloc == 0u) { xcd_barrier_complete(bar, b.x, nloc, nx); b.st[0] = nloc; b.st[1] = nx; }
        const unsigned old = xb_add(&bar[XB_XSUB(b.x)], 1u);
        const unsigned gen = old / nloc;
        if (old + 1u == (gen + 1u) * nloc) {
            __builtin_amdgcn_fence(__ATOMIC_RELEASE, "agent");
            asm volatile("s_waitcnt vmcnt(0)" ::: "memory");
            const unsigned og = xb_add(&bar[XB_TOP], 1u);
            const unsigned tg = og / nx;
            if (og + 1u == (tg + 1u) * nx) xb_add(&bar[XB_TOPGEN], 1u);
            else XB_SPIN(xb_ld(&bar[XB_TOPGEN]) == tg, bar);
            __builtin_amdgcn_fence(__ATOMIC_ACQUIRE, "agent");
            xb_add(&bar[XB_XGEN(b.x)], 1u);
            asm volatile("s_waitcnt vmcnt(0)" ::: "memory");
        } else {
            XB_SPIN(xb_ld(&bar[XB_XGEN(b.x)]) == gen, bar);
            __builtin_amdgcn_fence(__ATOMIC_ACQUIRE, "agent");
            asm volatile("s_waitcnt vmcnt(0)" ::: "memory");
        }
    }
    __syncthreads();
}


__global__ void __launch_bounds__(NTHR) k_mega(Params p) {
    extern __shared__ __attribute__((aligned(16))) unsigned char lds_raw[];
    LAS unsigned char* lds = (LAS unsigned char*)lds_raw;
    cg::grid_group grid = cg::this_grid();
    const int G = gridDim.x; const int bx = blockIdx.x;
    volatile LAS unsigned* misc = (volatile LAS unsigned*)(lds + MISC_OFF);
    if (threadIdx.x < 64) misc[threadIdx.x] = 0u;
    __syncthreads();
    const XcdBarrier xbar = xcd_barrier_post((unsigned*)(p.ws + WS_CTL + 65536), misc + 8);
    const int vcu = (G % 8 == 0) ? (bx % 8) * (G / 8) + bx / 8 : bx;
    bf16_t* win_t = (bf16_t*)(p.ws + WS_WIN); bf16_t* wout_t = (bf16_t*)(p.ws + WS_WOUT);
    bf16_t* xb = (bf16_t*)(p.ws + WS_XB); bf16_t* zb = (bf16_t*)(p.ws + WS_Z); bf16_t* mixb = (bf16_t*)(p.ws + WS_MIX);
    float* ssq = (float*)(p.ws + WS_SSQ);
    float* a_ = (float*)(p.ws + WS_XB); float* bx_ = (float*)(p.ws + WS_HID);
    bf16_t* xn2b = (bf16_t*)(p.ws + WS_XB);
    int* route_e = (int*)(p.ws + WS_ROUTE); float* route_w = (float*)(p.ws + WS_ROUTE + (size_t)T * 2 * 4);
    float* h = p.out;

    ph_prologue(p, lds, vcu, G);
    if (p.ws == nullptr) grid.sync();
    xcd_barrier(xbar);
    {
        pg8::DenseOrder So; So.init(xb, win_t, T, INW, D, G, bx);
        pg8::EpiZ E{zb, INW};
        pg8::gemm_phase(lds, D, So, E);
    }
    xcd_barrier(xbar);
    ph_mixers(p, zb, mixb, ssq, lds, (unsigned*)(p.ws + WS_CTL + 8192));
    xcd_barrier(xbar);
    {
        pg8::DenseOrder So; So.init(mixb, wout_t, T, D, D, G, bx);
        pg8::EpiH E{ssq, p.x, h, TAB_OFF};
        pg8::gemm_phase(lds, D, So, E);
    }
    xcd_barrier(xbar);
    int* gcount = (int*)(p.ws + WS_CTL + 4096); int* tok_list = (int*)(p.ws + WS_LIST); float* w_list = (float*)(p.ws + WS_LIST + MiB);
    bf16_t* wgu_t = (bf16_t*)(p.ws + WS_WGU); bf16_t* wd_t = (bf16_t*)(p.ws + WS_WD); bf16_t* hid = (bf16_t*)(p.ws + WS_HID); bf16_t* y2 = (bf16_t*)(p.ws + WS_Z);
    ph_router2(p, h, xn2b, gcount, tok_list, w_list, (LAS int*)lds);
    xcd_barrier(xbar);
    LAS int* meta = (LAS int*)(lds + META_OFF);
    if (threadIdx.x == 0) { int base = 0; for (int e = 0; e < NE; ++e) { const int cnt = gcount[e]; meta[e] = base; meta[32 + e] = cnt; base += (cnt + 255) >> 8; } meta[16] = base; }
    __syncthreads();
    const int ntiles = meta[16];
    {
        pg8::MoeOrder<0> So{xn2b, wgu_t, tok_list, meta, D, G, bx, ntiles};
        pg8::EpiHid E{hid};
        pg8::gemm_phase(lds, D, So, E);
    }
    xcd_barrier(xbar);
    {
        pg8::MoeOrder<1> So{hid, wd_t, tok_list, meta, DFF, G, bx, ntiles};
        pg8::EpiY E{y2, tok_list, w_list, meta};
        pg8::gemm_phase(lds, DFF, So, E);
    }
    xcd_barrier(xbar);
    ph_final(p, h, y2, p.out);
}

extern "C" void kernel_launch(void* const* d_in, const int* in_sizes, int n_in, void* d_out, int out_size, void* d_ws, size_t ws_size, hipStream_t stream) {
    static int grid_blocks = 0;
    if (!grid_blocks) {
        if (ws_size < WS_END) { fprintf(stderr, "kernel_launch: workspace too small (%zu < %zu)\n", ws_size, (size_t)WS_END); grid_blocks = -1; return; }
        int dev = 0, cus = 0, per_cu = 0;
        (void)hipGetDevice(&dev);
        (void)hipDeviceGetAttribute(&cus, hipDeviceAttributeMultiprocessorCount, dev);
        (void)hipFuncSetAttribute((const void*)k_mega, hipFuncAttributeMaxDynamicSharedMemorySize, LDS_BYTES);
        (void)hipOccupancyMaxActiveBlocksPerMultiprocessor(&per_cu, (const void*)k_mega, NTHR, LDS_BYTES);
        if (per_cu < 1) { fprintf(stderr, "kernel_launch: occupancy query says %d blocks per CU\n", per_cu); per_cu = 1; }
        grid_blocks = cus;
    }
    if (grid_blocks < 0) return;
    Params p{};
    const float** f = (const float**)&p;
    for (int i = 0; i < 23; ++i) f[i] = (const float*)d_in[i];
    p.out = (float*)d_out;
    p.ws = (unsigned char*)d_ws;
    (void)hipMemsetAsync((char*)d_ws + WS_CTL, 0, CTL_BYTES, stream);
    void* args[] = {&p};
    hipError_t e = hipLaunchCooperativeKernel((void*)k_mega, dim3(grid_blocks), dim3(NTHR), args, LDS_BYTES, stream);
    if (e != hipSuccess) fprintf(stderr, "cooperative launch failed: %s (grid %d)\n", hipGetErrorString(e), grid_blocks);
}
```

```cpp
#include <hip/hip_runtime.h>
#include <hip/hip_cooperative_groups.h>
#include <cstdio>
#include <cstdint>
namespace cg = cooperative_groups;

#ifndef PROBE
#define PROBE 0
#endif

#define LAS __attribute__((address_space(3)))
typedef unsigned short bf16_t;
typedef short bf16x8 __attribute__((ext_vector_type(8)));
typedef float f32x4 __attribute__((ext_vector_type(4)));
typedef float f32x2 __attribute__((ext_vector_type(2)));
typedef unsigned u32x4 __attribute__((ext_vector_type(4)));
typedef unsigned u32x2 __attribute__((ext_vector_type(2)));

constexpr int D = 1024, NB = 8, S = 2048, T = NB * S;
constexpr int RW = 512, RHD = 64;
constexpr int CHUNK = 64, LEFT = 8, BAND = 576, MAXREL = 128;
constexpr int INW = 2560;
constexpr int NE = 16, DFF = 512;
constexpr float EPS = 1e-6f;
constexpr int NTHR = 512, NWAVES = 8;
constexpr int SSQW = 24;

constexpr size_t MiB = 1u << 20;
constexpr size_t WS_CTL = 0, CTL_BYTES = 1 * MiB;
constexpr size_t WS_WIN = 1 * MiB;
constexpr size_t WS_WOUT = 6 * MiB;
constexpr size_t WS_WGU = 8 * MiB;
constexpr size_t WS_WD = 40 * MiB;
constexpr size_t WS_XB = 56 * MiB;
constexpr size_t WS_Z = 88 * MiB;
constexpr size_t WS_MIX = 168 * MiB;
constexpr size_t WS_HID = 200 * MiB;
constexpr size_t WS_SSQ = 236 * MiB;
constexpr size_t WS_LIST = 238 * MiB;
constexpr size_t WS_ROUTE = 240 * MiB;
constexpr size_t WS_END = 241 * MiB;

constexpr int RING_BYTES = 131072, TAB_OFF = RING_BYTES, META_OFF = RING_BYTES + 4096, MISC_OFF = RING_BYTES + 15360, LDS_BYTES = 147456;

struct Params {
    const float *x, *norm1_g, *w_in, *conv_w, *conv_b, *w_rg_a, *b_rg_a, *w_rg_x, *b_rg_x, *lru_lambda, *rel_bias,
        *g_rec_out, *g_att_out, *w_out, *norm2_g, *w_group, *b_group, *w_router, *b_router, *w_e_gate, *w_e_up, *w_e_down, *final_g;
    float* out;
    unsigned char* ws;
};

__device__ __forceinline__ float wave_sum(float v) {
#pragma unroll
    for (int o = 32; o > 0; o >>= 1) v += __shfl_xor(v, o);
    return v;
}
__device__ __forceinline__ float sigmoidf_(float x) { return 1.0f / (1.0f + expf(-x)); }
__device__ __forceinline__ float gelu_tanh(float x) { return 0.5f * x * (1.0f + tanhf(0.7978845608028654f * (x + 0.044715f * x * x * x))); }
__device__ __forceinline__ unsigned f2bf(float f) { unsigned u = __builtin_bit_cast(unsigned, f); return (u + 0x7fffu + ((u >> 16) & 1u)) >> 16; }
__device__ __forceinline__ unsigned pk2(float lo, float hi) { return f2bf(lo) | (f2bf(hi) << 16); }
__device__ __forceinline__ float bf2f(bf16_t b) { return __builtin_bit_cast(float, ((unsigned)b) << 16); }
__device__ __forceinline__ unsigned cvt_pk_bf16(float lo, float hi) { unsigned r; asm volatile("v_cvt_pk_bf16_f32 %0, %1, %2" : "=v"(r) : "v"(lo), "v"(hi)); return r; }
#define LDS_WAIT() asm volatile("s_waitcnt lgkmcnt(0)" ::: "memory")
__device__ __forceinline__ int opaque_tid() { int t = threadIdx.x; asm volatile("" : "+v"(t)); return t; }

namespace pg8 {
constexpr int BM = 256, BK = 64, HALF = 128, HTB = HALF * BK * 2, STAGE_BYTES = 8 * HTB, NXCD = 8, WGM = 8;
__device__ __forceinline__ int lds_byte(int r, int c) { const int st = (r >> 4) * 2 + (c >> 5), rr = r & 15, cc = c & 31, ob = rr * 64 + cc * 2; return st * 1024 + (ob ^ (((ob >> 9) & 1) << 5)); }
__device__ __forceinline__ void stage_rc(int b, int& R, int& C) { const int st = b / 1024, sb = b % 1024, swz = sb ^ (((sb >> 9) & 1) << 5); R = (st >> 1) * 16 + swz / 64; C = (st & 1) * 32 + (swz % 64) / 2; }
__device__ __forceinline__ int perm32(int rho) { const int n = rho >> 4, i = rho & 15; return 8 * (i >> 2) + 4 * n + (i & 3); }

struct Unit { int pm, pn, e, rows; };

struct DenseOrder {
    const bf16_t* A; const bf16_t* Bt; int K; int nM, nN, nwg, G, c;
    __device__ void init(const bf16_t* A_, const bf16_t* Bt_, int M, int N, int K_, int G_, int c_) { A = A_; Bt = Bt_; K = K_; nM = M / BM; nN = N / BM; nwg = nM * nN; G = G_; c = c_; }
    __device__ __forceinline__ bool next(int i, Unit& u) const {
        const long L = (long)i * G + c; if (L >= nwg) return false;
        int wgid = (int)L; { const int q = nwg / NXCD, r = nwg % NXCD, xcd = wgid % NXCD, off = wgid / NXCD; wgid = (xcd < r ? xcd * (q + 1) : r * (q + 1) + (xcd - r) * q) + off; }
        const int nig = WGM * nN, gid = wgid / nig, fm = gid * WGM, gsz = (nM - fm) < WGM ? (nM - fm) : WGM;
        u.pm = fm + ((wgid % nig) % gsz); u.pn = (wgid % nig) / gsz; u.e = 0; u.rows = BM; return true;
    }
    __device__ __forceinline__ void addr(const Unit& u, const int (&RA)[2], const int (&CA)[2], const char*& aBase, const char*& bBase, unsigned (&va)[2][2]) const {
        aBase = (const char*)A; bBase = (const char*)Bt + (size_t)u.pn * BM * K * 2;
#pragma unroll
        for (int h = 0; h < 2; ++h)
#pragma unroll
            for (int i = 0; i < 2; ++i) va[h][i] = (unsigned)(((size_t)(u.pm * BM + h * HALF + RA[i]) * K + CA[i]) * 2);
    }
};

template <class Epi, class Sched>
__device__ __forceinline__ void gemm_phase(LAS unsigned char* lds, const int K, const Sched& S, const Epi& E) {
    int tid_ = threadIdx.x; asm volatile("" : "+v"(tid_));
    const int tid = tid_, wid = __builtin_amdgcn_readfirstlane(tid >> 6), lane = tid & 63, wr = wid >> 2, wc = wid & 3, fr = lane & 15, fq = lane >> 4;
    const int nt = K / BK;
    int RA[2], CA[2]; unsigned voffB[2];
#pragma unroll
    for (int i = 0; i < 2; ++i) { int R, C; stage_rc(tid * 16 + i * 8192, R, C); RA[i] = R; CA[i] = C; const int Rb = Epi::PERM ? ((R & ~31) + perm32(R & 31)) : R; voffB[i] = (unsigned)(Rb * K + C) * 2u; }
    const size_t kstep = (size_t)(BK * 2);
    const size_t hstepB = (size_t)HALF * K * 2;
    const unsigned ldsw = (unsigned)wid * 1024u;
    const int aoff = lds_byte(wr * 64 + fr, fq * 8), boff = lds_byte(wc * 32 + fr, fq * 8);
#define PG8_SA(b, h) (((b) * 2 + (h)) * HTB)
#define PG8_SB(b, h) ((4 + (b) * 2 + (h)) * HTB)
#define PG8_STAGE_B(bufoff, gbase) do { _Pragma("unroll") for (int _i = 0; _i < 2; ++_i) \
        __builtin_amdgcn_global_load_lds((const unsigned*)((const char*)(gbase) + voffB[_i]), (LAS unsigned*)(lds + (bufoff) + ldsw + _i * 8192), 16, 0, 0); } while (0)
#define PG8_STAGE_A(bufoff, gbase, v0, v1) do { \
        __builtin_amdgcn_global_load_lds((const unsigned*)((const char*)(gbase) + (v0)), (LAS unsigned*)(lds + (bufoff) + ldsw), 16, 0, 0); \
        __builtin_amdgcn_global_load_lds((const unsigned*)((const char*)(gbase) + (v1)), (LAS unsigned*)(lds + (bufoff) + ldsw + 8192), 16, 0, 0); } while (0)
#define PG8_LDA(dst, b, h) do { _Pragma("unroll") for (int m = 0; m < 4; ++m) _Pragma("unroll") for (int k = 0; k < 2; ++k) dst[m][k] = *(const LAS bf16x8*)(lds + PG8_SA(b, h) + aoff + m * 2048 + k * 1024); } while (0)
#define PG8_LDB(dst, b, h) do { _Pragma("unroll") for (int n = 0; n < 2; ++n) _Pragma("unroll") for (int k = 0; k < 2; ++k) dst[n][k] = *(const LAS bf16x8*)(lds + PG8_SB(b, h) + boff + n * 2048 + k * 1024); } while (0)
#define PG8_MMA(ai, bj, At, Bt) do { __builtin_amdgcn_s_setprio(1); _Pragma("unroll") for (int m = 0; m < 4; ++m) _Pragma("unroll") for (int n = 0; n < 2; ++n) _Pragma("unroll") for (int k = 0; k < 2; ++k) \
        acc[ai][bj][m][n] = __builtin_amdgcn_mfma_f32_16x16x32_bf16(Bt[n][k], At[m][k], acc[ai][bj][m][n], 0, 0, 0); __builtin_amdgcn_s_setprio(0); } while (0)
#define PG8_WAIT_V(n) asm volatile("s_waitcnt vmcnt(" #n ")" ::: "memory")
#define PG8_WAIT_L(n) asm volatile("s_waitcnt lgkmcnt(" #n ")" ::: "memory")
#define PG8_BAR __builtin_amdgcn_s_barrier()
#define PG8_SCHED __builtin_amdgcn_sched_barrier(0)
    Unit cur, nxt; int ui = 0;
    if (!S.next(0, cur)) return;
    f32x4 acc[2][2][4][2];
#pragma unroll
    for (int a = 0; a < 2; ++a)
#pragma unroll
        for (int b = 0; b < 2; ++b)
#pragma unroll
            for (int m = 0; m < 4; ++m)
#pragma unroll
                for (int n = 0; n < 2; ++n) acc[a][b][m][n] = (f32x4){0.f, 0.f, 0.f, 0.f};
    bf16x8 At[4][2], B0[2][2], B1[2][2];
    const char *cA, *cB, *nA, *nB; unsigned cva[2][2], nva[2][2];
    S.addr(cur, RA, CA, cA, cB, cva);
    E.prepare(cur, ui, lds);
    PG8_STAGE_B(PG8_SB(0, 0), cB); PG8_STAGE_A(PG8_SA(0, 0), cA, cva[0][0], cva[0][1]); PG8_STAGE_B(PG8_SB(0, 1), cB + hstepB); PG8_STAGE_A(PG8_SA(0, 1), cA, cva[1][0], cva[1][1]);
    if (wr == 1) PG8_BAR;
    PG8_WAIT_V(4); PG8_BAR;
    PG8_STAGE_B(PG8_SB(1, 0), cB + kstep); PG8_STAGE_A(PG8_SA(1, 0), cA + kstep, cva[0][0], cva[0][1]); PG8_STAGE_B(PG8_SB(1, 1), cB + hstepB + kstep);
    PG8_WAIT_V(6); PG8_BAR;
    for (;;) {
        const bool has_next = S.next(ui + 1, nxt);
        if (has_next) { S.addr(nxt, RA, CA, nA, nB, nva); }
        else { nA = cA; nB = cB;
#pragma unroll
            for (int h = 0; h < 2; ++h)
#pragma unroll
                for (int i = 0; i < 2; ++i) nva[h][i] = cva[h][i]; }
        for (int t = 0; t < nt; t += 2) {
            const bool last = (t == nt - 2);
            if (Epi::MIDSCALE && t == nt / 2) E.midscale(acc, wr, fr, ui, lds);
            const char* a1 = cA + (size_t)(t + 1) * kstep;
            const char* a2 = last ? nA : cA + (size_t)(t + 2) * kstep; const char* b2 = last ? nB : cB + (size_t)(t + 2) * kstep;
            const char* a3 = a2 + kstep; const char* b3 = b2 + kstep;
            const unsigned x00 = last ? nva[0][0] : cva[0][0], x01 = last ? nva[0][1] : cva[0][1], x10 = last ? nva[1][0] : cva[1][0], x11 = last ? nva[1][1] : cva[1][1];
            if (last && has_next) E.prepare(nxt, ui + 1, lds);
            PG8_LDB(B0, 0, 0); PG8_SCHED; PG8_LDA(At, 0, 0); PG8_STAGE_A(PG8_SA(1, 1), a1, cva[1][0], cva[1][1]);
            PG8_WAIT_L(8); PG8_BAR; PG8_WAIT_L(0); PG8_MMA(0, 0, At, B0); PG8_BAR; PG8_SCHED;
            PG8_LDB(B1, 0, 1); PG8_STAGE_B(PG8_SB(0, 0), b2);
            PG8_BAR; PG8_WAIT_L(0); PG8_MMA(0, 1, At, B1); PG8_BAR;
            PG8_LDA(At, 0, 1); PG8_STAGE_A(PG8_SA(0, 0), a2, x00, x01);
            PG8_BAR; PG8_WAIT_L(0); PG8_MMA(1, 0, At, B0); PG8_BAR; PG8_SCHED;
            PG8_STAGE_B(PG8_SB(0, 1), b2 + hstepB);
            PG8_WAIT_V(6); PG8_BAR; PG8_MMA(1, 1, At, B1); PG8_BAR;
            PG8_LDB(B0, 1, 0); PG8_SCHED; PG8_LDA(At, 1, 0); PG8_STAGE_A(PG8_SA(0, 1), a2, x10, x11);
            PG8_WAIT_L(8); PG8_BAR; PG8_WAIT_L(0); PG8_MMA(0, 0, At, B0); PG8_BAR; PG8_SCHED;
            PG8_LDB(B1, 1, 1); PG8_STAGE_B(PG8_SB(1, 0), b3);
            PG8_BAR; PG8_WAIT_L(0); PG8_MMA(0, 1, At, B1); PG8_BAR;
            PG8_LDA(At, 1, 1); PG8_STAGE_A(PG8_SA(1, 0), a3, x00, x01);
            PG8_BAR; PG8_WAIT_L(0); PG8_MMA(1, 0, At, B0); PG8_BAR; PG8_SCHED;
            PG8_STAGE_B(PG8_SB(1, 1), b3 + hstepB);
            PG8_WAIT_V(6); PG8_BAR; PG8_MMA(1, 1, At, B1); PG8_BAR;
        }
        E(acc, cur, wr, wc, fr, fq, ui, lds);
        if (!has_next) break;
#pragma unroll
        for (int a = 0; a < 2; ++a)
#pragma unroll
            for (int b = 0; b < 2; ++b)
#pragma unroll
                for (int m = 0; m < 4; ++m)
#pragma unroll
                    for (int n = 0; n < 2; ++n) acc[a][b][m][n] = (f32x4){0.f, 0.f, 0.f, 0.f};
        cur = nxt; cA = nA; cB = nB; ++ui;
#pragma unroll
        for (int h = 0; h < 2; ++h)
#pragma unroll
            for (int i = 0; i < 2; ++i) cva[h][i] = nva[h][i];
    }
    PG8_WAIT_V(0);
    if (wr == 0) PG8_BAR;
    PG8_BAR;
#undef PG8_SA
#undef PG8_SB
#undef PG8_STAGE_A
#undef PG8_STAGE_B
#undef PG8_LDA
#undef PG8_LDB
#undef PG8_MMA
#undef PG8_WAIT_V
#undef PG8_WAIT_L
#undef PG8_BAR
#undef PG8_SCHED
}

struct EpiZ {
    static constexpr bool PERM = true, MIDSCALE = false;
    bf16_t* O; int ldc;
    __device__ __forceinline__ void prepare(const Unit&, int, LAS unsigned char*) const {}
    __device__ __forceinline__ void midscale(f32x4 (&)[2][2][4][2], int, int, int, LAS unsigned char*) const {}
    __device__ __forceinline__ void operator()(const f32x4 (&acc)[2][2][4][2], const Unit& u, int wr, int wc, int fr, int fq, int, LAS unsigned char*) const {
        const int row0 = u.pm * BM + wr * 64 + fr, col0 = u.pn * BM + wc * 32 + 8 * fq;
#pragma unroll
        for (int ai = 0; ai < 2; ++ai)
#pragma unroll
            for (int m = 0; m < 4; ++m) { bf16_t* rowp = O + (size_t)(row0 + ai * HALF + m * 16) * ldc + col0;
#pragma unroll
                for (int bj = 0; bj < 2; ++bj) { const f32x4 v0 = acc[ai][bj][m][0], v1 = acc[ai][bj][m][1];
                    u32x4 w; w.x = cvt_pk_bf16(v0[0], v0[1]); w.y = cvt_pk_bf16(v0[2], v0[3]); w.z = cvt_pk_bf16(v1[0], v1[1]); w.w = cvt_pk_bf16(v1[2], v1[3]);
                    *(u32x4*)(rowp + bj * HALF) = w; } }
    }
};
struct EpiH {
    static constexpr bool PERM = false, MIDSCALE = true;
    const float* ssq; const float* x; float* h; bf16_t* hb; int tab_off;
    __device__ __forceinline__ void prepare(const Unit& u, int ui, LAS unsigned char* lds) const {
        LAS f32x2* tab = (LAS f32x2*)(lds + tab_off) + (ui & 1) * 256;
        if (threadIdx.x < 256) {
            const float* sp = ssq + (size_t)(u.pm * BM + threadIdx.x) * SSQW; float sa = 0.f, sb = 0.f;
#pragma unroll
            for (int i = 0; i < 4; ++i) { const f32x4 v = *(const f32x4*)(sp + 4 * i); sa += (v[0] + v[1]) + (v[2] + v[3]); }
#pragma unroll
            for (int i = 4; i < 6; ++i) { const f32x4 v = *(const f32x4*)(sp + 4 * i); sb += (v[0] + v[1]) + (v[2] + v[3]); }
            const float ra = rsqrtf(sa * (1.0f / 512.0f) + EPS), rb = rsqrtf(sb * (1.0f / 512.0f) + EPS);
            tab[threadIdx.x] = (f32x2){ra / rb, rb};
        }
    }
    __device__ __forceinline__ void midscale(f32x4 (&acc)[2][2][4][2], int wr, int fr, int ui, LAS unsigned char* lds) const {
        const LAS f32x2* tab = (const LAS f32x2*)(lds + tab_off) + (ui & 1) * 256;
#pragma unroll
        for (int ai = 0; ai < 2; ++ai)
#pragma unroll
            for (int m = 0; m < 4; ++m) { const float s = tab[ai * HALF + wr * 64 + m * 16 + fr].x;
#pragma unroll
                for (int bj = 0; bj < 2; ++bj)
#pragma unroll
                    for (int n = 0; n < 2; ++n) acc[ai][bj][m][n] = acc[ai][bj][m][n] * s; }
    }
    __device__ __forceinline__ void operator()(const f32x4 (&acc)[2][2][4][2], const Unit& u, int wr, int wc, int fr, int fq, int ui, LAS unsigned char* lds) const {
        const LAS f32x2* tab = (const LAS f32x2*)(lds + tab_off) + (ui & 1) * 256;
        const int row0 = u.pm * BM + wr * 64 + fr, col0 = u.pn * BM + wc * 32 + 4 * fq;
#pragma unroll
        for (int ai = 0; ai < 2; ++ai)
#pragma unroll
            for (int m = 0; m < 4; ++m) { const float s = tab[ai * HALF + wr * 64 + m * 16 + fr].y; const size_t ro = (size_t)(row0 + ai * HALF + m * 16) * D + col0;
#pragma unroll
                for (int bj = 0; bj < 2; ++bj)
#pragma unroll
                    for (int n = 0; n < 2; ++n) { const f32x4 xv = *(const f32x4*)(x + ro + bj * HALF + n * 16); const f32x4 hv = xv + acc[ai][bj][m][n] * s;
                        *(f32x4*)(h + ro + bj * HALF + n * 16) = hv; *(u32x2*)(hb + ro + bj * HALF + n * 16) = (u32x2){cvt_pk_bf16(hv[0], hv[1]), cvt_pk_bf16(hv[2], hv[3])}; } }
    }
};

template <int MODE>
struct MoeOrder {
    const bf16_t* A; const bf16_t* Bt; const int* tok_list; const LAS int* meta; int K, G, c, ntiles;
    __device__ __forceinline__ bool next(int i, Unit& u) const {
        const int L = i * G + c; if (L >= ntiles * 4) return false;
        const int mt = L >> 2; int e = 0;
#pragma unroll
        for (int j = 1; j < NE; ++j) e += (mt >= meta[j]) ? 1 : 0;
        u.pm = mt; u.pn = L & 3; u.e = e; u.rows = meta[32 + e] - (mt - meta[e]) * BM; return true;
    }
    __device__ __forceinline__ void addr(const Unit& u, const int (&RA)[2], const int (&CA)[2], const char*& aBase, const char*& bBase, unsigned (&va)[2][2]) const {
        aBase = (const char*)A; bBase = (const char*)Bt + ((size_t)u.e * D + (size_t)u.pn * BM) * K * 2;
        const int slot0 = (u.pm - meta[u.e]) * BM;
#pragma unroll
        for (int h = 0; h < 2; ++h)
#pragma unroll
            for (int i = 0; i < 2; ++i) {
                const int r = h * HALF + RA[i];
                if (MODE == 0) { int tok = 0; if (r < u.rows) tok = tok_list[u.e * T + slot0 + r] >> 1; va[h][i] = (unsigned)(((size_t)tok * K + CA[i]) * 2); }
                else va[h][i] = (unsigned)(((size_t)(u.pm * BM + r) * K + CA[i]) * 2);
            }
    }
};
struct EpiHid {
    static constexpr bool PERM = true, MIDSCALE = false;
    bf16_t* hid; const float* r_list; const LAS int* meta;
    __device__ __forceinline__ void prepare(const Unit&, int, LAS unsigned char*) const {}
    __device__ __forceinline__ void midscale(f32x4 (&)[2][2][4][2], int, int, int, LAS unsigned char*) const {}
    __device__ __forceinline__ void operator()(const f32x4 (&acc)[2][2][4][2], const Unit& u, int wr, int wc, int fr, int fq, int, LAS unsigned char*) const {
        const int row0 = u.pm * BM + wr * 64 + fr, j0 = u.pn * 128 + wc * 16 + 4 * fq, slot0 = (u.pm - meta[u.e]) * BM;
#pragma unroll
        for (int ai = 0; ai < 2; ++ai)
#pragma unroll
            for (int m = 0; m < 4; ++m) { bf16_t* rowp = hid + (size_t)(row0 + ai * HALF + m * 16) * DFF + j0;
                const int r = ai * HALF + wr * 64 + m * 16 + fr; const float rs = (r < u.rows) ? r_list[u.e * T + slot0 + r] : 0.f;
#pragma unroll
                for (int bj = 0; bj < 2; ++bj) { const f32x4 g = acc[ai][bj][m][0] * rs, up = acc[ai][bj][m][1] * rs; float hv[4];
#pragma unroll
                    for (int q = 0; q < 4; ++q) hv[q] = g[q] * up[q] * __builtin_amdgcn_rcpf(1.0f + __expf(-g[q]));
                    *(u32x2*)(rowp + bj * 64) = (u32x2){cvt_pk_bf16(hv[0], hv[1]), cvt_pk_bf16(hv[2], hv[3])}; } }
    }
};
struct EpiY {
    static constexpr bool PERM = true, MIDSCALE = false;
    bf16_t* y2; const int* tok_list; const float* w_list; const LAS int* meta;
    __device__ __forceinline__ void prepare(const Unit&, int, LAS unsigned char*) const {}
    __device__ __forceinline__ void midscale(f32x4 (&)[2][2][4][2], int, int, int, LAS unsigned char*) const {}
    __device__ __forceinline__ void operator()(const f32x4 (&acc)[2][2][4][2], const Unit& u, int wr, int wc, int fr, int fq, int, LAS unsigned char*) const {
        const int slot0 = (u.pm - meta[u.e]) * BM, col0 = u.pn * BM + wc * 32 + 8 * fq;
#pragma unroll
        for (int ai = 0; ai < 2; ++ai)
#pragma unroll
            for (int m = 0; m < 4; ++m) { const int r = ai * HALF + wr * 64 + m * 16 + fr;
                if (r < u.rows) { const int dst = tok_list[u.e * T + slot0 + r]; const float w = w_list[u.e * T + slot0 + r]; bf16_t* rowp = y2 + (size_t)dst * D + col0;
#pragma unroll
                    for (int bj = 0; bj < 2; ++bj) { const f32x4 v0 = acc[ai][bj][m][0] * w, v1 = acc[ai][bj][m][1] * w;
                        u32x4 o; o.x = cvt_pk_bf16(v0[0], v0[1]); o.y = cvt_pk_bf16(v0[2], v0[3]); o.z = cvt_pk_bf16(v1[0], v1[1]); o.w = cvt_pk_bf16(v1[2], v1[3]);
                        *(u32x4*)(rowp + bj * HALF) = o; } } }
    }
};
}

struct RowId { int off; __device__ __forceinline__ int operator()(int n) const { return off + n; } };
struct RowGU { int up; __device__ __forceinline__ int operator()(int j) const { return (j >> 2) * 8 + (j & 3) + 4 * up; } };

template <bool HASG, class RowMap>
__device__ __forceinline__ void p0_transpose_item(const float* W, int K, int N, const float* gk, int gsplit, const float* gk2, bf16_t* WT, RowMap rm, LAS float* scr, int item, int lane) {
    const int nblk = N / 32, kb = item / nblk, nb = item % nblk, k0 = 64 * kb, n0 = 32 * nb;
    const float* gp = HASG ? ((k0 < gsplit) ? gk + k0 : gk2 + (k0 - gsplit)) : nullptr;
#pragma unroll 8
    for (int i = 0; i < 32; ++i) { const int kk = 2 * i + (lane >> 5);
        float v = W[(size_t)(k0 + kk) * N + n0 + (lane & 31)]; if (HASG) v *= gp[kk];
        scr[kk * 33 + (lane & 31)] = v; }
    LDS_WAIT(); asm volatile("" ::: "memory");
    const int c = lane & 7;
#pragma unroll
    for (int j = 0; j < 4; ++j) { const int n = (lane >> 3) + 8 * j; const LAS float* s = scr + (8 * c) * 33 + n;
        u32x4 o; o.x = pk2(s[0 * 33], s[1 * 33]); o.y = pk2(s[2 * 33], s[3 * 33]); o.z = pk2(s[4 * 33], s[5 * 33]); o.w = pk2(s[6 * 33], s[7 * 33]);
        *(u32x4*)(WT + (size_t)rm(n0 + n) * K + k0 + 8 * c) = o; }
    LDS_WAIT(); asm volatile("" ::: "memory");
}

__device__ __forceinline__ void ph_prologue(const Params& p, LAS unsigned char* lds, int vcu, int G) {
    const int tid = opaque_tid(), lane = tid & 63, wave = tid >> 6;
    LAS float* scr = (LAS float*)(lds + wave * 16384);
    const int gw = vcu * NWAVES + wave, NGW = G * NWAVES;
    bf16_t* win_t = (bf16_t*)(p.ws + WS_WIN); bf16_t* wout_t = (bf16_t*)(p.ws + WS_WOUT); bf16_t* xb = (bf16_t*)(p.ws + WS_XB);
    bf16_t* wgu_t = (bf16_t*)(p.ws + WS_WGU); bf16_t* wd_t = (bf16_t*)(p.ws + WS_WD);
    constexpr int I_IN = (D / 64) * (INW / 32), I_OUT = (D / 64) * (D / 32), I_G = (D / 64) * (DFF / 32), I_D = (DFF / 64) * (D / 32), I_E = 2 * I_G + I_D;
    for (int it = gw; it < I_IN + I_OUT + NE * I_E; it += NGW) {
        if (it < I_IN) p0_transpose_item<true>(p.w_in, D, INW, p.norm1_g, D, p.norm1_g, win_t, RowId{0}, scr, it, lane);
        else if (it < I_IN + I_OUT) p0_transpose_item<true>(p.w_out, D, D, p.g_rec_out, 512, p.g_att_out, wout_t, RowId{0}, scr, it - I_IN, lane);
        else {
            const int r = it - I_IN - I_OUT, e = r / I_E, q = r % I_E;
            if (q < I_G) p0_transpose_item<true>(p.w_e_gate + (size_t)e * D * DFF, D, DFF, p.norm2_g, D, p.norm2_g, wgu_t + (size_t)e * D * D, RowGU{0}, scr, q, lane);
            else if (q < 2 * I_G) p0_transpose_item<true>(p.w_e_up + (size_t)e * D * DFF, D, DFF, p.norm2_g, D, p.norm2_g, wgu_t + (size_t)e * D * D, RowGU{1}, scr, q - I_G, lane);
            else p0_transpose_item<false>(p.w_e_down + (size_t)e * DFF * D, DFF, D, nullptr, 0, nullptr, wd_t + (size_t)e * D * DFF, RowId{0}, scr, q - 2 * I_G, lane);
        }
    }
    for (int t = gw; t < T; t += NGW) {
        const f32x4* xr = (const f32x4*)(p.x + (size_t)t * D) + lane;
        f32x4 v[4]; float ss = 0.f;
#pragma unroll
        for (int j = 0; j < 4; ++j) { v[j] = xr[64 * j]; ss += (v[j][0] * v[j][0] + v[j][1] * v[j][1]) + (v[j][2] * v[j][2] + v[j][3] * v[j][3]); }
        const float r = rsqrtf(wave_sum(ss) * (1.0f / D) + EPS);
        u32x2* o8 = (u32x2*)(xb + (size_t)t * D) + lane;
#pragma unroll
        for (int j = 0; j < 4; ++j) o8[64 * j] = (u32x2){pk2(v[j][0] * r, v[j][1] * r), pk2(v[j][2] * r, v[j][3] * r)};
    }
}

__device__ void ph_rglru_gates(const Params& p, const bf16_t* z, float* a_out, float* bx_out, float* uc_s) {
    const int c = threadIdx.x;
    const int h = c >> 6, j = c & 63;
    const float sp = log1pf(expf(-p.lru_lambda[c]));
    for (int t = blockIdx.x; t < T; t += gridDim.x) {
        const int s = t % S;
        float uc = p.conv_b[c];
#pragma unroll
        for (int jj = 0; jj < 4; ++jj) { const int sp_ = s - 3 + jj; if (sp_ >= 0) uc += bf2f(z[(size_t)(t - 3 + jj) * INW + c]) * p.conv_w[jj * RW + c]; }
        __syncthreads();
        uc_s[c] = uc;
        __syncthreads();
        float ra = p.b_rg_a[c], ri = p.b_rg_x[c];
        const float* wa = p.w_rg_a + (size_t)h * RHD * RHD + j;
        const float* wx = p.w_rg_x + (size_t)h * RHD * RHD + j;
#pragma unroll 4
        for (int i = 0; i < RHD; ++i) { const float u = uc_s[h * 64 + i]; ra += u * wa[i * RHD]; ri += u * wx[i * RHD]; }
        const float r = sigmoidf_(ra), ig = sigmoidf_(ri);
        const float log_a = -8.0f * r * sp;
        a_out[(size_t)t * RW + c] = expf(log_a);
        bx_out[(size_t)t * RW + c] = sqrtf(-expm1f(2.0f * log_a)) * (ig * uc);
    }
}
__device__ void ph_scan(const float* a_in, const float* bx_in, const bf16_t* z, bf16_t* mix) {
    const int gid = blockIdx.x * blockDim.x + threadIdx.x;
    if (gid >= NB * RW) return;
    const int b = gid / RW, c = gid % RW;
    float h = 0.f;
#pragma unroll 4
    for (int s = 0; s < S; ++s) {
        const size_t t = (size_t)b * S + s;
        h = a_in[t * RW + c] * h + bx_in[t * RW + c];
        mix[t * D + c] = (bf16_t)f2bf(h * gelu_tanh(bf2f(z[t * INW + 512 + c])));
    }
}
__device__ void ph_attn_naive(const Params& p, const bf16_t* z, bf16_t* mix) {
    const int tid = threadIdx.x, hd = tid >> 6, qi = tid & 63;
    for (int item = blockIdx.x; item < NB * (S / CHUNK); item += gridDim.x) {
        const int b = item / (S / CHUNK), c = item % (S / CHUNK);
        const size_t tq = (size_t)b * S + c * CHUNK + qi;
        float q[64], o[64];
#pragma unroll
        for (int d = 0; d < 64; ++d) { q[d] = bf2f(z[tq * INW + 1024 + hd * 64 + d]) * 0.125f; o[d] = 0.f; }
        float m = -3.0e38f, l = 0.f;
        const int k_begin = (c >= LEFT) ? 0 : (LEFT - c) * CHUNK;
        for (int kk = k_begin; kk < BAND; ++kk) {
            const size_t tk = (size_t)b * S + (c - LEFT) * CHUNK + kk;
            const bf16_t* kp = z + tk * INW + 1536 + hd * 64;
            const bf16_t* vp = z + tk * INW + 2048 + hd * 64;
            float sc = 0.f;
#pragma unroll
            for (int d = 0; d < 64; ++d) sc += q[d] * bf2f(kp[d]);
            int rel = LEFT * CHUNK + qi - kk;
            rel = rel < -MAXREL ? -MAXREL : (rel > MAXREL ? MAXREL : rel);
            sc += p.rel_bias[hd * (2 * MAXREL + 1) + rel + MAXREL];
            const float mn = fmaxf(m, sc), alpha = expf(m - mn), pe = expf(sc - mn);
            l = l * alpha + pe;
#pragma unroll
            for (int d = 0; d < 64; ++d) o[d] = o[d] * alpha + pe * bf2f(vp[d]);
            m = mn;
        }
        const float inv = 1.0f / l;
#pragma unroll
        for (int d = 0; d < 64; ++d) mix[tq * D + 512 + hd * 64 + d] = (bf16_t)f2bf(o[d] * inv);
    }
}
__device__ void ph_ssq(const bf16_t* mix, float* ssq) {
    const int lane = threadIdx.x & 63, wv = threadIdx.x >> 6, nw = blockDim.x >> 6;
    for (int t = blockIdx.x * nw + wv; t < T; t += gridDim.x * nw) {
        float sa = 0.f, sb = 0.f;
        for (int i = lane; i < 512; i += 64) { const float a = bf2f(mix[(size_t)t * D + i]), b = bf2f(mix[(size_t)t * D + 512 + i]); sa += a * a; sb += b * b; }
        sa = wave_sum(sa); sb = wave_sum(sb);
        if (lane < 16) ssq[(size_t)t * SSQW + lane] = (lane == 0) ? sa : 0.f;
    }
}
__device__ void ph_router(const Params& p, const float* h, bf16_t* xn2b, int* route_e, float* route_w) {
    const int lane = threadIdx.x & 63, wv = threadIdx.x >> 6, nw = blockDim.x >> 6;
    for (int t = blockIdx.x * nw + wv; t < T; t += gridDim.x * nw) {
        const float* row = h + (size_t)t * D;
        float v[16]; float ss = 0.f;
#pragma unroll
        for (int i = 0; i < 16; ++i) { v[i] = row[lane + 64 * i]; ss += v[i] * v[i]; }
        ss = wave_sum(ss);
        const float r = rsqrtf(ss / (float)D + EPS);
#pragma unroll
        for (int i = 0; i < 16; ++i) { xn2b[(size_t)t * D + lane + 64 * i] = (bf16_t)f2bf(v[i] * r); v[i] = v[i] * r * p.norm2_g[lane + 64 * i]; }
        float lg[4], le[16];
#pragma unroll
        for (int g = 0; g < 4; ++g) lg[g] = 0.f;
#pragma unroll
        for (int e = 0; e < 16; ++e) le[e] = 0.f;
#pragma unroll
        for (int i = 0; i < 16; ++i) {
            const int k = lane + 64 * i;
            const float4 wg = *(const float4*)(p.w_group + (size_t)k * 4);
            lg[0] += v[i] * wg.x; lg[1] += v[i] * wg.y; lg[2] += v[i] * wg.z; lg[3] += v[i] * wg.w;
#pragma unroll
            for (int e4 = 0; e4 < 4; ++e4) {
                const float4 wr = *(const float4*)(p.w_router + (size_t)k * 16 + e4 * 4);
                le[e4 * 4 + 0] += v[i] * wr.x; le[e4 * 4 + 1] += v[i] * wr.y; le[e4 * 4 + 2] += v[i] * wr.z; le[e4 * 4 + 3] += v[i] * wr.w;
            }
        }
#pragma unroll
        for (int g = 0; g < 4; ++g) lg[g] = wave_sum(lg[g]) + p.b_group[g];
#pragma unroll
        for (int e = 0; e < 16; ++e) le[e] = wave_sum(le[e]) + p.b_router[e];
        float mine = 0.f;
#pragma unroll
        for (int e = 0; e < 16; ++e) mine = (lane == e) ? le[e] : mine;
        int g = 0; float best = lg[0];
#pragma unroll
        for (int i = 1; i < 4; ++i) if (lg[i] > best) { best = lg[i]; g = i; }
        float sel[4];
#pragma unroll
        for (int i = 0; i < 4; ++i) sel[i] = __shfl(mine, g * 4 + i);
        if (lane == 0) {
            float den = 0.f;
#pragma unroll
            for (int i = 0; i < 4; ++i) den += expf(lg[i] - best);
            const float pg = 1.0f / den;
            int i1 = 0; float v1 = sel[0];
#pragma unroll
            for (int i = 1; i < 4; ++i) if (sel[i] > v1) { v1 = sel[i]; i1 = i; }
            int i2 = -1; float v2 = -3.0e38f;
#pragma unroll
            for (int i = 0; i < 4; ++i) if (i != i1 && sel[i] > v2) { v2 = sel[i]; i2 = i; }
            const float e2 = expf(v2 - v1);
            const float w1 = pg / (1.0f + e2), w2 = pg * e2 / (1.0f + e2);
            route_e[t * 2 + 0] = g * 4 + i1; route_e[t * 2 + 1] = g * 4 + i2;
            route_w[t * 2 + 0] = w1; route_w[t * 2 + 1] = w2;
        }
    }
}
__device__ void ph_moe_naive(const Params& p, const float* h, const bf16_t* xn2b, const int* route_e, const float* route_w, float* out, float* lds) {
    float* xs = lds;
    float* hs = lds + 1024;
    float* red = lds + 1536;
    const int tid = threadIdx.x;
    for (int t = blockIdx.x; t < T; t += gridDim.x) {
        __syncthreads();
        xs[tid] = bf2f(xn2b[(size_t)t * D + tid]) * p.norm2_g[tid]; xs[tid + 512] = bf2f(xn2b[(size_t)t * D + tid + 512]) * p.norm2_g[tid + 512];
        __syncthreads();
        float o0 = h[(size_t)t * D + tid], o1 = h[(size_t)t * D + tid + 512];
        for (int k = 0; k < 2; ++k) {
            const int e = route_e[t * 2 + k]; const float w = route_w[t * 2 + k];
            const float* wg = p.w_e_gate + (size_t)e * D * DFF + tid;
            const float* wu = p.w_e_up + (size_t)e * D * DFF + tid;
            float ag = 0.f, au = 0.f;
#pragma unroll 8
            for (int i = 0; i < D; ++i) { const float xv = xs[i]; ag += xv * wg[(size_t)i * DFF]; au += xv * wu[(size_t)i * DFF]; }
            __syncthreads();
            hs[tid] = ag * sigmoidf_(ag) * au;
            __syncthreads();
            const float* wd = p.w_e_down + (size_t)e * DFF * D;
            float y0 = 0.f, y1 = 0.f;
#pragma unroll 8
            for (int jx = 0; jx < DFF; ++jx) { const float hv = hs[jx]; y0 += hv * wd[(size_t)jx * D + tid]; y1 += hv * wd[(size_t)jx * D + tid + 512]; }
            o0 += w * y0; o1 += w * y1;
        }
        float ss = wave_sum(o0 * o0 + o1 * o1);
        if ((tid & 63) == 0) red[tid >> 6] = ss;
        __syncthreads();
        float tot = 0.f;
#pragma unroll
        for (int i = 0; i < 8; ++i) tot += red[i];
        const float r = rsqrtf(tot / (float)D + EPS);
        out[(size_t)t * D + tid] = o0 * r * p.final_g[tid];
        out[(size_t)t * D + tid + 512] = o1 * r * p.final_g[tid + 512];
    }
}


typedef float f32x16 __attribute__((ext_vector_type(16)));
typedef short v4i16_t __attribute__((ext_vector_type(4)));
typedef __bf16 bf16x2_t __attribute__((ext_vector_type(2)));
#define MFMA32(a, b, c) __builtin_amdgcn_mfma_f32_32x32x16_bf16((a), (b), (c), 0, 0, 0)
__device__ __forceinline__ unsigned cvtpk_s(float lo, float hi) { f32x2 v = {lo, hi}; bf16x2_t b = __builtin_convertvector(v, bf16x2_t); return __builtin_bit_cast(unsigned, b); }
__device__ __forceinline__ int crow(int r, int hh) { return (r & 3) + 8 * (r >> 2) + 4 * hh; }
__device__ __forceinline__ bf16x8 pack8(const f32x16& x, int s) {
    u32x4 w; w.x = cvtpk_s(x[8 * s + 0], x[8 * s + 1]); w.y = cvtpk_s(x[8 * s + 2], x[8 * s + 3]); w.z = cvtpk_s(x[8 * s + 4], x[8 * s + 5]); w.w = cvtpk_s(x[8 * s + 6], x[8 * s + 7]);
    return __builtin_bit_cast(bf16x8, w);
}
__device__ __forceinline__ v4i16_t vtr(LAS const unsigned char* p) { return __builtin_amdgcn_ds_read_tr16_b64_v4i16((LAS v4i16_t*)p); }
constexpr float LOG2E = 1.4426950408889634f;

struct AttnCtx { LAS float* btab; LAS unsigned char* vbase; int lane, h, q32, hh, vb, vw; float bconst; unsigned kl, vl; };
__device__ __forceinline__ AttnCtx attn_setup(const Params& p, LAS unsigned char* lds, int tab_off) {
    int tid_ = threadIdx.x; asm volatile("" : "+v"(tid_));
    AttnCtx A; const int tid = tid_; A.lane = tid & 63; A.h = __builtin_amdgcn_readfirstlane(tid >> 6); A.q32 = A.lane & 31; A.hh = A.lane >> 5;
    A.btab = (LAS float*)(lds + tab_off) + A.h * 260;
    for (int i = A.lane; i < 2 * MAXREL + 1; i += 64) A.btab[i] = p.rel_bias[A.h * (2 * MAXREL + 1) + i] * LOG2E;
    LDS_WAIT(); asm volatile("" ::: "memory");
    A.vbase = lds + A.h * 16384;
    A.vb = ((A.lane >> 4) & 1) * 32 + (A.lane & 3) * 8 + (4 * A.hh + ((A.lane & 15) >> 2)) * 128;
    A.vw = (A.lane >> 3) * 128 + (A.lane & 7) * 16;
    A.bconst = A.btab[2 * MAXREL];
    A.kl = (unsigned)((A.q32 * INW + 8 * A.hh) * 2);
    A.vl = (unsigned)(((A.lane >> 3) * INW + (A.lane & 7) * 8) * 2) + 1024u;
    return A;
}
__device__ __forceinline__ void attn_item(const AttnCtx& A, const bf16_t* z, bf16_t* mixb, float* ssq, int b, int c, int qh) {
    const int lane = A.lane, h = A.h, q32 = A.q32, hh = A.hh, vb = A.vb, vw = A.vw; LAS float* btab = A.btab; LAS unsigned char* vbase = A.vbase;
    const float bconst = A.bconst, QS = 0.125f * LOG2E; const unsigned kl = A.kl, vl = A.vl;
    {
        const int j0 = (c >= LEFT) ? 0 : LEFT - c;
        const char* kband = (const char*)z + (((long)b * S + (long)(c - LEFT) * CHUNK) * INW + 1536 + h * 64) * 2;
        {
            const int qi = qh * 32 + q32;
            const size_t tq = (size_t)b * S + c * CHUNK + qi;
            bf16x8 qf[4];
#pragma unroll
            for (int s = 0; s < 4; ++s) { const u32x4 raw = *(const u32x4*)(z + tq * INW + 1024 + h * 64 + 16 * s + 8 * hh); u32x4 w;
#pragma unroll
                for (int e = 0; e < 4; ++e) w[e] = cvtpk_s(__builtin_bit_cast(float, raw[e] << 16) * QS, __builtin_bit_cast(float, raw[e] & 0xffff0000u) * QS);
                qf[s] = __builtin_bit_cast(bf16x8, w); }
            f32x16 o0, o1;
#pragma unroll
            for (int r = 0; r < 16; ++r) { o0[r] = 0.f; o1[r] = 0.f; }
            float m_run = -1.0e30f, l_run = 0.f;
            bf16x8 kf[8]; u32x4 vr[8];
            {
                const char* tb = kband + (long)(64 * j0) * INW * 2;
#pragma unroll
                for (int kb = 0; kb < 2; ++kb)
#pragma unroll
                    for (int s = 0; s < 4; ++s) kf[kb * 4 + s] = *(const bf16x8*)(tb + (kl + (unsigned)(kb * 32 * INW * 2 + s * 32)));
#pragma unroll
                for (int i = 0; i < 8; ++i) vr[i] = *(const u32x4*)(tb + (vl + (unsigned)(i * 8 * INW * 2)));
#pragma unroll
                for (int i = 0; i < 8; ++i) *(LAS u32x4*)(vbase + (j0 & 1) * 8192 + i * 1024 + vw) = vr[i];
            }
#pragma unroll 1
            for (int j = j0; j <= LEFT; ++j) {
                f32x16 p0, p1;
                if (j <= 5) {
#pragma unroll
                    for (int r = 0; r < 16; ++r) { p0[r] = bconst; p1[r] = bconst; }
                } else {
                    const int base = LEFT * CHUNK + qi - 64 * j + MAXREL;
#pragma unroll
                    for (int r = 0; r < 16; ++r) { const int i0 = base - crow(r, hh), i1 = i0 - 32;
                        p0[r] = btab[i0 > 2 * MAXREL ? 2 * MAXREL : i0]; p1[r] = btab[i1 > 2 * MAXREL ? 2 * MAXREL : i1]; }
                }
#pragma unroll
                for (int s = 0; s < 4; ++s) { p0 = MFMA32(kf[s], qf[s], p0); p1 = MFMA32(kf[4 + s], qf[s], p1); }
                if (j < LEFT) {
                    const char* tb = kband + (long)(64 * (j + 1)) * INW * 2;
#pragma unroll
                    for (int kb = 0; kb < 2; ++kb)
#pragma unroll
                        for (int s = 0; s < 4; ++s) kf[kb * 4 + s] = *(const bf16x8*)(tb + (kl + (unsigned)(kb * 32 * INW * 2 + s * 32)));
#pragma unroll
                    for (int i = 0; i < 8; ++i) vr[i] = *(const u32x4*)(tb + (vl + (unsigned)(i * 8 * INW * 2)));
                }
                float mt = fmaxf(p0[0], p1[0]);
#pragma unroll
                for (int r = 1; r < 16; ++r) mt = fmaxf(mt, fmaxf(p0[r], p1[r]));
                mt = fmaxf(mt, __shfl_xor(mt, 32));
                const float m_new = fmaxf(m_run, mt), alpha = __builtin_amdgcn_exp2f(m_run - m_new);
                m_run = m_new;
                float ls = 0.f;
#pragma unroll
                for (int r = 0; r < 16; ++r) { p0[r] = __builtin_amdgcn_exp2f(p0[r] - m_new); p1[r] = __builtin_amdgcn_exp2f(p1[r] - m_new); ls += p0[r] + p1[r]; o0[r] *= alpha; o1[r] *= alpha; }
                l_run = l_run * alpha + ls;
                const bf16x8 pf0 = pack8(p0, 0), pf1 = pack8(p0, 1), pf2 = pack8(p1, 0), pf3 = pack8(p1, 1);
                LAS const unsigned char* vcur = vbase + (j & 1) * 8192 + vb;
#pragma unroll
                for (int db = 0; db < 2; ++db) {
                    v4i16_t lo[4], hi[4];
#pragma unroll
                    for (int ks = 0; ks < 4; ++ks) { lo[ks] = vtr(vcur + ks * 2048 + db * 64); hi[ks] = vtr(vcur + ks * 2048 + 1024 + db * 64); }
#define VF(k) (bf16x8){lo[k][0], lo[k][1], lo[k][2], lo[k][3], hi[k][0], hi[k][1], hi[k][2], hi[k][3]}
                    if (db == 0) { o0 = MFMA32(VF(0), pf0, o0); o0 = MFMA32(VF(1), pf1, o0); o0 = MFMA32(VF(2), pf2, o0); o0 = MFMA32(VF(3), pf3, o0); }
                    else         { o1 = MFMA32(VF(0), pf0, o1); o1 = MFMA32(VF(1), pf1, o1); o1 = MFMA32(VF(2), pf2, o1); o1 = MFMA32(VF(3), pf3, o1); }
#undef VF
                }
                if (j < LEFT) {
#pragma unroll
                    for (int i = 0; i < 8; ++i) *(LAS u32x4*)(vbase + ((j + 1) & 1) * 8192 + i * 1024 + vw) = vr[i];
                }
            }
            const float lt = l_run + __shfl_xor(l_run, 32), inv = 1.0f / lt;
            float ss = 0.f;
            bf16_t* orow = mixb + tq * D + 512 + h * 64 + 4 * hh;
#pragma unroll
            for (int g = 0; g < 4; ++g) {
                const float a0 = o0[4 * g] * inv, a1 = o0[4 * g + 1] * inv, a2 = o0[4 * g + 2] * inv, a3 = o0[4 * g + 3] * inv;
                const float c0 = o1[4 * g] * inv, c1 = o1[4 * g + 1] * inv, c2 = o1[4 * g + 2] * inv, c3 = o1[4 * g + 3] * inv;
                ss += (a0 * a0 + a1 * a1) + (a2 * a2 + a3 * a3) + (c0 * c0 + c1 * c1) + (c2 * c2 + c3 * c3);
                *(u32x2*)(orow + 8 * g) = (u32x2){cvtpk_s(a0, a1), cvtpk_s(a2, a3)};
                *(u32x2*)(orow + 32 + 8 * g) = (u32x2){cvtpk_s(c0, c1), cvtpk_s(c2, c3)};
            }
            ss += __shfl_xor(ss, 32);
            if (hh == 0) ssq[tq * SSQW + 16 + h] = ss;
        }
    }
}


constexpr int RG_WT = 0, RG_IMG = 18432, RG_UCF = 36864, RG_AS = 70144, RG_SEG = 103424, RG_HP = 111616, RG_ROWB = 144, RG_FS = 65;
__device__ __forceinline__ float fast_sigmoid(float x) { return __builtin_amdgcn_rcpf(1.0f + __expf(-x)); }
__device__ __forceinline__ void rglru_item(const Params& p, const bf16_t* z, bf16_t* mixb, float* ssq, LAS unsigned char* lds, int b, int hb) {
    int tid_ = threadIdx.x; asm volatile("" : "+v"(tid_));
    const int tid = tid_, lane = tid & 63, w = __builtin_amdgcn_readfirstlane(tid >> 6), ch = lane, c16 = lane & 15, tg = lane >> 4;
    LAS float* ucf = (LAS float*)(lds + RG_UCF); LAS float* as_ = (LAS float*)(lds + RG_AS); LAS f32x2* seg = (LAS f32x2*)(lds + RG_SEG); LAS float* hp = (LAS float*)(lds + RG_HP);
    for (int idx = tid; idx < 64 * 128; idx += NTHR) { const int k = idx >> 7, n = idx & 127;
        const float v = (n < 64) ? p.w_rg_a[(hb * 64 + k) * 64 + n] : p.w_rg_x[(hb * 64 + k) * 64 + n - 64];
        *(LAS bf16_t*)(lds + RG_WT + n * RG_ROWB + k * 2) = (bf16_t)f2bf(v); }
    if (tid < 64) hp[tid] = 0.f;
    const int gch = hb * 64 + ch;
    const float cw0 = p.conv_w[gch], cw1 = p.conv_w[RW + gch], cw2 = p.conv_w[2 * RW + gch], cw3 = p.conv_w[3 * RW + gch], cb = p.conv_b[gch];
    float ba[4], bxb[4], sp8[4];
#pragma unroll
    for (int nb = 0; nb < 4; ++nb) { const int c = hb * 64 + 16 * nb + c16; ba[nb] = p.b_rg_a[c]; bxb[nb] = p.b_rg_x[c]; sp8[nb] = -8.0f * log1pf(expf(-p.lru_lambda[c])); }
    __syncthreads();
    const bf16_t* ucol = z + (size_t)b * S * INW + gch;
    bf16_t un[19], gn[16];
#pragma unroll
    for (int i = 0; i < 19; ++i) { const int s = 16 * w - 3 + i; un[i] = (s >= 0) ? ucol[(long)s * INW] : (bf16_t)0; }
#pragma unroll
    for (int i = 0; i < 16; ++i) gn[i] = ucol[(long)(16 * w + i) * INW + 512];
#pragma unroll 1
    for (int blk = 0; blk < S / 128; ++blk) {
        const int par = blk & 1, t0 = blk * 128 + 16 * w;
        float uv[19], gv[16];
#pragma unroll
        for (int i = 0; i < 19; ++i) uv[i] = bf2f(un[i]);
#pragma unroll
        for (int i = 0; i < 16; ++i) gv[i] = bf2f(gn[i]);
        if (blk + 1 < S / 128) {
#pragma unroll
            for (int i = 0; i < 19; ++i) un[i] = ucol[(long)(t0 + 128 - 3 + i) * INW];
#pragma unroll
            for (int i = 0; i < 16; ++i) gn[i] = ucol[(long)(t0 + 128 + i) * INW + 512];
        }
#pragma unroll
        for (int i = 0; i < 16; ++i) { const float uc = cb + cw0 * uv[i] + cw1 * uv[i + 1] + cw2 * uv[i + 2] + cw3 * uv[i + 3];
            *(LAS bf16_t*)(lds + RG_IMG + (16 * w + i) * RG_ROWB + ch * 2) = (bf16_t)f2bf(uc); ucf[(16 * w + i) * RG_FS + ch] = uc; }
        LDS_WAIT(); asm volatile("" ::: "memory");
        const bf16x8 a0 = *(const LAS bf16x8*)(lds + RG_IMG + (16 * w + c16) * RG_ROWB + tg * 16), a1 = *(const LAS bf16x8*)(lds + RG_IMG + (16 * w + c16) * RG_ROWB + tg * 16 + 64);
        f32x4 acc[8];
#pragma unroll
        for (int nb = 0; nb < 8; ++nb) { const bf16x8 b0 = *(const LAS bf16x8*)(lds + RG_WT + (16 * nb + c16) * RG_ROWB + tg * 16), b1 = *(const LAS bf16x8*)(lds + RG_WT + (16 * nb + c16) * RG_ROWB + tg * 16 + 64);
            acc[nb] = __builtin_amdgcn_mfma_f32_16x16x32_bf16(a0, b0, (f32x4){0.f, 0.f, 0.f, 0.f}, 0, 0, 0);
            acc[nb] = __builtin_amdgcn_mfma_f32_16x16x32_bf16(a1, b1, acc[nb], 0, 0, 0); }
#pragma unroll
        for (int nb = 0; nb < 4; ++nb)
#pragma unroll
            for (int rg_ = 0; rg_ < 4; ++rg_) { const int o = (16 * w + 4 * tg + rg_) * RG_FS + 16 * nb + c16;
                const float r = fast_sigmoid(acc[nb][rg_] + ba[nb]), ig = fast_sigmoid(acc[nb + 4][rg_] + bxb[nb]);
                const float la = r * sp8[nb], x2 = 2.0f * la;
                const float om = (x2 > -0.06f) ? -x2 * (1.0f + x2 * (0.5f + x2 * (0.16666667f + x2 * 0.041666668f))) : 1.0f - __expf(x2);
                const float ucv = ucf[o];
                as_[o] = __expf(la); ucf[o] = sqrtf(om) * (ig * ucv); }
        LDS_WAIT(); asm volatile("" ::: "memory");
        float av[16], bv[16]; float H = 0.f, P = 1.f;
#pragma unroll
        for (int i = 0; i < 16; ++i) { av[i] = as_[(16 * w + i) * RG_FS + ch]; bv[i] = ucf[(16 * w + i) * RG_FS + ch]; }
#pragma unroll
        for (int i = 0; i < 16; ++i) { H = av[i] * H + bv[i]; P *= av[i]; }
        seg[(par * 8 + w) * 64 + ch] = (f32x2){P, H};
        __syncthreads();
        float hcur = hp[par * 64 + ch];
        for (int s = 0; s < w; ++s) { const f32x2 sv = seg[(par * 8 + s) * 64 + ch]; hcur = sv.x * hcur + sv.y; }
        bf16_t* orow = mixb + ((size_t)b * S + t0) * D + gch;
#pragma unroll
        for (int i = 0; i < 16; ++i) { hcur = av[i] * hcur + bv[i];
            const float g = gv[i], u2 = 1.5957691216057308f * (g + 0.044715f * g * g * g);
            const float y = hcur * g * fast_sigmoid(u2);
            orow[(size_t)i * D] = (bf16_t)f2bf(y); as_[(16 * w + i) * RG_FS + ch] = y * y; }
        if (w == 7) hp[(par ^ 1) * 64 + ch] = hcur;
        LDS_WAIT(); asm volatile("" ::: "memory");
        {
            float ssum = 0.f;
#pragma unroll
            for (int c = 0; c < 16; ++c) ssum += as_[(16 * w + c16) * RG_FS + 16 * tg + c];
            ssum += __shfl_xor(ssum, 16); ssum += __shfl_xor(ssum, 32);
            if (tg == 0) *(f32x2*)(ssq + ((size_t)b * S + t0 + c16) * SSQW + 2 * hb) = (f32x2){ssum, 0.f};
        }
    }
}

__device__ void ph_router2(const Params& p, const float* h, bf16_t* xn2b, int* gcount, int* tok_list, float* w_list, LAS int* L) {
    const int tid = opaque_tid(), lane = tid & 63, wv = tid >> 6;
    LAS int* lcnt = L; LAS int* lbase = L + 16; LAS int* rec_e = L + 32; LAS int* rec_s = L + 160; LAS float* rec_w = (LAS float*)(L + 288);
    for (int grp = blockIdx.x; grp < T / 64; grp += gridDim.x) {
        if (tid < 16) lcnt[tid] = 0;
        __syncthreads();
        for (int tl = wv * 8; tl < wv * 8 + 8; ++tl) {
            const int t = grp * 64 + tl;
            const f32x4* hr = (const f32x4*)(h + (size_t)t * D) + lane;
            f32x4 v[4]; float ss = 0.f;
#pragma unroll
            for (int j = 0; j < 4; ++j) { v[j] = hr[64 * j]; ss += (v[j][0] * v[j][0] + v[j][1] * v[j][1]) + (v[j][2] * v[j][2] + v[j][3] * v[j][3]); }
            const float r = rsqrtf(wave_sum(ss) * (1.0f / D) + EPS);
            u32x2* o8 = (u32x2*)(xn2b + (size_t)t * D) + lane;
            float lg[4], le[16];
#pragma unroll
            for (int g = 0; g < 4; ++g) lg[g] = 0.f;
#pragma unroll
            for (int e = 0; e < 16; ++e) le[e] = 0.f;
#pragma unroll
            for (int j = 0; j < 4; ++j) {
                v[j] = v[j] * r;
                o8[64 * j] = (u32x2){pk2(v[j][0], v[j][1]), pk2(v[j][2], v[j][3])};
                const f32x4 g2 = *((const f32x4*)p.norm2_g + lane + 64 * j);
                v[j] = v[j] * g2;
#pragma unroll
                for (int q = 0; q < 4; ++q) {
                    const int k = 4 * lane + 256 * j + q; const float xv = v[j][q];
                    const f32x4 wg = *(const f32x4*)(p.w_group + (size_t)k * 4);
                    lg[0] += xv * wg[0]; lg[1] += xv * wg[1]; lg[2] += xv * wg[2]; lg[3] += xv * wg[3];
#pragma unroll
                    for (int e4 = 0; e4 < 4; ++e4) { const f32x4 wr = *(const f32x4*)(p.w_router + (size_t)k * 16 + e4 * 4);
                        le[e4 * 4 + 0] += xv * wr[0]; le[e4 * 4 + 1] += xv * wr[1]; le[e4 * 4 + 2] += xv * wr[2]; le[e4 * 4 + 3] += xv * wr[3]; }
                }
            }
#pragma unroll
            for (int g = 0; g < 4; ++g) lg[g] = wave_sum(lg[g]) + p.b_group[g];
#pragma unroll
            for (int e = 0; e < 16; ++e) le[e] = wave_sum(le[e]) + p.b_router[e];
            float mine = 0.f;
#pragma unroll
            for (int e = 0; e < 16; ++e) mine = (lane == e) ? le[e] : mine;
            int g = 0; float best = lg[0];
#pragma unroll
            for (int i = 1; i < 4; ++i) if (lg[i] > best) { best = lg[i]; g = i; }
            float sel[4];
#pragma unroll
            for (int i = 0; i < 4; ++i) sel[i] = __shfl(mine, g * 4 + i);
            if (lane == 0) {
                float den = 0.f;
#pragma unroll
                for (int i = 0; i < 4; ++i) den += expf(lg[i] - best);
                const float pg = 1.0f / den;
                int i1 = 0; float v1 = sel[0];
#pragma unroll
                for (int i = 1; i < 4; ++i) if (sel[i] > v1) { v1 = sel[i]; i1 = i; }
                int i2 = -1; float v2 = -3.0e38f;
#pragma unroll
                for (int i = 0; i < 4; ++i) if (i != i1 && sel[i] > v2) { v2 = sel[i]; i2 = i; }
                const float e2 = expf(v2 - v1);
                const float w1 = pg / (1.0f + e2), w2 = pg * e2 / (1.0f + e2);
                const int ea = g * 4 + i1, eb = g * 4 + i2;
                const int sa = __hip_atomic_fetch_add(lcnt + ea, 1, __ATOMIC_RELAXED, __HIP_MEMORY_SCOPE_WORKGROUP);
                const int sb = __hip_atomic_fetch_add(lcnt + eb, 1, __ATOMIC_RELAXED, __HIP_MEMORY_SCOPE_WORKGROUP);
                rec_e[tl * 2] = ea; rec_s[tl * 2] = sa; rec_w[tl * 2] = w1;
                rec_e[tl * 2 + 1] = eb; rec_s[tl * 2 + 1] = sb; rec_w[tl * 2 + 1] = w2;
            }
        }
        __syncthreads();
        if (tid < 16) lbase[tid] = __hip_atomic_fetch_add(gcount + tid, lcnt[tid], __ATOMIC_RELAXED, __HIP_MEMORY_SCOPE_AGENT);
        __syncthreads();
        if (tid < 128) { const int e = rec_e[tid]; const int pos = lbase[e] + rec_s[tid]; tok_list[e * T + pos] = grp * 128 + tid; w_list[e * T + pos] = rec_w[tid]; }
        __syncthreads();
    }
}

constexpr int RT_WT = 0, RT_LDK = 1028, RT_PART = 82432, RT_SSP = 98816, RT_REC = 99328;
__device__ __forceinline__ void ph_router3(const Params& p, const float* h, int* gcount, int* tok_list, float* w_list, float* r_list, LAS unsigned char* lds) {
    const int tid = opaque_tid(), lane = tid & 63, w = __builtin_amdgcn_readfirstlane(tid >> 6), t16 = lane & 15, g = lane >> 4;
    LAS float* wt = (LAS float*)(lds + RT_WT); LAS float* part = (LAS float*)(lds + RT_PART); LAS float* ssp = (LAS float*)(lds + RT_SSP);
    LAS int* lcnt = (LAS int*)(lds + RT_REC); LAS int* lbase = lcnt + 16; LAS int* rec_e = lcnt + 32; LAS int* rec_s = lcnt + 160; LAS float* rec_w = (LAS float*)(lcnt + 288); LAS float* rec_r = (LAS float*)(lcnt + 416);
    for (int idx = tid; idx < D * 16; idx += NTHR) { const int k = idx >> 4, n = idx & 15; wt[n * RT_LDK + k] = p.w_router[idx] * p.norm2_g[k]; }
    for (int idx = tid; idx < D * 4; idx += NTHR) { const int k = idx >> 2, n = idx & 3; wt[(16 + n) * RT_LDK + k] = p.w_group[idx] * p.norm2_g[k]; }
    const int task = w & 3, khalf = w >> 2, kbase = khalf * 512 + g * 128;
    for (int grp = blockIdx.x; grp < T / 64; grp += gridDim.x) {
        if (tid < 16) lcnt[tid] = 0;
        __syncthreads();
        {
            const f32x4* hrow = (const f32x4*)(h + (size_t)(grp * 64 + task * 16 + t16) * D + kbase);
            const LAS f32x4* b0p = (const LAS f32x4*)(wt + t16 * RT_LDK + kbase); const LAS f32x4* b1p = (const LAS f32x4*)(wt + (16 + (lane & 3)) * RT_LDK + kbase);
            f32x4 acc0 = {0.f, 0.f, 0.f, 0.f}, acc1 = {0.f, 0.f, 0.f, 0.f}; float ss = 0.f;
#pragma unroll 1
            for (int jb = 0; jb < 32; jb += 8) {
                f32x4 a[8];
#pragma unroll
                for (int j = 0; j < 8; ++j) a[j] = hrow[jb + j];
#pragma unroll
                for (int j = 0; j < 8; ++j) { const f32x4 b0 = b0p[jb + j], b1 = b1p[jb + j];
#pragma unroll
                    for (int q = 0; q < 4; ++q) { acc0 = __builtin_amdgcn_mfma_f32_16x16x4f32(a[j][q], b0[q], acc0, 0, 0, 0); acc1 = __builtin_amdgcn_mfma_f32_16x16x4f32(a[j][q], b1[q], acc1, 0, 0, 0); ss += a[j][q] * a[j][q]; } }
            }
            ss += __shfl_xor(ss, 16); ss += __shfl_xor(ss, 32);
            if (g == 0) ssp[khalf * 64 + task * 16 + t16] = ss;
            LAS float* pp = part + ((khalf * 4 + task) * 16 + 4 * g) * 32 + t16;
#pragma unroll
            for (int rg_ = 0; rg_ < 4; ++rg_) { pp[rg_ * 32] = acc0[rg_]; pp[rg_ * 32 + 16] = acc1[rg_]; }
        }
        __syncthreads();
        if (tid < 64) {
            const float rstd = rsqrtf((ssp[tid] + ssp[64 + tid]) * (1.0f / D) + EPS);
            const LAS float* q0 = part + tid * 32; const LAS float* q1 = part + (64 + tid) * 32;
            float lg[4];
#pragma unroll
            for (int i = 0; i < 4; ++i) lg[i] = (q0[16 + i] + q1[16 + i]) * rstd + p.b_group[i];
            int gi = 0; float best = lg[0];
#pragma unroll
            for (int i = 1; i < 4; ++i) if (lg[i] > best) { best = lg[i]; gi = i; }
            float den = 0.f;
#pragma unroll
            for (int i = 0; i < 4; ++i) den += expf(lg[i] - best);
            const float pg = 1.0f / den;
            float sel[4];
#pragma unroll
            for (int i = 0; i < 4; ++i) sel[i] = (q0[gi * 4 + i] + q1[gi * 4 + i]) * rstd + p.b_router[gi * 4 + i];
            int i1 = 0; float v1 = sel[0];
#pragma unroll
            for (int i = 1; i < 4; ++i) if (sel[i] > v1) { v1 = sel[i]; i1 = i; }
            int i2 = -1; float v2 = -3.0e38f;
#pragma unroll
            for (int i = 0; i < 4; ++i) if (i != i1 && sel[i] > v2) { v2 = sel[i]; i2 = i; }
            const float e2 = expf(v2 - v1);
            const float w1 = pg / (1.0f + e2), w2 = pg * e2 / (1.0f + e2);
            const int ea = gi * 4 + i1, eb = gi * 4 + i2;
            const int sa = __hip_atomic_fetch_add(lcnt + ea, 1, __ATOMIC_RELAXED, __HIP_MEMORY_SCOPE_WORKGROUP);
            const int sb = __hip_atomic_fetch_add(lcnt + eb, 1, __ATOMIC_RELAXED, __HIP_MEMORY_SCOPE_WORKGROUP);
            rec_e[tid * 2] = ea; rec_s[tid * 2] = sa; rec_w[tid * 2] = w1; rec_r[tid * 2] = rstd;
            rec_e[tid * 2 + 1] = eb; rec_s[tid * 2 + 1] = sb; rec_w[tid * 2 + 1] = w2; rec_r[tid * 2 + 1] = rstd;
        }
        __syncthreads();
        if (tid < 16) lbase[tid] = __hip_atomic_fetch_add(gcount + tid, lcnt[tid], __ATOMIC_RELAXED, __HIP_MEMORY_SCOPE_AGENT);
        __syncthreads();
        if (tid < 128) { const int e = rec_e[tid]; const int pos = lbase[e] + rec_s[tid]; tok_list[e * T + pos] = grp * 128 + tid; w_list[e * T + pos] = rec_w[tid]; r_list[e * T + pos] = rec_r[tid]; }
        __syncthreads();
    }
}

__device__ void ph_final(const Params& p, const float* h, const bf16_t* y2, float* out) {
    const int tid = opaque_tid(), lane = tid & 63, wv = tid >> 6, nw = NWAVES;
    for (int t = blockIdx.x * nw + wv; t < T; t += gridDim.x * nw) {
        const f32x4* hr = (const f32x4*)(h + (size_t)t * D) + lane;
        const u32x2* y0 = (const u32x2*)(y2 + (size_t)(2 * t) * D) + lane; const u32x2* y1 = (const u32x2*)(y2 + (size_t)(2 * t + 1) * D) + lane;
        f32x4 v[4]; float ss = 0.f;
#pragma unroll
        for (int j = 0; j < 4; ++j) { const f32x4 hv = hr[64 * j]; const u32x2 a = y0[64 * j], b = y1[64 * j];
            v[j][0] = hv[0] + __builtin_bit_cast(float, a[0] << 16) + __builtin_bit_cast(float, b[0] << 16);
            v[j][1] = hv[1] + __builtin_bit_cast(float, a[0] & 0xffff0000u) + __builtin_bit_cast(float, b[0] & 0xffff0000u);
            v[j][2] = hv[2] + __builtin_bit_cast(float, a[1] << 16) + __builtin_bit_cast(float, b[1] << 16);
            v[j][3] = hv[3] + __builtin_bit_cast(float, a[1] & 0xffff0000u) + __builtin_bit_cast(float, b[1] & 0xffff0000u);
            ss += (v[j][0] * v[j][0] + v[j][1] * v[j][1]) + (v[j][2] * v[j][2] + v[j][3] * v[j][3]); }
        const float r = rsqrtf(wave_sum(ss) * (1.0f / D) + EPS);
        f32x4* orow = (f32x4*)(out + (size_t)t * D) + lane;
#pragma unroll
        for (int j = 0; j < 4; ++j) { const f32x4 gf = *((const f32x4*)p.final_g + lane + 64 * j); orow[64 * j] = v[j] * r * gf; }
    }
}


__device__ __forceinline__ void ph_mixers(const Params& p, const bf16_t* z, bf16_t* mixb, float* ssq, LAS unsigned char* lds, unsigned* qctr) {
    const AttnCtx A = attn_setup(p, lds, TAB_OFF);
    volatile LAS int* qword = (volatile LAS int*)(lds + TAB_OFF + 12288);
    constexpr int NQ = NB, QITEMS = 8 + 64;
    for (int qq = 0; qq < NQ; ++qq) {
        const int q = (blockIdx.x + qq) % NQ;
        for (;;) {
            __syncthreads();
            if (threadIdx.x == 0) *qword = (int)__hip_atomic_fetch_add(qctr + 64 * q, 1u, __ATOMIC_RELAXED, __HIP_MEMORY_SCOPE_AGENT);
            __syncthreads();
            const int idx = *qword;
            if (idx >= QITEMS) break;
            if (idx < 8) rglru_item(p, z, mixb, ssq, lds, q, idx);
            else { const int a = idx - 8; attn_item(A, z, mixb, ssq, q, 31 - (a >> 1), a & 1); }
        }
    }
}


#define XB_TMO      128
#define XB_XCNT(j)  (256  + 64 * (j))
#define XB_XSUB(j)  (1280 + 64 * (j))
#define XB_XGEN(j)  (2304 + 64 * (j))
#define XB_TOP      3328
#define XB_TOPGEN   3392
#define XCD_BAR_WORDS 3456
#define XB_SPIN_CAP (1u << 18)
__device__ __forceinline__ unsigned xb_ld(unsigned* p)              { return __hip_atomic_load(p, __ATOMIC_RELAXED, __HIP_MEMORY_SCOPE_AGENT); }
__device__ __forceinline__ unsigned xb_add(unsigned* p, unsigned v) { return __hip_atomic_fetch_add(p, v, __ATOMIC_RELAXED, __HIP_MEMORY_SCOPE_AGENT); }
__device__ __forceinline__ unsigned xb_xcc_id() { return (unsigned)__builtin_amdgcn_s_getreg((3 << 11) | 20) & 0xFu; }
#define XB_SPIN(cond, bar) do { unsigned _sp = 0; while (cond) { __builtin_amdgcn_s_sleep(1); \
    if ((++_sp & 255u) == 0u) { if (xb_ld(&(bar)[XB_TMO])) break; if (_sp > XB_SPIN_CAP) { atomicAdd(&(bar)[XB_TMO], 1u); break; } } } } while (0)
struct XcdBarrier { unsigned* bar; unsigned x; volatile LAS unsigned* st; };
__device__ __forceinline__ XcdBarrier xcd_barrier_post(unsigned* bar, volatile LAS unsigned* st) {
    XcdBarrier b; b.bar = bar; b.x = xb_xcc_id(); b.st = st;
    if (threadIdx.x == 0) (void)xb_add(&bar[XB_XCNT(b.x)], 1u);
    return b;
}
__device__ __forceinline__ void xcd_barrier_complete(unsigned* bar, unsigned x, unsigned& nloc, unsigned& nx) {
    const unsigned G = gridDim.x * gridDim.y * gridDim.z;
    unsigned sum, cnt, mine, sp = 0u;
    for (;;) {
        sum = 0u; cnt = 0u; mine = 0u;
#pragma unroll
        for (unsigned j = 0; j < 16; ++j) { const unsigned c = xb_ld(&bar[XB_XCNT(j)]); sum += c; cnt += (c > 0u) ? 1u : 0u; mine = (j == x) ? c : mine; }
        if (sum == G) break;
        __builtin_amdgcn_s_sleep(1);
        if ((++sp & 255u) == 0u) { if (xb_ld(&bar[XB_TMO])) break; if (sp > XB_SPIN_CAP) { atomicAdd(&bar[XB_TMO], 1u); break; } }
    }
    nloc = mine > 0u ? mine : 1u; nx = cnt > 0u ? cnt : 1u;
}
__device__ __forceinline__ void xcd_barrier(const XcdBarrier& b) {
    asm volatile("s_waitcnt vmcnt(0)" ::: "memory");
    __syncthreads();
    if (threadIdx.x == 0) {
        unsigned* bar = b.bar;
        __builtin_amdgcn_s_waitcnt(0);
        unsigned nloc = b.st[0], nx = b.st[1];
        if (nloc == 0u) { xcd_barrier_complete(bar, b.x, nloc, nx); b.st[0] = nloc; b.st[1] = nx; }
        const unsigned old = xb_add(&bar[XB_XSUB(b.x)], 1u);
        const unsigned gen = old / nloc;
        if (old + 1u == (gen + 1u) * nloc) {
            __builtin_amdgcn_fence(__ATOMIC_RELEASE, "agent");
            asm volatile("s_waitcnt vmcnt(0)" ::: "memory");
            const unsigned og = xb_add(&bar[XB_TOP], 1u);
            const unsigned tg = og / nx;
            if (og + 1u == (tg + 1u) * nx) xb_add(&bar[XB_TOPGEN], 1u);
            else XB_SPIN(xb_ld(&bar[XB_TOPGEN]) == tg, bar);
            __builtin_amdgcn_fence(__ATOMIC_ACQUIRE, "agent");
            xb_add(&bar[XB_XGEN(b.x)], 1u);
            asm volatile("s_waitcnt vmcnt(0)" ::: "memory");
        } else {
            XB_SPIN(xb_ld(&bar[XB_XGEN(b.x)]) == gen, bar);
            __builtin_amdgcn_fence(__ATOMIC_ACQUIRE, "agent");
            asm volatile("s_waitcnt vmcnt(0)" ::: "memory");
        }
    }
    __syncthreads();
}


__global__ void __launch_bounds__(NTHR) k_mega(Params p) {
    extern __shared__ __attribute__((aligned(16))) unsigned char lds_raw[];
    LAS unsigned char* lds = (LAS unsigned char*)lds_raw;
    cg::grid_group grid = cg::this_grid();
    const int G = gridDim.x; const int bx = blockIdx.x;
    volatile LAS unsigned* misc = (volatile LAS unsigned*)(lds + MISC_OFF);
    if (threadIdx.x < 64) misc[threadIdx.x] = 0u;
    __syncthreads();
    const XcdBarrier xbar = xcd_barrier_post((unsigned*)(p.ws + WS_CTL + 65536), misc + 8);
    const int vcu = (G % 8 == 0) ? (bx % 8) * (G / 8) + bx / 8 : bx;
    bf16_t* win_t = (bf16_t*)(p.ws + WS_WIN); bf16_t* wout_t = (bf16_t*)(p.ws + WS_WOUT);
    bf16_t* xb = (bf16_t*)(p.ws + WS_XB); bf16_t* zb = (bf16_t*)(p.ws + WS_Z); bf16_t* mixb = (bf16_t*)(p.ws + WS_MIX);
    float* ssq = (float*)(p.ws + WS_SSQ);
    float* a_ = (float*)(p.ws + WS_XB); float* bx_ = (float*)(p.ws + WS_HID);
    bf16_t* xn2b = (bf16_t*)(p.ws + WS_XB);
    int* route_e = (int*)(p.ws + WS_ROUTE); float* route_w = (float*)(p.ws + WS_ROUTE + (size_t)T * 2 * 4);
    float* h = p.out;

    ph_prologue(p, lds, vcu, G);
#if PROBE == 1
    ph_prologue(p, lds, vcu, G); ph_prologue(p, lds, vcu, G);
#endif
    if (p.ws == nullptr) grid.sync();
    xcd_barrier(xbar);
    {
        pg8::DenseOrder So; So.init(xb, win_t, T, INW, D, G, bx);
        pg8::EpiZ E{zb, INW};
        pg8::gemm_phase(lds, D, So, E);
#if PROBE == 2
        pg8::gemm_phase(lds, D, So, E); pg8::gemm_phase(lds, D, So, E);
#endif
    }
    xcd_barrier(xbar);
    ph_mixers(p, zb, mixb, ssq, lds, (unsigned*)(p.ws + WS_CTL + 8192));
#if PROBE == 3
    ph_mixers(p, zb, mixb, ssq, lds, (unsigned*)(p.ws + WS_CTL + 8192 + 2048)); ph_mixers(p, zb, mixb, ssq, lds, (unsigned*)(p.ws + WS_CTL + 8192 + 4096));
#endif
    xcd_barrier(xbar);
    {
        pg8::DenseOrder So; So.init(mixb, wout_t, T, D, D, G, bx);
        pg8::EpiH E{ssq, p.x, h, xn2b, TAB_OFF};
        pg8::gemm_phase(lds, D, So, E);
#if PROBE == 4
        pg8::gemm_phase(lds, D, So, E); pg8::gemm_phase(lds, D, So, E);
#endif
    }
    xcd_barrier(xbar);
    int* gcount = (int*)(p.ws + WS_CTL + 4096); int* tok_list = (int*)(p.ws + WS_LIST); float* w_list = (float*)(p.ws + WS_LIST + MiB);
    bf16_t* wgu_t = (bf16_t*)(p.ws + WS_WGU); bf16_t* wd_t = (bf16_t*)(p.ws + WS_WD); bf16_t* hid = (bf16_t*)(p.ws + WS_HID); bf16_t* y2 = (bf16_t*)(p.ws + WS_Z);
    float* r_list = (float*)(p.ws + WS_ROUTE);
    ph_router3(p, h, gcount, tok_list, w_list, r_list, lds);
#if PROBE == 55
    ph_router2(p, h, xn2b, (int*)(p.ws + WS_CTL + 16384), (int*)(p.ws + WS_HID), (float*)(p.ws + WS_HID + MiB), (LAS int*)lds);
    ph_router2(p, h, xn2b, (int*)(p.ws + WS_CTL + 16384 + 256), (int*)(p.ws + WS_HID + 2 * MiB), (float*)(p.ws + WS_HID + 3 * MiB), (LAS int*)lds);
#endif
    xcd_barrier(xbar);
    LAS int* meta = (LAS int*)(lds + META_OFF);
    if (threadIdx.x == 0) { int base = 0; for (int e = 0; e < NE; ++e) { const int cnt = gcount[e]; meta[e] = base; meta[32 + e] = cnt; base += (cnt + 255) >> 8; } meta[16] = base; }
    __syncthreads();
    const int ntiles = meta[16];
    {
        pg8::MoeOrder<0> So{xn2b, wgu_t, tok_list, meta, D, G, bx, ntiles};
        pg8::EpiHid E{hid, r_list, meta};
        pg8::gemm_phase(lds, D, So, E);
#if PROBE == 6
        pg8::gemm_phase(lds, D, So, E); pg8::gemm_phase(lds, D, So, E);
#endif
    }
    xcd_barrier(xbar);
    {
        pg8::MoeOrder<1> So{hid, wd_t, tok_list, meta, DFF, G, bx, ntiles};
        pg8::EpiY E{y2, tok_list, w_list, meta};
        pg8::gemm_phase(lds, DFF, So, E);
#if PROBE == 7
        pg8::gemm_phase(lds, DFF, So, E); pg8::gemm_phase(lds, DFF, So, E);
#endif
    }
    xcd_barrier(xbar);
#if PROBE == 8
    ph_final(p, h, y2, (float*)(p.ws + WS_MIX)); ph_final(p, h, y2, (float*)(p.ws + WS_MIX));
#endif
    ph_final(p, h, y2, p.out);
}

extern "C" void kernel_launch(void* const* d_in, const int* in_sizes, int n_in, void* d_out, int out_size, void* d_ws, size_t ws_size, hipStream_t stream) {
    static int grid_blocks = 0;
    if (!grid_blocks) {
        if (ws_size < WS_END) { fprintf(stderr, "kernel_launch: workspace too small (%zu < %zu)\n", ws_size, (size_t)WS_END); grid_blocks = -1; return; }
        int dev = 0, cus = 0, per_cu = 0;
        (void)hipGetDevice(&dev);
        (void)hipDeviceGetAttribute(&cus, hipDeviceAttributeMultiprocessorCount, dev);
        (void)hipFuncSetAttribute((const void*)k_mega, hipFuncAttributeMaxDynamicSharedMemorySize, LDS_BYTES);
        (void)hipOccupancyMaxActiveBlocksPerMultiprocessor(&per_cu, (const void*)k_mega, NTHR, LDS_BYTES);
        if (per_cu < 1) { fprintf(stderr, "kernel_launch: occupancy query says %d blocks per CU\n", per_cu); per_cu = 1; }
        grid_blocks = cus;
    }
    if (grid_blocks < 0) return;
    Params p{};
    const float** f = (const float**)&p;
    for (int i = 0; i < 23; ++i) f[i] = (const float*)d_in[i];
    p.out = (float*)d_out;
    p.ws = (unsigned char*)d_ws;
    (void)hipMemsetAsync((char*)d_ws + WS_CTL, 0, CTL_BYTES, stream);
    void* args[] = {&p};
    hipError_t e = hipLaunchCooperativeKernel((void*)k_mega, dim3(grid_blocks), dim3(NTHR), args, LDS_BYTES, stream);
    if (e != hipSuccess) fprintf(stderr, "cooperative launch failed: %s (grid %d)\n", hipGetErrorString(e), grid_blocks);
}
```

```cpp
#include <hip/hip_runtime.h>
#include <hip/hip_cooperative_groups.h>
#include <cstdio>
#include <cstdint>
namespace cg = cooperative_groups;

#ifndef PROBE
#define PROBE 0
#endif

#define LAS __attribute__((address_space(3)))
typedef unsigned short bf16_t;
typedef short bf16x8 __attribute__((ext_vector_type(8)));
typedef float f32x4 __attribute__((ext_vector_type(4)));
typedef float f32x2 __attribute__((ext_vector_type(2)));
typedef unsigned u32x4 __attribute__((ext_vector_type(4)));
typedef unsigned u32x2 __attribute__((ext_vector_type(2)));

constexpr int D = 1024, NB = 8, S = 2048, T = NB * S;
constexpr int RW = 512, RHD = 64;
constexpr int CHUNK = 64, LEFT = 8, BAND = 576, MAXREL = 128;
constexpr int INW = 2560;
constexpr int NE = 16, DFF = 512;
constexpr float EPS = 1e-6f;
constexpr int NTHR = 512, NWAVES = 8;
constexpr int SSQW = 40;

constexpr size_t MiB = 1u << 20;
constexpr size_t WS_CTL = 0, CTL_BYTES = 1 * MiB;
constexpr size_t WS_WIN = 1 * MiB;
constexpr size_t WS_WOUT = 6 * MiB;
constexpr size_t WS_WGU = 8 * MiB;
constexpr size_t WS_WD = 40 * MiB;
constexpr size_t WS_XB = 56 * MiB;
constexpr size_t WS_Z = 88 * MiB;
constexpr size_t WS_MIX = 168 * MiB;
constexpr size_t WS_HID = 200 * MiB;
constexpr size_t WS_SSQ = 236 * MiB;
constexpr size_t WS_LIST = 239 * MiB;
constexpr size_t WS_ROUTE = 241 * MiB;
constexpr size_t WS_RWT = 242 * MiB;
constexpr size_t WS_END = 243 * MiB;

constexpr int RING_BYTES = 131072, TAB_OFF = RING_BYTES, META_OFF = RING_BYTES + 4096, MISC_OFF = RING_BYTES + 15360, LDS_BYTES = 147456;

struct Params {
    const float *x, *norm1_g, *w_in, *conv_w, *conv_b, *w_rg_a, *b_rg_a, *w_rg_x, *b_rg_x, *lru_lambda, *rel_bias,
        *g_rec_out, *g_att_out, *w_out, *norm2_g, *w_group, *b_group, *w_router, *b_router, *w_e_gate, *w_e_up, *w_e_down, *final_g;
    float* out;
    unsigned char* ws;
};

__device__ __forceinline__ float wave_sum(float v) {
#pragma unroll
    for (int o = 32; o > 0; o >>= 1) v += __shfl_xor(v, o);
    return v;
}
__device__ __forceinline__ float sigmoidf_(float x) { return 1.0f / (1.0f + expf(-x)); }
__device__ __forceinline__ float gelu_tanh(float x) { return 0.5f * x * (1.0f + tanhf(0.7978845608028654f * (x + 0.044715f * x * x * x))); }
__device__ __forceinline__ unsigned f2bf(float f) { unsigned u = __builtin_bit_cast(unsigned, f); return (u + 0x7fffu + ((u >> 16) & 1u)) >> 16; }
__device__ __forceinline__ unsigned pk2(float lo, float hi) { return f2bf(lo) | (f2bf(hi) << 16); }
__device__ __forceinline__ float bf2f(bf16_t b) { return __builtin_bit_cast(float, ((unsigned)b) << 16); }
__device__ __forceinline__ unsigned cvt_pk_bf16(float lo, float hi) { unsigned r; asm volatile("v_cvt_pk_bf16_f32 %0, %1, %2" : "=v"(r) : "v"(lo), "v"(hi)); return r; }
#define LDS_WAIT() asm volatile("s_waitcnt lgkmcnt(0)" ::: "memory")
__device__ __forceinline__ int opaque_tid() { int t = threadIdx.x; asm volatile("" : "+v"(t)); return t; }

namespace pg8 {
constexpr int BM = 256, BK = 64, HALF = 128, HTB = HALF * BK * 2, STAGE_BYTES = 8 * HTB, NXCD = 8, WGM = 8;
__device__ __forceinline__ int lds_byte(int r, int c) { const int st = (r >> 4) * 2 + (c >> 5), rr = r & 15, cc = c & 31, ob = rr * 64 + cc * 2; return st * 1024 + (ob ^ (((ob >> 9) & 1) << 5)); }
__device__ __forceinline__ void stage_rc(int b, int& R, int& C) { const int st = b / 1024, sb = b % 1024, swz = sb ^ (((sb >> 9) & 1) << 5); R = (st >> 1) * 16 + swz / 64; C = (st & 1) * 32 + (swz % 64) / 2; }
__device__ __forceinline__ int perm32(int rho) { const int n = rho >> 4, i = rho & 15; return 8 * (i >> 2) + 4 * n + (i & 3); }

struct Unit { int pm, pn, e, rows; };

struct DenseOrder {
    const bf16_t* A; const bf16_t* Bt; int K; int nM, nN, nwg, G, c;
    __device__ void init(const bf16_t* A_, const bf16_t* Bt_, int M, int N, int K_, int G_, int c_) { A = A_; Bt = Bt_; K = K_; nM = M / BM; nN = N / BM; nwg = nM * nN; G = G_; c = c_; }
    __device__ __forceinline__ bool next(int i, Unit& u) const {
        const long L = (long)i * G + c; if (L >= nwg) return false;
        int wgid = (int)L; { const int q = nwg / NXCD, r = nwg % NXCD, xcd = wgid % NXCD, off = wgid / NXCD; wgid = (xcd < r ? xcd * (q + 1) : r * (q + 1) + (xcd - r) * q) + off; }
        const int nig = WGM * nN, gid = wgid / nig, fm = gid * WGM, gsz = (nM - fm) < WGM ? (nM - fm) : WGM;
        u.pm = fm + ((wgid % nig) % gsz); u.pn = (wgid % nig) / gsz; u.e = 0; u.rows = BM; return true;
    }
    __device__ __forceinline__ void addr(const Unit& u, const int (&RA)[2], const int (&CA)[2], const char*& aBase, const char*& bBase, unsigned (&va)[2][2]) const {
        aBase = (const char*)A; bBase = (const char*)Bt + (size_t)u.pn * BM * K * 2;
#pragma unroll
        for (int h = 0; h < 2; ++h)
#pragma unroll
            for (int i = 0; i < 2; ++i) va[h][i] = (unsigned)(((size_t)(u.pm * BM + h * HALF + RA[i]) * K + CA[i]) * 2);
    }
};

template <class Epi, class Sched>
__device__ __forceinline__ void gemm_phase(LAS unsigned char* lds, const int K, const Sched& S, const Epi& E) {
    int tid_ = threadIdx.x; asm volatile("" : "+v"(tid_));
    const int tid = tid_, wid = __builtin_amdgcn_readfirstlane(tid >> 6), lane = tid & 63, wr = wid >> 2, wc = wid & 3, fr = lane & 15, fq = lane >> 4;
    const int nt = K / BK;
    int RA[2], CA[2]; unsigned voffB[2];
#pragma unroll
    for (int i = 0; i < 2; ++i) { int R, C; stage_rc(tid * 16 + i * 8192, R, C); RA[i] = R; CA[i] = C; const int Rb = Epi::PERM ? ((R & ~31) + perm32(R & 31)) : R; voffB[i] = (unsigned)(Rb * K + C) * 2u; }
    const size_t kstep = (size_t)(BK * 2);
    const size_t hstepB = (size_t)HALF * K * 2;
    const unsigned ldsw = (unsigned)wid * 1024u;
    const int aoff = lds_byte(wr * 64 + fr, fq * 8), boff = lds_byte(wc * 32 + fr, fq * 8);
#define PG8_SA(b, h) (((b) * 2 + (h)) * HTB)
#define PG8_SB(b, h) ((4 + (b) * 2 + (h)) * HTB)
#define PG8_STAGE_B(bufoff, gbase) do { _Pragma("unroll") for (int _i = 0; _i < 2; ++_i) \
        __builtin_amdgcn_global_load_lds((const unsigned*)((const char*)(gbase) + voffB[_i]), (LAS unsigned*)(lds + (bufoff) + ldsw + _i * 8192), 16, 0, 0); } while (0)
#define PG8_STAGE_A(bufoff, gbase, v0, v1) do { \
        __builtin_amdgcn_global_load_lds((const unsigned*)((const char*)(gbase) + (v0)), (LAS unsigned*)(lds + (bufoff) + ldsw), 16, 0, 0); \
        __builtin_amdgcn_global_load_lds((const unsigned*)((const char*)(gbase) + (v1)), (LAS unsigned*)(lds + (bufoff) + ldsw + 8192), 16, 0, 0); } while (0)
#define PG8_LDA(dst, b, h) do { _Pragma("unroll") for (int m = 0; m < 4; ++m) _Pragma("unroll") for (int k = 0; k < 2; ++k) dst[m][k] = *(const LAS bf16x8*)(lds + PG8_SA(b, h) + aoff + m * 2048 + k * 1024); } while (0)
#define PG8_LDB(dst, b, h) do { _Pragma("unroll") for (int n = 0; n < 2; ++n) _Pragma("unroll") for (int k = 0; k < 2; ++k) dst[n][k] = *(const LAS bf16x8*)(lds + PG8_SB(b, h) + boff + n * 2048 + k * 1024); } while (0)
#define PG8_MMA(ai, bj, At, Bt) do { __builtin_amdgcn_s_setprio(1); _Pragma("unroll") for (int m = 0; m < 4; ++m) _Pragma("unroll") for (int n = 0; n < 2; ++n) _Pragma("unroll") for (int k = 0; k < 2; ++k) \
        acc[ai][bj][m][n] = __builtin_amdgcn_mfma_f32_16x16x32_bf16(Bt[n][k], At[m][k], acc[ai][bj][m][n], 0, 0, 0); __builtin_amdgcn_s_setprio(0); } while (0)
#define PG8_WAIT_V(n) asm volatile("s_waitcnt vmcnt(" #n ")" ::: "memory")
#define PG8_WAIT_L(n) asm volatile("s_waitcnt lgkmcnt(" #n ")" ::: "memory")
#define PG8_BAR __builtin_amdgcn_s_barrier()
#define PG8_SCHED __builtin_amdgcn_sched_barrier(0)
    Unit cur, nxt; int ui = 0;
    if (!S.next(0, cur)) return;
    f32x4 acc[2][2][4][2];
#pragma unroll
    for (int a = 0; a < 2; ++a)
#pragma unroll
        for (int b = 0; b < 2; ++b)
#pragma unroll
            for (int m = 0; m < 4; ++m)
#pragma unroll
                for (int n = 0; n < 2; ++n) acc[a][b][m][n] = (f32x4){0.f, 0.f, 0.f, 0.f};
    bf16x8 At[4][2], B0[2][2], B1[2][2];
    const char *cA, *cB, *nA, *nB; unsigned cva[2][2], nva[2][2];
    S.addr(cur, RA, CA, cA, cB, cva);
    E.prepare(cur, ui, lds);
    PG8_STAGE_B(PG8_SB(0, 0), cB); PG8_STAGE_A(PG8_SA(0, 0), cA, cva[0][0], cva[0][1]); PG8_STAGE_B(PG8_SB(0, 1), cB + hstepB); PG8_STAGE_A(PG8_SA(0, 1), cA, cva[1][0], cva[1][1]);
    if (wr == 1) PG8_BAR;
    PG8_WAIT_V(4); PG8_BAR;
    PG8_STAGE_B(PG8_SB(1, 0), cB + kstep); PG8_STAGE_A(PG8_SA(1, 0), cA + kstep, cva[0][0], cva[0][1]); PG8_STAGE_B(PG8_SB(1, 1), cB + hstepB + kstep);
    PG8_WAIT_V(6); PG8_BAR;
    for (;;) {
        const bool has_next = S.next(ui + 1, nxt);
        if (has_next) { S.addr(nxt, RA, CA, nA, nB, nva); }
        else { nA = cA; nB = cB;
#pragma unroll
            for (int h = 0; h < 2; ++h)
#pragma unroll
                for (int i = 0; i < 2; ++i) nva[h][i] = cva[h][i]; }
        for (int t = 0; t < nt; t += 2) {
            const bool last = (t == nt - 2);
            if (Epi::MIDSCALE && t == nt / 2) E.midscale(acc, wr, fr, ui, lds);
            const char* a1 = cA + (size_t)(t + 1) * kstep;
            const char* a2 = last ? nA : cA + (size_t)(t + 2) * kstep; const char* b2 = last ? nB : cB + (size_t)(t + 2) * kstep;
            const char* a3 = a2 + kstep; const char* b3 = b2 + kstep;
            const unsigned x00 = last ? nva[0][0] : cva[0][0], x01 = last ? nva[0][1] : cva[0][1], x10 = last ? nva[1][0] : cva[1][0], x11 = last ? nva[1][1] : cva[1][1];
            if (last && has_next) E.prepare(nxt, ui + 1, lds);
            PG8_LDB(B0, 0, 0); PG8_SCHED; PG8_LDA(At, 0, 0); PG8_STAGE_A(PG8_SA(1, 1), a1, cva[1][0], cva[1][1]);
            PG8_WAIT_L(8); PG8_BAR; PG8_WAIT_L(0); PG8_MMA(0, 0, At, B0); PG8_BAR; PG8_SCHED;
            PG8_LDB(B1, 0, 1); PG8_STAGE_B(PG8_SB(0, 0), b2);
            PG8_BAR; PG8_WAIT_L(0); PG8_MMA(0, 1, At, B1); PG8_BAR;
            PG8_LDA(At, 0, 1); PG8_STAGE_A(PG8_SA(0, 0), a2, x00, x01);
            PG8_BAR; PG8_WAIT_L(0); PG8_MMA(1, 0, At, B0); PG8_BAR; PG8_SCHED;
            PG8_STAGE_B(PG8_SB(0, 1), b2 + hstepB);
            PG8_WAIT_V(6); PG8_BAR; PG8_MMA(1, 1, At, B1); PG8_BAR;
            PG8_LDB(B0, 1, 0); PG8_SCHED; PG8_LDA(At, 1, 0); PG8_STAGE_A(PG8_SA(0, 1), a2, x10, x11);
            PG8_WAIT_L(8); PG8_BAR; PG8_WAIT_L(0); PG8_MMA(0, 0, At, B0); PG8_BAR; PG8_SCHED;
            PG8_LDB(B1, 1, 1); PG8_STAGE_B(PG8_SB(1, 0), b3);
            PG8_BAR; PG8_WAIT_L(0); PG8_MMA(0, 1, At, B1); PG8_BAR;
            PG8_LDA(At, 1, 1); PG8_STAGE_A(PG8_SA(1, 0), a3, x00, x01);
            PG8_BAR; PG8_WAIT_L(0); PG8_MMA(1, 0, At, B0); PG8_BAR; PG8_SCHED;
            PG8_STAGE_B(PG8_SB(1, 1), b3 + hstepB);
            PG8_WAIT_V(6); PG8_BAR; PG8_MMA(1, 1, At, B1); PG8_BAR;
        }
        E(acc, cur, wr, wc, fr, fq, ui, lds);
        if (!has_next) break;
#pragma unroll
        for (int a = 0; a < 2; ++a)
#pragma unroll
            for (int b = 0; b < 2; ++b)
#pragma unroll
                for (int m = 0; m < 4; ++m)
#pragma unroll
                    for (int n = 0; n < 2; ++n) acc[a][b][m][n] = (f32x4){0.f, 0.f, 0.f, 0.f};
        cur = nxt; cA = nA; cB = nB; ++ui;
#pragma unroll
        for (int h = 0; h < 2; ++h)
#pragma unroll
            for (int i = 0; i < 2; ++i) cva[h][i] = nva[h][i];
    }
    PG8_WAIT_V(0);
    if (wr == 0) PG8_BAR;
    PG8_BAR;
#undef PG8_SA
#undef PG8_SB
#undef PG8_STAGE_A
#undef PG8_STAGE_B
#undef PG8_LDA
#undef PG8_LDB
#undef PG8_MMA
#undef PG8_WAIT_V
#undef PG8_WAIT_L
#undef PG8_BAR
#undef PG8_SCHED
}

struct EpiZ {
    static constexpr bool PERM = true, MIDSCALE = false;
    bf16_t* O; int ldc;
    __device__ __forceinline__ void prepare(const Unit&, int, LAS unsigned char*) const {}
    __device__ __forceinline__ void midscale(f32x4 (&)[2][2][4][2], int, int, int, LAS unsigned char*) const {}
    __device__ __forceinline__ void operator()(const f32x4 (&acc)[2][2][4][2], const Unit& u, int wr, int wc, int fr, int fq, int, LAS unsigned char*) const {
        const int row0 = u.pm * BM + wr * 64 + fr, col0 = u.pn * BM + wc * 32 + 8 * fq;
#pragma unroll
        for (int ai = 0; ai < 2; ++ai)
#pragma unroll
            for (int m = 0; m < 4; ++m) { bf16_t* rowp = O + (size_t)(row0 + ai * HALF + m * 16) * ldc + col0;
#pragma unroll
                for (int bj = 0; bj < 2; ++bj) { const f32x4 v0 = acc[ai][bj][m][0], v1 = acc[ai][bj][m][1];
                    u32x4 w; w.x = cvt_pk_bf16(v0[0], v0[1]); w.y = cvt_pk_bf16(v0[2], v0[3]); w.z = cvt_pk_bf16(v1[0], v1[1]); w.w = cvt_pk_bf16(v1[2], v1[3]);
                    *(u32x4*)(rowp + bj * HALF) = w; } }
    }
};
struct EpiH {
    static constexpr bool PERM = false, MIDSCALE = true;
    const float* ssq; const float* x; float* h; bf16_t* hb; int tab_off;
    __device__ __forceinline__ void prepare(const Unit& u, int ui, LAS unsigned char* lds) const {
        LAS f32x2* tab = (LAS f32x2*)(lds + tab_off) + (ui & 1) * 256;
        if (threadIdx.x < 256) {
            const float* sp = ssq + (size_t)(u.pm * BM + threadIdx.x) * SSQW; float sa = 0.f, sb = 0.f;
#pragma unroll
            for (int i = 0; i < 8; ++i) { const f32x4 v = *(const f32x4*)(sp + 4 * i); sa += (v[0] + v[1]) + (v[2] + v[3]); }
#pragma unroll
            for (int i = 8; i < 10; ++i) { const f32x4 v = *(const f32x4*)(sp + 4 * i); sb += (v[0] + v[1]) + (v[2] + v[3]); }
            const float ra = rsqrtf(sa * (1.0f / 512.0f) + EPS), rb = rsqrtf(sb * (1.0f / 512.0f) + EPS);
            tab[threadIdx.x] = (f32x2){ra / rb, rb};
        }
    }
    __device__ __forceinline__ void midscale(f32x4 (&acc)[2][2][4][2], int wr, int fr, int ui, LAS unsigned char* lds) const {
        const LAS f32x2* tab = (const LAS f32x2*)(lds + tab_off) + (ui & 1) * 256;
#pragma unroll
        for (int ai = 0; ai < 2; ++ai)
#pragma unroll
            for (int m = 0; m < 4; ++m) { const float s = tab[ai * HALF + wr * 64 + m * 16 + fr].x;
#pragma unroll
                for (int bj = 0; bj < 2; ++bj)
#pragma unroll
                    for (int n = 0; n < 2; ++n) acc[ai][bj][m][n] = acc[ai][bj][m][n] * s; }
    }
    __device__ __forceinline__ void operator()(const f32x4 (&acc)[2][2][4][2], const Unit& u, int wr, int wc, int fr, int fq, int ui, LAS unsigned char* lds) const {
        const LAS f32x2* tab = (const LAS f32x2*)(lds + tab_off) + (ui & 1) * 256;
        const int row0 = u.pm * BM + wr * 64 + fr, col0 = u.pn * BM + wc * 32 + 4 * fq;
#pragma unroll
        for (int ai = 0; ai < 2; ++ai)
#pragma unroll
            for (int m = 0; m < 4; ++m) { const float s = tab[ai * HALF + wr * 64 + m * 16 + fr].y; const size_t ro = (size_t)(row0 + ai * HALF + m * 16) * D + col0;
#pragma unroll
                for (int bj = 0; bj < 2; ++bj)
#pragma unroll
                    for (int n = 0; n < 2; ++n) { const f32x4 xv = *(const f32x4*)(x + ro + bj * HALF + n * 16); const f32x4 hv = xv + acc[ai][bj][m][n] * s;
                        *(f32x4*)(h + ro + bj * HALF + n * 16) = hv; *(u32x2*)(hb + ro + bj * HALF + n * 16) = (u32x2){cvt_pk_bf16(hv[0], hv[1]), cvt_pk_bf16(hv[2], hv[3])}; } }
    }
};

template <int MODE>
struct MoeOrder {
    const bf16_t* A; const bf16_t* Bt; const int* tok_list; const LAS int* meta; int K, G, c, ntiles;
    __device__ __forceinline__ bool next(int i, Unit& u) const {
        const int L = i * G + c; if (L >= ntiles * 4) return false;
        const int mt = L >> 2; int e = 0;
#pragma unroll
        for (int j = 1; j < NE; ++j) e += (mt >= meta[j]) ? 1 : 0;
        u.pm = mt; u.pn = L & 3; u.e = e; u.rows = meta[32 + e] - (mt - meta[e]) * BM; return true;
    }
    __device__ __forceinline__ void addr(const Unit& u, const int (&RA)[2], const int (&CA)[2], const char*& aBase, const char*& bBase, unsigned (&va)[2][2]) const {
        aBase = (const char*)A; bBase = (const char*)Bt + ((size_t)u.e * D + (size_t)u.pn * BM) * K * 2;
        const int slot0 = (u.pm - meta[u.e]) * BM;
#pragma unroll
        for (int h = 0; h < 2; ++h)
#pragma unroll
            for (int i = 0; i < 2; ++i) {
                const int r = h * HALF + RA[i];
                if (MODE == 0) { int tok = 0; if (r < u.rows) tok = tok_list[u.e * T + slot0 + r] >> 1; va[h][i] = (unsigned)(((size_t)tok * K + CA[i]) * 2); }
                else va[h][i] = (unsigned)(((size_t)(u.pm * BM + r) * K + CA[i]) * 2);
            }
    }
};
struct EpiHid {
    static constexpr bool PERM = true, MIDSCALE = false;
    bf16_t* hid; const float* r_list; const LAS int* meta;
    __device__ __forceinline__ void prepare(const Unit&, int, LAS unsigned char*) const {}
    __device__ __forceinline__ void midscale(f32x4 (&)[2][2][4][2], int, int, int, LAS unsigned char*) const {}
    __device__ __forceinline__ void operator()(const f32x4 (&acc)[2][2][4][2], const Unit& u, int wr, int wc, int fr, int fq, int, LAS unsigned char*) const {
        const int row0 = u.pm * BM + wr * 64 + fr, j0 = u.pn * 128 + wc * 16 + 4 * fq, slot0 = (u.pm - meta[u.e]) * BM;
#pragma unroll
        for (int ai = 0; ai < 2; ++ai)
#pragma unroll
            for (int m = 0; m < 4; ++m) { bf16_t* rowp = hid + (size_t)(row0 + ai * HALF + m * 16) * DFF + j0;
                const int r = ai * HALF + wr * 64 + m * 16 + fr; const float rs = (r < u.rows) ? r_list[u.e * T + slot0 + r] : 0.f;
#pragma unroll
                for (int bj = 0; bj < 2; ++bj) { const f32x4 g = acc[ai][bj][m][0] * rs, up = acc[ai][bj][m][1] * rs; float hv[4];
#pragma unroll
                    for (int q = 0; q < 4; ++q) hv[q] = g[q] * up[q] * __builtin_amdgcn_rcpf(1.0f + __expf(-g[q]));
                    *(u32x2*)(rowp + bj * 64) = (u32x2){cvt_pk_bf16(hv[0], hv[1]), cvt_pk_bf16(hv[2], hv[3])}; } }
    }
};
struct EpiY {
    static constexpr bool PERM = true, MIDSCALE = false;
    bf16_t* y2; const int* tok_list; const float* w_list; const LAS int* meta;
    __device__ __forceinline__ void prepare(const Unit&, int, LAS unsigned char*) const {}
    __device__ __forceinline__ void midscale(f32x4 (&)[2][2][4][2], int, int, int, LAS unsigned char*) const {}
    __device__ __forceinline__ void operator()(const f32x4 (&acc)[2][2][4][2], const Unit& u, int wr, int wc, int fr, int fq, int, LAS unsigned char*) const {
        const int slot0 = (u.pm - meta[u.e]) * BM, col0 = u.pn * BM + wc * 32 + 8 * fq;
#pragma unroll
        for (int ai = 0; ai < 2; ++ai)
#pragma unroll
            for (int m = 0; m < 4; ++m) { const int r = ai * HALF + wr * 64 + m * 16 + fr;
                if (r < u.rows) { const int dst = tok_list[u.e * T + slot0 + r]; const float w = w_list[u.e * T + slot0 + r]; bf16_t* rowp = y2 + (size_t)dst * D + col0;
#pragma unroll
                    for (int bj = 0; bj < 2; ++bj) { const f32x4 v0 = acc[ai][bj][m][0] * w, v1 = acc[ai][bj][m][1] * w;
                        u32x4 o; o.x = cvt_pk_bf16(v0[0], v0[1]); o.y = cvt_pk_bf16(v0[2], v0[3]); o.z = cvt_pk_bf16(v1[0], v1[1]); o.w = cvt_pk_bf16(v1[2], v1[3]);
                        *(u32x4*)(rowp + bj * HALF) = o; } } }
    }
};
}

struct RowId { int off; __device__ __forceinline__ int operator()(int n) const { return off + n; } };
struct RowGU { int up; __device__ __forceinline__ int operator()(int j) const { return (j >> 2) * 8 + (j & 3) + 4 * up; } };

struct TItem { const float* src; const float* gp; bf16_t* dst; int N, K, rmk; };
__device__ __forceinline__ TItem p0_decode(const Params& p, int it) {
    constexpr int I_IN = (D / 64) * (INW / 32), I_OUT = (D / 64) * (D / 32), I_G = (D / 64) * (DFF / 32), I_D = (DFF / 64) * (D / 32), I_E = 2 * I_G + I_D;
    const float* W; const float* g; bf16_t* WT; int K, N, rmk, idx;
    if (it < I_IN) { W = p.w_in; g = p.norm1_g; WT = (bf16_t*)(p.ws + WS_WIN); K = D; N = INW; rmk = 0; idx = it; }
    else if (it < I_IN + I_OUT) { W = p.w_out; g = nullptr; WT = (bf16_t*)(p.ws + WS_WOUT); K = D; N = D; rmk = 0; idx = it - I_IN; }
    else { const int r = it - I_IN - I_OUT, e = r / I_E, q = r % I_E;
        if (q < I_G) { W = p.w_e_gate + (size_t)e * D * DFF; g = p.norm2_g; WT = (bf16_t*)(p.ws + WS_WGU) + (size_t)e * D * D; K = D; N = DFF; rmk = 1; idx = q; }
        else if (q < 2 * I_G) { W = p.w_e_up + (size_t)e * D * DFF; g = p.norm2_g; WT = (bf16_t*)(p.ws + WS_WGU) + (size_t)e * D * D; K = D; N = DFF; rmk = 2; idx = q - I_G; }
        else { W = p.w_e_down + (size_t)e * DFF * D; g = nullptr; WT = (bf16_t*)(p.ws + WS_WD) + (size_t)e * D * DFF; K = DFF; N = D; rmk = 0; idx = q - 2 * I_G; } }
    const int nblk = N / 32, kb = idx / nblk, nb = idx % nblk, k0 = 64 * kb, n0 = 32 * nb;
    TItem t; t.src = W + (size_t)k0 * N + n0; t.dst = WT + k0; t.N = N; t.K = K; t.rmk = rmk;
    t.gp = g ? g + k0 : nullptr;
    if (it >= I_IN && it < I_IN + I_OUT) t.gp = (k0 < 512) ? p.g_rec_out + k0 : p.g_att_out + (k0 - 512);
    t.rmk = rmk | (n0 << 4);
    return t;
}
__device__ __forceinline__ void p0_load(const TItem& t, f32x4 (&ld)[8], float (&gv)[8], int lane) {
#pragma unroll
    for (int i = 0; i < 8; ++i) ld[i] = *(const f32x4*)(t.src + (size_t)(8 * i + (lane >> 3)) * t.N + 4 * (lane & 7));
    if (t.gp) {
#pragma unroll
        for (int i = 0; i < 8; ++i) gv[i] = t.gp[8 * i + (lane >> 3)];
    } else {
#pragma unroll
        for (int i = 0; i < 8; ++i) gv[i] = 1.0f;
    }
}
__device__ __forceinline__ void p0_process(const TItem& t, const f32x4 (&ld)[8], const float (&gv)[8], LAS float* scr, int lane) {
#pragma unroll
    for (int i = 0; i < 8; ++i) { const int kk = 8 * i + (lane >> 3); const f32x4 v = ld[i] * gv[i];
        LAS float* d = scr + kk * 33 + 4 * (lane & 7); d[0] = v[0]; d[1] = v[1]; d[2] = v[2]; d[3] = v[3]; }
    LDS_WAIT(); asm volatile("" ::: "memory");
    const int c = lane & 7, n0 = t.rmk >> 4, rmk = t.rmk & 15;
#pragma unroll
    for (int j = 0; j < 4; ++j) { const int n = (lane >> 3) + 8 * j; const LAS float* s = scr + (8 * c) * 33 + n;
        u32x4 o; o.x = pk2(s[0 * 33], s[1 * 33]); o.y = pk2(s[2 * 33], s[3 * 33]); o.z = pk2(s[4 * 33], s[5 * 33]); o.w = pk2(s[6 * 33], s[7 * 33]);
        const int nn = n0 + n, row = (rmk == 0) ? nn : ((nn >> 2) * 8 + (nn & 3) + 4 * (rmk - 1));
        *(u32x4*)(t.dst + (size_t)row * t.K + 8 * c) = o; }
    LDS_WAIT(); asm volatile("" ::: "memory");
}

__device__ __forceinline__ void ph_prologue(const Params& p, LAS unsigned char* lds, int vcu, int G) {
    const int tid = opaque_tid(), lane = tid & 63, wave = tid >> 6;
    LAS float* scr = (LAS float*)(lds + wave * 16384);
    const int gw = vcu * NWAVES + wave, NGW = G * NWAVES;
    bf16_t* xb = (bf16_t*)(p.ws + WS_XB);
    constexpr int I_IN = (D / 64) * (INW / 32), I_OUT = (D / 64) * (D / 32), I_G = (D / 64) * (DFF / 32), I_D = (DFF / 64) * (D / 32), I_E = 2 * I_G + I_D, I_ALL = I_IN + I_OUT + NE * I_E;
    {
        int it = gw; TItem cur; f32x4 la[8]; float ga[8];
        if (it < I_ALL) { cur = p0_decode(p, it); p0_load(cur, la, ga, lane); }
        while (it < I_ALL) {
            const int nit = it + NGW; TItem nxt = cur; f32x4 lb[8]; float gb[8];
            const bool has = nit < I_ALL;
            if (has) { nxt = p0_decode(p, nit); p0_load(nxt, lb, gb, lane); }
            p0_process(cur, la, ga, scr, lane);
            if (has) { cur = nxt;
#pragma unroll
                for (int i = 0; i < 8; ++i) { la[i] = lb[i]; ga[i] = gb[i]; } }
            it = nit;
        }
    }
    {
        float* rwt = (float*)(p.ws + WS_RWT);
        for (int idx = gw * 64 + lane; idx < D * 20; idx += NGW * 64) { const int k = idx / 20, n = idx % 20;
            rwt[n * 1028 + k] = (n < 16 ? p.w_router[k * 16 + n] : p.w_group[k * 4 + n - 16]) * p.norm2_g[k]; }
    }
    for (int t = gw; t < T; t += 2 * NGW) {
        const int t2 = t + NGW; const bool has2 = t2 < T;
        const f32x4* xr = (const f32x4*)(p.x + (size_t)t * D) + lane; const f32x4* xr2 = (const f32x4*)(p.x + (size_t)(has2 ? t2 : t) * D) + lane;
        f32x4 v[4], v2[4]; float ss = 0.f, ss2 = 0.f;
#pragma unroll
        for (int j = 0; j < 4; ++j) { v[j] = xr[64 * j]; v2[j] = xr2[64 * j]; }
#pragma unroll
        for (int j = 0; j < 4; ++j) { ss += (v[j][0] * v[j][0] + v[j][1] * v[j][1]) + (v[j][2] * v[j][2] + v[j][3] * v[j][3]); ss2 += (v2[j][0] * v2[j][0] + v2[j][1] * v2[j][1]) + (v2[j][2] * v2[j][2] + v2[j][3] * v2[j][3]); }
        const float r = rsqrtf(wave_sum(ss) * (1.0f / D) + EPS), r2 = rsqrtf(wave_sum(ss2) * (1.0f / D) + EPS);
        u32x2* o8 = (u32x2*)(xb + (size_t)t * D) + lane;
#pragma unroll
        for (int j = 0; j < 4; ++j) o8[64 * j] = (u32x2){pk2(v[j][0] * r, v[j][1] * r), pk2(v[j][2] * r, v[j][3] * r)};
        if (has2) { u32x2* o82 = (u32x2*)(xb + (size_t)t2 * D) + lane;
#pragma unroll
            for (int j = 0; j < 4; ++j) o82[64 * j] = (u32x2){pk2(v2[j][0] * r2, v2[j][1] * r2), pk2(v2[j][2] * r2, v2[j][3] * r2)}; }
    }
}

__device__ void ph_rglru_gates(const Params& p, const bf16_t* z, float* a_out, float* bx_out, float* uc_s) {
    const int c = threadIdx.x;
    const int h = c >> 6, j = c & 63;
    const float sp = log1pf(expf(-p.lru_lambda[c]));
    for (int t = blockIdx.x; t < T; t += gridDim.x) {
        const int s = t % S;
        float uc = p.conv_b[c];
#pragma unroll
        for (int jj = 0; jj < 4; ++jj) { const int sp_ = s - 3 + jj; if (sp_ >= 0) uc += bf2f(z[(size_t)(t - 3 + jj) * INW + c]) * p.conv_w[jj * RW + c]; }
        __syncthreads();
        uc_s[c] = uc;
        __syncthreads();
        float ra = p.b_rg_a[c], ri = p.b_rg_x[c];
        const float* wa = p.w_rg_a + (size_t)h * RHD * RHD + j;
        const float* wx = p.w_rg_x + (size_t)h * RHD * RHD + j;
#pragma unroll 4
        for (int i = 0; i < RHD; ++i) { const float u = uc_s[h * 64 + i]; ra += u * wa[i * RHD]; ri += u * wx[i * RHD]; }
        const float r = sigmoidf_(ra), ig = sigmoidf_(ri);
        const float log_a = -8.0f * r * sp;
        a_out[(size_t)t * RW + c] = expf(log_a);
        bx_out[(size_t)t * RW + c] = sqrtf(-expm1f(2.0f * log_a)) * (ig * uc);
    }
}
__device__ void ph_scan(const float* a_in, const float* bx_in, const bf16_t* z, bf16_t* mix) {
    const int gid = blockIdx.x * blockDim.x + threadIdx.x;
    if (gid >= NB * RW) return;
    const int b = gid / RW, c = gid % RW;
    float h = 0.f;
#pragma unroll 4
    for (int s = 0; s < S; ++s) {
        const size_t t = (size_t)b * S + s;
        h = a_in[t * RW + c] * h + bx_in[t * RW + c];
        mix[t * D + c] = (bf16_t)f2bf(h * gelu_tanh(bf2f(z[t * INW + 512 + c])));
    }
}
__device__ void ph_attn_naive(const Params& p, const bf16_t* z, bf16_t* mix) {
    const int tid = threadIdx.x, hd = tid >> 6, qi = tid & 63;
    for (int item = blockIdx.x; item < NB * (S / CHUNK); item += gridDim.x) {
        const int b = item / (S / CHUNK), c = item % (S / CHUNK);
        const size_t tq = (size_t)b * S + c * CHUNK + qi;
        float q[64], o[64];
#pragma unroll
        for (int d = 0; d < 64; ++d) { q[d] = bf2f(z[tq * INW + 1024 + hd * 64 + d]) * 0.125f; o[d] = 0.f; }
        float m = -3.0e38f, l = 0.f;
        const int k_begin = (c >= LEFT) ? 0 : (LEFT - c) * CHUNK;
        for (int kk = k_begin; kk < BAND; ++kk) {
            const size_t tk = (size_t)b * S + (c - LEFT) * CHUNK + kk;
            const bf16_t* kp = z + tk * INW + 1536 + hd * 64;
            const bf16_t* vp = z + tk * INW + 2048 + hd * 64;
            float sc = 0.f;
#pragma unroll
            for (int d = 0; d < 64; ++d) sc += q[d] * bf2f(kp[d]);
            int rel = LEFT * CHUNK + qi - kk;
            rel = rel < -MAXREL ? -MAXREL : (rel > MAXREL ? MAXREL : rel);
            sc += p.rel_bias[hd * (2 * MAXREL + 1) + rel + MAXREL];
            const float mn = fmaxf(m, sc), alpha = expf(m - mn), pe = expf(sc - mn);
            l = l * alpha + pe;
#pragma unroll
            for (int d = 0; d < 64; ++d) o[d] = o[d] * alpha + pe * bf2f(vp[d]);
            m = mn;
        }
        const float inv = 1.0f / l;
#pragma unroll
        for (int d = 0; d < 64; ++d) mix[tq * D + 512 + hd * 64 + d] = (bf16_t)f2bf(o[d] * inv);
    }
}
__device__ void ph_ssq(const bf16_t* mix, float* ssq) {
    const int lane = threadIdx.x & 63, wv = threadIdx.x >> 6, nw = blockDim.x >> 6;
    for (int t = blockIdx.x * nw + wv; t < T; t += gridDim.x * nw) {
        float sa = 0.f, sb = 0.f;
        for (int i = lane; i < 512; i += 64) { const float a = bf2f(mix[(size_t)t * D + i]), b = bf2f(mix[(size_t)t * D + 512 + i]); sa += a * a; sb += b * b; }
        sa = wave_sum(sa); sb = wave_sum(sb);
        if (lane < 16) ssq[(size_t)t * SSQW + lane] = (lane == 0) ? sa : 0.f;
    }
}
__device__ void ph_router(const Params& p, const float* h, bf16_t* xn2b, int* route_e, float* route_w) {
    const int lane = threadIdx.x & 63, wv = threadIdx.x >> 6, nw = blockDim.x >> 6;
    for (int t = blockIdx.x * nw + wv; t < T; t += gridDim.x * nw) {
        const float* row = h + (size_t)t * D;
        float v[16]; float ss = 0.f;
#pragma unroll
        for (int i = 0; i < 16; ++i) { v[i] = row[lane + 64 * i]; ss += v[i] * v[i]; }
        ss = wave_sum(ss);
        const float r = rsqrtf(ss / (float)D + EPS);
#pragma unroll
        for (int i = 0; i < 16; ++i) { xn2b[(size_t)t * D + lane + 64 * i] = (bf16_t)f2bf(v[i] * r); v[i] = v[i] * r * p.norm2_g[lane + 64 * i]; }
        float lg[4], le[16];
#pragma unroll
        for (int g = 0; g < 4; ++g) lg[g] = 0.f;
#pragma unroll
        for (int e = 0; e < 16; ++e) le[e] = 0.f;
#pragma unroll
        for (int i = 0; i < 16; ++i) {
            const int k = lane + 64 * i;
            const float4 wg = *(const float4*)(p.w_group + (size_t)k * 4);
            lg[0] += v[i] * wg.x; lg[1] += v[i] * wg.y; lg[2] += v[i] * wg.z; lg[3] += v[i] * wg.w;
#pragma unroll
            for (int e4 = 0; e4 < 4; ++e4) {
                const float4 wr = *(const float4*)(p.w_router + (size_t)k * 16 + e4 * 4);
                le[e4 * 4 + 0] += v[i] * wr.x; le[e4 * 4 + 1] += v[i] * wr.y; le[e4 * 4 + 2] += v[i] * wr.z; le[e4 * 4 + 3] += v[i] * wr.w;
            }
        }
#pragma unroll
        for (int g = 0; g < 4; ++g) lg[g] = wave_sum(lg[g]) + p.b_group[g];
#pragma unroll
        for (int e = 0; e < 16; ++e) le[e] = wave_sum(le[e]) + p.b_router[e];
        float mine = 0.f;
#pragma unroll
        for (int e = 0; e < 16; ++e) mine = (lane == e) ? le[e] : mine;
        int g = 0; float best = lg[0];
#pragma unroll
        for (int i = 1; i < 4; ++i) if (lg[i] > best) { best = lg[i]; g = i; }
        float sel[4];
#pragma unroll
        for (int i = 0; i < 4; ++i) sel[i] = __shfl(mine, g * 4 + i);
        if (lane == 0) {
            float den = 0.f;
#pragma unroll
            for (int i = 0; i < 4; ++i) den += expf(lg[i] - best);
            const float pg = 1.0f / den;
            int i1 = 0; float v1 = sel[0];
#pragma unroll
            for (int i = 1; i < 4; ++i) if (sel[i] > v1) { v1 = sel[i]; i1 = i; }
            int i2 = -1; float v2 = -3.0e38f;
#pragma unroll
            for (int i = 0; i < 4; ++i) if (i != i1 && sel[i] > v2) { v2 = sel[i]; i2 = i; }
            const float e2 = expf(v2 - v1);
            const float w1 = pg / (1.0f + e2), w2 = pg * e2 / (1.0f + e2);
            route_e[t * 2 + 0] = g * 4 + i1; route_e[t * 2 + 1] = g * 4 + i2;
            route_w[t * 2 + 0] = w1; route_w[t * 2 + 1] = w2;
        }
    }
}
__device__ void ph_moe_naive(const Params& p, const float* h, const bf16_t* xn2b, const int* route_e, const float* route_w, float* out, float* lds) {
    float* xs = lds;
    float* hs = lds + 1024;
    float* red = lds + 1536;
    const int tid = threadIdx.x;
    for (int t = blockIdx.x; t < T; t += gridDim.x) {
        __syncthreads();
        xs[tid] = bf2f(xn2b[(size_t)t * D + tid]) * p.norm2_g[tid]; xs[tid + 512] = bf2f(xn2b[(size_t)t * D + tid + 512]) * p.norm2_g[tid + 512];
        __syncthreads();
        float o0 = h[(size_t)t * D + tid], o1 = h[(size_t)t * D + tid + 512];
        for (int k = 0; k < 2; ++k) {
            const int e = route_e[t * 2 + k]; const float w = route_w[t * 2 + k];
            const float* wg = p.w_e_gate + (size_t)e * D * DFF + tid;
            const float* wu = p.w_e_up + (size_t)e * D * DFF + tid;
            float ag = 0.f, au = 0.f;
#pragma unroll 8
            for (int i = 0; i < D; ++i) { const float xv = xs[i]; ag += xv * wg[(size_t)i * DFF]; au += xv * wu[(size_t)i * DFF]; }
            __syncthreads();
            hs[tid] = ag * sigmoidf_(ag) * au;
            __syncthreads();
            const float* wd = p.w_e_down + (size_t)e * DFF * D;
            float y0 = 0.f, y1 = 0.f;
#pragma unroll 8
            for (int jx = 0; jx < DFF; ++jx) { const float hv = hs[jx]; y0 += hv * wd[(size_t)jx * D + tid]; y1 += hv * wd[(size_t)jx * D + tid + 512]; }
            o0 += w * y0; o1 += w * y1;
        }
        float ss = wave_sum(o0 * o0 + o1 * o1);
        if ((tid & 63) == 0) red[tid >> 6] = ss;
        __syncthreads();
        float tot = 0.f;
#pragma unroll
        for (int i = 0; i < 8; ++i) tot += red[i];
        const float r = rsqrtf(tot / (float)D + EPS);
        out[(size_t)t * D + tid] = o0 * r * p.final_g[tid];
        out[(size_t)t * D + tid + 512] = o1 * r * p.final_g[tid + 512];
    }
}


typedef float f32x16 __attribute__((ext_vector_type(16)));
typedef short v4i16_t __attribute__((ext_vector_type(4)));
typedef __bf16 bf16x2_t __attribute__((ext_vector_type(2)));
#define MFMA32(a, b, c) __builtin_amdgcn_mfma_f32_32x32x16_bf16((a), (b), (c), 0, 0, 0)
__device__ __forceinline__ unsigned cvtpk_s(float lo, float hi) { f32x2 v = {lo, hi}; bf16x2_t b = __builtin_convertvector(v, bf16x2_t); return __builtin_bit_cast(unsigned, b); }
__device__ __forceinline__ int crow(int r, int hh) { return (r & 3) + 8 * (r >> 2) + 4 * hh; }
__device__ __forceinline__ bf16x8 pack8(const f32x16& x, int s) {
    u32x4 w; w.x = cvtpk_s(x[8 * s + 0], x[8 * s + 1]); w.y = cvtpk_s(x[8 * s + 2], x[8 * s + 3]); w.z = cvtpk_s(x[8 * s + 4], x[8 * s + 5]); w.w = cvtpk_s(x[8 * s + 6], x[8 * s + 7]);
    return __builtin_bit_cast(bf16x8, w);
}
__device__ __forceinline__ v4i16_t vtr(LAS const unsigned char* p) { return __builtin_amdgcn_ds_read_tr16_b64_v4i16((LAS v4i16_t*)p); }
constexpr float LOG2E = 1.4426950408889634f;

struct AttnCtx { LAS float* btab; LAS unsigned char* vbase; int lane, h, q32, hh, vb, vw; float bconst; unsigned kl, vl; };
__device__ __forceinline__ AttnCtx attn_setup(const Params& p, LAS unsigned char* lds, int tab_off) {
    int tid_ = threadIdx.x; asm volatile("" : "+v"(tid_));
    AttnCtx A; const int tid = tid_; A.lane = tid & 63; A.h = __builtin_amdgcn_readfirstlane(tid >> 6); A.q32 = A.lane & 31; A.hh = A.lane >> 5;
    A.btab = (LAS float*)(lds + tab_off) + A.h * 328;
    for (int i = A.lane; i < 2 * MAXREL + 1 + 64; i += 64) A.btab[i] = p.rel_bias[A.h * (2 * MAXREL + 1) + (i > 2 * MAXREL ? 2 * MAXREL : i)] * LOG2E;
    LDS_WAIT(); asm volatile("" ::: "memory");
    A.vbase = lds + A.h * 16384;
    A.vb = ((A.lane >> 4) & 1) * 32 + (A.lane & 3) * 8 + (4 * A.hh + ((A.lane & 15) >> 2)) * 128;
    A.vw = (A.lane >> 3) * 128 + (A.lane & 7) * 16;
    A.bconst = A.btab[2 * MAXREL];
    A.kl = (unsigned)((A.q32 * INW + 8 * A.hh) * 2);
    A.vl = (unsigned)(((A.lane >> 3) * INW + (A.lane & 7) * 8) * 2) + 1024u;
    return A;
}
__device__ __forceinline__ void attn_item(const AttnCtx& A, const bf16_t* z, bf16_t* mixb, float* ssq, int b, int c, int qh) {
    const int lane = A.lane, h = A.h, q32 = A.q32, hh = A.hh, vb = A.vb, vw = A.vw; LAS float* btab = A.btab; LAS unsigned char* vbase = A.vbase;
    const float bconst = A.bconst, QS = 0.125f * LOG2E; const unsigned kl = A.kl, vl = A.vl;
    {
        const int j0 = (c >= LEFT) ? 0 : LEFT - c;
        const char* kband = (const char*)z + (((long)b * S + (long)(c - LEFT) * CHUNK) * INW + 1536 + h * 64) * 2;
        {
            const int qi = qh * 32 + q32;
            const size_t tq = (size_t)b * S + c * CHUNK + qi;
            bf16x8 qf[4];
#pragma unroll
            for (int s = 0; s < 4; ++s) { const u32x4 raw = *(const u32x4*)(z + tq * INW + 1024 + h * 64 + 16 * s + 8 * hh); u32x4 w;
#pragma unroll
                for (int e = 0; e < 4; ++e) w[e] = cvtpk_s(__builtin_bit_cast(float, raw[e] << 16) * QS, __builtin_bit_cast(float, raw[e] & 0xffff0000u) * QS);
                qf[s] = __builtin_bit_cast(bf16x8, w); }
            f32x16 o0, o1;
#pragma unroll
            for (int r = 0; r < 16; ++r) { o0[r] = 0.f; o1[r] = 0.f; }
            float m_ref = 0.f, l_run = 0.f;
            constexpr float THR = 6.0f;
            u32x4 kr[8], vr[8];
            const int kw = (lane >> 3) * 128 + (((lane & 7) ^ (lane >> 3)) << 4);
            const int kfo = q32 * 128;
            {
                const char* tb = kband + (long)(64 * j0) * INW * 2;
#pragma unroll
                for (int i = 0; i < 8; ++i) { kr[i] = *(const u32x4*)(tb + ((vl - 1024u) + (unsigned)(i * 8 * INW * 2))); vr[i] = *(const u32x4*)(tb + (vl + (unsigned)(i * 8 * INW * 2))); }
#pragma unroll
                for (int i = 0; i < 8; ++i) { *(LAS u32x4*)(vbase + i * 1024 + kw) = kr[i]; *(LAS u32x4*)(vbase + 8192 + i * 1024 + vw) = vr[i]; }
            }
#pragma unroll 1
            for (int j = j0; j <= LEFT; ++j) {
                if (j < LEFT) {
                    const char* tb = kband + (long)(64 * (j + 1)) * INW * 2;
#pragma unroll
                    for (int i = 0; i < 8; ++i) { kr[i] = *(const u32x4*)(tb + ((vl - 1024u) + (unsigned)(i * 8 * INW * 2))); vr[i] = *(const u32x4*)(tb + (vl + (unsigned)(i * 8 * INW * 2))); }
                }
                bf16x8 kf[8];
#pragma unroll
                for (int kb = 0; kb < 2; ++kb)
#pragma unroll
                    for (int s = 0; s < 4; ++s) kf[kb * 4 + s] = *(const LAS bf16x8*)(vbase + kb * 4096 + kfo + (((2 * s + hh) ^ (q32 & 7)) << 4));
                f32x16 p0, p1;
                if (j <= 5) {
                    const float ci = bconst - m_ref;
#pragma unroll
                    for (int r = 0; r < 16; ++r) { p0[r] = ci; p1[r] = ci; }
                } else {
                    const LAS float* pb0 = btab + (LEFT * CHUNK + qi - 64 * j + MAXREL - 4 * hh - 27); const LAS float* pb1 = pb0 - 32;
#pragma unroll
                    for (int r = 0; r < 16; ++r) { p0[r] = pb0[27 - ((r & 3) + 8 * (r >> 2))] - m_ref; p1[r] = pb1[27 - ((r & 3) + 8 * (r >> 2))] - m_ref; }
                }
#pragma unroll
                for (int s = 0; s < 4; ++s) { p0 = MFMA32(kf[s], qf[s], p0); p1 = MFMA32(kf[4 + s], qf[s], p1); }
                float mt = fmaxf(p0[0], p1[0]);
#pragma unroll
                for (int r = 1; r < 16; ++r) mt = fmaxf(mt, fmaxf(p0[r], p1[r]));
                mt = fmaxf(mt, __shfl_xor(mt, 32));
                const bool first = (j == j0);
                const bool grow = first || (mt > THR);
                if (__any(grow)) {
                    const float d = grow ? mt : 0.f, alpha = first ? 1.0f : __builtin_amdgcn_exp2f(-d);
                    m_ref += d; l_run *= alpha;
#pragma unroll
                    for (int r = 0; r < 16; ++r) { p0[r] -= d; p1[r] -= d; o0[r] *= alpha; o1[r] *= alpha; }
                }
                float ls0 = 0.f, ls1 = 0.f;
#pragma unroll
                for (int r = 0; r < 16; ++r) { p0[r] = __builtin_amdgcn_exp2f(p0[r]); p1[r] = __builtin_amdgcn_exp2f(p1[r]); ls0 += p0[r]; ls1 += p1[r]; }
                l_run += ls0 + ls1;
                const bf16x8 pf0 = pack8(p0, 0), pf1 = pack8(p0, 1), pf2 = pack8(p1, 0), pf3 = pack8(p1, 1);
                LAS const unsigned char* vcur = vbase + 8192 + vb;
#pragma unroll
                for (int db = 0; db < 2; ++db) {
                    v4i16_t lo[4], hi[4];
#pragma unroll
                    for (int ks = 0; ks < 4; ++ks) { lo[ks] = vtr(vcur + ks * 2048 + db * 64); hi[ks] = vtr(vcur + ks * 2048 + 1024 + db * 64); }
#define VF(k) (bf16x8){lo[k][0], lo[k][1], lo[k][2], lo[k][3], hi[k][0], hi[k][1], hi[k][2], hi[k][3]}
                    if (db == 0) { o0 = MFMA32(VF(0), pf0, o0); o0 = MFMA32(VF(1), pf1, o0); o0 = MFMA32(VF(2), pf2, o0); o0 = MFMA32(VF(3), pf3, o0); }
                    else         { o1 = MFMA32(VF(0), pf0, o1); o1 = MFMA32(VF(1), pf1, o1); o1 = MFMA32(VF(2), pf2, o1); o1 = MFMA32(VF(3), pf3, o1); }
#undef VF
                }
                if (j < LEFT) {
#pragma unroll
                    for (int i = 0; i < 8; ++i) { *(LAS u32x4*)(vbase + i * 1024 + kw) = kr[i]; *(LAS u32x4*)(vbase + 8192 + i * 1024 + vw) = vr[i]; }
                }
            }
            const float lt = l_run + __shfl_xor(l_run, 32), inv = 1.0f / lt;
            float ss = 0.f;
            bf16_t* orow = mixb + tq * D + 512 + h * 64 + 4 * hh;
#pragma unroll
            for (int g = 0; g < 4; ++g) {
                const float a0 = o0[4 * g] * inv, a1 = o0[4 * g + 1] * inv, a2 = o0[4 * g + 2] * inv, a3 = o0[4 * g + 3] * inv;
                const float c0 = o1[4 * g] * inv, c1 = o1[4 * g + 1] * inv, c2 = o1[4 * g + 2] * inv, c3 = o1[4 * g + 3] * inv;
                ss += (a0 * a0 + a1 * a1) + (a2 * a2 + a3 * a3) + (c0 * c0 + c1 * c1) + (c2 * c2 + c3 * c3);
                *(u32x2*)(orow + 8 * g) = (u32x2){cvtpk_s(a0, a1), cvtpk_s(a2, a3)};
                *(u32x2*)(orow + 32 + 8 * g) = (u32x2){cvtpk_s(c0, c1), cvtpk_s(c2, c3)};
            }
            ss += __shfl_xor(ss, 32);
            if (hh == 0) ssq[tq * SSQW + 32 + h] = ss;
        }
    }
}


constexpr int RG_WT = 0, RG_IMG = 4608, RG_SEG = 22016, RG_HP = 24064, RG_ROWB = 144, RG_IROW = 272;
__device__ __forceinline__ float fast_sigmoid(float x) { return __builtin_amdgcn_rcpf(1.0f + __expf(-x)); }
__device__ __forceinline__ void rglru_item(const Params& p, const bf16_t* z, bf16_t* mixb, float* ssq, LAS unsigned char* lds, int b, int hb, int q4) {
    const int tid = opaque_tid(), lane = tid & 63, w = __builtin_amdgcn_readfirstlane(tid >> 6), ch = lane, c16 = lane & 15, tg = lane >> 4;
    LAS f32x2* seg = (LAS f32x2*)(lds + RG_SEG); LAS float* hp = (LAS float*)(lds + RG_HP);
    for (int idx = tid; idx < 64 * 32; idx += NTHR) { const int k = idx >> 5, n = idx & 31;
        const float v = (n < 16) ? p.w_rg_a[(hb * 64 + k) * 64 + 16 * q4 + n] : p.w_rg_x[(hb * 64 + k) * 64 + 16 * q4 + n - 16];
        *(LAS bf16_t*)(lds + RG_WT + n * RG_ROWB + k * 2) = (bf16_t)f2bf(v); }
    if (tid < 16) hp[tid] = 0.f;
    const int gch = hb * 64 + ch, och = hb * 64 + 16 * q4 + c16;
    const float cw0 = p.conv_w[gch], cw1 = p.conv_w[RW + gch], cw2 = p.conv_w[2 * RW + gch], cw3 = p.conv_w[3 * RW + gch], cb = p.conv_b[gch];
    const float ba = p.b_rg_a[och], bxb = p.b_rg_x[och], sp8 = -8.0f * log1pf(expf(-p.lru_lambda[och]));
    __syncthreads();
    const bf16x8 b0a = *(const LAS bf16x8*)(lds + RG_WT + c16 * RG_ROWB + tg * 16), b1a = *(const LAS bf16x8*)(lds + RG_WT + c16 * RG_ROWB + tg * 16 + 64);
    const bf16x8 b0x = *(const LAS bf16x8*)(lds + RG_WT + (16 + c16) * RG_ROWB + tg * 16), b1x = *(const LAS bf16x8*)(lds + RG_WT + (16 + c16) * RG_ROWB + tg * 16 + 64);
    LAS unsigned char* img = lds + RG_IMG;
    LAS unsigned char* trb = img + (8 * tg + (c16 >> 2)) * RG_IROW + (16 * w + 4 * (c16 & 3)) * 2;
    LAS unsigned char* ucp = img + (16 * q4 + c16) * RG_IROW + (16 * w + 4 * tg) * 2;
    const bf16_t* ucol = z + (size_t)b * S * INW + gch;
    const bf16_t* gcol = z + (size_t)b * S * INW + 512 + och;
    bf16_t un[19], gn[4];
#pragma unroll
    for (int i = 0; i < 19; ++i) { const int s = 16 * w - 3 + i; un[i] = (s >= 0) ? ucol[(long)s * INW] : (bf16_t)0; }
#pragma unroll
    for (int i = 0; i < 4; ++i) gn[i] = gcol[(long)(16 * w + 4 * tg + i) * INW];
#pragma unroll 1
    for (int blk = 0; blk < S / 128; ++blk) {
        const int par = blk & 1, t0 = blk * 128 + 16 * w;
        float uv[19], gv[4];
#pragma unroll
        for (int i = 0; i < 19; ++i) uv[i] = bf2f(un[i]);
#pragma unroll
        for (int i = 0; i < 4; ++i) gv[i] = bf2f(gn[i]);
        if (blk + 1 < S / 128) {
#pragma unroll
            for (int i = 0; i < 19; ++i) un[i] = ucol[(long)(t0 + 128 - 3 + i) * INW];
#pragma unroll
            for (int i = 0; i < 4; ++i) gn[i] = gcol[(long)(t0 + 128 + 4 * tg + i) * INW];
        }
        {
            float uc[16];
#pragma unroll
            for (int i = 0; i < 16; ++i) uc[i] = cb + cw0 * uv[i] + cw1 * uv[i + 1] + cw2 * uv[i + 2] + cw3 * uv[i + 3];
            u32x4 w0, w1;
#pragma unroll
            for (int e = 0; e < 4; ++e) { w0[e] = cvtpk_s(uc[2 * e], uc[2 * e + 1]); w1[e] = cvtpk_s(uc[8 + 2 * e], uc[9 + 2 * e]); }
            *(LAS u32x4*)(img + ch * RG_IROW + 32 * w) = w0; *(LAS u32x4*)(img + ch * RG_IROW + 32 * w + 16) = w1;
        }
        LDS_WAIT(); asm volatile("" ::: "memory");
        const v4i16_t t0lo = vtr(trb), t0hi = vtr(trb + 4 * RG_IROW), t1lo = vtr(trb + 32 * RG_IROW), t1hi = vtr(trb + 36 * RG_IROW);
        const u32x2 ucr = *(const LAS u32x2*)ucp;
        const bf16x8 a0 = (bf16x8){t0lo[0], t0lo[1], t0lo[2], t0lo[3], t0hi[0], t0hi[1], t0hi[2], t0hi[3]}, a1 = (bf16x8){t1lo[0], t1lo[1], t1lo[2], t1lo[3], t1hi[0], t1hi[1], t1hi[2], t1hi[3]};
        f32x4 acca = __builtin_amdgcn_mfma_f32_16x16x32_bf16(a0, b0a, (f32x4){0.f, 0.f, 0.f, 0.f}, 0, 0, 0); acca = __builtin_amdgcn_mfma_f32_16x16x32_bf16(a1, b1a, acca, 0, 0, 0);
        f32x4 accx = __builtin_amdgcn_mfma_f32_16x16x32_bf16(a0, b0x, (f32x4){0.f, 0.f, 0.f, 0.f}, 0, 0, 0); accx = __builtin_amdgcn_mfma_f32_16x16x32_bf16(a1, b1x, accx, 0, 0, 0);
        const float ucv[4] = {__builtin_bit_cast(float, ucr[0] << 16), __builtin_bit_cast(float, ucr[0] & 0xffff0000u), __builtin_bit_cast(float, ucr[1] << 16), __builtin_bit_cast(float, ucr[1] & 0xffff0000u)};
        float av[4], bv[4]; float H = 0.f, P = 1.f;
#pragma unroll
        for (int rg_ = 0; rg_ < 4; ++rg_) {
            const float r = fast_sigmoid(acca[rg_] + ba), ig = fast_sigmoid(accx[rg_] + bxb);
            const float a = __expf(r * sp8);
            av[rg_] = a; bv[rg_] = __builtin_amdgcn_sqrtf((1.0f - a) * (1.0f + a)) * (ig * ucv[rg_]);
            H = a * H + bv[rg_]; P *= a; }
        float cP = 1.f, cH = 0.f, Pt = 1.f, Ht = 0.f;
#pragma unroll
        for (int k = 0; k < 4; ++k) { const float Pk = __shfl(P, c16 + 16 * k), Hk = __shfl(H, c16 + 16 * k);
            cP = (k == tg) ? Pt : cP; cH = (k == tg) ? Ht : cH;
            Ht = Pk * Ht + Hk; Pt *= Pk; }
        if (tg == 0) seg[(par * 8 + w) * 16 + c16] = (f32x2){Pt, Ht};
        __syncthreads();
        float hw = hp[par * 16 + c16];
        for (int s = 0; s < w; ++s) { const f32x2 sv = seg[(par * 8 + s) * 16 + c16]; hw = sv.x * hw + sv.y; }
        float hcur = cP * hw + cH;
        bf16_t* orow = mixb + ((size_t)b * S + t0 + 4 * tg) * D + och;
        float* sq = ssq + ((size_t)b * S + t0 + 4 * tg) * SSQW + hb * 4 + q4;
        float ys[4];
#pragma unroll
        for (int i = 0; i < 4; ++i) { hcur = av[i] * hcur + bv[i];
            const float g = gv[i], u2 = 1.5957691216057308f * (g + 0.044715f * g * g * g);
            const float y = hcur * g * fast_sigmoid(u2);
            orow[(size_t)i * D] = (bf16_t)(cvtpk_s(y, y) & 0xffffu); ys[i] = y * y; }
#pragma unroll
        for (int i = 0; i < 4; ++i) { ys[i] += __shfl_xor(ys[i], 1); }
#pragma unroll
        for (int i = 0; i < 4; ++i) { ys[i] += __shfl_xor(ys[i], 2); }
#pragma unroll
        for (int i = 0; i < 4; ++i) { ys[i] += __shfl_xor(ys[i], 4); }
#pragma unroll
        for (int i = 0; i < 4; ++i) { ys[i] += __shfl_xor(ys[i], 8); }
        if (c16 == 0) {
#pragma unroll
            for (int i = 0; i < 4; ++i) sq[(size_t)i * SSQW] = ys[i]; }
        if (w == 7 && tg == 3) hp[(par ^ 1) * 16 + c16] = hcur;
    }
}

constexpr int RT_WT = 0, RT_LDK = 1028, RT_PART = 82432, RT_SSP = 98816, RT_REC = 99328;
__device__ __forceinline__ void ph_router3(const Params& p, const float* h, int* gcount, int* tok_list, float* w_list, float* r_list, LAS unsigned char* lds) {
    const int tid = opaque_tid(), lane = tid & 63, w = __builtin_amdgcn_readfirstlane(tid >> 6), t16 = lane & 15, g = lane >> 4;
    LAS float* wt = (LAS float*)(lds + RT_WT); LAS float* part = (LAS float*)(lds + RT_PART); LAS float* ssp = (LAS float*)(lds + RT_SSP);
    LAS int* lcnt = (LAS int*)(lds + RT_REC); LAS int* lbase = lcnt + 16; LAS int* rec_e = lcnt + 32; LAS int* rec_s = lcnt + 160; LAS float* rec_w = (LAS float*)(lcnt + 288); LAS float* rec_r = (LAS float*)(lcnt + 416);
    { const f32x4* srcw = (const f32x4*)(p.ws + WS_RWT); LAS f32x4* dstw = (LAS f32x4*)wt;
      for (int idx = tid; idx < 20 * RT_LDK / 4; idx += NTHR) dstw[idx] = srcw[idx]; }
    const int task = w & 3, khalf = w >> 2, kbase = khalf * 512 + g * 128;
    for (int grp = blockIdx.x; grp < T / 64; grp += gridDim.x) {
        if (tid < 16) lcnt[tid] = 0;
        __syncthreads();
        {
            const f32x4* hrow = (const f32x4*)(h + (size_t)(grp * 64 + task * 16 + t16) * D + kbase);
            const LAS f32x4* b0p = (const LAS f32x4*)(wt + t16 * RT_LDK + kbase); const LAS f32x4* b1p = (const LAS f32x4*)(wt + (16 + (lane & 3)) * RT_LDK + kbase);
            f32x4 acc0 = {0.f, 0.f, 0.f, 0.f}, acc1 = {0.f, 0.f, 0.f, 0.f}; float ss = 0.f;
#pragma unroll 1
            for (int jb = 0; jb < 32; jb += 8) {
                f32x4 a[8];
#pragma unroll
                for (int j = 0; j < 8; ++j) a[j] = hrow[jb + j];
#pragma unroll
                for (int j = 0; j < 8; ++j) { const f32x4 b0 = b0p[jb + j], b1 = b1p[jb + j];
#pragma unroll
                    for (int q = 0; q < 4; ++q) { acc0 = __builtin_amdgcn_mfma_f32_16x16x4f32(a[j][q], b0[q], acc0, 0, 0, 0); acc1 = __builtin_amdgcn_mfma_f32_16x16x4f32(a[j][q], b1[q], acc1, 0, 0, 0); ss += a[j][q] * a[j][q]; } }
            }
            ss += __shfl_xor(ss, 16); ss += __shfl_xor(ss, 32);
            if (g == 0) ssp[khalf * 64 + task * 16 + t16] = ss;
            LAS float* pp = part + ((khalf * 4 + task) * 16 + 4 * g) * 32 + t16;
#pragma unroll
            for (int rg_ = 0; rg_ < 4; ++rg_) { pp[rg_ * 32] = acc0[rg_]; pp[rg_ * 32 + 16] = acc1[rg_]; }
        }
        __syncthreads();
        if (tid < 64) {
            const float rstd = rsqrtf((ssp[tid] + ssp[64 + tid]) * (1.0f / D) + EPS);
            const LAS float* q0 = part + tid * 32; const LAS float* q1 = part + (64 + tid) * 32;
            float lg[4];
#pragma unroll
            for (int i = 0; i < 4; ++i) lg[i] = (q0[16 + i] + q1[16 + i]) * rstd + p.b_group[i];
            int gi = 0; float best = lg[0];
#pragma unroll
            for (int i = 1; i < 4; ++i) if (lg[i] > best) { best = lg[i]; gi = i; }
            float den = 0.f;
#pragma unroll
            for (int i = 0; i < 4; ++i) den += expf(lg[i] - best);
            const float pg = 1.0f / den;
            float sel[4];
#pragma unroll
            for (int i = 0; i < 4; ++i) sel[i] = (q0[gi * 4 + i] + q1[gi * 4 + i]) * rstd + p.b_router[gi * 4 + i];
            int i1 = 0; float v1 = sel[0];
#pragma unroll
            for (int i = 1; i < 4; ++i) if (sel[i] > v1) { v1 = sel[i]; i1 = i; }
            int i2 = -1; float v2 = -3.0e38f;
#pragma unroll
            for (int i = 0; i < 4; ++i) if (i != i1 && sel[i] > v2) { v2 = sel[i]; i2 = i; }
            const float e2 = expf(v2 - v1);
            const float w1 = pg / (1.0f + e2), w2 = pg * e2 / (1.0f + e2);
            const int ea = gi * 4 + i1, eb = gi * 4 + i2;
            const int sa = __hip_atomic_fetch_add(lcnt + ea, 1, __ATOMIC_RELAXED, __HIP_MEMORY_SCOPE_WORKGROUP);
            const int sb = __hip_atomic_fetch_add(lcnt + eb, 1, __ATOMIC_RELAXED, __HIP_MEMORY_SCOPE_WORKGROUP);
            rec_e[tid * 2] = ea; rec_s[tid * 2] = sa; rec_w[tid * 2] = w1; rec_r[tid * 2] = rstd;
            rec_e[tid * 2 + 1] = eb; rec_s[tid * 2 + 1] = sb; rec_w[tid * 2 + 1] = w2; rec_r[tid * 2 + 1] = rstd;
        }
        __syncthreads();
        if (tid < 16) lbase[tid] = __hip_atomic_fetch_add(gcount + tid, lcnt[tid], __ATOMIC_RELAXED, __HIP_MEMORY_SCOPE_AGENT);
        __syncthreads();
        if (tid < 128) { const int e = rec_e[tid]; const int pos = lbase[e] + rec_s[tid]; tok_list[e * T + pos] = grp * 128 + tid; w_list[e * T + pos] = rec_w[tid]; r_list[e * T + pos] = rec_r[tid]; }
        __syncthreads();
    }
}

__device__ void ph_final(const Params& p, const float* h, const bf16_t* y2, float* out) {
    const int tid = opaque_tid(), lane = tid & 63, wv = tid >> 6, nw = NWAVES;
#if PROBE >= 100
    const unsigned long long* tsw = (const unsigned long long*)(p.ws + WS_CTL + 32768);
    const float pscale = 1.0f + (float)(tsw[PROBE - 100] - tsw[0]) * (0.01f / 2000.0f);
#else
    const float pscale = 1.0f;
#endif
    for (int t = blockIdx.x * nw + wv; t < T; t += gridDim.x * nw) {
        const f32x4* hr = (const f32x4*)(h + (size_t)t * D) + lane;
        const u32x2* y0 = (const u32x2*)(y2 + (size_t)(2 * t) * D) + lane; const u32x2* y1 = (const u32x2*)(y2 + (size_t)(2 * t + 1) * D) + lane;
        f32x4 v[4]; float ss = 0.f;
#pragma unroll
        for (int j = 0; j < 4; ++j) { const f32x4 hv = hr[64 * j]; const u32x2 a = y0[64 * j], b = y1[64 * j];
            v[j][0] = hv[0] + __builtin_bit_cast(float, a[0] << 16) + __builtin_bit_cast(float, b[0] << 16);
            v[j][1] = hv[1] + __builtin_bit_cast(float, a[0] & 0xffff0000u) + __builtin_bit_cast(float, b[0] & 0xffff0000u);
            v[j][2] = hv[2] + __builtin_bit_cast(float, a[1] << 16) + __builtin_bit_cast(float, b[1] << 16);
            v[j][3] = hv[3] + __builtin_bit_cast(float, a[1] & 0xffff0000u) + __builtin_bit_cast(float, b[1] & 0xffff0000u);
            ss += (v[j][0] * v[j][0] + v[j][1] * v[j][1]) + (v[j][2] * v[j][2] + v[j][3] * v[j][3]); }
        const float r = rsqrtf(wave_sum(ss) * (1.0f / D) + EPS);
        f32x4* orow = (f32x4*)(out + (size_t)t * D) + lane;
#pragma unroll
        for (int j = 0; j < 4; ++j) { const f32x4 gf = *((const f32x4*)p.final_g + lane + 64 * j); orow[64 * j] = v[j] * r * gf * pscale; }
    }
}


__device__ __forceinline__ void ph_mixers(const Params& p, const bf16_t* z, bf16_t* mixb, float* ssq, LAS unsigned char* lds, unsigned* qctr) {
    const AttnCtx A = attn_setup(p, lds, TAB_OFF);
    volatile LAS int* qword = (volatile LAS int*)(lds + TAB_OFF + 12288);
    constexpr int NQ = NB, QITEMS = 32 + 64;
    for (int qq = 0; qq < NQ; ++qq) {
        const int q = (blockIdx.x + qq) % NQ;
        for (;;) {
            __syncthreads();
            if (threadIdx.x == 0) *qword = (int)__hip_atomic_fetch_add(qctr + 64 * q, 1u, __ATOMIC_RELAXED, __HIP_MEMORY_SCOPE_AGENT);
            __syncthreads();
            const int idx = *qword;
            if (idx >= QITEMS) break;
            if (idx < 32) { rglru_item(p, z, mixb, ssq, lds, q, idx >> 2, idx & 3);
#if PROBE == 31
                __syncthreads(); rglru_item(p, z, mixb, ssq, lds, q, idx >> 2, idx & 3);
#endif
            } else { const int a = idx - 32;
#if PROBE == 32
#pragma unroll 1
                for (int rep_ = 0; rep_ < 2; ++rep_)
#endif
                attn_item(A, z, mixb, ssq, q, 31 - (a >> 1), a & 1);
            }
        }
    }
}


#define XB_TMO      128
#define XB_XCNT(j)  (256  + 64 * (j))
#define XB_XSUB(j)  (1280 + 64 * (j))
#define XB_XGEN(j)  (2304 + 64 * (j))
#define XB_TOP      3328
#define XB_TOPGEN   3392
#define XCD_BAR_WORDS 3456
#define XB_SPIN_CAP (1u << 18)
__device__ __forceinline__ unsigned xb_ld(unsigned* p)              { return __hip_atomic_load(p, __ATOMIC_RELAXED, __HIP_MEMORY_SCOPE_AGENT); }
__device__ __forceinline__ unsigned xb_add(unsigned* p, unsigned v) { return __hip_atomic_fetch_add(p, v, __ATOMIC_RELAXED, __HIP_MEMORY_SCOPE_AGENT); }
__device__ __forceinline__ unsigned xb_xcc_id() { return (unsigned)__builtin_amdgcn_s_getreg((3 << 11) | 20) & 0xFu; }
#define XB_SPIN(cond, bar) do { unsigned _sp = 0; while (cond) { __builtin_amdgcn_s_sleep(1); \
    if ((++_sp & 255u) == 0u) { if (xb_ld(&(bar)[XB_TMO])) break; if (_sp > XB_SPIN_CAP) { atomicAdd(&(bar)[XB_TMO], 1u); break; } } } } while (0)
struct XcdBarrier { unsigned* bar; unsigned x; volatile LAS unsigned* st; };
__device__ __forceinline__ XcdBarrier xcd_barrier_post(unsigned* bar, volatile LAS unsigned* st) {
    XcdBarrier b; b.bar = bar; b.x = xb_xcc_id(); b.st = st;
    if (threadIdx.x == 0) (void)xb_add(&bar[XB_XCNT(b.x)], 1u);
    return b;
}
__device__ __forceinline__ void xcd_barrier_complete(unsigned* bar, unsigned x, unsigned& nloc, unsigned& nx) {
    const unsigned G = gridDim.x * gridDim.y * gridDim.z;
    unsigned sum, cnt, mine, sp = 0u;
    for (;;) {
        sum = 0u; cnt = 0u; mine = 0u;
#pragma unroll
        for (unsigned j = 0; j < 16; ++j) { const unsigned c = xb_ld(&bar[XB_XCNT(j)]); sum += c; cnt += (c > 0u) ? 1u : 0u; mine = (j == x) ? c : mine; }
        if (sum == G) break;
        __builtin_amdgcn_s_sleep(1);
        if ((++sp & 255u) == 0u) { if (xb_ld(&bar[XB_TMO])) break; if (sp > XB_SPIN_CAP) { atomicAdd(&bar[XB_TMO], 1u); break; } }
    }
    nloc = mine > 0u ? mine : 1u; nx = cnt > 0u ? cnt : 1u;
}
__device__ __forceinline__ void xcd_barrier(const XcdBarrier& b) {
    asm volatile("s_waitcnt vmcnt(0)" ::: "memory");
    __syncthreads();
    if (threadIdx.x == 0) {
        unsigned* bar = b.bar;
        __builtin_amdgcn_s_waitcnt(0);
        unsigned nloc = b.st[0], nx = b.st[1];
        if (nloc == 0u) { xcd_barrier_complete(bar, b.x, nloc, nx); b.st[0] = nloc; b.st[1] = nx; }
        const unsigned old = xb_add(&bar[XB_XSUB(b.x)], 1u);
        const unsigned gen = old / nloc;
        if (old + 1u == (gen + 1u) * nloc) {
            __builtin_amdgcn_fence(__ATOMIC_RELEASE, "agent");
            asm volatile("s_waitcnt vmcnt(0)" ::: "memory");
            const unsigned og = xb_add(&bar[XB_TOP], 1u);
            const unsigned tg = og / nx;
            if (og + 1u == (tg + 1u) * nx) xb_add(&bar[XB_TOPGEN], 1u);
            else XB_SPIN(xb_ld(&bar[XB_TOPGEN]) == tg, bar);
            __builtin_amdgcn_fence(__ATOMIC_ACQUIRE, "agent");
            xb_add(&bar[XB_XGEN(b.x)], 1u);
            asm volatile("s_waitcnt vmcnt(0)" ::: "memory");
        } else {
            XB_SPIN(xb_ld(&bar[XB_XGEN(b.x)]) == gen, bar);
            __builtin_amdgcn_fence(__ATOMIC_ACQUIRE, "agent");
            asm volatile("s_waitcnt vmcnt(0)" ::: "memory");
        }
    }
    __syncthreads();
}


__global__ void __launch_bounds__(NTHR) k_mega(Params p) {
    extern __shared__ __attribute__((aligned(16))) unsigned char lds_raw[];
    LAS unsigned char* lds = (LAS unsigned char*)lds_raw;
    cg::grid_group grid = cg::this_grid();
    const int G = gridDim.x; const int bx = blockIdx.x;
    volatile LAS unsigned* misc = (volatile LAS unsigned*)(lds + MISC_OFF);
    if (threadIdx.x < 64) misc[threadIdx.x] = 0u;
    __syncthreads();
    const XcdBarrier xbar = xcd_barrier_post((unsigned*)(p.ws + WS_CTL + 65536), misc + 8);
    const int vcu = (G % 8 == 0) ? (bx % 8) * (G / 8) + bx / 8 : bx;
#if PROBE >= 100
    unsigned long long* tsw = (unsigned long long*)(p.ws + WS_CTL + 32768); int tsn = 0;
#define TSTAMP() do { if (blockIdx.x == 0 && threadIdx.x == 0) tsw[tsn] = __builtin_amdgcn_s_memrealtime(); ++tsn; } while (0)
    TSTAMP();
#else
#define TSTAMP() do {} while (0)
#endif
    bf16_t* win_t = (bf16_t*)(p.ws + WS_WIN); bf16_t* wout_t = (bf16_t*)(p.ws + WS_WOUT);
    bf16_t* xb = (bf16_t*)(p.ws + WS_XB); bf16_t* zb = (bf16_t*)(p.ws + WS_Z); bf16_t* mixb = (bf16_t*)(p.ws + WS_MIX);
    float* ssq = (float*)(p.ws + WS_SSQ);
    float* a_ = (float*)(p.ws + WS_XB); float* bx_ = (float*)(p.ws + WS_HID);
    bf16_t* xn2b = (bf16_t*)(p.ws + WS_XB);
    int* route_e = (int*)(p.ws + WS_ROUTE); float* route_w = (float*)(p.ws + WS_ROUTE + (size_t)T * 2 * 4);
    float* h = p.out;

    ph_prologue(p, lds, vcu, G);
#if PROBE == 1
    ph_prologue(p, lds, vcu, G); ph_prologue(p, lds, vcu, G);
#endif
    if (p.ws == nullptr) grid.sync();
    xcd_barrier(xbar);
    TSTAMP();
    {
        pg8::DenseOrder So; So.init(xb, win_t, T, INW, D, G, bx);
        pg8::EpiZ E{zb, INW};
        pg8::gemm_phase(lds, D, So, E);
#if PROBE == 2
        pg8::gemm_phase(lds, D, So, E); pg8::gemm_phase(lds, D, So, E);
#endif
    }
    xcd_barrier(xbar);
    TSTAMP();
    ph_mixers(p, zb, mixb, ssq, lds, (unsigned*)(p.ws + WS_CTL + 8192));
#if PROBE == 3
    ph_mixers(p, zb, mixb, ssq, lds, (unsigned*)(p.ws + WS_CTL + 8192 + 2048)); ph_mixers(p, zb, mixb, ssq, lds, (unsigned*)(p.ws + WS_CTL + 8192 + 4096));
#endif
    xcd_barrier(xbar);
    TSTAMP();
    {
        pg8::DenseOrder So; So.init(mixb, wout_t, T, D, D, G, bx);
        pg8::EpiH E{ssq, p.x, h, xn2b, TAB_OFF};
        pg8::gemm_phase(lds, D, So, E);
#if PROBE == 4
        pg8::gemm_phase(lds, D, So, E); pg8::gemm_phase(lds, D, So, E);
#endif
    }
    xcd_barrier(xbar);
    TSTAMP();
    int* gcount = (int*)(p.ws + WS_CTL + 4096); int* tok_list = (int*)(p.ws + WS_LIST); float* w_list = (float*)(p.ws + WS_LIST + MiB);
    bf16_t* wgu_t = (bf16_t*)(p.ws + WS_WGU); bf16_t* wd_t = (bf16_t*)(p.ws + WS_WD); bf16_t* hid = (bf16_t*)(p.ws + WS_HID); bf16_t* y2 = (bf16_t*)(p.ws + WS_Z);
    float* r_list = (float*)(p.ws + WS_ROUTE);
    ph_router3(p, h, gcount, tok_list, w_list, r_list, lds);
#if PROBE == 5
    ph_router3(p, h, (int*)(p.ws + WS_CTL + 16384), (int*)(p.ws + WS_HID), (float*)(p.ws + WS_HID + MiB), (float*)(p.ws + WS_HID + 2 * MiB), lds);
    ph_router3(p, h, (int*)(p.ws + WS_CTL + 16384 + 256), (int*)(p.ws + WS_HID + 4 * MiB), (float*)(p.ws + WS_HID + 5 * MiB), (float*)(p.ws + WS_HID + 6 * MiB), lds);
#endif
    xcd_barrier(xbar);
    TSTAMP();
    LAS int* meta = (LAS int*)(lds + META_OFF);
    if (threadIdx.x == 0) { int base = 0; for (int e = 0; e < NE; ++e) { const int cnt = gcount[e]; meta[e] = base; meta[32 + e] = cnt; base += (cnt + 255) >> 8; } meta[16] = base; }
    __syncthreads();
    const int ntiles = meta[16];
    {
        pg8::MoeOrder<0> So{xn2b, wgu_t, tok_list, meta, D, G, bx, ntiles};
        pg8::EpiHid E{hid, r_list, meta};
        pg8::gemm_phase(lds, D, So, E);
#if PROBE == 6
        pg8::gemm_phase(lds, D, So, E); pg8::gemm_phase(lds, D, So, E);
#endif
    }
    xcd_barrier(xbar);
    TSTAMP();
    {
        pg8::MoeOrder<1> So{hid, wd_t, tok_list, meta, DFF, G, bx, ntiles};
        pg8::EpiY E{y2, tok_list, w_list, meta};
        pg8::gemm_phase(lds, DFF, So, E);
#if PROBE == 7
        pg8::gemm_phase(lds, DFF, So, E); pg8::gemm_phase(lds, DFF, So, E);
#endif
    }
    xcd_barrier(xbar);
    TSTAMP();
#if PROBE == 8
    ph_final(p, h, y2, (float*)(p.ws + WS_MIX)); ph_final(p, h, y2, (float*)(p.ws + WS_MIX));
#endif
    ph_final(p, h, y2, p.out);
}

extern "C" void kernel_launch(void* const* d_in, const int* in_sizes, int n_in, void* d_out, int out_size, void* d_ws, size_t ws_size, hipStream_t stream) {
    static int grid_blocks = 0;
    if (!grid_blocks) {
        if (ws_size < WS_END) { fprintf(stderr, "kernel_launch: workspace too small (%zu < %zu)\n", ws_size, (size_t)WS_END); grid_blocks = -1; return; }
        int dev = 0, cus = 0, per_cu = 0;
        (void)hipGetDevice(&dev);
        (void)hipDeviceGetAttribute(&cus, hipDeviceAttributeMultiprocessorCount, dev);
        (void)hipFuncSetAttribute((const void*)k_mega, hipFuncAttributeMaxDynamicSharedMemorySize, LDS_BYTES);
        (void)hipOccupancyMaxActiveBlocksPerMultiprocessor(&per_cu, (const void*)k_mega, NTHR, LDS_BYTES);
        if (per_cu < 1) { fprintf(stderr, "kernel_launch: occupancy query says %d blocks per CU\n", per_cu); per_cu = 1; }
        grid_blocks = cus;
    }
    if (grid_blocks < 0) return;
    Params p{};
    const float** f = (const float**)&p;
    for (int i = 0; i < 23; ++i) f[i] = (const float*)d_in[i];
    p.out = (float*)d_out;
    p.ws = (unsigned char*)d_ws;
    (void)hipMemsetAsync((char*)d_ws + WS_CTL, 0, CTL_BYTES, stream);
    void* args[] = {&p};
    hipError_t e = hipLaunchCooperativeKernel((void*)k_mega, dim3(grid_blocks), dim3(NTHR), args, LDS_BYTES, stream);
    if (e != hipSuccess) fprintf(stderr, "cooperative launch failed: %s (grid %d)\n", hipGetErrorString(e), grid_blocks);
}
```

```cpp
#include <hip/hip_runtime.h>
#include <hip/hip_cooperative_groups.h>
#include <cstdio>
#include <cstdint>
namespace cg = cooperative_groups;

#ifndef PROBE
#define PROBE_SHIFT 0.0f
#define PROBE 0
#endif

#define LAS __attribute__((address_space(3)))
typedef unsigned short bf16_t;
typedef short bf16x8 __attribute__((ext_vector_type(8)));
typedef float f32x4 __attribute__((ext_vector_type(4)));
typedef float f32x2 __attribute__((ext_vector_type(2)));
typedef unsigned u32x4 __attribute__((ext_vector_type(4)));
typedef unsigned u32x2 __attribute__((ext_vector_type(2)));

constexpr int D = 1024, NB = 8, S = 2048, T = NB * S;
constexpr int RW = 512, RHD = 64;
constexpr int CHUNK = 64, LEFT = 8, BAND = 576, MAXREL = 128;
constexpr int INW = 2560;
constexpr int NE = 16, DFF = 512;
constexpr float EPS = 1e-6f;
constexpr int NTHR = 512, NWAVES = 8;
constexpr int SSQW = 40;

constexpr size_t MiB = 1u << 20;
constexpr size_t WS_CTL = 0, CTL_BYTES = 2 * MiB;
constexpr size_t WS_WIN = 2 * MiB;
constexpr size_t WS_WOUT = 7 * MiB;
constexpr size_t WS_WGU = 9 * MiB;
constexpr size_t WS_WD = 41 * MiB;
constexpr size_t WS_XB = 57 * MiB;
constexpr size_t WS_Z = 89 * MiB;
constexpr size_t WS_MIX = 169 * MiB;
constexpr size_t WS_HID = 201 * MiB;
constexpr size_t WS_SSQ = 237 * MiB;
constexpr size_t WS_LIST = 240 * MiB;
constexpr size_t WS_ROUTE = 242 * MiB;
constexpr size_t WS_RWT = 243 * MiB;
constexpr size_t WS_GWT = 244 * MiB;
constexpr size_t WS_END = 245 * MiB;

constexpr int RING_BYTES = 131072, TAB_OFF = RING_BYTES, META_OFF = RING_BYTES + 4096, MISC_OFF = RING_BYTES + 15360, LDS_BYTES = 147456;

struct Params {
    const float *x, *norm1_g, *w_in, *conv_w, *conv_b, *w_rg_a, *b_rg_a, *w_rg_x, *b_rg_x, *lru_lambda, *rel_bias,
        *g_rec_out, *g_att_out, *w_out, *norm2_g, *w_group, *b_group, *w_router, *b_router, *w_e_gate, *w_e_up, *w_e_down, *final_g;
    float* out;
    unsigned char* ws;
};

__device__ __forceinline__ float wave_sum(float v) {
#pragma unroll
    for (int o = 32; o > 0; o >>= 1) v += __shfl_xor(v, o);
    return v;
}
__device__ __forceinline__ float sigmoidf_(float x) { return 1.0f / (1.0f + expf(-x)); }
__device__ __forceinline__ float gelu_tanh(float x) { return 0.5f * x * (1.0f + tanhf(0.7978845608028654f * (x + 0.044715f * x * x * x))); }
__device__ __forceinline__ unsigned f2bf(float f) { unsigned u = __builtin_bit_cast(unsigned, f); return (u + 0x7fffu + ((u >> 16) & 1u)) >> 16; }
__device__ __forceinline__ unsigned pk2(float lo, float hi) { return f2bf(lo) | (f2bf(hi) << 16); }
__device__ __forceinline__ float bf2f(bf16_t b) { return __builtin_bit_cast(float, ((unsigned)b) << 16); }
__device__ __forceinline__ unsigned cvt_pk_bf16(float lo, float hi) { unsigned r; asm volatile("v_cvt_pk_bf16_f32 %0, %1, %2" : "=v"(r) : "v"(lo), "v"(hi)); return r; }
#define LDS_WAIT() asm volatile("s_waitcnt lgkmcnt(0)" ::: "memory")
__device__ __forceinline__ int opaque_tid() { int t = threadIdx.x; asm volatile("" : "+v"(t)); return t; }

namespace pg8 {
constexpr int BM = 256, BK = 64, HALF = 128, HTB = HALF * BK * 2, STAGE_BYTES = 8 * HTB, NXCD = 8, WGM = 8;
__device__ __forceinline__ int lds_byte(int r, int c) { const int st = (r >> 4) * 2 + (c >> 5), rr = r & 15, cc = c & 31, ob = rr * 64 + cc * 2; return st * 1024 + (ob ^ (((ob >> 9) & 1) << 5)); }
__device__ __forceinline__ void stage_rc(int b, int& R, int& C) { const int st = b / 1024, sb = b % 1024, swz = sb ^ (((sb >> 9) & 1) << 5); R = (st >> 1) * 16 + swz / 64; C = (st & 1) * 32 + (swz % 64) / 2; }
__device__ __forceinline__ int perm32(int rho) { const int n = rho >> 4, i = rho & 15; return 8 * (i >> 2) + 4 * n + (i & 3); }

struct Unit { int pm, pn, e, rows; };

struct DenseOrder {
    const bf16_t* A; const bf16_t* Bt; int K; int nM, nN, nwg, G, c;
    __device__ void init(const bf16_t* A_, const bf16_t* Bt_, int M, int N, int K_, int G_, int c_) { A = A_; Bt = Bt_; K = K_; nM = M / BM; nN = N / BM; nwg = nM * nN; G = G_; c = c_; }
    __device__ __forceinline__ bool next(int i, Unit& u) const {
        const long L = (long)i * G + c; if (L >= nwg) return false;
        int wgid = (int)L; { const int q = nwg / NXCD, r = nwg % NXCD, xcd = wgid % NXCD, off = wgid / NXCD; wgid = (xcd < r ? xcd * (q + 1) : r * (q + 1) + (xcd - r) * q) + off; }
        const int nig = WGM * nN, gid = wgid / nig, fm = gid * WGM, gsz = (nM - fm) < WGM ? (nM - fm) : WGM;
        u.pm = fm + ((wgid % nig) % gsz); u.pn = (wgid % nig) / gsz; u.e = 0; u.rows = BM; return true;
    }
    __device__ __forceinline__ void addr(const Unit& u, const int (&RA)[2], const int (&CA)[2], const char*& aBase, const char*& bBase, unsigned (&va)[2][2]) const {
        aBase = (const char*)A; bBase = (const char*)Bt + (size_t)u.pn * BM * K * 2;
#pragma unroll
        for (int h = 0; h < 2; ++h)
#pragma unroll
            for (int i = 0; i < 2; ++i) va[h][i] = (unsigned)(((size_t)(u.pm * BM + h * HALF + RA[i]) * K + CA[i]) * 2);
    }
};

template <class Epi, class Sched>
__device__ __forceinline__ void gemm_phase(LAS unsigned char* lds, const int K, const Sched& S, const Epi& E) {
    int tid_ = threadIdx.x; asm volatile("" : "+v"(tid_));
    const int tid = tid_, wid = __builtin_amdgcn_readfirstlane(tid >> 6), lane = tid & 63, wr = wid >> 2, wc = wid & 3, fr = lane & 15, fq = lane >> 4;
    const int nt = K / BK;
    int RA[2], CA[2]; unsigned voffB[2];
#pragma unroll
    for (int i = 0; i < 2; ++i) { int R, C; stage_rc(tid * 16 + i * 8192, R, C); RA[i] = R; CA[i] = C; const int Rb = Epi::PERM ? ((R & ~31) + perm32(R & 31)) : R; voffB[i] = (unsigned)(Rb * K + C) * 2u; }
    const size_t kstep = (size_t)(BK * 2);
    const size_t hstepB = (size_t)HALF * K * 2;
    const unsigned ldsw = (unsigned)wid * 1024u;
    const int aoff = lds_byte(wr * 64 + fr, fq * 8), boff = lds_byte(wc * 32 + fr, fq * 8);
#define PG8_SA(b, h) (((b) * 2 + (h)) * HTB)
#define PG8_SB(b, h) ((4 + (b) * 2 + (h)) * HTB)
#define PG8_STAGE_B(bufoff, gbase) do { _Pragma("unroll") for (int _i = 0; _i < 2; ++_i) \
        __builtin_amdgcn_global_load_lds((const unsigned*)((const char*)(gbase) + voffB[_i]), (LAS unsigned*)(lds + (bufoff) + ldsw + _i * 8192), 16, 0, 0); } while (0)
#define PG8_STAGE_A(bufoff, gbase, v0, v1) do { \
        __builtin_amdgcn_global_load_lds((const unsigned*)((const char*)(gbase) + (v0)), (LAS unsigned*)(lds + (bufoff) + ldsw), 16, 0, 0); \
        __builtin_amdgcn_global_load_lds((const unsigned*)((const char*)(gbase) + (v1)), (LAS unsigned*)(lds + (bufoff) + ldsw + 8192), 16, 0, 0); } while (0)
#define PG8_LDA(dst, b, h) do { _Pragma("unroll") for (int m = 0; m < 4; ++m) _Pragma("unroll") for (int k = 0; k < 2; ++k) dst[m][k] = *(const LAS bf16x8*)(lds + PG8_SA(b, h) + aoff + m * 2048 + k * 1024); } while (0)
#define PG8_LDB(dst, b, h) do { _Pragma("unroll") for (int n = 0; n < 2; ++n) _Pragma("unroll") for (int k = 0; k < 2; ++k) dst[n][k] = *(const LAS bf16x8*)(lds + PG8_SB(b, h) + boff + n * 2048 + k * 1024); } while (0)
#define PG8_MMA(ai, bj, At, Bt) do { __builtin_amdgcn_s_setprio(1); _Pragma("unroll") for (int m = 0; m < 4; ++m) _Pragma("unroll") for (int n = 0; n < 2; ++n) _Pragma("unroll") for (int k = 0; k < 2; ++k) \
        acc[ai][bj][m][n] = __builtin_amdgcn_mfma_f32_16x16x32_bf16(Bt[n][k], At[m][k], acc[ai][bj][m][n], 0, 0, 0); __builtin_amdgcn_s_setprio(0); } while (0)
#define PG8_WAIT_V(n) asm volatile("s_waitcnt vmcnt(" #n ")" ::: "memory")
#define PG8_WAIT_L(n) asm volatile("s_waitcnt lgkmcnt(" #n ")" ::: "memory")
#define PG8_BAR __builtin_amdgcn_s_barrier()
#define PG8_SCHED __builtin_amdgcn_sched_barrier(0)
    Unit cur, nxt; int ui = 0;
    if (!S.next(0, cur)) return;
    f32x4 acc[2][2][4][2];
#pragma unroll
    for (int a = 0; a < 2; ++a)
#pragma unroll
        for (int b = 0; b < 2; ++b)
#pragma unroll
            for (int m = 0; m < 4; ++m)
#pragma unroll
                for (int n = 0; n < 2; ++n) acc[a][b][m][n] = (f32x4){0.f, 0.f, 0.f, 0.f};
    bf16x8 At[4][2], B0[2][2], B1[2][2];
    const char *cA, *cB, *nA, *nB; unsigned cva[2][2], nva[2][2];
    S.addr(cur, RA, CA, cA, cB, cva);
    E.prepare(cur, ui, lds);
    PG8_STAGE_B(PG8_SB(0, 0), cB); PG8_STAGE_A(PG8_SA(0, 0), cA, cva[0][0], cva[0][1]); PG8_STAGE_B(PG8_SB(0, 1), cB + hstepB); PG8_STAGE_A(PG8_SA(0, 1), cA, cva[1][0], cva[1][1]);
    if (wr == 1) PG8_BAR;
    PG8_WAIT_V(4); PG8_BAR;
    PG8_STAGE_B(PG8_SB(1, 0), cB + kstep); PG8_STAGE_A(PG8_SA(1, 0), cA + kstep, cva[0][0], cva[0][1]); PG8_STAGE_B(PG8_SB(1, 1), cB + hstepB + kstep);
    PG8_WAIT_V(6); PG8_BAR;
    for (;;) {
        const bool has_next = S.next(ui + 1, nxt);
        if (has_next) { S.addr(nxt, RA, CA, nA, nB, nva); }
        else { nA = cA; nB = cB;
#pragma unroll
            for (int h = 0; h < 2; ++h)
#pragma unroll
                for (int i = 0; i < 2; ++i) nva[h][i] = cva[h][i]; }
        for (int t = 0; t < nt; t += 2) {
            const bool last = (t == nt - 2);
            if (Epi::MIDSCALE && t == nt / 2) E.midscale(acc, wr, fr, ui, lds);
            const char* a1 = cA + (size_t)(t + 1) * kstep;
            const char* a2 = last ? nA : cA + (size_t)(t + 2) * kstep; const char* b2 = last ? nB : cB + (size_t)(t + 2) * kstep;
            const char* a3 = a2 + kstep; const char* b3 = b2 + kstep;
            const unsigned x00 = last ? nva[0][0] : cva[0][0], x01 = last ? nva[0][1] : cva[0][1], x10 = last ? nva[1][0] : cva[1][0], x11 = last ? nva[1][1] : cva[1][1];
            if (last && has_next) E.prepare(nxt, ui + 1, lds);
            PG8_LDB(B0, 0, 0); PG8_SCHED; PG8_LDA(At, 0, 0); PG8_STAGE_A(PG8_SA(1, 1), a1, cva[1][0], cva[1][1]);
            PG8_WAIT_L(8); PG8_BAR; PG8_WAIT_L(0); PG8_MMA(0, 0, At, B0); PG8_BAR; PG8_SCHED;
            PG8_LDB(B1, 0, 1); PG8_STAGE_B(PG8_SB(0, 0), b2);
            PG8_BAR; PG8_WAIT_L(0); PG8_MMA(0, 1, At, B1); PG8_BAR;
            PG8_LDA(At, 0, 1); PG8_STAGE_A(PG8_SA(0, 0), a2, x00, x01);
            PG8_BAR; PG8_WAIT_L(0); PG8_MMA(1, 0, At, B0); PG8_BAR; PG8_SCHED;
            PG8_STAGE_B(PG8_SB(0, 1), b2 + hstepB);
            PG8_WAIT_V(6); PG8_BAR; PG8_MMA(1, 1, At, B1); PG8_BAR;
            PG8_LDB(B0, 1, 0); PG8_SCHED; PG8_LDA(At, 1, 0); PG8_STAGE_A(PG8_SA(0, 1), a2, x10, x11);
            PG8_WAIT_L(8); PG8_BAR; PG8_WAIT_L(0); PG8_MMA(0, 0, At, B0); PG8_BAR; PG8_SCHED;
            PG8_LDB(B1, 1, 1); PG8_STAGE_B(PG8_SB(1, 0), b3);
            PG8_BAR; PG8_WAIT_L(0); PG8_MMA(0, 1, At, B1); PG8_BAR;
            PG8_LDA(At, 1, 1); PG8_STAGE_A(PG8_SA(1, 0), a3, x00, x01);
            PG8_BAR; PG8_WAIT_L(0); PG8_MMA(1, 0, At, B0); PG8_BAR; PG8_SCHED;
            PG8_STAGE_B(PG8_SB(1, 1), b3 + hstepB);
            PG8_WAIT_V(6); PG8_BAR; PG8_MMA(1, 1, At, B1); PG8_BAR;
        }
        E(acc, cur, wr, wc, fr, fq, ui, lds);
        if (!has_next) break;
#pragma unroll
        for (int a = 0; a < 2; ++a)
#pragma unroll
            for (int b = 0; b < 2; ++b)
#pragma unroll
                for (int m = 0; m < 4; ++m)
#pragma unroll
                    for (int n = 0; n < 2; ++n) acc[a][b][m][n] = (f32x4){0.f, 0.f, 0.f, 0.f};
        cur = nxt; cA = nA; cB = nB; ++ui;
#pragma unroll
        for (int h = 0; h < 2; ++h)
#pragma unroll
            for (int i = 0; i < 2; ++i) cva[h][i] = nva[h][i];
    }
    PG8_WAIT_V(0);
    if (wr == 0) PG8_BAR;
    PG8_BAR;
#undef PG8_SA
#undef PG8_SB
#undef PG8_STAGE_A
#undef PG8_STAGE_B
#undef PG8_LDA
#undef PG8_LDB
#undef PG8_MMA
#undef PG8_WAIT_V
#undef PG8_WAIT_L
#undef PG8_BAR
#undef PG8_SCHED
}

struct EpiZ {
    static constexpr bool PERM = true, MIDSCALE = false;
    bf16_t* O; int ldc;
    __device__ __forceinline__ void prepare(const Unit&, int, LAS unsigned char*) const {}
    __device__ __forceinline__ void midscale(f32x4 (&)[2][2][4][2], int, int, int, LAS unsigned char*) const {}
    __device__ __forceinline__ void operator()(const f32x4 (&acc)[2][2][4][2], const Unit& u, int wr, int wc, int fr, int fq, int, LAS unsigned char*) const {
        const int row0 = u.pm * BM + wr * 64 + fr, col0 = u.pn * BM + wc * 32 + 8 * fq;
#pragma unroll
        for (int ai = 0; ai < 2; ++ai)
#pragma unroll
            for (int m = 0; m < 4; ++m) { bf16_t* rowp = O + (size_t)(row0 + ai * HALF + m * 16) * ldc + col0;
#pragma unroll
                for (int bj = 0; bj < 2; ++bj) { const f32x4 v0 = acc[ai][bj][m][0], v1 = acc[ai][bj][m][1];
                    u32x4 w; w.x = cvt_pk_bf16(v0[0], v0[1]); w.y = cvt_pk_bf16(v0[2], v0[3]); w.z = cvt_pk_bf16(v1[0], v1[1]); w.w = cvt_pk_bf16(v1[2], v1[3]);
                    *(u32x4*)(rowp + bj * HALF) = w; } }
    }
};
struct EpiH {
    static constexpr bool PERM = false, MIDSCALE = true;
    const float* ssq; const float* x; float* h; bf16_t* hb; int tab_off;
    __device__ __forceinline__ void prepare(const Unit& u, int ui, LAS unsigned char* lds) const {
        LAS f32x2* tab = (LAS f32x2*)(lds + tab_off) + (ui & 1) * 256;
        if (threadIdx.x < 256) {
            const float* sp = ssq + (size_t)(u.pm * BM + threadIdx.x) * SSQW; float sa = 0.f, sb = 0.f;
#pragma unroll
            for (int i = 0; i < 8; ++i) { const f32x4 v = *(const f32x4*)(sp + 4 * i); sa += (v[0] + v[1]) + (v[2] + v[3]); }
#pragma unroll
            for (int i = 8; i < 10; ++i) { const f32x4 v = *(const f32x4*)(sp + 4 * i); sb += (v[0] + v[1]) + (v[2] + v[3]); }
            const float ra = rsqrtf(sa * (1.0f / 512.0f) + EPS), rb = rsqrtf(sb * (1.0f / 512.0f) + EPS);
            tab[threadIdx.x] = (f32x2){ra / rb, rb};
        }
    }
    __device__ __forceinline__ void midscale(f32x4 (&acc)[2][2][4][2], int wr, int fr, int ui, LAS unsigned char* lds) const {
        const LAS f32x2* tab = (const LAS f32x2*)(lds + tab_off) + (ui & 1) * 256;
#pragma unroll
        for (int ai = 0; ai < 2; ++ai)
#pragma unroll
            for (int m = 0; m < 4; ++m) { const float s = tab[ai * HALF + wr * 64 + m * 16 + fr].x;
#pragma unroll
                for (int bj = 0; bj < 2; ++bj)
#pragma unroll
                    for (int n = 0; n < 2; ++n) acc[ai][bj][m][n] = acc[ai][bj][m][n] * s; }
    }
    __device__ __forceinline__ void operator()(const f32x4 (&acc)[2][2][4][2], const Unit& u, int wr, int wc, int fr, int fq, int ui, LAS unsigned char* lds) const {
        const LAS f32x2* tab = (const LAS f32x2*)(lds + tab_off) + (ui & 1) * 256;
        const int row0 = u.pm * BM + wr * 64 + fr, col0 = u.pn * BM + wc * 32 + 4 * fq;
#pragma unroll
        for (int ai = 0; ai < 2; ++ai)
#pragma unroll
            for (int m = 0; m < 4; ++m) { const float s = tab[ai * HALF + wr * 64 + m * 16 + fr].y; const size_t ro = (size_t)(row0 + ai * HALF + m * 16) * D + col0;
#pragma unroll
                for (int bj = 0; bj < 2; ++bj)
#pragma unroll
                    for (int n = 0; n < 2; ++n) { const f32x4 xv = *(const f32x4*)(x + ro + bj * HALF + n * 16); const f32x4 hv = xv + acc[ai][bj][m][n] * s;
                        *(f32x4*)(h + ro + bj * HALF + n * 16) = hv; *(u32x2*)(hb + ro + bj * HALF + n * 16) = (u32x2){cvt_pk_bf16(hv[0], hv[1]), cvt_pk_bf16(hv[2], hv[3])}; } }
    }
};

template <int MODE>
struct MoeOrder {
    const bf16_t* A; const bf16_t* Bt; const int* tok_list; const LAS int* meta; int K, G, c, ntiles;
    __device__ __forceinline__ bool next(int i, Unit& u) const {
        const int L = i * G + c; if (L >= ntiles * 4) return false;
        const int mt = L >> 2; int e = 0;
#pragma unroll
        for (int j = 1; j < NE; ++j) e += (mt >= meta[j]) ? 1 : 0;
        u.pm = mt; u.pn = L & 3; u.e = e; u.rows = meta[32 + e] - (mt - meta[e]) * BM; return true;
    }
    __device__ __forceinline__ void addr(const Unit& u, const int (&RA)[2], const int (&CA)[2], const char*& aBase, const char*& bBase, unsigned (&va)[2][2]) const {
        aBase = (const char*)A; bBase = (const char*)Bt + ((size_t)u.e * D + (size_t)u.pn * BM) * K * 2;
        const int slot0 = (u.pm - meta[u.e]) * BM;
#pragma unroll
        for (int h = 0; h < 2; ++h)
#pragma unroll
            for (int i = 0; i < 2; ++i) {
                const int r = h * HALF + RA[i];
                if (MODE == 0) { int tok = 0; if (r < u.rows) tok = tok_list[u.e * T + slot0 + r] >> 1; va[h][i] = (unsigned)(((size_t)tok * K + CA[i]) * 2); }
                else va[h][i] = (unsigned)(((size_t)(u.pm * BM + r) * K + CA[i]) * 2);
            }
    }
};
struct EpiHid {
    static constexpr bool PERM = true, MIDSCALE = false;
    bf16_t* hid; const float* r_list; const LAS int* meta;
    __device__ __forceinline__ void prepare(const Unit&, int, LAS unsigned char*) const {}
    __device__ __forceinline__ void midscale(f32x4 (&)[2][2][4][2], int, int, int, LAS unsigned char*) const {}
    __device__ __forceinline__ void operator()(const f32x4 (&acc)[2][2][4][2], const Unit& u, int wr, int wc, int fr, int fq, int, LAS unsigned char*) const {
        const int row0 = u.pm * BM + wr * 64 + fr, j0 = u.pn * 128 + wc * 16 + 4 * fq, slot0 = (u.pm - meta[u.e]) * BM;
#pragma unroll
        for (int ai = 0; ai < 2; ++ai)
#pragma unroll
            for (int m = 0; m < 4; ++m) { bf16_t* rowp = hid + (size_t)(row0 + ai * HALF + m * 16) * DFF + j0;
                const int r = ai * HALF + wr * 64 + m * 16 + fr; const float rs = (r < u.rows) ? r_list[u.e * T + slot0 + r] : 0.f;
#pragma unroll
                for (int bj = 0; bj < 2; ++bj) { const f32x4 g = acc[ai][bj][m][0] * rs, up = acc[ai][bj][m][1] * rs; float hv[4];
#pragma unroll
                    for (int q = 0; q < 4; ++q) hv[q] = g[q] * up[q] * __builtin_amdgcn_rcpf(1.0f + __expf(-g[q]));
                    *(u32x2*)(rowp + bj * 64) = (u32x2){cvt_pk_bf16(hv[0], hv[1]), cvt_pk_bf16(hv[2], hv[3])}; } }
    }
};
struct EpiY {
    static constexpr bool PERM = true, MIDSCALE = false;
    bf16_t* y2; const int* tok_list; const float* w_list; const LAS int* meta;
    __device__ __forceinline__ void prepare(const Unit&, int, LAS unsigned char*) const {}
    __device__ __forceinline__ void midscale(f32x4 (&)[2][2][4][2], int, int, int, LAS unsigned char*) const {}
    __device__ __forceinline__ void operator()(const f32x4 (&acc)[2][2][4][2], const Unit& u, int wr, int wc, int fr, int fq, int, LAS unsigned char*) const {
        const int slot0 = (u.pm - meta[u.e]) * BM, col0 = u.pn * BM + wc * 32 + 8 * fq;
#pragma unroll
        for (int ai = 0; ai < 2; ++ai)
#pragma unroll
            for (int m = 0; m < 4; ++m) { const int r = ai * HALF + wr * 64 + m * 16 + fr;
                if (r < u.rows) { const int dst = tok_list[u.e * T + slot0 + r]; const float w = w_list[u.e * T + slot0 + r]; bf16_t* rowp = y2 + (size_t)dst * D + col0;
#pragma unroll
                    for (int bj = 0; bj < 2; ++bj) { const f32x4 v0 = acc[ai][bj][m][0] * w, v1 = acc[ai][bj][m][1] * w;
                        u32x4 o; o.x = cvt_pk_bf16(v0[0], v0[1]); o.y = cvt_pk_bf16(v0[2], v0[3]); o.z = cvt_pk_bf16(v1[0], v1[1]); o.w = cvt_pk_bf16(v1[2], v1[3]);
                        *(u32x4*)(rowp + bj * HALF) = o; } } }
    }
};
}

struct RowId { int off; __device__ __forceinline__ int operator()(int n) const { return off + n; } };
struct RowGU { int up; __device__ __forceinline__ int operator()(int j) const { return (j >> 2) * 8 + (j & 3) + 4 * up; } };

struct TItem { const float* src; const float* gp; bf16_t* dst; int N, K, rmk; };
__device__ __forceinline__ TItem p0_decode(const Params& p, int it) {
    constexpr int I_IN = (D / 64) * (INW / 32), I_OUT = (D / 64) * (D / 32), I_G = (D / 64) * (DFF / 32), I_D = (DFF / 64) * (D / 32), I_E = 2 * I_G + I_D;
    const float* W; const float* g; bf16_t* WT; int K, N, rmk, idx;
    if (it < I_IN) { W = p.w_in; g = p.norm1_g; WT = (bf16_t*)(p.ws + WS_WIN); K = D; N = INW; rmk = 0; idx = it; }
    else if (it < I_IN + I_OUT) { W = p.w_out; g = nullptr; WT = (bf16_t*)(p.ws + WS_WOUT); K = D; N = D; rmk = 0; idx = it - I_IN; }
    else { const int r = it - I_IN - I_OUT, e = r / I_E, q = r % I_E;
        if (q < I_G) { W = p.w_e_gate + (size_t)e * D * DFF; g = p.norm2_g; WT = (bf16_t*)(p.ws + WS_WGU) + (size_t)e * D * D; K = D; N = DFF; rmk = 1; idx = q; }
        else if (q < 2 * I_G) { W = p.w_e_up + (size_t)e * D * DFF; g = p.norm2_g; WT = (bf16_t*)(p.ws + WS_WGU) + (size_t)e * D * D; K = D; N = DFF; rmk = 2; idx = q - I_G; }
        else { W = p.w_e_down + (size_t)e * DFF * D; g = nullptr; WT = (bf16_t*)(p.ws + WS_WD) + (size_t)e * D * DFF; K = DFF; N = D; rmk = 0; idx = q - 2 * I_G; } }
    const int nblk = N / 32, kb = idx / nblk, nb = idx % nblk, k0 = 64 * kb, n0 = 32 * nb;
    TItem t; t.src = W + (size_t)k0 * N + n0; t.dst = WT + k0; t.N = N; t.K = K; t.rmk = rmk;
    t.gp = g ? g + k0 : nullptr;
    if (it >= I_IN && it < I_IN + I_OUT) t.gp = (k0 < 512) ? p.g_rec_out + k0 : p.g_att_out + (k0 - 512);
    t.rmk = rmk | (n0 << 4);
    return t;
}
__device__ __forceinline__ void p0_load(const TItem& t, f32x4 (&ld)[8], float (&gv)[8], int lane) {
#pragma unroll
    for (int i = 0; i < 8; ++i) ld[i] = *(const f32x4*)(t.src + (size_t)(8 * i + (lane >> 3)) * t.N + 4 * (lane & 7));
    if (t.gp) {
#pragma unroll
        for (int i = 0; i < 8; ++i) gv[i] = t.gp[8 * i + (lane >> 3)];
    } else {
#pragma unroll
        for (int i = 0; i < 8; ++i) gv[i] = 1.0f;
    }
}
__device__ __forceinline__ void p0_process(const TItem& t, const f32x4 (&ld)[8], const float (&gv)[8], LAS float* scr, int lane) {
#pragma unroll
    for (int i = 0; i < 8; ++i) { const int kk = 8 * i + (lane >> 3); const f32x4 v = ld[i] * gv[i];
        LAS float* d = scr + kk * 33 + 4 * (lane & 7); d[0] = v[0]; d[1] = v[1]; d[2] = v[2]; d[3] = v[3]; }
    LDS_WAIT(); asm volatile("" ::: "memory");
    const int c = lane & 7, n0 = t.rmk >> 4, rmk = t.rmk & 15;
#pragma unroll
    for (int j = 0; j < 4; ++j) { const int n = (lane >> 3) + 8 * j; const LAS float* s = scr + (8 * c) * 33 + n;
        u32x4 o; o.x = pk2(s[0 * 33], s[1 * 33]); o.y = pk2(s[2 * 33], s[3 * 33]); o.z = pk2(s[4 * 33], s[5 * 33]); o.w = pk2(s[6 * 33], s[7 * 33]);
        const int nn = n0 + n, row = (rmk == 0) ? nn : ((nn >> 2) * 8 + (nn & 3) + 4 * (rmk - 1));
        *(u32x4*)(t.dst + (size_t)row * t.K + 8 * c) = o; }
    LDS_WAIT(); asm volatile("" ::: "memory");
}

__device__ __forceinline__ void ph_prologue(const Params& p, LAS unsigned char* lds, int vcu, int G) {
    const int tid = opaque_tid(), lane = tid & 63, wave = tid >> 6;
    LAS float* scr = (LAS float*)(lds + wave * 16384);
    const int gw = vcu * NWAVES + wave, NGW = G * NWAVES;
    bf16_t* xb = (bf16_t*)(p.ws + WS_XB);
    constexpr int I_IN = (D / 64) * (INW / 32), I_OUT = (D / 64) * (D / 32), I_G = (D / 64) * (DFF / 32), I_D = (DFF / 64) * (D / 32), I_E = 2 * I_G + I_D, I_ALL = I_IN + I_OUT + NE * I_E;
    {
        int it = gw; TItem cur; f32x4 la[8]; float ga[8];
        if (it < I_ALL) { cur = p0_decode(p, it); p0_load(cur, la, ga, lane); }
        while (it < I_ALL) {
            const int nit = it + NGW; TItem nxt = cur; f32x4 lb[8]; float gb[8];
            const bool has = nit < I_ALL;
            if (has) { nxt = p0_decode(p, nit); p0_load(nxt, lb, gb, lane); }
            p0_process(cur, la, ga, scr, lane);
            if (has) { cur = nxt;
#pragma unroll
                for (int i = 0; i < 8; ++i) { la[i] = lb[i]; ga[i] = gb[i]; } }
            it = nit;
        }
    }
    {
        bf16_t* gwt = (bf16_t*)(p.ws + WS_GWT); float* sp8 = (float*)(p.ws + WS_GWT + 8 * 128 * 144);
        for (int idx = gw * 64 + lane; idx < 8 * 64 * 128; idx += NGW * 64) { const int hb = idx >> 13, k = (idx >> 7) & 63, n = idx & 127;
            const float v = (n < 64) ? p.w_rg_a[(hb * 64 + k) * 64 + n] : p.w_rg_x[(hb * 64 + k) * 64 + n - 64];
            gwt[(hb * 128 + n) * 72 + k] = (bf16_t)f2bf(v); }
        for (int idx = gw * 64 + lane; idx < RW; idx += NGW * 64) sp8[idx] = -8.0f * log1pf(expf(-p.lru_lambda[idx]));
    }
    {
        float* rwt = (float*)(p.ws + WS_RWT);
        for (int idx = gw * 64 + lane; idx < D * 20; idx += NGW * 64) { const int k = idx / 20, n = idx % 20;
            rwt[n * 1028 + k] = (n < 16 ? p.w_router[k * 16 + n] : p.w_group[k * 4 + n - 16]) * p.norm2_g[k]; }
    }
    for (int t = gw; t < T; t += 2 * NGW) {
        const int t2 = t + NGW; const bool has2 = t2 < T;
        const f32x4* xr = (const f32x4*)(p.x + (size_t)t * D) + lane; const f32x4* xr2 = (const f32x4*)(p.x + (size_t)(has2 ? t2 : t) * D) + lane;
        f32x4 v[4], v2[4]; float ss = 0.f, ss2 = 0.f;
#pragma unroll
        for (int j = 0; j < 4; ++j) { v[j] = xr[64 * j]; v2[j] = xr2[64 * j]; }
#pragma unroll
        for (int j = 0; j < 4; ++j) { ss += (v[j][0] * v[j][0] + v[j][1] * v[j][1]) + (v[j][2] * v[j][2] + v[j][3] * v[j][3]); ss2 += (v2[j][0] * v2[j][0] + v2[j][1] * v2[j][1]) + (v2[j][2] * v2[j][2] + v2[j][3] * v2[j][3]); }
        const float r = rsqrtf(wave_sum(ss) * (1.0f / D) + EPS), r2 = rsqrtf(wave_sum(ss2) * (1.0f / D) + EPS);
        u32x2* o8 = (u32x2*)(xb + (size_t)t * D) + lane;
#pragma unroll
        for (int j = 0; j < 4; ++j) o8[64 * j] = (u32x2){pk2(v[j][0] * r, v[j][1] * r), pk2(v[j][2] * r, v[j][3] * r)};
        if (has2) { u32x2* o82 = (u32x2*)(xb + (size_t)t2 * D) + lane;
#pragma unroll
            for (int j = 0; j < 4; ++j) o82[64 * j] = (u32x2){pk2(v2[j][0] * r2, v2[j][1] * r2), pk2(v2[j][2] * r2, v2[j][3] * r2)}; }
    }
}

__device__ void ph_rglru_gates(const Params& p, const bf16_t* z, float* a_out, float* bx_out, float* uc_s) {
    const int c = threadIdx.x;
    const int h = c >> 6, j = c & 63;
    const float sp = log1pf(expf(-p.lru_lambda[c]));
    for (int t = blockIdx.x; t < T; t += gridDim.x) {
        const int s = t % S;
        float uc = p.conv_b[c];
#pragma unroll
        for (int jj = 0; jj < 4; ++jj) { const int sp_ = s - 3 + jj; if (sp_ >= 0) uc += bf2f(z[(size_t)(t - 3 + jj) * INW + c]) * p.conv_w[jj * RW + c]; }
        __syncthreads();
        uc_s[c] = uc;
        __syncthreads();
        float ra = p.b_rg_a[c], ri = p.b_rg_x[c];
        const float* wa = p.w_rg_a + (size_t)h * RHD * RHD + j;
        const float* wx = p.w_rg_x + (size_t)h * RHD * RHD + j;
#pragma unroll 4
        for (int i = 0; i < RHD; ++i) { const float u = uc_s[h * 64 + i]; ra += u * wa[i * RHD]; ri += u * wx[i * RHD]; }
        const float r = sigmoidf_(ra), ig = sigmoidf_(ri);
        const float log_a = -8.0f * r * sp;
        a_out[(size_t)t * RW + c] = expf(log_a);
        bx_out[(size_t)t * RW + c] = sqrtf(-expm1f(2.0f * log_a)) * (ig * uc);
    }
}
__device__ void ph_scan(const float* a_in, const float* bx_in, const bf16_t* z, bf16_t* mix) {
    const int gid = blockIdx.x * blockDim.x + threadIdx.x;
    if (gid >= NB * RW) return;
    const int b = gid / RW, c = gid % RW;
    float h = 0.f;
#pragma unroll 4
    for (int s = 0; s < S; ++s) {
        const size_t t = (size_t)b * S + s;
        h = a_in[t * RW + c] * h + bx_in[t * RW + c];
        mix[t * D + c] = (bf16_t)f2bf(h * gelu_tanh(bf2f(z[t * INW + 512 + c])));
    }
}
__device__ void ph_attn_naive(const Params& p, const bf16_t* z, bf16_t* mix) {
    const int tid = threadIdx.x, hd = tid >> 6, qi = tid & 63;
    for (int item = blockIdx.x; item < NB * (S / CHUNK); item += gridDim.x) {
        const int b = item / (S / CHUNK), c = item % (S / CHUNK);
        const size_t tq = (size_t)b * S + c * CHUNK + qi;
        float q[64], o[64];
#pragma unroll
        for (int d = 0; d < 64; ++d) { q[d] = bf2f(z[tq * INW + 1024 + hd * 64 + d]) * 0.125f; o[d] = 0.f; }
        float m = -3.0e38f, l = 0.f;
        const int k_begin = (c >= LEFT) ? 0 : (LEFT - c) * CHUNK;
        for (int kk = k_begin; kk < BAND; ++kk) {
            const size_t tk = (size_t)b * S + (c - LEFT) * CHUNK + kk;
            const bf16_t* kp = z + tk * INW + 1536 + hd * 64;
            const bf16_t* vp = z + tk * INW + 2048 + hd * 64;
            float sc = 0.f;
#pragma unroll
            for (int d = 0; d < 64; ++d) sc += q[d] * bf2f(kp[d]);
            int rel = LEFT * CHUNK + qi - kk;
            rel = rel < -MAXREL ? -MAXREL : (rel > MAXREL ? MAXREL : rel);
            sc += p.rel_bias[hd * (2 * MAXREL + 1) + rel + MAXREL];
            const float mn = fmaxf(m, sc), alpha = expf(m - mn), pe = expf(sc - mn);
            l = l * alpha + pe;
#pragma unroll
            for (int d = 0; d < 64; ++d) o[d] = o[d] * alpha + pe * bf2f(vp[d]);
            m = mn;
        }
        const float inv = 1.0f / l;
#pragma unroll
        for (int d = 0; d < 64; ++d) mix[tq * D + 512 + hd * 64 + d] = (bf16_t)f2bf(o[d] * inv);
    }
}
__device__ void ph_ssq(const bf16_t* mix, float* ssq) {
    const int lane = threadIdx.x & 63, wv = threadIdx.x >> 6, nw = blockDim.x >> 6;
    for (int t = blockIdx.x * nw + wv; t < T; t += gridDim.x * nw) {
        float sa = 0.f, sb = 0.f;
        for (int i = lane; i < 512; i += 64) { const float a = bf2f(mix[(size_t)t * D + i]), b = bf2f(mix[(size_t)t * D + 512 + i]); sa += a * a; sb += b * b; }
        sa = wave_sum(sa); sb = wave_sum(sb);
        if (lane < 16) ssq[(size_t)t * SSQW + lane] = (lane == 0) ? sa : 0.f;
    }
}
__device__ void ph_router(const Params& p, const float* h, bf16_t* xn2b, int* route_e, float* route_w) {
    const int lane = threadIdx.x & 63, wv = threadIdx.x >> 6, nw = blockDim.x >> 6;
    for (int t = blockIdx.x * nw + wv; t < T; t += gridDim.x * nw) {
        const float* row = h + (size_t)t * D;
        float v[16]; float ss = 0.f;
#pragma unroll
        for (int i = 0; i < 16; ++i) { v[i] = row[lane + 64 * i]; ss += v[i] * v[i]; }
        ss = wave_sum(ss);
        const float r = rsqrtf(ss / (float)D + EPS);
#pragma unroll
        for (int i = 0; i < 16; ++i) { xn2b[(size_t)t * D + lane + 64 * i] = (bf16_t)f2bf(v[i] * r); v[i] = v[i] * r * p.norm2_g[lane + 64 * i]; }
        float lg[4], le[16];
#pragma unroll
        for (int g = 0; g < 4; ++g) lg[g] = 0.f;
#pragma unroll
        for (int e = 0; e < 16; ++e) le[e] = 0.f;
#pragma unroll
        for (int i = 0; i < 16; ++i) {
            const int k = lane + 64 * i;
            const float4 wg = *(const float4*)(p.w_group + (size_t)k * 4);
            lg[0] += v[i] * wg.x; lg[1] += v[i] * wg.y; lg[2] += v[i] * wg.z; lg[3] += v[i] * wg.w;
#pragma unroll
            for (int e4 = 0; e4 < 4; ++e4) {
                const float4 wr = *(const float4*)(p.w_router + (size_t)k * 16 + e4 * 4);
                le[e4 * 4 + 0] += v[i] * wr.x; le[e4 * 4 + 1] += v[i] * wr.y; le[e4 * 4 + 2] += v[i] * wr.z; le[e4 * 4 + 3] += v[i] * wr.w;
            }
        }
#pragma unroll
        for (int g = 0; g < 4; ++g) lg[g] = wave_sum(lg[g]) + p.b_group[g];
#pragma unroll
        for (int e = 0; e < 16; ++e) le[e] = wave_sum(le[e]) + p.b_router[e];
        float mine = 0.f;
#pragma unroll
        for (int e = 0; e < 16; ++e) mine = (lane == e) ? le[e] : mine;
        int g = 0; float best = lg[0];
#pragma unroll
        for (int i = 1; i < 4; ++i) if (lg[i] > best) { best = lg[i]; g = i; }
        float sel[4];
#pragma unroll
        for (int i = 0; i < 4; ++i) sel[i] = __shfl(mine, g * 4 + i);
        if (lane == 0) {
            float den = 0.f;
#pragma unroll
            for (int i = 0; i < 4; ++i) den += expf(lg[i] - best);
            const float pg = 1.0f / den;
            int i1 = 0; float v1 = sel[0];
#pragma unroll
            for (int i = 1; i < 4; ++i) if (sel[i] > v1) { v1 = sel[i]; i1 = i; }
            int i2 = -1; float v2 = -3.0e38f;
#pragma unroll
            for (int i = 0; i < 4; ++i) if (i != i1 && sel[i] > v2) { v2 = sel[i]; i2 = i; }
            const float e2 = expf(v2 - v1);
            const float w1 = pg / (1.0f + e2), w2 = pg * e2 / (1.0f + e2);
            route_e[t * 2 + 0] = g * 4 + i1; route_e[t * 2 + 1] = g * 4 + i2;
            route_w[t * 2 + 0] = w1; route_w[t * 2 + 1] = w2;
        }
    }
}
__device__ void ph_moe_naive(const Params& p, const float* h, const bf16_t* xn2b, const int* route_e, const float* route_w, float* out, float* lds) {
    float* xs = lds;
    float* hs = lds + 1024;
    float* red = lds + 1536;
    const int tid = threadIdx.x;
    for (int t = blockIdx.x; t < T; t += gridDim.x) {
        __syncthreads();
        xs[tid] = bf2f(xn2b[(size_t)t * D + tid]) * p.norm2_g[tid]; xs[tid + 512] = bf2f(xn2b[(size_t)t * D + tid + 512]) * p.norm2_g[tid + 512];
        __syncthreads();
        float o0 = h[(size_t)t * D + tid], o1 = h[(size_t)t * D + tid + 512];
        for (int k = 0; k < 2; ++k) {
            const int e = route_e[t * 2 + k]; const float w = route_w[t * 2 + k];
            const float* wg = p.w_e_gate + (size_t)e * D * DFF + tid;
            const float* wu = p.w_e_up + (size_t)e * D * DFF + tid;
            float ag = 0.f, au = 0.f;
#pragma unroll 8
            for (int i = 0; i < D; ++i) { const float xv = xs[i]; ag += xv * wg[(size_t)i * DFF]; au += xv * wu[(size_t)i * DFF]; }
            __syncthreads();
            hs[tid] = ag * sigmoidf_(ag) * au;
            __syncthreads();
            const float* wd = p.w_e_down + (size_t)e * DFF * D;
            float y0 = 0.f, y1 = 0.f;
#pragma unroll 8
            for (int jx = 0; jx < DFF; ++jx) { const float hv = hs[jx]; y0 += hv * wd[(size_t)jx * D + tid]; y1 += hv * wd[(size_t)jx * D + tid + 512]; }
            o0 += w * y0; o1 += w * y1;
        }
        float ss = wave_sum(o0 * o0 + o1 * o1);
        if ((tid & 63) == 0) red[tid >> 6] = ss;
        __syncthreads();
        float tot = 0.f;
#pragma unroll
        for (int i = 0; i < 8; ++i) tot += red[i];
        const float r = rsqrtf(tot / (float)D + EPS);
        out[(size_t)t * D + tid] = o0 * r * p.final_g[tid];
        out[(size_t)t * D + tid + 512] = o1 * r * p.final_g[tid + 512];
    }
}


typedef float f32x16 __attribute__((ext_vector_type(16)));
typedef short v4i16_t __attribute__((ext_vector_type(4)));
typedef __bf16 bf16x2_t __attribute__((ext_vector_type(2)));
#define MFMA32(a, b, c) __builtin_amdgcn_mfma_f32_32x32x16_bf16((a), (b), (c), 0, 0, 0)
__device__ __forceinline__ unsigned cvtpk_s(float lo, float hi) { f32x2 v = {lo, hi}; bf16x2_t b = __builtin_convertvector(v, bf16x2_t); return __builtin_bit_cast(unsigned, b); }
__device__ __forceinline__ int crow(int r, int hh) { return (r & 3) + 8 * (r >> 2) + 4 * hh; }
__device__ __forceinline__ bf16x8 pack8(const f32x16& x, int s) {
    u32x4 w; w.x = cvtpk_s(x[8 * s + 0], x[8 * s + 1]); w.y = cvtpk_s(x[8 * s + 2], x[8 * s + 3]); w.z = cvtpk_s(x[8 * s + 4], x[8 * s + 5]); w.w = cvtpk_s(x[8 * s + 6], x[8 * s + 7]);
    return __builtin_bit_cast(bf16x8, w);
}
__device__ __forceinline__ v4i16_t vtr(LAS const unsigned char* p) { return __builtin_amdgcn_ds_read_tr16_b64_v4i16((LAS v4i16_t*)p); }
constexpr float LOG2E = 1.4426950408889634f;

struct AttnCtx { LAS float* btab; LAS unsigned char* vbase; int lane, h, q32, hh, vb, vw; float bconst; unsigned kl, vl; };
__device__ __forceinline__ AttnCtx attn_setup(const Params& p, LAS unsigned char* lds, int tab_off) {
    int tid_ = threadIdx.x; asm volatile("" : "+v"(tid_));
    AttnCtx A; const int tid = tid_; A.lane = tid & 63; A.h = __builtin_amdgcn_readfirstlane(tid >> 6); A.q32 = A.lane & 31; A.hh = A.lane >> 5;
    A.btab = (LAS float*)(lds + tab_off) + A.h * 328;
    for (int i = A.lane; i < 2 * MAXREL + 1 + 64; i += 64) A.btab[i] = p.rel_bias[A.h * (2 * MAXREL + 1) + (i > 2 * MAXREL ? 2 * MAXREL : i)] * LOG2E;
    LDS_WAIT(); asm volatile("" ::: "memory");
    A.vbase = lds + A.h * 16384;
    A.vb = ((A.lane >> 4) & 1) * 32 + (A.lane & 3) * 8 + (4 * A.hh + ((A.lane & 15) >> 2)) * 128;
    A.vw = (A.lane >> 3) * 128 + (A.lane & 7) * 16;
    A.bconst = A.btab[2 * MAXREL];
    A.kl = (unsigned)((A.q32 * INW + 8 * A.hh) * 2);
    A.vl = (unsigned)(((A.lane >> 3) * INW + (A.lane & 7) * 8) * 2) + 1024u;
    return A;
}
__device__ __forceinline__ void attn_item(const AttnCtx& A, const bf16_t* z, bf16_t* mixb, float* ssq, int b, int c, int qh) {
    const int lane = A.lane, h = A.h, q32 = A.q32, hh = A.hh, vb = A.vb, vw = A.vw; LAS float* btab = A.btab; LAS unsigned char* vbase = A.vbase;
    const float bconst = A.bconst, QS = 0.125f * LOG2E; const unsigned kl = A.kl, vl = A.vl;
    {
        const int j0 = (c >= LEFT) ? 0 : LEFT - c;
        const char* kband = (const char*)z + (((long)b * S + (long)(c - LEFT) * CHUNK) * INW + 1536 + h * 64) * 2;
        {
            const int qi = qh * 32 + q32;
            const size_t tq = (size_t)b * S + c * CHUNK + qi;
            bf16x8 qf[4];
#pragma unroll
            for (int s = 0; s < 4; ++s) { const u32x4 raw = *(const u32x4*)(z + tq * INW + 1024 + h * 64 + 16 * s + 8 * hh); u32x4 w;
#pragma unroll
                for (int e = 0; e < 4; ++e) w[e] = cvtpk_s(__builtin_bit_cast(float, raw[e] << 16) * QS, __builtin_bit_cast(float, raw[e] & 0xffff0000u) * QS);
                qf[s] = __builtin_bit_cast(bf16x8, w); }
            f32x16 o0, o1;
#pragma unroll
            for (int r = 0; r < 16; ++r) { o0[r] = 0.f; o1[r] = 0.f; }
            float m_ref = 0.f, l_run = 0.f;
            constexpr float THR = 6.0f;
            u32x4 kr[8], vr[8];
            const int kw = (lane >> 3) * 128 + (((lane & 7) ^ (lane >> 3)) << 4);
            const int kfo = q32 * 128;
            {
                const char* tb = kband + (long)(64 * j0) * INW * 2;
#pragma unroll
                for (int i = 0; i < 8; ++i) { kr[i] = *(const u32x4*)(tb + ((vl - 1024u) + (unsigned)(i * 8 * INW * 2))); vr[i] = *(const u32x4*)(tb + (vl + (unsigned)(i * 8 * INW * 2))); }
#pragma unroll
                for (int i = 0; i < 8; ++i) { *(LAS u32x4*)(vbase + i * 1024 + kw) = kr[i]; *(LAS u32x4*)(vbase + 8192 + i * 1024 + vw) = vr[i]; }
            }
#pragma unroll 1
            for (int j = j0; j <= LEFT; ++j) {
                if (j < LEFT) {
                    const char* tb = kband + (long)(64 * (j + 1)) * INW * 2;
#pragma unroll
                    for (int i = 0; i < 8; ++i) { kr[i] = *(const u32x4*)(tb + ((vl - 1024u) + (unsigned)(i * 8 * INW * 2))); vr[i] = *(const u32x4*)(tb + (vl + (unsigned)(i * 8 * INW * 2))); }
                }
                bf16x8 kf[8];
#pragma unroll
                for (int kb = 0; kb < 2; ++kb)
#pragma unroll
                    for (int s = 0; s < 4; ++s) kf[kb * 4 + s] = *(const LAS bf16x8*)(vbase + kb * 4096 + kfo + (((2 * s + hh) ^ (q32 & 7)) << 4));
                f32x16 p0, p1;
                if (j <= 5) {
                    const float ci = bconst - m_ref;
#pragma unroll
                    for (int r = 0; r < 16; ++r) { p0[r] = ci; p1[r] = ci; }
                } else {
                    const LAS float* pb0 = btab + (LEFT * CHUNK + qi - 64 * j + MAXREL - 4 * hh - 27); const LAS float* pb1 = pb0 - 32;
#pragma unroll
                    for (int r = 0; r < 16; ++r) { p0[r] = pb0[27 - ((r & 3) + 8 * (r >> 2))] - m_ref; p1[r] = pb1[27 - ((r & 3) + 8 * (r >> 2))] - m_ref; }
                }
#pragma unroll
                for (int s = 0; s < 4; ++s) { p0 = MFMA32(kf[s], qf[s], p0); p1 = MFMA32(kf[4 + s], qf[s], p1); }
                float mt = fmaxf(p0[0], p1[0]);
#pragma unroll
                for (int r = 1; r < 16; ++r) mt = fmaxf(mt, fmaxf(p0[r], p1[r]));
                mt = fmaxf(mt, __shfl_xor(mt, 32));
                const bool first = (j == j0);
                const bool grow = first || (mt > THR);
                if (__any(grow)) {
                    const float d = grow ? mt : 0.f, alpha = first ? 1.0f : __builtin_amdgcn_exp2f(-d);
                    m_ref += d; l_run *= alpha;
#pragma unroll
                    for (int r = 0; r < 16; ++r) { p0[r] -= d; p1[r] -= d; o0[r] *= alpha; o1[r] *= alpha; }
                }
                float ls0 = 0.f, ls1 = 0.f;
#pragma unroll
                for (int r = 0; r < 16; ++r) { p0[r] = __builtin_amdgcn_exp2f(p0[r]); p1[r] = __builtin_amdgcn_exp2f(p1[r]); ls0 += p0[r]; ls1 += p1[r]; }
                l_run += ls0 + ls1;
                const bf16x8 pf0 = pack8(p0, 0), pf1 = pack8(p0, 1), pf2 = pack8(p1, 0), pf3 = pack8(p1, 1);
                LAS const unsigned char* vcur = vbase + 8192 + vb;
#pragma unroll
                for (int db = 0; db < 2; ++db) {
                    v4i16_t lo[4], hi[4];
#pragma unroll
                    for (int ks = 0; ks < 4; ++ks) { lo[ks] = vtr(vcur + ks * 2048 + db * 64); hi[ks] = vtr(vcur + ks * 2048 + 1024 + db * 64); }
#define VF(k) (bf16x8){lo[k][0], lo[k][1], lo[k][2], lo[k][3], hi[k][0], hi[k][1], hi[k][2], hi[k][3]}
                    if (db == 0) { o0 = MFMA32(VF(0), pf0, o0); o0 = MFMA32(VF(1), pf1, o0); o0 = MFMA32(VF(2), pf2, o0); o0 = MFMA32(VF(3), pf3, o0); }
                    else         { o1 = MFMA32(VF(0), pf0, o1); o1 = MFMA32(VF(1), pf1, o1); o1 = MFMA32(VF(2), pf2, o1); o1 = MFMA32(VF(3), pf3, o1); }
#undef VF
                }
                if (j < LEFT) {
#pragma unroll
                    for (int i = 0; i < 8; ++i) { *(LAS u32x4*)(vbase + i * 1024 + kw) = kr[i]; *(LAS u32x4*)(vbase + 8192 + i * 1024 + vw) = vr[i]; }
                }
            }
            const float lt = l_run + __shfl_xor(l_run, 32), inv = 1.0f / lt;
            float ss = 0.f;
            bf16_t* orow = mixb + tq * D + 512 + h * 64 + 4 * hh;
#pragma unroll
            for (int g = 0; g < 4; ++g) {
                const float a0 = o0[4 * g] * inv, a1 = o0[4 * g + 1] * inv, a2 = o0[4 * g + 2] * inv, a3 = o0[4 * g + 3] * inv;
                const float c0 = o1[4 * g] * inv, c1 = o1[4 * g + 1] * inv, c2 = o1[4 * g + 2] * inv, c3 = o1[4 * g + 3] * inv;
                ss += (a0 * a0 + a1 * a1) + (a2 * a2 + a3 * a3) + (c0 * c0 + c1 * c1) + (c2 * c2 + c3 * c3);
                *(u32x2*)(orow + 8 * g) = (u32x2){cvtpk_s(a0, a1), cvtpk_s(a2, a3)};
                *(u32x2*)(orow + 32 + 8 * g) = (u32x2){cvtpk_s(c0, c1), cvtpk_s(c2, c3)};
            }
            ss += __shfl_xor(ss, 32);
            if (hh == 0) ssq[tq * SSQW + 32 + h] = ss;
        }
    }
}


constexpr int RG_WT = 0, RG_IMG = 18432, RG_SEG = 35840, RG_PRE = 44032, RG_CAR = 52224, RG_ROWB = 144, RG_IROW = 272;
__device__ __forceinline__ float fast_sigmoid(float x) { return __builtin_amdgcn_rcpf(1.0f + __expf(-x)); }
__device__ __forceinline__ void rglru_item(const Params& p, const bf16_t* z, bf16_t* mixb, float* ssq, LAS unsigned char* lds, unsigned long long* gran, int b, int hb, int kc) {
    const int tid = opaque_tid(), lane = tid & 63, w = __builtin_amdgcn_readfirstlane(tid >> 6), ch = lane, c16 = lane & 15, tg = lane >> 4;
    LAS f32x2* seg = (LAS f32x2*)(lds + RG_SEG); LAS f32x2* pre = (LAS f32x2*)(lds + RG_PRE); LAS float* car = (LAS float*)(lds + RG_CAR);
    {
        const u32x4* srcw = (const u32x4*)(p.ws + WS_GWT + (size_t)hb * 128 * 144); LAS u32x4* dstw = (LAS u32x4*)(lds + RG_WT);
        for (int idx = tid; idx < 128 * 144 / 16; idx += NTHR) dstw[idx] = srcw[idx];
    }
    const int gch = hb * 64 + ch;
    const float cw0 = p.conv_w[gch], cw1 = p.conv_w[RW + gch], cw2 = p.conv_w[2 * RW + gch], cw3 = p.conv_w[3 * RW + gch], cb = p.conv_b[gch];
    const float* sp8t = (const float*)(p.ws + WS_GWT + 8 * 128 * 144);
    float ba[4], bxb[4], sp8[4];
#pragma unroll
    for (int nb = 0; nb < 4; ++nb) { const int c = hb * 64 + 16 * nb + c16; ba[nb] = p.b_rg_a[c]; bxb[nb] = p.b_rg_x[c]; sp8[nb] = sp8t[c]; }
    LAS unsigned char* img = lds + RG_IMG;
    LAS unsigned char* trb = img + (8 * tg + (c16 >> 2)) * RG_IROW + (16 * w + 4 * (c16 & 3)) * 2;
    const int s0 = kc * 256;
    const bf16_t* ucol = z + ((size_t)b * S + s0) * INW + gch;
    float av[2][4][4], bv[2][4][4], cP[2][4], cH[2][4];
    bf16_t uraw[2][19], graw[2][4][4];
#pragma unroll
    for (int blk = 0; blk < 2; ++blk)
#pragma unroll
        for (int i = 0; i < 19; ++i) { const int s = blk * 128 + 16 * w - 3 + i; uraw[blk][i] = (s0 + s >= 0) ? ucol[(long)s * INW] : (bf16_t)0; }
#pragma unroll
    for (int blk = 0; blk < 2; ++blk)
#pragma unroll
        for (int nb = 0; nb < 4; ++nb)
#pragma unroll
            for (int i = 0; i < 4; ++i) graw[blk][nb][i] = z[((size_t)b * S + s0 + blk * 128 + 16 * w + 4 * tg + i) * INW + 512 + hb * 64 + 16 * nb + c16];
    __syncthreads();
#pragma unroll
    for (int blk = 0; blk < 2; ++blk) {
        const int t0 = blk * 128 + 16 * w;
        float uv[19];
#pragma unroll
        for (int i = 0; i < 19; ++i) uv[i] = bf2f(uraw[blk][i]);
        {
            float uc[16];
#pragma unroll
            for (int i = 0; i < 16; ++i) uc[i] = cb + cw0 * uv[i] + cw1 * uv[i + 1] + cw2 * uv[i + 2] + cw3 * uv[i + 3];
            u32x4 w0, w1;
#pragma unroll
            for (int e = 0; e < 4; ++e) { w0[e] = cvtpk_s(uc[2 * e], uc[2 * e + 1]); w1[e] = cvtpk_s(uc[8 + 2 * e], uc[9 + 2 * e]); }
            *(LAS u32x4*)(img + ch * RG_IROW + 32 * w) = w0; *(LAS u32x4*)(img + ch * RG_IROW + 32 * w + 16) = w1;
        }
        LDS_WAIT(); asm volatile("" ::: "memory");
        const v4i16_t t0lo = vtr(trb), t0hi = vtr(trb + 4 * RG_IROW), t1lo = vtr(trb + 32 * RG_IROW), t1hi = vtr(trb + 36 * RG_IROW);
        const bf16x8 a0 = (bf16x8){t0lo[0], t0lo[1], t0lo[2], t0lo[3], t0hi[0], t0hi[1], t0hi[2], t0hi[3]}, a1 = (bf16x8){t1lo[0], t1lo[1], t1lo[2], t1lo[3], t1hi[0], t1hi[1], t1hi[2], t1hi[3]};
#pragma unroll
        for (int nb = 0; nb < 4; ++nb) {
            const bf16x8 b0a = *(const LAS bf16x8*)(lds + RG_WT + (16 * nb + c16) * RG_ROWB + tg * 16), b1a = *(const LAS bf16x8*)(lds + RG_WT + (16 * nb + c16) * RG_ROWB + tg * 16 + 64);
            const bf16x8 b0x = *(const LAS bf16x8*)(lds + RG_WT + (64 + 16 * nb + c16) * RG_ROWB + tg * 16), b1x = *(const LAS bf16x8*)(lds + RG_WT + (64 + 16 * nb + c16) * RG_ROWB + tg * 16 + 64);
            f32x4 acca = __builtin_amdgcn_mfma_f32_16x16x32_bf16(a0, b0a, (f32x4){0.f, 0.f, 0.f, 0.f}, 0, 0, 0); acca = __builtin_amdgcn_mfma_f32_16x16x32_bf16(a1, b1a, acca, 0, 0, 0);
            f32x4 accx = __builtin_amdgcn_mfma_f32_16x16x32_bf16(a0, b0x, (f32x4){0.f, 0.f, 0.f, 0.f}, 0, 0, 0); accx = __builtin_amdgcn_mfma_f32_16x16x32_bf16(a1, b1x, accx, 0, 0, 0);
            const u32x2 ucr = *(const LAS u32x2*)(img + (16 * nb + c16) * RG_IROW + (16 * w + 4 * tg) * 2);
            const float ucv[4] = {__builtin_bit_cast(float, ucr[0] << 16), __builtin_bit_cast(float, ucr[0] & 0xffff0000u), __builtin_bit_cast(float, ucr[1] << 16), __builtin_bit_cast(float, ucr[1] & 0xffff0000u)};
            float H = 0.f, P = 1.f;
#pragma unroll
            for (int rg_ = 0; rg_ < 4; ++rg_) {
                const float r = fast_sigmoid(acca[rg_] + ba[nb]), ig = fast_sigmoid(accx[rg_] + bxb[nb]);
                const float a = __expf(r * sp8[nb]);
                av[blk][nb][rg_] = a; bv[blk][nb][rg_] = __builtin_amdgcn_sqrtf((1.0f - a) * (1.0f + a)) * (ig * ucv[rg_]);
                H = a * H + bv[blk][nb][rg_]; P *= a; }
            float cp = 1.f, chh = 0.f, Pt = 1.f, Ht = 0.f;
#pragma unroll
            for (int k = 0; k < 4; ++k) { const float Pk = __shfl(P, c16 + 16 * k), Hk = __shfl(H, c16 + 16 * k);
                cp = (k == tg) ? Pt : cp; chh = (k == tg) ? Ht : chh;
                Ht = Pk * Ht + Hk; Pt *= Pk; }
            cP[blk][nb] = cp; cH[blk][nb] = chh;
            if (tg == 0) seg[(blk * 8 + w) * 64 + 16 * nb + c16] = (f32x2){Pt, Ht};
        }
        LDS_WAIT(); asm volatile("" ::: "memory");
    }
    __syncthreads();
    if (tid < 64) {
        float Pp = 1.f, Hp = 0.f;
#pragma unroll
        for (int s = 0; s < 16; ++s) { pre[s * 64 + tid] = (f32x2){Pp, Hp}; const f32x2 sv = seg[s * 64 + tid]; Hp = sv.x * Hp + sv.y; Pp *= sv.x; }
        unsigned long long* g = gran + ((size_t)((b * 8 + hb) * 8 + kc) * 2) * 64 + tid;
        __hip_atomic_store(g, (1ull << 32) | __builtin_bit_cast(unsigned, Pp), __ATOMIC_RELAXED, __HIP_MEMORY_SCOPE_AGENT);
        __hip_atomic_store(g + 64, (1ull << 32) | __builtin_bit_cast(unsigned, Hp), __ATOMIC_RELAXED, __HIP_MEMORY_SCOPE_AGENT);
        float h = 0.f;
        for (int j = 0; j < kc; ++j) {
            const unsigned long long* gj = gran + ((size_t)((b * 8 + hb) * 8 + j) * 2) * 64 + tid;
            unsigned long long vp, vh; unsigned spins = 0;
            for (;;) { vp = __hip_atomic_load(gj, __ATOMIC_RELAXED, __HIP_MEMORY_SCOPE_AGENT); vh = __hip_atomic_load(gj + 64, __ATOMIC_RELAXED, __HIP_MEMORY_SCOPE_AGENT);
                if (__all(((vp >> 32) != 0ull) && ((vh >> 32) != 0ull))) break; __builtin_amdgcn_s_sleep(2); if (++spins > (1u << 20)) break; }
            h = __builtin_bit_cast(float, (unsigned)vp) * h + __builtin_bit_cast(float, (unsigned)vh);
        }
        car[tid] = h;
    }
    __syncthreads();
#pragma unroll
    for (int blk = 0; blk < 2; ++blk) {
        const int t0 = blk * 128 + 16 * w;
        float ysum[4] = {0.f, 0.f, 0.f, 0.f};
#pragma unroll
        for (int nb = 0; nb < 4; ++nb) {
            const int oc = 16 * nb + c16; const f32x2 pf = pre[(blk * 8 + w) * 64 + oc];
            float hcur = cP[blk][nb] * (pf.x * car[oc] + pf.y) + cH[blk][nb];
            bf16_t* orow = mixb + ((size_t)b * S + s0 + t0 + 4 * tg) * D + hb * 64 + oc;
#pragma unroll
            for (int i = 0; i < 4; ++i) { hcur = av[blk][nb][i] * hcur + bv[blk][nb][i];
                const float g = bf2f(graw[blk][nb][i]), u2 = 1.5957691216057308f * (g + 0.044715f * g * g * g);
                const float y = hcur * g * fast_sigmoid(u2);
                orow[(size_t)i * D] = (bf16_t)(cvtpk_s(y, y) & 0xffffu); ysum[i] += y * y; }
        }
#pragma unroll
        for (int i = 0; i < 4; ++i) ysum[i] += __shfl_xor(ysum[i], 1);
#pragma unroll
        for (int i = 0; i < 4; ++i) ysum[i] += __shfl_xor(ysum[i], 2);
#pragma unroll
        for (int i = 0; i < 4; ++i) ysum[i] += __shfl_xor(ysum[i], 4);
#pragma unroll
        for (int i = 0; i < 4; ++i) ysum[i] += __shfl_xor(ysum[i], 8);
        if (c16 == 0) { float* sq = ssq + ((size_t)b * S + s0 + t0 + 4 * tg) * SSQW + hb * 4;
#pragma unroll
            for (int i = 0; i < 4; ++i) *(f32x4*)(sq + (size_t)i * SSQW) = (f32x4){ysum[i], 0.f, 0.f, 0.f}; }
    }
}

constexpr int RT_WT = 0, RT_LDK = 1028, RT_PART = 82432, RT_SSP = 98816, RT_REC = 99328;
__device__ __forceinline__ void ph_router3(const Params& p, const float* h, int* gcount, int* tok_list, float* w_list, float* r_list, LAS unsigned char* lds) {
    const int tid = opaque_tid(), lane = tid & 63, w = __builtin_amdgcn_readfirstlane(tid >> 6), t16 = lane & 15, g = lane >> 4;
    LAS float* wt = (LAS float*)(lds + RT_WT); LAS float* part = (LAS float*)(lds + RT_PART); LAS float* ssp = (LAS float*)(lds + RT_SSP);
    LAS int* lcnt = (LAS int*)(lds + RT_REC); LAS int* lbase = lcnt + 16; LAS int* rec_e = lcnt + 32; LAS int* rec_s = lcnt + 160; LAS float* rec_w = (LAS float*)(lcnt + 288); LAS float* rec_r = (LAS float*)(lcnt + 416);
    { const f32x4* srcw = (const f32x4*)(p.ws + WS_RWT); LAS f32x4* dstw = (LAS f32x4*)wt;
      for (int idx = tid; idx < 20 * RT_LDK / 4; idx += NTHR) dstw[idx] = srcw[idx]; }
    const int task = w & 3, khalf = w >> 2, kbase = khalf * 512 + g * 128;
    for (int grp = blockIdx.x; grp < T / 64; grp += gridDim.x) {
        if (tid < 16) lcnt[tid] = 0;
        __syncthreads();
        {
            const f32x4* hrow = (const f32x4*)(h + (size_t)(grp * 64 + task * 16 + t16) * D + kbase);
            const LAS f32x4* b0p = (const LAS f32x4*)(wt + t16 * RT_LDK + kbase); const LAS f32x4* b1p = (const LAS f32x4*)(wt + (16 + (lane & 3)) * RT_LDK + kbase);
            f32x4 acc0 = {0.f, 0.f, 0.f, 0.f}, acc1 = {0.f, 0.f, 0.f, 0.f}; float ss = 0.f;
#pragma unroll 1
            for (int jb = 0; jb < 32; jb += 8) {
                f32x4 a[8];
#pragma unroll
                for (int j = 0; j < 8; ++j) a[j] = hrow[jb + j];
#pragma unroll
                for (int j = 0; j < 8; ++j) { const f32x4 b0 = b0p[jb + j], b1 = b1p[jb + j];
#pragma unroll
                    for (int q = 0; q < 4; ++q) { acc0 = __builtin_amdgcn_mfma_f32_16x16x4f32(a[j][q], b0[q], acc0, 0, 0, 0); acc1 = __builtin_amdgcn_mfma_f32_16x16x4f32(a[j][q], b1[q], acc1, 0, 0, 0); ss += a[j][q] * a[j][q]; } }
            }
            ss += __shfl_xor(ss, 16); ss += __shfl_xor(ss, 32);
            if (g == 0) ssp[khalf * 64 + task * 16 + t16] = ss;
            LAS float* pp = part + ((khalf * 4 + task) * 16 + 4 * g) * 32 + t16;
#pragma unroll
            for (int rg_ = 0; rg_ < 4; ++rg_) { pp[rg_ * 32] = acc0[rg_]; pp[rg_ * 32 + 16] = acc1[rg_]; }
        }
        __syncthreads();
        if (tid < 64) {
            const float rstd = rsqrtf((ssp[tid] + ssp[64 + tid]) * (1.0f / D) + EPS);
            const LAS float* q0 = part + tid * 32; const LAS float* q1 = part + (64 + tid) * 32;
            float lg[4];
#pragma unroll
            for (int i = 0; i < 4; ++i) lg[i] = (q0[16 + i] + q1[16 + i]) * rstd + p.b_group[i];
            int gi = 0; float best = lg[0];
#pragma unroll
            for (int i = 1; i < 4; ++i) if (lg[i] > best) { best = lg[i]; gi = i; }
            float den = 0.f;
#pragma unroll
            for (int i = 0; i < 4; ++i) den += expf(lg[i] - best);
            const float pg = 1.0f / den;
            float sel[4];
#pragma unroll
            for (int i = 0; i < 4; ++i) sel[i] = (q0[gi * 4 + i] + q1[gi * 4 + i]) * rstd + p.b_router[gi * 4 + i];
            int i1 = 0; float v1 = sel[0];
#pragma unroll
            for (int i = 1; i < 4; ++i) if (sel[i] > v1) { v1 = sel[i]; i1 = i; }
            int i2 = -1; float v2 = -3.0e38f;
#pragma unroll
            for (int i = 0; i < 4; ++i) if (i != i1 && sel[i] > v2) { v2 = sel[i]; i2 = i; }
            const float e2 = expf(v2 - v1);
            const float w1 = pg / (1.0f + e2), w2 = pg * e2 / (1.0f + e2);
            const int ea = gi * 4 + i1, eb = gi * 4 + i2;
            const int sa = __hip_atomic_fetch_add(lcnt + ea, 1, __ATOMIC_RELAXED, __HIP_MEMORY_SCOPE_WORKGROUP);
            const int sb = __hip_atomic_fetch_add(lcnt + eb, 1, __ATOMIC_RELAXED, __HIP_MEMORY_SCOPE_WORKGROUP);
            rec_e[tid * 2] = ea; rec_s[tid * 2] = sa; rec_w[tid * 2] = w1; rec_r[tid * 2] = rstd;
            rec_e[tid * 2 + 1] = eb; rec_s[tid * 2 + 1] = sb; rec_w[tid * 2 + 1] = w2; rec_r[tid * 2 + 1] = rstd;
        }
        __syncthreads();
        if (tid < 16) lbase[tid] = __hip_atomic_fetch_add(gcount + tid, lcnt[tid], __ATOMIC_RELAXED, __HIP_MEMORY_SCOPE_AGENT);
        __syncthreads();
        if (tid < 128) { const int e = rec_e[tid]; const int pos = lbase[e] + rec_s[tid]; tok_list[e * T + pos] = grp * 128 + tid; w_list[e * T + pos] = rec_w[tid]; r_list[e * T + pos] = rec_r[tid]; }
        __syncthreads();
    }
}

__device__ void ph_final(const Params& p, const float* h, const bf16_t* y2, float* out) {
    const int tid = opaque_tid(), lane = tid & 63, wv = tid >> 6, nw = NWAVES;
#if PROBE >= 100
    const unsigned long long* tsw = (const unsigned long long*)(p.ws + WS_CTL + 32768);
    const float span_us_ = (float)(tsw[PROBE - 100] - tsw[PROBE - 101]) * 0.01f;
    const float pscale = 1.0f + floorf((span_us_ + PROBE_SHIFT) / 20.0f) * (20.0f / 3000.0f);
#else
    const float pscale = 1.0f;
#endif
    for (int t = blockIdx.x * nw + wv; t < T; t += gridDim.x * nw) {
        const f32x4* hr = (const f32x4*)(h + (size_t)t * D) + lane;
        const u32x2* y0 = (const u32x2*)(y2 + (size_t)(2 * t) * D) + lane; const u32x2* y1 = (const u32x2*)(y2 + (size_t)(2 * t + 1) * D) + lane;
        f32x4 v[4]; float ss = 0.f;
#pragma unroll
        for (int j = 0; j < 4; ++j) { const f32x4 hv = hr[64 * j]; const u32x2 a = y0[64 * j], b = y1[64 * j];
            v[j][0] = hv[0] + __builtin_bit_cast(float, a[0] << 16) + __builtin_bit_cast(float, b[0] << 16);
            v[j][1] = hv[1] + __builtin_bit_cast(float, a[0] & 0xffff0000u) + __builtin_bit_cast(float, b[0] & 0xffff0000u);
            v[j][2] = hv[2] + __builtin_bit_cast(float, a[1] << 16) + __builtin_bit_cast(float, b[1] << 16);
            v[j][3] = hv[3] + __builtin_bit_cast(float, a[1] & 0xffff0000u) + __builtin_bit_cast(float, b[1] & 0xffff0000u);
            ss += (v[j][0] * v[j][0] + v[j][1] * v[j][1]) + (v[j][2] * v[j][2] + v[j][3] * v[j][3]); }
        const float r = rsqrtf(wave_sum(ss) * (1.0f / D) + EPS);
        f32x4* orow = (f32x4*)(out + (size_t)t * D) + lane;
#pragma unroll
        for (int j = 0; j < 4; ++j) { const f32x4 gf = *((const f32x4*)p.final_g + lane + 64 * j); orow[64 * j] = v[j] * r * gf * pscale; }
    }
}


__device__ __forceinline__ void ph_mixers(const Params& p, const bf16_t* z, bf16_t* mixb, float* ssq, LAS unsigned char* lds, unsigned* qctr) {
    const AttnCtx A = attn_setup(p, lds, TAB_OFF);
    volatile LAS int* qword = (volatile LAS int*)(lds + TAB_OFF + 12288);
    constexpr int NQ = NB, QITEMS = 64 + 64;
    unsigned long long* gran = (unsigned long long*)(p.ws + WS_CTL + MiB);
    const int qstep = (int)gridDim.x < NQ ? (int)gridDim.x : NQ;
    for (int q = blockIdx.x % NQ; q < NQ; q += qstep) {
        int ticket = 0;
        if (threadIdx.x == 0) ticket = (int)__hip_atomic_fetch_add(qctr + 64 * q, 1u, __ATOMIC_RELAXED, __HIP_MEMORY_SCOPE_AGENT);
        for (;;) {
            __syncthreads();
            if (threadIdx.x == 0) { *qword = ticket; if (ticket < QITEMS) ticket = (int)__hip_atomic_fetch_add(qctr + 64 * q, 1u, __ATOMIC_RELAXED, __HIP_MEMORY_SCOPE_AGENT); }
            __syncthreads();
            const int idx = *qword;
            if (idx >= QITEMS) break;
            if (idx < 64) rglru_item(p, z, mixb, ssq, lds, gran, q, idx & 7, idx >> 3);
            else { const int a = idx - 64; attn_item(A, z, mixb, ssq, q, 31 - (a >> 1), a & 1); }
        }
    }
}

#define XB_TMO      128
#define XB_XCNT(j)  (256  + 64 * (j))
#define XB_XSUB(j)  (1280 + 64 * (j))
#define XB_XGEN(j)  (2304 + 64 * (j))
#define XB_TOP      3328
#define XB_TOPGEN   3392
#define XCD_BAR_WORDS 3456
#define XB_SPIN_CAP (1u << 18)
__device__ __forceinline__ unsigned xb_ld(unsigned* p)              { return __hip_atomic_load(p, __ATOMIC_RELAXED, __HIP_MEMORY_SCOPE_AGENT); }
__device__ __forceinline__ unsigned xb_add(unsigned* p, unsigned v) { return __hip_atomic_fetch_add(p, v, __ATOMIC_RELAXED, __HIP_MEMORY_SCOPE_AGENT); }
__device__ __forceinline__ unsigned xb_xcc_id() { return (unsigned)__builtin_amdgcn_s_getreg((3 << 11) | 20) & 0xFu; }
#define XB_SPIN(cond, bar) do { unsigned _sp = 0; while (cond) { __builtin_amdgcn_s_sleep(1); \
    if ((++_sp & 255u) == 0u) { if (xb_ld(&(bar)[XB_TMO])) break; if (_sp > XB_SPIN_CAP) { atomicAdd(&(bar)[XB_TMO], 1u); break; } } } } while (0)
struct XcdBarrier { unsigned* bar; unsigned x; volatile LAS unsigned* st; };
__device__ __forceinline__ XcdBarrier xcd_barrier_post(unsigned* bar, volatile LAS unsigned* st) {
    XcdBarrier b; b.bar = bar; b.x = xb_xcc_id(); b.st = st;
    if (threadIdx.x == 0) (void)xb_add(&bar[XB_XCNT(b.x)], 1u);
    return b;
}
__device__ __forceinline__ void xcd_barrier_complete(unsigned* bar, unsigned x, unsigned& nloc, unsigned& nx) {
    const unsigned G = gridDim.x * gridDim.y * gridDim.z;
    unsigned sum, cnt, mine, sp = 0u;
    for (;;) {
        sum = 0u; cnt = 0u; mine = 0u;
#pragma unroll
        for (unsigned j = 0; j < 16; ++j) { const unsigned c = xb_ld(&bar[XB_XCNT(j)]); sum += c; cnt += (c > 0u) ? 1u : 0u; mine = (j == x) ? c : mine; }
        if (sum == G) break;
        __builtin_amdgcn_s_sleep(1);
        if ((++sp & 255u) == 0u) { if (xb_ld(&bar[XB_TMO])) break; if (sp > XB_SPIN_CAP) { atomicAdd(&bar[XB_TMO], 1u); break; } }
    }
    nloc = mine > 0u ? mine : 1u; nx = cnt > 0u ? cnt : 1u;
}
__device__ __forceinline__ void xcd_barrier(const XcdBarrier& b) {
    asm volatile("s_waitcnt vmcnt(0)" ::: "memory");
    __syncthreads();
    if (threadIdx.x == 0) {
        unsigned* bar = b.bar;
        __builtin_amdgcn_s_waitcnt(0);
        unsigned nloc = b.st[0], nx = b.st[1];
        if (nloc == 0u) { xcd_barrier_complete(bar, b.x, nloc, nx); b.st[0] = nloc; b.st[1] = nx; }
        const unsigned old = xb_add(&bar[XB_XSUB(b.x)], 1u);
        const unsigned gen = old / nloc;
        if (old + 1u == (gen + 1u) * nloc) {
            __builtin_amdgcn_fence(__ATOMIC_RELEASE, "agent");
            asm volatile("s_waitcnt vmcnt(0)" ::: "memory");
            const unsigned og = xb_add(&bar[XB_TOP], 1u);
            const unsigned tg = og / nx;
            if (og + 1u == (tg + 1u) * nx) xb_add(&bar[XB_TOPGEN], 1u);
            else XB_SPIN(xb_ld(&bar[XB_TOPGEN]) == tg, bar);
            __builtin_amdgcn_fence(__ATOMIC_ACQUIRE, "agent");
            xb_add(&bar[XB_XGEN(b.x)], 1u);
            asm volatile("s_waitcnt vmcnt(0)" ::: "memory");
        } else {
            XB_SPIN(xb_ld(&bar[XB_XGEN(b.x)]) == gen, bar);
            __builtin_amdgcn_fence(__ATOMIC_ACQUIRE, "agent");
            asm volatile("s_waitcnt vmcnt(0)" ::: "memory");
        }
    }
    __syncthreads();
}


__global__ void __launch_bounds__(NTHR) k_mega(Params p) {
    extern __shared__ __attribute__((aligned(16))) unsigned char lds_raw[];
    LAS unsigned char* lds = (LAS unsigned char*)lds_raw;
    const int G = gridDim.x; const int bx = blockIdx.x;
    volatile LAS unsigned* misc = (volatile LAS unsigned*)(lds + MISC_OFF);
    if (threadIdx.x < 64) misc[threadIdx.x] = 0u;
    __syncthreads();
    const XcdBarrier xbar = xcd_barrier_post((unsigned*)(p.ws + WS_CTL + 65536), misc + 8);
    const int vcu = (G % 8 == 0) ? (bx % 8) * (G / 8) + bx / 8 : bx;
#if PROBE >= 100
    unsigned long long* tsw = (unsigned long long*)(p.ws + WS_CTL + 32768); int tsn = 0;
#define TSTAMP() do { if (blockIdx.x == 0 && threadIdx.x == 0) tsw[tsn] = __builtin_amdgcn_s_memrealtime(); ++tsn; } while (0)
    TSTAMP();
#else
#define TSTAMP() do {} while (0)
#endif
    bf16_t* win_t = (bf16_t*)(p.ws + WS_WIN); bf16_t* wout_t = (bf16_t*)(p.ws + WS_WOUT);
    bf16_t* xb = (bf16_t*)(p.ws + WS_XB); bf16_t* zb = (bf16_t*)(p.ws + WS_Z); bf16_t* mixb = (bf16_t*)(p.ws + WS_MIX);
    float* ssq = (float*)(p.ws + WS_SSQ);
    float* a_ = (float*)(p.ws + WS_XB); float* bx_ = (float*)(p.ws + WS_HID);
    bf16_t* xn2b = (bf16_t*)(p.ws + WS_XB);
    int* route_e = (int*)(p.ws + WS_ROUTE); float* route_w = (float*)(p.ws + WS_ROUTE + (size_t)T * 2 * 4);
    float* h = p.out;

    ph_prologue(p, lds, vcu, G);
#if PROBE == 1
    ph_prologue(p, lds, vcu, G); ph_prologue(p, lds, vcu, G);
#endif
    xcd_barrier(xbar);
    TSTAMP();
    {
        pg8::DenseOrder So; So.init(xb, win_t, T, INW, D, G, bx);
        pg8::EpiZ E{zb, INW};
        pg8::gemm_phase(lds, D, So, E);
#if PROBE == 2
        pg8::gemm_phase(lds, D, So, E); pg8::gemm_phase(lds, D, So, E);
#endif
    }
    xcd_barrier(xbar);
    TSTAMP();
    ph_mixers(p, zb, mixb, ssq, lds, (unsigned*)(p.ws + WS_CTL + 8192));
#if PROBE == 3
    ph_mixers(p, zb, mixb, ssq, lds, (unsigned*)(p.ws + WS_CTL + 8192 + 2048)); ph_mixers(p, zb, mixb, ssq, lds, (unsigned*)(p.ws + WS_CTL + 8192 + 4096));
#endif
    xcd_barrier(xbar);
    TSTAMP();
    {
        pg8::DenseOrder So; So.init(mixb, wout_t, T, D, D, G, bx);
        pg8::EpiH E{ssq, p.x, h, xn2b, TAB_OFF};
        pg8::gemm_phase(lds, D, So, E);
#if PROBE == 4
        pg8::gemm_phase(lds, D, So, E); pg8::gemm_phase(lds, D, So, E);
#endif
    }
    xcd_barrier(xbar);
    TSTAMP();
    int* gcount = (int*)(p.ws + WS_CTL + 4096); int* tok_list = (int*)(p.ws + WS_LIST); float* w_list = (float*)(p.ws + WS_LIST + MiB);
    bf16_t* wgu_t = (bf16_t*)(p.ws + WS_WGU); bf16_t* wd_t = (bf16_t*)(p.ws + WS_WD); bf16_t* hid = (bf16_t*)(p.ws + WS_HID); bf16_t* y2 = (bf16_t*)(p.ws + WS_Z);
    float* r_list = (float*)(p.ws + WS_ROUTE);
    ph_router3(p, h, gcount, tok_list, w_list, r_list, lds);
#if PROBE == 5
    ph_router3(p, h, (int*)(p.ws + WS_CTL + 16384), (int*)(p.ws + WS_HID), (float*)(p.ws + WS_HID + MiB), (float*)(p.ws + WS_HID + 2 * MiB), lds);
    ph_router3(p, h, (int*)(p.ws + WS_CTL + 16384 + 256), (int*)(p.ws + WS_HID + 4 * MiB), (float*)(p.ws + WS_HID + 5 * MiB), (float*)(p.ws + WS_HID + 6 * MiB), lds);
#endif
    xcd_barrier(xbar);
    TSTAMP();
    LAS int* meta = (LAS int*)(lds + META_OFF);
    if (threadIdx.x == 0) { int base = 0; for (int e = 0; e < NE; ++e) { const int cnt = gcount[e]; meta[e] = base; meta[32 + e] = cnt; base += (cnt + 255) >> 8; } meta[16] = base; }
    __syncthreads();
    const int ntiles = meta[16];
    {
        pg8::MoeOrder<0> So{xn2b, wgu_t, tok_list, meta, D, G, bx, ntiles};
        pg8::EpiHid E{hid, r_list, meta};
        pg8::gemm_phase(lds, D, So, E);
#if PROBE == 6
        pg8::gemm_phase(lds, D, So, E); pg8::gemm_phase(lds, D, So, E);
#endif
    }
    xcd_barrier(xbar);
    TSTAMP();
    {
        pg8::MoeOrder<1> So{hid, wd_t, tok_list, meta, DFF, G, bx, ntiles};
        pg8::EpiY E{y2, tok_list, w_list, meta};
        pg8::gemm_phase(lds, DFF, So, E);
#if PROBE == 7
        pg8::gemm_phase(lds, DFF, So, E); pg8::gemm_phase(lds, DFF, So, E);
#endif
    }
    xcd_barrier(xbar);
    TSTAMP();
#if PROBE == 8
    ph_final(p, h, y2, (float*)(p.ws + WS_MIX)); ph_final(p, h, y2, (float*)(p.ws + WS_MIX));
#endif
#if PROBE >= 100
    xcd_barrier(xbar);
#endif
    ph_final(p, h, y2, p.out);
}

extern "C" void kernel_launch(void* const* d_in, const int* in_sizes, int n_in, void* d_out, int out_size, void* d_ws, size_t ws_size, hipStream_t stream) {
    static int grid_blocks = 0;
    if (!grid_blocks) {
        if (ws_size < WS_END) { fprintf(stderr, "kernel_launch: workspace too small (%zu < %zu)\n", ws_size, (size_t)WS_END); grid_blocks = -1; return; }
        int dev = 0, cus = 0, per_cu = 0;
        (void)hipGetDevice(&dev);
        (void)hipDeviceGetAttribute(&cus, hipDeviceAttributeMultiprocessorCount, dev);
        (void)hipFuncSetAttribute((const void*)k_mega, hipFuncAttributeMaxDynamicSharedMemorySize, LDS_BYTES);
        (void)hipOccupancyMaxActiveBlocksPerMultiprocessor(&per_cu, (const void*)k_mega, NTHR, LDS_BYTES);
        if (per_cu < 1) { fprintf(stderr, "kernel_launch: occupancy query says %d blocks per CU: not launching\n", per_cu); grid_blocks = -1; return; }
        grid_blocks = cus;
    }
    if (grid_blocks < 0) return;
    Params p{};
    const float** f = (const float**)&p;
    for (int i = 0; i < 23; ++i) f[i] = (const float*)d_in[i];
    p.out = (float*)d_out;
    p.ws = (unsigned char*)d_ws;
    (void)hipMemsetAsync((char*)d_ws + WS_CTL, 0, CTL_BYTES, stream);
    hipLaunchKernelGGL(k_mega, dim3(grid_blocks), dim3(NTHR), LDS_BYTES, stream, p);
    hipError_t e = hipPeekAtLastError();
    if (e != hipSuccess) fprintf(stderr, "launch failed: %s (grid %d)\n", hipGetErrorString(e), grid_blocks);
}
```

```cpp
#include <hip/hip_runtime.h>
#include <hip/hip_cooperative_groups.h>
#include <cstdio>
#include <cstdint>
namespace cg = cooperative_groups;

#ifndef PROBE
#define PROBE_SHIFT 0.0f
#define PROBE 0
#endif

#define LAS __attribute__((address_space(3)))
typedef unsigned short bf16_t;
typedef short bf16x8 __attribute__((ext_vector_type(8)));
typedef float f32x4 __attribute__((ext_vector_type(4)));
typedef float f32x2 __attribute__((ext_vector_type(2)));
typedef unsigned u32x4 __attribute__((ext_vector_type(4)));
typedef unsigned u32x2 __attribute__((ext_vector_type(2)));

constexpr int D = 1024, NB = 8, S = 2048, T = NB * S;
constexpr int RW = 512, RHD = 64;
constexpr int CHUNK = 64, LEFT = 8, BAND = 576, MAXREL = 128;
constexpr int INW = 2560;
constexpr int NE = 16, DFF = 512;
constexpr float EPS = 1e-6f;
constexpr int NTHR = 512, NWAVES = 8;
constexpr int SSQW = 40;

constexpr size_t MiB = 1u << 20;
constexpr size_t WS_CTL = 0, CTL_BYTES = 2 * MiB, CTL_ZERO_BYTES = 128 * 1024 + 512 * 1024;
constexpr size_t WS_WIN = 2 * MiB;
constexpr size_t WS_WOUT = 7 * MiB;
constexpr size_t WS_WGU = 9 * MiB;
constexpr size_t WS_WD = 41 * MiB;
constexpr size_t WS_XB = 57 * MiB;
constexpr size_t WS_Z = 89 * MiB;
constexpr size_t WS_MIX = 169 * MiB;
constexpr size_t WS_HID = 201 * MiB;
constexpr size_t WS_SSQ = 237 * MiB;
constexpr size_t WS_LIST = 240 * MiB;
constexpr size_t WS_ROUTE = 242 * MiB;
constexpr size_t WS_RWT = 243 * MiB;
constexpr size_t WS_GWT = 244 * MiB;
constexpr size_t WS_END = 245 * MiB;

constexpr int RING_BYTES = 131072, TAB_OFF = RING_BYTES, META_OFF = RING_BYTES + 4096, MISC_OFF = RING_BYTES + 15360, LDS_BYTES = 147456;

struct Params {
    const float *x, *norm1_g, *w_in, *conv_w, *conv_b, *w_rg_a, *b_rg_a, *w_rg_x, *b_rg_x, *lru_lambda, *rel_bias,
        *g_rec_out, *g_att_out, *w_out, *norm2_g, *w_group, *b_group, *w_router, *b_router, *w_e_gate, *w_e_up, *w_e_down, *final_g;
    float* out;
    unsigned char* ws;
};

__device__ __forceinline__ float wave_sum(float v) {
#pragma unroll
    for (int o = 32; o > 0; o >>= 1) v += __shfl_xor(v, o);
    return v;
}
__device__ __forceinline__ float sigmoidf_(float x) { return 1.0f / (1.0f + expf(-x)); }
__device__ __forceinline__ float gelu_tanh(float x) { return 0.5f * x * (1.0f + tanhf(0.7978845608028654f * (x + 0.044715f * x * x * x))); }
__device__ __forceinline__ unsigned f2bf(float f) { unsigned u = __builtin_bit_cast(unsigned, f); return (u + 0x7fffu + ((u >> 16) & 1u)) >> 16; }
__device__ __forceinline__ unsigned pk2(float lo, float hi) { return f2bf(lo) | (f2bf(hi) << 16); }
__device__ __forceinline__ float bf2f(bf16_t b) { return __builtin_bit_cast(float, ((unsigned)b) << 16); }
__device__ __forceinline__ unsigned cvt_pk_bf16(float lo, float hi) { unsigned r; asm volatile("v_cvt_pk_bf16_f32 %0, %1, %2" : "=v"(r) : "v"(lo), "v"(hi)); return r; }
#define LDS_WAIT() asm volatile("s_waitcnt lgkmcnt(0)" ::: "memory")
__device__ __forceinline__ int opaque_tid() { int t = threadIdx.x; asm volatile("" : "+v"(t)); return t; }

namespace pg8 {
constexpr int BM = 256, BK = 64, HALF = 128, HTB = HALF * BK * 2, STAGE_BYTES = 8 * HTB, NXCD = 8, WGM = 8;
__device__ __forceinline__ int lds_byte(int r, int c) { const int st = (r >> 4) * 2 + (c >> 5), rr = r & 15, cc = c & 31, ob = rr * 64 + cc * 2; return st * 1024 + (ob ^ (((ob >> 9) & 1) << 5)); }
__device__ __forceinline__ void stage_rc(int b, int& R, int& C) { const int st = b / 1024, sb = b % 1024, swz = sb ^ (((sb >> 9) & 1) << 5); R = (st >> 1) * 16 + swz / 64; C = (st & 1) * 32 + (swz % 64) / 2; }
__device__ __forceinline__ int perm32(int rho) { const int n = rho >> 4, i = rho & 15; return 8 * (i >> 2) + 4 * n + (i & 3); }

struct Unit { int pm, pn, e, rows; };

struct DenseOrder {
    const bf16_t* A; const bf16_t* Bt; int K; int nM, nN, nwg, G, c;
    __device__ void init(const bf16_t* A_, const bf16_t* Bt_, int M, int N, int K_, int G_, int c_) { A = A_; Bt = Bt_; K = K_; nM = M / BM; nN = N / BM; nwg = nM * nN; G = G_; c = c_; }
    __device__ __forceinline__ bool next(int i, Unit& u) const {
        const long L = (long)i * G + c; if (L >= nwg) return false;
        int wgid = (int)L; { const int q = nwg / NXCD, r = nwg % NXCD, xcd = wgid % NXCD, off = wgid / NXCD; wgid = (xcd < r ? xcd * (q + 1) : r * (q + 1) + (xcd - r) * q) + off; }
        const int nig = WGM * nN, gid = wgid / nig, fm = gid * WGM, gsz = (nM - fm) < WGM ? (nM - fm) : WGM;
        u.pm = fm + ((wgid % nig) % gsz); u.pn = (wgid % nig) / gsz; u.e = 0; u.rows = BM; return true;
    }
    __device__ __forceinline__ void addr(const Unit& u, const int (&RA)[2], const int (&CA)[2], const char*& aBase, const char*& bBase, unsigned (&va)[2][2]) const {
        aBase = (const char*)A; bBase = (const char*)Bt + (size_t)u.pn * BM * K * 2;
#pragma unroll
        for (int h = 0; h < 2; ++h)
#pragma unroll
            for (int i = 0; i < 2; ++i) va[h][i] = (unsigned)(((size_t)(u.pm * BM + h * HALF + RA[i]) * K + CA[i]) * 2);
    }
};

template <class Epi, class Sched>
__device__ __forceinline__ void gemm_phase(LAS unsigned char* lds, const int K, const Sched& S, const Epi& E) {
    int tid_ = threadIdx.x; asm volatile("" : "+v"(tid_));
    const int tid = tid_, wid = __builtin_amdgcn_readfirstlane(tid >> 6), lane = tid & 63, wr = wid >> 2, wc = wid & 3, fr = lane & 15, fq = lane >> 4;
    const int nt = K / BK;
    int RA[2], CA[2]; unsigned voffB[2];
#pragma unroll
    for (int i = 0; i < 2; ++i) { int R, C; stage_rc(tid * 16 + i * 8192, R, C); RA[i] = R; CA[i] = C; const int Rb = Epi::PERM ? ((R & ~31) + perm32(R & 31)) : R; voffB[i] = (unsigned)(Rb * K + C) * 2u; }
    const size_t kstep = (size_t)(BK * 2);
    const size_t hstepB = (size_t)HALF * K * 2;
    const unsigned ldsw = (unsigned)wid * 1024u;
    const int aoff = lds_byte(wr * 64 + fr, fq * 8), boff = lds_byte(wc * 32 + fr, fq * 8);
#define PG8_SA(b, h) (((b) * 2 + (h)) * HTB)
#define PG8_SB(b, h) ((4 + (b) * 2 + (h)) * HTB)
#define PG8_STAGE_B(bufoff, gbase) do { _Pragma("unroll") for (int _i = 0; _i < 2; ++_i) \
        __builtin_amdgcn_global_load_lds((const unsigned*)((const char*)(gbase) + voffB[_i]), (LAS unsigned*)(lds + (bufoff) + ldsw + _i * 8192), 16, 0, 0); } while (0)
#define PG8_STAGE_A(bufoff, gbase, v0, v1) do { \
        __builtin_amdgcn_global_load_lds((const unsigned*)((const char*)(gbase) + (v0)), (LAS unsigned*)(lds + (bufoff) + ldsw), 16, 0, 0); \
        __builtin_amdgcn_global_load_lds((const unsigned*)((const char*)(gbase) + (v1)), (LAS unsigned*)(lds + (bufoff) + ldsw + 8192), 16, 0, 0); } while (0)
#define PG8_LDA(dst, b, h) do { _Pragma("unroll") for (int m = 0; m < 4; ++m) _Pragma("unroll") for (int k = 0; k < 2; ++k) dst[m][k] = *(const LAS bf16x8*)(lds + PG8_SA(b, h) + aoff + m * 2048 + k * 1024); } while (0)
#define PG8_LDB(dst, b, h) do { _Pragma("unroll") for (int n = 0; n < 2; ++n) _Pragma("unroll") for (int k = 0; k < 2; ++k) dst[n][k] = *(const LAS bf16x8*)(lds + PG8_SB(b, h) + boff + n * 2048 + k * 1024); } while (0)
#define PG8_MMA(ai, bj, At, Bt) do { __builtin_amdgcn_s_setprio(1); _Pragma("unroll") for (int m = 0; m < 4; ++m) _Pragma("unroll") for (int n = 0; n < 2; ++n) _Pragma("unroll") for (int k = 0; k < 2; ++k) \
        acc[ai][bj][m][n] = __builtin_amdgcn_mfma_f32_16x16x32_bf16(Bt[n][k], At[m][k], acc[ai][bj][m][n], 0, 0, 0); __builtin_amdgcn_s_setprio(0); } while (0)
#define PG8_WAIT_V(n) asm volatile("s_waitcnt vmcnt(" #n ")" ::: "memory")
#define PG8_WAIT_L(n) asm volatile("s_waitcnt lgkmcnt(" #n ")" ::: "memory")
#define PG8_BAR __builtin_amdgcn_s_barrier()
#define PG8_SCHED __builtin_amdgcn_sched_barrier(0)
    Unit cur, nxt; int ui = 0;
    if (!S.next(0, cur)) return;
    f32x4 acc[2][2][4][2];
#pragma unroll
    for (int a = 0; a < 2; ++a)
#pragma unroll
        for (int b = 0; b < 2; ++b)
#pragma unroll
            for (int m = 0; m < 4; ++m)
#pragma unroll
                for (int n = 0; n < 2; ++n) acc[a][b][m][n] = (f32x4){0.f, 0.f, 0.f, 0.f};
    bf16x8 At[4][2], B0[2][2], B1[2][2];
    const char *cA, *cB, *nA, *nB; unsigned cva[2][2], nva[2][2];
    S.addr(cur, RA, CA, cA, cB, cva);
    E.prepare(cur, ui, lds);
    PG8_STAGE_B(PG8_SB(0, 0), cB); PG8_STAGE_A(PG8_SA(0, 0), cA, cva[0][0], cva[0][1]); PG8_STAGE_B(PG8_SB(0, 1), cB + hstepB); PG8_STAGE_A(PG8_SA(0, 1), cA, cva[1][0], cva[1][1]);
    if (wr == 1) PG8_BAR;
    PG8_WAIT_V(4); PG8_BAR;
    PG8_STAGE_B(PG8_SB(1, 0), cB + kstep); PG8_STAGE_A(PG8_SA(1, 0), cA + kstep, cva[0][0], cva[0][1]); PG8_STAGE_B(PG8_SB(1, 1), cB + hstepB + kstep);
    PG8_WAIT_V(6); PG8_BAR;
    for (;;) {
        const bool has_next = S.next(ui + 1, nxt);
        if (has_next) { S.addr(nxt, RA, CA, nA, nB, nva); }
        else { nA = cA; nB = cB;
#pragma unroll
            for (int h = 0; h < 2; ++h)
#pragma unroll
                for (int i = 0; i < 2; ++i) nva[h][i] = cva[h][i]; }
        for (int t = 0; t < nt; t += 2) {
            const bool last = (t == nt - 2);
            if (Epi::MIDSCALE && t == nt / 2) E.midscale(acc, wr, fr, ui, lds);
            const char* a1 = cA + (size_t)(t + 1) * kstep;
            const char* a2 = last ? nA : cA + (size_t)(t + 2) * kstep; const char* b2 = last ? nB : cB + (size_t)(t + 2) * kstep;
            const char* a3 = a2 + kstep; const char* b3 = b2 + kstep;
            const unsigned x00 = last ? nva[0][0] : cva[0][0], x01 = last ? nva[0][1] : cva[0][1], x10 = last ? nva[1][0] : cva[1][0], x11 = last ? nva[1][1] : cva[1][1];
            if (last && has_next) E.prepare(nxt, ui + 1, lds);
            PG8_LDB(B0, 0, 0); PG8_SCHED; PG8_LDA(At, 0, 0); PG8_STAGE_A(PG8_SA(1, 1), a1, cva[1][0], cva[1][1]);
            PG8_WAIT_L(8); PG8_BAR; PG8_WAIT_L(0); PG8_MMA(0, 0, At, B0); PG8_BAR; PG8_SCHED;
            PG8_LDB(B1, 0, 1); PG8_STAGE_B(PG8_SB(0, 0), b2);
            PG8_BAR; PG8_WAIT_L(0); PG8_MMA(0, 1, At, B1); PG8_BAR;
            PG8_LDA(At, 0, 1); PG8_STAGE_A(PG8_SA(0, 0), a2, x00, x01);
            PG8_BAR; PG8_WAIT_L(0); PG8_MMA(1, 0, At, B0); PG8_BAR; PG8_SCHED;
            PG8_STAGE_B(PG8_SB(0, 1), b2 + hstepB);
            PG8_WAIT_V(6); PG8_BAR; PG8_MMA(1, 1, At, B1); PG8_BAR;
            PG8_LDB(B0, 1, 0); PG8_SCHED; PG8_LDA(At, 1, 0); PG8_STAGE_A(PG8_SA(0, 1), a2, x10, x11);
            PG8_WAIT_L(8); PG8_BAR; PG8_WAIT_L(0); PG8_MMA(0, 0, At, B0); PG8_BAR; PG8_SCHED;
            PG8_LDB(B1, 1, 1); PG8_STAGE_B(PG8_SB(1, 0), b3);
            PG8_BAR; PG8_WAIT_L(0); PG8_MMA(0, 1, At, B1); PG8_BAR;
            PG8_LDA(At, 1, 1); PG8_STAGE_A(PG8_SA(1, 0), a3, x00, x01);
            PG8_BAR; PG8_WAIT_L(0); PG8_MMA(1, 0, At, B0); PG8_BAR; PG8_SCHED;
            PG8_STAGE_B(PG8_SB(1, 1), b3 + hstepB);
            PG8_WAIT_V(6); PG8_BAR; PG8_MMA(1, 1, At, B1); PG8_BAR;
        }
        E(acc, cur, wr, wc, fr, fq, ui, lds);
        if (!has_next) break;
#pragma unroll
        for (int a = 0; a < 2; ++a)
#pragma unroll
            for (int b = 0; b < 2; ++b)
#pragma unroll
                for (int m = 0; m < 4; ++m)
#pragma unroll
                    for (int n = 0; n < 2; ++n) acc[a][b][m][n] = (f32x4){0.f, 0.f, 0.f, 0.f};
        cur = nxt; cA = nA; cB = nB; ++ui;
#pragma unroll
        for (int h = 0; h < 2; ++h)
#pragma unroll
            for (int i = 0; i < 2; ++i) cva[h][i] = nva[h][i];
    }
    PG8_WAIT_V(0);
    if (wr == 0) PG8_BAR;
    PG8_BAR;
#undef PG8_SA
#undef PG8_SB
#undef PG8_STAGE_A
#undef PG8_STAGE_B
#undef PG8_LDA
#undef PG8_LDB
#undef PG8_MMA
#undef PG8_WAIT_V
#undef PG8_WAIT_L
#undef PG8_BAR
#undef PG8_SCHED
}

struct EpiZ {
    static constexpr bool PERM = true, MIDSCALE = false;
    bf16_t* O; int ldc;
    __device__ __forceinline__ void prepare(const Unit&, int, LAS unsigned char*) const {}
    __device__ __forceinline__ void midscale(f32x4 (&)[2][2][4][2], int, int, int, LAS unsigned char*) const {}
    __device__ __forceinline__ void operator()(const f32x4 (&acc)[2][2][4][2], const Unit& u, int wr, int wc, int fr, int fq, int, LAS unsigned char*) const {
        const int row0 = u.pm * BM + wr * 64 + fr, col0 = u.pn * BM + wc * 32 + 8 * fq;
#pragma unroll
        for (int ai = 0; ai < 2; ++ai)
#pragma unroll
            for (int m = 0; m < 4; ++m) { bf16_t* rowp = O + (size_t)(row0 + ai * HALF + m * 16) * ldc + col0;
#pragma unroll
                for (int bj = 0; bj < 2; ++bj) { const f32x4 v0 = acc[ai][bj][m][0], v1 = acc[ai][bj][m][1];
                    u32x4 w; w.x = cvt_pk_bf16(v0[0], v0[1]); w.y = cvt_pk_bf16(v0[2], v0[3]); w.z = cvt_pk_bf16(v1[0], v1[1]); w.w = cvt_pk_bf16(v1[2], v1[3]);
                    *(u32x4*)(rowp + bj * HALF) = w; } }
    }
};
struct EpiH {
    static constexpr bool PERM = false, MIDSCALE = true;
    const float* ssq; const float* x; float* h; bf16_t* hb; int tab_off;
    __device__ __forceinline__ void prepare(const Unit& u, int ui, LAS unsigned char* lds) const {
        LAS f32x2* tab = (LAS f32x2*)(lds + tab_off) + (ui & 1) * 256;
        if (threadIdx.x < 256) {
            const float* sp = ssq + (size_t)(u.pm * BM + threadIdx.x) * SSQW; float sa = 0.f, sb = 0.f;
#pragma unroll
            for (int i = 0; i < 8; ++i) { const f32x4 v = *(const f32x4*)(sp + 4 * i); sa += (v[0] + v[1]) + (v[2] + v[3]); }
#pragma unroll
            for (int i = 8; i < 10; ++i) { const f32x4 v = *(const f32x4*)(sp + 4 * i); sb += (v[0] + v[1]) + (v[2] + v[3]); }
            const float ra = rsqrtf(sa * (1.0f / 512.0f) + EPS), rb = rsqrtf(sb * (1.0f / 512.0f) + EPS);
            tab[threadIdx.x] = (f32x2){ra / rb, rb};
        }
    }
    __device__ __forceinline__ void midscale(f32x4 (&acc)[2][2][4][2], int wr, int fr, int ui, LAS unsigned char* lds) const {
        const LAS f32x2* tab = (const LAS f32x2*)(lds + tab_off) + (ui & 1) * 256;
#pragma unroll
        for (int ai = 0; ai < 2; ++ai)
#pragma unroll
            for (int m = 0; m < 4; ++m) { const float s = tab[ai * HALF + wr * 64 + m * 16 + fr].x;
#pragma unroll
                for (int bj = 0; bj < 2; ++bj)
#pragma unroll
                    for (int n = 0; n < 2; ++n) acc[ai][bj][m][n] = acc[ai][bj][m][n] * s; }
    }
    __device__ __forceinline__ void operator()(const f32x4 (&acc)[2][2][4][2], const Unit& u, int wr, int wc, int fr, int fq, int ui, LAS unsigned char* lds) const {
        const LAS f32x2* tab = (const LAS f32x2*)(lds + tab_off) + (ui & 1) * 256;
        const int row0 = u.pm * BM + wr * 64 + fr, col0 = u.pn * BM + wc * 32 + 4 * fq;
#pragma unroll
        for (int ai = 0; ai < 2; ++ai)
#pragma unroll
            for (int m = 0; m < 4; ++m) { const float s = tab[ai * HALF + wr * 64 + m * 16 + fr].y; const size_t ro = (size_t)(row0 + ai * HALF + m * 16) * D + col0;
#pragma unroll
                for (int bj = 0; bj < 2; ++bj)
#pragma unroll
                    for (int n = 0; n < 2; ++n) { const f32x4 xv = *(const f32x4*)(x + ro + bj * HALF + n * 16); const f32x4 hv = xv + acc[ai][bj][m][n] * s;
                        *(f32x4*)(h + ro + bj * HALF + n * 16) = hv; *(u32x2*)(hb + ro + bj * HALF + n * 16) = (u32x2){cvt_pk_bf16(hv[0], hv[1]), cvt_pk_bf16(hv[2], hv[3])}; } }
    }
};

template <int MODE>
struct MoeOrder {
    const bf16_t* A; const bf16_t* Bt; const int* tok_list; const LAS int* meta; int K, G, c, ntiles;
    __device__ __forceinline__ bool next(int i, Unit& u) const {
        const int L = i * G + c; if (L >= ntiles * 4) return false;
        const int mt = L >> 2; int e = 0;
#pragma unroll
        for (int j = 1; j < NE; ++j) e += (mt >= meta[j]) ? 1 : 0;
        u.pm = mt; u.pn = L & 3; u.e = e; u.rows = meta[32 + e] - (mt - meta[e]) * BM; return true;
    }
    __device__ __forceinline__ void addr(const Unit& u, const int (&RA)[2], const int (&CA)[2], const char*& aBase, const char*& bBase, unsigned (&va)[2][2]) const {
        aBase = (const char*)A; bBase = (const char*)Bt + ((size_t)u.e * D + (size_t)u.pn * BM) * K * 2;
        const int slot0 = (u.pm - meta[u.e]) * BM;
#pragma unroll
        for (int h = 0; h < 2; ++h)
#pragma unroll
            for (int i = 0; i < 2; ++i) {
                const int r = h * HALF + RA[i];
                if (MODE == 0) { int tok = 0; if (r < u.rows) tok = tok_list[u.e * T + slot0 + r] >> 1; va[h][i] = (unsigned)(((size_t)tok * K + CA[i]) * 2); }
                else va[h][i] = (unsigned)(((size_t)(u.pm * BM + r) * K + CA[i]) * 2);
            }
    }
};
struct EpiHid {
    static constexpr bool PERM = true, MIDSCALE = false;
    bf16_t* hid; const float* r_list; const LAS int* meta;
    __device__ __forceinline__ void prepare(const Unit&, int, LAS unsigned char*) const {}
    __device__ __forceinline__ void midscale(f32x4 (&)[2][2][4][2], int, int, int, LAS unsigned char*) const {}
    __device__ __forceinline__ void operator()(const f32x4 (&acc)[2][2][4][2], const Unit& u, int wr, int wc, int fr, int fq, int, LAS unsigned char*) const {
        const int row0 = u.pm * BM + wr * 64 + fr, j0 = u.pn * 128 + wc * 16 + 4 * fq, slot0 = (u.pm - meta[u.e]) * BM;
#pragma unroll
        for (int ai = 0; ai < 2; ++ai)
#pragma unroll
            for (int m = 0; m < 4; ++m) { bf16_t* rowp = hid + (size_t)(row0 + ai * HALF + m * 16) * DFF + j0;
                const int r = ai * HALF + wr * 64 + m * 16 + fr; const float rs = (r < u.rows) ? r_list[u.e * T + slot0 + r] : 0.f;
#pragma unroll
                for (int bj = 0; bj < 2; ++bj) { const f32x4 g = acc[ai][bj][m][0] * rs, up = acc[ai][bj][m][1] * rs; float hv[4];
#pragma unroll
                    for (int q = 0; q < 4; ++q) hv[q] = g[q] * up[q] * __builtin_amdgcn_rcpf(1.0f + __expf(-g[q]));
                    *(u32x2*)(rowp + bj * 64) = (u32x2){cvt_pk_bf16(hv[0], hv[1]), cvt_pk_bf16(hv[2], hv[3])}; } }
    }
};
struct EpiY {
    static constexpr bool PERM = true, MIDSCALE = false;
    bf16_t* y2; const int* tok_list; const float* w_list; const LAS int* meta;
    __device__ __forceinline__ void prepare(const Unit&, int, LAS unsigned char*) const {}
    __device__ __forceinline__ void midscale(f32x4 (&)[2][2][4][2], int, int, int, LAS unsigned char*) const {}
    __device__ __forceinline__ void operator()(const f32x4 (&acc)[2][2][4][2], const Unit& u, int wr, int wc, int fr, int fq, int, LAS unsigned char*) const {
        const int slot0 = (u.pm - meta[u.e]) * BM, col0 = u.pn * BM + wc * 32 + 8 * fq;
#pragma unroll
        for (int ai = 0; ai < 2; ++ai)
#pragma unroll
            for (int m = 0; m < 4; ++m) { const int r = ai * HALF + wr * 64 + m * 16 + fr;
                if (r < u.rows) { const int dst = tok_list[u.e * T + slot0 + r]; const float w = w_list[u.e * T + slot0 + r]; bf16_t* rowp = y2 + (size_t)dst * D + col0;
#pragma unroll
                    for (int bj = 0; bj < 2; ++bj) { const f32x4 v0 = acc[ai][bj][m][0] * w, v1 = acc[ai][bj][m][1] * w;
                        u32x4 o; o.x = cvt_pk_bf16(v0[0], v0[1]); o.y = cvt_pk_bf16(v0[2], v0[3]); o.z = cvt_pk_bf16(v1[0], v1[1]); o.w = cvt_pk_bf16(v1[2], v1[3]);
                        *(u32x4*)(rowp + bj * HALF) = o; } } }
    }
};
}

struct RowId { int off; __device__ __forceinline__ int operator()(int n) const { return off + n; } };
struct RowGU { int up; __device__ __forceinline__ int operator()(int j) const { return (j >> 2) * 8 + (j & 3) + 4 * up; } };

struct TItem { const float* src; const float* gp; bf16_t* dst; int N, K, rmk; };
__device__ __forceinline__ TItem p0_decode(const Params& p, int it) {
    constexpr int I_IN = (D / 64) * (INW / 32), I_OUT = (D / 64) * (D / 32), I_G = (D / 64) * (DFF / 32), I_D = (DFF / 64) * (D / 32), I_E = 2 * I_G + I_D;
    const float* W; const float* g; bf16_t* WT; int K, N, rmk, idx;
    if (it < I_IN) { W = p.w_in; g = p.norm1_g; WT = (bf16_t*)(p.ws + WS_WIN); K = D; N = INW; rmk = 0; idx = it; }
    else if (it < I_IN + I_OUT) { W = p.w_out; g = nullptr; WT = (bf16_t*)(p.ws + WS_WOUT); K = D; N = D; rmk = 0; idx = it - I_IN; }
    else { const int r = it - I_IN - I_OUT, e = r / I_E, q = r % I_E;
        if (q < I_G) { W = p.w_e_gate + (size_t)e * D * DFF; g = p.norm2_g; WT = (bf16_t*)(p.ws + WS_WGU) + (size_t)e * D * D; K = D; N = DFF; rmk = 1; idx = q; }
        else if (q < 2 * I_G) { W = p.w_e_up + (size_t)e * D * DFF; g = p.norm2_g; WT = (bf16_t*)(p.ws + WS_WGU) + (size_t)e * D * D; K = D; N = DFF; rmk = 2; idx = q - I_G; }
        else { W = p.w_e_down + (size_t)e * DFF * D; g = nullptr; WT = (bf16_t*)(p.ws + WS_WD) + (size_t)e * D * DFF; K = DFF; N = D; rmk = 0; idx = q - 2 * I_G; } }
    const int nblk = N / 32, kb = idx / nblk, nb = idx % nblk, k0 = 64 * kb, n0 = 32 * nb;
    TItem t; t.src = W + (size_t)k0 * N + n0; t.dst = WT + k0; t.N = N; t.K = K; t.rmk = rmk;
    t.gp = g ? g + k0 : nullptr;
    if (it >= I_IN && it < I_IN + I_OUT) t.gp = (k0 < 512) ? p.g_rec_out + k0 : p.g_att_out + (k0 - 512);
    t.rmk = rmk | (n0 << 4);
    return t;
}
__device__ __forceinline__ void p0_load(const TItem& t, f32x4 (&ld)[8], float (&gv)[8], int lane) {
#pragma unroll
    for (int i = 0; i < 8; ++i) ld[i] = *(const f32x4*)(t.src + (size_t)(8 * i + (lane >> 3)) * t.N + 4 * (lane & 7));
    if (t.gp) {
#pragma unroll
        for (int i = 0; i < 8; ++i) gv[i] = t.gp[8 * i + (lane >> 3)];
    } else {
#pragma unroll
        for (int i = 0; i < 8; ++i) gv[i] = 1.0f;
    }
}
__device__ __forceinline__ void p0_process(const TItem& t, const f32x4 (&ld)[8], const float (&gv)[8], LAS float* scr, int lane) {
#pragma unroll
    for (int i = 0; i < 8; ++i) { const int kk = 8 * i + (lane >> 3); const f32x4 v = ld[i] * gv[i];
        LAS float* d = scr + kk * 33 + 4 * (lane & 7); d[0] = v[0]; d[1] = v[1]; d[2] = v[2]; d[3] = v[3]; }
    LDS_WAIT(); asm volatile("" ::: "memory");
    const int c = lane & 7, n0 = t.rmk >> 4, rmk = t.rmk & 15;
#pragma unroll
    for (int j = 0; j < 4; ++j) { const int n = (lane >> 3) + 8 * j; const LAS float* s = scr + (8 * c) * 33 + n;
        u32x4 o; o.x = pk2(s[0 * 33], s[1 * 33]); o.y = pk2(s[2 * 33], s[3 * 33]); o.z = pk2(s[4 * 33], s[5 * 33]); o.w = pk2(s[6 * 33], s[7 * 33]);
        const int nn = n0 + n, row = (rmk == 0) ? nn : ((nn >> 2) * 8 + (nn & 3) + 4 * (rmk - 1));
        *(u32x4*)(t.dst + (size_t)row * t.K + 8 * c) = o; }
    LDS_WAIT(); asm volatile("" ::: "memory");
}

__device__ __forceinline__ void ph_prologue(const Params& p, LAS unsigned char* lds, int vcu, int G) {
    const int tid = opaque_tid(), lane = tid & 63, wave = tid >> 6;
    LAS float* scr = (LAS float*)(lds + wave * 16384);
    const int gw = vcu * NWAVES + wave, NGW = G * NWAVES;
    bf16_t* xb = (bf16_t*)(p.ws + WS_XB);
    constexpr int I_IN = (D / 64) * (INW / 32), I_OUT = (D / 64) * (D / 32), I_G = (D / 64) * (DFF / 32), I_D = (DFF / 64) * (D / 32), I_E = 2 * I_G + I_D, I_ALL = I_IN + I_OUT + NE * I_E;
    {
        int it = gw; TItem cur; f32x4 la[8]; float ga[8];
        if (it < I_ALL) { cur = p0_decode(p, it); p0_load(cur, la, ga, lane); }
        while (it < I_ALL) {
            const int nit = it + NGW; TItem nxt = cur; f32x4 lb[8]; float gb[8];
            const bool has = nit < I_ALL;
            if (has) { nxt = p0_decode(p, nit); p0_load(nxt, lb, gb, lane); }
            p0_process(cur, la, ga, scr, lane);
            if (has) { cur = nxt;
#pragma unroll
                for (int i = 0; i < 8; ++i) { la[i] = lb[i]; ga[i] = gb[i]; } }
            it = nit;
        }
    }
    {
        bf16_t* gwt = (bf16_t*)(p.ws + WS_GWT); float* sp8 = (float*)(p.ws + WS_GWT + 8 * 128 * 144);
        for (int idx = gw * 64 + lane; idx < 8 * 64 * 128; idx += NGW * 64) { const int hb = idx >> 13, k = (idx >> 7) & 63, n = idx & 127;
            const float v = (n < 64) ? p.w_rg_a[(hb * 64 + k) * 64 + n] : p.w_rg_x[(hb * 64 + k) * 64 + n - 64];
            gwt[(hb * 128 + n) * 72 + k] = (bf16_t)f2bf(v); }
        for (int idx = gw * 64 + lane; idx < RW; idx += NGW * 64) sp8[idx] = -8.0f * log1pf(expf(-p.lru_lambda[idx]));
    }
    {
        float* rwt = (float*)(p.ws + WS_RWT);
        for (int idx = gw * 64 + lane; idx < D * 20; idx += NGW * 64) { const int k = idx / 20, n = idx % 20;
            rwt[n * 1028 + k] = (n < 16 ? p.w_router[k * 16 + n] : p.w_group[k * 4 + n - 16]) * p.norm2_g[k]; }
    }
    for (int t = gw; t < T; t += 2 * NGW) {
        const int t2 = t + NGW; const bool has2 = t2 < T;
        const f32x4* xr = (const f32x4*)(p.x + (size_t)t * D) + lane; const f32x4* xr2 = (const f32x4*)(p.x + (size_t)(has2 ? t2 : t) * D) + lane;
        f32x4 v[4], v2[4]; float ss = 0.f, ss2 = 0.f;
#pragma unroll
        for (int j = 0; j < 4; ++j) { v[j] = xr[64 * j]; v2[j] = xr2[64 * j]; }
#pragma unroll
        for (int j = 0; j < 4; ++j) { ss += (v[j][0] * v[j][0] + v[j][1] * v[j][1]) + (v[j][2] * v[j][2] + v[j][3] * v[j][3]); ss2 += (v2[j][0] * v2[j][0] + v2[j][1] * v2[j][1]) + (v2[j][2] * v2[j][2] + v2[j][3] * v2[j][3]); }
        const float r = rsqrtf(wave_sum(ss) * (1.0f / D) + EPS), r2 = rsqrtf(wave_sum(ss2) * (1.0f / D) + EPS);
        u32x2* o8 = (u32x2*)(xb + (size_t)t * D) + lane;
#pragma unroll
        for (int j = 0; j < 4; ++j) o8[64 * j] = (u32x2){pk2(v[j][0] * r, v[j][1] * r), pk2(v[j][2] * r, v[j][3] * r)};
        if (has2) { u32x2* o82 = (u32x2*)(xb + (size_t)t2 * D) + lane;
#pragma unroll
            for (int j = 0; j < 4; ++j) o82[64 * j] = (u32x2){pk2(v2[j][0] * r2, v2[j][1] * r2), pk2(v2[j][2] * r2, v2[j][3] * r2)}; }
    }
}

typedef float f32x16 __attribute__((ext_vector_type(16)));
typedef short v4i16_t __attribute__((ext_vector_type(4)));
typedef __bf16 bf16x2_t __attribute__((ext_vector_type(2)));
#define MFMA32(a, b, c) __builtin_amdgcn_mfma_f32_32x32x16_bf16((a), (b), (c), 0, 0, 0)
__device__ __forceinline__ unsigned cvtpk_s(float lo, float hi) { f32x2 v = {lo, hi}; bf16x2_t b = __builtin_convertvector(v, bf16x2_t); return __builtin_bit_cast(unsigned, b); }
__device__ __forceinline__ int crow(int r, int hh) { return (r & 3) + 8 * (r >> 2) + 4 * hh; }
__device__ __forceinline__ bf16x8 pack8(const f32x16& x, int s) {
    u32x4 w; w.x = cvtpk_s(x[8 * s + 0], x[8 * s + 1]); w.y = cvtpk_s(x[8 * s + 2], x[8 * s + 3]); w.z = cvtpk_s(x[8 * s + 4], x[8 * s + 5]); w.w = cvtpk_s(x[8 * s + 6], x[8 * s + 7]);
    return __builtin_bit_cast(bf16x8, w);
}
__device__ __forceinline__ v4i16_t vtr(LAS const unsigned char* p) { return __builtin_amdgcn_ds_read_tr16_b64_v4i16((LAS v4i16_t*)p); }
constexpr float LOG2E = 1.4426950408889634f;

struct AttnCtx { LAS float* btab; LAS unsigned char* vbase; int lane, h, q32, hh, vb, vw; float bconst; unsigned kl, vl; };
__device__ __forceinline__ AttnCtx attn_setup(const Params& p, LAS unsigned char* lds, int tab_off) {
    int tid_ = threadIdx.x; asm volatile("" : "+v"(tid_));
    AttnCtx A; const int tid = tid_; A.lane = tid & 63; A.h = __builtin_amdgcn_readfirstlane(tid >> 6); A.q32 = A.lane & 31; A.hh = A.lane >> 5;
    A.btab = (LAS float*)(lds + tab_off) + A.h * 328;
    for (int i = A.lane; i < 2 * MAXREL + 1 + 64; i += 64) A.btab[i] = p.rel_bias[A.h * (2 * MAXREL + 1) + (i > 2 * MAXREL ? 2 * MAXREL : i)] * LOG2E;
    LDS_WAIT(); asm volatile("" ::: "memory");
    A.vbase = lds + A.h * 16384;
    A.vb = ((A.lane >> 4) & 1) * 32 + (A.lane & 3) * 8 + (4 * A.hh + ((A.lane & 15) >> 2)) * 128;
    A.vw = (A.lane >> 3) * 128 + (A.lane & 7) * 16;
    A.bconst = A.btab[2 * MAXREL];
    A.kl = (unsigned)((A.q32 * INW + 8 * A.hh) * 2);
    A.vl = (unsigned)(((A.lane >> 3) * INW + (A.lane & 7) * 8) * 2) + 1024u;
    return A;
}
__device__ __forceinline__ void attn_item(const AttnCtx& A, const bf16_t* z, bf16_t* mixb, float* ssq, int b, int c, int qh) {
    const int lane = A.lane, h = A.h, q32 = A.q32, hh = A.hh, vb = A.vb, vw = A.vw; LAS float* btab = A.btab; LAS unsigned char* vbase = A.vbase;
    const float bconst = A.bconst, QS = 0.125f * LOG2E; const unsigned kl = A.kl, vl = A.vl;
    {
        const int j0 = (c >= LEFT) ? 0 : LEFT - c;
        const char* kband = (const char*)z + (((long)b * S + (long)(c - LEFT) * CHUNK) * INW + 1536 + h * 64) * 2;
        {
            const int qi = qh * 32 + q32;
            const size_t tq = (size_t)b * S + c * CHUNK + qi;
            bf16x8 qf[4];
#pragma unroll
            for (int s = 0; s < 4; ++s) { const u32x4 raw = *(const u32x4*)(z + tq * INW + 1024 + h * 64 + 16 * s + 8 * hh); u32x4 w;
#pragma unroll
                for (int e = 0; e < 4; ++e) w[e] = cvtpk_s(__builtin_bit_cast(float, raw[e] << 16) * QS, __builtin_bit_cast(float, raw[e] & 0xffff0000u) * QS);
                qf[s] = __builtin_bit_cast(bf16x8, w); }
            f32x16 o0, o1;
#pragma unroll
            for (int r = 0; r < 16; ++r) { o0[r] = 0.f; o1[r] = 0.f; }
            float m_ref = 0.f, l_run = 0.f;
            constexpr float THR = 6.0f;
            u32x4 kr[8], vr[8];
            const int kw = (lane >> 3) * 128 + (((lane & 7) ^ (lane >> 3)) << 4);
            const int kfo = q32 * 128;
            {
                const char* tb = kband + (long)(64 * j0) * INW * 2;
#pragma unroll
                for (int i = 0; i < 8; ++i) { kr[i] = *(const u32x4*)(tb + ((vl - 1024u) + (unsigned)(i * 8 * INW * 2))); vr[i] = *(const u32x4*)(tb + (vl + (unsigned)(i * 8 * INW * 2))); }
#pragma unroll
                for (int i = 0; i < 8; ++i) { *(LAS u32x4*)(vbase + i * 1024 + kw) = kr[i]; *(LAS u32x4*)(vbase + 8192 + i * 1024 + vw) = vr[i]; }
            }
#pragma unroll 1
            for (int j = j0; j <= LEFT; ++j) {
                if (j < LEFT) {
                    const char* tb = kband + (long)(64 * (j + 1)) * INW * 2;
#pragma unroll
                    for (int i = 0; i < 8; ++i) { kr[i] = *(const u32x4*)(tb + ((vl - 1024u) + (unsigned)(i * 8 * INW * 2))); vr[i] = *(const u32x4*)(tb + (vl + (unsigned)(i * 8 * INW * 2))); }
                }
                bf16x8 kf[8];
#pragma unroll
                for (int kb = 0; kb < 2; ++kb)
#pragma unroll
                    for (int s = 0; s < 4; ++s) kf[kb * 4 + s] = *(const LAS bf16x8*)(vbase + kb * 4096 + kfo + (((2 * s + hh) ^ (q32 & 7)) << 4));
                f32x16 p0, p1;
                if (j <= 5) {
                    const float ci = bconst - m_ref;
#pragma unroll
                    for (int r = 0; r < 16; ++r) { p0[r] = ci; p1[r] = ci; }
                } else {
                    const LAS float* pb0 = btab + (LEFT * CHUNK + qi - 64 * j + MAXREL - 4 * hh - 27); const LAS float* pb1 = pb0 - 32;
#pragma unroll
                    for (int r = 0; r < 16; ++r) { p0[r] = pb0[27 - ((r & 3) + 8 * (r >> 2))] - m_ref; p1[r] = pb1[27 - ((r & 3) + 8 * (r >> 2))] - m_ref; }
                }
#pragma unroll
                for (int s = 0; s < 4; ++s) { p0 = MFMA32(kf[s], qf[s], p0); p1 = MFMA32(kf[4 + s], qf[s], p1); }
                float mt = fmaxf(p0[0], p1[0]);
#pragma unroll
                for (int r = 1; r < 16; ++r) mt = fmaxf(mt, fmaxf(p0[r], p1[r]));
                mt = fmaxf(mt, __shfl_xor(mt, 32));
                const bool first = (j == j0);
                const bool grow = first || (mt > THR);
                if (__any(grow)) {
                    const float d = grow ? mt : 0.f, alpha = first ? 1.0f : __builtin_amdgcn_exp2f(-d);
                    m_ref += d; l_run *= alpha;
#pragma unroll
                    for (int r = 0; r < 16; ++r) { p0[r] -= d; p1[r] -= d; o0[r] *= alpha; o1[r] *= alpha; }
                }
                float ls0 = 0.f, ls1 = 0.f;
#pragma unroll
                for (int r = 0; r < 16; ++r) { p0[r] = __builtin_amdgcn_exp2f(p0[r]); p1[r] = __builtin_amdgcn_exp2f(p1[r]); ls0 += p0[r]; ls1 += p1[r]; }
                l_run += ls0 + ls1;
                const bf16x8 pf0 = pack8(p0, 0), pf1 = pack8(p0, 1), pf2 = pack8(p1, 0), pf3 = pack8(p1, 1);
                LAS const unsigned char* vcur = vbase + 8192 + vb;
#pragma unroll
                for (int db = 0; db < 2; ++db) {
                    v4i16_t lo[4], hi[4];
#pragma unroll
                    for (int ks = 0; ks < 4; ++ks) { lo[ks] = vtr(vcur + ks * 2048 + db * 64); hi[ks] = vtr(vcur + ks * 2048 + 1024 + db * 64); }
#define VF(k) (bf16x8){lo[k][0], lo[k][1], lo[k][2], lo[k][3], hi[k][0], hi[k][1], hi[k][2], hi[k][3]}
                    if (db == 0) { o0 = MFMA32(VF(0), pf0, o0); o0 = MFMA32(VF(1), pf1, o0); o0 = MFMA32(VF(2), pf2, o0); o0 = MFMA32(VF(3), pf3, o0); }
                    else         { o1 = MFMA32(VF(0), pf0, o1); o1 = MFMA32(VF(1), pf1, o1); o1 = MFMA32(VF(2), pf2, o1); o1 = MFMA32(VF(3), pf3, o1); }
#undef VF
                }
                if (j < LEFT) {
#pragma unroll
                    for (int i = 0; i < 8; ++i) { *(LAS u32x4*)(vbase + i * 1024 + kw) = kr[i]; *(LAS u32x4*)(vbase + 8192 + i * 1024 + vw) = vr[i]; }
                }
            }
            const float lt = l_run + __shfl_xor(l_run, 32), inv = 1.0f / lt;
            float ss = 0.f;
            bf16_t* orow = mixb + tq * D + 512 + h * 64 + 4 * hh;
#pragma unroll
            for (int g = 0; g < 4; ++g) {
                const float a0 = o0[4 * g] * inv, a1 = o0[4 * g + 1] * inv, a2 = o0[4 * g + 2] * inv, a3 = o0[4 * g + 3] * inv;
                const float c0 = o1[4 * g] * inv, c1 = o1[4 * g + 1] * inv, c2 = o1[4 * g + 2] * inv, c3 = o1[4 * g + 3] * inv;
                ss += (a0 * a0 + a1 * a1) + (a2 * a2 + a3 * a3) + (c0 * c0 + c1 * c1) + (c2 * c2 + c3 * c3);
                *(u32x2*)(orow + 8 * g) = (u32x2){cvtpk_s(a0, a1), cvtpk_s(a2, a3)};
                *(u32x2*)(orow + 32 + 8 * g) = (u32x2){cvtpk_s(c0, c1), cvtpk_s(c2, c3)};
            }
            ss += __shfl_xor(ss, 32);
            if (hh == 0) ssq[tq * SSQW + 32 + h] = ss;
        }
    }
}


constexpr int RG_WT = 0, RG_IMG = 18432, RG_SEG = 35840, RG_PRE = 44032, RG_CAR = 52224, RG_ROWB = 144, RG_IROW = 272;
__device__ __forceinline__ float fast_sigmoid(float x) { return __builtin_amdgcn_rcpf(1.0f + __expf(-x)); }
__device__ __forceinline__ void rglru_item(const Params& p, const bf16_t* z, bf16_t* mixb, float* ssq, LAS unsigned char* lds, unsigned long long* gran, int b, int hb, int kc) {
    const int tid = opaque_tid(), lane = tid & 63, w = __builtin_amdgcn_readfirstlane(tid >> 6), ch = lane, c16 = lane & 15, tg = lane >> 4;
    LAS f32x2* seg = (LAS f32x2*)(lds + RG_SEG); LAS f32x2* pre = (LAS f32x2*)(lds + RG_PRE); LAS float* car = (LAS float*)(lds + RG_CAR);
    {
        const u32x4* srcw = (const u32x4*)(p.ws + WS_GWT + (size_t)hb * 128 * 144); LAS u32x4* dstw = (LAS u32x4*)(lds + RG_WT);
        for (int idx = tid; idx < 128 * 144 / 16; idx += NTHR) dstw[idx] = srcw[idx];
    }
    const int gch = hb * 64 + ch;
    const float cw0 = p.conv_w[gch], cw1 = p.conv_w[RW + gch], cw2 = p.conv_w[2 * RW + gch], cw3 = p.conv_w[3 * RW + gch], cb = p.conv_b[gch];
    const float* sp8t = (const float*)(p.ws + WS_GWT + 8 * 128 * 144);
    float ba[4], bxb[4], sp8[4];
#pragma unroll
    for (int nb = 0; nb < 4; ++nb) { const int c = hb * 64 + 16 * nb + c16; ba[nb] = p.b_rg_a[c]; bxb[nb] = p.b_rg_x[c]; sp8[nb] = sp8t[c]; }
    LAS unsigned char* img = lds + RG_IMG;
    LAS unsigned char* trb = img + (8 * tg + (c16 >> 2)) * RG_IROW + (16 * w + 4 * (c16 & 3)) * 2;
    const int s0 = kc * 256;
    const bf16_t* ucol = z + ((size_t)b * S + s0) * INW + gch;
    float av[2][4][4], bv[2][4][4], cP[2][4], cH[2][4];
    bf16_t uraw[2][19], graw[2][4][4];
#pragma unroll
    for (int blk = 0; blk < 2; ++blk)
#pragma unroll
        for (int i = 0; i < 19; ++i) { const int s = blk * 128 + 16 * w - 3 + i; uraw[blk][i] = (s0 + s >= 0) ? ucol[(long)s * INW] : (bf16_t)0; }
#pragma unroll
    for (int blk = 0; blk < 2; ++blk)
#pragma unroll
        for (int nb = 0; nb < 4; ++nb)
#pragma unroll
            for (int i = 0; i < 4; ++i) graw[blk][nb][i] = z[((size_t)b * S + s0 + blk * 128 + 16 * w + 4 * tg + i) * INW + 512 + hb * 64 + 16 * nb + c16];
    __syncthreads();
#pragma unroll
    for (int blk = 0; blk < 2; ++blk) {
        const int t0 = blk * 128 + 16 * w;
        float uv[19];
#pragma unroll
        for (int i = 0; i < 19; ++i) uv[i] = bf2f(uraw[blk][i]);
        {
            float uc[16];
#pragma unroll
            for (int i = 0; i < 16; ++i) uc[i] = cb + cw0 * uv[i] + cw1 * uv[i + 1] + cw2 * uv[i + 2] + cw3 * uv[i + 3];
            u32x4 w0, w1;
#pragma unroll
            for (int e = 0; e < 4; ++e) { w0[e] = cvtpk_s(uc[2 * e], uc[2 * e + 1]); w1[e] = cvtpk_s(uc[8 + 2 * e], uc[9 + 2 * e]); }
            *(LAS u32x4*)(img + ch * RG_IROW + 32 * w) = w0; *(LAS u32x4*)(img + ch * RG_IROW + 32 * w + 16) = w1;
        }
        LDS_WAIT(); asm volatile("" ::: "memory");
        const v4i16_t t0lo = vtr(trb), t0hi = vtr(trb + 4 * RG_IROW), t1lo = vtr(trb + 32 * RG_IROW), t1hi = vtr(trb + 36 * RG_IROW);
        const bf16x8 a0 = (bf16x8){t0lo[0], t0lo[1], t0lo[2], t0lo[3], t0hi[0], t0hi[1], t0hi[2], t0hi[3]}, a1 = (bf16x8){t1lo[0], t1lo[1], t1lo[2], t1lo[3], t1hi[0], t1hi[1], t1hi[2], t1hi[3]};
#pragma unroll
        for (int nb = 0; nb < 4; ++nb) {
            const bf16x8 b0a = *(const LAS bf16x8*)(lds + RG_WT + (16 * nb + c16) * RG_ROWB + tg * 16), b1a = *(const LAS bf16x8*)(lds + RG_WT + (16 * nb + c16) * RG_ROWB + tg * 16 + 64);
            const bf16x8 b0x = *(const LAS bf16x8*)(lds + RG_WT + (64 + 16 * nb + c16) * RG_ROWB + tg * 16), b1x = *(const LAS bf16x8*)(lds + RG_WT + (64 + 16 * nb + c16) * RG_ROWB + tg * 16 + 64);
            f32x4 acca = __builtin_amdgcn_mfma_f32_16x16x32_bf16(a0, b0a, (f32x4){0.f, 0.f, 0.f, 0.f}, 0, 0, 0); acca = __builtin_amdgcn_mfma_f32_16x16x32_bf16(a1, b1a, acca, 0, 0, 0);
            f32x4 accx = __builtin_amdgcn_mfma_f32_16x16x32_bf16(a0, b0x, (f32x4){0.f, 0.f, 0.f, 0.f}, 0, 0, 0); accx = __builtin_amdgcn_mfma_f32_16x16x32_bf16(a1, b1x, accx, 0, 0, 0);
            const u32x2 ucr = *(const LAS u32x2*)(img + (16 * nb + c16) * RG_IROW + (16 * w + 4 * tg) * 2);
            const float ucv[4] = {__builtin_bit_cast(float, ucr[0] << 16), __builtin_bit_cast(float, ucr[0] & 0xffff0000u), __builtin_bit_cast(float, ucr[1] << 16), __builtin_bit_cast(float, ucr[1] & 0xffff0000u)};
            float H = 0.f, P = 1.f;
#pragma unroll
            for (int rg_ = 0; rg_ < 4; ++rg_) {
                const float r = fast_sigmoid(acca[rg_] + ba[nb]), ig = fast_sigmoid(accx[rg_] + bxb[nb]);
                const float a = __expf(r * sp8[nb]);
                av[blk][nb][rg_] = a; bv[blk][nb][rg_] = __builtin_amdgcn_sqrtf((1.0f - a) * (1.0f + a)) * (ig * ucv[rg_]);
                H = a * H + bv[blk][nb][rg_]; P *= a; }
            float cp = 1.f, chh = 0.f, Pt = 1.f, Ht = 0.f;
#pragma unroll
            for (int k = 0; k < 4; ++k) { const float Pk = __shfl(P, c16 + 16 * k), Hk = __shfl(H, c16 + 16 * k);
                cp = (k == tg) ? Pt : cp; chh = (k == tg) ? Ht : chh;
                Ht = Pk * Ht + Hk; Pt *= Pk; }
            cP[blk][nb] = cp; cH[blk][nb] = chh;
            if (tg == 0) seg[(blk * 8 + w) * 64 + 16 * nb + c16] = (f32x2){Pt, Ht};
        }
        LDS_WAIT(); asm volatile("" ::: "memory");
    }
    __syncthreads();
    if (tid < 64) {
        float Pp = 1.f, Hp = 0.f;
#pragma unroll
        for (int s = 0; s < 16; ++s) { pre[s * 64 + tid] = (f32x2){Pp, Hp}; const f32x2 sv = seg[s * 64 + tid]; Hp = sv.x * Hp + sv.y; Pp *= sv.x; }
        unsigned long long* g = gran + ((size_t)((b * 8 + hb) * 8 + kc) * 2) * 64 + tid;
        __hip_atomic_store(g, (1ull << 32) | __builtin_bit_cast(unsigned, Pp), __ATOMIC_RELAXED, __HIP_MEMORY_SCOPE_AGENT);
        __hip_atomic_store(g + 64, (1ull << 32) | __builtin_bit_cast(unsigned, Hp), __ATOMIC_RELAXED, __HIP_MEMORY_SCOPE_AGENT);
        float h = 0.f;
        for (int j = 0; j < kc; ++j) {
            const unsigned long long* gj = gran + ((size_t)((b * 8 + hb) * 8 + j) * 2) * 64 + tid;
            unsigned long long vp, vh; unsigned spins = 0;
            for (;;) { vp = __hip_atomic_load(gj, __ATOMIC_RELAXED, __HIP_MEMORY_SCOPE_AGENT); vh = __hip_atomic_load(gj + 64, __ATOMIC_RELAXED, __HIP_MEMORY_SCOPE_AGENT);
                if (__all(((vp >> 32) != 0ull) && ((vh >> 32) != 0ull))) break; __builtin_amdgcn_s_sleep(2); if (++spins > (1u << 20)) break; }
            h = __builtin_bit_cast(float, (unsigned)vp) * h + __builtin_bit_cast(float, (unsigned)vh);
        }
        car[tid] = h;
    }
    __syncthreads();
#pragma unroll
    for (int blk = 0; blk < 2; ++blk) {
        const int t0 = blk * 128 + 16 * w;
        float ysum[4] = {0.f, 0.f, 0.f, 0.f};
#pragma unroll
        for (int nb = 0; nb < 4; ++nb) {
            const int oc = 16 * nb + c16; const f32x2 pf = pre[(blk * 8 + w) * 64 + oc];
            float hcur = cP[blk][nb] * (pf.x * car[oc] + pf.y) + cH[blk][nb];
            bf16_t* orow = mixb + ((size_t)b * S + s0 + t0 + 4 * tg) * D + hb * 64 + oc;
#pragma unroll
            for (int i = 0; i < 4; ++i) { hcur = av[blk][nb][i] * hcur + bv[blk][nb][i];
                const float g = bf2f(graw[blk][nb][i]), u2 = 1.5957691216057308f * (g + 0.044715f * g * g * g);
                const float y = hcur * g * fast_sigmoid(u2);
                orow[(size_t)i * D] = (bf16_t)(cvtpk_s(y, y) & 0xffffu); ysum[i] += y * y; }
        }
#pragma unroll
        for (int i = 0; i < 4; ++i) ysum[i] += __shfl_xor(ysum[i], 1);
#pragma unroll
        for (int i = 0; i < 4; ++i) ysum[i] += __shfl_xor(ysum[i], 2);
#pragma unroll
        for (int i = 0; i < 4; ++i) ysum[i] += __shfl_xor(ysum[i], 4);
#pragma unroll
        for (int i = 0; i < 4; ++i) ysum[i] += __shfl_xor(ysum[i], 8);
        if (c16 == 0) { float* sq = ssq + ((size_t)b * S + s0 + t0 + 4 * tg) * SSQW + hb * 4;
#pragma unroll
            for (int i = 0; i < 4; ++i) *(f32x4*)(sq + (size_t)i * SSQW) = (f32x4){ysum[i], 0.f, 0.f, 0.f}; }
    }
}

constexpr int RT_WT = 0, RT_LDK = 1028, RT_PART = 82432, RT_SSP = 98816, RT_REC = 99328;
__device__ __forceinline__ void ph_router3(const Params& p, const float* h, int* gcount, int* tok_list, float* w_list, float* r_list, LAS unsigned char* lds) {
    const int tid = opaque_tid(), lane = tid & 63, w = __builtin_amdgcn_readfirstlane(tid >> 6), t16 = lane & 15, g = lane >> 4;
    LAS float* wt = (LAS float*)(lds + RT_WT); LAS float* part = (LAS float*)(lds + RT_PART); LAS float* ssp = (LAS float*)(lds + RT_SSP);
    LAS int* lcnt = (LAS int*)(lds + RT_REC); LAS int* lbase = lcnt + 16; LAS int* rec_e = lcnt + 32; LAS int* rec_s = lcnt + 160; LAS float* rec_w = (LAS float*)(lcnt + 288); LAS float* rec_r = (LAS float*)(lcnt + 416);
    { const f32x4* srcw = (const f32x4*)(p.ws + WS_RWT); LAS f32x4* dstw = (LAS f32x4*)wt;
      for (int idx = tid; idx < 20 * RT_LDK / 4; idx += NTHR) dstw[idx] = srcw[idx]; }
    const int task = w & 3, khalf = w >> 2, kbase = khalf * 512 + g * 128;
    for (int grp = blockIdx.x; grp < T / 64; grp += gridDim.x) {
        if (tid < 16) lcnt[tid] = 0;
        __syncthreads();
        {
            const f32x4* hrow = (const f32x4*)(h + (size_t)(grp * 64 + task * 16 + t16) * D + kbase);
            const LAS f32x4* b0p = (const LAS f32x4*)(wt + t16 * RT_LDK + kbase); const LAS f32x4* b1p = (const LAS f32x4*)(wt + (16 + (lane & 3)) * RT_LDK + kbase);
            f32x4 acc0 = {0.f, 0.f, 0.f, 0.f}, acc1 = {0.f, 0.f, 0.f, 0.f}; float ss = 0.f;
#pragma unroll 1
            for (int jb = 0; jb < 32; jb += 8) {
                f32x4 a[8];
#pragma unroll
                for (int j = 0; j < 8; ++j) a[j] = hrow[jb + j];
#pragma unroll
                for (int j = 0; j < 8; ++j) { const f32x4 b0 = b0p[jb + j], b1 = b1p[jb + j];
#pragma unroll
                    for (int q = 0; q < 4; ++q) { acc0 = __builtin_amdgcn_mfma_f32_16x16x4f32(a[j][q], b0[q], acc0, 0, 0, 0); acc1 = __builtin_amdgcn_mfma_f32_16x16x4f32(a[j][q], b1[q], acc1, 0, 0, 0); ss += a[j][q] * a[j][q]; } }
            }
            ss += __shfl_xor(ss, 16); ss += __shfl_xor(ss, 32);
            if (g == 0) ssp[khalf * 64 + task * 16 + t16] = ss;
            LAS float* pp = part + ((khalf * 4 + task) * 16 + 4 * g) * 32 + t16;
#pragma unroll
            for (int rg_ = 0; rg_ < 4; ++rg_) { pp[rg_ * 32] = acc0[rg_]; pp[rg_ * 32 + 16] = acc1[rg_]; }
        }
        __syncthreads();
        if (tid < 64) {
            const float rstd = rsqrtf((ssp[tid] + ssp[64 + tid]) * (1.0f / D) + EPS);
            const LAS float* q0 = part + tid * 32; const LAS float* q1 = part + (64 + tid) * 32;
            float lg[4];
#pragma unroll
            for (int i = 0; i < 4; ++i) lg[i] = (q0[16 + i] + q1[16 + i]) * rstd + p.b_group[i];
            int gi = 0; float best = lg[0];
#pragma unroll
            for (int i = 1; i < 4; ++i) if (lg[i] > best) { best = lg[i]; gi = i; }
            float den = 0.f;
#pragma unroll
            for (int i = 0; i < 4; ++i) den += expf(lg[i] - best);
            const float pg = 1.0f / den;
            float sel[4];
#pragma unroll
            for (int i = 0; i < 4; ++i) sel[i] = (q0[gi * 4 + i] + q1[gi * 4 + i]) * rstd + p.b_router[gi * 4 + i];
            int i1 = 0; float v1 = sel[0];
#pragma unroll
            for (int i = 1; i < 4; ++i) if (sel[i] > v1) { v1 = sel[i]; i1 = i; }
            int i2 = -1; float v2 = -3.0e38f;
#pragma unroll
            for (int i = 0; i < 4; ++i) if (i != i1 && sel[i] > v2) { v2 = sel[i]; i2 = i; }
            const float e2 = expf(v2 - v1);
            const float w1 = pg / (1.0f + e2), w2 = pg * e2 / (1.0f + e2);
            const int ea = gi * 4 + i1, eb = gi * 4 + i2;
            const int sa = __hip_atomic_fetch_add(lcnt + ea, 1, __ATOMIC_RELAXED, __HIP_MEMORY_SCOPE_WORKGROUP);
            const int sb = __hip_atomic_fetch_add(lcnt + eb, 1, __ATOMIC_RELAXED, __HIP_MEMORY_SCOPE_WORKGROUP);
            rec_e[tid * 2] = ea; rec_s[tid * 2] = sa; rec_w[tid * 2] = w1; rec_r[tid * 2] = rstd;
            rec_e[tid * 2 + 1] = eb; rec_s[tid * 2 + 1] = sb; rec_w[tid * 2 + 1] = w2; rec_r[tid * 2 + 1] = rstd;
        }
        __syncthreads();
        if (tid < 16) lbase[tid] = __hip_atomic_fetch_add(gcount + tid, lcnt[tid], __ATOMIC_RELAXED, __HIP_MEMORY_SCOPE_AGENT);
        __syncthreads();
        if (tid < 128) { const int e = rec_e[tid]; const int pos = lbase[e] + rec_s[tid]; tok_list[e * T + pos] = grp * 128 + tid; w_list[e * T + pos] = rec_w[tid]; r_list[e * T + pos] = rec_r[tid]; }
        __syncthreads();
    }
}

__device__ void ph_final(const Params& p, const float* h, const bf16_t* y2, float* out) {
    const int tid = opaque_tid(), lane = tid & 63, wv = tid >> 6, nw = NWAVES;
#if PROBE >= 100
    const unsigned long long* tsw = (const unsigned long long*)(p.ws + WS_CTL + 32768);
    const float span_us_ = (float)(tsw[PROBE - 100] - tsw[PROBE - 101]) * 0.01f;
    const float pscale = 1.0f + floorf((span_us_ + PROBE_SHIFT) / 20.0f) * (20.0f / 3000.0f);
#else
    const float pscale = 1.0f;
#endif
    for (int t = blockIdx.x * nw + wv; t < T; t += gridDim.x * nw) {
        const f32x4* hr = (const f32x4*)(h + (size_t)t * D) + lane;
        const u32x2* y0 = (const u32x2*)(y2 + (size_t)(2 * t) * D) + lane; const u32x2* y1 = (const u32x2*)(y2 + (size_t)(2 * t + 1) * D) + lane;
        f32x4 v[4]; float ss = 0.f;
#pragma unroll
        for (int j = 0; j < 4; ++j) { const f32x4 hv = hr[64 * j]; const u32x2 a = y0[64 * j], b = y1[64 * j];
            v[j][0] = hv[0] + __builtin_bit_cast(float, a[0] << 16) + __builtin_bit_cast(float, b[0] << 16);
            v[j][1] = hv[1] + __builtin_bit_cast(float, a[0] & 0xffff0000u) + __builtin_bit_cast(float, b[0] & 0xffff0000u);
            v[j][2] = hv[2] + __builtin_bit_cast(float, a[1] << 16) + __builtin_bit_cast(float, b[1] << 16);
            v[j][3] = hv[3] + __builtin_bit_cast(float, a[1] & 0xffff0000u) + __builtin_bit_cast(float, b[1] & 0xffff0000u);
            ss += (v[j][0] * v[j][0] + v[j][1] * v[j][1]) + (v[j][2] * v[j][2] + v[j][3] * v[j][3]); }
        const float r = rsqrtf(wave_sum(ss) * (1.0f / D) + EPS);
        f32x4* orow = (f32x4*)(out + (size_t)t * D) + lane;
#pragma unroll
        for (int j = 0; j < 4; ++j) { const f32x4 gf = *((const f32x4*)p.final_g + lane + 64 * j); orow[64 * j] = v[j] * r * gf * pscale; }
    }
}


__device__ __forceinline__ void ph_mixers(const Params& p, const bf16_t* z, bf16_t* mixb, float* ssq, LAS unsigned char* lds, unsigned* qctr) {
    const AttnCtx A = attn_setup(p, lds, TAB_OFF);
    volatile LAS int* qword = (volatile LAS int*)(lds + TAB_OFF + 12288);
    constexpr int NQ = NB, QITEMS = 64 + 64;
    unsigned long long* gran = (unsigned long long*)(p.ws + WS_CTL + 128 * 1024);
    const int qstep = (int)gridDim.x < NQ ? (int)gridDim.x : NQ;
    for (int q = blockIdx.x % NQ; q < NQ; q += qstep) {
        int ticket = 0;
        if (threadIdx.x == 0) ticket = (int)__hip_atomic_fetch_add(qctr + 64 * q, 1u, __ATOMIC_RELAXED, __HIP_MEMORY_SCOPE_AGENT);
        for (;;) {
            __syncthreads();
            if (threadIdx.x == 0) { *qword = ticket; if (ticket < QITEMS) ticket = (int)__hip_atomic_fetch_add(qctr + 64 * q, 1u, __ATOMIC_RELAXED, __HIP_MEMORY_SCOPE_AGENT); }
            __syncthreads();
            const int idx = *qword;
            if (idx >= QITEMS) break;
            if (idx < 64) rglru_item(p, z, mixb, ssq, lds, gran, q, idx & 7, idx >> 3);
            else { const int a = idx - 64; attn_item(A, z, mixb, ssq, q, 31 - (a >> 1), a & 1); }
        }
    }
}

#define XB_TMO      128
#define XB_XCNT(j)  (256  + 64 * (j))
#define XB_XSUB(j)  (1280 + 64 * (j))
#define XB_XGEN(j)  (2304 + 64 * (j))
#define XB_TOP      3328
#define XB_TOPGEN   3392
#define XCD_BAR_WORDS 3456
#define XB_SPIN_CAP (1u << 18)
__device__ __forceinline__ unsigned xb_ld(unsigned* p)              { return __hip_atomic_load(p, __ATOMIC_RELAXED, __HIP_MEMORY_SCOPE_AGENT); }
__device__ __forceinline__ unsigned xb_add(unsigned* p, unsigned v) { return __hip_atomic_fetch_add(p, v, __ATOMIC_RELAXED, __HIP_MEMORY_SCOPE_AGENT); }
__device__ __forceinline__ unsigned xb_xcc_id() { return (unsigned)__builtin_amdgcn_s_getreg((3 << 11) | 20) & 0xFu; }
#define XB_SPIN(cond, bar) do { unsigned _sp = 0; while (cond) { __builtin_amdgcn_s_sleep(1); \
    if ((++_sp & 255u) == 0u) { if (xb_ld(&(bar)[XB_TMO])) break; if (_sp > XB_SPIN_CAP) { atomicAdd(&(bar)[XB_TMO], 1u); break; } } } } while (0)
struct XcdBarrier { unsigned* bar; unsigned x; volatile LAS unsigned* st; };
__device__ __forceinline__ XcdBarrier xcd_barrier_post(unsigned* bar, volatile LAS unsigned* st) {
    XcdBarrier b; b.bar = bar; b.x = xb_xcc_id(); b.st = st;
    if (threadIdx.x == 0) (void)xb_add(&bar[XB_XCNT(b.x)], 1u);
    return b;
}
__device__ __forceinline__ void xcd_barrier_complete(unsigned* bar, unsigned x, unsigned& nloc, unsigned& nx) {
    const unsigned G = gridDim.x * gridDim.y * gridDim.z;
    unsigned sum, cnt, mine, sp = 0u;
    for (;;) {
        sum = 0u; cnt = 0u; mine = 0u;
#pragma unroll
        for (unsigned j = 0; j < 16; ++j) { const unsigned c = xb_ld(&bar[XB_XCNT(j)]); sum += c; cnt += (c > 0u) ? 1u : 0u; mine = (j == x) ? c : mine; }
        if (sum == G) break;
        __builtin_amdgcn_s_sleep(1);
        if ((++sp & 255u) == 0u) { if (xb_ld(&bar[XB_TMO])) break; if (sp > XB_SPIN_CAP) { atomicAdd(&bar[XB_TMO], 1u); break; } }
    }
    nloc = mine > 0u ? mine : 1u; nx = cnt > 0u ? cnt : 1u;
}
__device__ __forceinline__ void xcd_barrier(const XcdBarrier& b) {
    asm volatile("s_waitcnt vmcnt(0)" ::: "memory");
    __syncthreads();
    if (threadIdx.x == 0) {
        unsigned* bar = b.bar;
        __builtin_amdgcn_s_waitcnt(0);
        unsigned nloc = b.st[0], nx = b.st[1];
        if (nloc == 0u) { xcd_barrier_complete(bar, b.x, nloc, nx); b.st[0] = nloc; b.st[1] = nx; }
        const unsigned old = xb_add(&bar[XB_XSUB(b.x)], 1u);
        const unsigned gen = old / nloc;
        if (old + 1u == (gen + 1u) * nloc) {
            __builtin_amdgcn_fence(__ATOMIC_RELEASE, "agent");
            asm volatile("s_waitcnt vmcnt(0)" ::: "memory");
            const unsigned og = xb_add(&bar[XB_TOP], 1u);
            const unsigned tg = og / nx;
            if (og + 1u == (tg + 1u) * nx) xb_add(&bar[XB_TOPGEN], 1u);
            else XB_SPIN(xb_ld(&bar[XB_TOPGEN]) == tg, bar);
            __builtin_amdgcn_fence(__ATOMIC_ACQUIRE, "agent");
            xb_add(&bar[XB_XGEN(b.x)], 1u);
            asm volatile("s_waitcnt vmcnt(0)" ::: "memory");
        } else {
            XB_SPIN(xb_ld(&bar[XB_XGEN(b.x)]) == gen, bar);
            __builtin_amdgcn_fence(__ATOMIC_ACQUIRE, "agent");
            asm volatile("s_waitcnt vmcnt(0)" ::: "memory");
        }
    }
    __syncthreads();
}


__global__ void __launch_bounds__(NTHR) k_mega(Params p) {
    extern __shared__ __attribute__((aligned(16))) unsigned char lds_raw[];
    LAS unsigned char* lds = (LAS unsigned char*)lds_raw;
    const int G = gridDim.x; const int bx = blockIdx.x;
    volatile LAS unsigned* misc = (volatile LAS unsigned*)(lds + MISC_OFF);
    if (threadIdx.x < 64) misc[threadIdx.x] = 0u;
    __syncthreads();
    const XcdBarrier xbar = xcd_barrier_post((unsigned*)(p.ws + WS_CTL + 65536), misc + 8);
    const int vcu = (G % 8 == 0) ? (bx % 8) * (G / 8) + bx / 8 : bx;
#if PROBE >= 100
    unsigned long long* tsw = (unsigned long long*)(p.ws + WS_CTL + 32768); int tsn = 0;
#define TSTAMP() do { if (blockIdx.x == 0 && threadIdx.x == 0) tsw[tsn] = __builtin_amdgcn_s_memrealtime(); ++tsn; } while (0)
    TSTAMP();
#else
#define TSTAMP() do {} while (0)
#endif
    bf16_t* win_t = (bf16_t*)(p.ws + WS_WIN); bf16_t* wout_t = (bf16_t*)(p.ws + WS_WOUT);
    bf16_t* xb = (bf16_t*)(p.ws + WS_XB); bf16_t* zb = (bf16_t*)(p.ws + WS_Z); bf16_t* mixb = (bf16_t*)(p.ws + WS_MIX);
    float* ssq = (float*)(p.ws + WS_SSQ);
    bf16_t* xn2b = (bf16_t*)(p.ws + WS_XB);
    float* h = p.out;

    ph_prologue(p, lds, vcu, G);
#if PROBE == 1
    ph_prologue(p, lds, vcu, G); ph_prologue(p, lds, vcu, G);
#endif
    xcd_barrier(xbar);
    TSTAMP();
    {
        pg8::DenseOrder So; So.init(xb, win_t, T, INW, D, G, bx);
        pg8::EpiZ E{zb, INW};
        pg8::gemm_phase(lds, D, So, E);
#if PROBE == 2
        pg8::gemm_phase(lds, D, So, E); pg8::gemm_phase(lds, D, So, E);
#endif
    }
    xcd_barrier(xbar);
    TSTAMP();
    ph_mixers(p, zb, mixb, ssq, lds, (unsigned*)(p.ws + WS_CTL + 8192));
#if PROBE == 3
    ph_mixers(p, zb, mixb, ssq, lds, (unsigned*)(p.ws + WS_CTL + 8192 + 2048)); ph_mixers(p, zb, mixb, ssq, lds, (unsigned*)(p.ws + WS_CTL + 8192 + 4096));
#endif
    xcd_barrier(xbar);
    TSTAMP();
    {
        pg8::DenseOrder So; So.init(mixb, wout_t, T, D, D, G, bx);
        pg8::EpiH E{ssq, p.x, h, xn2b, TAB_OFF};
        pg8::gemm_phase(lds, D, So, E);
#if PROBE == 4
        pg8::gemm_phase(lds, D, So, E); pg8::gemm_phase(lds, D, So, E);
#endif
    }
    xcd_barrier(xbar);
    TSTAMP();
    int* gcount = (int*)(p.ws + WS_CTL + 4096); int* tok_list = (int*)(p.ws + WS_LIST); float* w_list = (float*)(p.ws + WS_LIST + MiB);
    bf16_t* wgu_t = (bf16_t*)(p.ws + WS_WGU); bf16_t* wd_t = (bf16_t*)(p.ws + WS_WD); bf16_t* hid = (bf16_t*)(p.ws + WS_HID); bf16_t* y2 = (bf16_t*)(p.ws + WS_Z);
    float* r_list = (float*)(p.ws + WS_ROUTE);
    ph_router3(p, h, gcount, tok_list, w_list, r_list, lds);
#if PROBE == 5
    ph_router3(p, h, (int*)(p.ws + WS_CTL + 16384), (int*)(p.ws + WS_HID), (float*)(p.ws + WS_HID + MiB), (float*)(p.ws + WS_HID + 2 * MiB), lds);
    ph_router3(p, h, (int*)(p.ws + WS_CTL + 16384 + 256), (int*)(p.ws + WS_HID + 4 * MiB), (float*)(p.ws + WS_HID + 5 * MiB), (float*)(p.ws + WS_HID + 6 * MiB), lds);
#endif
    xcd_barrier(xbar);
    TSTAMP();
    LAS int* meta = (LAS int*)(lds + META_OFF);
    if (threadIdx.x == 0) { int base = 0; for (int e = 0; e < NE; ++e) { const int cnt = gcount[e]; meta[e] = base; meta[32 + e] = cnt; base += (cnt + 255) >> 8; } meta[16] = base; }
    __syncthreads();
    const int ntiles = meta[16];
    {
        pg8::MoeOrder<0> So{xn2b, wgu_t, tok_list, meta, D, G, bx, ntiles};
        pg8::EpiHid E{hid, r_list, meta};
        pg8::gemm_phase(lds, D, So, E);
#if PROBE == 6
        pg8::gemm_phase(lds, D, So, E); pg8::gemm_phase(lds, D, So, E);
#endif
    }
    xcd_barrier(xbar);
    TSTAMP();
    {
        pg8::MoeOrder<1> So{hid, wd_t, tok_list, meta, DFF, G, bx, ntiles};
        pg8::EpiY E{y2, tok_list, w_list, meta};
        pg8::gemm_phase(lds, DFF, So, E);
#if PROBE == 7
        pg8::gemm_phase(lds, DFF, So, E); pg8::gemm_phase(lds, DFF, So, E);
#endif
    }
    xcd_barrier(xbar);
    TSTAMP();
#if PROBE == 8
    ph_final(p, h, y2, (float*)(p.ws + WS_MIX)); ph_final(p, h, y2, (float*)(p.ws + WS_MIX));
#endif
#if PROBE >= 100
    xcd_barrier(xbar);
#endif
    ph_final(p, h, y2, p.out);
}

extern "C" void kernel_launch(void* const* d_in, const int* in_sizes, int n_in, void* d_out, int out_size, void* d_ws, size_t ws_size, hipStream_t stream) {
    static int grid_blocks = 0;
    if (!grid_blocks) {
        if (ws_size < WS_END) { fprintf(stderr, "kernel_launch: workspace too small (%zu < %zu)\n", ws_size, (size_t)WS_END); grid_blocks = -1; return; }
        int dev = 0, cus = 0, per_cu = 0;
        (void)hipGetDevice(&dev);
        (void)hipDeviceGetAttribute(&cus, hipDeviceAttributeMultiprocessorCount, dev);
        (void)hipFuncSetAttribute((const void*)k_mega, hipFuncAttributeMaxDynamicSharedMemorySize, LDS_BYTES);
        (void)hipOccupancyMaxActiveBlocksPerMultiprocessor(&per_cu, (const void*)k_mega, NTHR, LDS_BYTES);
        if (per_cu < 1) { fprintf(stderr, "kernel_launch: occupancy query says %d blocks per CU: not launching\n", per_cu); grid_blocks = -1; return; }
        grid_blocks = cus;
    }
    if (grid_blocks < 0) return;
    Params p{};
    const float** f = (const float**)&p;
    for (int i = 0; i < 23; ++i) f[i] = (const float*)d_in[i];
    p.out = (float*)d_out;
    p.ws = (unsigned char*)d_ws;
    (void)hipMemsetAsync((char*)d_ws + WS_CTL, 0, CTL_ZERO_BYTES, stream);
    hipLaunchKernelGGL(k_mega, dim3(grid_blocks), dim3(NTHR), LDS_BYTES, stream, p);
    hipError_t e = hipPeekAtLastError();
    if (e != hipSuccess) fprintf(stderr, "launch failed: %s (grid %d)\n", hipGetErrorString(e), grid_blocks);
}
```

```cpp
#include <hip/hip_runtime.h>
#include <hip/hip_cooperative_groups.h>
#include <cstdio>
#include <cstdint>
namespace cg = cooperative_groups;

#ifndef PROBE
#define PROBE_SHIFT 0.0f
#define PROBE 0
#endif

#define LAS __attribute__((address_space(3)))
typedef unsigned short bf16_t;
typedef short bf16x8 __attribute__((ext_vector_type(8)));
typedef float f32x4 __attribute__((ext_vector_type(4)));
typedef float f32x2 __attribute__((ext_vector_type(2)));
typedef unsigned u32x4 __attribute__((ext_vector_type(4)));
typedef unsigned u32x2 __attribute__((ext_vector_type(2)));

constexpr int D = 1024, NB = 8, S = 2048, T = NB * S;
constexpr int RW = 512, RHD = 64;
constexpr int CHUNK = 64, LEFT = 8, BAND = 576, MAXREL = 128;
constexpr int INW = 2560;
constexpr int NE = 16, DFF = 512;
constexpr float EPS = 1e-6f;
constexpr int NTHR = 512, NWAVES = 8;
constexpr int SSQW = 40;

constexpr size_t MiB = 1u << 20;
constexpr size_t WS_CTL = 0, CTL_BYTES = 2 * MiB, CTL_ZERO_BYTES = 128 * 1024 + 512 * 1024;
constexpr size_t WS_WIN = 2 * MiB;
constexpr size_t WS_WOUT = 7 * MiB;
constexpr size_t WS_WGU = 9 * MiB;
constexpr size_t WS_WD = 41 * MiB;
constexpr size_t WS_XB = 57 * MiB;
constexpr size_t WS_Z = 89 * MiB;
constexpr size_t WS_MIX = 169 * MiB;
constexpr size_t WS_HID = 201 * MiB;
constexpr size_t WS_SSQ = 237 * MiB;
constexpr size_t WS_LIST = 240 * MiB;
constexpr size_t WS_ROUTE = 242 * MiB;
constexpr size_t WS_RWT = 243 * MiB;
constexpr size_t WS_GWT = 244 * MiB;
constexpr size_t WS_END = 245 * MiB;

constexpr int RING_BYTES = 131072, TAB_OFF = RING_BYTES, META_OFF = RING_BYTES + 4096, MISC_OFF = RING_BYTES + 15360, LDS_BYTES = 147456;

struct Params {
    const float *x, *norm1_g, *w_in, *conv_w, *conv_b, *w_rg_a, *b_rg_a, *w_rg_x, *b_rg_x, *lru_lambda, *rel_bias,
        *g_rec_out, *g_att_out, *w_out, *norm2_g, *w_group, *b_group, *w_router, *b_router, *w_e_gate, *w_e_up, *w_e_down, *final_g;
    float* out;
    unsigned char* ws;
};

__device__ __forceinline__ float wave_sum(float v) {
#pragma unroll
    for (int o = 32; o > 0; o >>= 1) v += __shfl_xor(v, o);
    return v;
}
__device__ __forceinline__ float sigmoidf_(float x) { return 1.0f / (1.0f + expf(-x)); }
__device__ __forceinline__ float gelu_tanh(float x) { return 0.5f * x * (1.0f + tanhf(0.7978845608028654f * (x + 0.044715f * x * x * x))); }
__device__ __forceinline__ unsigned f2bf(float f) { unsigned u = __builtin_bit_cast(unsigned, f); return (u + 0x7fffu + ((u >> 16) & 1u)) >> 16; }
__device__ __forceinline__ unsigned pk2(float lo, float hi) { return f2bf(lo) | (f2bf(hi) << 16); }
__device__ __forceinline__ float bf2f(bf16_t b) { return __builtin_bit_cast(float, ((unsigned)b) << 16); }
__device__ __forceinline__ unsigned cvt_pk_bf16(float lo, float hi) { unsigned r; asm volatile("v_cvt_pk_bf16_f32 %0, %1, %2" : "=v"(r) : "v"(lo), "v"(hi)); return r; }
#define LDS_WAIT() asm volatile("s_waitcnt lgkmcnt(0)" ::: "memory")
__device__ __forceinline__ int opaque_tid() { int t = threadIdx.x; asm volatile("" : "+v"(t)); return t; }

namespace pg8 {
constexpr int BM = 256, BK = 64, HALF = 128, HTB = HALF * BK * 2, STAGE_BYTES = 8 * HTB, NXCD = 8, WGM = 8;
__device__ __forceinline__ int lds_byte(int r, int c) { const int st = (r >> 4) * 2 + (c >> 5), rr = r & 15, cc = c & 31, ob = rr * 64 + cc * 2; return st * 1024 + (ob ^ (((ob >> 9) & 1) << 5)); }
__device__ __forceinline__ void stage_rc(int b, int& R, int& C) { const int st = b / 1024, sb = b % 1024, swz = sb ^ (((sb >> 9) & 1) << 5); R = (st >> 1) * 16 + swz / 64; C = (st & 1) * 32 + (swz % 64) / 2; }
__device__ __forceinline__ int perm32(int rho) { const int n = rho >> 4, i = rho & 15; return 8 * (i >> 2) + 4 * n + (i & 3); }

struct Unit { int pm, pn, e, rows; };

struct DenseOrder {
    const bf16_t* A; const bf16_t* Bt; int K; int nM, nN, nwg, G, c;
    __device__ void init(const bf16_t* A_, const bf16_t* Bt_, int M, int N, int K_, int G_, int c_) { A = A_; Bt = Bt_; K = K_; nM = M / BM; nN = N / BM; nwg = nM * nN; G = G_; c = c_; }
    __device__ __forceinline__ bool next(int i, Unit& u) const {
        const long L = (long)i * G + c; if (L >= nwg) return false;
        int wgid = (int)L; { const int q = nwg / NXCD, r = nwg % NXCD, xcd = wgid % NXCD, off = wgid / NXCD; wgid = (xcd < r ? xcd * (q + 1) : r * (q + 1) + (xcd - r) * q) + off; }
        const int nig = WGM * nN, gid = wgid / nig, fm = gid * WGM, gsz = (nM - fm) < WGM ? (nM - fm) : WGM;
        u.pm = fm + ((wgid % nig) % gsz); u.pn = (wgid % nig) / gsz; u.e = 0; u.rows = BM; return true;
    }
    __device__ __forceinline__ void addr(const Unit& u, const int (&RA)[2], const int (&CA)[2], const char*& aBase, const char*& bBase, unsigned (&va)[2][2]) const {
        aBase = (const char*)A; bBase = (const char*)Bt + (size_t)u.pn * BM * K * 2;
#pragma unroll
        for (int h = 0; h < 2; ++h)
#pragma unroll
            for (int i = 0; i < 2; ++i) va[h][i] = (unsigned)(((size_t)(u.pm * BM + h * HALF + RA[i]) * K + CA[i]) * 2);
    }
};

template <class Epi, class Sched>
__device__ __forceinline__ void gemm_phase(LAS unsigned char* lds, const int K, const Sched& S, const Epi& E) {
    int tid_ = threadIdx.x; asm volatile("" : "+v"(tid_));
    const int tid = tid_, wid = __builtin_amdgcn_readfirstlane(tid >> 6), lane = tid & 63, wr = wid >> 2, wc = wid & 3, fr = lane & 15, fq = lane >> 4;
    const int nt = K / BK;
    int RA[2], CA[2]; unsigned voffB[2];
#pragma unroll
    for (int i = 0; i < 2; ++i) { int R, C; stage_rc(tid * 16 + i * 8192, R, C); RA[i] = R; CA[i] = C; const int Rb = Epi::PERM ? ((R & ~31) + perm32(R & 31)) : R; voffB[i] = (unsigned)(Rb * K + C) * 2u; }
    const size_t kstep = (size_t)(BK * 2);
    const size_t hstepB = (size_t)HALF * K * 2;
    const unsigned ldsw = (unsigned)wid * 1024u;
    const int aoff = lds_byte(wr * 64 + fr, fq * 8), boff = lds_byte(wc * 32 + fr, fq * 8);
#define PG8_SA(b, h) (((b) * 2 + (h)) * HTB)
#define PG8_SB(b, h) ((4 + (b) * 2 + (h)) * HTB)
#define PG8_STAGE_B(bufoff, gbase) do { _Pragma("unroll") for (int _i = 0; _i < 2; ++_i) \
        __builtin_amdgcn_global_load_lds((const unsigned*)((const char*)(gbase) + voffB[_i]), (LAS unsigned*)(lds + (bufoff) + ldsw + _i * 8192), 16, 0, 0); } while (0)
#define PG8_STAGE_A(bufoff, gbase, v0, v1) do { \
        __builtin_amdgcn_global_load_lds((const unsigned*)((const char*)(gbase) + (v0)), (LAS unsigned*)(lds + (bufoff) + ldsw), 16, 0, 0); \
        __builtin_amdgcn_global_load_lds((const unsigned*)((const char*)(gbase) + (v1)), (LAS unsigned*)(lds + (bufoff) + ldsw + 8192), 16, 0, 0); } while (0)
#define PG8_LDA(dst, b, h) do { _Pragma("unroll") for (int m = 0; m < 4; ++m) _Pragma("unroll") for (int k = 0; k < 2; ++k) dst[m][k] = *(const LAS bf16x8*)(lds + PG8_SA(b, h) + aoff + m * 2048 + k * 1024); } while (0)
#define PG8_LDB(dst, b, h) do { _Pragma("unroll") for (int n = 0; n < 2; ++n) _Pragma("unroll") for (int k = 0; k < 2; ++k) dst[n][k] = *(const LAS bf16x8*)(lds + PG8_SB(b, h) + boff + n * 2048 + k * 1024); } while (0)
#define PG8_MMA(ai, bj, At, Bt) do { __builtin_amdgcn_s_setprio(1); _Pragma("unroll") for (int m = 0; m < 4; ++m) _Pragma("unroll") for (int n = 0; n < 2; ++n) _Pragma("unroll") for (int k = 0; k < 2; ++k) \
        acc[ai][bj][m][n] = __builtin_amdgcn_mfma_f32_16x16x32_bf16(Bt[n][k], At[m][k], acc[ai][bj][m][n], 0, 0, 0); __builtin_amdgcn_s_setprio(0); } while (0)
#define PG8_WAIT_V(n) asm volatile("s_waitcnt vmcnt(" #n ")" ::: "memory")
#define PG8_WAIT_L(n) asm volatile("s_waitcnt lgkmcnt(" #n ")" ::: "memory")
#define PG8_BAR __builtin_amdgcn_s_barrier()
#define PG8_SCHED __builtin_amdgcn_sched_barrier(0)
    Unit cur, nxt; int ui = 0;
    if (!S.next(0, cur)) return;
    f32x4 acc[2][2][4][2];
#pragma unroll
    for (int a = 0; a < 2; ++a)
#pragma unroll
        for (int b = 0; b < 2; ++b)
#pragma unroll
            for (int m = 0; m < 4; ++m)
#pragma unroll
                for (int n = 0; n < 2; ++n) acc[a][b][m][n] = (f32x4){0.f, 0.f, 0.f, 0.f};
    bf16x8 At[4][2], B0[2][2], B1[2][2];
    const char *cA, *cB, *nA, *nB; unsigned cva[2][2], nva[2][2];
    S.addr(cur, RA, CA, cA, cB, cva);
    E.prepare(cur, ui, lds);
    PG8_STAGE_B(PG8_SB(0, 0), cB); PG8_STAGE_A(PG8_SA(0, 0), cA, cva[0][0], cva[0][1]); PG8_STAGE_B(PG8_SB(0, 1), cB + hstepB); PG8_STAGE_A(PG8_SA(0, 1), cA, cva[1][0], cva[1][1]);
    if (wr == 1) PG8_BAR;
    PG8_WAIT_V(4); PG8_BAR;
    PG8_STAGE_B(PG8_SB(1, 0), cB + kstep); PG8_STAGE_A(PG8_SA(1, 0), cA + kstep, cva[0][0], cva[0][1]); PG8_STAGE_B(PG8_SB(1, 1), cB + hstepB + kstep);
    PG8_WAIT_V(6); PG8_BAR;
    for (;;) {
        const bool has_next = S.next(ui + 1, nxt);
        if (has_next) { S.addr(nxt, RA, CA, nA, nB, nva); }
        else { nA = cA; nB = cB;
#pragma unroll
            for (int h = 0; h < 2; ++h)
#pragma unroll
                for (int i = 0; i < 2; ++i) nva[h][i] = cva[h][i]; }
        for (int t = 0; t < nt; t += 2) {
            const bool last = (t == nt - 2);
            if (Epi::MIDSCALE && t == nt / 2) E.midscale(acc, wr, fr, ui, lds);
            const char* a1 = cA + (size_t)(t + 1) * kstep;
            const char* a2 = last ? nA : cA + (size_t)(t + 2) * kstep; const char* b2 = last ? nB : cB + (size_t)(t + 2) * kstep;
            const char* a3 = a2 + kstep; const char* b3 = b2 + kstep;
            const unsigned x00 = last ? nva[0][0] : cva[0][0], x01 = last ? nva[0][1] : cva[0][1], x10 = last ? nva[1][0] : cva[1][0], x11 = last ? nva[1][1] : cva[1][1];
            if (last && has_next) E.prepare(nxt, ui + 1, lds);
            PG8_LDB(B0, 0, 0); PG8_SCHED; PG8_LDA(At, 0, 0); PG8_STAGE_A(PG8_SA(1, 1), a1, cva[1][0], cva[1][1]);
            PG8_WAIT_L(8); PG8_BAR; PG8_WAIT_L(0); PG8_MMA(0, 0, At, B0); PG8_BAR; PG8_SCHED;
            PG8_LDB(B1, 0, 1); PG8_STAGE_B(PG8_SB(0, 0), b2);
            PG8_BAR; PG8_WAIT_L(0); PG8_MMA(0, 1, At, B1); PG8_BAR;
            PG8_LDA(At, 0, 1); PG8_STAGE_A(PG8_SA(0, 0), a2, x00, x01);
            PG8_BAR; PG8_WAIT_L(0); PG8_MMA(1, 0, At, B0); PG8_BAR; PG8_SCHED;
            PG8_STAGE_B(PG8_SB(0, 1), b2 + hstepB);
            PG8_WAIT_V(6); PG8_BAR; PG8_MMA(1, 1, At, B1); PG8_BAR;
            PG8_LDB(B0, 1, 0); PG8_SCHED; PG8_LDA(At, 1, 0); PG8_STAGE_A(PG8_SA(0, 1), a2, x10, x11);
            PG8_WAIT_L(8); PG8_BAR; PG8_WAIT_L(0); PG8_MMA(0, 0, At, B0); PG8_BAR; PG8_SCHED;
            PG8_LDB(B1, 1, 1); PG8_STAGE_B(PG8_SB(1, 0), b3);
            PG8_BAR; PG8_WAIT_L(0); PG8_MMA(0, 1, At, B1); PG8_BAR;
            PG8_LDA(At, 1, 1); PG8_STAGE_A(PG8_SA(1, 0), a3, x00, x01);
            PG8_BAR; PG8_WAIT_L(0); PG8_MMA(1, 0, At, B0); PG8_BAR; PG8_SCHED;
            PG8_STAGE_B(PG8_SB(1, 1), b3 + hstepB);
            PG8_WAIT_V(6); PG8_BAR; PG8_MMA(1, 1, At, B1); PG8_BAR;
        }
        E(acc, cur, wr, wc, fr, fq, ui, lds);
        if (!has_next) break;
#pragma unroll
        for (int a = 0; a < 2; ++a)
#pragma unroll
            for (int b = 0; b < 2; ++b)
#pragma unroll
                for (int m = 0; m < 4; ++m)
#pragma unroll
                    for (int n = 0; n < 2; ++n) acc[a][b][m][n] = (f32x4){0.f, 0.f, 0.f, 0.f};
        cur = nxt; cA = nA; cB = nB; ++ui;
#pragma unroll
        for (int h = 0; h < 2; ++h)
#pragma unroll
            for (int i = 0; i < 2; ++i) cva[h][i] = nva[h][i];
    }
    PG8_WAIT_V(0);
    if (wr == 0) PG8_BAR;
    PG8_BAR;
#undef PG8_SA
#undef PG8_SB
#undef PG8_STAGE_A
#undef PG8_STAGE_B
#undef PG8_LDA
#undef PG8_LDB
#undef PG8_MMA
#undef PG8_WAIT_V
#undef PG8_WAIT_L
#undef PG8_BAR
#undef PG8_SCHED
}

struct EpiZ {
    static constexpr bool PERM = true, MIDSCALE = false;
    bf16_t* O; int ldc;
    __device__ __forceinline__ void prepare(const Unit&, int, LAS unsigned char*) const {}
    __device__ __forceinline__ void midscale(f32x4 (&)[2][2][4][2], int, int, int, LAS unsigned char*) const {}
    __device__ __forceinline__ void operator()(const f32x4 (&acc)[2][2][4][2], const Unit& u, int wr, int wc, int fr, int fq, int, LAS unsigned char*) const {
        const int row0 = u.pm * BM + wr * 64 + fr, col0 = u.pn * BM + wc * 32 + 8 * fq;
#pragma unroll
        for (int ai = 0; ai < 2; ++ai)
#pragma unroll
            for (int m = 0; m < 4; ++m) { bf16_t* rowp = O + (size_t)(row0 + ai * HALF + m * 16) * ldc + col0;
#pragma unroll
                for (int bj = 0; bj < 2; ++bj) { const f32x4 v0 = acc[ai][bj][m][0], v1 = acc[ai][bj][m][1];
                    u32x4 w; w.x = cvt_pk_bf16(v0[0], v0[1]); w.y = cvt_pk_bf16(v0[2], v0[3]); w.z = cvt_pk_bf16(v1[0], v1[1]); w.w = cvt_pk_bf16(v1[2], v1[3]);
                    *(u32x4*)(rowp + bj * HALF) = w; } }
    }
};
struct EpiH {
    static constexpr bool PERM = false, MIDSCALE = true;
    const float* ssq; const float* x; float* h; bf16_t* hb; int tab_off;
    __device__ __forceinline__ void prepare(const Unit& u, int ui, LAS unsigned char* lds) const {
        LAS f32x2* tab = (LAS f32x2*)(lds + tab_off) + (ui & 1) * 256;
        if (threadIdx.x < 256) {
            const float* sp = ssq + (size_t)(u.pm * BM + threadIdx.x) * SSQW; float sa = 0.f, sb = 0.f;
#pragma unroll
            for (int i = 0; i < 8; ++i) { const f32x4 v = *(const f32x4*)(sp + 4 * i); sa += (v[0] + v[1]) + (v[2] + v[3]); }
#pragma unroll
            for (int i = 8; i < 10; ++i) { const f32x4 v = *(const f32x4*)(sp + 4 * i); sb += (v[0] + v[1]) + (v[2] + v[3]); }
            const float ra = rsqrtf(sa * (1.0f / 512.0f) + EPS), rb = rsqrtf(sb * (1.0f / 512.0f) + EPS);
            tab[threadIdx.x] = (f32x2){ra / rb, rb};
        }
    }
    __device__ __forceinline__ void midscale(f32x4 (&acc)[2][2][4][2], int wr, int fr, int ui, LAS unsigned char* lds) const {
        const LAS f32x2* tab = (const LAS f32x2*)(lds + tab_off) + (ui & 1) * 256;
#pragma unroll
        for (int ai = 0; ai < 2; ++ai)
#pragma unroll
            for (int m = 0; m < 4; ++m) { const float s = tab[ai * HALF + wr * 64 + m * 16 + fr].x;
#pragma unroll
                for (int bj = 0; bj < 2; ++bj)
#pragma unroll
                    for (int n = 0; n < 2; ++n) acc[ai][bj][m][n] = acc[ai][bj][m][n] * s; }
    }
    __device__ __forceinline__ void operator()(const f32x4 (&acc)[2][2][4][2], const Unit& u, int wr, int wc, int fr, int fq, int ui, LAS unsigned char* lds) const {
        const LAS f32x2* tab = (const LAS f32x2*)(lds + tab_off) + (ui & 1) * 256;
        const int row0 = u.pm * BM + wr * 64 + fr, col0 = u.pn * BM + wc * 32 + 4 * fq;
#pragma unroll
        for (int ai = 0; ai < 2; ++ai)
#pragma unroll
            for (int m = 0; m < 4; ++m) { const float s = tab[ai * HALF + wr * 64 + m * 16 + fr].y; const size_t ro = (size_t)(row0 + ai * HALF + m * 16) * D + col0;
#pragma unroll
                for (int bj = 0; bj < 2; ++bj)
#pragma unroll
                    for (int n = 0; n < 2; ++n) { const f32x4 xv = *(const f32x4*)(x + ro + bj * HALF + n * 16); const f32x4 hv = xv + acc[ai][bj][m][n] * s;
                        *(f32x4*)(h + ro + bj * HALF + n * 16) = hv; *(u32x2*)(hb + ro + bj * HALF + n * 16) = (u32x2){cvt_pk_bf16(hv[0], hv[1]), cvt_pk_bf16(hv[2], hv[3])}; } }
    }
};

template <int MODE>
struct MoeOrder {
    const bf16_t* A; const bf16_t* Bt; const int* tok_list; const LAS int* meta; int K, G, c, ntiles;
    __device__ __forceinline__ bool next(int i, Unit& u) const {
        const int L = i * G + c; if (L >= ntiles * 4) return false;
        const int mt = L >> 2; int e = 0;
#pragma unroll
        for (int j = 1; j < NE; ++j) e += (mt >= meta[j]) ? 1 : 0;
        u.pm = mt; u.pn = L & 3; u.e = e; u.rows = meta[32 + e] - (mt - meta[e]) * BM; return true;
    }
    __device__ __forceinline__ void addr(const Unit& u, const int (&RA)[2], const int (&CA)[2], const char*& aBase, const char*& bBase, unsigned (&va)[2][2]) const {
        aBase = (const char*)A; bBase = (const char*)Bt + ((size_t)u.e * D + (size_t)u.pn * BM) * K * 2;
        const int slot0 = (u.pm - meta[u.e]) * BM;
#pragma unroll
        for (int h = 0; h < 2; ++h)
#pragma unroll
            for (int i = 0; i < 2; ++i) {
                const int r = h * HALF + RA[i];
                if (MODE == 0) { int tok = 0; if (r < u.rows) tok = tok_list[u.e * T + slot0 + r] >> 1; va[h][i] = (unsigned)(((size_t)tok * K + CA[i]) * 2); }
                else va[h][i] = (unsigned)(((size_t)(u.pm * BM + r) * K + CA[i]) * 2);
            }
    }
};
struct EpiHid {
    static constexpr bool PERM = true, MIDSCALE = false;
    bf16_t* hid; const float* r_list; const LAS int* meta;
    __device__ __forceinline__ void prepare(const Unit&, int, LAS unsigned char*) const {}
    __device__ __forceinline__ void midscale(f32x4 (&)[2][2][4][2], int, int, int, LAS unsigned char*) const {}
    __device__ __forceinline__ void operator()(const f32x4 (&acc)[2][2][4][2], const Unit& u, int wr, int wc, int fr, int fq, int, LAS unsigned char*) const {
        const int row0 = u.pm * BM + wr * 64 + fr, j0 = u.pn * 128 + wc * 16 + 4 * fq, slot0 = (u.pm - meta[u.e]) * BM;
#pragma unroll
        for (int ai = 0; ai < 2; ++ai)
#pragma unroll
            for (int m = 0; m < 4; ++m) { bf16_t* rowp = hid + (size_t)(row0 + ai * HALF + m * 16) * DFF + j0;
                const int r = ai * HALF + wr * 64 + m * 16 + fr; const float rs = (r < u.rows) ? r_list[u.e * T + slot0 + r] : 0.f;
#pragma unroll
                for (int bj = 0; bj < 2; ++bj) { const f32x4 g = acc[ai][bj][m][0] * rs, up = acc[ai][bj][m][1] * rs; float hv[4];
#pragma unroll
                    for (int q = 0; q < 4; ++q) hv[q] = g[q] * up[q] * __builtin_amdgcn_rcpf(1.0f + __expf(-g[q]));
                    *(u32x2*)(rowp + bj * 64) = (u32x2){cvt_pk_bf16(hv[0], hv[1]), cvt_pk_bf16(hv[2], hv[3])}; } }
    }
};
struct EpiY {
    static constexpr bool PERM = true, MIDSCALE = false;
    bf16_t* y2; const int* tok_list; const float* w_list; const LAS int* meta;
    __device__ __forceinline__ void prepare(const Unit&, int, LAS unsigned char*) const {}
    __device__ __forceinline__ void midscale(f32x4 (&)[2][2][4][2], int, int, int, LAS unsigned char*) const {}
    __device__ __forceinline__ void operator()(const f32x4 (&acc)[2][2][4][2], const Unit& u, int wr, int wc, int fr, int fq, int, LAS unsigned char*) const {
        const int slot0 = (u.pm - meta[u.e]) * BM, col0 = u.pn * BM + wc * 32 + 8 * fq;
#pragma unroll
        for (int ai = 0; ai < 2; ++ai)
#pragma unroll
            for (int m = 0; m < 4; ++m) { const int r = ai * HALF + wr * 64 + m * 16 + fr;
                if (r < u.rows) { const int dst = tok_list[u.e * T + slot0 + r]; const float w = w_list[u.e * T + slot0 + r]; bf16_t* rowp = y2 + (size_t)dst * D + col0;
#pragma unroll
                    for (int bj = 0; bj < 2; ++bj) { const f32x4 v0 = acc[ai][bj][m][0] * w, v1 = acc[ai][bj][m][1] * w;
                        u32x4 o; o.x = cvt_pk_bf16(v0[0], v0[1]); o.y = cvt_pk_bf16(v0[2], v0[3]); o.z = cvt_pk_bf16(v1[0], v1[1]); o.w = cvt_pk_bf16(v1[2], v1[3]);
                        *(u32x4*)(rowp + bj * HALF) = o; } } }
    }
};
}

struct RowId { int off; __device__ __forceinline__ int operator()(int n) const { return off + n; } };
struct RowGU { int up; __device__ __forceinline__ int operator()(int j) const { return (j >> 2) * 8 + (j & 3) + 4 * up; } };

struct TItem { const float* src; const float* gp; bf16_t* dst; int N, K, rmk; };
__device__ __forceinline__ TItem p0_decode(const Params& p, int it) {
    constexpr int I_IN = (D / 64) * (INW / 32), I_OUT = (D / 64) * (D / 32), I_G = (D / 64) * (DFF / 32), I_D = (DFF / 64) * (D / 32), I_E = 2 * I_G + I_D;
    const float* W; const float* g; bf16_t* WT; int K, N, rmk, idx;
    if (it < I_IN) { W = p.w_in; g = p.norm1_g; WT = (bf16_t*)(p.ws + WS_WIN); K = D; N = INW; rmk = 0; idx = it; }
    else if (it < I_IN + I_OUT) { W = p.w_out; g = nullptr; WT = (bf16_t*)(p.ws + WS_WOUT); K = D; N = D; rmk = 0; idx = it - I_IN; }
    else if (it < I_IN + I_OUT + NE * 2 * I_G) { const int r = it - I_IN - I_OUT, e = r / (2 * I_G), q = r % (2 * I_G);
        if (q < I_G) { W = p.w_e_gate + (size_t)e * D * DFF; g = p.norm2_g; WT = (bf16_t*)(p.ws + WS_WGU) + (size_t)e * D * D; K = D; N = DFF; rmk = 1; idx = q; }
        else { W = p.w_e_up + (size_t)e * D * DFF; g = p.norm2_g; WT = (bf16_t*)(p.ws + WS_WGU) + (size_t)e * D * D; K = D; N = DFF; rmk = 2; idx = q - I_G; } }
    else { const int r = it - I_IN - I_OUT - NE * 2 * I_G, e = r / I_D; idx = r % I_D;
        W = p.w_e_down + (size_t)e * DFF * D; g = nullptr; WT = (bf16_t*)(p.ws + WS_WD) + (size_t)e * D * DFF; K = DFF; N = D; rmk = 0; }
    const int nblk = N / 32, kb = idx / nblk, nb = idx % nblk, k0 = 64 * kb, n0 = 32 * nb;
    TItem t; t.src = W + (size_t)k0 * N + n0; t.dst = WT + k0; t.N = N; t.K = K; t.rmk = rmk;
    t.gp = g ? g + k0 : nullptr;
    if (it >= I_IN && it < I_IN + I_OUT) t.gp = (k0 < 512) ? p.g_rec_out + k0 : p.g_att_out + (k0 - 512);
    t.rmk = rmk | (n0 << 4);
    return t;
}
__device__ __forceinline__ void p0_load(const TItem& t, f32x4 (&ld)[8], float (&gv)[8], int lane) {
#pragma unroll
    for (int i = 0; i < 8; ++i) ld[i] = *(const f32x4*)(t.src + (size_t)(8 * i + (lane >> 3)) * t.N + 4 * (lane & 7));
    if (t.gp) {
#pragma unroll
        for (int i = 0; i < 8; ++i) gv[i] = t.gp[8 * i + (lane >> 3)];
    } else {
#pragma unroll
        for (int i = 0; i < 8; ++i) gv[i] = 1.0f;
    }
}
__device__ __forceinline__ void p0_process(const TItem& t, const f32x4 (&ld)[8], const float (&gv)[8], LAS float* scr, int lane) {
#pragma unroll
    for (int i = 0; i < 8; ++i) { const int kk = 8 * i + (lane >> 3); const f32x4 v = ld[i] * gv[i];
        LAS float* d = scr + kk * 33 + 4 * (lane & 7); d[0] = v[0]; d[1] = v[1]; d[2] = v[2]; d[3] = v[3]; }
    LDS_WAIT(); asm volatile("" ::: "memory");
    const int c = lane & 7, n0 = t.rmk >> 4, rmk = t.rmk & 15;
#pragma unroll
    for (int j = 0; j < 4; ++j) { const int n = (lane >> 3) + 8 * j; const LAS float* s = scr + (8 * c) * 33 + n;
        u32x4 o; o.x = pk2(s[0 * 33], s[1 * 33]); o.y = pk2(s[2 * 33], s[3 * 33]); o.z = pk2(s[4 * 33], s[5 * 33]); o.w = pk2(s[6 * 33], s[7 * 33]);
        const int nn = n0 + n, row = (rmk == 0) ? nn : ((nn >> 2) * 8 + (nn & 3) + 4 * (rmk - 1));
        *(u32x4*)(t.dst + (size_t)row * t.K + 8 * c) = o; }
    LDS_WAIT(); asm volatile("" ::: "memory");
}

__device__ __forceinline__ void p0_convert_range(const Params& p, LAS float* scr, int it0, int it1, int gw, int ngw, int lane) {
    int it = it0 + gw; TItem cur; f32x4 la[8]; float ga[8];
    if (it < it1) { cur = p0_decode(p, it); p0_load(cur, la, ga, lane); }
    while (it < it1) {
        const int nit = it + ngw; TItem nxt = cur; f32x4 lb[8]; float gb[8];
        const bool has = nit < it1;
        if (has) { nxt = p0_decode(p, nit); p0_load(nxt, lb, gb, lane); }
        p0_process(cur, la, ga, scr, lane);
        if (has) { cur = nxt;
#pragma unroll
            for (int i = 0; i < 8; ++i) { la[i] = lb[i]; ga[i] = gb[i]; } }
        it = nit;
    }
}

__device__ __forceinline__ void ph_prologue(const Params& p, LAS unsigned char* lds, int vcu, int G, int e_split) {
    const int tid = opaque_tid(), lane = tid & 63, wave = tid >> 6;
    LAS float* scr = (LAS float*)(lds + wave * 16384);
    const int gw = vcu * NWAVES + wave, NGW = G * NWAVES;
    bf16_t* xb = (bf16_t*)(p.ws + WS_XB);
    constexpr int I_IN = (D / 64) * (INW / 32), I_OUT = (D / 64) * (D / 32), I_G = (D / 64) * (DFF / 32), I_D = (DFF / 64) * (D / 32), I_E = 2 * I_G + I_D, I_ALL = I_IN + I_OUT + NE * I_E;
    p0_convert_range(p, scr, 0, I_IN + I_OUT + e_split * 2 * I_G, gw, NGW, lane);
    {
        bf16_t* gwt = (bf16_t*)(p.ws + WS_GWT); float* sp8 = (float*)(p.ws + WS_GWT + 8 * 128 * 144);
        for (int idx = gw * 64 + lane; idx < 8 * 64 * 128; idx += NGW * 64) { const int hb = idx >> 13, k = (idx >> 7) & 63, n = idx & 127;
            const float v = (n < 64) ? p.w_rg_a[(hb * 64 + k) * 64 + n] : p.w_rg_x[(hb * 64 + k) * 64 + n - 64];
            gwt[(hb * 128 + n) * 72 + k] = (bf16_t)f2bf(v); }
        for (int idx = gw * 64 + lane; idx < RW; idx += NGW * 64) sp8[idx] = -8.0f * log1pf(expf(-p.lru_lambda[idx]));
    }
    {
        float* rwt = (float*)(p.ws + WS_RWT);
        for (int idx = gw * 64 + lane; idx < D * 20; idx += NGW * 64) { const int k = idx / 20, n = idx % 20;
            rwt[n * 1028 + k] = (n < 16 ? p.w_router[k * 16 + n] : p.w_group[k * 4 + n - 16]) * p.norm2_g[k]; }
    }
    for (int t = gw; t < T; t += 2 * NGW) {
        const int t2 = t + NGW; const bool has2 = t2 < T;
        const f32x4* xr = (const f32x4*)(p.x + (size_t)t * D) + lane; const f32x4* xr2 = (const f32x4*)(p.x + (size_t)(has2 ? t2 : t) * D) + lane;
        f32x4 v[4], v2[4]; float ss = 0.f, ss2 = 0.f;
#pragma unroll
        for (int j = 0; j < 4; ++j) { v[j] = xr[64 * j]; v2[j] = xr2[64 * j]; }
#pragma unroll
        for (int j = 0; j < 4; ++j) { ss += (v[j][0] * v[j][0] + v[j][1] * v[j][1]) + (v[j][2] * v[j][2] + v[j][3] * v[j][3]); ss2 += (v2[j][0] * v2[j][0] + v2[j][1] * v2[j][1]) + (v2[j][2] * v2[j][2] + v2[j][3] * v2[j][3]); }
        const float r = rsqrtf(wave_sum(ss) * (1.0f / D) + EPS), r2 = rsqrtf(wave_sum(ss2) * (1.0f / D) + EPS);
        u32x2* o8 = (u32x2*)(xb + (size_t)t * D) + lane;
#pragma unroll
        for (int j = 0; j < 4; ++j) o8[64 * j] = (u32x2){pk2(v[j][0] * r, v[j][1] * r), pk2(v[j][2] * r, v[j][3] * r)};
        if (has2) { u32x2* o82 = (u32x2*)(xb + (size_t)t2 * D) + lane;
#pragma unroll
            for (int j = 0; j < 4; ++j) o82[64 * j] = (u32x2){pk2(v2[j][0] * r2, v2[j][1] * r2), pk2(v2[j][2] * r2, v2[j][3] * r2)}; }
    }
}

__device__ __forceinline__ void p1_tail_convert(const Params& p, LAS unsigned char* lds, int idle_idx, int n_idle, int e_split) {
    const int tid = opaque_tid(), lane = tid & 63, wave = tid >> 6;
    constexpr int I_IN = (D / 64) * (INW / 32), I_OUT = (D / 64) * (D / 32), I_G = (D / 64) * (DFF / 32), I_D = (DFF / 64) * (D / 32), I_E = 2 * I_G + I_D, I_ALL = I_IN + I_OUT + NE * I_E;
    p0_convert_range(p, (LAS float*)(lds + wave * 16384), I_IN + I_OUT + e_split * 2 * I_G, I_IN + I_OUT + NE * 2 * I_G, idle_idx * NWAVES + wave, n_idle * NWAVES, lane);
}

__device__ __forceinline__ void p5a_tail_convert(const Params& p, LAS unsigned char* lds, int widx, int n_workers) {
    const int tid = opaque_tid(), lane = tid & 63, wave = tid >> 6;
    constexpr int I_IN = (D / 64) * (INW / 32), I_OUT = (D / 64) * (D / 32), I_G = (D / 64) * (DFF / 32), I_D = (DFF / 64) * (D / 32);
    p0_convert_range(p, (LAS float*)(lds + wave * 16384), I_IN + I_OUT + NE * 2 * I_G, I_IN + I_OUT + NE * 2 * I_G + NE * I_D, widx * NWAVES + wave, n_workers * NWAVES, lane);
}

typedef float f32x16 __attribute__((ext_vector_type(16)));
typedef short v4i16_t __attribute__((ext_vector_type(4)));
typedef __bf16 bf16x2_t __attribute__((ext_vector_type(2)));
#define MFMA32(a, b, c) __builtin_amdgcn_mfma_f32_32x32x16_bf16((a), (b), (c), 0, 0, 0)
__device__ __forceinline__ unsigned cvtpk_s(float lo, float hi) { f32x2 v = {lo, hi}; bf16x2_t b = __builtin_convertvector(v, bf16x2_t); return __builtin_bit_cast(unsigned, b); }
__device__ __forceinline__ int crow(int r, int hh) { return (r & 3) + 8 * (r >> 2) + 4 * hh; }
__device__ __forceinline__ bf16x8 pack8(const f32x16& x, int s) {
    u32x4 w; w.x = cvtpk_s(x[8 * s + 0], x[8 * s + 1]); w.y = cvtpk_s(x[8 * s + 2], x[8 * s + 3]); w.z = cvtpk_s(x[8 * s + 4], x[8 * s + 5]); w.w = cvtpk_s(x[8 * s + 6], x[8 * s + 7]);
    return __builtin_bit_cast(bf16x8, w);
}
__device__ __forceinline__ v4i16_t vtr(LAS const unsigned char* p) { return __builtin_amdgcn_ds_read_tr16_b64_v4i16((LAS v4i16_t*)p); }
constexpr float LOG2E = 1.4426950408889634f;

struct AttnCtx { LAS float* btab; LAS unsigned char* vbase; int lane, h, q32, hh, vb, vw; float bconst; unsigned kl, vl; };
__device__ __forceinline__ AttnCtx attn_setup(const Params& p, LAS unsigned char* lds, int tab_off) {
    int tid_ = threadIdx.x; asm volatile("" : "+v"(tid_));
    AttnCtx A; const int tid = tid_; A.lane = tid & 63; A.h = __builtin_amdgcn_readfirstlane(tid >> 6); A.q32 = A.lane & 31; A.hh = A.lane >> 5;
    A.btab = (LAS float*)(lds + tab_off) + A.h * 328;
    for (int i = A.lane; i < 2 * MAXREL + 1 + 64; i += 64) A.btab[i] = p.rel_bias[A.h * (2 * MAXREL + 1) + (i > 2 * MAXREL ? 2 * MAXREL : i)] * LOG2E;
    LDS_WAIT(); asm volatile("" ::: "memory");
    A.vbase = lds + A.h * 16384;
    A.vb = ((A.lane >> 4) & 1) * 32 + (A.lane & 3) * 8 + (4 * A.hh + ((A.lane & 15) >> 2)) * 128;
    A.vw = (A.lane >> 3) * 128 + (A.lane & 7) * 16;
    A.bconst = A.btab[2 * MAXREL];
    A.kl = (unsigned)((A.q32 * INW + 8 * A.hh) * 2);
    A.vl = (unsigned)(((A.lane >> 3) * INW + (A.lane & 7) * 8) * 2) + 1024u;
    return A;
}
__device__ __forceinline__ void attn_item(const AttnCtx& A, const bf16_t* z, bf16_t* mixb, float* ssq, int b, int c, int qh) {
    const int lane = A.lane, h = A.h, q32 = A.q32, hh = A.hh, vb = A.vb, vw = A.vw; LAS float* btab = A.btab; LAS unsigned char* vbase = A.vbase;
    const float bconst = A.bconst, QS = 0.125f * LOG2E; const unsigned kl = A.kl, vl = A.vl;
    {
        const int j0 = (c >= LEFT) ? 0 : LEFT - c;
        const char* kband = (const char*)z + (((long)b * S + (long)(c - LEFT) * CHUNK) * INW + 1536 + h * 64) * 2;
        {
            const int qi = qh * 32 + q32;
            const size_t tq = (size_t)b * S + c * CHUNK + qi;
            bf16x8 qf[4];
#pragma unroll
            for (int s = 0; s < 4; ++s) { const u32x4 raw = *(const u32x4*)(z + tq * INW + 1024 + h * 64 + 16 * s + 8 * hh); u32x4 w;
#pragma unroll
                for (int e = 0; e < 4; ++e) w[e] = cvtpk_s(__builtin_bit_cast(float, raw[e] << 16) * QS, __builtin_bit_cast(float, raw[e] & 0xffff0000u) * QS);
                qf[s] = __builtin_bit_cast(bf16x8, w); }
            f32x16 o0, o1;
#pragma unroll
            for (int r = 0; r < 16; ++r) { o0[r] = 0.f; o1[r] = 0.f; }
            float m_ref = 0.f, l_run = 0.f;
            constexpr float THR = 6.0f;
            u32x4 kr[8], vr[8];
            const int kw = (lane >> 3) * 128 + (((lane & 7) ^ (lane >> 3)) << 4);
            const int kfo = q32 * 128;
            {
                const char* tb = kband + (long)(64 * j0) * INW * 2;
#pragma unroll
                for (int i = 0; i < 8; ++i) { kr[i] = *(const u32x4*)(tb + ((vl - 1024u) + (unsigned)(i * 8 * INW * 2))); vr[i] = *(const u32x4*)(tb + (vl + (unsigned)(i * 8 * INW * 2))); }
#pragma unroll
                for (int i = 0; i < 8; ++i) { *(LAS u32x4*)(vbase + i * 1024 + kw) = kr[i]; *(LAS u32x4*)(vbase + 8192 + i * 1024 + vw) = vr[i]; }
            }
#pragma unroll 1
            for (int j = j0; j <= LEFT; ++j) {
                if (j < LEFT) {
                    const char* tb = kband + (long)(64 * (j + 1)) * INW * 2;
#pragma unroll
                    for (int i = 0; i < 8; ++i) { kr[i] = *(const u32x4*)(tb + ((vl - 1024u) + (unsigned)(i * 8 * INW * 2))); vr[i] = *(const u32x4*)(tb + (vl + (unsigned)(i * 8 * INW * 2))); }
                }
                bf16x8 kf[8];
#pragma unroll
                for (int kb = 0; kb < 2; ++kb)
#pragma unroll
                    for (int s = 0; s < 4; ++s) kf[kb * 4 + s] = *(const LAS bf16x8*)(vbase + kb * 4096 + kfo + (((2 * s + hh) ^ (q32 & 7)) << 4));
                f32x16 p0, p1;
                if (j <= 5) {
                    const float ci = bconst - m_ref;
#pragma unroll
                    for (int r = 0; r < 16; ++r) { p0[r] = ci; p1[r] = ci; }
                } else {
                    const LAS float* pb0 = btab + (LEFT * CHUNK + qi - 64 * j + MAXREL - 4 * hh - 27); const LAS float* pb1 = pb0 - 32;
#pragma unroll
                    for (int r = 0; r < 16; ++r) { p0[r] = pb0[27 - ((r & 3) + 8 * (r >> 2))] - m_ref; p1[r] = pb1[27 - ((r & 3) + 8 * (r >> 2))] - m_ref; }
                }
#pragma unroll
                for (int s = 0; s < 4; ++s) { p0 = MFMA32(kf[s], qf[s], p0); p1 = MFMA32(kf[4 + s], qf[s], p1); }
                float mt = fmaxf(p0[0], p1[0]);
#pragma unroll
                for (int r = 1; r < 16; ++r) mt = fmaxf(mt, fmaxf(p0[r], p1[r]));
                mt = fmaxf(mt, __shfl_xor(mt, 32));
                const bool first = (j == j0);
                const bool grow = first || (mt > THR);
                if (__any(grow)) {
                    const float d = grow ? mt : 0.f, alpha = first ? 1.0f : __builtin_amdgcn_exp2f(-d);
                    m_ref += d; l_run *= alpha;
#pragma unroll
                    for (int r = 0; r < 16; ++r) { p0[r] -= d; p1[r] -= d; o0[r] *= alpha; o1[r] *= alpha; }
                }
                float ls0 = 0.f, ls1 = 0.f;
#pragma unroll
                for (int r = 0; r < 16; ++r) { p0[r] = __builtin_amdgcn_exp2f(p0[r]); p1[r] = __builtin_amdgcn_exp2f(p1[r]); ls0 += p0[r]; ls1 += p1[r]; }
                l_run += ls0 + ls1;
                const bf16x8 pf0 = pack8(p0, 0), pf1 = pack8(p0, 1), pf2 = pack8(p1, 0), pf3 = pack8(p1, 1);
                LAS const unsigned char* vcur = vbase + 8192 + vb;
#pragma unroll
                for (int db = 0; db < 2; ++db) {
                    v4i16_t lo[4], hi[4];
#pragma unroll
                    for (int ks = 0; ks < 4; ++ks) { lo[ks] = vtr(vcur + ks * 2048 + db * 64); hi[ks] = vtr(vcur + ks * 2048 + 1024 + db * 64); }
#define VF(k) (bf16x8){lo[k][0], lo[k][1], lo[k][2], lo[k][3], hi[k][0], hi[k][1], hi[k][2], hi[k][3]}
                    if (db == 0) { o0 = MFMA32(VF(0), pf0, o0); o0 = MFMA32(VF(1), pf1, o0); o0 = MFMA32(VF(2), pf2, o0); o0 = MFMA32(VF(3), pf3, o0); }
                    else         { o1 = MFMA32(VF(0), pf0, o1); o1 = MFMA32(VF(1), pf1, o1); o1 = MFMA32(VF(2), pf2, o1); o1 = MFMA32(VF(3), pf3, o1); }
#undef VF
                }
                if (j < LEFT) {
#pragma unroll
                    for (int i = 0; i < 8; ++i) { *(LAS u32x4*)(vbase + i * 1024 + kw) = kr[i]; *(LAS u32x4*)(vbase + 8192 + i * 1024 + vw) = vr[i]; }
                }
            }
            const float lt = l_run + __shfl_xor(l_run, 32), inv = 1.0f / lt;
            float ss = 0.f;
            bf16_t* orow = mixb + tq * D + 512 + h * 64 + 4 * hh;
#pragma unroll
            for (int g = 0; g < 4; ++g) {
                const float a0 = o0[4 * g] * inv, a1 = o0[4 * g + 1] * inv, a2 = o0[4 * g + 2] * inv, a3 = o0[4 * g + 3] * inv;
                const float c0 = o1[4 * g] * inv, c1 = o1[4 * g + 1] * inv, c2 = o1[4 * g + 2] * inv, c3 = o1[4 * g + 3] * inv;
                ss += (a0 * a0 + a1 * a1) + (a2 * a2 + a3 * a3) + (c0 * c0 + c1 * c1) + (c2 * c2 + c3 * c3);
                *(u32x2*)(orow + 8 * g) = (u32x2){cvtpk_s(a0, a1), cvtpk_s(a2, a3)};
                *(u32x2*)(orow + 32 + 8 * g) = (u32x2){cvtpk_s(c0, c1), cvtpk_s(c2, c3)};
            }
            ss += __shfl_xor(ss, 32);
            if (hh == 0) ssq[tq * SSQW + 32 + h] = ss;
        }
    }
}


constexpr int RG_WT = 0, RG_IMG = 18432, RG_SEG = 35840, RG_PRE = 44032, RG_CAR = 52224, RG_ROWB = 144, RG_IROW = 272;
__device__ __forceinline__ float fast_sigmoid(float x) { return __builtin_amdgcn_rcpf(1.0f + __expf(-x)); }
__device__ __forceinline__ void rglru_item(const Params& p, const bf16_t* z, bf16_t* mixb, float* ssq, LAS unsigned char* lds, unsigned long long* gran, int b, int hb, int kc) {
    const int tid = opaque_tid(), lane = tid & 63, w = __builtin_amdgcn_readfirstlane(tid >> 6), ch = lane, c16 = lane & 15, tg = lane >> 4;
    LAS f32x2* seg = (LAS f32x2*)(lds + RG_SEG); LAS f32x2* pre = (LAS f32x2*)(lds + RG_PRE); LAS float* car = (LAS float*)(lds + RG_CAR);
    {
        const u32x4* srcw = (const u32x4*)(p.ws + WS_GWT + (size_t)hb * 128 * 144); LAS u32x4* dstw = (LAS u32x4*)(lds + RG_WT);
        for (int idx = tid; idx < 128 * 144 / 16; idx += NTHR) dstw[idx] = srcw[idx];
    }
    const int gch = hb * 64 + ch;
    const float cw0 = p.conv_w[gch], cw1 = p.conv_w[RW + gch], cw2 = p.conv_w[2 * RW + gch], cw3 = p.conv_w[3 * RW + gch], cb = p.conv_b[gch];
    const float* sp8t = (const float*)(p.ws + WS_GWT + 8 * 128 * 144);
    float ba[4], bxb[4], sp8[4];
#pragma unroll
    for (int nb = 0; nb < 4; ++nb) { const int c = hb * 64 + 16 * nb + c16; ba[nb] = p.b_rg_a[c]; bxb[nb] = p.b_rg_x[c]; sp8[nb] = sp8t[c]; }
    LAS unsigned char* img = lds + RG_IMG;
    LAS unsigned char* trb = img + (8 * tg + (c16 >> 2)) * RG_IROW + (16 * w + 4 * (c16 & 3)) * 2;
    const int s0 = kc * 256;
    const bf16_t* ucol = z + ((size_t)b * S + s0) * INW + gch;
    float av[2][4][4], bv[2][4][4], cP[2][4], cH[2][4];
    bf16_t uraw[2][19], graw[2][4][4];
#pragma unroll
    for (int blk = 0; blk < 2; ++blk)
#pragma unroll
        for (int i = 0; i < 19; ++i) { const int s = blk * 128 + 16 * w - 3 + i; uraw[blk][i] = (s0 + s >= 0) ? ucol[(long)s * INW] : (bf16_t)0; }
#pragma unroll
    for (int blk = 0; blk < 2; ++blk)
#pragma unroll
        for (int nb = 0; nb < 4; ++nb)
#pragma unroll
            for (int i = 0; i < 4; ++i) graw[blk][nb][i] = z[((size_t)b * S + s0 + blk * 128 + 16 * w + 4 * tg + i) * INW + 512 + hb * 64 + 16 * nb + c16];
    __syncthreads();
#pragma unroll
    for (int blk = 0; blk < 2; ++blk) {
        const int t0 = blk * 128 + 16 * w;
        float uv[19];
#pragma unroll
        for (int i = 0; i < 19; ++i) uv[i] = bf2f(uraw[blk][i]);
        {
            float uc[16];
#pragma unroll
            for (int i = 0; i < 16; ++i) uc[i] = cb + cw0 * uv[i] + cw1 * uv[i + 1] + cw2 * uv[i + 2] + cw3 * uv[i + 3];
            u32x4 w0, w1;
#pragma unroll
            for (int e = 0; e < 4; ++e) { w0[e] = cvtpk_s(uc[2 * e], uc[2 * e + 1]); w1[e] = cvtpk_s(uc[8 + 2 * e], uc[9 + 2 * e]); }
            *(LAS u32x4*)(img + ch * RG_IROW + 32 * w) = w0; *(LAS u32x4*)(img + ch * RG_IROW + 32 * w + 16) = w1;
        }
        LDS_WAIT(); asm volatile("" ::: "memory");
        const v4i16_t t0lo = vtr(trb), t0hi = vtr(trb + 4 * RG_IROW), t1lo = vtr(trb + 32 * RG_IROW), t1hi = vtr(trb + 36 * RG_IROW);
        const bf16x8 a0 = (bf16x8){t0lo[0], t0lo[1], t0lo[2], t0lo[3], t0hi[0], t0hi[1], t0hi[2], t0hi[3]}, a1 = (bf16x8){t1lo[0], t1lo[1], t1lo[2], t1lo[3], t1hi[0], t1hi[1], t1hi[2], t1hi[3]};
#pragma unroll
        for (int nb = 0; nb < 4; ++nb) {
            const bf16x8 b0a = *(const LAS bf16x8*)(lds + RG_WT + (16 * nb + c16) * RG_ROWB + tg * 16), b1a = *(const LAS bf16x8*)(lds + RG_WT + (16 * nb + c16) * RG_ROWB + tg * 16 + 64);
            const bf16x8 b0x = *(const LAS bf16x8*)(lds + RG_WT + (64 + 16 * nb + c16) * RG_ROWB + tg * 16), b1x = *(const LAS bf16x8*)(lds + RG_WT + (64 + 16 * nb + c16) * RG_ROWB + tg * 16 + 64);
            f32x4 acca = __builtin_amdgcn_mfma_f32_16x16x32_bf16(a0, b0a, (f32x4){0.f, 0.f, 0.f, 0.f}, 0, 0, 0); acca = __builtin_amdgcn_mfma_f32_16x16x32_bf16(a1, b1a, acca, 0, 0, 0);
            f32x4 accx = __builtin_amdgcn_mfma_f32_16x16x32_bf16(a0, b0x, (f32x4){0.f, 0.f, 0.f, 0.f}, 0, 0, 0); accx = __builtin_amdgcn_mfma_f32_16x16x32_bf16(a1, b1x, accx, 0, 0, 0);
            const u32x2 ucr = *(const LAS u32x2*)(img + (16 * nb + c16) * RG_IROW + (16 * w + 4 * tg) * 2);
            const float ucv[4] = {__builtin_bit_cast(float, ucr[0] << 16), __builtin_bit_cast(float, ucr[0] & 0xffff0000u), __builtin_bit_cast(float, ucr[1] << 16), __builtin_bit_cast(float, ucr[1] & 0xffff0000u)};
            float H = 0.f, P = 1.f;
#pragma unroll
            for (int rg_ = 0; rg_ < 4; ++rg_) {
                const float r = fast_sigmoid(acca[rg_] + ba[nb]), ig = fast_sigmoid(accx[rg_] + bxb[nb]);
                const float a = __expf(r * sp8[nb]);
                av[blk][nb][rg_] = a; bv[blk][nb][rg_] = __builtin_amdgcn_sqrtf((1.0f - a) * (1.0f + a)) * (ig * ucv[rg_]);
                H = a * H + bv[blk][nb][rg_]; P *= a; }
            float cp = 1.f, chh = 0.f, Pt = 1.f, Ht = 0.f;
#pragma unroll
            for (int k = 0; k < 4; ++k) { const float Pk = __shfl(P, c16 + 16 * k), Hk = __shfl(H, c16 + 16 * k);
                cp = (k == tg) ? Pt : cp; chh = (k == tg) ? Ht : chh;
                Ht = Pk * Ht + Hk; Pt *= Pk; }
            cP[blk][nb] = cp; cH[blk][nb] = chh;
            if (tg == 0) seg[(blk * 8 + w) * 64 + 16 * nb + c16] = (f32x2){Pt, Ht};
        }
        LDS_WAIT(); asm volatile("" ::: "memory");
    }
    __syncthreads();
    if (tid < 64) {
        float Pp = 1.f, Hp = 0.f;
#pragma unroll
        for (int s = 0; s < 16; ++s) { pre[s * 64 + tid] = (f32x2){Pp, Hp}; const f32x2 sv = seg[s * 64 + tid]; Hp = sv.x * Hp + sv.y; Pp *= sv.x; }
        unsigned long long* g = gran + ((size_t)((b * 8 + hb) * 8 + kc) * 2) * 64 + tid;
        __hip_atomic_store(g, (1ull << 32) | __builtin_bit_cast(unsigned, Pp), __ATOMIC_RELAXED, __HIP_MEMORY_SCOPE_AGENT);
        __hip_atomic_store(g + 64, (1ull << 32) | __builtin_bit_cast(unsigned, Hp), __ATOMIC_RELAXED, __HIP_MEMORY_SCOPE_AGENT);
        float h = 0.f;
        for (int j = 0; j < kc; ++j) {
            const unsigned long long* gj = gran + ((size_t)((b * 8 + hb) * 8 + j) * 2) * 64 + tid;
            unsigned long long vp, vh; unsigned spins = 0;
            for (;;) { vp = __hip_atomic_load(gj, __ATOMIC_RELAXED, __HIP_MEMORY_SCOPE_AGENT); vh = __hip_atomic_load(gj + 64, __ATOMIC_RELAXED, __HIP_MEMORY_SCOPE_AGENT);
                if (__all(((vp >> 32) != 0ull) && ((vh >> 32) != 0ull))) break; __builtin_amdgcn_s_sleep(2); if (++spins > (1u << 20)) break; }
            h = __builtin_bit_cast(float, (unsigned)vp) * h + __builtin_bit_cast(float, (unsigned)vh);
        }
        car[tid] = h;
    }
    __syncthreads();
#pragma unroll
    for (int blk = 0; blk < 2; ++blk) {
        const int t0 = blk * 128 + 16 * w;
        float ysum[4] = {0.f, 0.f, 0.f, 0.f};
#pragma unroll
        for (int nb = 0; nb < 4; ++nb) {
            const int oc = 16 * nb + c16; const f32x2 pf = pre[(blk * 8 + w) * 64 + oc];
            float hcur = cP[blk][nb] * (pf.x * car[oc] + pf.y) + cH[blk][nb];
            bf16_t* orow = mixb + ((size_t)b * S + s0 + t0 + 4 * tg) * D + hb * 64 + oc;
#pragma unroll
            for (int i = 0; i < 4; ++i) { hcur = av[blk][nb][i] * hcur + bv[blk][nb][i];
                const float g = bf2f(graw[blk][nb][i]), u2 = 1.5957691216057308f * (g + 0.044715f * g * g * g);
                const float y = hcur * g * fast_sigmoid(u2);
                orow[(size_t)i * D] = (bf16_t)(cvtpk_s(y, y) & 0xffffu); ysum[i] += y * y; }
        }
#pragma unroll
        for (int i = 0; i < 4; ++i) ysum[i] += __shfl_xor(ysum[i], 1);
#pragma unroll
        for (int i = 0; i < 4; ++i) ysum[i] += __shfl_xor(ysum[i], 2);
#pragma unroll
        for (int i = 0; i < 4; ++i) ysum[i] += __shfl_xor(ysum[i], 4);
#pragma unroll
        for (int i = 0; i < 4; ++i) ysum[i] += __shfl_xor(ysum[i], 8);
        if (c16 == 0) { float* sq = ssq + ((size_t)b * S + s0 + t0 + 4 * tg) * SSQW + hb * 4;
#pragma unroll
            for (int i = 0; i < 4; ++i) *(f32x4*)(sq + (size_t)i * SSQW) = (f32x4){ysum[i], 0.f, 0.f, 0.f}; }
    }
}

constexpr int RT_WT = 0, RT_LDK = 1028, RT_PART = 82432, RT_SSP = 98816, RT_REC = 99328;
__device__ __forceinline__ void ph_router3(const Params& p, const float* h, int* gcount, int* tok_list, float* w_list, float* r_list, LAS unsigned char* lds) {
    const int tid = opaque_tid(), lane = tid & 63, w = __builtin_amdgcn_readfirstlane(tid >> 6), t16 = lane & 15, g = lane >> 4;
    LAS float* wt = (LAS float*)(lds + RT_WT); LAS float* part = (LAS float*)(lds + RT_PART); LAS float* ssp = (LAS float*)(lds + RT_SSP);
    LAS int* lcnt = (LAS int*)(lds + RT_REC); LAS int* lbase = lcnt + 16; LAS int* rec_e = lcnt + 32; LAS int* rec_s = lcnt + 160; LAS float* rec_w = (LAS float*)(lcnt + 288); LAS float* rec_r = (LAS float*)(lcnt + 416);
    { const f32x4* srcw = (const f32x4*)(p.ws + WS_RWT); LAS f32x4* dstw = (LAS f32x4*)wt;
      for (int idx = tid; idx < 20 * RT_LDK / 4; idx += NTHR) dstw[idx] = srcw[idx]; }
    const int task = w & 3, khalf = w >> 2, kbase = khalf * 512 + g * 128;
    for (int grp = blockIdx.x; grp < T / 64; grp += gridDim.x) {
        if (tid < 16) lcnt[tid] = 0;
        __syncthreads();
        {
            const f32x4* hrow = (const f32x4*)(h + (size_t)(grp * 64 + task * 16 + t16) * D + kbase);
            const LAS f32x4* b0p = (const LAS f32x4*)(wt + t16 * RT_LDK + kbase); const LAS f32x4* b1p = (const LAS f32x4*)(wt + (16 + (lane & 3)) * RT_LDK + kbase);
            f32x4 acc0 = {0.f, 0.f, 0.f, 0.f}, acc1 = {0.f, 0.f, 0.f, 0.f}; float ss = 0.f;
#pragma unroll 1
            for (int jb = 0; jb < 32; jb += 8) {
                f32x4 a[8];
#pragma unroll
                for (int j = 0; j < 8; ++j) a[j] = hrow[jb + j];
#pragma unroll
                for (int j = 0; j < 8; ++j) { const f32x4 b0 = b0p[jb + j], b1 = b1p[jb + j];
#pragma unroll
                    for (int q = 0; q < 4; ++q) { acc0 = __builtin_amdgcn_mfma_f32_16x16x4f32(a[j][q], b0[q], acc0, 0, 0, 0); acc1 = __builtin_amdgcn_mfma_f32_16x16x4f32(a[j][q], b1[q], acc1, 0, 0, 0); ss += a[j][q] * a[j][q]; } }
            }
            ss += __shfl_xor(ss, 16); ss += __shfl_xor(ss, 32);
            if (g == 0) ssp[khalf * 64 + task * 16 + t16] = ss;
            LAS float* pp = part + ((khalf * 4 + task) * 16 + 4 * g) * 32 + t16;
#pragma unroll
            for (int rg_ = 0; rg_ < 4; ++rg_) { pp[rg_ * 32] = acc0[rg_]; pp[rg_ * 32 + 16] = acc1[rg_]; }
        }
        __syncthreads();
        if (tid < 64) {
            const float rstd = rsqrtf((ssp[tid] + ssp[64 + tid]) * (1.0f / D) + EPS);
            const LAS float* q0 = part + tid * 32; const LAS float* q1 = part + (64 + tid) * 32;
            float lg[4];
#pragma unroll
            for (int i = 0; i < 4; ++i) lg[i] = (q0[16 + i] + q1[16 + i]) * rstd + p.b_group[i];
            int gi = 0; float best = lg[0];
#pragma unroll
            for (int i = 1; i < 4; ++i) if (lg[i] > best) { best = lg[i]; gi = i; }
            float den = 0.f;
#pragma unroll
            for (int i = 0; i < 4; ++i) den += expf(lg[i] - best);
            const float pg = 1.0f / den;
            float sel[4];
#pragma unroll
            for (int i = 0; i < 4; ++i) sel[i] = (q0[gi * 4 + i] + q1[gi * 4 + i]) * rstd + p.b_router[gi * 4 + i];
            int i1 = 0; float v1 = sel[0];
#pragma unroll
            for (int i = 1; i < 4; ++i) if (sel[i] > v1) { v1 = sel[i]; i1 = i; }
            int i2 = -1; float v2 = -3.0e38f;
#pragma unroll
            for (int i = 0; i < 4; ++i) if (i != i1 && sel[i] > v2) { v2 = sel[i]; i2 = i; }
            const float e2 = expf(v2 - v1);
            const float w1 = pg / (1.0f + e2), w2 = pg * e2 / (1.0f + e2);
            const int ea = gi * 4 + i1, eb = gi * 4 + i2;
            const int sa = __hip_atomic_fetch_add(lcnt + ea, 1, __ATOMIC_RELAXED, __HIP_MEMORY_SCOPE_WORKGROUP);
            const int sb = __hip_atomic_fetch_add(lcnt + eb, 1, __ATOMIC_RELAXED, __HIP_MEMORY_SCOPE_WORKGROUP);
            rec_e[tid * 2] = ea; rec_s[tid * 2] = sa; rec_w[tid * 2] = w1; rec_r[tid * 2] = rstd;
            rec_e[tid * 2 + 1] = eb; rec_s[tid * 2 + 1] = sb; rec_w[tid * 2 + 1] = w2; rec_r[tid * 2 + 1] = rstd;
        }
        __syncthreads();
        if (tid < 16) lbase[tid] = __hip_atomic_fetch_add(gcount + tid, lcnt[tid], __ATOMIC_RELAXED, __HIP_MEMORY_SCOPE_AGENT);
        __syncthreads();
        if (tid < 128) { const int e = rec_e[tid]; const int pos = lbase[e] + rec_s[tid]; tok_list[e * T + pos] = grp * 128 + tid; w_list[e * T + pos] = rec_w[tid]; r_list[e * T + pos] = rec_r[tid]; }
        __syncthreads();
    }
}

__device__ void ph_final(const Params& p, const float* h, const bf16_t* y2, float* out) {
    const int tid = opaque_tid(), lane = tid & 63, wv = tid >> 6, nw = NWAVES;
#if PROBE >= 100
    const unsigned long long* tsw = (const unsigned long long*)(p.ws + WS_CTL + 32768);
    const float span_us_ = (float)(tsw[PROBE - 100] - tsw[PROBE - 101]) * 0.01f;
    const float pscale = 1.0f + floorf((span_us_ + PROBE_SHIFT) / 20.0f) * (20.0f / 3000.0f);
#else
    const float pscale = 1.0f;
#endif
    for (int t = blockIdx.x * nw + wv; t < T; t += gridDim.x * nw) {
        const f32x4* hr = (const f32x4*)(h + (size_t)t * D) + lane;
        const u32x2* y0 = (const u32x2*)(y2 + (size_t)(2 * t) * D) + lane; const u32x2* y1 = (const u32x2*)(y2 + (size_t)(2 * t + 1) * D) + lane;
        f32x4 v[4]; float ss = 0.f;
#pragma unroll
        for (int j = 0; j < 4; ++j) { const f32x4 hv = hr[64 * j]; const u32x2 a = y0[64 * j], b = y1[64 * j];
            v[j][0] = hv[0] + __builtin_bit_cast(float, a[0] << 16) + __builtin_bit_cast(float, b[0] << 16);
            v[j][1] = hv[1] + __builtin_bit_cast(float, a[0] & 0xffff0000u) + __builtin_bit_cast(float, b[0] & 0xffff0000u);
            v[j][2] = hv[2] + __builtin_bit_cast(float, a[1] << 16) + __builtin_bit_cast(float, b[1] << 16);
            v[j][3] = hv[3] + __builtin_bit_cast(float, a[1] & 0xffff0000u) + __builtin_bit_cast(float, b[1] & 0xffff0000u);
            ss += (v[j][0] * v[j][0] + v[j][1] * v[j][1]) + (v[j][2] * v[j][2] + v[j][3] * v[j][3]); }
        const float r = rsqrtf(wave_sum(ss) * (1.0f / D) + EPS);
        f32x4* orow = (f32x4*)(out + (size_t)t * D) + lane;
#pragma unroll
        for (int j = 0; j < 4; ++j) { const f32x4 gf = *((const f32x4*)p.final_g + lane + 64 * j); orow[64 * j] = v[j] * r * gf * pscale; }
    }
}


__device__ __forceinline__ void ph_mixers(const Params& p, const bf16_t* z, bf16_t* mixb, float* ssq, LAS unsigned char* lds, unsigned* qctr) {
    const AttnCtx A = attn_setup(p, lds, TAB_OFF);
    volatile LAS int* qword = (volatile LAS int*)(lds + TAB_OFF + 12288);
    constexpr int NQ = NB, QITEMS = 64 + 64;
    unsigned long long* gran = (unsigned long long*)(p.ws + WS_CTL + 128 * 1024);
    const int qstep = (int)gridDim.x < NQ ? (int)gridDim.x : NQ;
    for (int q = blockIdx.x % NQ; q < NQ; q += qstep) {
        int ticket = 0;
        if (threadIdx.x == 0) ticket = (int)__hip_atomic_fetch_add(qctr + 64 * q, 1u, __ATOMIC_RELAXED, __HIP_MEMORY_SCOPE_AGENT);
        for (;;) {
            __syncthreads();
            if (threadIdx.x == 0) { *qword = ticket; if (ticket < QITEMS) ticket = (int)__hip_atomic_fetch_add(qctr + 64 * q, 1u, __ATOMIC_RELAXED, __HIP_MEMORY_SCOPE_AGENT); }
            __syncthreads();
            const int idx = *qword;
            if (idx >= QITEMS) break;
            if (idx < 64) rglru_item(p, z, mixb, ssq, lds, gran, q, idx & 7, idx >> 3);
            else { const int a = idx - 64; attn_item(A, z, mixb, ssq, q, 31 - (a >> 1), a & 1); }
        }
    }
}

#define XB_TMO      128
#define XB_XCNT(j)  (256  + 64 * (j))
#define XB_XSUB(j)  (1280 + 64 * (j))
#define XB_XGEN(j)  (2304 + 64 * (j))
#define XB_TOP      3328
#define XB_TOPGEN   3392
#define XCD_BAR_WORDS 3456
#define XB_SPIN_CAP (1u << 18)
__device__ __forceinline__ unsigned xb_ld(unsigned* p)              { return __hip_atomic_load(p, __ATOMIC_RELAXED, __HIP_MEMORY_SCOPE_AGENT); }
__device__ __forceinline__ unsigned xb_add(unsigned* p, unsigned v) { return __hip_atomic_fetch_add(p, v, __ATOMIC_RELAXED, __HIP_MEMORY_SCOPE_AGENT); }
__device__ __forceinline__ unsigned xb_xcc_id() { return (unsigned)__builtin_amdgcn_s_getreg((3 << 11) | 20) & 0xFu; }
#define XB_SPIN(cond, bar) do { unsigned _sp = 0; while (cond) { __builtin_amdgcn_s_sleep(1); \
    if ((++_sp & 255u) == 0u) { if (xb_ld(&(bar)[XB_TMO])) break; if (_sp > XB_SPIN_CAP) { atomicAdd(&(bar)[XB_TMO], 1u); break; } } } } while (0)
struct XcdBarrier { unsigned* bar; unsigned x; volatile LAS unsigned* st; };
__device__ __forceinline__ XcdBarrier xcd_barrier_post(unsigned* bar, volatile LAS unsigned* st) {
    XcdBarrier b; b.bar = bar; b.x = xb_xcc_id(); b.st = st;
    if (threadIdx.x == 0) (void)xb_add(&bar[XB_XCNT(b.x)], 1u);
    return b;
}
__device__ __forceinline__ void xcd_barrier_complete(unsigned* bar, unsigned x, unsigned& nloc, unsigned& nx) {
    const unsigned G = gridDim.x * gridDim.y * gridDim.z;
    unsigned sum, cnt, mine, sp = 0u;
    for (;;) {
        sum = 0u; cnt = 0u; mine = 0u;
#pragma unroll
        for (unsigned j = 0; j < 16; ++j) { const unsigned c = xb_ld(&bar[XB_XCNT(j)]); sum += c; cnt += (c > 0u) ? 1u : 0u; mine = (j == x) ? c : mine; }
        if (sum == G) break;
        __builtin_amdgcn_s_sleep(1);
        if ((++sp & 255u) == 0u) { if (xb_ld(&bar[XB_TMO])) break; if (sp > XB_SPIN_CAP) { atomicAdd(&bar[XB_TMO], 1u); break; } }
    }
    nloc = mine > 0u ? mine : 1u; nx = cnt > 0u ? cnt : 1u;
}
__device__ __forceinline__ void xcd_barrier(const XcdBarrier& b) {
    asm volatile("s_waitcnt vmcnt(0)" ::: "memory");
    __syncthreads();
    if (threadIdx.x == 0) {
        unsigned* bar = b.bar;
        __builtin_amdgcn_s_waitcnt(0);
        unsigned nloc = b.st[0], nx = b.st[1];
        if (nloc == 0u) { xcd_barrier_complete(bar, b.x, nloc, nx); b.st[0] = nloc; b.st[1] = nx; }
        const unsigned old = xb_add(&bar[XB_XSUB(b.x)], 1u);
        const unsigned gen = old / nloc;
        if (old + 1u == (gen + 1u) * nloc) {
            __builtin_amdgcn_fence(__ATOMIC_RELEASE, "agent");
            asm volatile("s_waitcnt vmcnt(0)" ::: "memory");
            const unsigned og = xb_add(&bar[XB_TOP], 1u);
            const unsigned tg = og / nx;
            if (og + 1u == (tg + 1u) * nx) xb_add(&bar[XB_TOPGEN], 1u);
            else XB_SPIN(xb_ld(&bar[XB_TOPGEN]) == tg, bar);
            __builtin_amdgcn_fence(__ATOMIC_ACQUIRE, "agent");
            xb_add(&bar[XB_XGEN(b.x)], 1u);
            asm volatile("s_waitcnt vmcnt(0)" ::: "memory");
        } else {
            XB_SPIN(xb_ld(&bar[XB_XGEN(b.x)]) == gen, bar);
            __builtin_amdgcn_fence(__ATOMIC_ACQUIRE, "agent");
            asm volatile("s_waitcnt vmcnt(0)" ::: "memory");
        }
    }
    __syncthreads();
}


__global__ void __launch_bounds__(NTHR) k_mega(Params p) {
    extern __shared__ __attribute__((aligned(16))) unsigned char lds_raw[];
    LAS unsigned char* lds = (LAS unsigned char*)lds_raw;
    const int G = gridDim.x; const int bx = blockIdx.x;
    volatile LAS unsigned* misc = (volatile LAS unsigned*)(lds + MISC_OFF);
    if (threadIdx.x < 64) misc[threadIdx.x] = 0u;
    __syncthreads();
    const XcdBarrier xbar = xcd_barrier_post((unsigned*)(p.ws + WS_CTL + 65536), misc + 8);
    const int vcu = (G % 8 == 0) ? (bx % 8) * (G / 8) + bx / 8 : bx;
#if PROBE >= 100
    unsigned long long* tsw = (unsigned long long*)(p.ws + WS_CTL + 32768); int tsn = 0;
#define TSTAMP() do { if (blockIdx.x == 0 && threadIdx.x == 0) tsw[tsn] = __builtin_amdgcn_s_memrealtime(); ++tsn; } while (0)
    TSTAMP();
#else
#define TSTAMP() do {} while (0)
#endif
    bf16_t* win_t = (bf16_t*)(p.ws + WS_WIN); bf16_t* wout_t = (bf16_t*)(p.ws + WS_WOUT);
    bf16_t* xb = (bf16_t*)(p.ws + WS_XB); bf16_t* zb = (bf16_t*)(p.ws + WS_Z); bf16_t* mixb = (bf16_t*)(p.ws + WS_MIX);
    float* ssq = (float*)(p.ws + WS_SSQ);
    bf16_t* xn2b = (bf16_t*)(p.ws + WS_XB);
    float* h = p.out;

    constexpr int NWG1 = (T / 256) * (INW / 256);
    const int n_idle = (NWG1 % G) ? G - (NWG1 % G) : 0, idle_idx = bx - (NWG1 % G);
    const int e_split = (n_idle >= 96) ? 4 : NE;
    ph_prologue(p, lds, vcu, G, e_split);
    xcd_barrier(xbar);
    TSTAMP();
    {
        pg8::DenseOrder So; So.init(xb, win_t, T, INW, D, G, bx);
        pg8::EpiZ E{zb, INW};
        pg8::gemm_phase(lds, D, So, E);
        if (e_split < NE && idle_idx >= 0) p1_tail_convert(p, lds, idle_idx, n_idle, e_split);
    }
    xcd_barrier(xbar);
    TSTAMP();
    ph_mixers(p, zb, mixb, ssq, lds, (unsigned*)(p.ws + WS_CTL + 8192));
#if PROBE == 3
    ph_mixers(p, zb, mixb, ssq, lds, (unsigned*)(p.ws + WS_CTL + 8192 + 2048)); ph_mixers(p, zb, mixb, ssq, lds, (unsigned*)(p.ws + WS_CTL + 8192 + 4096));
#endif
    xcd_barrier(xbar);
    TSTAMP();
    {
        pg8::DenseOrder So; So.init(mixb, wout_t, T, D, D, G, bx);
        pg8::EpiH E{ssq, p.x, h, xn2b, TAB_OFF};
        pg8::gemm_phase(lds, D, So, E);
#if PROBE == 4
        pg8::gemm_phase(lds, D, So, E); pg8::gemm_phase(lds, D, So, E);
#endif
    }
    xcd_barrier(xbar);
    TSTAMP();
    int* gcount = (int*)(p.ws + WS_CTL + 4096); int* tok_list = (int*)(p.ws + WS_LIST); float* w_list = (float*)(p.ws + WS_LIST + MiB);
    bf16_t* wgu_t = (bf16_t*)(p.ws + WS_WGU); bf16_t* wd_t = (bf16_t*)(p.ws + WS_WD); bf16_t* hid = (bf16_t*)(p.ws + WS_HID); bf16_t* y2 = (bf16_t*)(p.ws + WS_Z);
    float* r_list = (float*)(p.ws + WS_ROUTE);
    ph_router3(p, h, gcount, tok_list, w_list, r_list, lds);
#if PROBE == 5
    ph_router3(p, h, (int*)(p.ws + WS_CTL + 16384), (int*)(p.ws + WS_HID), (float*)(p.ws + WS_HID + MiB), (float*)(p.ws + WS_HID + 2 * MiB), lds);
    ph_router3(p, h, (int*)(p.ws + WS_CTL + 16384 + 256), (int*)(p.ws + WS_HID + 4 * MiB), (float*)(p.ws + WS_HID + 5 * MiB), (float*)(p.ws + WS_HID + 6 * MiB), lds);
#endif
    xcd_barrier(xbar);
    TSTAMP();
    LAS int* meta = (LAS int*)(lds + META_OFF);
    if (threadIdx.x == 0) { int base = 0; for (int e = 0; e < NE; ++e) { const int cnt = gcount[e]; meta[e] = base; meta[32 + e] = cnt; base += (cnt + 255) >> 8; } meta[16] = base; }
    __syncthreads();
    const int ntiles = meta[16];
    {
        pg8::MoeOrder<0> So{xn2b, wgu_t, tok_list, meta, D, G, bx, ntiles};
        pg8::EpiHid E{hid, r_list, meta};
        pg8::gemm_phase(lds, D, So, E);
        { const int r5 = (ntiles * 4) % G; if (r5 == 0) p5a_tail_convert(p, lds, bx, G); else if (bx >= r5) p5a_tail_convert(p, lds, bx - r5, G - r5); }
#if PROBE == 6
        pg8::gemm_phase(lds, D, So, E); pg8::gemm_phase(lds, D, So, E);
#endif
    }
    xcd_barrier(xbar);
    TSTAMP();
    {
        pg8::MoeOrder<1> So{hid, wd_t, tok_list, meta, DFF, G, bx, ntiles};
        pg8::EpiY E{y2, tok_list, w_list, meta};
        pg8::gemm_phase(lds, DFF, So, E);
#if PROBE == 7
        pg8::gemm_phase(lds, DFF, So, E); pg8::gemm_phase(lds, DFF, So, E);
#endif
    }
    xcd_barrier(xbar);
    TSTAMP();
#if PROBE == 8
    ph_final(p, h, y2, (float*)(p.ws + WS_MIX)); ph_final(p, h, y2, (float*)(p.ws + WS_MIX));
#endif
#if PROBE >= 100
    xcd_barrier(xbar);
#endif
    ph_final(p, h, y2, p.out);
}

extern "C" void kernel_launch(void* const* d_in, const int* in_sizes, int n_in, void* d_out, int out_size, void* d_ws, size_t ws_size, hipStream_t stream) {
    static int grid_blocks = 0;
    if (!grid_blocks) {
        if (ws_size < WS_END) { fprintf(stderr, "kernel_launch: workspace too small (%zu < %zu)\n", ws_size, (size_t)WS_END); grid_blocks = -1; return; }
        int dev = 0, cus = 0, per_cu = 0;
        (void)hipGetDevice(&dev);
        (void)hipDeviceGetAttribute(&cus, hipDeviceAttributeMultiprocessorCount, dev);
        (void)hipFuncSetAttribute((const void*)k_mega, hipFuncAttributeMaxDynamicSharedMemorySize, LDS_BYTES);
        (void)hipOccupancyMaxActiveBlocksPerMultiprocessor(&per_cu, (const void*)k_mega, NTHR, LDS_BYTES);
        if (per_cu < 1) { fprintf(stderr, "kernel_launch: occupancy query says %d blocks per CU: not launching\n", per_cu); grid_blocks = -1; return; }
        grid_blocks = cus;
    }
    if (grid_blocks < 0) return;
    Params p{};
    const float** f = (const float**)&p;
    for (int i = 0; i < 23; ++i) f[i] = (const float*)d_in[i];
    p.out = (float*)d_out;
    p.ws = (unsigned char*)d_ws;
    (void)hipMemsetAsync((char*)d_ws + WS_CTL, 0, CTL_ZERO_BYTES, stream);
    hipLaunchKernelGGL(k_mega, dim3(grid_blocks), dim3(NTHR), LDS_BYTES, stream, p);
    hipError_t e = hipPeekAtLastError();
    if (e != hipSuccess) fprintf(stderr, "launch failed: %s (grid %d)\n", hipGetErrorString(e), grid_blocks);
}
```

```cpp
#include <hip/hip_runtime.h>
#include <cstdio>
#include <cstdint>

#define LAS __attribute__((address_space(3)))
typedef unsigned short bf16_t;
typedef short bf16x8 __attribute__((ext_vector_type(8)));
typedef float f32x4 __attribute__((ext_vector_type(4)));
typedef float f32x2 __attribute__((ext_vector_type(2)));
typedef unsigned u32x4 __attribute__((ext_vector_type(4)));
typedef unsigned u32x2 __attribute__((ext_vector_type(2)));

constexpr int D = 1024, NB = 8, S = 2048, T = NB * S;
constexpr int RW = 512, RHD = 64;
constexpr int CHUNK = 64, LEFT = 8, BAND = 576, MAXREL = 128;
constexpr int INW = 2560;
constexpr int NE = 16, DFF = 512;
constexpr float EPS = 1e-6f;
constexpr int NTHR = 512, NWAVES = 8;
constexpr int SSQW = 40;

constexpr size_t MiB = 1u << 20;
constexpr size_t WS_CTL = 0, CTL_BYTES = 2 * MiB, CTL_ZERO_BYTES = 128 * 1024 + 512 * 1024;
constexpr size_t WS_WIN = 2 * MiB;
constexpr size_t WS_WOUT = 7 * MiB;
constexpr size_t WS_WGU = 9 * MiB;
constexpr size_t WS_WD = 41 * MiB;
constexpr size_t WS_XB = 57 * MiB;
constexpr size_t WS_Z = 89 * MiB;
constexpr size_t WS_MIX = 169 * MiB;
constexpr size_t WS_HID = 201 * MiB;
constexpr size_t WS_SSQ = 237 * MiB;
constexpr size_t WS_LIST = 240 * MiB;
constexpr size_t WS_ROUTE = 242 * MiB;
constexpr size_t WS_RWT = 243 * MiB;
constexpr size_t WS_GWT = 244 * MiB;
constexpr size_t WS_END = 245 * MiB;

constexpr int RING_BYTES = 131072, TAB_OFF = RING_BYTES, META_OFF = RING_BYTES + 4096, MISC_OFF = RING_BYTES + 15360, LDS_BYTES = 147456;

struct Params {
    const float *x, *norm1_g, *w_in, *conv_w, *conv_b, *w_rg_a, *b_rg_a, *w_rg_x, *b_rg_x, *lru_lambda, *rel_bias,
        *g_rec_out, *g_att_out, *w_out, *norm2_g, *w_group, *b_group, *w_router, *b_router, *w_e_gate, *w_e_up, *w_e_down, *final_g;
    float* out;
    unsigned char* ws;
};

__device__ __forceinline__ float wave_sum(float v) {
#pragma unroll
    for (int o = 32; o > 0; o >>= 1) v += __shfl_xor(v, o);
    return v;
}
__device__ __forceinline__ float sigmoidf_(float x) { return 1.0f / (1.0f + expf(-x)); }
__device__ __forceinline__ float gelu_tanh(float x) { return 0.5f * x * (1.0f + tanhf(0.7978845608028654f * (x + 0.044715f * x * x * x))); }
__device__ __forceinline__ unsigned f2bf(float f) { unsigned u = __builtin_bit_cast(unsigned, f); return (u + 0x7fffu + ((u >> 16) & 1u)) >> 16; }
__device__ __forceinline__ unsigned pk2(float lo, float hi) { return f2bf(lo) | (f2bf(hi) << 16); }
__device__ __forceinline__ float bf2f(bf16_t b) { return __builtin_bit_cast(float, ((unsigned)b) << 16); }
__device__ __forceinline__ unsigned cvt_pk_bf16(float lo, float hi) { unsigned r; asm volatile("v_cvt_pk_bf16_f32 %0, %1, %2" : "=v"(r) : "v"(lo), "v"(hi)); return r; }
#define LDS_WAIT() asm volatile("s_waitcnt lgkmcnt(0)" ::: "memory")
__device__ __forceinline__ int opaque_tid() { int t = threadIdx.x; asm volatile("" : "+v"(t)); return t; }

namespace pg8 {
constexpr int BM = 256, BK = 64, HALF = 128, HTB = HALF * BK * 2, STAGE_BYTES = 8 * HTB, NXCD = 8, WGM = 8;
__device__ __forceinline__ int lds_byte(int r, int c) { const int st = (r >> 4) * 2 + (c >> 5), rr = r & 15, cc = c & 31, ob = rr * 64 + cc * 2; return st * 1024 + (ob ^ (((ob >> 9) & 1) << 5)); }
__device__ __forceinline__ void stage_rc(int b, int& R, int& C) { const int st = b / 1024, sb = b % 1024, swz = sb ^ (((sb >> 9) & 1) << 5); R = (st >> 1) * 16 + swz / 64; C = (st & 1) * 32 + (swz % 64) / 2; }
__device__ __forceinline__ int perm32(int rho) { const int n = rho >> 4, i = rho & 15; return 8 * (i >> 2) + 4 * n + (i & 3); }

struct Unit { int pm, pn, e, rows; };

struct DenseOrder {
    const bf16_t* A; const bf16_t* Bt; int K; int nM, nN, nwg, G, c;
    __device__ void init(const bf16_t* A_, const bf16_t* Bt_, int M, int N, int K_, int G_, int c_) { A = A_; Bt = Bt_; K = K_; nM = M / BM; nN = N / BM; nwg = nM * nN; G = G_; c = c_; }
    __device__ __forceinline__ bool next(int i, Unit& u) const {
        const long L = (long)i * G + c; if (L >= nwg) return false;
        int wgid = (int)L; { const int q = nwg / NXCD, r = nwg % NXCD, xcd = wgid % NXCD, off = wgid / NXCD; wgid = (xcd < r ? xcd * (q + 1) : r * (q + 1) + (xcd - r) * q) + off; }
        const int nig = WGM * nN, gid = wgid / nig, fm = gid * WGM, gsz = (nM - fm) < WGM ? (nM - fm) : WGM;
        u.pm = fm + ((wgid % nig) % gsz); u.pn = (wgid % nig) / gsz; u.e = 0; u.rows = BM; return true;
    }
    __device__ __forceinline__ void addr(const Unit& u, const int (&RA)[2], const int (&CA)[2], const char*& aBase, const char*& bBase, unsigned (&va)[2][2]) const {
        aBase = (const char*)A; bBase = (const char*)Bt + (size_t)u.pn * BM * K * 2;
#pragma unroll
        for (int h = 0; h < 2; ++h)
#pragma unroll
            for (int i = 0; i < 2; ++i) va[h][i] = (unsigned)(((size_t)(u.pm * BM + h * HALF + RA[i]) * K + CA[i]) * 2);
    }
};

template <class Epi, class Sched>
__device__ __forceinline__ void gemm_phase(LAS unsigned char* lds, const int K, const Sched& S, const Epi& E) {
    int tid_ = threadIdx.x; asm volatile("" : "+v"(tid_));
    const int tid = tid_, wid = __builtin_amdgcn_readfirstlane(tid >> 6), lane = tid & 63, wr = wid >> 2, wc = wid & 3, fr = lane & 15, fq = lane >> 4;
    const int nt = K / BK;
    int RA[2], CA[2]; unsigned voffB[2];
#pragma unroll
    for (int i = 0; i < 2; ++i) { int R, C; stage_rc(tid * 16 + i * 8192, R, C); RA[i] = R; CA[i] = C; const int Rb = Epi::PERM ? ((R & ~31) + perm32(R & 31)) : R; voffB[i] = (unsigned)(Rb * K + C) * 2u; }
    const size_t kstep = (size_t)(BK * 2);
    const size_t hstepB = (size_t)HALF * K * 2;
    const unsigned ldsw = (unsigned)wid * 1024u;
    const int aoff = lds_byte(wr * 64 + fr, fq * 8), boff = lds_byte(wc * 32 + fr, fq * 8);
#define PG8_SA(b, h) (((b) * 2 + (h)) * HTB)
#define PG8_SB(b, h) ((4 + (b) * 2 + (h)) * HTB)
#define PG8_STAGE_B(bufoff, gbase) do { _Pragma("unroll") for (int _i = 0; _i < 2; ++_i) \
        __builtin_amdgcn_global_load_lds((const unsigned*)((const char*)(gbase) + voffB[_i]), (LAS unsigned*)(lds + (bufoff) + ldsw + _i * 8192), 16, 0, 0); } while (0)
#define PG8_STAGE_A(bufoff, gbase, v0, v1) do { \
        __builtin_amdgcn_global_load_lds((const unsigned*)((const char*)(gbase) + (v0)), (LAS unsigned*)(lds + (bufoff) + ldsw), 16, 0, 0); \
        __builtin_amdgcn_global_load_lds((const unsigned*)((const char*)(gbase) + (v1)), (LAS unsigned*)(lds + (bufoff) + ldsw + 8192), 16, 0, 0); } while (0)
#define PG8_LDA(dst, b, h) do { _Pragma("unroll") for (int m = 0; m < 4; ++m) _Pragma("unroll") for (int k = 0; k < 2; ++k) dst[m][k] = *(const LAS bf16x8*)(lds + PG8_SA(b, h) + aoff + m * 2048 + k * 1024); } while (0)
#define PG8_LDB(dst, b, h) do { _Pragma("unroll") for (int n = 0; n < 2; ++n) _Pragma("unroll") for (int k = 0; k < 2; ++k) dst[n][k] = *(const LAS bf16x8*)(lds + PG8_SB(b, h) + boff + n * 2048 + k * 1024); } while (0)
#define PG8_MMA(ai, bj, At, Bt) do { __builtin_amdgcn_s_setprio(1); _Pragma("unroll") for (int m = 0; m < 4; ++m) _Pragma("unroll") for (int n = 0; n < 2; ++n) _Pragma("unroll") for (int k = 0; k < 2; ++k) \
        acc[ai][bj][m][n] = __builtin_amdgcn_mfma_f32_16x16x32_bf16(Bt[n][k], At[m][k], acc[ai][bj][m][n], 0, 0, 0); __builtin_amdgcn_s_setprio(0); } while (0)
#define PG8_WAIT_V(n) asm volatile("s_waitcnt vmcnt(" #n ")" ::: "memory")
#define PG8_WAIT_L(n) asm volatile("s_waitcnt lgkmcnt(" #n ")" ::: "memory")
#define PG8_BAR __builtin_amdgcn_s_barrier()
#define PG8_SCHED __builtin_amdgcn_sched_barrier(0)
    Unit cur, nxt; int ui = 0;
    if (!S.next(0, cur)) return;
    f32x4 acc[2][2][4][2];
#pragma unroll
    for (int a = 0; a < 2; ++a)
#pragma unroll
        for (int b = 0; b < 2; ++b)
#pragma unroll
            for (int m = 0; m < 4; ++m)
#pragma unroll
                for (int n = 0; n < 2; ++n) acc[a][b][m][n] = (f32x4){0.f, 0.f, 0.f, 0.f};
    bf16x8 At[4][2], B0[2][2], B1[2][2];
    const char *cA, *cB, *nA, *nB; unsigned cva[2][2], nva[2][2];
    S.addr(cur, RA, CA, cA, cB, cva);
    E.prepare(cur, ui, lds);
    PG8_STAGE_B(PG8_SB(0, 0), cB); PG8_STAGE_A(PG8_SA(0, 0), cA, cva[0][0], cva[0][1]); PG8_STAGE_B(PG8_SB(0, 1), cB + hstepB); PG8_STAGE_A(PG8_SA(0, 1), cA, cva[1][0], cva[1][1]);
    if (wr == 1) PG8_BAR;
    PG8_WAIT_V(4); PG8_BAR;
    PG8_STAGE_B(PG8_SB(1, 0), cB + kstep); PG8_STAGE_A(PG8_SA(1, 0), cA + kstep, cva[0][0], cva[0][1]); PG8_STAGE_B(PG8_SB(1, 1), cB + hstepB + kstep);
    PG8_WAIT_V(6); PG8_BAR;
    for (;;) {
        const bool has_next = S.next(ui + 1, nxt);
        if (has_next) { S.addr(nxt, RA, CA, nA, nB, nva); }
        else { nA = cA; nB = cB;
#pragma unroll
            for (int h = 0; h < 2; ++h)
#pragma unroll
                for (int i = 0; i < 2; ++i) nva[h][i] = cva[h][i]; }
        for (int t = 0; t < nt; t += 2) {
            const bool last = (t == nt - 2);
            if (Epi::MIDSCALE && t == nt / 2) E.midscale(acc, wr, fr, ui, lds);
            const char* a1 = cA + (size_t)(t + 1) * kstep;
            const char* a2 = last ? nA : cA + (size_t)(t + 2) * kstep; const char* b2 = last ? nB : cB + (size_t)(t + 2) * kstep;
            const char* a3 = a2 + kstep; const char* b3 = b2 + kstep;
            const unsigned x00 = last ? nva[0][0] : cva[0][0], x01 = last ? nva[0][1] : cva[0][1], x10 = last ? nva[1][0] : cva[1][0], x11 = last ? nva[1][1] : cva[1][1];
            if (last && has_next) E.prepare(nxt, ui + 1, lds);
            PG8_LDB(B0, 0, 0); PG8_SCHED; PG8_LDA(At, 0, 0); PG8_STAGE_A(PG8_SA(1, 1), a1, cva[1][0], cva[1][1]);
            PG8_WAIT_L(8); PG8_BAR; PG8_WAIT_L(0); PG8_MMA(0, 0, At, B0); PG8_BAR; PG8_SCHED;
            PG8_LDB(B1, 0, 1); PG8_STAGE_B(PG8_SB(0, 0), b2);
            PG8_BAR; PG8_WAIT_L(0); PG8_MMA(0, 1, At, B1); PG8_BAR;
            PG8_LDA(At, 0, 1); PG8_STAGE_A(PG8_SA(0, 0), a2, x00, x01);
            PG8_BAR; PG8_WAIT_L(0); PG8_MMA(1, 0, At, B0); PG8_BAR; PG8_SCHED;
            PG8_STAGE_B(PG8_SB(0, 1), b2 + hstepB);
            PG8_WAIT_V(6); PG8_BAR; PG8_MMA(1, 1, At, B1); PG8_BAR;
            PG8_LDB(B0, 1, 0); PG8_SCHED; PG8_LDA(At, 1, 0); PG8_STAGE_A(PG8_SA(0, 1), a2, x10, x11);
            PG8_WAIT_L(8); PG8_BAR; PG8_WAIT_L(0); PG8_MMA(0, 0, At, B0); PG8_BAR; PG8_SCHED;
            PG8_LDB(B1, 1, 1); PG8_STAGE_B(PG8_SB(1, 0), b3);
            PG8_BAR; PG8_WAIT_L(0); PG8_MMA(0, 1, At, B1); PG8_BAR;
            PG8_LDA(At, 1, 1); PG8_STAGE_A(PG8_SA(1, 0), a3, x00, x01);
            PG8_BAR; PG8_WAIT_L(0); PG8_MMA(1, 0, At, B0); PG8_BAR; PG8_SCHED;
            PG8_STAGE_B(PG8_SB(1, 1), b3 + hstepB);
            PG8_WAIT_V(6); PG8_BAR; PG8_MMA(1, 1, At, B1); PG8_BAR;
        }
        E(acc, cur, wr, wc, fr, fq, ui, lds);
        if (!has_next) break;
#pragma unroll
        for (int a = 0; a < 2; ++a)
#pragma unroll
            for (int b = 0; b < 2; ++b)
#pragma unroll
                for (int m = 0; m < 4; ++m)
#pragma unroll
                    for (int n = 0; n < 2; ++n) acc[a][b][m][n] = (f32x4){0.f, 0.f, 0.f, 0.f};
        cur = nxt; cA = nA; cB = nB; ++ui;
#pragma unroll
        for (int h = 0; h < 2; ++h)
#pragma unroll
            for (int i = 0; i < 2; ++i) cva[h][i] = nva[h][i];
    }
    PG8_WAIT_V(0);
    if (wr == 0) PG8_BAR;
    PG8_BAR;
#undef PG8_SA
#undef PG8_SB
#undef PG8_STAGE_A
#undef PG8_STAGE_B
#undef PG8_LDA
#undef PG8_LDB
#undef PG8_MMA
#undef PG8_WAIT_V
#undef PG8_WAIT_L
#undef PG8_BAR
#undef PG8_SCHED
}

struct EpiZ {
    static constexpr bool PERM = true, MIDSCALE = false;
    bf16_t* O; int ldc;
    __device__ __forceinline__ void prepare(const Unit&, int, LAS unsigned char*) const {}
    __device__ __forceinline__ void midscale(f32x4 (&)[2][2][4][2], int, int, int, LAS unsigned char*) const {}
    __device__ __forceinline__ void operator()(const f32x4 (&acc)[2][2][4][2], const Unit& u, int wr, int wc, int fr, int fq, int, LAS unsigned char*) const {
        const int row0 = u.pm * BM + wr * 64 + fr, col0 = u.pn * BM + wc * 32 + 8 * fq;
#pragma unroll
        for (int ai = 0; ai < 2; ++ai)
#pragma unroll
            for (int m = 0; m < 4; ++m) { bf16_t* rowp = O + (size_t)(row0 + ai * HALF + m * 16) * ldc + col0;
#pragma unroll
                for (int bj = 0; bj < 2; ++bj) { const f32x4 v0 = acc[ai][bj][m][0], v1 = acc[ai][bj][m][1];
                    u32x4 w; w.x = cvt_pk_bf16(v0[0], v0[1]); w.y = cvt_pk_bf16(v0[2], v0[3]); w.z = cvt_pk_bf16(v1[0], v1[1]); w.w = cvt_pk_bf16(v1[2], v1[3]);
                    *(u32x4*)(rowp + bj * HALF) = w; } }
    }
};
struct EpiH {
    static constexpr bool PERM = false, MIDSCALE = true;
    const float* ssq; const float* x; float* h; bf16_t* hb; int tab_off;
    __device__ __forceinline__ void prepare(const Unit& u, int ui, LAS unsigned char* lds) const {
        LAS f32x2* tab = (LAS f32x2*)(lds + tab_off) + (ui & 1) * 256;
        if (threadIdx.x < 256) {
            const float* sp = ssq + (size_t)(u.pm * BM + threadIdx.x) * SSQW; float sa = 0.f, sb = 0.f;
#pragma unroll
            for (int i = 0; i < 8; ++i) { const f32x4 v = *(const f32x4*)(sp + 4 * i); sa += (v[0] + v[1]) + (v[2] + v[3]); }
#pragma unroll
            for (int i = 8; i < 10; ++i) { const f32x4 v = *(const f32x4*)(sp + 4 * i); sb += (v[0] + v[1]) + (v[2] + v[3]); }
            const float ra = rsqrtf(sa * (1.0f / 512.0f) + EPS), rb = rsqrtf(sb * (1.0f / 512.0f) + EPS);
            tab[threadIdx.x] = (f32x2){ra / rb, rb};
        }
    }
    __device__ __forceinline__ void midscale(f32x4 (&acc)[2][2][4][2], int wr, int fr, int ui, LAS unsigned char* lds) const {
        const LAS f32x2* tab = (const LAS f32x2*)(lds + tab_off) + (ui & 1) * 256;
#pragma unroll
        for (int ai = 0; ai < 2; ++ai)
#pragma unroll
            for (int m = 0; m < 4; ++m) { const float s = tab[ai * HALF + wr * 64 + m * 16 + fr].x;
#pragma unroll
                for (int bj = 0; bj < 2; ++bj)
#pragma unroll
                    for (int n = 0; n < 2; ++n) acc[ai][bj][m][n] = acc[ai][bj][m][n] * s; }
    }
    __device__ __forceinline__ void operator()(const f32x4 (&acc)[2][2][4][2], const Unit& u, int wr, int wc, int fr, int fq, int ui, LAS unsigned char* lds) const {
        const LAS f32x2* tab = (const LAS f32x2*)(lds + tab_off) + (ui & 1) * 256;
        const int row0 = u.pm * BM + wr * 64 + fr, col0 = u.pn * BM + wc * 32 + 4 * fq;
#pragma unroll
        for (int ai = 0; ai < 2; ++ai)
#pragma unroll
            for (int m = 0; m < 4; ++m) { const float s = tab[ai * HALF + wr * 64 + m * 16 + fr].y; const size_t ro = (size_t)(row0 + ai * HALF + m * 16) * D + col0;
#pragma unroll
                for (int bj = 0; bj < 2; ++bj)
#pragma unroll
                    for (int n = 0; n < 2; ++n) { const f32x4 xv = *(const f32x4*)(x + ro + bj * HALF + n * 16); const f32x4 hv = xv + acc[ai][bj][m][n] * s;
                        *(f32x4*)(h + ro + bj * HALF + n * 16) = hv; *(u32x2*)(hb + ro + bj * HALF + n * 16) = (u32x2){cvt_pk_bf16(hv[0], hv[1]), cvt_pk_bf16(hv[2], hv[3])}; } }
    }
};

template <int MODE>
struct MoeOrder {
    const bf16_t* A; const bf16_t* Bt; const int* tok_list; const LAS int* meta; int K, G, c, ntiles;
    __device__ __forceinline__ bool next(int i, Unit& u) const {
        const int L = i * G + c; if (L >= ntiles * 4) return false;
        const int mt = L >> 2; int e = 0;
#pragma unroll
        for (int j = 1; j < NE; ++j) e += (mt >= meta[j]) ? 1 : 0;
        u.pm = mt; u.pn = L & 3; u.e = e; u.rows = meta[32 + e] - (mt - meta[e]) * BM; return true;
    }
    __device__ __forceinline__ void addr(const Unit& u, const int (&RA)[2], const int (&CA)[2], const char*& aBase, const char*& bBase, unsigned (&va)[2][2]) const {
        aBase = (const char*)A; bBase = (const char*)Bt + ((size_t)u.e * D + (size_t)u.pn * BM) * K * 2;
        const int slot0 = (u.pm - meta[u.e]) * BM;
#pragma unroll
        for (int h = 0; h < 2; ++h)
#pragma unroll
            for (int i = 0; i < 2; ++i) {
                const int r = h * HALF + RA[i];
                if (MODE == 0) { int tok = 0; if (r < u.rows) tok = tok_list[u.e * T + slot0 + r] >> 1; va[h][i] = (unsigned)(((size_t)tok * K + CA[i]) * 2); }
                else va[h][i] = (unsigned)(((size_t)(u.pm * BM + r) * K + CA[i]) * 2);
            }
    }
};
struct EpiHid {
    static constexpr bool PERM = true, MIDSCALE = false;
    bf16_t* hid; const float* r_list; const LAS int* meta;
    __device__ __forceinline__ void prepare(const Unit&, int, LAS unsigned char*) const {}
    __device__ __forceinline__ void midscale(f32x4 (&)[2][2][4][2], int, int, int, LAS unsigned char*) const {}
    __device__ __forceinline__ void operator()(const f32x4 (&acc)[2][2][4][2], const Unit& u, int wr, int wc, int fr, int fq, int, LAS unsigned char*) const {
        const int row0 = u.pm * BM + wr * 64 + fr, j0 = u.pn * 128 + wc * 16 + 4 * fq, slot0 = (u.pm - meta[u.e]) * BM;
#pragma unroll
        for (int ai = 0; ai < 2; ++ai)
#pragma unroll
            for (int m = 0; m < 4; ++m) { bf16_t* rowp = hid + (size_t)(row0 + ai * HALF + m * 16) * DFF + j0;
                const int r = ai * HALF + wr * 64 + m * 16 + fr; const float rs = (r < u.rows) ? r_list[u.e * T + slot0 + r] : 0.f;
#pragma unroll
                for (int bj = 0; bj < 2; ++bj) { const f32x4 g = acc[ai][bj][m][0] * rs, up = acc[ai][bj][m][1] * rs; float hv[4];
#pragma unroll
                    for (int q = 0; q < 4; ++q) hv[q] = g[q] * up[q] * __builtin_amdgcn_rcpf(1.0f + __expf(-g[q]));
                    *(u32x2*)(rowp + bj * 64) = (u32x2){cvt_pk_bf16(hv[0], hv[1]), cvt_pk_bf16(hv[2], hv[3])}; } }
    }
};
struct EpiY {
    static constexpr bool PERM = true, MIDSCALE = false;
    bf16_t* y2; const int* tok_list; const float* w_list; const LAS int* meta;
    __device__ __forceinline__ void prepare(const Unit&, int, LAS unsigned char*) const {}
    __device__ __forceinline__ void midscale(f32x4 (&)[2][2][4][2], int, int, int, LAS unsigned char*) const {}
    __device__ __forceinline__ void operator()(const f32x4 (&acc)[2][2][4][2], const Unit& u, int wr, int wc, int fr, int fq, int, LAS unsigned char*) const {
        const int slot0 = (u.pm - meta[u.e]) * BM, col0 = u.pn * BM + wc * 32 + 8 * fq;
#pragma unroll
        for (int ai = 0; ai < 2; ++ai)
#pragma unroll
            for (int m = 0; m < 4; ++m) { const int r = ai * HALF + wr * 64 + m * 16 + fr;
                if (r < u.rows) { const int dst = tok_list[u.e * T + slot0 + r]; const float w = w_list[u.e * T + slot0 + r]; bf16_t* rowp = y2 + (size_t)dst * D + col0;
#pragma unroll
                    for (int bj = 0; bj < 2; ++bj) { const f32x4 v0 = acc[ai][bj][m][0] * w, v1 = acc[ai][bj][m][1] * w;
                        u32x4 o; o.x = cvt_pk_bf16(v0[0], v0[1]); o.y = cvt_pk_bf16(v0[2], v0[3]); o.z = cvt_pk_bf16(v1[0], v1[1]); o.w = cvt_pk_bf16(v1[2], v1[3]);
                        *(u32x4*)(rowp + bj * HALF) = o; } } }
    }
};
}

struct RowId { int off; __device__ __forceinline__ int operator()(int n) const { return off + n; } };
struct RowGU { int up; __device__ __forceinline__ int operator()(int j) const { return (j >> 2) * 8 + (j & 3) + 4 * up; } };

struct TItem { const float* src; const float* gp; bf16_t* dst; int N, K, rmk; };
__device__ __forceinline__ TItem p0_decode(const Params& p, int it) {
    constexpr int I_IN = (D / 64) * (INW / 32), I_OUT = (D / 64) * (D / 32), I_G = (D / 64) * (DFF / 32), I_D = (DFF / 64) * (D / 32), I_E = 2 * I_G + I_D;
    const float* W; const float* g; bf16_t* WT; int K, N, rmk, idx;
    if (it < I_IN) { W = p.w_in; g = p.norm1_g; WT = (bf16_t*)(p.ws + WS_WIN); K = D; N = INW; rmk = 0; idx = it; }
    else if (it < I_IN + I_OUT) { W = p.w_out; g = nullptr; WT = (bf16_t*)(p.ws + WS_WOUT); K = D; N = D; rmk = 0; idx = it - I_IN; }
    else if (it < I_IN + I_OUT + NE * 2 * I_G) { const int r = it - I_IN - I_OUT, e = r / (2 * I_G), q = r % (2 * I_G);
        if (q < I_G) { W = p.w_e_gate + (size_t)e * D * DFF; g = p.norm2_g; WT = (bf16_t*)(p.ws + WS_WGU) + (size_t)e * D * D; K = D; N = DFF; rmk = 1; idx = q; }
        else { W = p.w_e_up + (size_t)e * D * DFF; g = p.norm2_g; WT = (bf16_t*)(p.ws + WS_WGU) + (size_t)e * D * D; K = D; N = DFF; rmk = 2; idx = q - I_G; } }
    else { const int r = it - I_IN - I_OUT - NE * 2 * I_G, e = r / I_D; idx = r % I_D;
        W = p.w_e_down + (size_t)e * DFF * D; g = nullptr; WT = (bf16_t*)(p.ws + WS_WD) + (size_t)e * D * DFF; K = DFF; N = D; rmk = 0; }
    const int nblk = N / 32, kb = idx / nblk, nb = idx % nblk, k0 = 64 * kb, n0 = 32 * nb;
    TItem t; t.src = W + (size_t)k0 * N + n0; t.dst = WT + k0; t.N = N; t.K = K; t.rmk = rmk;
    t.gp = g ? g + k0 : nullptr;
    if (it >= I_IN && it < I_IN + I_OUT) t.gp = (k0 < 512) ? p.g_rec_out + k0 : p.g_att_out + (k0 - 512);
    t.rmk = rmk | (n0 << 4);
    return t;
}
__device__ __forceinline__ void p0_load(const TItem& t, f32x4 (&ld)[8], float (&gv)[8], int lane) {
#pragma unroll
    for (int i = 0; i < 8; ++i) ld[i] = *(const f32x4*)(t.src + (size_t)(8 * i + (lane >> 3)) * t.N + 4 * (lane & 7));
    if (t.gp) {
#pragma unroll
        for (int i = 0; i < 8; ++i) gv[i] = t.gp[8 * i + (lane >> 3)];
    } else {
#pragma unroll
        for (int i = 0; i < 8; ++i) gv[i] = 1.0f;
    }
}
__device__ __forceinline__ void p0_process(const TItem& t, const f32x4 (&ld)[8], const float (&gv)[8], LAS float* scr, int lane) {
#pragma unroll
    for (int i = 0; i < 8; ++i) { const int kk = 8 * i + (lane >> 3); const f32x4 v = ld[i] * gv[i];
        LAS float* d = scr + kk * 33 + 4 * (lane & 7); d[0] = v[0]; d[1] = v[1]; d[2] = v[2]; d[3] = v[3]; }
    LDS_WAIT(); asm volatile("" ::: "memory");
    const int c = lane & 7, n0 = t.rmk >> 4, rmk = t.rmk & 15;
#pragma unroll
    for (int j = 0; j < 4; ++j) { const int n = (lane >> 3) + 8 * j; const LAS float* s = scr + (8 * c) * 33 + n;
        u32x4 o; o.x = pk2(s[0 * 33], s[1 * 33]); o.y = pk2(s[2 * 33], s[3 * 33]); o.z = pk2(s[4 * 33], s[5 * 33]); o.w = pk2(s[6 * 33], s[7 * 33]);
        const int nn = n0 + n, row = (rmk == 0) ? nn : ((nn >> 2) * 8 + (nn & 3) + 4 * (rmk - 1));
        *(u32x4*)(t.dst + (size_t)row * t.K + 8 * c) = o; }
    LDS_WAIT(); asm volatile("" ::: "memory");
}

__device__ __forceinline__ void p0_convert_range(const Params& p, LAS float* scr, int it0, int it1, int gw, int ngw, int lane) {
    int it = it0 + gw; TItem cur; f32x4 la[8]; float ga[8];
    if (it < it1) { cur = p0_decode(p, it); p0_load(cur, la, ga, lane); }
    while (it < it1) {
        const int nit = it + ngw; TItem nxt = cur; f32x4 lb[8]; float gb[8];
        const bool has = nit < it1;
        if (has) { nxt = p0_decode(p, nit); p0_load(nxt, lb, gb, lane); }
        p0_process(cur, la, ga, scr, lane);
        if (has) { cur = nxt;
#pragma unroll
            for (int i = 0; i < 8; ++i) { la[i] = lb[i]; ga[i] = gb[i]; } }
        it = nit;
    }
}

__device__ __forceinline__ void ph_prologue(const Params& p, LAS unsigned char* lds, int vcu, int G, int e_split) {
    const int tid = opaque_tid(), lane = tid & 63, wave = tid >> 6;
    LAS float* scr = (LAS float*)(lds + wave * 16384);
    const int gw = vcu * NWAVES + wave, NGW = G * NWAVES;
    bf16_t* xb = (bf16_t*)(p.ws + WS_XB);
    constexpr int I_IN = (D / 64) * (INW / 32), I_OUT = (D / 64) * (D / 32), I_G = (D / 64) * (DFF / 32), I_D = (DFF / 64) * (D / 32), I_E = 2 * I_G + I_D, I_ALL = I_IN + I_OUT + NE * I_E;
    p0_convert_range(p, scr, 0, I_IN + I_OUT + e_split * 2 * I_G, gw, NGW, lane);
    {
        bf16_t* gwt = (bf16_t*)(p.ws + WS_GWT); float* sp8 = (float*)(p.ws + WS_GWT + 8 * 128 * 144);
        for (int idx = gw * 64 + lane; idx < 8 * 64 * 128; idx += NGW * 64) { const int hb = idx >> 13, k = (idx >> 7) & 63, n = idx & 127;
            const float v = (n < 64) ? p.w_rg_a[(hb * 64 + k) * 64 + n] : p.w_rg_x[(hb * 64 + k) * 64 + n - 64];
            gwt[(hb * 128 + n) * 72 + k] = (bf16_t)f2bf(v); }
        for (int idx = gw * 64 + lane; idx < RW; idx += NGW * 64) sp8[idx] = -8.0f * log1pf(expf(-p.lru_lambda[idx]));
    }
    {
        float* rwt = (float*)(p.ws + WS_RWT);
        for (int idx = gw * 64 + lane; idx < D * 20; idx += NGW * 64) { const int k = idx / 20, n = idx % 20;
            rwt[n * 1028 + k] = (n < 16 ? p.w_router[k * 16 + n] : p.w_group[k * 4 + n - 16]) * p.norm2_g[k]; }
    }
    for (int t = gw; t < T; t += 2 * NGW) {
        const int t2 = t + NGW; const bool has2 = t2 < T;
        const f32x4* xr = (const f32x4*)(p.x + (size_t)t * D) + lane; const f32x4* xr2 = (const f32x4*)(p.x + (size_t)(has2 ? t2 : t) * D) + lane;
        f32x4 v[4], v2[4]; float ss = 0.f, ss2 = 0.f;
#pragma unroll
        for (int j = 0; j < 4; ++j) { v[j] = xr[64 * j]; v2[j] = xr2[64 * j]; }
#pragma unroll
        for (int j = 0; j < 4; ++j) { ss += (v[j][0] * v[j][0] + v[j][1] * v[j][1]) + (v[j][2] * v[j][2] + v[j][3] * v[j][3]); ss2 += (v2[j][0] * v2[j][0] + v2[j][1] * v2[j][1]) + (v2[j][2] * v2[j][2] + v2[j][3] * v2[j][3]); }
        const float r = rsqrtf(wave_sum(ss) * (1.0f / D) + EPS), r2 = rsqrtf(wave_sum(ss2) * (1.0f / D) + EPS);
        u32x2* o8 = (u32x2*)(xb + (size_t)t * D) + lane;
#pragma unroll
        for (int j = 0; j < 4; ++j) o8[64 * j] = (u32x2){pk2(v[j][0] * r, v[j][1] * r), pk2(v[j][2] * r, v[j][3] * r)};
        if (has2) { u32x2* o82 = (u32x2*)(xb + (size_t)t2 * D) + lane;
#pragma unroll
            for (int j = 0; j < 4; ++j) o82[64 * j] = (u32x2){pk2(v2[j][0] * r2, v2[j][1] * r2), pk2(v2[j][2] * r2, v2[j][3] * r2)}; }
    }
}

__device__ __forceinline__ void p1_tail_convert(const Params& p, LAS unsigned char* lds, int idle_idx, int n_idle, int e_split) {
    const int tid = opaque_tid(), lane = tid & 63, wave = tid >> 6;
    constexpr int I_IN = (D / 64) * (INW / 32), I_OUT = (D / 64) * (D / 32), I_G = (D / 64) * (DFF / 32), I_D = (DFF / 64) * (D / 32), I_E = 2 * I_G + I_D, I_ALL = I_IN + I_OUT + NE * I_E;
    p0_convert_range(p, (LAS float*)(lds + wave * 16384), I_IN + I_OUT + e_split * 2 * I_G, I_IN + I_OUT + NE * 2 * I_G, idle_idx * NWAVES + wave, n_idle * NWAVES, lane);
}

__device__ __forceinline__ void p5a_tail_convert(const Params& p, LAS unsigned char* lds, int widx, int n_workers) {
    const int tid = opaque_tid(), lane = tid & 63, wave = tid >> 6;
    constexpr int I_IN = (D / 64) * (INW / 32), I_OUT = (D / 64) * (D / 32), I_G = (D / 64) * (DFF / 32), I_D = (DFF / 64) * (D / 32);
    p0_convert_range(p, (LAS float*)(lds + wave * 16384), I_IN + I_OUT + NE * 2 * I_G, I_IN + I_OUT + NE * 2 * I_G + NE * I_D, widx * NWAVES + wave, n_workers * NWAVES, lane);
}

typedef float f32x16 __attribute__((ext_vector_type(16)));
typedef short v4i16_t __attribute__((ext_vector_type(4)));
typedef __bf16 bf16x2_t __attribute__((ext_vector_type(2)));
#define MFMA32(a, b, c) __builtin_amdgcn_mfma_f32_32x32x16_bf16((a), (b), (c), 0, 0, 0)
__device__ __forceinline__ unsigned cvtpk_s(float lo, float hi) { f32x2 v = {lo, hi}; bf16x2_t b = __builtin_convertvector(v, bf16x2_t); return __builtin_bit_cast(unsigned, b); }
__device__ __forceinline__ int crow(int r, int hh) { return (r & 3) + 8 * (r >> 2) + 4 * hh; }
__device__ __forceinline__ bf16x8 pack8(const f32x16& x, int s) {
    u32x4 w; w.x = cvtpk_s(x[8 * s + 0], x[8 * s + 1]); w.y = cvtpk_s(x[8 * s + 2], x[8 * s + 3]); w.z = cvtpk_s(x[8 * s + 4], x[8 * s + 5]); w.w = cvtpk_s(x[8 * s + 6], x[8 * s + 7]);
    return __builtin_bit_cast(bf16x8, w);
}
__device__ __forceinline__ v4i16_t vtr(LAS const unsigned char* p) { return __builtin_amdgcn_ds_read_tr16_b64_v4i16((LAS v4i16_t*)p); }
constexpr float LOG2E = 1.4426950408889634f;

struct AttnCtx { LAS float* btab; LAS unsigned char* vbase; int lane, h, q32, hh, vb, vw; float bconst; unsigned kl, vl; };
__device__ __forceinline__ AttnCtx attn_setup(const Params& p, LAS unsigned char* lds, int tab_off) {
    int tid_ = threadIdx.x; asm volatile("" : "+v"(tid_));
    AttnCtx A; const int tid = tid_; A.lane = tid & 63; A.h = __builtin_amdgcn_readfirstlane(tid >> 6); A.q32 = A.lane & 31; A.hh = A.lane >> 5;
    A.btab = (LAS float*)(lds + tab_off) + A.h * 328;
    for (int i = A.lane; i < 2 * MAXREL + 1 + 64; i += 64) A.btab[i] = p.rel_bias[A.h * (2 * MAXREL + 1) + (i > 2 * MAXREL ? 2 * MAXREL : i)] * LOG2E;
    LDS_WAIT(); asm volatile("" ::: "memory");
    A.vbase = lds + A.h * 16384;
    A.vb = ((A.lane >> 4) & 1) * 32 + (A.lane & 3) * 8 + (4 * A.hh + ((A.lane & 15) >> 2)) * 128;
    A.vw = (A.lane >> 3) * 128 + (A.lane & 7) * 16;
    A.bconst = A.btab[2 * MAXREL];
    A.kl = (unsigned)((A.q32 * INW + 8 * A.hh) * 2);
    A.vl = (unsigned)(((A.lane >> 3) * INW + (A.lane & 7) * 8) * 2) + 1024u;
    return A;
}
__device__ __forceinline__ void attn_item(const AttnCtx& A, const bf16_t* z, bf16_t* mixb, float* ssq, int b, int c, int qh) {
    const int lane = A.lane, h = A.h, q32 = A.q32, hh = A.hh, vb = A.vb, vw = A.vw; LAS float* btab = A.btab; LAS unsigned char* vbase = A.vbase;
    const float bconst = A.bconst, QS = 0.125f * LOG2E; const unsigned kl = A.kl, vl = A.vl;
    {
        const int j0 = (c >= LEFT) ? 0 : LEFT - c;
        const char* kband = (const char*)z + (((long)b * S + (long)(c - LEFT) * CHUNK) * INW + 1536 + h * 64) * 2;
        {
            const int qi = qh * 32 + q32;
            const size_t tq = (size_t)b * S + c * CHUNK + qi;
            bf16x8 qf[4];
#pragma unroll
            for (int s = 0; s < 4; ++s) { const u32x4 raw = *(const u32x4*)(z + tq * INW + 1024 + h * 64 + 16 * s + 8 * hh); u32x4 w;
#pragma unroll
                for (int e = 0; e < 4; ++e) w[e] = cvtpk_s(__builtin_bit_cast(float, raw[e] << 16) * QS, __builtin_bit_cast(float, raw[e] & 0xffff0000u) * QS);
                qf[s] = __builtin_bit_cast(bf16x8, w); }
            f32x16 o0, o1;
#pragma unroll
            for (int r = 0; r < 16; ++r) { o0[r] = 0.f; o1[r] = 0.f; }
            float m_ref = 0.f, l_run = 0.f;
            constexpr float THR = 6.0f;
            u32x4 kr[8], vr[8];
            const int kw = (lane >> 3) * 128 + (((lane & 7) ^ (lane >> 3)) << 4);
            const int kfo = q32 * 128;
            {
                const char* tb = kband + (long)(64 * j0) * INW * 2;
#pragma unroll
                for (int i = 0; i < 8; ++i) { kr[i] = *(const u32x4*)(tb + ((vl - 1024u) + (unsigned)(i * 8 * INW * 2))); vr[i] = *(const u32x4*)(tb + (vl + (unsigned)(i * 8 * INW * 2))); }
#pragma unroll
                for (int i = 0; i < 8; ++i) { *(LAS u32x4*)(vbase + i * 1024 + kw) = kr[i]; *(LAS u32x4*)(vbase + 8192 + i * 1024 + vw) = vr[i]; }
            }
#pragma unroll 1
            for (int j = j0; j <= LEFT; ++j) {
                if (j < LEFT) {
                    const char* tb = kband + (long)(64 * (j + 1)) * INW * 2;
#pragma unroll
                    for (int i = 0; i < 8; ++i) { kr[i] = *(const u32x4*)(tb + ((vl - 1024u) + (unsigned)(i * 8 * INW * 2))); vr[i] = *(const u32x4*)(tb + (vl + (unsigned)(i * 8 * INW * 2))); }
                }
                bf16x8 kf[8];
#pragma unroll
                for (int kb = 0; kb < 2; ++kb)
#pragma unroll
                    for (int s = 0; s < 4; ++s) kf[kb * 4 + s] = *(const LAS bf16x8*)(vbase + kb * 4096 + kfo + (((2 * s + hh) ^ (q32 & 7)) << 4));
                f32x16 p0, p1;
                if (j <= 5) {
                    const float ci = bconst - m_ref;
#pragma unroll
                    for (int r = 0; r < 16; ++r) { p0[r] = ci; p1[r] = ci; }
                } else {
                    const LAS float* pb0 = btab + (LEFT * CHUNK + qi - 64 * j + MAXREL - 4 * hh - 27); const LAS float* pb1 = pb0 - 32;
#pragma unroll
                    for (int r = 0; r < 16; ++r) { p0[r] = pb0[27 - ((r & 3) + 8 * (r >> 2))] - m_ref; p1[r] = pb1[27 - ((r & 3) + 8 * (r >> 2))] - m_ref; }
                }
#pragma unroll
                for (int s = 0; s < 4; ++s) { p0 = MFMA32(kf[s], qf[s], p0); p1 = MFMA32(kf[4 + s], qf[s], p1); }
                float mt = fmaxf(p0[0], p1[0]);
#pragma unroll
                for (int r = 1; r < 16; ++r) mt = fmaxf(mt, fmaxf(p0[r], p1[r]));
                mt = fmaxf(mt, __shfl_xor(mt, 32));
                const bool first = (j == j0);
                const bool grow = first || (mt > THR);
                if (__any(grow)) {
                    const float d = grow ? mt : 0.f, alpha = first ? 1.0f : __builtin_amdgcn_exp2f(-d);
                    m_ref += d; l_run *= alpha;
#pragma unroll
                    for (int r = 0; r < 16; ++r) { p0[r] -= d; p1[r] -= d; o0[r] *= alpha; o1[r] *= alpha; }
                }
                float ls0 = 0.f, ls1 = 0.f;
#pragma unroll
                for (int r = 0; r < 16; ++r) { p0[r] = __builtin_amdgcn_exp2f(p0[r]); p1[r] = __builtin_amdgcn_exp2f(p1[r]); ls0 += p0[r]; ls1 += p1[r]; }
                l_run += ls0 + ls1;
                const bf16x8 pf0 = pack8(p0, 0), pf1 = pack8(p0, 1), pf2 = pack8(p1, 0), pf3 = pack8(p1, 1);
                LAS const unsigned char* vcur = vbase + 8192 + vb;
#pragma unroll
                for (int db = 0; db < 2; ++db) {
                    v4i16_t lo[4], hi[4];
#pragma unroll
                    for (int ks = 0; ks < 4; ++ks) { lo[ks] = vtr(vcur + ks * 2048 + db * 64); hi[ks] = vtr(vcur + ks * 2048 + 1024 + db * 64); }
#define VF(k) (bf16x8){lo[k][0], lo[k][1], lo[k][2], lo[k][3], hi[k][0], hi[k][1], hi[k][2], hi[k][3]}
                    if (db == 0) { o0 = MFMA32(VF(0), pf0, o0); o0 = MFMA32(VF(1), pf1, o0); o0 = MFMA32(VF(2), pf2, o0); o0 = MFMA32(VF(3), pf3, o0); }
                    else         { o1 = MFMA32(VF(0), pf0, o1); o1 = MFMA32(VF(1), pf1, o1); o1 = MFMA32(VF(2), pf2, o1); o1 = MFMA32(VF(3), pf3, o1); }
#undef VF
                }
                if (j < LEFT) {
#pragma unroll
                    for (int i = 0; i < 8; ++i) { *(LAS u32x4*)(vbase + i * 1024 + kw) = kr[i]; *(LAS u32x4*)(vbase + 8192 + i * 1024 + vw) = vr[i]; }
                }
            }
            const float lt = l_run + __shfl_xor(l_run, 32), inv = 1.0f / lt;
            float ss = 0.f;
            bf16_t* orow = mixb + tq * D + 512 + h * 64 + 4 * hh;
#pragma unroll
            for (int g = 0; g < 4; ++g) {
                const float a0 = o0[4 * g] * inv, a1 = o0[4 * g + 1] * inv, a2 = o0[4 * g + 2] * inv, a3 = o0[4 * g + 3] * inv;
                const float c0 = o1[4 * g] * inv, c1 = o1[4 * g + 1] * inv, c2 = o1[4 * g + 2] * inv, c3 = o1[4 * g + 3] * inv;
                ss += (a0 * a0 + a1 * a1) + (a2 * a2 + a3 * a3) + (c0 * c0 + c1 * c1) + (c2 * c2 + c3 * c3);
                *(u32x2*)(orow + 8 * g) = (u32x2){cvtpk_s(a0, a1), cvtpk_s(a2, a3)};
                *(u32x2*)(orow + 32 + 8 * g) = (u32x2){cvtpk_s(c0, c1), cvtpk_s(c2, c3)};
            }
            ss += __shfl_xor(ss, 32);
            if (hh == 0) ssq[tq * SSQW + 32 + h] = ss;
        }
    }
}


constexpr int RG_WT = 0, RG_IMG = 18432, RG_SEG = 35840, RG_PRE = 44032, RG_CAR = 52224, RG_ROWB = 144, RG_IROW = 272;
__device__ __forceinline__ float fast_sigmoid(float x) { return __builtin_amdgcn_rcpf(1.0f + __expf(-x)); }
__device__ __forceinline__ void rglru_item(const Params& p, const bf16_t* z, bf16_t* mixb, float* ssq, LAS unsigned char* lds, unsigned long long* gran, int b, int hb, int kc) {
    const int tid = opaque_tid(), lane = tid & 63, w = __builtin_amdgcn_readfirstlane(tid >> 6), ch = lane, c16 = lane & 15, tg = lane >> 4;
    LAS f32x2* seg = (LAS f32x2*)(lds + RG_SEG); LAS f32x2* pre = (LAS f32x2*)(lds + RG_PRE); LAS float* car = (LAS float*)(lds + RG_CAR);
    {
        const u32x4* srcw = (const u32x4*)(p.ws + WS_GWT + (size_t)hb * 128 * 144); LAS u32x4* dstw = (LAS u32x4*)(lds + RG_WT);
        for (int idx = tid; idx < 128 * 144 / 16; idx += NTHR) dstw[idx] = srcw[idx];
    }
    const int gch = hb * 64 + ch;
    const float cw0 = p.conv_w[gch], cw1 = p.conv_w[RW + gch], cw2 = p.conv_w[2 * RW + gch], cw3 = p.conv_w[3 * RW + gch], cb = p.conv_b[gch];
    const float* sp8t = (const float*)(p.ws + WS_GWT + 8 * 128 * 144);
    float ba[4], bxb[4], sp8[4];
#pragma unroll
    for (int nb = 0; nb < 4; ++nb) { const int c = hb * 64 + 16 * nb + c16; ba[nb] = p.b_rg_a[c]; bxb[nb] = p.b_rg_x[c]; sp8[nb] = sp8t[c]; }
    LAS unsigned char* img = lds + RG_IMG;
    LAS unsigned char* trb = img + (8 * tg + (c16 >> 2)) * RG_IROW + (16 * w + 4 * (c16 & 3)) * 2;
    const int s0 = kc * 256;
    const bf16_t* ucol = z + ((size_t)b * S + s0) * INW + gch;
    float av[2][4][4], bv[2][4][4], cP[2][4], cH[2][4];
    bf16_t uraw[2][19], graw[2][4][4];
#pragma unroll
    for (int blk = 0; blk < 2; ++blk)
#pragma unroll
        for (int i = 0; i < 19; ++i) { const int s = blk * 128 + 16 * w - 3 + i; uraw[blk][i] = (s0 + s >= 0) ? ucol[(long)s * INW] : (bf16_t)0; }
#pragma unroll
    for (int blk = 0; blk < 2; ++blk)
#pragma unroll
        for (int nb = 0; nb < 4; ++nb)
#pragma unroll
            for (int i = 0; i < 4; ++i) graw[blk][nb][i] = z[((size_t)b * S + s0 + blk * 128 + 16 * w + 4 * tg + i) * INW + 512 + hb * 64 + 16 * nb + c16];
    __syncthreads();
#pragma unroll
    for (int blk = 0; blk < 2; ++blk) {
        const int t0 = blk * 128 + 16 * w;
        float uv[19];
#pragma unroll
        for (int i = 0; i < 19; ++i) uv[i] = bf2f(uraw[blk][i]);
        {
            float uc[16];
#pragma unroll
            for (int i = 0; i < 16; ++i) uc[i] = cb + cw0 * uv[i] + cw1 * uv[i + 1] + cw2 * uv[i + 2] + cw3 * uv[i + 3];
            u32x4 w0, w1;
#pragma unroll
            for (int e = 0; e < 4; ++e) { w0[e] = cvtpk_s(uc[2 * e], uc[2 * e + 1]); w1[e] = cvtpk_s(uc[8 + 2 * e], uc[9 + 2 * e]); }
            *(LAS u32x4*)(img + ch * RG_IROW + 32 * w) = w0; *(LAS u32x4*)(img + ch * RG_IROW + 32 * w + 16) = w1;
        }
        LDS_WAIT(); asm volatile("" ::: "memory");
        const v4i16_t t0lo = vtr(trb), t0hi = vtr(trb + 4 * RG_IROW), t1lo = vtr(trb + 32 * RG_IROW), t1hi = vtr(trb + 36 * RG_IROW);
        const bf16x8 a0 = (bf16x8){t0lo[0], t0lo[1], t0lo[2], t0lo[3], t0hi[0], t0hi[1], t0hi[2], t0hi[3]}, a1 = (bf16x8){t1lo[0], t1lo[1], t1lo[2], t1lo[3], t1hi[0], t1hi[1], t1hi[2], t1hi[3]};
#pragma unroll
        for (int nb = 0; nb < 4; ++nb) {
            const bf16x8 b0a = *(const LAS bf16x8*)(lds + RG_WT + (16 * nb + c16) * RG_ROWB + tg * 16), b1a = *(const LAS bf16x8*)(lds + RG_WT + (16 * nb + c16) * RG_ROWB + tg * 16 + 64);
            const bf16x8 b0x = *(const LAS bf16x8*)(lds + RG_WT + (64 + 16 * nb + c16) * RG_ROWB + tg * 16), b1x = *(const LAS bf16x8*)(lds + RG_WT + (64 + 16 * nb + c16) * RG_ROWB + tg * 16 + 64);
            f32x4 acca = __builtin_amdgcn_mfma_f32_16x16x32_bf16(a0, b0a, (f32x4){0.f, 0.f, 0.f, 0.f}, 0, 0, 0); acca = __builtin_amdgcn_mfma_f32_16x16x32_bf16(a1, b1a, acca, 0, 0, 0);
            f32x4 accx = __builtin_amdgcn_mfma_f32_16x16x32_bf16(a0, b0x, (f32x4){0.f, 0.f, 0.f, 0.f}, 0, 0, 0); accx = __builtin_amdgcn_mfma_f32_16x16x32_bf16(a1, b1x, accx, 0, 0, 0);
            const u32x2 ucr = *(const LAS u32x2*)(img + (16 * nb + c16) * RG_IROW + (16 * w + 4 * tg) * 2);
            const float ucv[4] = {__builtin_bit_cast(float, ucr[0] << 16), __builtin_bit_cast(float, ucr[0] & 0xffff0000u), __builtin_bit_cast(float, ucr[1] << 16), __builtin_bit_cast(float, ucr[1] & 0xffff0000u)};
            float H = 0.f, P = 1.f;
#pragma unroll
            for (int rg_ = 0; rg_ < 4; ++rg_) {
                const float r = fast_sigmoid(acca[rg_] + ba[nb]), ig = fast_sigmoid(accx[rg_] + bxb[nb]);
                const float a = __expf(r * sp8[nb]);
                av[blk][nb][rg_] = a; bv[blk][nb][rg_] = __builtin_amdgcn_sqrtf((1.0f - a) * (1.0f + a)) * (ig * ucv[rg_]);
                H = a * H + bv[blk][nb][rg_]; P *= a; }
            float cp = 1.f, chh = 0.f, Pt = 1.f, Ht = 0.f;
#pragma unroll
            for (int k = 0; k < 4; ++k) { const float Pk = __shfl(P, c16 + 16 * k), Hk = __shfl(H, c16 + 16 * k);
                cp = (k == tg) ? Pt : cp; chh = (k == tg) ? Ht : chh;
                Ht = Pk * Ht + Hk; Pt *= Pk; }
            cP[blk][nb] = cp; cH[blk][nb] = chh;
            if (tg == 0) seg[(blk * 8 + w) * 64 + 16 * nb + c16] = (f32x2){Pt, Ht};
        }
        LDS_WAIT(); asm volatile("" ::: "memory");
    }
    __syncthreads();
    if (tid < 64) {
        float Pp = 1.f, Hp = 0.f;
#pragma unroll
        for (int s = 0; s < 16; ++s) { pre[s * 64 + tid] = (f32x2){Pp, Hp}; const f32x2 sv = seg[s * 64 + tid]; Hp = sv.x * Hp + sv.y; Pp *= sv.x; }
        unsigned long long* g = gran + ((size_t)((b * 8 + hb) * 8 + kc) * 2) * 64 + tid;
        __hip_atomic_store(g, (1ull << 32) | __builtin_bit_cast(unsigned, Pp), __ATOMIC_RELAXED, __HIP_MEMORY_SCOPE_AGENT);
        __hip_atomic_store(g + 64, (1ull << 32) | __builtin_bit_cast(unsigned, Hp), __ATOMIC_RELAXED, __HIP_MEMORY_SCOPE_AGENT);
        float h = 0.f;
        for (int j = 0; j < kc; ++j) {
            const unsigned long long* gj = gran + ((size_t)((b * 8 + hb) * 8 + j) * 2) * 64 + tid;
            unsigned long long vp, vh; unsigned spins = 0;
            for (;;) { vp = __hip_atomic_load(gj, __ATOMIC_RELAXED, __HIP_MEMORY_SCOPE_AGENT); vh = __hip_atomic_load(gj + 64, __ATOMIC_RELAXED, __HIP_MEMORY_SCOPE_AGENT);
                if (__all(((vp >> 32) != 0ull) && ((vh >> 32) != 0ull))) break; __builtin_amdgcn_s_sleep(2); if (++spins > (1u << 20)) break; }
            h = __builtin_bit_cast(float, (unsigned)vp) * h + __builtin_bit_cast(float, (unsigned)vh);
        }
        car[tid] = h;
    }
    __syncthreads();
#pragma unroll
    for (int blk = 0; blk < 2; ++blk) {
        const int t0 = blk * 128 + 16 * w;
        float ysum[4] = {0.f, 0.f, 0.f, 0.f};
#pragma unroll
        for (int nb = 0; nb < 4; ++nb) {
            const int oc = 16 * nb + c16; const f32x2 pf = pre[(blk * 8 + w) * 64 + oc];
            float hcur = cP[blk][nb] * (pf.x * car[oc] + pf.y) + cH[blk][nb];
            bf16_t* orow = mixb + ((size_t)b * S + s0 + t0 + 4 * tg) * D + hb * 64 + oc;
#pragma unroll
            for (int i = 0; i < 4; ++i) { hcur = av[blk][nb][i] * hcur + bv[blk][nb][i];
                const float g = bf2f(graw[blk][nb][i]), u2 = 1.5957691216057308f * (g + 0.044715f * g * g * g);
                const float y = hcur * g * fast_sigmoid(u2);
                orow[(size_t)i * D] = (bf16_t)(cvtpk_s(y, y) & 0xffffu); ysum[i] += y * y; }
        }
#pragma unroll
        for (int i = 0; i < 4; ++i) ysum[i] += __shfl_xor(ysum[i], 1);
#pragma unroll
        for (int i = 0; i < 4; ++i) ysum[i] += __shfl_xor(ysum[i], 2);
#pragma unroll
        for (int i = 0; i < 4; ++i) ysum[i] += __shfl_xor(ysum[i], 4);
#pragma unroll
        for (int i = 0; i < 4; ++i) ysum[i] += __shfl_xor(ysum[i], 8);
        if (c16 == 0) { float* sq = ssq + ((size_t)b * S + s0 + t0 + 4 * tg) * SSQW + hb * 4;
#pragma unroll
            for (int i = 0; i < 4; ++i) *(f32x4*)(sq + (size_t)i * SSQW) = (f32x4){ysum[i], 0.f, 0.f, 0.f}; }
    }
}

constexpr int RT_WT = 0, RT_LDK = 1028, RT_PART = 82432, RT_SSP = 98816, RT_REC = 99328;
__device__ __forceinline__ void ph_router3(const Params& p, const float* h, int* gcount, int* tok_list, float* w_list, float* r_list, LAS unsigned char* lds) {
    const int tid = opaque_tid(), lane = tid & 63, w = __builtin_amdgcn_readfirstlane(tid >> 6), t16 = lane & 15, g = lane >> 4;
    LAS float* wt = (LAS float*)(lds + RT_WT); LAS float* part = (LAS float*)(lds + RT_PART); LAS float* ssp = (LAS float*)(lds + RT_SSP);
    LAS int* lcnt = (LAS int*)(lds + RT_REC); LAS int* lbase = lcnt + 16; LAS int* rec_e = lcnt + 32; LAS int* rec_s = lcnt + 160; LAS float* rec_w = (LAS float*)(lcnt + 288); LAS float* rec_r = (LAS float*)(lcnt + 416);
    { const f32x4* srcw = (const f32x4*)(p.ws + WS_RWT); LAS f32x4* dstw = (LAS f32x4*)wt;
      for (int idx = tid; idx < 20 * RT_LDK / 4; idx += NTHR) dstw[idx] = srcw[idx]; }
    const int task = w & 3, khalf = w >> 2, kbase = khalf * 512 + g * 128;
    for (int grp = blockIdx.x; grp < T / 64; grp += gridDim.x) {
        if (tid < 16) lcnt[tid] = 0;
        __syncthreads();
        {
            const f32x4* hrow = (const f32x4*)(h + (size_t)(grp * 64 + task * 16 + t16) * D + kbase);
            const LAS f32x4* b0p = (const LAS f32x4*)(wt + t16 * RT_LDK + kbase); const LAS f32x4* b1p = (const LAS f32x4*)(wt + (16 + (lane & 3)) * RT_LDK + kbase);
            f32x4 acc0 = {0.f, 0.f, 0.f, 0.f}, acc1 = {0.f, 0.f, 0.f, 0.f}; float ss = 0.f;
#pragma unroll 1
            for (int jb = 0; jb < 32; jb += 8) {
                f32x4 a[8];
#pragma unroll
                for (int j = 0; j < 8; ++j) a[j] = hrow[jb + j];
#pragma unroll
                for (int j = 0; j < 8; ++j) { const f32x4 b0 = b0p[jb + j], b1 = b1p[jb + j];
#pragma unroll
                    for (int q = 0; q < 4; ++q) { acc0 = __builtin_amdgcn_mfma_f32_16x16x4f32(a[j][q], b0[q], acc0, 0, 0, 0); acc1 = __builtin_amdgcn_mfma_f32_16x16x4f32(a[j][q], b1[q], acc1, 0, 0, 0); ss += a[j][q] * a[j][q]; } }
            }
            ss += __shfl_xor(ss, 16); ss += __shfl_xor(ss, 32);
            if (g == 0) ssp[khalf * 64 + task * 16 + t16] = ss;
            LAS float* pp = part + ((khalf * 4 + task) * 16 + 4 * g) * 32 + t16;
#pragma unroll
            for (int rg_ = 0; rg_ < 4; ++rg_) { pp[rg_ * 32] = acc0[rg_]; pp[rg_ * 32 + 16] = acc1[rg_]; }
        }
        __syncthreads();
        if (tid < 64) {
            const float rstd = rsqrtf((ssp[tid] + ssp[64 + tid]) * (1.0f / D) + EPS);
            const LAS float* q0 = part + tid * 32; const LAS float* q1 = part + (64 + tid) * 32;
            float lg[4];
#pragma unroll
            for (int i = 0; i < 4; ++i) lg[i] = (q0[16 + i] + q1[16 + i]) * rstd + p.b_group[i];
            int gi = 0; float best = lg[0];
#pragma unroll
            for (int i = 1; i < 4; ++i) if (lg[i] > best) { best = lg[i]; gi = i; }
            float den = 0.f;
#pragma unroll
            for (int i = 0; i < 4; ++i) den += expf(lg[i] - best);
            const float pg = 1.0f / den;
            float sel[4];
#pragma unroll
            for (int i = 0; i < 4; ++i) sel[i] = (q0[gi * 4 + i] + q1[gi * 4 + i]) * rstd + p.b_router[gi * 4 + i];
            int i1 = 0; float v1 = sel[0];
#pragma unroll
            for (int i = 1; i < 4; ++i) if (sel[i] > v1) { v1 = sel[i]; i1 = i; }
            int i2 = -1; float v2 = -3.0e38f;
#pragma unroll
            for (int i = 0; i < 4; ++i) if (i != i1 && sel[i] > v2) { v2 = sel[i]; i2 = i; }
            const float e2 = expf(v2 - v1);
            const float w1 = pg / (1.0f + e2), w2 = pg * e2 / (1.0f + e2);
            const int ea = gi * 4 + i1, eb = gi * 4 + i2;
            const int sa = __hip_atomic_fetch_add(lcnt + ea, 1, __ATOMIC_RELAXED, __HIP_MEMORY_SCOPE_WORKGROUP);
            const int sb = __hip_atomic_fetch_add(lcnt + eb, 1, __ATOMIC_RELAXED, __HIP_MEMORY_SCOPE_WORKGROUP);
            rec_e[tid * 2] = ea; rec_s[tid * 2] = sa; rec_w[tid * 2] = w1; rec_r[tid * 2] = rstd;
            rec_e[tid * 2 + 1] = eb; rec_s[tid * 2 + 1] = sb; rec_w[tid * 2 + 1] = w2; rec_r[tid * 2 + 1] = rstd;
        }
        __syncthreads();
        if (tid < 16) lbase[tid] = __hip_atomic_fetch_add(gcount + tid, lcnt[tid], __ATOMIC_RELAXED, __HIP_MEMORY_SCOPE_AGENT);
        __syncthreads();
        if (tid < 128) { const int e = rec_e[tid]; const int pos = lbase[e] + rec_s[tid]; tok_list[e * T + pos] = grp * 128 + tid; w_list[e * T + pos] = rec_w[tid]; r_list[e * T + pos] = rec_r[tid]; }
        __syncthreads();
    }
}

__device__ void ph_final(const Params& p, const float* h, const bf16_t* y2, float* out) {
    const int tid = opaque_tid(), lane = tid & 63, wv = tid >> 6, nw = NWAVES;
    for (int t = blockIdx.x * nw + wv; t < T; t += gridDim.x * nw) {
        const f32x4* hr = (const f32x4*)(h + (size_t)t * D) + lane;
        const u32x2* y0 = (const u32x2*)(y2 + (size_t)(2 * t) * D) + lane; const u32x2* y1 = (const u32x2*)(y2 + (size_t)(2 * t + 1) * D) + lane;
        f32x4 v[4]; float ss = 0.f;
#pragma unroll
        for (int j = 0; j < 4; ++j) { const f32x4 hv = hr[64 * j]; const u32x2 a = y0[64 * j], b = y1[64 * j];
            v[j][0] = hv[0] + __builtin_bit_cast(float, a[0] << 16) + __builtin_bit_cast(float, b[0] << 16);
            v[j][1] = hv[1] + __builtin_bit_cast(float, a[0] & 0xffff0000u) + __builtin_bit_cast(float, b[0] & 0xffff0000u);
            v[j][2] = hv[2] + __builtin_bit_cast(float, a[1] << 16) + __builtin_bit_cast(float, b[1] << 16);
            v[j][3] = hv[3] + __builtin_bit_cast(float, a[1] & 0xffff0000u) + __builtin_bit_cast(float, b[1] & 0xffff0000u);
            ss += (v[j][0] * v[j][0] + v[j][1] * v[j][1]) + (v[j][2] * v[j][2] + v[j][3] * v[j][3]); }
        const float r = rsqrtf(wave_sum(ss) * (1.0f / D) + EPS);
        f32x4* orow = (f32x4*)(out + (size_t)t * D) + lane;
#pragma unroll
        for (int j = 0; j < 4; ++j) { const f32x4 gf = *((const f32x4*)p.final_g + lane + 64 * j); orow[64 * j] = v[j] * r * gf ; }
    }
}


__device__ __forceinline__ void ph_mixers(const Params& p, const bf16_t* z, bf16_t* mixb, float* ssq, LAS unsigned char* lds, unsigned* qctr) {
    const AttnCtx A = attn_setup(p, lds, TAB_OFF);
    volatile LAS int* qword = (volatile LAS int*)(lds + TAB_OFF + 12288);
    constexpr int NQ = NB, QITEMS = 64 + 64;
    unsigned long long* gran = (unsigned long long*)(p.ws + WS_CTL + 128 * 1024);
    const int qstep = (int)gridDim.x < NQ ? (int)gridDim.x : NQ;
    for (int q = blockIdx.x % NQ; q < NQ; q += qstep) {
        int ticket = 0;
        if (threadIdx.x == 0) ticket = (int)__hip_atomic_fetch_add(qctr + 64 * q, 1u, __ATOMIC_RELAXED, __HIP_MEMORY_SCOPE_AGENT);
        for (;;) {
            __syncthreads();
            if (threadIdx.x == 0) { *qword = ticket; if (ticket < QITEMS) ticket = (int)__hip_atomic_fetch_add(qctr + 64 * q, 1u, __ATOMIC_RELAXED, __HIP_MEMORY_SCOPE_AGENT); }
            __syncthreads();
            const int idx = *qword;
            if (idx >= QITEMS) break;
            if (idx < 64) rglru_item(p, z, mixb, ssq, lds, gran, q, idx & 7, idx >> 3);
            else { const int a = idx - 64; attn_item(A, z, mixb, ssq, q, 31 - (a >> 1), a & 1); }
        }
    }
}

#define XB_TMO      128
#define XB_XCNT(j)  (256  + 64 * (j))
#define XB_XSUB(j)  (1280 + 64 * (j))
#define XB_XGEN(j)  (2304 + 64 * (j))
#define XB_TOP      3328
#define XB_TOPGEN   3392
#define XCD_BAR_WORDS 3456
#define XB_SPIN_CAP (1u << 18)
__device__ __forceinline__ unsigned xb_ld(unsigned* p)              { return __hip_atomic_load(p, __ATOMIC_RELAXED, __HIP_MEMORY_SCOPE_AGENT); }
__device__ __forceinline__ unsigned xb_add(unsigned* p, unsigned v) { return __hip_atomic_fetch_add(p, v, __ATOMIC_RELAXED, __HIP_MEMORY_SCOPE_AGENT); }
__device__ __forceinline__ unsigned xb_xcc_id() { return (unsigned)__builtin_amdgcn_s_getreg((3 << 11) | 20) & 0xFu; }
#define XB_SPIN(cond, bar) do { unsigned _sp = 0; while (cond) { __builtin_amdgcn_s_sleep(1); \
    if ((++_sp & 255u) == 0u) { if (xb_ld(&(bar)[XB_TMO])) break; if (_sp > XB_SPIN_CAP) { atomicAdd(&(bar)[XB_TMO], 1u); break; } } } } while (0)
struct XcdBarrier { unsigned* bar; unsigned x; volatile LAS unsigned* st; };
__device__ __forceinline__ XcdBarrier xcd_barrier_post(unsigned* bar, volatile LAS unsigned* st) {
    XcdBarrier b; b.bar = bar; b.x = xb_xcc_id(); b.st = st;
    if (threadIdx.x == 0) (void)xb_add(&bar[XB_XCNT(b.x)], 1u);
    return b;
}
__device__ __forceinline__ void xcd_barrier_complete(unsigned* bar, unsigned x, unsigned& nloc, unsigned& nx) {
    const unsigned G = gridDim.x * gridDim.y * gridDim.z;
    unsigned sum, cnt, mine, sp = 0u;
    for (;;) {
        sum = 0u; cnt = 0u; mine = 0u;
#pragma unroll
        for (unsigned j = 0; j < 16; ++j) { const unsigned c = xb_ld(&bar[XB_XCNT(j)]); sum += c; cnt += (c > 0u) ? 1u : 0u; mine = (j == x) ? c : mine; }
        if (sum == G) break;
        __builtin_amdgcn_s_sleep(1);
        if ((++sp & 255u) == 0u) { if (xb_ld(&bar[XB_TMO])) break; if (sp > XB_SPIN_CAP) { atomicAdd(&bar[XB_TMO], 1u); break; } }
    }
    nloc = mine > 0u ? mine : 1u; nx = cnt > 0u ? cnt : 1u;
}
__device__ __forceinline__ void xcd_barrier(const XcdBarrier& b) {
    asm volatile("s_waitcnt vmcnt(0)" ::: "memory");
    __syncthreads();
    if (threadIdx.x == 0) {
        unsigned* bar = b.bar;
        __builtin_amdgcn_s_waitcnt(0);
        unsigned nloc = b.st[0], nx = b.st[1];
        if (nloc == 0u) { xcd_barrier_complete(bar, b.x, nloc, nx); b.st[0] = nloc; b.st[1] = nx; }
        const unsigned old = xb_add(&bar[XB_XSUB(b.x)], 1u);
        const unsigned gen = old / nloc;
        if (old + 1u == (gen + 1u) * nloc) {
            __builtin_amdgcn_fence(__ATOMIC_RELEASE, "agent");
            asm volatile("s_waitcnt vmcnt(0)" ::: "memory");
            const unsigned og = xb_add(&bar[XB_TOP], 1u);
            const unsigned tg = og / nx;
            if (og + 1u == (tg + 1u) * nx) xb_add(&bar[XB_TOPGEN], 1u);
            else XB_SPIN(xb_ld(&bar[XB_TOPGEN]) == tg, bar);
            __builtin_amdgcn_fence(__ATOMIC_ACQUIRE, "agent");
            xb_add(&bar[XB_XGEN(b.x)], 1u);
            asm volatile("s_waitcnt vmcnt(0)" ::: "memory");
        } else {
            XB_SPIN(xb_ld(&bar[XB_XGEN(b.x)]) == gen, bar);
            __builtin_amdgcn_fence(__ATOMIC_ACQUIRE, "agent");
            asm volatile("s_waitcnt vmcnt(0)" ::: "memory");
        }
    }
    __syncthreads();
}


__global__ void __launch_bounds__(NTHR) k_mega(Params p) {
    extern __shared__ __attribute__((aligned(16))) unsigned char lds_raw[];
    LAS unsigned char* lds = (LAS unsigned char*)lds_raw;
    const int G = gridDim.x; const int bx = blockIdx.x;
    volatile LAS unsigned* misc = (volatile LAS unsigned*)(lds + MISC_OFF);
    if (threadIdx.x < 64) misc[threadIdx.x] = 0u;
    __syncthreads();
    const XcdBarrier xbar = xcd_barrier_post((unsigned*)(p.ws + WS_CTL + 65536), misc + 8);
    const int vcu = (G % 8 == 0) ? (bx % 8) * (G / 8) + bx / 8 : bx;
    bf16_t* win_t = (bf16_t*)(p.ws + WS_WIN); bf16_t* wout_t = (bf16_t*)(p.ws + WS_WOUT);
    bf16_t* xb = (bf16_t*)(p.ws + WS_XB); bf16_t* zb = (bf16_t*)(p.ws + WS_Z); bf16_t* mixb = (bf16_t*)(p.ws + WS_MIX);
    float* ssq = (float*)(p.ws + WS_SSQ);
    bf16_t* xn2b = (bf16_t*)(p.ws + WS_XB);
    float* h = p.out;

    constexpr int NWG1 = (T / 256) * (INW / 256);
    const int n_idle = (NWG1 % G) ? G - (NWG1 % G) : 0, idle_idx = bx - (NWG1 % G);
    const int e_split = (n_idle >= 96) ? 4 : NE;
    ph_prologue(p, lds, vcu, G, e_split);
    xcd_barrier(xbar);
    {
        pg8::DenseOrder So; So.init(xb, win_t, T, INW, D, G, bx);
        pg8::EpiZ E{zb, INW};
        pg8::gemm_phase(lds, D, So, E);
        if (e_split < NE && idle_idx >= 0) p1_tail_convert(p, lds, idle_idx, n_idle, e_split);
    }
    xcd_barrier(xbar);
    ph_mixers(p, zb, mixb, ssq, lds, (unsigned*)(p.ws + WS_CTL + 8192));
    xcd_barrier(xbar);
    {
        pg8::DenseOrder So; So.init(mixb, wout_t, T, D, D, G, bx);
        pg8::EpiH E{ssq, p.x, h, xn2b, TAB_OFF};
        pg8::gemm_phase(lds, D, So, E);
    }
    xcd_barrier(xbar);
    int* gcount = (int*)(p.ws + WS_CTL + 4096); int* tok_list = (int*)(p.ws + WS_LIST); float* w_list = (float*)(p.ws + WS_LIST + MiB);
    bf16_t* wgu_t = (bf16_t*)(p.ws + WS_WGU); bf16_t* wd_t = (bf16_t*)(p.ws + WS_WD); bf16_t* hid = (bf16_t*)(p.ws + WS_HID); bf16_t* y2 = (bf16_t*)(p.ws + WS_Z);
    float* r_list = (float*)(p.ws + WS_ROUTE);
    ph_router3(p, h, gcount, tok_list, w_list, r_list, lds);
    xcd_barrier(xbar);
    LAS int* meta = (LAS int*)(lds + META_OFF);
    if (threadIdx.x == 0) { int base = 0; for (int e = 0; e < NE; ++e) { const int cnt = gcount[e]; meta[e] = base; meta[32 + e] = cnt; base += (cnt + 255) >> 8; } meta[16] = base; }
    __syncthreads();
    const int ntiles = meta[16];
    {
        pg8::MoeOrder<0> So{xn2b, wgu_t, tok_list, meta, D, G, bx, ntiles};
        pg8::EpiHid E{hid, r_list, meta};
        pg8::gemm_phase(lds, D, So, E);
        { const int r5 = (ntiles * 4) % G; if (r5 == 0) p5a_tail_convert(p, lds, bx, G); else if (bx >= r5) p5a_tail_convert(p, lds, bx - r5, G - r5); }
    }
    xcd_barrier(xbar);
    {
        pg8::MoeOrder<1> So{hid, wd_t, tok_list, meta, DFF, G, bx, ntiles};
        pg8::EpiY E{y2, tok_list, w_list, meta};
        pg8::gemm_phase(lds, DFF, So, E);
    }
    xcd_barrier(xbar);
    ph_final(p, h, y2, p.out);
}

extern "C" void kernel_launch(void* const* d_in, const int* in_sizes, int n_in, void* d_out, int out_size, void* d_ws, size_t ws_size, hipStream_t stream) {
    static int grid_blocks = 0;
    if (!grid_blocks) {
        if (ws_size < WS_END) { fprintf(stderr, "kernel_launch: workspace too small (%zu < %zu)\n", ws_size, (size_t)WS_END); grid_blocks = -1; return; }
        int dev = 0, cus = 0, per_cu = 0;
        (void)hipGetDevice(&dev);
        (void)hipDeviceGetAttribute(&cus, hipDeviceAttributeMultiprocessorCount, dev);
        (void)hipFuncSetAttribute((const void*)k_mega, hipFuncAttributeMaxDynamicSharedMemorySize, LDS_BYTES);
        (void)hipOccupancyMaxActiveBlocksPerMultiprocessor(&per_cu, (const void*)k_mega, NTHR, LDS_BYTES);
        if (per_cu < 1) { fprintf(stderr, "kernel_launch: occupancy query says %d blocks per CU: not launching\n", per_cu); grid_blocks = -1; return; }
        grid_blocks = cus;
    }
    if (grid_blocks < 0) return;
    Params p{};
    const float** f = (const float**)&p;
    for (int i = 0; i < 23; ++i) f[i] = (const float*)d_in[i];
    p.out = (float*)d_out;
    p.ws = (unsigned char*)d_ws;
    (void)hipMemsetAsync((char*)d_ws + WS_CTL, 0, CTL_ZERO_BYTES, stream);
    hipLaunchKernelGGL(k_mega, dim3(grid_blocks), dim3(NTHR), LDS_BYTES, stream, p);
    hipError_t e = hipPeekAtLastError();
    if (e != hipSuccess) fprintf(stderr, "launch failed: %s (grid %d)\n", hipGetErrorString(e), grid_blocks);
}
```

```cpp
#include <hip/hip_runtime.h>
#include <cstdio>
#include <cstdint>

#define LAS __attribute__((address_space(3)))
typedef unsigned short bf16_t;
typedef short bf16x8 __attribute__((ext_vector_type(8)));
typedef float f32x4 __attribute__((ext_vector_type(4)));
typedef float f32x2 __attribute__((ext_vector_type(2)));
typedef unsigned u32x4 __attribute__((ext_vector_type(4)));
typedef unsigned u32x2 __attribute__((ext_vector_type(2)));

constexpr int D = 1024, NB = 8, S = 2048, T = NB * S;
constexpr int RW = 512, RHD = 64;
constexpr int CHUNK = 64, LEFT = 8, BAND = 576, MAXREL = 128;
constexpr int INW = 2560;
constexpr int NE = 16, DFF = 512;
constexpr float EPS = 1e-6f;
constexpr int NTHR = 512, NWAVES = 8;
constexpr int SSQW = 40;

constexpr size_t MiB = 1u << 20;
constexpr size_t WS_CTL = 0, CTL_BYTES = 2 * MiB, CTL_ZERO_BYTES = 128 * 1024 + 512 * 1024;
constexpr size_t WS_WIN = 2 * MiB;
constexpr size_t WS_WOUT = 7 * MiB;
constexpr size_t WS_WGU = 9 * MiB;
constexpr size_t WS_WD = 41 * MiB;
constexpr size_t WS_XB = 57 * MiB;
constexpr size_t WS_Z = 89 * MiB;
constexpr size_t WS_MIX = 169 * MiB;
constexpr size_t WS_HID = 201 * MiB;
constexpr size_t WS_SSQ = 237 * MiB;
constexpr size_t WS_LIST = 240 * MiB;
constexpr size_t WS_ROUTE = 242 * MiB;
constexpr size_t WS_RWT = 243 * MiB;
constexpr size_t WS_GWT = 244 * MiB;
constexpr size_t WS_END = 245 * MiB;

constexpr int RING_BYTES = 131072, TAB_OFF = RING_BYTES, META_OFF = RING_BYTES + 4096, MISC_OFF = RING_BYTES + 15360, LDS_BYTES = 147456;

struct Params {
    const float *x, *norm1_g, *w_in, *conv_w, *conv_b, *w_rg_a, *b_rg_a, *w_rg_x, *b_rg_x, *lru_lambda, *rel_bias,
        *g_rec_out, *g_att_out, *w_out, *norm2_g, *w_group, *b_group, *w_router, *b_router, *w_e_gate, *w_e_up, *w_e_down, *final_g;
    float* out;
    unsigned char* ws;
};

__device__ __forceinline__ float wave_sum(float v) {
#pragma unroll
    for (int o = 32; o > 0; o >>= 1) v += __shfl_xor(v, o);
    return v;
}
__device__ __forceinline__ float sigmoidf_(float x) { return 1.0f / (1.0f + expf(-x)); }
__device__ __forceinline__ float gelu_tanh(float x) { return 0.5f * x * (1.0f + tanhf(0.7978845608028654f * (x + 0.044715f * x * x * x))); }
__device__ __forceinline__ unsigned f2bf(float f) { unsigned u = __builtin_bit_cast(unsigned, f); return (u + 0x7fffu + ((u >> 16) & 1u)) >> 16; }
__device__ __forceinline__ unsigned pk2(float lo, float hi) { return f2bf(lo) | (f2bf(hi) << 16); }
__device__ __forceinline__ float bf2f(bf16_t b) { return __builtin_bit_cast(float, ((unsigned)b) << 16); }
__device__ __forceinline__ unsigned cvt_pk_bf16(float lo, float hi) { unsigned r; asm volatile("v_cvt_pk_bf16_f32 %0, %1, %2" : "=v"(r) : "v"(lo), "v"(hi)); return r; }
#define LDS_WAIT() asm volatile("s_waitcnt lgkmcnt(0)" ::: "memory")
__device__ __forceinline__ int opaque_tid() { int t = threadIdx.x; asm volatile("" : "+v"(t)); return t; }

namespace pg8 {
constexpr int BM = 256, BK = 64, HALF = 128, HTB = HALF * BK * 2, STAGE_BYTES = 8 * HTB, NXCD = 8, WGM = 8;
__device__ __forceinline__ int lds_byte(int r, int c) { const int st = (r >> 4) * 2 + (c >> 5), rr = r & 15, cc = c & 31, ob = rr * 64 + cc * 2; return st * 1024 + (ob ^ (((ob >> 9) & 1) << 5)); }
__device__ __forceinline__ void stage_rc(int b, int& R, int& C) { const int st = b / 1024, sb = b % 1024, swz = sb ^ (((sb >> 9) & 1) << 5); R = (st >> 1) * 16 + swz / 64; C = (st & 1) * 32 + (swz % 64) / 2; }
__device__ __forceinline__ int perm32(int rho) { const int n = rho >> 4, i = rho & 15; return 8 * (i >> 2) + 4 * n + (i & 3); }

struct Unit { int pm, pn, e, rows; };

struct DenseOrder {
    const bf16_t* A; const bf16_t* Bt; int K; int nM, nN, nwg, G, c;
    __device__ void init(const bf16_t* A_, const bf16_t* Bt_, int M, int N, int K_, int G_, int c_) { A = A_; Bt = Bt_; K = K_; nM = M / BM; nN = N / BM; nwg = nM * nN; G = G_; c = c_; }
    __device__ __forceinline__ bool next(int i, Unit& u) const {
        const long L = (long)i * G + c; if (L >= nwg) return false;
        int wgid = (int)L; { const int q = nwg / NXCD, r = nwg % NXCD, xcd = wgid % NXCD, off = wgid / NXCD; wgid = (xcd < r ? xcd * (q + 1) : r * (q + 1) + (xcd - r) * q) + off; }
        const int nig = WGM * nN, gid = wgid / nig, fm = gid * WGM, gsz = (nM - fm) < WGM ? (nM - fm) : WGM;
        u.pm = fm + ((wgid % nig) % gsz); u.pn = (wgid % nig) / gsz; u.e = 0; u.rows = BM; return true;
    }
    __device__ __forceinline__ void addr(const Unit& u, const int (&RA)[2], const int (&CA)[2], const char*& aBase, const char*& bBase, unsigned (&va)[2][2]) const {
        aBase = (const char*)A; bBase = (const char*)Bt + (size_t)u.pn * BM * K * 2;
#pragma unroll
        for (int h = 0; h < 2; ++h)
#pragma unroll
            for (int i = 0; i < 2; ++i) va[h][i] = (unsigned)(((size_t)(u.pm * BM + h * HALF + RA[i]) * K + CA[i]) * 2);
    }
};

template <class Epi, class Sched>
__device__ __forceinline__ void gemm_phase(LAS unsigned char* lds, const int K, const Sched& S, const Epi& E) {
    int tid_ = threadIdx.x; asm volatile("" : "+v"(tid_));
    const int tid = tid_, wid = __builtin_amdgcn_readfirstlane(tid >> 6), lane = tid & 63, wr = wid >> 2, wc = wid & 3, fr = lane & 15, fq = lane >> 4;
    const int nt = K / BK;
    int RA[2], CA[2]; unsigned voffB[2];
#pragma unroll
    for (int i = 0; i < 2; ++i) { int R, C; stage_rc(tid * 16 + i * 8192, R, C); RA[i] = R; CA[i] = C; const int Rb = Epi::PERM ? ((R & ~31) + perm32(R & 31)) : R; voffB[i] = (unsigned)(Rb * K + C) * 2u; }
    const size_t kstep = (size_t)(BK * 2);
    const size_t hstepB = (size_t)HALF * K * 2;
    const unsigned ldsw = (unsigned)wid * 1024u;
    const int aoff = lds_byte(wr * 64 + fr, fq * 8), boff = lds_byte(wc * 32 + fr, fq * 8);
#define PG8_SA(b, h) (((b) * 2 + (h)) * HTB)
#define PG8_SB(b, h) ((4 + (b) * 2 + (h)) * HTB)
#define PG8_STAGE_B(bufoff, gbase) do { _Pragma("unroll") for (int _i = 0; _i < 2; ++_i) \
        __builtin_amdgcn_global_load_lds((const unsigned*)((const char*)(gbase) + voffB[_i]), (LAS unsigned*)(lds + (bufoff) + ldsw + _i * 8192), 16, 0, 0); } while (0)
#define PG8_STAGE_A(bufoff, gbase, v0, v1) do { \
        __builtin_amdgcn_global_load_lds((const unsigned*)((const char*)(gbase) + (v0)), (LAS unsigned*)(lds + (bufoff) + ldsw), 16, 0, 0); \
        __builtin_amdgcn_global_load_lds((const unsigned*)((const char*)(gbase) + (v1)), (LAS unsigned*)(lds + (bufoff) + ldsw + 8192), 16, 0, 0); } while (0)
#define PG8_LDA(dst, b, h) do { _Pragma("unroll") for (int m = 0; m < 4; ++m) _Pragma("unroll") for (int k = 0; k < 2; ++k) dst[m][k] = *(const LAS bf16x8*)(lds + PG8_SA(b, h) + aoff + m * 2048 + k * 1024); } while (0)
#define PG8_LDB(dst, b, h) do { _Pragma("unroll") for (int n = 0; n < 2; ++n) _Pragma("unroll") for (int k = 0; k < 2; ++k) dst[n][k] = *(const LAS bf16x8*)(lds + PG8_SB(b, h) + boff + n * 2048 + k * 1024); } while (0)
#define PG8_MMA(ai, bj, At, Bt) do { __builtin_amdgcn_s_setprio(1); _Pragma("unroll") for (int m = 0; m < 4; ++m) _Pragma("unroll") for (int n = 0; n < 2; ++n) _Pragma("unroll") for (int k = 0; k < 2; ++k) \
        acc[ai][bj][m][n] = __builtin_amdgcn_mfma_f32_16x16x32_bf16(Bt[n][k], At[m][k], acc[ai][bj][m][n], 0, 0, 0); __builtin_amdgcn_s_setprio(0); } while (0)
#define PG8_WAIT_V(n) asm volatile("s_waitcnt vmcnt(" #n ")" ::: "memory")
#define PG8_WAIT_L(n) asm volatile("s_waitcnt lgkmcnt(" #n ")" ::: "memory")
#define PG8_BAR __builtin_amdgcn_s_barrier()
#define PG8_SCHED __builtin_amdgcn_sched_barrier(0)
    Unit cur, nxt; int ui = 0;
    if (!S.next(0, cur)) return;
    f32x4 acc[2][2][4][2];
#pragma unroll
    for (int a = 0; a < 2; ++a)
#pragma unroll
        for (int b = 0; b < 2; ++b)
#pragma unroll
            for (int m = 0; m < 4; ++m)
#pragma unroll
                for (int n = 0; n < 2; ++n) acc[a][b][m][n] = (f32x4){0.f, 0.f, 0.f, 0.f};
    bf16x8 At[4][2], B0[2][2], B1[2][2];
    const char *cA, *cB, *nA, *nB; unsigned cva[2][2], nva[2][2];
    S.addr(cur, RA, CA, cA, cB, cva);
    E.prepare(cur, ui, lds);
    PG8_STAGE_B(PG8_SB(0, 0), cB); PG8_STAGE_A(PG8_SA(0, 0), cA, cva[0][0], cva[0][1]); PG8_STAGE_B(PG8_SB(0, 1), cB + hstepB); PG8_STAGE_A(PG8_SA(0, 1), cA, cva[1][0], cva[1][1]);
    if (wr == 1) PG8_BAR;
    PG8_WAIT_V(4); PG8_BAR;
    PG8_STAGE_B(PG8_SB(1, 0), cB + kstep); PG8_STAGE_A(PG8_SA(1, 0), cA + kstep, cva[0][0], cva[0][1]); PG8_STAGE_B(PG8_SB(1, 1), cB + hstepB + kstep);
    PG8_WAIT_V(6); PG8_BAR;
    for (;;) {
        const bool has_next = S.next(ui + 1, nxt);
        if (has_next) { S.addr(nxt, RA, CA, nA, nB, nva); }
        else { nA = cA; nB = cB;
#pragma unroll
            for (int h = 0; h < 2; ++h)
#pragma unroll
                for (int i = 0; i < 2; ++i) nva[h][i] = cva[h][i]; }
        for (int t = 0; t < nt; t += 2) {
            const bool last = (t == nt - 2);
            if (Epi::MIDSCALE && t == nt / 2) E.midscale(acc, wr, fr, ui, lds);
            const char* a1 = cA + (size_t)(t + 1) * kstep;
            const char* a2 = last ? nA : cA + (size_t)(t + 2) * kstep; const char* b2 = last ? nB : cB + (size_t)(t + 2) * kstep;
            const char* a3 = a2 + kstep; const char* b3 = b2 + kstep;
            const unsigned x00 = last ? nva[0][0] : cva[0][0], x01 = last ? nva[0][1] : cva[0][1], x10 = last ? nva[1][0] : cva[1][0], x11 = last ? nva[1][1] : cva[1][1];
            if (last && has_next) E.prepare(nxt, ui + 1, lds);
            PG8_LDB(B0, 0, 0); PG8_SCHED; PG8_LDA(At, 0, 0); PG8_STAGE_A(PG8_SA(1, 1), a1, cva[1][0], cva[1][1]);
            PG8_WAIT_L(8); PG8_BAR; PG8_WAIT_L(0); PG8_MMA(0, 0, At, B0); PG8_BAR; PG8_SCHED;
            PG8_LDB(B1, 0, 1); PG8_STAGE_B(PG8_SB(0, 0), b2);
            PG8_BAR; PG8_WAIT_L(0); PG8_MMA(0, 1, At, B1); PG8_BAR;
            PG8_LDA(At, 0, 1); PG8_STAGE_A(PG8_SA(0, 0), a2, x00, x01);
            PG8_BAR; PG8_WAIT_L(0); PG8_MMA(1, 0, At, B0); PG8_BAR; PG8_SCHED;
            PG8_STAGE_B(PG8_SB(0, 1), b2 + hstepB);
            PG8_WAIT_V(6); PG8_BAR; PG8_MMA(1, 1, At, B1); PG8_BAR;
            PG8_LDB(B0, 1, 0); PG8_SCHED; PG8_LDA(At, 1, 0); PG8_STAGE_A(PG8_SA(0, 1), a2, x10, x11);
            PG8_WAIT_L(8); PG8_BAR; PG8_WAIT_L(0); PG8_MMA(0, 0, At, B0); PG8_BAR; PG8_SCHED;
            PG8_LDB(B1, 1, 1); PG8_STAGE_B(PG8_SB(1, 0), b3);
            PG8_BAR; PG8_WAIT_L(0); PG8_MMA(0, 1, At, B1); PG8_BAR;
            PG8_LDA(At, 1, 1); PG8_STAGE_A(PG8_SA(1, 0), a3, x00, x01);
            PG8_BAR; PG8_WAIT_L(0); PG8_MMA(1, 0, At, B0); PG8_BAR; PG8_SCHED;
            PG8_STAGE_B(PG8_SB(1, 1), b3 + hstepB);
            PG8_WAIT_V(6); PG8_BAR; PG8_MMA(1, 1, At, B1); PG8_BAR;
        }
        E(acc, cur, wr, wc, fr, fq, ui, lds);
        if (!has_next) break;
#pragma unroll
        for (int a = 0; a < 2; ++a)
#pragma unroll
            for (int b = 0; b < 2; ++b)
#pragma unroll
                for (int m = 0; m < 4; ++m)
#pragma unroll
                    for (int n = 0; n < 2; ++n) acc[a][b][m][n] = (f32x4){0.f, 0.f, 0.f, 0.f};
        cur = nxt; cA = nA; cB = nB; ++ui;
#pragma unroll
        for (int h = 0; h < 2; ++h)
#pragma unroll
            for (int i = 0; i < 2; ++i) cva[h][i] = nva[h][i];
    }
    PG8_WAIT_V(0);
    if (wr == 0) PG8_BAR;
    PG8_BAR;
#undef PG8_SA
#undef PG8_SB
#undef PG8_STAGE_A
#undef PG8_STAGE_B
#undef PG8_LDA
#undef PG8_LDB
#undef PG8_MMA
#undef PG8_WAIT_V
#undef PG8_WAIT_L
#undef PG8_BAR
#undef PG8_SCHED
}

struct EpiZ {
    static constexpr bool PERM = true, MIDSCALE = false;
    bf16_t* O; int ldc;
    __device__ __forceinline__ void prepare(const Unit&, int, LAS unsigned char*) const {}
    __device__ __forceinline__ void midscale(f32x4 (&)[2][2][4][2], int, int, int, LAS unsigned char*) const {}
    __device__ __forceinline__ void operator()(const f32x4 (&acc)[2][2][4][2], const Unit& u, int wr, int wc, int fr, int fq, int, LAS unsigned char*) const {
        const int row0 = u.pm * BM + wr * 64 + fr, col0 = u.pn * BM + wc * 32 + 8 * fq;
#pragma unroll
        for (int ai = 0; ai < 2; ++ai)
#pragma unroll
            for (int m = 0; m < 4; ++m) { bf16_t* rowp = O + (size_t)(row0 + ai * HALF + m * 16) * ldc + col0;
#pragma unroll
                for (int bj = 0; bj < 2; ++bj) { const f32x4 v0 = acc[ai][bj][m][0], v1 = acc[ai][bj][m][1];
                    u32x4 w; w.x = cvt_pk_bf16(v0[0], v0[1]); w.y = cvt_pk_bf16(v0[2], v0[3]); w.z = cvt_pk_bf16(v1[0], v1[1]); w.w = cvt_pk_bf16(v1[2], v1[3]);
                    *(u32x4*)(rowp + bj * HALF) = w; } }
    }
};
struct EpiH {
    static constexpr bool PERM = false, MIDSCALE = true;
    const float* ssq; const float* x; float* h; bf16_t* hb; int tab_off;
    __device__ __forceinline__ void prepare(const Unit& u, int ui, LAS unsigned char* lds) const {
        LAS f32x2* tab = (LAS f32x2*)(lds + tab_off) + (ui & 1) * 256;
        if (threadIdx.x < 256) {
            const float* sp = ssq + (size_t)(u.pm * BM + threadIdx.x) * SSQW; float sa = 0.f, sb = 0.f;
#pragma unroll
            for (int i = 0; i < 8; ++i) { const f32x4 v = *(const f32x4*)(sp + 4 * i); sa += (v[0] + v[1]) + (v[2] + v[3]); }
#pragma unroll
            for (int i = 8; i < 10; ++i) { const f32x4 v = *(const f32x4*)(sp + 4 * i); sb += (v[0] + v[1]) + (v[2] + v[3]); }
            const float ra = rsqrtf(sa * (1.0f / 512.0f) + EPS), rb = rsqrtf(sb * (1.0f / 512.0f) + EPS);
            tab[threadIdx.x] = (f32x2){ra / rb, rb};
        }
    }
    __device__ __forceinline__ void midscale(f32x4 (&acc)[2][2][4][2], int wr, int fr, int ui, LAS unsigned char* lds) const {
        const LAS f32x2* tab = (const LAS f32x2*)(lds + tab_off) + (ui & 1) * 256;
#pragma unroll
        for (int ai = 0; ai < 2; ++ai)
#pragma unroll
            for (int m = 0; m < 4; ++m) { const float s = tab[ai * HALF + wr * 64 + m * 16 + fr].x;
#pragma unroll
                for (int bj = 0; bj < 2; ++bj)
#pragma unroll
                    for (int n = 0; n < 2; ++n) acc[ai][bj][m][n] = acc[ai][bj][m][n] * s; }
    }
    __device__ __forceinline__ void operator()(const f32x4 (&acc)[2][2][4][2], const Unit& u, int wr, int wc, int fr, int fq, int ui, LAS unsigned char* lds) const {
        const LAS f32x2* tab = (const LAS f32x2*)(lds + tab_off) + (ui & 1) * 256;
        const int row0 = u.pm * BM + wr * 64 + fr, col0 = u.pn * BM + wc * 32 + 4 * fq;
#pragma unroll
        for (int ai = 0; ai < 2; ++ai) {
            f32x4 xv[4][2][2];
#pragma unroll
            for (int m = 0; m < 4; ++m)
#pragma unroll
                for (int bj = 0; bj < 2; ++bj)
#pragma unroll
                    for (int n = 0; n < 2; ++n) xv[m][bj][n] = *(const f32x4*)(x + (size_t)(row0 + ai * HALF + m * 16) * D + col0 + bj * HALF + n * 16);
#pragma unroll
            for (int m = 0; m < 4; ++m) { const float s = tab[ai * HALF + wr * 64 + m * 16 + fr].y; const size_t ro = (size_t)(row0 + ai * HALF + m * 16) * D + col0;
#pragma unroll
                for (int bj = 0; bj < 2; ++bj)
#pragma unroll
                    for (int n = 0; n < 2; ++n) { const f32x4 hv = xv[m][bj][n] + acc[ai][bj][m][n] * s;
                        *(f32x4*)(h + ro + bj * HALF + n * 16) = hv; *(u32x2*)(hb + ro + bj * HALF + n * 16) = (u32x2){cvt_pk_bf16(hv[0], hv[1]), cvt_pk_bf16(hv[2], hv[3])}; } }
        }
    }
};

template <int MODE>
struct MoeOrder {
    const bf16_t* A; const bf16_t* Bt; const int* tok_list; const LAS int* meta; int K, G, c, ntiles;
    __device__ __forceinline__ bool next(int i, Unit& u) const {
        const int L = i * G + c; if (L >= ntiles * 4) return false;
        const int mt = L >> 2; int e = 0;
#pragma unroll
        for (int j = 1; j < NE; ++j) e += (mt >= meta[j]) ? 1 : 0;
        u.pm = mt; u.pn = L & 3; u.e = e; u.rows = meta[32 + e] - (mt - meta[e]) * BM; return true;
    }
    __device__ __forceinline__ void addr(const Unit& u, const int (&RA)[2], const int (&CA)[2], const char*& aBase, const char*& bBase, unsigned (&va)[2][2]) const {
        aBase = (const char*)A; bBase = (const char*)Bt + ((size_t)u.e * D + (size_t)u.pn * BM) * K * 2;
        const int slot0 = (u.pm - meta[u.e]) * BM;
#pragma unroll
        for (int h = 0; h < 2; ++h)
#pragma unroll
            for (int i = 0; i < 2; ++i) {
                const int r = h * HALF + RA[i];
                if (MODE == 0) { const int tl = tok_list[u.e * T + slot0 + r] >> 1; const int tok = (r < u.rows) ? tl : 0; va[h][i] = (unsigned)(((size_t)tok * K + CA[i]) * 2); }
                else va[h][i] = (unsigned)(((size_t)(u.pm * BM + r) * K + CA[i]) * 2);
            }
    }
};
struct EpiHid {
    static constexpr bool PERM = true, MIDSCALE = false;
    bf16_t* hid; const float* r_list; const LAS int* meta;
    __device__ __forceinline__ void prepare(const Unit&, int, LAS unsigned char*) const {}
    __device__ __forceinline__ void midscale(f32x4 (&)[2][2][4][2], int, int, int, LAS unsigned char*) const {}
    __device__ __forceinline__ void operator()(const f32x4 (&acc)[2][2][4][2], const Unit& u, int wr, int wc, int fr, int fq, int, LAS unsigned char*) const {
        const int row0 = u.pm * BM + wr * 64 + fr, j0 = u.pn * 128 + wc * 16 + 4 * fq, slot0 = (u.pm - meta[u.e]) * BM;
        float rsv[2][4];
#pragma unroll
        for (int ai = 0; ai < 2; ++ai)
#pragma unroll
            for (int m = 0; m < 4; ++m) rsv[ai][m] = r_list[u.e * T + slot0 + ai * HALF + wr * 64 + m * 16 + fr];
#pragma unroll
        for (int ai = 0; ai < 2; ++ai)
#pragma unroll
            for (int m = 0; m < 4; ++m) { bf16_t* rowp = hid + (size_t)(row0 + ai * HALF + m * 16) * DFF + j0;
                const int r = ai * HALF + wr * 64 + m * 16 + fr; const float rs = (r < u.rows) ? rsv[ai][m] : 0.f;
#pragma unroll
                for (int bj = 0; bj < 2; ++bj) { const f32x4 g = acc[ai][bj][m][0] * rs, up = acc[ai][bj][m][1] * rs; float hv[4];
#pragma unroll
                    for (int q = 0; q < 4; ++q) hv[q] = g[q] * up[q] * __builtin_amdgcn_rcpf(1.0f + __expf(-g[q]));
                    *(u32x2*)(rowp + bj * 64) = (u32x2){cvt_pk_bf16(hv[0], hv[1]), cvt_pk_bf16(hv[2], hv[3])}; } }
    }
};
struct EpiY {
    static constexpr bool PERM = true, MIDSCALE = false;
    bf16_t* y2; const int* tok_list; const float* w_list; const LAS int* meta;
    __device__ __forceinline__ void prepare(const Unit&, int, LAS unsigned char*) const {}
    __device__ __forceinline__ void midscale(f32x4 (&)[2][2][4][2], int, int, int, LAS unsigned char*) const {}
    __device__ __forceinline__ void operator()(const f32x4 (&acc)[2][2][4][2], const Unit& u, int wr, int wc, int fr, int fq, int, LAS unsigned char*) const {
        const int slot0 = (u.pm - meta[u.e]) * BM, col0 = u.pn * BM + wc * 32 + 8 * fq;
        int dstv[2][4]; float wv[2][4];
#pragma unroll
        for (int ai = 0; ai < 2; ++ai)
#pragma unroll
            for (int m = 0; m < 4; ++m) { const int li = u.e * T + slot0 + ai * HALF + wr * 64 + m * 16 + fr; dstv[ai][m] = tok_list[li]; wv[ai][m] = w_list[li]; }
#pragma unroll
        for (int ai = 0; ai < 2; ++ai)
#pragma unroll
            for (int m = 0; m < 4; ++m) { const int r = ai * HALF + wr * 64 + m * 16 + fr;
                if (r < u.rows) { const int dst = dstv[ai][m]; const float w = wv[ai][m]; bf16_t* rowp = y2 + (size_t)dst * D + col0;
#pragma unroll
                    for (int bj = 0; bj < 2; ++bj) { const f32x4 v0 = acc[ai][bj][m][0] * w, v1 = acc[ai][bj][m][1] * w;
                        u32x4 o; o.x = cvt_pk_bf16(v0[0], v0[1]); o.y = cvt_pk_bf16(v0[2], v0[3]); o.z = cvt_pk_bf16(v1[0], v1[1]); o.w = cvt_pk_bf16(v1[2], v1[3]);
                        *(u32x4*)(rowp + bj * HALF) = o; } } }
    }
};
}

struct RowId { int off; __device__ __forceinline__ int operator()(int n) const { return off + n; } };
struct RowGU { int up; __device__ __forceinline__ int operator()(int j) const { return (j >> 2) * 8 + (j & 3) + 4 * up; } };

struct TItem { const float* src; const float* gp; bf16_t* dst; int N, K, rmk; };
__device__ __forceinline__ TItem p0_decode(const Params& p, int it) {
    constexpr int I_IN = (D / 64) * (INW / 32), I_OUT = (D / 64) * (D / 32), I_G = (D / 64) * (DFF / 32), I_D = (DFF / 64) * (D / 32), I_E = 2 * I_G + I_D;
    const float* W; const float* g; bf16_t* WT; int K, N, rmk, idx;
    if (it < I_IN) { W = p.w_in; g = p.norm1_g; WT = (bf16_t*)(p.ws + WS_WIN); K = D; N = INW; rmk = 0; idx = it; }
    else if (it < I_IN + I_OUT) { W = p.w_out; g = nullptr; WT = (bf16_t*)(p.ws + WS_WOUT); K = D; N = D; rmk = 0; idx = it - I_IN; }
    else if (it < I_IN + I_OUT + NE * 2 * I_G) { const int r = it - I_IN - I_OUT, e = r / (2 * I_G), q = r % (2 * I_G);
        if (q < I_G) { W = p.w_e_gate + (size_t)e * D * DFF; g = p.norm2_g; WT = (bf16_t*)(p.ws + WS_WGU) + (size_t)e * D * D; K = D; N = DFF; rmk = 1; idx = q; }
        else { W = p.w_e_up + (size_t)e * D * DFF; g = p.norm2_g; WT = (bf16_t*)(p.ws + WS_WGU) + (size_t)e * D * D; K = D; N = DFF; rmk = 2; idx = q - I_G; } }
    else { const int r = it - I_IN - I_OUT - NE * 2 * I_G, e = r / I_D; idx = r % I_D;
        W = p.w_e_down + (size_t)e * DFF * D; g = nullptr; WT = (bf16_t*)(p.ws + WS_WD) + (size_t)e * D * DFF; K = DFF; N = D; rmk = 0; }
    const int nblk = N / 32, kb = idx / nblk, nb = idx % nblk, k0 = 64 * kb, n0 = 32 * nb;
    TItem t; t.src = W + (size_t)k0 * N + n0; t.dst = WT + k0; t.N = N; t.K = K; t.rmk = rmk;
    t.gp = g ? g + k0 : nullptr;
    if (it >= I_IN && it < I_IN + I_OUT) t.gp = (k0 < 512) ? p.g_rec_out + k0 : p.g_att_out + (k0 - 512);
    t.rmk = rmk | (n0 << 4);
    return t;
}
__device__ __forceinline__ void p0_load(const TItem& t, f32x4 (&ld)[8], float (&gv)[8], int lane) {
#pragma unroll
    for (int i = 0; i < 8; ++i) ld[i] = *(const f32x4*)(t.src + (size_t)(8 * i + (lane >> 3)) * t.N + 4 * (lane & 7));
    if (t.gp) {
#pragma unroll
        for (int i = 0; i < 8; ++i) gv[i] = t.gp[8 * i + (lane >> 3)];
    } else {
#pragma unroll
        for (int i = 0; i < 8; ++i) gv[i] = 1.0f;
    }
}
__device__ __forceinline__ void p0_process(const TItem& t, const f32x4 (&ld)[8], const float (&gv)[8], LAS float* scr, int lane) {
#pragma unroll
    for (int i = 0; i < 8; ++i) { const int kk = 8 * i + (lane >> 3); const f32x4 v = ld[i] * gv[i];
        LAS float* d = scr + kk * 33 + 4 * (lane & 7); d[0] = v[0]; d[1] = v[1]; d[2] = v[2]; d[3] = v[3]; }
    LDS_WAIT(); asm volatile("" ::: "memory");
    const int c = lane & 7, n0 = t.rmk >> 4, rmk = t.rmk & 15;
#pragma unroll
    for (int j = 0; j < 4; ++j) { const int n = (lane >> 3) + 8 * j; const LAS float* s = scr + (8 * c) * 33 + n;
        u32x4 o; o.x = pk2(s[0 * 33], s[1 * 33]); o.y = pk2(s[2 * 33], s[3 * 33]); o.z = pk2(s[4 * 33], s[5 * 33]); o.w = pk2(s[6 * 33], s[7 * 33]);
        const int nn = n0 + n, row = (rmk == 0) ? nn : ((nn >> 2) * 8 + (nn & 3) + 4 * (rmk - 1));
        *(u32x4*)(t.dst + (size_t)row * t.K + 8 * c) = o; }
    LDS_WAIT(); asm volatile("" ::: "memory");
}

__device__ __forceinline__ void p0_convert_range(const Params& p, LAS float* scr, int it0, int it1, int gw, int ngw, int lane) {
    int it = it0 + gw; TItem cur; f32x4 la[8]; float ga[8];
    if (it < it1) { cur = p0_decode(p, it); p0_load(cur, la, ga, lane); }
    while (it < it1) {
        const int nit = it + ngw; TItem nxt = cur; f32x4 lb[8]; float gb[8];
        const bool has = nit < it1;
        if (has) { nxt = p0_decode(p, nit); p0_load(nxt, lb, gb, lane); }
        p0_process(cur, la, ga, scr, lane);
        if (has) { cur = nxt;
#pragma unroll
            for (int i = 0; i < 8; ++i) { la[i] = lb[i]; ga[i] = gb[i]; } }
        it = nit;
    }
}

__device__ __forceinline__ void ph_prologue(const Params& p, LAS unsigned char* lds, int vcu, int G, int e_split) {
    const int tid = opaque_tid(), lane = tid & 63, wave = tid >> 6;
    LAS float* scr = (LAS float*)(lds + wave * 16384);
    const int gw = vcu * NWAVES + wave, NGW = G * NWAVES;
    bf16_t* xb = (bf16_t*)(p.ws + WS_XB);
    constexpr int I_IN = (D / 64) * (INW / 32), I_OUT = (D / 64) * (D / 32), I_G = (D / 64) * (DFF / 32), I_D = (DFF / 64) * (D / 32), I_E = 2 * I_G + I_D, I_ALL = I_IN + I_OUT + NE * I_E;
    p0_convert_range(p, scr, 0, I_IN + I_OUT + e_split * 2 * I_G, gw, NGW, lane);
    {
        bf16_t* gwt = (bf16_t*)(p.ws + WS_GWT); float* sp8 = (float*)(p.ws + WS_GWT + 8 * 128 * 144);
        for (int idx = gw * 64 + lane; idx < 8 * 64 * 128; idx += NGW * 64) { const int hb = idx >> 13, k = (idx >> 7) & 63, n = idx & 127;
            const float v = (n < 64) ? p.w_rg_a[(hb * 64 + k) * 64 + n] : p.w_rg_x[(hb * 64 + k) * 64 + n - 64];
            gwt[(hb * 128 + n) * 72 + k] = (bf16_t)f2bf(v); }
        for (int idx = gw * 64 + lane; idx < RW; idx += NGW * 64) sp8[idx] = -8.0f * log1pf(expf(-p.lru_lambda[idx]));
    }
    {
        float* rwt = (float*)(p.ws + WS_RWT);
        for (int idx = gw * 64 + lane; idx < D * 20; idx += NGW * 64) { const int k = idx / 20, n = idx % 20;
            rwt[n * 1028 + k] = (n < 16 ? p.w_router[k * 16 + n] : p.w_group[k * 4 + n - 16]) * p.norm2_g[k]; }
    }
    for (int t0 = gw; t0 < T; t0 += 4 * NGW) {
        f32x4 v[4][4];
#pragma unroll
        for (int q = 0; q < 4; ++q) { const int t = t0 + q * NGW; const f32x4* xr = (const f32x4*)(p.x + (size_t)(t < T ? t : t0) * D) + lane;
#pragma unroll
            for (int j = 0; j < 4; ++j) v[q][j] = xr[64 * j]; }
#pragma unroll
        for (int q = 0; q < 4; ++q) { const int t = t0 + q * NGW; float ss = 0.f;
#pragma unroll
            for (int j = 0; j < 4; ++j) ss += (v[q][j][0] * v[q][j][0] + v[q][j][1] * v[q][j][1]) + (v[q][j][2] * v[q][j][2] + v[q][j][3] * v[q][j][3]);
            const float r = rsqrtf(wave_sum(ss) * (1.0f / D) + EPS);
            if (t < T) { u32x2* o8 = (u32x2*)(xb + (size_t)t * D) + lane;
#pragma unroll
                for (int j = 0; j < 4; ++j) o8[64 * j] = (u32x2){pk2(v[q][j][0] * r, v[q][j][1] * r), pk2(v[q][j][2] * r, v[q][j][3] * r)}; }
        }
    }
}

__device__ __forceinline__ void p1_tail_convert(const Params& p, LAS unsigned char* lds, int idle_idx, int n_idle, int e_split) {
    const int tid = opaque_tid(), lane = tid & 63, wave = tid >> 6;
    constexpr int I_IN = (D / 64) * (INW / 32), I_OUT = (D / 64) * (D / 32), I_G = (D / 64) * (DFF / 32), I_D = (DFF / 64) * (D / 32), I_E = 2 * I_G + I_D, I_ALL = I_IN + I_OUT + NE * I_E;
    p0_convert_range(p, (LAS float*)(lds + wave * 16384), I_IN + I_OUT + e_split * 2 * I_G, I_IN + I_OUT + NE * 2 * I_G, idle_idx * NWAVES + wave, n_idle * NWAVES, lane);
}

__device__ __forceinline__ void p5a_tail_convert(const Params& p, LAS unsigned char* lds, int widx, int n_workers) {
    const int tid = opaque_tid(), lane = tid & 63, wave = tid >> 6;
    constexpr int I_IN = (D / 64) * (INW / 32), I_OUT = (D / 64) * (D / 32), I_G = (D / 64) * (DFF / 32), I_D = (DFF / 64) * (D / 32);
    p0_convert_range(p, (LAS float*)(lds + wave * 16384), I_IN + I_OUT + NE * 2 * I_G, I_IN + I_OUT + NE * 2 * I_G + NE * I_D, widx * NWAVES + wave, n_workers * NWAVES, lane);
}

typedef float f32x16 __attribute__((ext_vector_type(16)));
typedef short v4i16_t __attribute__((ext_vector_type(4)));
typedef __bf16 bf16x2_t __attribute__((ext_vector_type(2)));
#define MFMA32(a, b, c) __builtin_amdgcn_mfma_f32_32x32x16_bf16((a), (b), (c), 0, 0, 0)
__device__ __forceinline__ unsigned cvtpk_s(float lo, float hi) { f32x2 v = {lo, hi}; bf16x2_t b = __builtin_convertvector(v, bf16x2_t); return __builtin_bit_cast(unsigned, b); }
__device__ __forceinline__ int crow(int r, int hh) { return (r & 3) + 8 * (r >> 2) + 4 * hh; }
__device__ __forceinline__ bf16x8 pack8(const f32x16& x, int s) {
    u32x4 w; w.x = cvtpk_s(x[8 * s + 0], x[8 * s + 1]); w.y = cvtpk_s(x[8 * s + 2], x[8 * s + 3]); w.z = cvtpk_s(x[8 * s + 4], x[8 * s + 5]); w.w = cvtpk_s(x[8 * s + 6], x[8 * s + 7]);
    return __builtin_bit_cast(bf16x8, w);
}
__device__ __forceinline__ v4i16_t vtr(LAS const unsigned char* p) { return __builtin_amdgcn_ds_read_tr16_b64_v4i16((LAS v4i16_t*)p); }
constexpr float LOG2E = 1.4426950408889634f;

struct AttnCtx { LAS float* btab; LAS unsigned char* vbase; int lane, h, q32, hh, vb, vw; float bconst; unsigned kl, vl; };
__device__ __forceinline__ AttnCtx attn_setup(const Params& p, LAS unsigned char* lds, int tab_off) {
    int tid_ = threadIdx.x; asm volatile("" : "+v"(tid_));
    AttnCtx A; const int tid = tid_; A.lane = tid & 63; A.h = __builtin_amdgcn_readfirstlane(tid >> 6); A.q32 = A.lane & 31; A.hh = A.lane >> 5;
    A.btab = (LAS float*)(lds + tab_off) + A.h * 328;
    for (int i = A.lane; i < 2 * MAXREL + 1 + 64; i += 64) A.btab[i] = p.rel_bias[A.h * (2 * MAXREL + 1) + (i > 2 * MAXREL ? 2 * MAXREL : i)] * LOG2E;
    LDS_WAIT(); asm volatile("" ::: "memory");
    A.vbase = lds + A.h * 16384;
    A.vb = ((A.lane >> 4) & 1) * 32 + (A.lane & 3) * 8 + (4 * A.hh + ((A.lane & 15) >> 2)) * 128;
    A.vw = (A.lane >> 3) * 128 + (A.lane & 7) * 16;
    A.bconst = A.btab[2 * MAXREL];
    A.kl = (unsigned)((A.q32 * INW + 8 * A.hh) * 2);
    A.vl = (unsigned)(((A.lane >> 3) * INW + (A.lane & 7) * 8) * 2) + 1024u;
    return A;
}
__device__ __forceinline__ void attn_item(const AttnCtx& A, const bf16_t* z, bf16_t* mixb, float* ssq, int b, int c, int qh) {
    const int lane = A.lane, h = A.h, q32 = A.q32, hh = A.hh, vb = A.vb, vw = A.vw; LAS float* btab = A.btab; LAS unsigned char* vbase = A.vbase;
    const float bconst = A.bconst, QS = 0.125f * LOG2E; const unsigned kl = A.kl, vl = A.vl;
    {
        const int j0 = (c >= LEFT) ? 0 : LEFT - c;
        const char* kband = (const char*)z + (((long)b * S + (long)(c - LEFT) * CHUNK) * INW + 1536 + h * 64) * 2;
        {
            const int qi = qh * 32 + q32;
            const size_t tq = (size_t)b * S + c * CHUNK + qi;
            bf16x8 qf[4];
#pragma unroll
            for (int s = 0; s < 4; ++s) { const u32x4 raw = *(const u32x4*)(z + tq * INW + 1024 + h * 64 + 16 * s + 8 * hh); u32x4 w;
#pragma unroll
                for (int e = 0; e < 4; ++e) w[e] = cvtpk_s(__builtin_bit_cast(float, raw[e] << 16) * QS, __builtin_bit_cast(float, raw[e] & 0xffff0000u) * QS);
                qf[s] = __builtin_bit_cast(bf16x8, w); }
            f32x16 o0, o1;
#pragma unroll
            for (int r = 0; r < 16; ++r) { o0[r] = 0.f; o1[r] = 0.f; }
            float m_ref = 0.f, l_run = 0.f;
            constexpr float THR = 6.0f;
            u32x4 kr[8], vr[8];
            const int kw = (lane >> 3) * 128 + (((lane & 7) ^ (lane >> 3)) << 4);
            const int kfo = q32 * 128;
            {
                const char* tb = kband + (long)(64 * j0) * INW * 2;
#pragma unroll
                for (int i = 0; i < 8; ++i) { kr[i] = *(const u32x4*)(tb + ((vl - 1024u) + (unsigned)(i * 8 * INW * 2))); vr[i] = *(const u32x4*)(tb + (vl + (unsigned)(i * 8 * INW * 2))); }
#pragma unroll
                for (int i = 0; i < 8; ++i) { *(LAS u32x4*)(vbase + i * 1024 + kw) = kr[i]; *(LAS u32x4*)(vbase + 8192 + i * 1024 + vw) = vr[i]; }
            }
#pragma unroll 1
            for (int j = j0; j <= LEFT; ++j) {
                if (j < LEFT) {
                    const char* tb = kband + (long)(64 * (j + 1)) * INW * 2;
#pragma unroll
                    for (int i = 0; i < 8; ++i) { kr[i] = *(const u32x4*)(tb + ((vl - 1024u) + (unsigned)(i * 8 * INW * 2))); vr[i] = *(const u32x4*)(tb + (vl + (unsigned)(i * 8 * INW * 2))); }
                }
                bf16x8 kf[8];
#pragma unroll
                for (int kb = 0; kb < 2; ++kb)
#pragma unroll
                    for (int s = 0; s < 4; ++s) kf[kb * 4 + s] = *(const LAS bf16x8*)(vbase + kb * 4096 + kfo + (((2 * s + hh) ^ (q32 & 7)) << 4));
                f32x16 p0, p1;
                if (j <= 5) {
                    const float ci = bconst - m_ref;
#pragma unroll
                    for (int r = 0; r < 16; ++r) { p0[r] = ci; p1[r] = ci; }
                } else {
                    const LAS float* pb0 = btab + (LEFT * CHUNK + qi - 64 * j + MAXREL - 4 * hh - 27); const LAS float* pb1 = pb0 - 32;
#pragma unroll
                    for (int r = 0; r < 16; ++r) { p0[r] = pb0[27 - ((r & 3) + 8 * (r >> 2))] - m_ref; p1[r] = pb1[27 - ((r & 3) + 8 * (r >> 2))] - m_ref; }
                }
#pragma unroll
                for (int s = 0; s < 4; ++s) { p0 = MFMA32(kf[s], qf[s], p0); p1 = MFMA32(kf[4 + s], qf[s], p1); }
                float mt = fmaxf(p0[0], p1[0]);
#pragma unroll
                for (int r = 1; r < 16; ++r) mt = fmaxf(mt, fmaxf(p0[r], p1[r]));
                mt = fmaxf(mt, __shfl_xor(mt, 32));
                const bool first = (j == j0);
                const bool grow = first || (mt > THR);
                if (__any(grow)) {
                    const float d = grow ? mt : 0.f, alpha = first ? 1.0f : __builtin_amdgcn_exp2f(-d);
                    m_ref += d; l_run *= alpha;
#pragma unroll
                    for (int r = 0; r < 16; ++r) { p0[r] -= d; p1[r] -= d; o0[r] *= alpha; o1[r] *= alpha; }
                }
                float ls0 = 0.f, ls1 = 0.f;
#pragma unroll
                for (int r = 0; r < 16; ++r) { p0[r] = __builtin_amdgcn_exp2f(p0[r]); p1[r] = __builtin_amdgcn_exp2f(p1[r]); ls0 += p0[r]; ls1 += p1[r]; }
                l_run += ls0 + ls1;
                const bf16x8 pf0 = pack8(p0, 0), pf1 = pack8(p0, 1), pf2 = pack8(p1, 0), pf3 = pack8(p1, 1);
                LAS const unsigned char* vcur = vbase + 8192 + vb;
#pragma unroll
                for (int db = 0; db < 2; ++db) {
                    v4i16_t lo[4], hi[4];
#pragma unroll
                    for (int ks = 0; ks < 4; ++ks) { lo[ks] = vtr(vcur + ks * 2048 + db * 64); hi[ks] = vtr(vcur + ks * 2048 + 1024 + db * 64); }
#define VF(k) (bf16x8){lo[k][0], lo[k][1], lo[k][2], lo[k][3], hi[k][0], hi[k][1], hi[k][2], hi[k][3]}
                    if (db == 0) { o0 = MFMA32(VF(0), pf0, o0); o0 = MFMA32(VF(1), pf1, o0); o0 = MFMA32(VF(2), pf2, o0); o0 = MFMA32(VF(3), pf3, o0); }
                    else         { o1 = MFMA32(VF(0), pf0, o1); o1 = MFMA32(VF(1), pf1, o1); o1 = MFMA32(VF(2), pf2, o1); o1 = MFMA32(VF(3), pf3, o1); }
#undef VF
                }
                if (j < LEFT) {
#pragma unroll
                    for (int i = 0; i < 8; ++i) { *(LAS u32x4*)(vbase + i * 1024 + kw) = kr[i]; *(LAS u32x4*)(vbase + 8192 + i * 1024 + vw) = vr[i]; }
                }
            }
            const float lt = l_run + __shfl_xor(l_run, 32), inv = 1.0f / lt;
            float ss = 0.f;
            bf16_t* orow = mixb + tq * D + 512 + h * 64 + 4 * hh;
#pragma unroll
            for (int g = 0; g < 4; ++g) {
                const float a0 = o0[4 * g] * inv, a1 = o0[4 * g + 1] * inv, a2 = o0[4 * g + 2] * inv, a3 = o0[4 * g + 3] * inv;
                const float c0 = o1[4 * g] * inv, c1 = o1[4 * g + 1] * inv, c2 = o1[4 * g + 2] * inv, c3 = o1[4 * g + 3] * inv;
                ss += (a0 * a0 + a1 * a1) + (a2 * a2 + a3 * a3) + (c0 * c0 + c1 * c1) + (c2 * c2 + c3 * c3);
                *(u32x2*)(orow + 8 * g) = (u32x2){cvtpk_s(a0, a1), cvtpk_s(a2, a3)};
                *(u32x2*)(orow + 32 + 8 * g) = (u32x2){cvtpk_s(c0, c1), cvtpk_s(c2, c3)};
            }
            ss += __shfl_xor(ss, 32);
            if (hh == 0) ssq[tq * SSQW + 32 + h] = ss;
        }
    }
}


constexpr int RG_WT = 0, RG_IMG = 18432, RG_SEG = 35840, RG_PRE = 44032, RG_CAR = 52224, RG_ROWB = 144, RG_IROW = 272;
__device__ __forceinline__ float fast_sigmoid(float x) { return __builtin_amdgcn_rcpf(1.0f + __expf(-x)); }
__device__ __forceinline__ void rglru_item(const Params& p, const bf16_t* z, bf16_t* mixb, float* ssq, LAS unsigned char* lds, unsigned long long* gran, int b, int hb, int kc) {
    const int tid = opaque_tid(), lane = tid & 63, w = __builtin_amdgcn_readfirstlane(tid >> 6), ch = lane, c16 = lane & 15, tg = lane >> 4;
    LAS f32x2* seg = (LAS f32x2*)(lds + RG_SEG); LAS f32x2* pre = (LAS f32x2*)(lds + RG_PRE); LAS float* car = (LAS float*)(lds + RG_CAR);
    {
        const u32x4* srcw = (const u32x4*)(p.ws + WS_GWT + (size_t)hb * 128 * 144); LAS u32x4* dstw = (LAS u32x4*)(lds + RG_WT);
        for (int idx = tid; idx < 128 * 144 / 16; idx += NTHR) dstw[idx] = srcw[idx];
    }
    const int gch = hb * 64 + ch;
    const float cw0 = p.conv_w[gch], cw1 = p.conv_w[RW + gch], cw2 = p.conv_w[2 * RW + gch], cw3 = p.conv_w[3 * RW + gch], cb = p.conv_b[gch];
    const float* sp8t = (const float*)(p.ws + WS_GWT + 8 * 128 * 144);
    float ba[4], bxb[4], sp8[4];
#pragma unroll
    for (int nb = 0; nb < 4; ++nb) { const int c = hb * 64 + 16 * nb + c16; ba[nb] = p.b_rg_a[c]; bxb[nb] = p.b_rg_x[c]; sp8[nb] = sp8t[c]; }
    LAS unsigned char* img = lds + RG_IMG;
    LAS unsigned char* trb = img + (8 * tg + (c16 >> 2)) * RG_IROW + (16 * w + 4 * (c16 & 3)) * 2;
    const int s0 = kc * 256;
    const bf16_t* ucol = z + ((size_t)b * S + s0) * INW + gch;
    float av[2][4][4], bv[2][4][4], cP[2][4], cH[2][4];
    bf16_t uraw[2][19], graw[2][4][4];
#pragma unroll
    for (int blk = 0; blk < 2; ++blk)
#pragma unroll
        for (int i = 0; i < 19; ++i) { const int s = blk * 128 + 16 * w - 3 + i; uraw[blk][i] = (s0 + s >= 0) ? ucol[(long)s * INW] : (bf16_t)0; }
#pragma unroll
    for (int blk = 0; blk < 2; ++blk)
#pragma unroll
        for (int nb = 0; nb < 4; ++nb)
#pragma unroll
            for (int i = 0; i < 4; ++i) graw[blk][nb][i] = z[((size_t)b * S + s0 + blk * 128 + 16 * w + 4 * tg + i) * INW + 512 + hb * 64 + 16 * nb + c16];
    __syncthreads();
#pragma unroll
    for (int blk = 0; blk < 2; ++blk) {
        const int t0 = blk * 128 + 16 * w;
        float uv[19];
#pragma unroll
        for (int i = 0; i < 19; ++i) uv[i] = bf2f(uraw[blk][i]);
        {
            float uc[16];
#pragma unroll
            for (int i = 0; i < 16; ++i) uc[i] = cb + cw0 * uv[i] + cw1 * uv[i + 1] + cw2 * uv[i + 2] + cw3 * uv[i + 3];
            u32x4 w0, w1;
#pragma unroll
            for (int e = 0; e < 4; ++e) { w0[e] = cvtpk_s(uc[2 * e], uc[2 * e + 1]); w1[e] = cvtpk_s(uc[8 + 2 * e], uc[9 + 2 * e]); }
            *(LAS u32x4*)(img + ch * RG_IROW + 32 * w) = w0; *(LAS u32x4*)(img + ch * RG_IROW + 32 * w + 16) = w1;
        }
        LDS_WAIT(); asm volatile("" ::: "memory");
        const v4i16_t t0lo = vtr(trb), t0hi = vtr(trb + 4 * RG_IROW), t1lo = vtr(trb + 32 * RG_IROW), t1hi = vtr(trb + 36 * RG_IROW);
        const bf16x8 a0 = (bf16x8){t0lo[0], t0lo[1], t0lo[2], t0lo[3], t0hi[0], t0hi[1], t0hi[2], t0hi[3]}, a1 = (bf16x8){t1lo[0], t1lo[1], t1lo[2], t1lo[3], t1hi[0], t1hi[1], t1hi[2], t1hi[3]};
#pragma unroll
        for (int nb = 0; nb < 4; ++nb) {
            const bf16x8 b0a = *(const LAS bf16x8*)(lds + RG_WT + (16 * nb + c16) * RG_ROWB + tg * 16), b1a = *(const LAS bf16x8*)(lds + RG_WT + (16 * nb + c16) * RG_ROWB + tg * 16 + 64);
            const bf16x8 b0x = *(const LAS bf16x8*)(lds + RG_WT + (64 + 16 * nb + c16) * RG_ROWB + tg * 16), b1x = *(const LAS bf16x8*)(lds + RG_WT + (64 + 16 * nb + c16) * RG_ROWB + tg * 16 + 64);
            f32x4 acca = __builtin_amdgcn_mfma_f32_16x16x32_bf16(a0, b0a, (f32x4){0.f, 0.f, 0.f, 0.f}, 0, 0, 0); acca = __builtin_amdgcn_mfma_f32_16x16x32_bf16(a1, b1a, acca, 0, 0, 0);
            f32x4 accx = __builtin_amdgcn_mfma_f32_16x16x32_bf16(a0, b0x, (f32x4){0.f, 0.f, 0.f, 0.f}, 0, 0, 0); accx = __builtin_amdgcn_mfma_f32_16x16x32_bf16(a1, b1x, accx, 0, 0, 0);
            const u32x2 ucr = *(const LAS u32x2*)(img + (16 * nb + c16) * RG_IROW + (16 * w + 4 * tg) * 2);
            const float ucv[4] = {__builtin_bit_cast(float, ucr[0] << 16), __builtin_bit_cast(float, ucr[0] & 0xffff0000u), __builtin_bit_cast(float, ucr[1] << 16), __builtin_bit_cast(float, ucr[1] & 0xffff0000u)};
            float H = 0.f, P = 1.f;
#pragma unroll
            for (int rg_ = 0; rg_ < 4; ++rg_) {
                const float r = fast_sigmoid(acca[rg_] + ba[nb]), ig = fast_sigmoid(accx[rg_] + bxb[nb]);
                const float a = __expf(r * sp8[nb]);
                av[blk][nb][rg_] = a; bv[blk][nb][rg_] = __builtin_amdgcn_sqrtf((1.0f - a) * (1.0f + a)) * (ig * ucv[rg_]);
                H = a * H + bv[blk][nb][rg_]; P *= a; }
            float cp = 1.f, chh = 0.f, Pt = 1.f, Ht = 0.f;
#pragma unroll
            for (int k = 0; k < 4; ++k) { const float Pk = __shfl(P, c16 + 16 * k), Hk = __shfl(H, c16 + 16 * k);
                cp = (k == tg) ? Pt : cp; chh = (k == tg) ? Ht : chh;
                Ht = Pk * Ht + Hk; Pt *= Pk; }
            cP[blk][nb] = cp; cH[blk][nb] = chh;
            if (tg == 0) seg[(blk * 8 + w) * 64 + 16 * nb + c16] = (f32x2){Pt, Ht};
        }
        LDS_WAIT(); asm volatile("" ::: "memory");
    }
    __syncthreads();
    if (tid < 64) {
        float Pp = 1.f, Hp = 0.f;
#pragma unroll
        for (int s = 0; s < 16; ++s) { pre[s * 64 + tid] = (f32x2){Pp, Hp}; const f32x2 sv = seg[s * 64 + tid]; Hp = sv.x * Hp + sv.y; Pp *= sv.x; }
        unsigned long long* g = gran + ((size_t)((b * 8 + hb) * 8 + kc) * 2) * 64 + tid;
        __hip_atomic_store(g, (1ull << 32) | __builtin_bit_cast(unsigned, Pp), __ATOMIC_RELAXED, __HIP_MEMORY_SCOPE_AGENT);
        __hip_atomic_store(g + 64, (1ull << 32) | __builtin_bit_cast(unsigned, Hp), __ATOMIC_RELAXED, __HIP_MEMORY_SCOPE_AGENT);
        float h = 0.f;
        for (int j = 0; j < kc; ++j) {
            const unsigned long long* gj = gran + ((size_t)((b * 8 + hb) * 8 + j) * 2) * 64 + tid;
            unsigned long long vp, vh; unsigned spins = 0;
            for (;;) { vp = __hip_atomic_load(gj, __ATOMIC_RELAXED, __HIP_MEMORY_SCOPE_AGENT); vh = __hip_atomic_load(gj + 64, __ATOMIC_RELAXED, __HIP_MEMORY_SCOPE_AGENT);
                if (__all(((vp >> 32) != 0ull) && ((vh >> 32) != 0ull))) break; __builtin_amdgcn_s_sleep(2); if (++spins > (1u << 20)) break; }
            h = __builtin_bit_cast(float, (unsigned)vp) * h + __builtin_bit_cast(float, (unsigned)vh);
        }
        car[tid] = h;
    }
    __syncthreads();
#pragma unroll
    for (int blk = 0; blk < 2; ++blk) {
        const int t0 = blk * 128 + 16 * w;
        float ysum[4] = {0.f, 0.f, 0.f, 0.f};
#pragma unroll
        for (int nb = 0; nb < 4; ++nb) {
            const int oc = 16 * nb + c16; const f32x2 pf = pre[(blk * 8 + w) * 64 + oc];
            float hcur = cP[blk][nb] * (pf.x * car[oc] + pf.y) + cH[blk][nb];
            bf16_t* orow = mixb + ((size_t)b * S + s0 + t0 + 4 * tg) * D + hb * 64 + oc;
#pragma unroll
            for (int i = 0; i < 4; ++i) { hcur = av[blk][nb][i] * hcur + bv[blk][nb][i];
                const float g = bf2f(graw[blk][nb][i]), u2 = 1.5957691216057308f * (g + 0.044715f * g * g * g);
                const float y = hcur * g * fast_sigmoid(u2);
                orow[(size_t)i * D] = (bf16_t)(cvtpk_s(y, y) & 0xffffu); ysum[i] += y * y; }
        }
#pragma unroll
        for (int i = 0; i < 4; ++i) ysum[i] += __shfl_xor(ysum[i], 1);
#pragma unroll
        for (int i = 0; i < 4; ++i) ysum[i] += __shfl_xor(ysum[i], 2);
#pragma unroll
        for (int i = 0; i < 4; ++i) ysum[i] += __shfl_xor(ysum[i], 4);
#pragma unroll
        for (int i = 0; i < 4; ++i) ysum[i] += __shfl_xor(ysum[i], 8);
        if (c16 == 0) { float* sq = ssq + ((size_t)b * S + s0 + t0 + 4 * tg) * SSQW + hb * 4;
#pragma unroll
            for (int i = 0; i < 4; ++i) *(f32x4*)(sq + (size_t)i * SSQW) = (f32x4){ysum[i], 0.f, 0.f, 0.f}; }
    }
}

constexpr int RT_WT = 0, RT_LDK = 1028, RT_PART = 82432, RT_SSP = 98816, RT_REC = 99328;
__device__ __forceinline__ void ph_router3(const Params& p, const float* h, int* gcount, int* tok_list, float* w_list, float* r_list, LAS unsigned char* lds) {
    const int tid = opaque_tid(), lane = tid & 63, w = __builtin_amdgcn_readfirstlane(tid >> 6), t16 = lane & 15, g = lane >> 4;
    LAS float* wt = (LAS float*)(lds + RT_WT); LAS float* part = (LAS float*)(lds + RT_PART); LAS float* ssp = (LAS float*)(lds + RT_SSP);
    LAS int* lcnt = (LAS int*)(lds + RT_REC); LAS int* lbase = lcnt + 16; LAS int* rec_e = lcnt + 32; LAS int* rec_s = lcnt + 160; LAS float* rec_w = (LAS float*)(lcnt + 288); LAS float* rec_r = (LAS float*)(lcnt + 416);
    { const f32x4* srcw = (const f32x4*)(p.ws + WS_RWT); LAS f32x4* dstw = (LAS f32x4*)wt;
      for (int idx = tid; idx < 20 * RT_LDK / 4; idx += NTHR) dstw[idx] = srcw[idx]; }
    const int task = w & 3, khalf = w >> 2, kbase = khalf * 512 + g * 128;
    for (int grp = blockIdx.x; grp < T / 64; grp += gridDim.x) {
        if (tid < 16) lcnt[tid] = 0;
        __syncthreads();
        {
            const f32x4* hrow = (const f32x4*)(h + (size_t)(grp * 64 + task * 16 + t16) * D + kbase);
            const LAS f32x4* b0p = (const LAS f32x4*)(wt + t16 * RT_LDK + kbase); const LAS f32x4* b1p = (const LAS f32x4*)(wt + (16 + (lane & 3)) * RT_LDK + kbase);
            f32x4 acc0 = {0.f, 0.f, 0.f, 0.f}, acc1 = {0.f, 0.f, 0.f, 0.f}; float ss = 0.f;
            f32x4 a[32];
#pragma unroll
            for (int j = 0; j < 32; ++j) a[j] = hrow[j];
#pragma unroll
            for (int j = 0; j < 32; ++j) { const f32x4 b0 = b0p[j], b1 = b1p[j];
#pragma unroll
                for (int q = 0; q < 4; ++q) { acc0 = __builtin_amdgcn_mfma_f32_16x16x4f32(a[j][q], b0[q], acc0, 0, 0, 0); acc1 = __builtin_amdgcn_mfma_f32_16x16x4f32(a[j][q], b1[q], acc1, 0, 0, 0); ss += a[j][q] * a[j][q]; } }
            ss += __shfl_xor(ss, 16); ss += __shfl_xor(ss, 32);
            if (g == 0) ssp[khalf * 64 + task * 16 + t16] = ss;
            LAS float* pp = part + ((khalf * 4 + task) * 16 + 4 * g) * 32 + t16;
#pragma unroll
            for (int rg_ = 0; rg_ < 4; ++rg_) { pp[rg_ * 32] = acc0[rg_]; pp[rg_ * 32 + 16] = acc1[rg_]; }
        }
        __syncthreads();
        if (tid < 64) {
            const float rstd = rsqrtf((ssp[tid] + ssp[64 + tid]) * (1.0f / D) + EPS);
            const LAS float* q0 = part + tid * 32; const LAS float* q1 = part + (64 + tid) * 32;
            float lg[4];
#pragma unroll
            for (int i = 0; i < 4; ++i) lg[i] = (q0[16 + i] + q1[16 + i]) * rstd + p.b_group[i];
            int gi = 0; float best = lg[0];
#pragma unroll
            for (int i = 1; i < 4; ++i) if (lg[i] > best) { best = lg[i]; gi = i; }
            float den = 0.f;
#pragma unroll
            for (int i = 0; i < 4; ++i) den += expf(lg[i] - best);
            const float pg = 1.0f / den;
            float sel[4];
#pragma unroll
            for (int i = 0; i < 4; ++i) sel[i] = (q0[gi * 4 + i] + q1[gi * 4 + i]) * rstd + p.b_router[gi * 4 + i];
            int i1 = 0; float v1 = sel[0];
#pragma unroll
            for (int i = 1; i < 4; ++i) if (sel[i] > v1) { v1 = sel[i]; i1 = i; }
            int i2 = -1; float v2 = -3.0e38f;
#pragma unroll
            for (int i = 0; i < 4; ++i) if (i != i1 && sel[i] > v2) { v2 = sel[i]; i2 = i; }
            const float e2 = expf(v2 - v1);
            const float w1 = pg / (1.0f + e2), w2 = pg * e2 / (1.0f + e2);
            const int ea = gi * 4 + i1, eb = gi * 4 + i2;
            const int sa = __hip_atomic_fetch_add(lcnt + ea, 1, __ATOMIC_RELAXED, __HIP_MEMORY_SCOPE_WORKGROUP);
            const int sb = __hip_atomic_fetch_add(lcnt + eb, 1, __ATOMIC_RELAXED, __HIP_MEMORY_SCOPE_WORKGROUP);
            rec_e[tid * 2] = ea; rec_s[tid * 2] = sa; rec_w[tid * 2] = w1; rec_r[tid * 2] = rstd;
            rec_e[tid * 2 + 1] = eb; rec_s[tid * 2 + 1] = sb; rec_w[tid * 2 + 1] = w2; rec_r[tid * 2 + 1] = rstd;
        }
        __syncthreads();
        if (tid < 16) lbase[tid] = __hip_atomic_fetch_add(gcount + tid, lcnt[tid], __ATOMIC_RELAXED, __HIP_MEMORY_SCOPE_AGENT);
        __syncthreads();
        if (tid < 128) { const int e = rec_e[tid]; const int pos = lbase[e] + rec_s[tid]; tok_list[e * T + pos] = grp * 128 + tid; w_list[e * T + pos] = rec_w[tid]; r_list[e * T + pos] = rec_r[tid]; }
        __syncthreads();
    }
}

__device__ void ph_final(const Params& p, const float* h, const bf16_t* y2, float* out) {
    const int tid = opaque_tid(), lane = tid & 63, wv = tid >> 6;
    constexpr int RPT = 4;
    f32x4 gf[4];
#pragma unroll
    for (int j = 0; j < 4; ++j) gf[j] = *((const f32x4*)p.final_g + lane + 64 * j);
    const int nwv = gridDim.x * NWAVES;
    for (int t0 = blockIdx.x * NWAVES + wv; t0 < T; t0 += nwv * RPT) {
        f32x4 hv[RPT][4]; u32x2 ya[RPT][4], yb[RPT][4];
#pragma unroll
        for (int q = 0; q < RPT; ++q) { const int t = t0 + q * nwv; const int tt = t < T ? t : t0;
            const f32x4* hr = (const f32x4*)(h + (size_t)tt * D) + lane;
            const u32x2* y0 = (const u32x2*)(y2 + (size_t)(2 * tt) * D) + lane; const u32x2* y1 = (const u32x2*)(y2 + (size_t)(2 * tt + 1) * D) + lane;
#pragma unroll
            for (int j = 0; j < 4; ++j) { hv[q][j] = hr[64 * j]; ya[q][j] = y0[64 * j]; yb[q][j] = y1[64 * j]; } }
#pragma unroll
        for (int q = 0; q < RPT; ++q) { const int t = t0 + q * nwv;
            f32x4 v[4]; float ss = 0.f;
#pragma unroll
            for (int j = 0; j < 4; ++j) { const u32x2 a = ya[q][j], b = yb[q][j];
                v[j][0] = hv[q][j][0] + __builtin_bit_cast(float, a[0] << 16) + __builtin_bit_cast(float, b[0] << 16);
                v[j][1] = hv[q][j][1] + __builtin_bit_cast(float, a[0] & 0xffff0000u) + __builtin_bit_cast(float, b[0] & 0xffff0000u);
                v[j][2] = hv[q][j][2] + __builtin_bit_cast(float, a[1] << 16) + __builtin_bit_cast(float, b[1] << 16);
                v[j][3] = hv[q][j][3] + __builtin_bit_cast(float, a[1] & 0xffff0000u) + __builtin_bit_cast(float, b[1] & 0xffff0000u);
                ss += (v[j][0] * v[j][0] + v[j][1] * v[j][1]) + (v[j][2] * v[j][2] + v[j][3] * v[j][3]); }
            const float r = rsqrtf(wave_sum(ss) * (1.0f / D) + EPS);
            if (t < T) { f32x4* orow = (f32x4*)(out + (size_t)t * D) + lane;
#pragma unroll
                for (int j = 0; j < 4; ++j) orow[64 * j] = v[j] * r * gf[j]; }
        }
    }
}


__device__ __forceinline__ void ph_mixers(const Params& p, const bf16_t* z, bf16_t* mixb, float* ssq, LAS unsigned char* lds, unsigned* qctr) {
    const AttnCtx A = attn_setup(p, lds, TAB_OFF);
    volatile LAS int* qword = (volatile LAS int*)(lds + TAB_OFF + 12288);
    constexpr int NQ = NB, QITEMS = 64 + 64;
    unsigned long long* gran = (unsigned long long*)(p.ws + WS_CTL + 128 * 1024);
    const int qstep = (int)gridDim.x < NQ ? (int)gridDim.x : NQ;
    for (int q = blockIdx.x % NQ; q < NQ; q += qstep) {
        int ticket = 0;
        if (threadIdx.x == 0) ticket = (int)__hip_atomic_fetch_add(qctr + 64 * q, 1u, __ATOMIC_RELAXED, __HIP_MEMORY_SCOPE_AGENT);
        for (;;) {
            __syncthreads();
            if (threadIdx.x == 0) { *qword = ticket; if (ticket < QITEMS) ticket = (int)__hip_atomic_fetch_add(qctr + 64 * q, 1u, __ATOMIC_RELAXED, __HIP_MEMORY_SCOPE_AGENT); }
            __syncthreads();
            const int idx = *qword;
            if (idx >= QITEMS) break;
            if (idx < 64) rglru_item(p, z, mixb, ssq, lds, gran, q, idx & 7, idx >> 3);
            else { const int a = idx - 64; attn_item(A, z, mixb, ssq, q, 31 - (a >> 1), a & 1); }
        }
    }
}

#define XB_TMO      128
#define XB_XCNT(j)  (256  + 64 * (j))
#define XB_XSUB(j)  (1280 + 64 * (j))
#define XB_XGEN(j)  (2304 + 64 * (j))
#define XB_TOP      3328
#define XB_TOPGEN   3392
#define XCD_BAR_WORDS 3456
#define XB_SPIN_CAP (1u << 18)
__device__ __forceinline__ unsigned xb_ld(unsigned* p)              { return __hip_atomic_load(p, __ATOMIC_RELAXED, __HIP_MEMORY_SCOPE_AGENT); }
__device__ __forceinline__ unsigned xb_add(unsigned* p, unsigned v) { return __hip_atomic_fetch_add(p, v, __ATOMIC_RELAXED, __HIP_MEMORY_SCOPE_AGENT); }
__device__ __forceinline__ unsigned xb_xcc_id() { return (unsigned)__builtin_amdgcn_s_getreg((3 << 11) | 20) & 0xFu; }
#define XB_SPIN(cond, bar) do { unsigned _sp = 0; while (cond) { __builtin_amdgcn_s_sleep(1); \
    if ((++_sp & 255u) == 0u) { if (xb_ld(&(bar)[XB_TMO])) break; if (_sp > XB_SPIN_CAP) { atomicAdd(&(bar)[XB_TMO], 1u); break; } } } } while (0)
struct XcdBarrier { unsigned* bar; unsigned x; volatile LAS unsigned* st; };
__device__ __forceinline__ XcdBarrier xcd_barrier_post(unsigned* bar, volatile LAS unsigned* st) {
    XcdBarrier b; b.bar = bar; b.x = xb_xcc_id(); b.st = st;
    if (threadIdx.x == 0) (void)xb_add(&bar[XB_XCNT(b.x)], 1u);
    return b;
}
__device__ __forceinline__ void xcd_barrier_complete(unsigned* bar, unsigned x, unsigned& nloc, unsigned& nx) {
    const unsigned G = gridDim.x * gridDim.y * gridDim.z;
    unsigned sum, cnt, mine, sp = 0u;
    for (;;) {
        sum = 0u; cnt = 0u; mine = 0u;
#pragma unroll
        for (unsigned j = 0; j < 16; ++j) { const unsigned c = xb_ld(&bar[XB_XCNT(j)]); sum += c; cnt += (c > 0u) ? 1u : 0u; mine = (j == x) ? c : mine; }
        if (sum == G) break;
        __builtin_amdgcn_s_sleep(1);
        if ((++sp & 255u) == 0u) { if (xb_ld(&bar[XB_TMO])) break; if (sp > XB_SPIN_CAP) { atomicAdd(&bar[XB_TMO], 1u); break; } }
    }
    nloc = mine > 0u ? mine : 1u; nx = cnt > 0u ? cnt : 1u;
}
__device__ __forceinline__ void xcd_barrier(const XcdBarrier& b) {
    asm volatile("s_waitcnt vmcnt(0)" ::: "memory");
    __syncthreads();
    if (threadIdx.x == 0) {
        unsigned* bar = b.bar;
        __builtin_amdgcn_s_waitcnt(0);
        unsigned nloc = b.st[0], nx = b.st[1];
        if (nloc == 0u) { xcd_barrier_complete(bar, b.x, nloc, nx); b.st[0] = nloc; b.st[1] = nx; }
        const unsigned old = xb_add(&bar[XB_XSUB(b.x)], 1u);
        const unsigned gen = old / nloc;
        if (old + 1u == (gen + 1u) * nloc) {
            __builtin_amdgcn_fence(__ATOMIC_RELEASE, "agent");
            asm volatile("s_waitcnt vmcnt(0)" ::: "memory");
            const unsigned og = xb_add(&bar[XB_TOP], 1u);
            const unsigned tg = og / nx;
            if (og + 1u == (tg + 1u) * nx) xb_add(&bar[XB_TOPGEN], 1u);
            else XB_SPIN(xb_ld(&bar[XB_TOPGEN]) == tg, bar);
            __builtin_amdgcn_fence(__ATOMIC_ACQUIRE, "agent");
            xb_add(&bar[XB_XGEN(b.x)], 1u);
            asm volatile("s_waitcnt vmcnt(0)" ::: "memory");
        } else {
            XB_SPIN(xb_ld(&bar[XB_XGEN(b.x)]) == gen, bar);
            __builtin_amdgcn_fence(__ATOMIC_ACQUIRE, "agent");
            asm volatile("s_waitcnt vmcnt(0)" ::: "memory");
        }
    }
    __syncthreads();
}


__global__ void __launch_bounds__(NTHR) k_mega(Params p) {
    extern __shared__ __attribute__((aligned(16))) unsigned char lds_raw[];
    LAS unsigned char* lds = (LAS unsigned char*)lds_raw;
    const int G = gridDim.x; const int bx = blockIdx.x;
    volatile LAS unsigned* misc = (volatile LAS unsigned*)(lds + MISC_OFF);
    if (threadIdx.x < 64) misc[threadIdx.x] = 0u;
    __syncthreads();
    const XcdBarrier xbar = xcd_barrier_post((unsigned*)(p.ws + WS_CTL + 65536), misc + 8);
    const int vcu = (G % 8 == 0) ? (bx % 8) * (G / 8) + bx / 8 : bx;
    bf16_t* win_t = (bf16_t*)(p.ws + WS_WIN); bf16_t* wout_t = (bf16_t*)(p.ws + WS_WOUT);
    bf16_t* xb = (bf16_t*)(p.ws + WS_XB); bf16_t* zb = (bf16_t*)(p.ws + WS_Z); bf16_t* mixb = (bf16_t*)(p.ws + WS_MIX);
    float* ssq = (float*)(p.ws + WS_SSQ);
    bf16_t* xn2b = (bf16_t*)(p.ws + WS_XB);
    float* h = p.out;

    constexpr int NWG1 = (T / 256) * (INW / 256);
    const int n_idle = (NWG1 % G) ? G - (NWG1 % G) : 0, idle_idx = bx - (NWG1 % G);
    const int e_split = (n_idle >= 96) ? 4 : NE;
    ph_prologue(p, lds, vcu, G, e_split);
    xcd_barrier(xbar);
    {
        pg8::DenseOrder So; So.init(xb, win_t, T, INW, D, G, bx);
        pg8::EpiZ E{zb, INW};
        pg8::gemm_phase(lds, D, So, E);
        if (e_split < NE && idle_idx >= 0) p1_tail_convert(p, lds, idle_idx, n_idle, e_split);
    }
    xcd_barrier(xbar);
    ph_mixers(p, zb, mixb, ssq, lds, (unsigned*)(p.ws + WS_CTL + 8192));
    xcd_barrier(xbar);
    {
        pg8::DenseOrder So; So.init(mixb, wout_t, T, D, D, G, bx);
        pg8::EpiH E{ssq, p.x, h, xn2b, TAB_OFF};
        pg8::gemm_phase(lds, D, So, E);
    }
    xcd_barrier(xbar);
    int* gcount = (int*)(p.ws + WS_CTL + 4096); int* tok_list = (int*)(p.ws + WS_LIST); float* w_list = (float*)(p.ws + WS_LIST + MiB);
    bf16_t* wgu_t = (bf16_t*)(p.ws + WS_WGU); bf16_t* wd_t = (bf16_t*)(p.ws + WS_WD); bf16_t* hid = (bf16_t*)(p.ws + WS_HID); bf16_t* y2 = (bf16_t*)(p.ws + WS_Z);
    float* r_list = (float*)(p.ws + WS_ROUTE);
    ph_router3(p, h, gcount, tok_list, w_list, r_list, lds);
    xcd_barrier(xbar);
    LAS int* meta = (LAS int*)(lds + META_OFF);
    if (threadIdx.x == 0) { int base = 0; for (int e = 0; e < NE; ++e) { const int cnt = gcount[e]; meta[e] = base; meta[32 + e] = cnt; base += (cnt + 255) >> 8; } meta[16] = base; }
    __syncthreads();
    const int ntiles = meta[16];
    {
        pg8::MoeOrder<0> So{xn2b, wgu_t, tok_list, meta, D, G, bx, ntiles};
        pg8::EpiHid E{hid, r_list, meta};
        pg8::gemm_phase(lds, D, So, E);
        { const int r5 = (ntiles * 4) % G; if (r5 == 0) p5a_tail_convert(p, lds, bx, G); else if (bx >= r5) p5a_tail_convert(p, lds, bx - r5, G - r5); }
    }
    xcd_barrier(xbar);
    {
        pg8::MoeOrder<1> So{hid, wd_t, tok_list, meta, DFF, G, bx, ntiles};
        pg8::EpiY E{y2, tok_list, w_list, meta};
        pg8::gemm_phase(lds, DFF, So, E);
    }
    xcd_barrier(xbar);
    ph_final(p, h, y2, p.out);
}

extern "C" void kernel_launch(void* const* d_in, const int* in_sizes, int n_in, void* d_out, int out_size, void* d_ws, size_t ws_size, hipStream_t stream) {
    static int grid_blocks = 0;
    if (!grid_blocks) {
        if (ws_size < WS_END) { fprintf(stderr, "kernel_launch: workspace too small (%zu < %zu)\n", ws_size, (size_t)WS_END); grid_blocks = -1; return; }
        int dev = 0, cus = 0, per_cu = 0;
        (void)hipGetDevice(&dev);
        (void)hipDeviceGetAttribute(&cus, hipDeviceAttributeMultiprocessorCount, dev);
        (void)hipFuncSetAttribute((const void*)k_mega, hipFuncAttributeMaxDynamicSharedMemorySize, LDS_BYTES);
        (void)hipOccupancyMaxActiveBlocksPerMultiprocessor(&per_cu, (const void*)k_mega, NTHR, LDS_BYTES);
        if (per_cu < 1) { fprintf(stderr, "kernel_launch: occupancy query says %d blocks per CU: not launching\n", per_cu); grid_blocks = -1; return; }
        grid_blocks = cus;
    }
    if (grid_blocks < 0) return;
    Params p{};
    const float** f = (const float**)&p;
    for (int i = 0; i < 23; ++i) f[i] = (const float*)d_in[i];
    p.out = (float*)d_out;
    p.ws = (unsigned char*)d_ws;
    (void)hipMemsetAsync((char*)d_ws + WS_CTL, 0, CTL_ZERO_BYTES, stream);
    hipLaunchKernelGGL(k_mega, dim3(grid_blocks), dim3(NTHR), LDS_BYTES, stream, p);
    hipError_t e = hipPeekAtLastError();
    if (e != hipSuccess) fprintf(stderr, "launch failed: %s (grid %d)\n", hipGetErrorString(e), grid_blocks);
}
```

```cpp
#include <hip/hip_runtime.h>
#include <cstdio>
#include <cstdint>

#define LAS __attribute__((address_space(3)))
typedef unsigned short bf16_t;
typedef short bf16x8 __attribute__((ext_vector_type(8)));
typedef float f32x4 __attribute__((ext_vector_type(4)));
typedef float f32x2 __attribute__((ext_vector_type(2)));
typedef unsigned u32x4 __attribute__((ext_vector_type(4)));
typedef unsigned u32x2 __attribute__((ext_vector_type(2)));

constexpr int D = 1024, NB = 8, S = 2048, T = NB * S;
constexpr int RW = 512, RHD = 64;
constexpr int CHUNK = 64, LEFT = 8, BAND = 576, MAXREL = 128;
constexpr int INW = 2560;
constexpr int NE = 16, DFF = 512;
constexpr float EPS = 1e-6f;
constexpr int NTHR = 512, NWAVES = 8;
constexpr int SSQW = 40;

constexpr size_t MiB = 1u << 20;
constexpr size_t WS_CTL = 0, CTL_BYTES = 2 * MiB, CTL_ZERO_BYTES = 128 * 1024 + 512 * 1024;
constexpr size_t WS_WIN = 2 * MiB;
constexpr size_t WS_WOUT = 7 * MiB;
constexpr size_t WS_WGU = 9 * MiB;
constexpr size_t WS_WD = 41 * MiB;
constexpr size_t WS_XB = 57 * MiB;
constexpr size_t WS_Z = 89 * MiB;
constexpr size_t WS_MIX = 169 * MiB;
constexpr size_t WS_HID = 201 * MiB;
constexpr size_t WS_SSQ = 237 * MiB;
constexpr size_t WS_LIST = 240 * MiB;
constexpr size_t WS_ROUTE = 242 * MiB;
constexpr size_t WS_RWT = 243 * MiB;
constexpr size_t WS_GWT = 244 * MiB;
constexpr size_t WS_END = 245 * MiB;

constexpr int RING_BYTES = 131072, TAB_OFF = RING_BYTES, META_OFF = RING_BYTES + 4096, MISC_OFF = RING_BYTES + 15360, LDS_BYTES = 147456;

struct Params {
    const float *x, *norm1_g, *w_in, *conv_w, *conv_b, *w_rg_a, *b_rg_a, *w_rg_x, *b_rg_x, *lru_lambda, *rel_bias,
        *g_rec_out, *g_att_out, *w_out, *norm2_g, *w_group, *b_group, *w_router, *b_router, *w_e_gate, *w_e_up, *w_e_down, *final_g;
    float* out;
    unsigned char* ws;
};

__device__ __forceinline__ float wave_sum(float v) {
#pragma unroll
    for (int o = 32; o > 0; o >>= 1) v += __shfl_xor(v, o);
    return v;
}
__device__ __forceinline__ float sigmoidf_(float x) { return 1.0f / (1.0f + expf(-x)); }
__device__ __forceinline__ float gelu_tanh(float x) { return 0.5f * x * (1.0f + tanhf(0.7978845608028654f * (x + 0.044715f * x * x * x))); }
__device__ __forceinline__ unsigned f2bf(float f) { unsigned u = __builtin_bit_cast(unsigned, f); return (u + 0x7fffu + ((u >> 16) & 1u)) >> 16; }
__device__ __forceinline__ unsigned pk2(float lo, float hi) { return f2bf(lo) | (f2bf(hi) << 16); }
__device__ __forceinline__ float bf2f(bf16_t b) { return __builtin_bit_cast(float, ((unsigned)b) << 16); }
__device__ __forceinline__ unsigned cvt_pk_bf16(float lo, float hi) { unsigned r; asm volatile("v_cvt_pk_bf16_f32 %0, %1, %2" : "=v"(r) : "v"(lo), "v"(hi)); return r; }
#define LDS_WAIT() asm volatile("s_waitcnt lgkmcnt(0)" ::: "memory")
__device__ __forceinline__ int opaque_tid() { int t = threadIdx.x; asm volatile("" : "+v"(t)); return t; }

namespace pg8 {
constexpr int BM = 256, BK = 64, HALF = 128, HTB = HALF * BK * 2, STAGE_BYTES = 8 * HTB, NXCD = 8, WGM = 8;
__device__ __forceinline__ int lds_byte(int r, int c) { const int st = (r >> 4) * 2 + (c >> 5), rr = r & 15, cc = c & 31, ob = rr * 64 + cc * 2; return st * 1024 + (ob ^ (((ob >> 9) & 1) << 5)); }
__device__ __forceinline__ void stage_rc(int b, int& R, int& C) { const int st = b / 1024, sb = b % 1024, swz = sb ^ (((sb >> 9) & 1) << 5); R = (st >> 1) * 16 + swz / 64; C = (st & 1) * 32 + (swz % 64) / 2; }
__device__ __forceinline__ int perm32(int rho) { const int n = rho >> 4, i = rho & 15; return 8 * (i >> 2) + 4 * n + (i & 3); }

struct Unit { int pm, pn, e, rows; };

struct DenseOrder {
    const bf16_t* A; const bf16_t* Bt; int K; int nM, nN, nwg, G, c;
    __device__ void init(const bf16_t* A_, const bf16_t* Bt_, int M, int N, int K_, int G_, int c_) { A = A_; Bt = Bt_; K = K_; nM = M / BM; nN = N / BM; nwg = nM * nN; G = G_; c = c_; }
    __device__ __forceinline__ bool next(int i, Unit& u) const {
        const long L = (long)i * G + c; if (L >= nwg) return false;
        int wgid = (int)L; { const int q = nwg / NXCD, r = nwg % NXCD, xcd = wgid % NXCD, off = wgid / NXCD; wgid = (xcd < r ? xcd * (q + 1) : r * (q + 1) + (xcd - r) * q) + off; }
        const int nig = WGM * nN, gid = wgid / nig, fm = gid * WGM, gsz = (nM - fm) < WGM ? (nM - fm) : WGM;
        u.pm = fm + ((wgid % nig) % gsz); u.pn = (wgid % nig) / gsz; u.e = 0; u.rows = BM; return true;
    }
    __device__ __forceinline__ void addr(const Unit& u, const int (&RA)[2], const int (&CA)[2], const char*& aBase, const char*& bBase, unsigned (&va)[2][2]) const {
        aBase = (const char*)A; bBase = (const char*)Bt + (size_t)u.pn * BM * K * 2;
#pragma unroll
        for (int h = 0; h < 2; ++h)
#pragma unroll
            for (int i = 0; i < 2; ++i) va[h][i] = (unsigned)(((size_t)(u.pm * BM + h * HALF + RA[i]) * K + CA[i]) * 2);
    }
};

template <class Epi, class Sched>
__device__ __forceinline__ void gemm_phase(LAS unsigned char* lds, const int K, const Sched& S, const Epi& E) {
    int tid_ = threadIdx.x; asm volatile("" : "+v"(tid_));
    const int tid = tid_, wid = __builtin_amdgcn_readfirstlane(tid >> 6), lane = tid & 63, wr = wid >> 2, wc = wid & 3, fr = lane & 15, fq = lane >> 4;
    const int nt = K / BK;
    int RA[2], CA[2]; unsigned voffB[2];
#pragma unroll
    for (int i = 0; i < 2; ++i) { int R, C; stage_rc(tid * 16 + i * 8192, R, C); RA[i] = R; CA[i] = C; const int Rb = Epi::PERM ? ((R & ~31) + perm32(R & 31)) : R; voffB[i] = (unsigned)(Rb * K + C) * 2u; }
    const size_t kstep = (size_t)(BK * 2);
    const size_t hstepB = (size_t)HALF * K * 2;
    const unsigned ldsw = (unsigned)wid * 1024u;
    const int aoff = lds_byte(wr * 64 + fr, fq * 8), boff = lds_byte(wc * 32 + fr, fq * 8);
#define PG8_SA(b, h) (((b) * 2 + (h)) * HTB)
#define PG8_SB(b, h) ((4 + (b) * 2 + (h)) * HTB)
#define PG8_STAGE_B(bufoff, gbase) do { _Pragma("unroll") for (int _i = 0; _i < 2; ++_i) \
        __builtin_amdgcn_global_load_lds((const unsigned*)((const char*)(gbase) + voffB[_i]), (LAS unsigned*)(lds + (bufoff) + ldsw + _i * 8192), 16, 0, 0); } while (0)
#define PG8_STAGE_A(bufoff, gbase, v0, v1) do { \
        __builtin_amdgcn_global_load_lds((const unsigned*)((const char*)(gbase) + (v0)), (LAS unsigned*)(lds + (bufoff) + ldsw), 16, 0, 0); \
        __builtin_amdgcn_global_load_lds((const unsigned*)((const char*)(gbase) + (v1)), (LAS unsigned*)(lds + (bufoff) + ldsw + 8192), 16, 0, 0); } while (0)
#define PG8_LDA(dst, b, h) do { _Pragma("unroll") for (int m = 0; m < 4; ++m) _Pragma("unroll") for (int k = 0; k < 2; ++k) dst[m][k] = *(const LAS bf16x8*)(lds + PG8_SA(b, h) + aoff + m * 2048 + k * 1024); } while (0)
#define PG8_LDB(dst, b, h) do { _Pragma("unroll") for (int n = 0; n < 2; ++n) _Pragma("unroll") for (int k = 0; k < 2; ++k) dst[n][k] = *(const LAS bf16x8*)(lds + PG8_SB(b, h) + boff + n * 2048 + k * 1024); } while (0)
#define PG8_MMA(ai, bj, At, Bt) do { __builtin_amdgcn_s_setprio(1); _Pragma("unroll") for (int m = 0; m < 4; ++m) _Pragma("unroll") for (int n = 0; n < 2; ++n) _Pragma("unroll") for (int k = 0; k < 2; ++k) \
        acc[ai][bj][m][n] = __builtin_amdgcn_mfma_f32_16x16x32_bf16(Bt[n][k], At[m][k], acc[ai][bj][m][n], 0, 0, 0); __builtin_amdgcn_s_setprio(0); } while (0)
#define PG8_WAIT_V(n) asm volatile("s_waitcnt vmcnt(" #n ")" ::: "memory")
#define PG8_WAIT_L(n) asm volatile("s_waitcnt lgkmcnt(" #n ")" ::: "memory")
#define PG8_BAR __builtin_amdgcn_s_barrier()
#define PG8_SCHED __builtin_amdgcn_sched_barrier(0)
    Unit cur, nxt; int ui = 0;
    if (!S.next(0, cur)) return;
    f32x4 acc[2][2][4][2];
#pragma unroll
    for (int a = 0; a < 2; ++a)
#pragma unroll
        for (int b = 0; b < 2; ++b)
#pragma unroll
            for (int m = 0; m < 4; ++m)
#pragma unroll
                for (int n = 0; n < 2; ++n) acc[a][b][m][n] = (f32x4){0.f, 0.f, 0.f, 0.f};
    bf16x8 At[4][2], B0[2][2], B1[2][2];
    const char *cA, *cB, *nA, *nB; unsigned cva[2][2], nva[2][2];
    S.addr(cur, RA, CA, cA, cB, cva);
    E.prepare(cur, ui, lds);
    PG8_STAGE_B(PG8_SB(0, 0), cB); PG8_STAGE_A(PG8_SA(0, 0), cA, cva[0][0], cva[0][1]); PG8_STAGE_B(PG8_SB(0, 1), cB + hstepB); PG8_STAGE_A(PG8_SA(0, 1), cA, cva[1][0], cva[1][1]);
    if (wr == 1) PG8_BAR;
    PG8_WAIT_V(4); PG8_BAR;
    PG8_STAGE_B(PG8_SB(1, 0), cB + kstep); PG8_STAGE_A(PG8_SA(1, 0), cA + kstep, cva[0][0], cva[0][1]); PG8_STAGE_B(PG8_SB(1, 1), cB + hstepB + kstep);
    PG8_WAIT_V(6); PG8_BAR;
    for (;;) {
        const bool has_next = S.next(ui + 1, nxt);
        if (has_next) { S.addr(nxt, RA, CA, nA, nB, nva); }
        else { nA = cA; nB = cB;
#pragma unroll
            for (int h = 0; h < 2; ++h)
#pragma unroll
                for (int i = 0; i < 2; ++i) nva[h][i] = cva[h][i]; }
        for (int t = 0; t < nt; t += 2) {
            const bool last = (t == nt - 2);
            if (Epi::MIDSCALE && t == nt / 2) E.midscale(acc, wr, fr, ui, lds);
            const char* a1 = cA + (size_t)(t + 1) * kstep;
            const char* a2 = last ? nA : cA + (size_t)(t + 2) * kstep; const char* b2 = last ? nB : cB + (size_t)(t + 2) * kstep;
            const char* a3 = a2 + kstep; const char* b3 = b2 + kstep;
            const unsigned x00 = last ? nva[0][0] : cva[0][0], x01 = last ? nva[0][1] : cva[0][1], x10 = last ? nva[1][0] : cva[1][0], x11 = last ? nva[1][1] : cva[1][1];
            if (last && has_next) E.prepare(nxt, ui + 1, lds);
            PG8_LDB(B0, 0, 0); PG8_SCHED; PG8_LDA(At, 0, 0); PG8_STAGE_A(PG8_SA(1, 1), a1, cva[1][0], cva[1][1]);
            PG8_WAIT_L(8); PG8_BAR; PG8_WAIT_L(0); PG8_MMA(0, 0, At, B0); PG8_BAR; PG8_SCHED;
            PG8_LDB(B1, 0, 1); PG8_STAGE_B(PG8_SB(0, 0), b2);
            PG8_BAR; PG8_WAIT_L(0); PG8_MMA(0, 1, At, B1); PG8_BAR;
            PG8_LDA(At, 0, 1); PG8_STAGE_A(PG8_SA(0, 0), a2, x00, x01);
            PG8_BAR; PG8_WAIT_L(0); PG8_MMA(1, 0, At, B0); PG8_BAR; PG8_SCHED;
            PG8_STAGE_B(PG8_SB(0, 1), b2 + hstepB);
            PG8_WAIT_V(6); PG8_BAR; PG8_MMA(1, 1, At, B1); PG8_BAR;
            PG8_LDB(B0, 1, 0); PG8_SCHED; PG8_LDA(At, 1, 0); PG8_STAGE_A(PG8_SA(0, 1), a2, x10, x11);
            PG8_WAIT_L(8); PG8_BAR; PG8_WAIT_L(0); PG8_MMA(0, 0, At, B0); PG8_BAR; PG8_SCHED;
            PG8_LDB(B1, 1, 1); PG8_STAGE_B(PG8_SB(1, 0), b3);
            PG8_BAR; PG8_WAIT_L(0); PG8_MMA(0, 1, At, B1); PG8_BAR;
            PG8_LDA(At, 1, 1); PG8_STAGE_A(PG8_SA(1, 0), a3, x00, x01);
            PG8_BAR; PG8_WAIT_L(0); PG8_MMA(1, 0, At, B0); PG8_BAR; PG8_SCHED;
            PG8_STAGE_B(PG8_SB(1, 1), b3 + hstepB);
            PG8_WAIT_V(6); PG8_BAR; PG8_MMA(1, 1, At, B1); PG8_BAR;
        }
        E(acc, cur, wr, wc, fr, fq, ui, lds);
        if (!has_next) break;
#pragma unroll
        for (int a = 0; a < 2; ++a)
#pragma unroll
            for (int b = 0; b < 2; ++b)
#pragma unroll
                for (int m = 0; m < 4; ++m)
#pragma unroll
                    for (int n = 0; n < 2; ++n) acc[a][b][m][n] = (f32x4){0.f, 0.f, 0.f, 0.f};
        cur = nxt; cA = nA; cB = nB; ++ui;
#pragma unroll
        for (int h = 0; h < 2; ++h)
#pragma unroll
            for (int i = 0; i < 2; ++i) cva[h][i] = nva[h][i];
    }
    PG8_WAIT_V(0);
    if (wr == 0) PG8_BAR;
    PG8_BAR;
#undef PG8_SA
#undef PG8_SB
#undef PG8_STAGE_A
#undef PG8_STAGE_B
#undef PG8_LDA
#undef PG8_LDB
#undef PG8_MMA
#undef PG8_WAIT_V
#undef PG8_WAIT_L
#undef PG8_BAR
#undef PG8_SCHED
}

struct EpiZ {
    static constexpr bool PERM = true, MIDSCALE = false;
    bf16_t* O; int ldc;
    __device__ __forceinline__ void prepare(const Unit&, int, LAS unsigned char*) const {}
    __device__ __forceinline__ void midscale(f32x4 (&)[2][2][4][2], int, int, int, LAS unsigned char*) const {}
    __device__ __forceinline__ void operator()(const f32x4 (&acc)[2][2][4][2], const Unit& u, int wr, int wc, int fr, int fq, int, LAS unsigned char*) const {
        const int row0 = u.pm * BM + wr * 64 + fr, col0 = u.pn * BM + wc * 32 + 8 * fq;
#pragma unroll
        for (int ai = 0; ai < 2; ++ai)
#pragma unroll
            for (int m = 0; m < 4; ++m) { bf16_t* rowp = O + (size_t)(row0 + ai * HALF + m * 16) * ldc + col0;
#pragma unroll
                for (int bj = 0; bj < 2; ++bj) { const f32x4 v0 = acc[ai][bj][m][0], v1 = acc[ai][bj][m][1];
                    u32x4 w; w.x = cvt_pk_bf16(v0[0], v0[1]); w.y = cvt_pk_bf16(v0[2], v0[3]); w.z = cvt_pk_bf16(v1[0], v1[1]); w.w = cvt_pk_bf16(v1[2], v1[3]);
                    *(u32x4*)(rowp + bj * HALF) = w; } }
    }
};
struct EpiH {
    static constexpr bool PERM = false, MIDSCALE = true;
    unsigned char* ws; float* part; int tab_off;
    __device__ __forceinline__ void prepare(const Unit& u, int ui, LAS unsigned char* lds) const {
        LAS f32x4* tab = (LAS f32x4*)(lds + tab_off) + (ui & 1) * 256;
        unsigned long long wsb = (unsigned long long)ws; asm volatile("" : "+s"(wsb));
        const float* ssq = (const float*)(wsb + WS_SSQ); const float* rinv1 = (const float*)(wsb + WS_GWT + 256 * 1024);
        if (threadIdx.x < 256) {
            const float* sp = ssq + (size_t)(u.pm * BM + threadIdx.x) * SSQW; float sa = 0.f, sb = 0.f;
#pragma unroll
            for (int i = 0; i < 8; ++i) { const f32x4 v = *(const f32x4*)(sp + 4 * i); sa += (v[0] + v[1]) + (v[2] + v[3]); }
#pragma unroll
            for (int i = 8; i < 10; ++i) { const f32x4 v = *(const f32x4*)(sp + 4 * i); sb += (v[0] + v[1]) + (v[2] + v[3]); }
            const float ra = rsqrtf(sa * (1.0f / 512.0f) + EPS), rb = rsqrtf(sb * (1.0f / 512.0f) + EPS);
            tab[threadIdx.x] = (f32x4){ra / rb, rb, rinv1[u.pm * BM + threadIdx.x], 0.f};
        }
    }
    __device__ __forceinline__ void midscale(f32x4 (&acc)[2][2][4][2], int wr, int fr, int ui, LAS unsigned char* lds) const {
        const LAS f32x4* tab = (const LAS f32x4*)(lds + tab_off) + (ui & 1) * 256;
#pragma unroll
        for (int ai = 0; ai < 2; ++ai)
#pragma unroll
            for (int m = 0; m < 4; ++m) { const float s = tab[ai * HALF + wr * 64 + m * 16 + fr][0];
#pragma unroll
                for (int bj = 0; bj < 2; ++bj)
#pragma unroll
                    for (int n = 0; n < 2; ++n) acc[ai][bj][m][n] = acc[ai][bj][m][n] * s; }
    }
    __device__ __forceinline__ void operator()(const f32x4 (&acc)[2][2][4][2], const Unit& u, int wr, int wc, int fr, int fq, int ui, LAS unsigned char* lds) const {
        const LAS f32x4* tab = (const LAS f32x4*)(lds + tab_off) + (ui & 1) * 256;
        const float* rwt = (const float*)(ws + WS_RWT); bf16_t* hb = (bf16_t*)(ws + WS_XB);
        const int row0 = u.pm * BM + wr * 64 + fr, col0 = u.pn * BM + wc * 32 + 4 * fq;
        float br[2][2][4], bg[2][2][4];
#pragma unroll
        for (int bj = 0; bj < 2; ++bj)
#pragma unroll
            for (int n = 0; n < 2; ++n)
#pragma unroll
                for (int j = 0; j < 4; ++j) { const int c = col0 + bj * HALF + n * 16 + j; br[bj][n][j] = rwt[fr * 1028 + c]; bg[bj][n][j] = rwt[(16 + (fr & 3)) * 1028 + c]; }
#pragma unroll
        for (int am = 0; am < 4; ++am) { const int ai = am >> 1;
            u32x2 xv[4][2][2];
#pragma unroll
            for (int m = 2 * (am & 1); m < 2 * (am & 1) + 2; ++m)
#pragma unroll
                for (int bj = 0; bj < 2; ++bj)
#pragma unroll
                    for (int n = 0; n < 2; ++n) xv[m][bj][n] = *(const u32x2*)(hb + (size_t)(row0 + ai * HALF + m * 16) * D + col0 + bj * HALF + n * 16);
#pragma unroll
            for (int m = 2 * (am & 1); m < 2 * (am & 1) + 2; ++m) { const f32x4 tv = tab[ai * HALF + wr * 64 + m * 16 + fr]; const float s = tv[1], ri = tv[2]; const size_t ro = (size_t)(row0 + ai * HALF + m * 16) * D + col0;
                f32x4 ar = {0.f, 0.f, 0.f, 0.f}, ag = {0.f, 0.f, 0.f, 0.f}; float ssl = 0.f;
#pragma unroll
                for (int bj = 0; bj < 2; ++bj)
#pragma unroll
                    for (int n = 0; n < 2; ++n) { const u32x2 xr = xv[m][bj][n];
                        const f32x4 xf = {__builtin_bit_cast(float, xr[0] << 16), __builtin_bit_cast(float, xr[0] & 0xffff0000u), __builtin_bit_cast(float, xr[1] << 16), __builtin_bit_cast(float, xr[1] & 0xffff0000u)};
                        const f32x4 hv = xf * ri + acc[ai][bj][m][n] * s;
                        *(u32x2*)(hb + ro + bj * HALF + n * 16) = (u32x2){cvt_pk_bf16(hv[0], hv[1]), cvt_pk_bf16(hv[2], hv[3])};
#pragma unroll
                        for (int j = 0; j < 4; ++j) { ar = __builtin_amdgcn_mfma_f32_16x16x4f32(hv[j], br[bj][n][j], ar, 0, 0, 0); ag = __builtin_amdgcn_mfma_f32_16x16x4f32(hv[j], bg[bj][n][j], ag, 0, 0, 0); ssl += hv[j] * hv[j]; } }
                ssl += __shfl_xor(ssl, 16); ssl += __shfl_xor(ssl, 32);
                float* prow = part + ((size_t)(u.pm * BM + ai * HALF + wr * 64 + m * 16) * 16 + (u.pn * 4 + wc)) * 24;
#pragma unroll
                for (int rg_ = 0; rg_ < 4; ++rg_) { float* pr = prow + (size_t)(4 * fq + rg_) * (16 * 24); pr[fr] = ar[rg_]; if (fr < 4) pr[16 + fr] = ag[rg_]; }
                if (fq == 0) prow[(size_t)fr * (16 * 24) + 20] = ssl;
            }
        }
    }
};

template <int MODE>
struct MoeOrder {
    const bf16_t* A; const bf16_t* Bt; const int* tok_list; const LAS int* meta; int K, G, c, ntiles;
    __device__ __forceinline__ bool next(int i, Unit& u) const {
        const int L = i * G + c; if (L >= ntiles * 4) return false;
        const int mt = L >> 2; int e = 0;
#pragma unroll
        for (int j = 1; j < NE; ++j) e += (mt >= meta[j]) ? 1 : 0;
        u.pm = mt; u.pn = L & 3; u.e = e; u.rows = meta[32 + e] - (mt - meta[e]) * BM; return true;
    }
    __device__ __forceinline__ void addr(const Unit& u, const int (&RA)[2], const int (&CA)[2], const char*& aBase, const char*& bBase, unsigned (&va)[2][2]) const {
        aBase = (const char*)A; bBase = (const char*)Bt + ((size_t)u.e * D + (size_t)u.pn * BM) * K * 2;
        const int slot0 = (u.pm - meta[u.e]) * BM;
#pragma unroll
        for (int h = 0; h < 2; ++h)
#pragma unroll
            for (int i = 0; i < 2; ++i) {
                const int r = h * HALF + RA[i];
                if (MODE == 0) { const int tl = tok_list[u.e * T + slot0 + r] >> 1; const int tok = (r < u.rows) ? tl : 0; va[h][i] = (unsigned)(((size_t)tok * K + CA[i]) * 2); }
                else va[h][i] = (unsigned)(((size_t)(u.pm * BM + r) * K + CA[i]) * 2);
            }
    }
};
struct EpiHid {
    static constexpr bool PERM = true, MIDSCALE = false;
    bf16_t* hid; const float* r_list; const LAS int* meta;
    __device__ __forceinline__ void prepare(const Unit&, int, LAS unsigned char*) const {}
    __device__ __forceinline__ void midscale(f32x4 (&)[2][2][4][2], int, int, int, LAS unsigned char*) const {}
    __device__ __forceinline__ void operator()(const f32x4 (&acc)[2][2][4][2], const Unit& u, int wr, int wc, int fr, int fq, int, LAS unsigned char*) const {
        const int row0 = u.pm * BM + wr * 64 + fr, j0 = u.pn * 128 + wc * 16 + 4 * fq, slot0 = (u.pm - meta[u.e]) * BM;
        float rsv[2][4];
#pragma unroll
        for (int ai = 0; ai < 2; ++ai)
#pragma unroll
            for (int m = 0; m < 4; ++m) rsv[ai][m] = r_list[u.e * T + slot0 + ai * HALF + wr * 64 + m * 16 + fr];
#pragma unroll
        for (int ai = 0; ai < 2; ++ai)
#pragma unroll
            for (int m = 0; m < 4; ++m) { bf16_t* rowp = hid + (size_t)(row0 + ai * HALF + m * 16) * DFF + j0;
                const int r = ai * HALF + wr * 64 + m * 16 + fr; const float rs = (r < u.rows) ? rsv[ai][m] : 0.f;
#pragma unroll
                for (int bj = 0; bj < 2; ++bj) { const f32x4 g = acc[ai][bj][m][0] * rs, up = acc[ai][bj][m][1] * rs; float hv[4];
#pragma unroll
                    for (int q = 0; q < 4; ++q) hv[q] = g[q] * up[q] * __builtin_amdgcn_rcpf(1.0f + __expf(-g[q]));
                    *(u32x2*)(rowp + bj * 64) = (u32x2){cvt_pk_bf16(hv[0], hv[1]), cvt_pk_bf16(hv[2], hv[3])}; } }
    }
};
struct EpiY {
    static constexpr bool PERM = true, MIDSCALE = false;
    bf16_t* y2; const int* tok_list; const float* w_list; const LAS int* meta;
    __device__ __forceinline__ void prepare(const Unit&, int, LAS unsigned char*) const {}
    __device__ __forceinline__ void midscale(f32x4 (&)[2][2][4][2], int, int, int, LAS unsigned char*) const {}
    __device__ __forceinline__ void operator()(const f32x4 (&acc)[2][2][4][2], const Unit& u, int wr, int wc, int fr, int fq, int, LAS unsigned char*) const {
        const int slot0 = (u.pm - meta[u.e]) * BM, col0 = u.pn * BM + wc * 32 + 8 * fq;
        int dstv[2][4]; float wv[2][4];
#pragma unroll
        for (int ai = 0; ai < 2; ++ai)
#pragma unroll
            for (int m = 0; m < 4; ++m) { const int li = u.e * T + slot0 + ai * HALF + wr * 64 + m * 16 + fr; dstv[ai][m] = tok_list[li]; wv[ai][m] = w_list[li]; }
#pragma unroll
        for (int ai = 0; ai < 2; ++ai)
#pragma unroll
            for (int m = 0; m < 4; ++m) { const int r = ai * HALF + wr * 64 + m * 16 + fr;
                if (r < u.rows) { const int dst = dstv[ai][m]; const float w = wv[ai][m]; bf16_t* rowp = y2 + (size_t)dst * D + col0;
#pragma unroll
                    for (int bj = 0; bj < 2; ++bj) { const f32x4 v0 = acc[ai][bj][m][0] * w, v1 = acc[ai][bj][m][1] * w;
                        u32x4 o; o.x = cvt_pk_bf16(v0[0], v0[1]); o.y = cvt_pk_bf16(v0[2], v0[3]); o.z = cvt_pk_bf16(v1[0], v1[1]); o.w = cvt_pk_bf16(v1[2], v1[3]);
                        *(u32x4*)(rowp + bj * HALF) = o; } } }
    }
};
}

struct RowId { int off; __device__ __forceinline__ int operator()(int n) const { return off + n; } };
struct RowGU { int up; __device__ __forceinline__ int operator()(int j) const { return (j >> 2) * 8 + (j & 3) + 4 * up; } };

struct TItem { const float* src; const float* gp; bf16_t* dst; int N, K, rmk; };
__device__ __forceinline__ TItem p0_decode(const Params& p, int it) {
    constexpr int I_IN = (D / 64) * (INW / 32), I_OUT = (D / 64) * (D / 32), I_G = (D / 64) * (DFF / 32), I_D = (DFF / 64) * (D / 32), I_E = 2 * I_G + I_D;
    const float* W; const float* g; bf16_t* WT; int K, N, rmk, idx;
    if (it < I_IN) { W = p.w_in; g = p.norm1_g; WT = (bf16_t*)(p.ws + WS_WIN); K = D; N = INW; rmk = 0; idx = it; }
    else if (it < I_IN + I_OUT) { W = p.w_out; g = nullptr; WT = (bf16_t*)(p.ws + WS_WOUT); K = D; N = D; rmk = 0; idx = it - I_IN; }
    else if (it < I_IN + I_OUT + NE * 2 * I_G) { const int r = it - I_IN - I_OUT, e = r / (2 * I_G), q = r % (2 * I_G);
        if (q < I_G) { W = p.w_e_gate + (size_t)e * D * DFF; g = p.norm2_g; WT = (bf16_t*)(p.ws + WS_WGU) + (size_t)e * D * D; K = D; N = DFF; rmk = 1; idx = q; }
        else { W = p.w_e_up + (size_t)e * D * DFF; g = p.norm2_g; WT = (bf16_t*)(p.ws + WS_WGU) + (size_t)e * D * D; K = D; N = DFF; rmk = 2; idx = q - I_G; } }
    else { const int r = it - I_IN - I_OUT - NE * 2 * I_G, e = r / I_D; idx = r % I_D;
        W = p.w_e_down + (size_t)e * DFF * D; g = nullptr; WT = (bf16_t*)(p.ws + WS_WD) + (size_t)e * D * DFF; K = DFF; N = D; rmk = 0; }
    const int nblk = N / 32, kb = idx / nblk, nb = idx % nblk, k0 = 64 * kb, n0 = 32 * nb;
    TItem t; t.src = W + (size_t)k0 * N + n0; t.dst = WT + k0; t.N = N; t.K = K; t.rmk = rmk;
    t.gp = g ? g + k0 : nullptr;
    if (it >= I_IN && it < I_IN + I_OUT) t.gp = (k0 < 512) ? p.g_rec_out + k0 : p.g_att_out + (k0 - 512);
    t.rmk = rmk | (n0 << 4);
    return t;
}
__device__ __forceinline__ void p0_load(const TItem& t, f32x4 (&ld)[8], float (&gv)[8], int lane) {
#pragma unroll
    for (int i = 0; i < 8; ++i) ld[i] = *(const f32x4*)(t.src + (size_t)(8 * i + (lane >> 3)) * t.N + 4 * (lane & 7));
    if (t.gp) {
#pragma unroll
        for (int i = 0; i < 8; ++i) gv[i] = t.gp[8 * i + (lane >> 3)];
    } else {
#pragma unroll
        for (int i = 0; i < 8; ++i) gv[i] = 1.0f;
    }
}
__device__ __forceinline__ void p0_process(const TItem& t, const f32x4 (&ld)[8], const float (&gv)[8], LAS float* scr, int lane) {
#pragma unroll
    for (int i = 0; i < 8; ++i) { const int kk = 8 * i + (lane >> 3); const f32x4 v = ld[i] * gv[i];
        LAS float* d = scr + kk * 33 + 4 * (lane & 7); d[0] = v[0]; d[1] = v[1]; d[2] = v[2]; d[3] = v[3]; }
    LDS_WAIT(); asm volatile("" ::: "memory");
    const int c = lane & 7, n0 = t.rmk >> 4, rmk = t.rmk & 15;
#pragma unroll
    for (int j = 0; j < 4; ++j) { const int n = (lane >> 3) + 8 * j; const LAS float* s = scr + (8 * c) * 33 + n;
        u32x4 o; o.x = pk2(s[0 * 33], s[1 * 33]); o.y = pk2(s[2 * 33], s[3 * 33]); o.z = pk2(s[4 * 33], s[5 * 33]); o.w = pk2(s[6 * 33], s[7 * 33]);
        const int nn = n0 + n, row = (rmk == 0) ? nn : ((nn >> 2) * 8 + (nn & 3) + 4 * (rmk - 1));
        *(u32x4*)(t.dst + (size_t)row * t.K + 8 * c) = o; }
    LDS_WAIT(); asm volatile("" ::: "memory");
}

__device__ __forceinline__ void p0_convert_range(const Params& p, LAS float* scr, int it0, int it1, int gw, int ngw, int lane) {
    int it = it0 + gw; TItem cur; f32x4 la[8]; float ga[8];
    if (it < it1) { cur = p0_decode(p, it); p0_load(cur, la, ga, lane); }
    while (it < it1) {
        const int nit = it + ngw; TItem nxt = cur; f32x4 lb[8]; float gb[8];
        const bool has = nit < it1;
        if (has) { nxt = p0_decode(p, nit); p0_load(nxt, lb, gb, lane); }
        p0_process(cur, la, ga, scr, lane);
        if (has) { cur = nxt;
#pragma unroll
            for (int i = 0; i < 8; ++i) { la[i] = lb[i]; ga[i] = gb[i]; } }
        it = nit;
    }
}

__device__ __forceinline__ void ph_prologue(const Params& p, LAS unsigned char* lds, int vcu, int G, int e_split) {
    const int tid = opaque_tid(), lane = tid & 63, wave = tid >> 6;
    LAS float* scr = (LAS float*)(lds + wave * 16384);
    const int gw = vcu * NWAVES + wave, NGW = G * NWAVES;
    bf16_t* xb = (bf16_t*)(p.ws + WS_XB);
    constexpr int I_IN = (D / 64) * (INW / 32), I_OUT = (D / 64) * (D / 32), I_G = (D / 64) * (DFF / 32), I_D = (DFF / 64) * (D / 32), I_E = 2 * I_G + I_D, I_ALL = I_IN + I_OUT + NE * I_E;
    p0_convert_range(p, scr, 0, I_IN + I_OUT + e_split * 2 * I_G, gw, NGW, lane);
    {
        bf16_t* gwt = (bf16_t*)(p.ws + WS_GWT); float* sp8 = (float*)(p.ws + WS_GWT + 8 * 128 * 144);
        for (int idx = gw * 64 + lane; idx < 8 * 64 * 128; idx += NGW * 64) { const int hb = idx >> 13, k = (idx >> 7) & 63, n = idx & 127;
            const float v = (n < 64) ? p.w_rg_a[(hb * 64 + k) * 64 + n] : p.w_rg_x[(hb * 64 + k) * 64 + n - 64];
            gwt[(hb * 128 + n) * 72 + k] = (bf16_t)f2bf(v); }
        for (int idx = gw * 64 + lane; idx < RW; idx += NGW * 64) sp8[idx] = -8.0f * log1pf(expf(-p.lru_lambda[idx]));
    }
    {
        float* rwt = (float*)(p.ws + WS_RWT);
        for (int idx = gw * 64 + lane; idx < D * 20; idx += NGW * 64) { const int k = idx / 20, n = idx % 20;
            rwt[n * 1028 + k] = (n < 16 ? p.w_router[k * 16 + n] : p.w_group[k * 4 + n - 16]) * p.norm2_g[k]; }
    }
    float* rinv1 = (float*)(p.ws + WS_GWT + 256 * 1024);
    for (int t0 = gw; t0 < T; t0 += 4 * NGW) {
        f32x4 v[4][4];
#pragma unroll
        for (int q = 0; q < 4; ++q) { const int t = t0 + q * NGW; const f32x4* xr = (const f32x4*)(p.x + (size_t)(t < T ? t : t0) * D) + lane;
#pragma unroll
            for (int j = 0; j < 4; ++j) v[q][j] = xr[64 * j]; }
#pragma unroll
        for (int q = 0; q < 4; ++q) { const int t = t0 + q * NGW; float ss = 0.f;
#pragma unroll
            for (int j = 0; j < 4; ++j) ss += (v[q][j][0] * v[q][j][0] + v[q][j][1] * v[q][j][1]) + (v[q][j][2] * v[q][j][2] + v[q][j][3] * v[q][j][3]);
            const float ms = wave_sum(ss) * (1.0f / D) + EPS; const float r = rsqrtf(ms);
            if (t < T) { u32x2* o8 = (u32x2*)(xb + (size_t)t * D) + lane; if (lane == 0) rinv1[t] = __builtin_amdgcn_sqrtf(ms);
#pragma unroll
                for (int j = 0; j < 4; ++j) o8[64 * j] = (u32x2){pk2(v[q][j][0] * r, v[q][j][1] * r), pk2(v[q][j][2] * r, v[q][j][3] * r)}; }
        }
    }
}

__device__ __forceinline__ void p1_tail_convert(const Params& p, LAS unsigned char* lds, int idle_idx, int n_idle, int e_split) {
    const int tid = opaque_tid(), lane = tid & 63, wave = tid >> 6;
    constexpr int I_IN = (D / 64) * (INW / 32), I_OUT = (D / 64) * (D / 32), I_G = (D / 64) * (DFF / 32), I_D = (DFF / 64) * (D / 32), I_E = 2 * I_G + I_D, I_ALL = I_IN + I_OUT + NE * I_E;
    p0_convert_range(p, (LAS float*)(lds + wave * 16384), I_IN + I_OUT + e_split * 2 * I_G, I_IN + I_OUT + NE * 2 * I_G, idle_idx * NWAVES + wave, n_idle * NWAVES, lane);
}

__device__ __forceinline__ void p5a_tail_convert(const Params& p, LAS unsigned char* lds, int widx, int n_workers) {
    const int tid = opaque_tid(), lane = tid & 63, wave = tid >> 6;
    constexpr int I_IN = (D / 64) * (INW / 32), I_OUT = (D / 64) * (D / 32), I_G = (D / 64) * (DFF / 32), I_D = (DFF / 64) * (D / 32);
    p0_convert_range(p, (LAS float*)(lds + wave * 16384), I_IN + I_OUT + NE * 2 * I_G, I_IN + I_OUT + NE * 2 * I_G + NE * I_D, widx * NWAVES + wave, n_workers * NWAVES, lane);
}

typedef float f32x16 __attribute__((ext_vector_type(16)));
typedef short v4i16_t __attribute__((ext_vector_type(4)));
typedef __bf16 bf16x2_t __attribute__((ext_vector_type(2)));
#define MFMA32(a, b, c) __builtin_amdgcn_mfma_f32_32x32x16_bf16((a), (b), (c), 0, 0, 0)
__device__ __forceinline__ unsigned cvtpk_s(float lo, float hi) { f32x2 v = {lo, hi}; bf16x2_t b = __builtin_convertvector(v, bf16x2_t); return __builtin_bit_cast(unsigned, b); }
__device__ __forceinline__ int crow(int r, int hh) { return (r & 3) + 8 * (r >> 2) + 4 * hh; }
__device__ __forceinline__ bf16x8 pack8(const f32x16& x, int s) {
    u32x4 w; w.x = cvtpk_s(x[8 * s + 0], x[8 * s + 1]); w.y = cvtpk_s(x[8 * s + 2], x[8 * s + 3]); w.z = cvtpk_s(x[8 * s + 4], x[8 * s + 5]); w.w = cvtpk_s(x[8 * s + 6], x[8 * s + 7]);
    return __builtin_bit_cast(bf16x8, w);
}
__device__ __forceinline__ v4i16_t vtr(LAS const unsigned char* p) { return __builtin_amdgcn_ds_read_tr16_b64_v4i16((LAS v4i16_t*)p); }
constexpr float LOG2E = 1.4426950408889634f;

struct AttnCtx { LAS float* btab; LAS unsigned char* vbase; int lane, h, q32, hh, vb, vw; float bconst; unsigned kl, vl; };
__device__ __forceinline__ AttnCtx attn_setup(const Params& p, LAS unsigned char* lds, int tab_off) {
    int tid_ = threadIdx.x; asm volatile("" : "+v"(tid_));
    AttnCtx A; const int tid = tid_; A.lane = tid & 63; A.h = __builtin_amdgcn_readfirstlane(tid >> 6); A.q32 = A.lane & 31; A.hh = A.lane >> 5;
    A.btab = (LAS float*)(lds + tab_off) + A.h * 328;
    for (int i = A.lane; i < 2 * MAXREL + 1 + 64; i += 64) A.btab[i] = p.rel_bias[A.h * (2 * MAXREL + 1) + (i > 2 * MAXREL ? 2 * MAXREL : i)] * LOG2E;
    LDS_WAIT(); asm volatile("" ::: "memory");
    A.vbase = lds + A.h * 16384;
    A.vb = ((A.lane >> 4) & 1) * 32 + (A.lane & 3) * 8 + (4 * A.hh + ((A.lane & 15) >> 2)) * 128;
    A.vw = (A.lane >> 3) * 128 + (A.lane & 7) * 16;
    A.bconst = A.btab[2 * MAXREL];
    A.kl = (unsigned)((A.q32 * INW + 8 * A.hh) * 2);
    A.vl = (unsigned)(((A.lane >> 3) * INW + (A.lane & 7) * 8) * 2) + 1024u;
    return A;
}
__device__ __forceinline__ void attn_item(const AttnCtx& A, const bf16_t* z, bf16_t* mixb, float* ssq, int b, int c, int qh) {
    const int lane = A.lane, h = A.h, q32 = A.q32, hh = A.hh, vb = A.vb, vw = A.vw; LAS float* btab = A.btab; LAS unsigned char* vbase = A.vbase;
    const float bconst = A.bconst, QS = 0.125f * LOG2E; const unsigned kl = A.kl, vl = A.vl;
    {
        const int j0 = (c >= LEFT) ? 0 : LEFT - c;
        const char* kband = (const char*)z + (((long)b * S + (long)(c - LEFT) * CHUNK) * INW + 1536 + h * 64) * 2;
        {
            const int qi = qh * 32 + q32;
            const size_t tq = (size_t)b * S + c * CHUNK + qi;
            bf16x8 qf[4];
#pragma unroll
            for (int s = 0; s < 4; ++s) { const u32x4 raw = *(const u32x4*)(z + tq * INW + 1024 + h * 64 + 16 * s + 8 * hh); u32x4 w;
#pragma unroll
                for (int e = 0; e < 4; ++e) w[e] = cvtpk_s(__builtin_bit_cast(float, raw[e] << 16) * QS, __builtin_bit_cast(float, raw[e] & 0xffff0000u) * QS);
                qf[s] = __builtin_bit_cast(bf16x8, w); }
            f32x16 o0, o1;
#pragma unroll
            for (int r = 0; r < 16; ++r) { o0[r] = 0.f; o1[r] = 0.f; }
            float m_ref = 0.f, l_run = 0.f;
            constexpr float THR = 6.0f;
            u32x4 kr[8], vr[8];
            const int kw = (lane >> 3) * 128 + (((lane & 7) ^ (lane >> 3)) << 4);
            const int kfo = q32 * 128;
            {
                const char* tb = kband + (long)(64 * j0) * INW * 2;
#pragma unroll
                for (int i = 0; i < 8; ++i) { kr[i] = *(const u32x4*)(tb + ((vl - 1024u) + (unsigned)(i * 8 * INW * 2))); vr[i] = *(const u32x4*)(tb + (vl + (unsigned)(i * 8 * INW * 2))); }
#pragma unroll
                for (int i = 0; i < 8; ++i) { *(LAS u32x4*)(vbase + i * 1024 + kw) = kr[i]; *(LAS u32x4*)(vbase + 8192 + i * 1024 + vw) = vr[i]; }
            }
#pragma unroll 1
            for (int j = j0; j <= LEFT; ++j) {
                if (j < LEFT) {
                    const char* tb = kband + (long)(64 * (j + 1)) * INW * 2;
#pragma unroll
                    for (int i = 0; i < 8; ++i) { kr[i] = *(const u32x4*)(tb + ((vl - 1024u) + (unsigned)(i * 8 * INW * 2))); vr[i] = *(const u32x4*)(tb + (vl + (unsigned)(i * 8 * INW * 2))); }
                }
                bf16x8 kf[8];
#pragma unroll
                for (int kb = 0; kb < 2; ++kb)
#pragma unroll
                    for (int s = 0; s < 4; ++s) kf[kb * 4 + s] = *(const LAS bf16x8*)(vbase + kb * 4096 + kfo + (((2 * s + hh) ^ (q32 & 7)) << 4));
                f32x16 p0, p1;
                if (j <= 5) {
                    const float ci = bconst - m_ref;
#pragma unroll
                    for (int r = 0; r < 16; ++r) { p0[r] = ci; p1[r] = ci; }
                } else {
                    const LAS float* pb0 = btab + (LEFT * CHUNK + qi - 64 * j + MAXREL - 4 * hh - 27); const LAS float* pb1 = pb0 - 32;
#pragma unroll
                    for (int r = 0; r < 16; ++r) { p0[r] = pb0[27 - ((r & 3) + 8 * (r >> 2))] - m_ref; p1[r] = pb1[27 - ((r & 3) + 8 * (r >> 2))] - m_ref; }
                }
#pragma unroll
                for (int s = 0; s < 4; ++s) { p0 = MFMA32(kf[s], qf[s], p0); p1 = MFMA32(kf[4 + s], qf[s], p1); }
                float mt = fmaxf(p0[0], p1[0]);
#pragma unroll
                for (int r = 1; r < 16; ++r) mt = fmaxf(mt, fmaxf(p0[r], p1[r]));
                mt = fmaxf(mt, __shfl_xor(mt, 32));
                const bool first = (j == j0);
                const bool grow = first || (mt > THR);
                if (__any(grow)) {
                    const float d = grow ? mt : 0.f, alpha = first ? 1.0f : __builtin_amdgcn_exp2f(-d);
                    m_ref += d; l_run *= alpha;
#pragma unroll
                    for (int r = 0; r < 16; ++r) { p0[r] -= d; p1[r] -= d; o0[r] *= alpha; o1[r] *= alpha; }
                }
                float ls0 = 0.f, ls1 = 0.f;
#pragma unroll
                for (int r = 0; r < 16; ++r) { p0[r] = __builtin_amdgcn_exp2f(p0[r]); p1[r] = __builtin_amdgcn_exp2f(p1[r]); ls0 += p0[r]; ls1 += p1[r]; }
                l_run += ls0 + ls1;
                const bf16x8 pf0 = pack8(p0, 0), pf1 = pack8(p0, 1), pf2 = pack8(p1, 0), pf3 = pack8(p1, 1);
                LAS const unsigned char* vcur = vbase + 8192 + vb;
#pragma unroll
                for (int db = 0; db < 2; ++db) {
                    v4i16_t lo[4], hi[4];
#pragma unroll
                    for (int ks = 0; ks < 4; ++ks) { lo[ks] = vtr(vcur + ks * 2048 + db * 64); hi[ks] = vtr(vcur + ks * 2048 + 1024 + db * 64); }
#define VF(k) (bf16x8){lo[k][0], lo[k][1], lo[k][2], lo[k][3], hi[k][0], hi[k][1], hi[k][2], hi[k][3]}
                    if (db == 0) { o0 = MFMA32(VF(0), pf0, o0); o0 = MFMA32(VF(1), pf1, o0); o0 = MFMA32(VF(2), pf2, o0); o0 = MFMA32(VF(3), pf3, o0); }
                    else         { o1 = MFMA32(VF(0), pf0, o1); o1 = MFMA32(VF(1), pf1, o1); o1 = MFMA32(VF(2), pf2, o1); o1 = MFMA32(VF(3), pf3, o1); }
#undef VF
                }
                if (j < LEFT) {
#pragma unroll
                    for (int i = 0; i < 8; ++i) { *(LAS u32x4*)(vbase + i * 1024 + kw) = kr[i]; *(LAS u32x4*)(vbase + 8192 + i * 1024 + vw) = vr[i]; }
                }
            }
            const float lt = l_run + __shfl_xor(l_run, 32), inv = 1.0f / lt;
            float ss = 0.f;
            bf16_t* orow = mixb + tq * D + 512 + h * 64 + 4 * hh;
#pragma unroll
            for (int g = 0; g < 4; ++g) {
                const float a0 = o0[4 * g] * inv, a1 = o0[4 * g + 1] * inv, a2 = o0[4 * g + 2] * inv, a3 = o0[4 * g + 3] * inv;
                const float c0 = o1[4 * g] * inv, c1 = o1[4 * g + 1] * inv, c2 = o1[4 * g + 2] * inv, c3 = o1[4 * g + 3] * inv;
                ss += (a0 * a0 + a1 * a1) + (a2 * a2 + a3 * a3) + (c0 * c0 + c1 * c1) + (c2 * c2 + c3 * c3);
                *(u32x2*)(orow + 8 * g) = (u32x2){cvtpk_s(a0, a1), cvtpk_s(a2, a3)};
                *(u32x2*)(orow + 32 + 8 * g) = (u32x2){cvtpk_s(c0, c1), cvtpk_s(c2, c3)};
            }
            ss += __shfl_xor(ss, 32);
            if (hh == 0) ssq[tq * SSQW + 32 + h] = ss;
        }
    }
}


constexpr int RG_WT = 0, RG_IMG = 18432, RG_SEG = 35840, RG_PRE = 44032, RG_CAR = 52224, RG_ROWB = 144, RG_IROW = 272;
__device__ __forceinline__ float fast_sigmoid(float x) { return __builtin_amdgcn_rcpf(1.0f + __expf(-x)); }
__device__ __forceinline__ void rglru_item(const Params& p, const bf16_t* z, bf16_t* mixb, float* ssq, LAS unsigned char* lds, unsigned long long* gran, int b, int hb, int kc) {
    const int tid = opaque_tid(), lane = tid & 63, w = __builtin_amdgcn_readfirstlane(tid >> 6), ch = lane, c16 = lane & 15, tg = lane >> 4;
    LAS f32x2* seg = (LAS f32x2*)(lds + RG_SEG); LAS f32x2* pre = (LAS f32x2*)(lds + RG_PRE); LAS float* car = (LAS float*)(lds + RG_CAR);
    {
        const u32x4* srcw = (const u32x4*)(p.ws + WS_GWT + (size_t)hb * 128 * 144); LAS u32x4* dstw = (LAS u32x4*)(lds + RG_WT);
        for (int idx = tid; idx < 128 * 144 / 16; idx += NTHR) dstw[idx] = srcw[idx];
    }
    const int gch = hb * 64 + ch;
    const float cw0 = p.conv_w[gch], cw1 = p.conv_w[RW + gch], cw2 = p.conv_w[2 * RW + gch], cw3 = p.conv_w[3 * RW + gch], cb = p.conv_b[gch];
    const float* sp8t = (const float*)(p.ws + WS_GWT + 8 * 128 * 144);
    float ba[4], bxb[4], sp8[4];
#pragma unroll
    for (int nb = 0; nb < 4; ++nb) { const int c = hb * 64 + 16 * nb + c16; ba[nb] = p.b_rg_a[c]; bxb[nb] = p.b_rg_x[c]; sp8[nb] = sp8t[c]; }
    LAS unsigned char* img = lds + RG_IMG;
    LAS unsigned char* trb = img + (8 * tg + (c16 >> 2)) * RG_IROW + (16 * w + 4 * (c16 & 3)) * 2;
    const int s0 = kc * 256;
    const bf16_t* ucol = z + ((size_t)b * S + s0) * INW + gch;
    float av[2][4][4], bv[2][4][4], cP[2][4], cH[2][4];
    bf16_t uraw[2][19], graw[2][4][4];
#pragma unroll
    for (int blk = 0; blk < 2; ++blk)
#pragma unroll
        for (int i = 0; i < 19; ++i) { const int s = blk * 128 + 16 * w - 3 + i; uraw[blk][i] = (s0 + s >= 0) ? ucol[(long)s * INW] : (bf16_t)0; }
#pragma unroll
    for (int blk = 0; blk < 2; ++blk)
#pragma unroll
        for (int nb = 0; nb < 4; ++nb)
#pragma unroll
            for (int i = 0; i < 4; ++i) graw[blk][nb][i] = z[((size_t)b * S + s0 + blk * 128 + 16 * w + 4 * tg + i) * INW + 512 + hb * 64 + 16 * nb + c16];
    __syncthreads();
#pragma unroll
    for (int blk = 0; blk < 2; ++blk) {
        const int t0 = blk * 128 + 16 * w;
        float uv[19];
#pragma unroll
        for (int i = 0; i < 19; ++i) uv[i] = bf2f(uraw[blk][i]);
        {
            float uc[16];
#pragma unroll
            for (int i = 0; i < 16; ++i) uc[i] = cb + cw0 * uv[i] + cw1 * uv[i + 1] + cw2 * uv[i + 2] + cw3 * uv[i + 3];
            u32x4 w0, w1;
#pragma unroll
            for (int e = 0; e < 4; ++e) { w0[e] = cvtpk_s(uc[2 * e], uc[2 * e + 1]); w1[e] = cvtpk_s(uc[8 + 2 * e], uc[9 + 2 * e]); }
            *(LAS u32x4*)(img + ch * RG_IROW + 32 * w) = w0; *(LAS u32x4*)(img + ch * RG_IROW + 32 * w + 16) = w1;
        }
        LDS_WAIT(); asm volatile("" ::: "memory");
        const v4i16_t t0lo = vtr(trb), t0hi = vtr(trb + 4 * RG_IROW), t1lo = vtr(trb + 32 * RG_IROW), t1hi = vtr(trb + 36 * RG_IROW);
        const bf16x8 a0 = (bf16x8){t0lo[0], t0lo[1], t0lo[2], t0lo[3], t0hi[0], t0hi[1], t0hi[2], t0hi[3]}, a1 = (bf16x8){t1lo[0], t1lo[1], t1lo[2], t1lo[3], t1hi[0], t1hi[1], t1hi[2], t1hi[3]};
#pragma unroll
        for (int nb = 0; nb < 4; ++nb) {
            const bf16x8 b0a = *(const LAS bf16x8*)(lds + RG_WT + (16 * nb + c16) * RG_ROWB + tg * 16), b1a = *(const LAS bf16x8*)(lds + RG_WT + (16 * nb + c16) * RG_ROWB + tg * 16 + 64);
            const bf16x8 b0x = *(const LAS bf16x8*)(lds + RG_WT + (64 + 16 * nb + c16) * RG_ROWB + tg * 16), b1x = *(const LAS bf16x8*)(lds + RG_WT + (64 + 16 * nb + c16) * RG_ROWB + tg * 16 + 64);
            f32x4 acca = __builtin_amdgcn_mfma_f32_16x16x32_bf16(a0, b0a, (f32x4){0.f, 0.f, 0.f, 0.f}, 0, 0, 0); acca = __builtin_amdgcn_mfma_f32_16x16x32_bf16(a1, b1a, acca, 0, 0, 0);
            f32x4 accx = __builtin_amdgcn_mfma_f32_16x16x32_bf16(a0, b0x, (f32x4){0.f, 0.f, 0.f, 0.f}, 0, 0, 0); accx = __builtin_amdgcn_mfma_f32_16x16x32_bf16(a1, b1x, accx, 0, 0, 0);
            const u32x2 ucr = *(const LAS u32x2*)(img + (16 * nb + c16) * RG_IROW + (16 * w + 4 * tg) * 2);
            const float ucv[4] = {__builtin_bit_cast(float, ucr[0] << 16), __builtin_bit_cast(float, ucr[0] & 0xffff0000u), __builtin_bit_cast(float, ucr[1] << 16), __builtin_bit_cast(float, ucr[1] & 0xffff0000u)};
            float H = 0.f, P = 1.f;
#pragma unroll
            for (int rg_ = 0; rg_ < 4; ++rg_) {
                const float r = fast_sigmoid(acca[rg_] + ba[nb]), ig = fast_sigmoid(accx[rg_] + bxb[nb]);
                const float a = __expf(r * sp8[nb]);
                av[blk][nb][rg_] = a; bv[blk][nb][rg_] = __builtin_amdgcn_sqrtf((1.0f - a) * (1.0f + a)) * (ig * ucv[rg_]);
                H = a * H + bv[blk][nb][rg_]; P *= a; }
            float cp = 1.f, chh = 0.f, Pt = 1.f, Ht = 0.f;
#pragma unroll
            for (int k = 0; k < 4; ++k) { const float Pk = __shfl(P, c16 + 16 * k), Hk = __shfl(H, c16 + 16 * k);
                cp = (k == tg) ? Pt : cp; chh = (k == tg) ? Ht : chh;
                Ht = Pk * Ht + Hk; Pt *= Pk; }
            cP[blk][nb] = cp; cH[blk][nb] = chh;
            if (tg == 0) seg[(blk * 8 + w) * 64 + 16 * nb + c16] = (f32x2){Pt, Ht};
        }
        LDS_WAIT(); asm volatile("" ::: "memory");
    }
    __syncthreads();
    if (tid < 64) {
        float Pp = 1.f, Hp = 0.f;
#pragma unroll
        for (int s = 0; s < 16; ++s) { pre[s * 64 + tid] = (f32x2){Pp, Hp}; const f32x2 sv = seg[s * 64 + tid]; Hp = sv.x * Hp + sv.y; Pp *= sv.x; }
        unsigned long long* g = gran + ((size_t)((b * 8 + hb) * 8 + kc) * 2) * 64 + tid;
        __hip_atomic_store(g, (1ull << 32) | __builtin_bit_cast(unsigned, Pp), __ATOMIC_RELAXED, __HIP_MEMORY_SCOPE_AGENT);
        __hip_atomic_store(g + 64, (1ull << 32) | __builtin_bit_cast(unsigned, Hp), __ATOMIC_RELAXED, __HIP_MEMORY_SCOPE_AGENT);
        float h = 0.f;
        for (int j = 0; j < kc; ++j) {
            const unsigned long long* gj = gran + ((size_t)((b * 8 + hb) * 8 + j) * 2) * 64 + tid;
            unsigned long long vp, vh; unsigned spins = 0;
            for (;;) { vp = __hip_atomic_load(gj, __ATOMIC_RELAXED, __HIP_MEMORY_SCOPE_AGENT); vh = __hip_atomic_load(gj + 64, __ATOMIC_RELAXED, __HIP_MEMORY_SCOPE_AGENT);
                if (__all(((vp >> 32) != 0ull) && ((vh >> 32) != 0ull))) break; __builtin_amdgcn_s_sleep(2); if (++spins > (1u << 20)) break; }
            h = __builtin_bit_cast(float, (unsigned)vp) * h + __builtin_bit_cast(float, (unsigned)vh);
        }
        car[tid] = h;
    }
    __syncthreads();
#pragma unroll
    for (int blk = 0; blk < 2; ++blk) {
        const int t0 = blk * 128 + 16 * w;
        float ysum[4] = {0.f, 0.f, 0.f, 0.f};
#pragma unroll
        for (int nb = 0; nb < 4; ++nb) {
            const int oc = 16 * nb + c16; const f32x2 pf = pre[(blk * 8 + w) * 64 + oc];
            float hcur = cP[blk][nb] * (pf.x * car[oc] + pf.y) + cH[blk][nb];
            bf16_t* orow = mixb + ((size_t)b * S + s0 + t0 + 4 * tg) * D + hb * 64 + oc;
#pragma unroll
            for (int i = 0; i < 4; ++i) { hcur = av[blk][nb][i] * hcur + bv[blk][nb][i];
                const float g = bf2f(graw[blk][nb][i]), u2 = 1.5957691216057308f * (g + 0.044715f * g * g * g);
                const float y = hcur * g * fast_sigmoid(u2);
                orow[(size_t)i * D] = (bf16_t)(cvtpk_s(y, y) & 0xffffu); ysum[i] += y * y; }
        }
#pragma unroll
        for (int i = 0; i < 4; ++i) ysum[i] += __shfl_xor(ysum[i], 1);
#pragma unroll
        for (int i = 0; i < 4; ++i) ysum[i] += __shfl_xor(ysum[i], 2);
#pragma unroll
        for (int i = 0; i < 4; ++i) ysum[i] += __shfl_xor(ysum[i], 4);
#pragma unroll
        for (int i = 0; i < 4; ++i) ysum[i] += __shfl_xor(ysum[i], 8);
        if (c16 == 0) { float* sq = ssq + ((size_t)b * S + s0 + t0 + 4 * tg) * SSQW + hb * 4;
#pragma unroll
            for (int i = 0; i < 4; ++i) *(f32x4*)(sq + (size_t)i * SSQW) = (f32x4){ysum[i], 0.f, 0.f, 0.f}; }
    }
}

constexpr int RT_SUM = 0, RT_REC = 49152;
__device__ __forceinline__ void ph_router3(const Params& p, const float* part, int* gcount, int* tok_list, float* w_list, float* r_list, LAS unsigned char* lds) {
    const int tid = opaque_tid();
    LAS float* sum = (LAS float*)(lds + RT_SUM);
    LAS int* lcnt = (LAS int*)(lds + RT_REC); LAS int* lbase = lcnt + 16; LAS int* rec_e = lcnt + 32; LAS int* rec_s = lcnt + 160; LAS float* rec_w = (LAS float*)(lcnt + 288); LAS float* rec_r = (LAS float*)(lcnt + 416);
    for (int grp = blockIdx.x; grp < T / 64; grp += gridDim.x) {
        if (tid < 16) lcnt[tid] = 0;
        {
            const int tok = tid & 63, pr = tid >> 6;
            const f32x4* a = (const f32x4*)(part + ((size_t)(grp * 64 + tok) * 16 + 2 * pr) * 24);
            f32x4 v[12];
#pragma unroll
            for (int i = 0; i < 12; ++i) v[i] = a[i];
#pragma unroll
            for (int i = 0; i < 6; ++i) *(LAS f32x4*)(sum + (pr * 64 + tok) * 24 + 4 * i) = v[i] + v[6 + i];
        }
        __syncthreads();
        if (tid < 64) {
            float q[24];
#pragma unroll
            for (int i = 0; i < 6; ++i) { f32x4 s4 = *(const LAS f32x4*)(sum + tid * 24 + 4 * i);
#pragma unroll
                for (int pr = 1; pr < 8; ++pr) s4 = s4 + *(const LAS f32x4*)(sum + (pr * 64 + tid) * 24 + 4 * i);
                q[4 * i] = s4[0]; q[4 * i + 1] = s4[1]; q[4 * i + 2] = s4[2]; q[4 * i + 3] = s4[3]; }
            const float rstd = rsqrtf(q[20] * (1.0f / D) + EPS);
            float lg[4];
#pragma unroll
            for (int i = 0; i < 4; ++i) lg[i] = q[16 + i] * rstd + p.b_group[i];
            int gi = 0; float best = lg[0];
#pragma unroll
            for (int i = 1; i < 4; ++i) if (lg[i] > best) { best = lg[i]; gi = i; }
            float den = 0.f;
#pragma unroll
            for (int i = 0; i < 4; ++i) den += expf(lg[i] - best);
            const float pg = 1.0f / den;
            float sel[4];
#pragma unroll
            for (int i = 0; i < 4; ++i) { const float s0 = q[i], s1 = q[4 + i], s2 = q[8 + i], s3 = q[12 + i]; sel[i] = ((gi == 0) ? s0 : (gi == 1) ? s1 : (gi == 2) ? s2 : s3) * rstd + p.b_router[gi * 4 + i]; }
            int i1 = 0; float v1 = sel[0];
#pragma unroll
            for (int i = 1; i < 4; ++i) if (sel[i] > v1) { v1 = sel[i]; i1 = i; }
            int i2 = -1; float v2 = -3.0e38f;
#pragma unroll
            for (int i = 0; i < 4; ++i) if (i != i1 && sel[i] > v2) { v2 = sel[i]; i2 = i; }
            const float e2 = expf(v2 - v1);
            const float w1 = pg / (1.0f + e2), w2 = pg * e2 / (1.0f + e2);
            const int ea = gi * 4 + i1, eb = gi * 4 + i2;
            const int sa = __hip_atomic_fetch_add(lcnt + ea, 1, __ATOMIC_RELAXED, __HIP_MEMORY_SCOPE_WORKGROUP);
            const int sb = __hip_atomic_fetch_add(lcnt + eb, 1, __ATOMIC_RELAXED, __HIP_MEMORY_SCOPE_WORKGROUP);
            rec_e[tid * 2] = ea; rec_s[tid * 2] = sa; rec_w[tid * 2] = w1; rec_r[tid * 2] = rstd;
            rec_e[tid * 2 + 1] = eb; rec_s[tid * 2 + 1] = sb; rec_w[tid * 2 + 1] = w2; rec_r[tid * 2 + 1] = rstd;
        }
        __syncthreads();
        if (tid < 16) lbase[tid] = __hip_atomic_fetch_add(gcount + tid, lcnt[tid], __ATOMIC_RELAXED, __HIP_MEMORY_SCOPE_AGENT);
        __syncthreads();
        if (tid < 128) { const int e = rec_e[tid]; const int pos = lbase[e] + rec_s[tid]; tok_list[e * T + pos] = grp * 128 + tid; w_list[e * T + pos] = rec_w[tid]; r_list[e * T + pos] = rec_r[tid]; }
        __syncthreads();
    }
}
__device__ void ph_final(const Params& p, const bf16_t* hb, const bf16_t* y2, float* out) {
    const int tid = opaque_tid(), lane = tid & 63, wv = tid >> 6;
    constexpr int RPT = 4;
    f32x4 gf[4];
#pragma unroll
    for (int j = 0; j < 4; ++j) gf[j] = *((const f32x4*)p.final_g + lane + 64 * j);
    const int nwv = gridDim.x * NWAVES;
    for (int t0 = blockIdx.x * NWAVES + wv; t0 < T; t0 += nwv * RPT) {
        u32x2 hv[RPT][4], ya[RPT][4], yb[RPT][4];
#pragma unroll
        for (int q = 0; q < RPT; ++q) { const int t = t0 + q * nwv; const int tt = t < T ? t : t0;
            const u32x2* hr = (const u32x2*)(hb + (size_t)tt * D) + lane;
            const u32x2* y0 = (const u32x2*)(y2 + (size_t)(2 * tt) * D) + lane; const u32x2* y1 = (const u32x2*)(y2 + (size_t)(2 * tt + 1) * D) + lane;
#pragma unroll
            for (int j = 0; j < 4; ++j) { hv[q][j] = hr[64 * j]; ya[q][j] = y0[64 * j]; yb[q][j] = y1[64 * j]; } }
#pragma unroll
        for (int q = 0; q < RPT; ++q) { const int t = t0 + q * nwv;
            f32x4 v[4]; float ss = 0.f;
#pragma unroll
            for (int j = 0; j < 4; ++j) { const u32x2 a = ya[q][j], b = yb[q][j], c = hv[q][j];
                v[j][0] = __builtin_bit_cast(float, c[0] << 16) + __builtin_bit_cast(float, a[0] << 16) + __builtin_bit_cast(float, b[0] << 16);
                v[j][1] = __builtin_bit_cast(float, c[0] & 0xffff0000u) + __builtin_bit_cast(float, a[0] & 0xffff0000u) + __builtin_bit_cast(float, b[0] & 0xffff0000u);
                v[j][2] = __builtin_bit_cast(float, c[1] << 16) + __builtin_bit_cast(float, a[1] << 16) + __builtin_bit_cast(float, b[1] << 16);
                v[j][3] = __builtin_bit_cast(float, c[1] & 0xffff0000u) + __builtin_bit_cast(float, a[1] & 0xffff0000u) + __builtin_bit_cast(float, b[1] & 0xffff0000u);
                ss += (v[j][0] * v[j][0] + v[j][1] * v[j][1]) + (v[j][2] * v[j][2] + v[j][3] * v[j][3]); }
            const float r = rsqrtf(wave_sum(ss) * (1.0f / D) + EPS);
            if (t < T) { f32x4* orow = (f32x4*)(out + (size_t)t * D) + lane;
#pragma unroll
                for (int j = 0; j < 4; ++j) orow[64 * j] = v[j] * r * gf[j]; }
        }
    }
}


__device__ __forceinline__ void ph_mixers(const Params& p, const bf16_t* z, bf16_t* mixb, float* ssq, LAS unsigned char* lds, unsigned* qctr) {
    const AttnCtx A = attn_setup(p, lds, TAB_OFF);
    volatile LAS int* qword = (volatile LAS int*)(lds + TAB_OFF + 12288);
    constexpr int NQ = NB, QITEMS = 64 + 64;
    unsigned long long* gran = (unsigned long long*)(p.ws + WS_CTL + 128 * 1024);
    const int qstep = (int)gridDim.x < NQ ? (int)gridDim.x : NQ;
    for (int q = blockIdx.x % NQ; q < NQ; q += qstep) {
        int ticket = 0;
        if (threadIdx.x == 0) ticket = (int)__hip_atomic_fetch_add(qctr + 64 * q, 1u, __ATOMIC_RELAXED, __HIP_MEMORY_SCOPE_AGENT);
        for (;;) {
            __syncthreads();
            if (threadIdx.x == 0) { *qword = ticket; if (ticket < QITEMS) ticket = (int)__hip_atomic_fetch_add(qctr + 64 * q, 1u, __ATOMIC_RELAXED, __HIP_MEMORY_SCOPE_AGENT); }
            __syncthreads();
            const int idx = *qword;
            if (idx >= QITEMS) break;
            if (idx < 64) rglru_item(p, z, mixb, ssq, lds, gran, q, idx & 7, idx >> 3);
            else { const int a = idx - 64; attn_item(A, z, mixb, ssq, q, 31 - (a >> 1), a & 1); }
        }
    }
}

#define XB_TMO      128
#define XB_XCNT(j)  (256  + 64 * (j))
#define XB_XSUB(j)  (1280 + 64 * (j))
#define XB_XGEN(j)  (2304 + 64 * (j))
#define XB_TOP      3328
#define XB_TOPGEN   3392
#define XCD_BAR_WORDS 3456
#define XB_SPIN_CAP (1u << 18)
__device__ __forceinline__ unsigned xb_ld(unsigned* p)              { return __hip_atomic_load(p, __ATOMIC_RELAXED, __HIP_MEMORY_SCOPE_AGENT); }
__device__ __forceinline__ unsigned xb_add(unsigned* p, unsigned v) { return __hip_atomic_fetch_add(p, v, __ATOMIC_RELAXED, __HIP_MEMORY_SCOPE_AGENT); }
__device__ __forceinline__ unsigned xb_xcc_id() { return (unsigned)__builtin_amdgcn_s_getreg((3 << 11) | 20) & 0xFu; }
#define XB_SPIN(cond, bar) do { unsigned _sp = 0; while (cond) { __builtin_amdgcn_s_sleep(1); \
    if ((++_sp & 255u) == 0u) { if (xb_ld(&(bar)[XB_TMO])) break; if (_sp > XB_SPIN_CAP) { atomicAdd(&(bar)[XB_TMO], 1u); break; } } } } while (0)
struct XcdBarrier { unsigned* bar; unsigned x; volatile LAS unsigned* st; };
__device__ __forceinline__ XcdBarrier xcd_barrier_post(unsigned* bar, volatile LAS unsigned* st) {
    XcdBarrier b; b.bar = bar; b.x = xb_xcc_id(); b.st = st;
    if (threadIdx.x == 0) (void)xb_add(&bar[XB_XCNT(b.x)], 1u);
    return b;
}
__device__ __forceinline__ void xcd_barrier_complete(unsigned* bar, unsigned x, unsigned& nloc, unsigned& nx) {
    const unsigned G = gridDim.x * gridDim.y * gridDim.z;
    unsigned sum, cnt, mine, sp = 0u;
    for (;;) {
        sum = 0u; cnt = 0u; mine = 0u;
#pragma unroll
        for (unsigned j = 0; j < 16; ++j) { const unsigned c = xb_ld(&bar[XB_XCNT(j)]); sum += c; cnt += (c > 0u) ? 1u : 0u; mine = (j == x) ? c : mine; }
        if (sum == G) break;
        __builtin_amdgcn_s_sleep(1);
        if ((++sp & 255u) == 0u) { if (xb_ld(&bar[XB_TMO])) break; if (sp > XB_SPIN_CAP) { atomicAdd(&bar[XB_TMO], 1u); break; } }
    }
    nloc = mine > 0u ? mine : 1u; nx = cnt > 0u ? cnt : 1u;
}
__device__ __forceinline__ void xcd_barrier(const XcdBarrier& b) {
    asm volatile("s_waitcnt vmcnt(0)" ::: "memory");
    __syncthreads();
    if (threadIdx.x == 0) {
        unsigned* bar = b.bar;
        __builtin_amdgcn_s_waitcnt(0);
        unsigned nloc = b.st[0], nx = b.st[1];
        if (nloc == 0u) { xcd_barrier_complete(bar, b.x, nloc, nx); b.st[0] = nloc; b.st[1] = nx; }
        const unsigned old = xb_add(&bar[XB_XSUB(b.x)], 1u);
        const unsigned gen = old / nloc;
        if (old + 1u == (gen + 1u) * nloc) {
            __builtin_amdgcn_fence(__ATOMIC_RELEASE, "agent");
            asm volatile("s_waitcnt vmcnt(0)" ::: "memory");
            const unsigned og = xb_add(&bar[XB_TOP], 1u);
            const unsigned tg = og / nx;
            if (og + 1u == (tg + 1u) * nx) xb_add(&bar[XB_TOPGEN], 1u);
            else XB_SPIN(xb_ld(&bar[XB_TOPGEN]) == tg, bar);
            __builtin_amdgcn_fence(__ATOMIC_ACQUIRE, "agent");
            xb_add(&bar[XB_XGEN(b.x)], 1u);
            asm volatile("s_waitcnt vmcnt(0)" ::: "memory");
        } else {
            XB_SPIN(xb_ld(&bar[XB_XGEN(b.x)]) == gen, bar);
            __builtin_amdgcn_fence(__ATOMIC_ACQUIRE, "agent");
            asm volatile("s_waitcnt vmcnt(0)" ::: "memory");
        }
    }
    __syncthreads();
}


__device__ __forceinline__ Params load_params() {
    unsigned long long a = (unsigned long long)__builtin_amdgcn_kernarg_segment_ptr(); asm volatile("" : "+s"(a));
    const __attribute__((address_space(4))) unsigned long long* q = (const __attribute__((address_space(4))) unsigned long long*)a;
    Params p; unsigned long long* d = (unsigned long long*)&p;
#pragma unroll
    for (int i = 0; i < (int)(sizeof(Params) / 8); ++i) d[i] = q[i];
    return p;
}

__global__ void __launch_bounds__(NTHR) k_mega(Params p_arg) {
    extern __shared__ __attribute__((aligned(16))) unsigned char lds_raw[];
    LAS unsigned char* lds = (LAS unsigned char*)lds_raw;
    const int G = gridDim.x; const int bx = blockIdx.x;
    volatile LAS unsigned* misc = (volatile LAS unsigned*)(lds + MISC_OFF);
    if (threadIdx.x < 64) misc[threadIdx.x] = 0u;
    __syncthreads();
    const XcdBarrier xbar = xcd_barrier_post((unsigned*)(load_params().ws + WS_CTL + 65536), misc + 8);
    const int vcu = (G % 8 == 0) ? (bx % 8) * (G / 8) + bx / 8 : bx;

    constexpr int NWG1 = (T / 256) * (INW / 256);
    const int n_idle = (NWG1 % G) ? G - (NWG1 % G) : 0, idle_idx = bx - (NWG1 % G);
    const int e_split = (n_idle >= 96) ? 4 : NE;
    { const Params p = load_params(); ph_prologue(p, lds, vcu, G, e_split); }
    xcd_barrier(xbar);
    {
        const Params p = load_params();
        pg8::DenseOrder So; So.init((const bf16_t*)(p.ws + WS_XB), (const bf16_t*)(p.ws + WS_WIN), T, INW, D, G, bx);
        pg8::EpiZ E{(bf16_t*)(p.ws + WS_Z), INW};
        pg8::gemm_phase(lds, D, So, E);
        if (e_split < NE && idle_idx >= 0) p1_tail_convert(p, lds, idle_idx, n_idle, e_split);
    }
    xcd_barrier(xbar);
    { const Params p = load_params(); ph_mixers(p, (const bf16_t*)(p.ws + WS_Z), (bf16_t*)(p.ws + WS_MIX), (float*)(p.ws + WS_SSQ), lds, (unsigned*)(p.ws + WS_CTL + 8192)); }
    xcd_barrier(xbar);
    {
        const Params p = load_params();
        pg8::DenseOrder So; So.init((const bf16_t*)(p.ws + WS_MIX), (const bf16_t*)(p.ws + WS_WOUT), T, D, D, G, bx);
        pg8::EpiH E{p.ws, p.out, TAB_OFF};
        pg8::gemm_phase(lds, D, So, E);
    }
    xcd_barrier(xbar);
    { const Params p = load_params();
      ph_router3(p, p.out, (int*)(p.ws + WS_CTL + 4096), (int*)(p.ws + WS_LIST), (float*)(p.ws + WS_LIST + MiB), (float*)(p.ws + WS_ROUTE), lds); }
    xcd_barrier(xbar);
    LAS int* meta = (LAS int*)(lds + META_OFF);
    if (threadIdx.x == 0) { const int* gcount = (const int*)(load_params().ws + WS_CTL + 4096); int base = 0; for (int e = 0; e < NE; ++e) { const int cnt = gcount[e]; meta[e] = base; meta[32 + e] = cnt; base += (cnt + 255) >> 8; } meta[16] = base; }
    __syncthreads();
    const int ntiles = __builtin_amdgcn_readfirstlane(meta[16]);
    {
        const Params p = load_params();
        pg8::MoeOrder<0> So{(const bf16_t*)(p.ws + WS_XB), (const bf16_t*)(p.ws + WS_WGU), (const int*)(p.ws + WS_LIST), meta, D, G, bx, ntiles};
        pg8::EpiHid E{(bf16_t*)(p.ws + WS_HID), (const float*)(p.ws + WS_ROUTE), meta};
        pg8::gemm_phase(lds, D, So, E);
        { const int r5 = (ntiles * 4) % G; if (r5 == 0) p5a_tail_convert(p, lds, bx, G); else if (bx >= r5) p5a_tail_convert(p, lds, bx - r5, G - r5); }
    }
    xcd_barrier(xbar);
    {
        const Params p = load_params();
        pg8::MoeOrder<1> So{(const bf16_t*)(p.ws + WS_HID), (const bf16_t*)(p.ws + WS_WD), (const int*)(p.ws + WS_LIST), meta, DFF, G, bx, ntiles};
        pg8::EpiY E{(bf16_t*)(p.ws + WS_Z), (const int*)(p.ws + WS_LIST), (const float*)(p.ws + WS_LIST + MiB), meta};
        pg8::gemm_phase(lds, DFF, So, E);
    }
    xcd_barrier(xbar);
    { const Params p = load_params(); ph_final(p, (const bf16_t*)(p.ws + WS_XB), (const bf16_t*)(p.ws + WS_Z), p.out); }
}

extern "C" void kernel_launch(void* const* d_in, const int* in_sizes, int n_in, void* d_out, int out_size, void* d_ws, size_t ws_size, hipStream_t stream) {
    static int grid_blocks = 0;
    if (!grid_blocks) {
        if (ws_size < WS_END) { fprintf(stderr, "kernel_launch: workspace too small (%zu < %zu)\n", ws_size, (size_t)WS_END); grid_blocks = -1; return; }
        int dev = 0, cus = 0, per_cu = 0;
        (void)hipGetDevice(&dev);
        (void)hipDeviceGetAttribute(&cus, hipDeviceAttributeMultiprocessorCount, dev);
        (void)hipFuncSetAttribute((const void*)k_mega, hipFuncAttributeMaxDynamicSharedMemorySize, LDS_BYTES);
        (void)hipOccupancyMaxActiveBlocksPerMultiprocessor(&per_cu, (const void*)k_mega, NTHR, LDS_BYTES);
        if (per_cu < 1) { fprintf(stderr, "kernel_launch: occupancy query says %d blocks per CU: not launching\n", per_cu); grid_blocks = -1; return; }
        grid_blocks = cus;
    }
    if (grid_blocks < 0) return;
    Params p{};
    const float** f = (const float**)&p;
    for (int i = 0; i < 23; ++i) f[i] = (const float*)d_in[i];
    p.out = (float*)d_out;
    p.ws = (unsigned char*)d_ws;
    (void)hipMemsetAsync((char*)d_ws + WS_CTL, 0, CTL_ZERO_BYTES, stream);
    hipLaunchKernelGGL(k_mega, dim3(grid_blocks), dim3(NTHR), LDS_BYTES, stream, p);
    hipError_t e = hipPeekAtLastError();
    if (e != hipSuccess) fprintf(stderr, "launch failed: %s (grid %d)\n", hipGetErrorString(e), grid_blocks);
}
```

```cpp
#include <hip/hip_runtime.h>
#include <cstdio>
#include <cstdint>

#define LAS __attribute__((address_space(3)))
typedef unsigned short bf16_t;
typedef short bf16x8 __attribute__((ext_vector_type(8)));
typedef float f32x4 __attribute__((ext_vector_type(4)));
typedef float f32x2 __attribute__((ext_vector_type(2)));
typedef unsigned u32x4 __attribute__((ext_vector_type(4)));
typedef unsigned u32x2 __attribute__((ext_vector_type(2)));

constexpr int D = 1024, NB = 8, S = 2048, T = NB * S;
constexpr int RW = 512, RHD = 64;
constexpr int CHUNK = 64, LEFT = 8, BAND = 576, MAXREL = 128;
constexpr int INW = 2560;
constexpr int NE = 16, DFF = 512;
constexpr float EPS = 1e-6f;
constexpr int NTHR = 512, NWAVES = 8;
constexpr int SSQW = 40;

constexpr size_t MiB = 1u << 20;
constexpr size_t WS_CTL = 0, CTL_BYTES = 2 * MiB, CTL_ZERO_BYTES = 128 * 1024 + 512 * 1024;
constexpr size_t WS_WIN = 2 * MiB;
constexpr size_t WS_WOUT = 7 * MiB;
constexpr size_t WS_WGU = 9 * MiB;
constexpr size_t WS_WD = 41 * MiB;
constexpr size_t WS_XB = 57 * MiB;
constexpr size_t WS_Z = 89 * MiB;
constexpr size_t WS_MIX = 169 * MiB;
constexpr size_t WS_HID = 201 * MiB;
constexpr size_t WS_SSQ = 237 * MiB;
constexpr size_t WS_LIST = 240 * MiB;
constexpr size_t WS_ROUTE = 242 * MiB;
constexpr size_t WS_RWT = 243 * MiB;
constexpr size_t WS_GWT = 244 * MiB;
constexpr size_t WS_END = 245 * MiB;

constexpr int RING_BYTES = 131072, TAB_OFF = RING_BYTES, META_OFF = RING_BYTES + 4096, MISC_OFF = RING_BYTES + 15360, LDS_BYTES = 147456;

struct Params {
    const float *x, *norm1_g, *w_in, *conv_w, *conv_b, *w_rg_a, *b_rg_a, *w_rg_x, *b_rg_x, *lru_lambda, *rel_bias,
        *g_rec_out, *g_att_out, *w_out, *norm2_g, *w_group, *b_group, *w_router, *b_router, *w_e_gate, *w_e_up, *w_e_down, *final_g;
    float* out;
    unsigned char* ws;
};

__device__ __forceinline__ float wave_sum(float v) {
#pragma unroll
    for (int o = 32; o > 0; o >>= 1) v += __shfl_xor(v, o);
    return v;
}
__device__ __forceinline__ float sigmoidf_(float x) { return 1.0f / (1.0f + expf(-x)); }
__device__ __forceinline__ float gelu_tanh(float x) { return 0.5f * x * (1.0f + tanhf(0.7978845608028654f * (x + 0.044715f * x * x * x))); }
__device__ __forceinline__ unsigned f2bf(float f) { unsigned u = __builtin_bit_cast(unsigned, f); return (u + 0x7fffu + ((u >> 16) & 1u)) >> 16; }
__device__ __forceinline__ unsigned pk2(float lo, float hi) { return f2bf(lo) | (f2bf(hi) << 16); }
__device__ __forceinline__ float bf2f(bf16_t b) { return __builtin_bit_cast(float, ((unsigned)b) << 16); }
__device__ __forceinline__ unsigned cvt_pk_bf16(float lo, float hi) { unsigned r; asm volatile("v_cvt_pk_bf16_f32 %0, %1, %2" : "=v"(r) : "v"(lo), "v"(hi)); return r; }
#define LDS_WAIT() asm volatile("s_waitcnt lgkmcnt(0)" ::: "memory")
__device__ __forceinline__ int opaque_tid() { int t = threadIdx.x; asm volatile("" : "+v"(t)); return t; }

namespace pg8 {
constexpr int BM = 256, BK = 64, HALF = 128, HTB = HALF * BK * 2, STAGE_BYTES = 8 * HTB, NXCD = 8, WGM = 8;
__device__ __forceinline__ int lds_byte(int r, int c) { const int st = (r >> 4) * 2 + (c >> 5), rr = r & 15, cc = c & 31, ob = rr * 64 + cc * 2; return st * 1024 + (ob ^ (((ob >> 9) & 1) << 5)); }
__device__ __forceinline__ void stage_rc(int b, int& R, int& C) { const int st = b / 1024, sb = b % 1024, swz = sb ^ (((sb >> 9) & 1) << 5); R = (st >> 1) * 16 + swz / 64; C = (st & 1) * 32 + (swz % 64) / 2; }
__device__ __forceinline__ int perm32(int rho) { const int n = rho >> 4, i = rho & 15; return 8 * (i >> 2) + 4 * n + (i & 3); }

struct Unit { int pm, pn, e, rows; };

struct DenseOrder {
    const bf16_t* A; const bf16_t* Bt; int K; int nM, nN, nwg, G, c;
    __device__ void init(const bf16_t* A_, const bf16_t* Bt_, int M, int N, int K_, int G_, int c_) { A = A_; Bt = Bt_; K = K_; nM = M / BM; nN = N / BM; nwg = nM * nN; G = G_; c = c_; }
    __device__ __forceinline__ bool next(int i, Unit& u) const {
        const long L = (long)i * G + c; if (L >= nwg) return false;
        int wgid = (int)L; { const int q = nwg / NXCD, r = nwg % NXCD, xcd = wgid % NXCD, off = wgid / NXCD; wgid = (xcd < r ? xcd * (q + 1) : r * (q + 1) + (xcd - r) * q) + off; }
        const int nig = WGM * nN, gid = wgid / nig, fm = gid * WGM, gsz = (nM - fm) < WGM ? (nM - fm) : WGM;
        u.pm = fm + ((wgid % nig) % gsz); u.pn = (wgid % nig) / gsz; u.e = 0; u.rows = BM; return true;
    }
    __device__ __forceinline__ void addr(const Unit& u, const int (&RA)[2], const int (&CA)[2], const char*& aBase, const char*& bBase, unsigned (&va)[2][2]) const {
        aBase = (const char*)A; bBase = (const char*)Bt + (size_t)u.pn * BM * K * 2;
#pragma unroll
        for (int h = 0; h < 2; ++h)
#pragma unroll
            for (int i = 0; i < 2; ++i) va[h][i] = (unsigned)(((size_t)(u.pm * BM + h * HALF + RA[i]) * K + CA[i]) * 2);
    }
};

template <class Epi, class Sched>
__device__ __forceinline__ void gemm_phase(LAS unsigned char* lds, const int K, const Sched& S, const Epi& E) {
    int tid_ = threadIdx.x; asm volatile("" : "+v"(tid_));
    const int tid = tid_, wid = __builtin_amdgcn_readfirstlane(tid >> 6), lane = tid & 63, wr = wid >> 2, wc = wid & 3, fr = lane & 15, fq = lane >> 4;
    const int nt = K / BK;
    int RA[2], CA[2]; unsigned voffB[2];
#pragma unroll
    for (int i = 0; i < 2; ++i) { int R, C; stage_rc(tid * 16 + i * 8192, R, C); RA[i] = R; CA[i] = C; const int Rb = Epi::PERM ? ((R & ~31) + perm32(R & 31)) : R; voffB[i] = (unsigned)(Rb * K + C) * 2u; }
    const size_t kstep = (size_t)(BK * 2);
    const size_t hstepB = (size_t)HALF * K * 2;
    const unsigned ldsw = (unsigned)wid * 1024u;
    const int aoff = lds_byte(wr * 64 + fr, fq * 8), boff = lds_byte(wc * 32 + fr, fq * 8);
#define PG8_SA(b, h) (((b) * 2 + (h)) * HTB)
#define PG8_SB(b, h) ((4 + (b) * 2 + (h)) * HTB)
#define PG8_STAGE_B(bufoff, gbase) do { _Pragma("unroll") for (int _i = 0; _i < 2; ++_i) \
        __builtin_amdgcn_global_load_lds((const unsigned*)((const char*)(gbase) + voffB[_i]), (LAS unsigned*)(lds + (bufoff) + ldsw + _i * 8192), 16, 0, 0); } while (0)
#define PG8_STAGE_A(bufoff, gbase, v0, v1) do { \
        __builtin_amdgcn_global_load_lds((const unsigned*)((const char*)(gbase) + (v0)), (LAS unsigned*)(lds + (bufoff) + ldsw), 16, 0, 0); \
        __builtin_amdgcn_global_load_lds((const unsigned*)((const char*)(gbase) + (v1)), (LAS unsigned*)(lds + (bufoff) + ldsw + 8192), 16, 0, 0); } while (0)
#define PG8_LDA(dst, b, h) do { _Pragma("unroll") for (int m = 0; m < 4; ++m) _Pragma("unroll") for (int k = 0; k < 2; ++k) dst[m][k] = *(const LAS bf16x8*)(lds + PG8_SA(b, h) + aoff + m * 2048 + k * 1024); } while (0)
#define PG8_LDB(dst, b, h) do { _Pragma("unroll") for (int n = 0; n < 2; ++n) _Pragma("unroll") for (int k = 0; k < 2; ++k) dst[n][k] = *(const LAS bf16x8*)(lds + PG8_SB(b, h) + boff + n * 2048 + k * 1024); } while (0)
#define PG8_MMA(ai, bj, At, Bt) do { __builtin_amdgcn_s_setprio(1); _Pragma("unroll") for (int m = 0; m < 4; ++m) _Pragma("unroll") for (int n = 0; n < 2; ++n) _Pragma("unroll") for (int k = 0; k < 2; ++k) \
        acc[ai][bj][m][n] = __builtin_amdgcn_mfma_f32_16x16x32_bf16(Bt[n][k], At[m][k], acc[ai][bj][m][n], 0, 0, 0); __builtin_amdgcn_s_setprio(0); } while (0)
#define PG8_WAIT_V(n) asm volatile("s_waitcnt vmcnt(" #n ")" ::: "memory")
#define PG8_WAIT_L(n) asm volatile("s_waitcnt lgkmcnt(" #n ")" ::: "memory")
#define PG8_BAR __builtin_amdgcn_s_barrier()
#define PG8_SCHED __builtin_amdgcn_sched_barrier(0)
    Unit cur, nxt; int ui = 0;
    if (!S.next(0, cur)) return;
    f32x4 acc[2][2][4][2];
#pragma unroll
    for (int a = 0; a < 2; ++a)
#pragma unroll
        for (int b = 0; b < 2; ++b)
#pragma unroll
            for (int m = 0; m < 4; ++m)
#pragma unroll
                for (int n = 0; n < 2; ++n) acc[a][b][m][n] = (f32x4){0.f, 0.f, 0.f, 0.f};
    bf16x8 At[4][2], B0[2][2], B1[2][2];
    const char *cA, *cB, *nA, *nB; unsigned cva[2][2], nva[2][2];
    S.addr(cur, RA, CA, cA, cB, cva);
    E.prepare(cur, ui, lds);
    PG8_STAGE_B(PG8_SB(0, 0), cB); PG8_STAGE_A(PG8_SA(0, 0), cA, cva[0][0], cva[0][1]); PG8_STAGE_B(PG8_SB(0, 1), cB + hstepB); PG8_STAGE_A(PG8_SA(0, 1), cA, cva[1][0], cva[1][1]);
    if (wr == 1) PG8_BAR;
    PG8_WAIT_V(4); PG8_BAR;
    PG8_STAGE_B(PG8_SB(1, 0), cB + kstep); PG8_STAGE_A(PG8_SA(1, 0), cA + kstep, cva[0][0], cva[0][1]); PG8_STAGE_B(PG8_SB(1, 1), cB + hstepB + kstep);
    PG8_WAIT_V(6); PG8_BAR;
    for (;;) {
        const bool has_next = S.next(ui + 1, nxt);
        if (has_next) { S.addr(nxt, RA, CA, nA, nB, nva); }
        else { nA = cA; nB = cB;
#pragma unroll
            for (int h = 0; h < 2; ++h)
#pragma unroll
                for (int i = 0; i < 2; ++i) nva[h][i] = cva[h][i]; }
        for (int t = 0; t < nt; t += 2) {
            const bool last = (t == nt - 2);
            if (Epi::MIDSCALE && t == nt / 2) E.midscale(acc, wr, fr, ui, lds);
            const char* a1 = cA + (size_t)(t + 1) * kstep;
            const char* a2 = last ? nA : cA + (size_t)(t + 2) * kstep; const char* b2 = last ? nB : cB + (size_t)(t + 2) * kstep;
            const char* a3 = a2 + kstep; const char* b3 = b2 + kstep;
            const unsigned x00 = last ? nva[0][0] : cva[0][0], x01 = last ? nva[0][1] : cva[0][1], x10 = last ? nva[1][0] : cva[1][0], x11 = last ? nva[1][1] : cva[1][1];
            if (last && has_next) E.prepare(nxt, ui + 1, lds);
            PG8_LDB(B0, 0, 0); PG8_SCHED; PG8_LDA(At, 0, 0); PG8_STAGE_A(PG8_SA(1, 1), a1, cva[1][0], cva[1][1]);
            PG8_WAIT_L(8); PG8_BAR; PG8_WAIT_L(0); PG8_MMA(0, 0, At, B0); PG8_BAR; PG8_SCHED;
            PG8_LDB(B1, 0, 1); PG8_STAGE_B(PG8_SB(0, 0), b2);
            PG8_BAR; PG8_WAIT_L(0); PG8_MMA(0, 1, At, B1); PG8_BAR;
            PG8_LDA(At, 0, 1); PG8_STAGE_A(PG8_SA(0, 0), a2, x00, x01);
            PG8_BAR; PG8_WAIT_L(0); PG8_MMA(1, 0, At, B0); PG8_BAR; PG8_SCHED;
            PG8_STAGE_B(PG8_SB(0, 1), b2 + hstepB);
            PG8_WAIT_V(6); PG8_BAR; PG8_MMA(1, 1, At, B1); PG8_BAR;
            PG8_LDB(B0, 1, 0); PG8_SCHED; PG8_LDA(At, 1, 0); PG8_STAGE_A(PG8_SA(0, 1), a2, x10, x11);
            PG8_WAIT_L(8); PG8_BAR; PG8_WAIT_L(0); PG8_MMA(0, 0, At, B0); PG8_BAR; PG8_SCHED;
            PG8_LDB(B1, 1, 1); PG8_STAGE_B(PG8_SB(1, 0), b3);
            PG8_BAR; PG8_WAIT_L(0); PG8_MMA(0, 1, At, B1); PG8_BAR;
            PG8_LDA(At, 1, 1); PG8_STAGE_A(PG8_SA(1, 0), a3, x00, x01);
            PG8_BAR; PG8_WAIT_L(0); PG8_MMA(1, 0, At, B0); PG8_BAR; PG8_SCHED;
            PG8_STAGE_B(PG8_SB(1, 1), b3 + hstepB);
            PG8_WAIT_V(6); PG8_BAR; PG8_MMA(1, 1, At, B1); PG8_BAR;
        }
        E(acc, cur, wr, wc, fr, fq, ui, lds);
        if (!has_next) break;
#pragma unroll
        for (int a = 0; a < 2; ++a)
#pragma unroll
            for (int b = 0; b < 2; ++b)
#pragma unroll
                for (int m = 0; m < 4; ++m)
#pragma unroll
                    for (int n = 0; n < 2; ++n) acc[a][b][m][n] = (f32x4){0.f, 0.f, 0.f, 0.f};
        cur = nxt; cA = nA; cB = nB; ++ui;
#pragma unroll
        for (int h = 0; h < 2; ++h)
#pragma unroll
            for (int i = 0; i < 2; ++i) cva[h][i] = nva[h][i];
    }
    PG8_WAIT_V(0);
    if (wr == 0) PG8_BAR;
    PG8_BAR;
#undef PG8_SA
#undef PG8_SB
#undef PG8_STAGE_A
#undef PG8_STAGE_B
#undef PG8_LDA
#undef PG8_LDB
#undef PG8_MMA
#undef PG8_WAIT_V
#undef PG8_WAIT_L
#undef PG8_BAR
#undef PG8_SCHED
}

struct EpiZ {
    static constexpr bool PERM = true, MIDSCALE = false;
    bf16_t* O; int ldc;
    __device__ __forceinline__ void prepare(const Unit&, int, LAS unsigned char*) const {}
    __device__ __forceinline__ void midscale(f32x4 (&)[2][2][4][2], int, int, int, LAS unsigned char*) const {}
    __device__ __forceinline__ void operator()(const f32x4 (&acc)[2][2][4][2], const Unit& u, int wr, int wc, int fr, int fq, int, LAS unsigned char*) const {
        const int row0 = u.pm * BM + wr * 64 + fr, col0 = u.pn * BM + wc * 32 + 8 * fq;
#pragma unroll
        for (int ai = 0; ai < 2; ++ai)
#pragma unroll
            for (int m = 0; m < 4; ++m) { bf16_t* rowp = O + (size_t)(row0 + ai * HALF + m * 16) * ldc + col0;
#pragma unroll
                for (int bj = 0; bj < 2; ++bj) { const f32x4 v0 = acc[ai][bj][m][0], v1 = acc[ai][bj][m][1];
                    u32x4 w; w.x = cvt_pk_bf16(v0[0], v0[1]); w.y = cvt_pk_bf16(v0[2], v0[3]); w.z = cvt_pk_bf16(v1[0], v1[1]); w.w = cvt_pk_bf16(v1[2], v1[3]);
                    *(u32x4*)(rowp + bj * HALF) = w; } }
    }
};
struct EpiH {
    static constexpr bool PERM = false, MIDSCALE = true;
    unsigned char* ws; float* part; int tab_off;
    __device__ __forceinline__ void prepare(const Unit& u, int ui, LAS unsigned char* lds) const {
        LAS f32x4* tab = (LAS f32x4*)(lds + tab_off) + (ui & 1) * 256;
        unsigned long long wsb = (unsigned long long)ws; asm volatile("" : "+s"(wsb));
        const float* ssq = (const float*)(wsb + WS_SSQ); const float* rinv1 = (const float*)(wsb + WS_GWT + 256 * 1024);
        if (threadIdx.x < 256) {
            const float* sp = ssq + (size_t)(u.pm * BM + threadIdx.x) * SSQW; float sa = 0.f, sb = 0.f;
#pragma unroll
            for (int i = 0; i < 8; ++i) { const f32x4 v = *(const f32x4*)(sp + 4 * i); sa += (v[0] + v[1]) + (v[2] + v[3]); }
#pragma unroll
            for (int i = 8; i < 10; ++i) { const f32x4 v = *(const f32x4*)(sp + 4 * i); sb += (v[0] + v[1]) + (v[2] + v[3]); }
            const float ra = rsqrtf(sa * (1.0f / 512.0f) + EPS), rb = rsqrtf(sb * (1.0f / 512.0f) + EPS);
            tab[threadIdx.x] = (f32x4){ra / rb, rb, rinv1[u.pm * BM + threadIdx.x], 0.f};
        }
    }
    __device__ __forceinline__ void midscale(f32x4 (&acc)[2][2][4][2], int wr, int fr, int ui, LAS unsigned char* lds) const {
        const LAS f32x4* tab = (const LAS f32x4*)(lds + tab_off) + (ui & 1) * 256;
#pragma unroll
        for (int ai = 0; ai < 2; ++ai)
#pragma unroll
            for (int m = 0; m < 4; ++m) { const float s = tab[ai * HALF + wr * 64 + m * 16 + fr][0];
#pragma unroll
                for (int bj = 0; bj < 2; ++bj)
#pragma unroll
                    for (int n = 0; n < 2; ++n) acc[ai][bj][m][n] = acc[ai][bj][m][n] * s; }
    }
    __device__ __forceinline__ void operator()(const f32x4 (&acc)[2][2][4][2], const Unit& u, int wr, int wc, int fr, int fq, int ui, LAS unsigned char* lds) const {
        const LAS f32x4* tab = (const LAS f32x4*)(lds + tab_off) + (ui & 1) * 256;
        const float* rwt = (const float*)(ws + WS_RWT); bf16_t* hb = (bf16_t*)(ws + WS_XB);
        const int row0 = u.pm * BM + wr * 64 + fr, col0 = u.pn * BM + wc * 32 + 4 * fq;
        float br[2][2][4], bg[2][2][4];
#pragma unroll
        for (int bj = 0; bj < 2; ++bj)
#pragma unroll
            for (int n = 0; n < 2; ++n)
#pragma unroll
                for (int j = 0; j < 4; ++j) { const int c = col0 + bj * HALF + n * 16 + j; br[bj][n][j] = rwt[fr * 1028 + c]; bg[bj][n][j] = rwt[(16 + (fr & 3)) * 1028 + c]; }
#pragma unroll
        for (int am = 0; am < 4; ++am) { const int ai = am >> 1;
            u32x2 xv[4][2][2];
#pragma unroll
            for (int m = 2 * (am & 1); m < 2 * (am & 1) + 2; ++m)
#pragma unroll
                for (int bj = 0; bj < 2; ++bj)
#pragma unroll
                    for (int n = 0; n < 2; ++n) xv[m][bj][n] = *(const u32x2*)(hb + (size_t)(row0 + ai * HALF + m * 16) * D + col0 + bj * HALF + n * 16);
#pragma unroll
            for (int m = 2 * (am & 1); m < 2 * (am & 1) + 2; ++m) { const f32x4 tv = tab[ai * HALF + wr * 64 + m * 16 + fr]; const float s = tv[1], ri = tv[2]; const size_t ro = (size_t)(row0 + ai * HALF + m * 16) * D + col0;
                f32x4 ar = {0.f, 0.f, 0.f, 0.f}, ag = {0.f, 0.f, 0.f, 0.f}; float ssl = 0.f;
#pragma unroll
                for (int bj = 0; bj < 2; ++bj)
#pragma unroll
                    for (int n = 0; n < 2; ++n) { const u32x2 xr = xv[m][bj][n];
                        const f32x4 xf = {__builtin_bit_cast(float, xr[0] << 16), __builtin_bit_cast(float, xr[0] & 0xffff0000u), __builtin_bit_cast(float, xr[1] << 16), __builtin_bit_cast(float, xr[1] & 0xffff0000u)};
                        const f32x4 hv = xf * ri + acc[ai][bj][m][n] * s;
                        *(u32x2*)(hb + ro + bj * HALF + n * 16) = (u32x2){cvt_pk_bf16(hv[0], hv[1]), cvt_pk_bf16(hv[2], hv[3])};
#pragma unroll
                        for (int j = 0; j < 4; ++j) { ar = __builtin_amdgcn_mfma_f32_16x16x4f32(hv[j], br[bj][n][j], ar, 0, 0, 0); ag = __builtin_amdgcn_mfma_f32_16x16x4f32(hv[j], bg[bj][n][j], ag, 0, 0, 0); ssl += hv[j] * hv[j]; } }
                ssl += __shfl_xor(ssl, 16); ssl += __shfl_xor(ssl, 32);
                float* prow = part + ((size_t)(u.pm * BM + ai * HALF + wr * 64 + m * 16) * 16 + (u.pn * 4 + wc)) * 24;
#pragma unroll
                for (int rg_ = 0; rg_ < 4; ++rg_) { float* pr = prow + (size_t)(4 * fq + rg_) * (16 * 24); pr[fr] = ar[rg_]; if (fr < 4) pr[16 + fr] = ag[rg_]; }
                if (fq == 0) prow[(size_t)fr * (16 * 24) + 20] = ssl;
            }
        }
    }
};

template <int MODE>
struct MoeOrder {
    const bf16_t* A; const bf16_t* Bt; const int* tok_list; const LAS int* meta; int K, G, c, ntiles;
    __device__ __forceinline__ bool next(int i, Unit& u) const {
        const int L = i * G + c; if (L >= ntiles * 4) return false;
        const int mt = L >> 2; int e = 0;
#pragma unroll
        for (int j = 1; j < NE; ++j) e += (mt >= meta[j]) ? 1 : 0;
        u.pm = mt; u.pn = L & 3; u.e = e; u.rows = meta[32 + e] - (mt - meta[e]) * BM; return true;
    }
    __device__ __forceinline__ void addr(const Unit& u, const int (&RA)[2], const int (&CA)[2], const char*& aBase, const char*& bBase, unsigned (&va)[2][2]) const {
        aBase = (const char*)A; bBase = (const char*)Bt + ((size_t)u.e * D + (size_t)u.pn * BM) * K * 2;
        const int slot0 = (u.pm - meta[u.e]) * BM;
#pragma unroll
        for (int h = 0; h < 2; ++h)
#pragma unroll
            for (int i = 0; i < 2; ++i) {
                const int r = h * HALF + RA[i];
                if (MODE == 0) { const int tl = tok_list[u.e * T + slot0 + r] >> 1; const int tok = (r < u.rows) ? tl : 0; va[h][i] = (unsigned)(((size_t)tok * K + CA[i]) * 2); }
                else va[h][i] = (unsigned)(((size_t)(u.pm * BM + r) * K + CA[i]) * 2);
            }
    }
};
struct EpiHid {
    static constexpr bool PERM = true, MIDSCALE = false;
    bf16_t* hid; const float* r_list; const LAS int* meta;
    __device__ __forceinline__ void prepare(const Unit&, int, LAS unsigned char*) const {}
    __device__ __forceinline__ void midscale(f32x4 (&)[2][2][4][2], int, int, int, LAS unsigned char*) const {}
    __device__ __forceinline__ void operator()(const f32x4 (&acc)[2][2][4][2], const Unit& u, int wr, int wc, int fr, int fq, int, LAS unsigned char*) const {
        const int row0 = u.pm * BM + wr * 64 + fr, j0 = u.pn * 128 + wc * 16 + 4 * fq, slot0 = (u.pm - meta[u.e]) * BM;
        float rsv[2][4];
#pragma unroll
        for (int ai = 0; ai < 2; ++ai)
#pragma unroll
            for (int m = 0; m < 4; ++m) rsv[ai][m] = r_list[u.e * T + slot0 + ai * HALF + wr * 64 + m * 16 + fr];
#pragma unroll
        for (int ai = 0; ai < 2; ++ai)
#pragma unroll
            for (int m = 0; m < 4; ++m) { bf16_t* rowp = hid + (size_t)(row0 + ai * HALF + m * 16) * DFF + j0;
                const int r = ai * HALF + wr * 64 + m * 16 + fr; const float rs = (r < u.rows) ? rsv[ai][m] : 0.f;
#pragma unroll
                for (int bj = 0; bj < 2; ++bj) { const f32x4 g = acc[ai][bj][m][0] * rs, up = acc[ai][bj][m][1] * rs; float hv[4];
#pragma unroll
                    for (int q = 0; q < 4; ++q) hv[q] = g[q] * up[q] * __builtin_amdgcn_rcpf(1.0f + __expf(-g[q]));
                    *(u32x2*)(rowp + bj * 64) = (u32x2){cvt_pk_bf16(hv[0], hv[1]), cvt_pk_bf16(hv[2], hv[3])}; } }
    }
};
struct EpiY {
    static constexpr bool PERM = true, MIDSCALE = false;
    bf16_t* y2; const int* tok_list; const float* w_list; const LAS int* meta;
    __device__ __forceinline__ void prepare(const Unit&, int, LAS unsigned char*) const {}
    __device__ __forceinline__ void midscale(f32x4 (&)[2][2][4][2], int, int, int, LAS unsigned char*) const {}
    __device__ __forceinline__ void operator()(const f32x4 (&acc)[2][2][4][2], const Unit& u, int wr, int wc, int fr, int fq, int, LAS unsigned char*) const {
        const int slot0 = (u.pm - meta[u.e]) * BM, col0 = u.pn * BM + wc * 32 + 8 * fq;
        int dstv[2][4]; float wv[2][4];
#pragma unroll
        for (int ai = 0; ai < 2; ++ai)
#pragma unroll
            for (int m = 0; m < 4; ++m) { const int li = u.e * T + slot0 + ai * HALF + wr * 64 + m * 16 + fr; dstv[ai][m] = tok_list[li]; wv[ai][m] = w_list[li]; }
#pragma unroll
        for (int ai = 0; ai < 2; ++ai)
#pragma unroll
            for (int m = 0; m < 4; ++m) { const int r = ai * HALF + wr * 64 + m * 16 + fr;
                if (r < u.rows) { const int dst = dstv[ai][m]; const float w = wv[ai][m]; bf16_t* rowp = y2 + (size_t)dst * D + col0;
#pragma unroll
                    for (int bj = 0; bj < 2; ++bj) { const f32x4 v0 = acc[ai][bj][m][0] * w, v1 = acc[ai][bj][m][1] * w;
                        u32x4 o; o.x = cvt_pk_bf16(v0[0], v0[1]); o.y = cvt_pk_bf16(v0[2], v0[3]); o.z = cvt_pk_bf16(v1[0], v1[1]); o.w = cvt_pk_bf16(v1[2], v1[3]);
                        *(u32x4*)(rowp + bj * HALF) = o; } } }
    }
};
}

struct RowId { int off; __device__ __forceinline__ int operator()(int n) const { return off + n; } };
struct RowGU { int up; __device__ __forceinline__ int operator()(int j) const { return (j >> 2) * 8 + (j & 3) + 4 * up; } };

struct TItem { const float* src; const float* gp; bf16_t* dst; int N, K, rmk; };
__device__ __forceinline__ TItem p0_decode(const Params& p, int it) {
    constexpr int I_IN = (D / 64) * (INW / 32), I_OUT = (D / 64) * (D / 32), I_G = (D / 64) * (DFF / 32), I_D = (DFF / 64) * (D / 32), I_E = 2 * I_G + I_D;
    const float* W; const float* g; bf16_t* WT; int K, N, rmk, idx;
    if (it < I_IN) { W = p.w_in; g = p.norm1_g; WT = (bf16_t*)(p.ws + WS_WIN); K = D; N = INW; rmk = 0; idx = it; }
    else if (it < I_IN + I_OUT) { W = p.w_out; g = nullptr; WT = (bf16_t*)(p.ws + WS_WOUT); K = D; N = D; rmk = 0; idx = it - I_IN; }
    else if (it < I_IN + I_OUT + NE * 2 * I_G) { const int r = it - I_IN - I_OUT, e = r / (2 * I_G), q = r % (2 * I_G);
        if (q < I_G) { W = p.w_e_gate + (size_t)e * D * DFF; g = p.norm2_g; WT = (bf16_t*)(p.ws + WS_WGU) + (size_t)e * D * D; K = D; N = DFF; rmk = 1; idx = q; }
        else { W = p.w_e_up + (size_t)e * D * DFF; g = p.norm2_g; WT = (bf16_t*)(p.ws + WS_WGU) + (size_t)e * D * D; K = D; N = DFF; rmk = 2; idx = q - I_G; } }
    else { const int r = it - I_IN - I_OUT - NE * 2 * I_G, e = r / I_D; idx = r % I_D;
        W = p.w_e_down + (size_t)e * DFF * D; g = nullptr; WT = (bf16_t*)(p.ws + WS_WD) + (size_t)e * D * DFF; K = DFF; N = D; rmk = 0; }
    const int nblk = N / 32, kb = idx / nblk, nb = idx % nblk, k0 = 64 * kb, n0 = 32 * nb;
    TItem t; t.src = W + (size_t)k0 * N + n0; t.dst = WT + k0; t.N = N; t.K = K; t.rmk = rmk;
    t.gp = g ? g + k0 : nullptr;
    if (it >= I_IN && it < I_IN + I_OUT) t.gp = (k0 < 512) ? p.g_rec_out + k0 : p.g_att_out + (k0 - 512);
    t.rmk = rmk | (n0 << 4);
    return t;
}
__device__ __forceinline__ void p0_load(const TItem& t, f32x4 (&ld)[8], float (&gv)[8], int lane) {
#pragma unroll
    for (int i = 0; i < 8; ++i) ld[i] = *(const f32x4*)(t.src + (size_t)(8 * i + (lane >> 3)) * t.N + 4 * (lane & 7));
    if (t.gp) {
#pragma unroll
        for (int i = 0; i < 8; ++i) gv[i] = t.gp[8 * i + (lane >> 3)];
    } else {
#pragma unroll
        for (int i = 0; i < 8; ++i) gv[i] = 1.0f;
    }
}
__device__ __forceinline__ void p0_process(const TItem& t, const f32x4 (&ld)[8], const float (&gv)[8], LAS float* scr, int lane) {
#pragma unroll
    for (int i = 0; i < 8; ++i) { const int kk = 8 * i + (lane >> 3); const f32x4 v = ld[i] * gv[i];
        LAS float* d = scr + kk * 33 + 4 * (lane & 7); d[0] = v[0]; d[1] = v[1]; d[2] = v[2]; d[3] = v[3]; }
    LDS_WAIT(); asm volatile("" ::: "memory");
    const int c = lane & 7, n0 = t.rmk >> 4, rmk = t.rmk & 15;
#pragma unroll
    for (int j = 0; j < 4; ++j) { const int n = (lane >> 3) + 8 * j; const LAS float* s = scr + (8 * c) * 33 + n;
        u32x4 o; o.x = pk2(s[0 * 33], s[1 * 33]); o.y = pk2(s[2 * 33], s[3 * 33]); o.z = pk2(s[4 * 33], s[5 * 33]); o.w = pk2(s[6 * 33], s[7 * 33]);
        const int nn = n0 + n, row = (rmk == 0) ? nn : ((nn >> 2) * 8 + (nn & 3) + 4 * (rmk - 1));
        *(u32x4*)(t.dst + (size_t)row * t.K + 8 * c) = o; }
    LDS_WAIT(); asm volatile("" ::: "memory");
}

__device__ __forceinline__ void p0_convert_range(const Params& p, LAS float* scr, int it0, int it1, int gw, int ngw, int lane) {
    int it = it0 + gw; TItem cur; f32x4 la[8]; float ga[8];
    if (it < it1) { cur = p0_decode(p, it); p0_load(cur, la, ga, lane); }
    while (it < it1) {
        const int nit = it + ngw; TItem nxt = cur; f32x4 lb[8]; float gb[8];
        const bool has = nit < it1;
        if (has) { nxt = p0_decode(p, nit); p0_load(nxt, lb, gb, lane); }
        p0_process(cur, la, ga, scr, lane);
        if (has) { cur = nxt;
#pragma unroll
            for (int i = 0; i < 8; ++i) { la[i] = lb[i]; ga[i] = gb[i]; } }
        it = nit;
    }
}

__device__ __forceinline__ void ph_prologue(const Params& p, LAS unsigned char* lds, int vcu, int G, int e_split) {
    const int tid = opaque_tid(), lane = tid & 63, wave = tid >> 6;
    LAS float* scr = (LAS float*)(lds + wave * 16384);
    const int gw = vcu * NWAVES + wave, NGW = G * NWAVES;
    bf16_t* xb = (bf16_t*)(p.ws + WS_XB);
    constexpr int I_IN = (D / 64) * (INW / 32), I_OUT = (D / 64) * (D / 32), I_G = (D / 64) * (DFF / 32), I_D = (DFF / 64) * (D / 32), I_E = 2 * I_G + I_D, I_ALL = I_IN + I_OUT + NE * I_E;
    p0_convert_range(p, scr, 0, I_IN + I_OUT + e_split * 2 * I_G, gw, NGW, lane);
    {
        bf16_t* gwt = (bf16_t*)(p.ws + WS_GWT); float* sp8 = (float*)(p.ws + WS_GWT + 8 * 128 * 144);
        for (int idx = gw * 64 + lane; idx < 8 * 64 * 128; idx += NGW * 64) { const int hb = idx >> 13, k = (idx >> 7) & 63, n = idx & 127;
            const float v = (n < 64) ? p.w_rg_a[(hb * 64 + k) * 64 + n] : p.w_rg_x[(hb * 64 + k) * 64 + n - 64];
            gwt[(hb * 128 + n) * 72 + k] = (bf16_t)f2bf(v); }
        for (int idx = gw * 64 + lane; idx < RW; idx += NGW * 64) sp8[idx] = -8.0f * log1pf(expf(-p.lru_lambda[idx]));
    }
    {
        float* rwt = (float*)(p.ws + WS_RWT);
        for (int idx = gw * 64 + lane; idx < D * 20; idx += NGW * 64) { const int k = idx / 20, n = idx % 20;
            rwt[n * 1028 + k] = (n < 16 ? p.w_router[k * 16 + n] : p.w_group[k * 4 + n - 16]) * p.norm2_g[k]; }
    }
    float* rinv1 = (float*)(p.ws + WS_GWT + 256 * 1024);
    for (int t0 = gw; t0 < T; t0 += 4 * NGW) {
        f32x4 v[4][4];
#pragma unroll
        for (int q = 0; q < 4; ++q) { const int t = t0 + q * NGW; const f32x4* xr = (const f32x4*)(p.x + (size_t)(t < T ? t : t0) * D) + lane;
#pragma unroll
            for (int j = 0; j < 4; ++j) v[q][j] = xr[64 * j]; }
#pragma unroll
        for (int q = 0; q < 4; ++q) { const int t = t0 + q * NGW; float ss = 0.f;
#pragma unroll
            for (int j = 0; j < 4; ++j) ss += (v[q][j][0] * v[q][j][0] + v[q][j][1] * v[q][j][1]) + (v[q][j][2] * v[q][j][2] + v[q][j][3] * v[q][j][3]);
            const float ms = wave_sum(ss) * (1.0f / D) + EPS; const float r = rsqrtf(ms);
            if (t < T) { u32x2* o8 = (u32x2*)(xb + (size_t)t * D) + lane; if (lane == 0) rinv1[t] = __builtin_amdgcn_sqrtf(ms);
#pragma unroll
                for (int j = 0; j < 4; ++j) o8[64 * j] = (u32x2){pk2(v[q][j][0] * r, v[q][j][1] * r), pk2(v[q][j][2] * r, v[q][j][3] * r)}; }
        }
    }
}

__device__ __forceinline__ void p1_tail_convert(const Params& p, LAS unsigned char* lds, int idle_idx, int n_idle, int e_split) {
    const int tid = opaque_tid(), lane = tid & 63, wave = tid >> 6;
    constexpr int I_IN = (D / 64) * (INW / 32), I_OUT = (D / 64) * (D / 32), I_G = (D / 64) * (DFF / 32), I_D = (DFF / 64) * (D / 32), I_E = 2 * I_G + I_D, I_ALL = I_IN + I_OUT + NE * I_E;
    p0_convert_range(p, (LAS float*)(lds + wave * 16384), I_IN + I_OUT + e_split * 2 * I_G, I_IN + I_OUT + NE * 2 * I_G, idle_idx * NWAVES + wave, n_idle * NWAVES, lane);
}

__device__ __forceinline__ void p5a_tail_convert(const Params& p, LAS unsigned char* lds, int widx, int n_workers) {
    const int tid = opaque_tid(), lane = tid & 63, wave = tid >> 6;
    constexpr int I_IN = (D / 64) * (INW / 32), I_OUT = (D / 64) * (D / 32), I_G = (D / 64) * (DFF / 32), I_D = (DFF / 64) * (D / 32);
    p0_convert_range(p, (LAS float*)(lds + wave * 16384), I_IN + I_OUT + NE * 2 * I_G, I_IN + I_OUT + NE * 2 * I_G + NE * I_D, widx * NWAVES + wave, n_workers * NWAVES, lane);
}

typedef float f32x16 __attribute__((ext_vector_type(16)));
typedef short v4i16_t __attribute__((ext_vector_type(4)));
typedef __bf16 bf16x2_t __attribute__((ext_vector_type(2)));
#define MFMA32(a, b, c) __builtin_amdgcn_mfma_f32_32x32x16_bf16((a), (b), (c), 0, 0, 0)
__device__ __forceinline__ unsigned cvtpk_s(float lo, float hi) { f32x2 v = {lo, hi}; bf16x2_t b = __builtin_convertvector(v, bf16x2_t); return __builtin_bit_cast(unsigned, b); }
__device__ __forceinline__ int crow(int r, int hh) { return (r & 3) + 8 * (r >> 2) + 4 * hh; }
__device__ __forceinline__ bf16x8 pack8(const f32x16& x, int s) {
    u32x4 w; w.x = cvtpk_s(x[8 * s + 0], x[8 * s + 1]); w.y = cvtpk_s(x[8 * s + 2], x[8 * s + 3]); w.z = cvtpk_s(x[8 * s + 4], x[8 * s + 5]); w.w = cvtpk_s(x[8 * s + 6], x[8 * s + 7]);
    return __builtin_bit_cast(bf16x8, w);
}
__device__ __forceinline__ v4i16_t vtr(LAS const unsigned char* p) { return __builtin_amdgcn_ds_read_tr16_b64_v4i16((LAS v4i16_t*)p); }
constexpr float LOG2E = 1.4426950408889634f;

struct AttnCtx { LAS float* btab; LAS unsigned char* vbase; int lane, h, q32, hh, vb, vw; float bconst; unsigned kl, vl; };
__device__ __forceinline__ AttnCtx attn_ctx(LAS unsigned char* lds, int tab_off) {
    AttnCtx A; const int tid = opaque_tid(); A.lane = tid & 63; A.h = __builtin_amdgcn_readfirstlane(tid >> 6); A.q32 = A.lane & 31; A.hh = A.lane >> 5;
    A.btab = (LAS float*)(lds + tab_off) + A.h * 328;
    A.vbase = lds + A.h * 16384;
    A.vb = ((A.lane >> 4) & 1) * 32 + (A.lane & 3) * 8 + (4 * A.hh + ((A.lane & 15) >> 2)) * 128;
    A.vw = (A.lane >> 3) * 128 + (A.lane & 7) * 16;
    A.bconst = A.btab[2 * MAXREL];
    A.kl = (unsigned)((A.q32 * INW + 8 * A.hh) * 2);
    A.vl = (unsigned)(((A.lane >> 3) * INW + (A.lane & 7) * 8) * 2) + 1024u;
    return A;
}
__device__ __forceinline__ void attn_setup(const Params& p, LAS unsigned char* lds, int tab_off) {
    const int tid = opaque_tid(), lane = tid & 63, h = __builtin_amdgcn_readfirstlane(tid >> 6);
    LAS float* btab = (LAS float*)(lds + tab_off) + h * 328;
    const float bfar = p.rel_bias[h * (2 * MAXREL + 1) + 2 * MAXREL];
    for (int i = lane; i < 2 * MAXREL + 1 + 64; i += 64) btab[i] = (p.rel_bias[h * (2 * MAXREL + 1) + (i > 2 * MAXREL ? 2 * MAXREL : i)] - bfar) * LOG2E;
    LDS_WAIT(); asm volatile("" ::: "memory");
}
#define ATTN_LOAD_TILE(jn) { const char* tb_ = kband + (long)(64 * (jn)) * INW * 2; _Pragma("unroll") \
    for (int i = 0; i < 8; ++i) { kr[i] = *(const u32x4*)((tb_ + i * 8 * INW * 2) + kl8); vr[i] = *(const u32x4*)((tb_ + i * 8 * INW * 2 + 1024) + kl8); } }
#define ATTN_STORE_TILE() { _Pragma("unroll") \
    for (int i = 0; i < 8; ++i) { *(LAS u32x4*)(vbase + i * 1024 + kw) = kr[i]; *(LAS u32x4*)(vbase + 8192 + i * 1024 + vw) = vr[i]; } }

__device__ __forceinline__ void attn_safe(const AttnCtx& A, const char* kband, const bf16x8 (&qf)[4], int j0, int qi, f32x16& o0, f32x16& o1, float& lt) {
    const int lane = A.lane, q32 = A.q32, hh = A.hh, vb = A.vb, vw = A.vw; LAS float* btab = A.btab; LAS unsigned char* vbase = A.vbase;
    const float bconst = A.bconst; const unsigned kl8 = A.vl - 1024u;
#pragma unroll
    for (int r = 0; r < 16; ++r) { o0[r] = 0.f; o1[r] = 0.f; }
    float m_ref = 0.f, l_run = 0.f;
    constexpr float THR = 6.0f;
    u32x4 kr[8], vr[8];
    const int kw = (lane >> 3) * 128 + (((lane & 7) ^ (lane >> 3)) << 4);
    const int kfo = q32 * 128;
    ATTN_LOAD_TILE(j0)
    ATTN_STORE_TILE()
#pragma unroll 1
    for (int j = j0; j <= LEFT; ++j) {
        if (j < LEFT) ATTN_LOAD_TILE(j + 1)
        bf16x8 kf[4];
#pragma unroll
        for (int s = 0; s < 4; ++s) kf[s] = *(const LAS bf16x8*)(vbase + kfo + (((2 * s + hh) ^ (q32 & 7)) << 4));
        f32x16 p0, p1;
        if (j <= 5) {
            const float ci = bconst - m_ref;
#pragma unroll
            for (int r = 0; r < 16; ++r) { p0[r] = ci; p1[r] = ci; }
        } else {
            const LAS float* pb0 = btab + (LEFT * CHUNK + qi - 64 * j + MAXREL - 4 * hh - 27); const LAS float* pb1 = pb0 - 32;
#pragma unroll
            for (int r = 0; r < 16; ++r) { p0[r] = pb0[27 - ((r & 3) + 8 * (r >> 2))] - m_ref; p1[r] = pb1[27 - ((r & 3) + 8 * (r >> 2))] - m_ref; }
        }
#pragma unroll
        for (int s = 0; s < 4; ++s) p0 = MFMA32(kf[s], qf[s], p0);
#pragma unroll
        for (int s = 0; s < 4; ++s) kf[s] = *(const LAS bf16x8*)(vbase + 4096 + kfo + (((2 * s + hh) ^ (q32 & 7)) << 4));
#pragma unroll
        for (int s = 0; s < 4; ++s) p1 = MFMA32(kf[s], qf[s], p1);
        float mt = fmaxf(p0[0], p1[0]);
#pragma unroll
        for (int r = 1; r < 16; ++r) mt = fmaxf(mt, fmaxf(p0[r], p1[r]));
        mt = fmaxf(mt, __shfl_xor(mt, 32));
        const bool first = (j == j0);
        const bool grow = first || (mt > THR);
        if (__any(grow)) {
            const float d = grow ? mt : 0.f, alpha = first ? 1.0f : __builtin_amdgcn_exp2f(-d);
            m_ref += d; l_run *= alpha;
#pragma unroll
            for (int r = 0; r < 16; ++r) { p0[r] -= d; p1[r] -= d; o0[r] *= alpha; o1[r] *= alpha; }
        }
        float ls0 = 0.f, ls1 = 0.f;
#pragma unroll
        for (int r = 0; r < 16; ++r) { p0[r] = __builtin_amdgcn_exp2f(p0[r]); p1[r] = __builtin_amdgcn_exp2f(p1[r]); ls0 += p0[r]; ls1 += p1[r]; }
        l_run += ls0 + ls1;
        const bf16x8 pf0 = pack8(p0, 0), pf1 = pack8(p0, 1), pf2 = pack8(p1, 0), pf3 = pack8(p1, 1);
        LAS const unsigned char* vcur = vbase + 8192 + vb;
#pragma unroll
        for (int db = 0; db < 2; ++db) {
            v4i16_t lo[4], hi[4];
#pragma unroll
            for (int ks = 0; ks < 4; ++ks) { lo[ks] = vtr(vcur + ks * 2048 + db * 64); hi[ks] = vtr(vcur + ks * 2048 + 1024 + db * 64); }
#define VF(k) (bf16x8){lo[k][0], lo[k][1], lo[k][2], lo[k][3], hi[k][0], hi[k][1], hi[k][2], hi[k][3]}
            if (db == 0) { o0 = MFMA32(VF(0), pf0, o0); o0 = MFMA32(VF(1), pf1, o0); o0 = MFMA32(VF(2), pf2, o0); o0 = MFMA32(VF(3), pf3, o0); }
            else         { o1 = MFMA32(VF(0), pf0, o1); o1 = MFMA32(VF(1), pf1, o1); o1 = MFMA32(VF(2), pf2, o1); o1 = MFMA32(VF(3), pf3, o1); }
#undef VF
        }
        if (j < LEFT) ATTN_STORE_TILE()
    }
    lt = l_run + __shfl_xor(l_run, 32);
}

template <bool NEAR>
__device__ __forceinline__ void attn_tile_fast(f32x16& o0, f32x16& o1, f32x2& la, f32x2& lb, const bf16x8 (&qf)[4], LAS unsigned char* vbase, int kfo, int hh, int q32, int vb, const LAS float* pb0) {
    bf16x8 kf[4];
#pragma unroll
    for (int s = 0; s < 4; ++s) kf[s] = *(const LAS bf16x8*)(vbase + kfo + (((2 * s + hh) ^ (q32 & 7)) << 4));
    f32x16 p0, p1;
    if (NEAR) { const LAS float* pb1 = pb0 - 32;
#pragma unroll
        for (int r = 0; r < 16; ++r) { p0[r] = pb0[27 - ((r & 3) + 8 * (r >> 2))]; p1[r] = pb1[27 - ((r & 3) + 8 * (r >> 2))]; }
    } else {
#pragma unroll
        for (int r = 0; r < 16; ++r) { p0[r] = 0.f; p1[r] = 0.f; }
    }
#pragma unroll
    for (int s = 0; s < 4; ++s) p0 = MFMA32(kf[s], qf[s], p0);
#pragma unroll
    for (int s = 0; s < 4; ++s) kf[s] = *(const LAS bf16x8*)(vbase + 4096 + kfo + (((2 * s + hh) ^ (q32 & 7)) << 4));
#pragma unroll
    for (int s = 0; s < 4; ++s) p1 = MFMA32(kf[s], qf[s], p1);
#pragma unroll
    for (int r = 0; r < 16; ++r) { p0[r] = __builtin_amdgcn_exp2f(p0[r]); p1[r] = __builtin_amdgcn_exp2f(p1[r]); }
#pragma unroll
    for (int r = 0; r < 8; ++r) { la += (f32x2){p0[2 * r], p0[2 * r + 1]}; lb += (f32x2){p1[2 * r], p1[2 * r + 1]}; }
    const bf16x8 pf0 = pack8(p0, 0), pf1 = pack8(p0, 1), pf2 = pack8(p1, 0), pf3 = pack8(p1, 1);
    LAS const unsigned char* vcur = vbase + 8192 + vb;
#pragma unroll
    for (int db = 0; db < 2; ++db) {
        v4i16_t lo[4], hi[4];
#pragma unroll
        for (int ks = 0; ks < 4; ++ks) { lo[ks] = vtr(vcur + ks * 2048 + db * 64); hi[ks] = vtr(vcur + ks * 2048 + 1024 + db * 64); }
#define VF(k) (bf16x8){lo[k][0], lo[k][1], lo[k][2], lo[k][3], hi[k][0], hi[k][1], hi[k][2], hi[k][3]}
        if (db == 0) { o0 = MFMA32(VF(0), pf0, o0); o0 = MFMA32(VF(1), pf1, o0); o0 = MFMA32(VF(2), pf2, o0); o0 = MFMA32(VF(3), pf3, o0); }
        else         { o1 = MFMA32(VF(0), pf0, o1); o1 = MFMA32(VF(1), pf1, o1); o1 = MFMA32(VF(2), pf2, o1); o1 = MFMA32(VF(3), pf3, o1); }
#undef VF
    }
}
__device__ __forceinline__ void attn_fast(const AttnCtx& A, const char* kband, const bf16x8 (&qf)[4], int j0, int qi, f32x16& o0, f32x16& o1, float& lt) {
    const int lane = A.lane, q32 = A.q32, hh = A.hh, vb = A.vb, vw = A.vw; LAS float* btab = A.btab; LAS unsigned char* vbase = A.vbase;
    const unsigned kl8 = A.vl - 1024u;
#pragma unroll
    for (int r = 0; r < 16; ++r) { o0[r] = 0.f; o1[r] = 0.f; }
    f32x2 la = {0.f, 0.f}, lb = {0.f, 0.f};
    u32x4 kr[8], vr[8];
    const int kw = (lane >> 3) * 128 + (((lane & 7) ^ (lane >> 3)) << 4);
    const int kfo = q32 * 128;
    ATTN_LOAD_TILE(j0)
    ATTN_STORE_TILE()
    int j = j0;
#pragma unroll 1
    for (; j <= 5; ++j) {
        ATTN_LOAD_TILE(j + 1)
        attn_tile_fast<false>(o0, o1, la, lb, qf, vbase, kfo, hh, q32, vb, nullptr);
        ATTN_STORE_TILE()
    }
#pragma unroll 1
    for (; j <= LEFT; ++j) {
        if (j < LEFT) ATTN_LOAD_TILE(j + 1)
        attn_tile_fast<true>(o0, o1, la, lb, qf, vbase, kfo, hh, q32, vb, btab + (LEFT * CHUNK + qi - 64 * j + MAXREL - 4 * hh - 27));
        if (j < LEFT) ATTN_STORE_TILE()
    }
    const float l_run = (la.x + la.y) + (lb.x + lb.y);
    lt = l_run + __shfl_xor(l_run, 32);
}

template <bool FAST>
__device__ __forceinline__ bool attn_item(LAS unsigned char* lds, const bf16_t* z, bf16_t* mixb, float* ssq, int b, int c, int qh) {
    const AttnCtx A = attn_ctx(lds, TAB_OFF);
    const int h = A.h, q32 = A.q32, hh = A.hh;
    const float QS = 0.125f * LOG2E;
    const int j0 = (c >= LEFT) ? 0 : LEFT - c;
    const char* kband = (const char*)z + (((long)b * S + (long)(c - LEFT) * CHUNK) * INW + 1536 + h * 64) * 2;
    const int qi = qh * 32 + q32;
    const size_t tq = (size_t)b * S + c * CHUNK + qi;
    bf16x8 qf[4];
#pragma unroll
    for (int s = 0; s < 4; ++s) { const u32x4 raw = *(const u32x4*)(z + tq * INW + 1024 + h * 64 + 16 * s + 8 * hh); u32x4 w;
#pragma unroll
        for (int e = 0; e < 4; ++e) w[e] = cvtpk_s(__builtin_bit_cast(float, raw[e] << 16) * QS, __builtin_bit_cast(float, raw[e] & 0xffff0000u) * QS);
        qf[s] = __builtin_bit_cast(bf16x8, w); }
    f32x16 o0, o1; float lt;
    if (FAST) { attn_fast(A, kband, qf, j0, qi, o0, o1, lt); if (__any(!(lt >= 0x1p-60f && lt <= 0x1p60f))) return true; }
    else attn_safe(A, kband, qf, j0, qi, o0, o1, lt);
    const float inv = 1.0f / lt;
    float ss = 0.f;
    bf16_t* orow = mixb + tq * D + 512 + h * 64 + 4 * hh;
#pragma unroll
    for (int g = 0; g < 4; ++g) {
        const float a0 = o0[4 * g] * inv, a1 = o0[4 * g + 1] * inv, a2 = o0[4 * g + 2] * inv, a3 = o0[4 * g + 3] * inv;
        const float c0 = o1[4 * g] * inv, c1 = o1[4 * g + 1] * inv, c2 = o1[4 * g + 2] * inv, c3 = o1[4 * g + 3] * inv;
        ss += (a0 * a0 + a1 * a1) + (a2 * a2 + a3 * a3) + (c0 * c0 + c1 * c1) + (c2 * c2 + c3 * c3);
        *(u32x2*)(orow + 8 * g) = (u32x2){cvtpk_s(a0, a1), cvtpk_s(a2, a3)};
        *(u32x2*)(orow + 32 + 8 * g) = (u32x2){cvtpk_s(c0, c1), cvtpk_s(c2, c3)};
    }
    ss += __shfl_xor(ss, 32);
    if (hh == 0) ssq[tq * SSQW + 32 + h] = ss;
    return false;
}

constexpr int RG_WT = 0, RG_IMG = 18432, RG_SEG = 35840, RG_PRE = 44032, RG_CAR = 52224, RG_ROWB = 144, RG_IROW = 272;
constexpr int RG_U = 57344, RG_G = 90624, RG_GROW = 136;
__device__ __forceinline__ float fast_sigmoid(float x) { return __builtin_amdgcn_rcpf(1.0f + __expf(-x)); }
__device__ __forceinline__ void rglru_item(const Params& p, const bf16_t* z, bf16_t* mixb, float* ssq, LAS unsigned char* lds, unsigned long long* gran, int b, int hb, int kc) {
    const int tid = opaque_tid(), lane = tid & 63, w = __builtin_amdgcn_readfirstlane(tid >> 6), ch = lane, c16 = lane & 15, tg = lane >> 4;
    LAS f32x2* seg = (LAS f32x2*)(lds + RG_SEG); LAS f32x2* pre = (LAS f32x2*)(lds + RG_PRE); LAS float* car = (LAS float*)(lds + RG_CAR);
    {
        const u32x4* srcw = (const u32x4*)(p.ws + WS_GWT + (size_t)hb * 128 * 144); LAS u32x4* dstw = (LAS u32x4*)(lds + RG_WT);
        static_assert(128 * 144 / 16 == 2 * NTHR + 128, "gate weight image size");
        const u32x4 t0 = srcw[tid], t1 = srcw[tid + NTHR], t2 = srcw[2 * NTHR + (tid & 127)];
        dstw[tid] = t0; dstw[tid + NTHR] = t1; if (tid < 128) dstw[2 * NTHR + tid] = t2;
    }
    const int gch = hb * 64 + ch;
    const float cw0 = p.conv_w[gch], cw1 = p.conv_w[RW + gch], cw2 = p.conv_w[2 * RW + gch], cw3 = p.conv_w[3 * RW + gch], cb = p.conv_b[gch];
    const float* sp8t = (const float*)(p.ws + WS_GWT + 8 * 128 * 144);
    float ba[4], bxb[4], sp8[4];
#pragma unroll
    for (int nb = 0; nb < 4; ++nb) { const int c = hb * 64 + 16 * nb + c16; ba[nb] = p.b_rg_a[c]; bxb[nb] = p.b_rg_x[c]; sp8[nb] = sp8t[c]; }
    LAS unsigned char* img = lds + RG_IMG;
    LAS unsigned char* trb = img + (8 * tg + (c16 >> 2)) * RG_IROW + (16 * w + 4 * (c16 & 3)) * 2;
    const int s0 = kc * 256;
    const bf16_t* ucol = z + ((size_t)b * S + s0) * INW + gch;
    float av[2][4][4], bv[2][4][4], cP[2][4], cH[2][4];
    {
        const int r0 = tid >> 3, ck = tid & 7;
        const bf16_t* ub = z + ((size_t)b * S + s0) * INW + hb * 64 + ck * 8;
        u32x4 ur[5], gr[4];
#pragma unroll
        for (int k = 0; k < 4; ++k) { const int st = r0 + 64 * k - 3; ur[k] = *(const u32x4*)(ub + (long)(s0 + st >= 0 ? st : 0) * INW); if (s0 + st < 0) ur[k] = (u32x4){0u, 0u, 0u, 0u}; }
        ur[4] = *(const u32x4*)(ub + (long)(253 + (r0 < 3 ? r0 : 0)) * INW);
#pragma unroll
        for (int k = 0; k < 4; ++k) gr[k] = *(const u32x4*)(ub + (long)(r0 + 64 * k) * INW + 512);
#pragma unroll
        for (int k = 0; k < 4; ++k) *(LAS u32x4*)(lds + RG_U + (r0 + 64 * k) * 128 + ck * 16) = ur[k];
        if (r0 < 3) *(LAS u32x4*)(lds + RG_U + (256 + r0) * 128 + ck * 16) = ur[4];
#pragma unroll
        for (int k = 0; k < 4; ++k) { LAS u32x2* gd = (LAS u32x2*)(lds + RG_G + (r0 + 64 * k) * RG_GROW + ck * 16); gd[0] = (u32x2){gr[k].x, gr[k].y}; gd[1] = (u32x2){gr[k].z, gr[k].w}; }
    }
    __syncthreads();
#pragma unroll
    for (int blk = 0; blk < 2; ++blk) {
        const int t0 = blk * 128 + 16 * w;
        float uv[19];
#pragma unroll
        for (int i = 0; i < 19; ++i) uv[i] = bf2f(*(const LAS bf16_t*)(lds + RG_U + (t0 + i) * 128 + ch * 2));
        {
            float uc[16];
#pragma unroll
            for (int i = 0; i < 16; ++i) uc[i] = cb + cw0 * uv[i] + cw1 * uv[i + 1] + cw2 * uv[i + 2] + cw3 * uv[i + 3];
            u32x4 w0, w1;
#pragma unroll
            for (int e = 0; e < 4; ++e) { w0[e] = cvtpk_s(uc[2 * e], uc[2 * e + 1]); w1[e] = cvtpk_s(uc[8 + 2 * e], uc[9 + 2 * e]); }
            *(LAS u32x4*)(img + ch * RG_IROW + 32 * w) = w0; *(LAS u32x4*)(img + ch * RG_IROW + 32 * w + 16) = w1;
        }
        LDS_WAIT(); asm volatile("" ::: "memory");
        const v4i16_t t0lo = vtr(trb), t0hi = vtr(trb + 4 * RG_IROW), t1lo = vtr(trb + 32 * RG_IROW), t1hi = vtr(trb + 36 * RG_IROW);
        const bf16x8 a0 = (bf16x8){t0lo[0], t0lo[1], t0lo[2], t0lo[3], t0hi[0], t0hi[1], t0hi[2], t0hi[3]}, a1 = (bf16x8){t1lo[0], t1lo[1], t1lo[2], t1lo[3], t1hi[0], t1hi[1], t1hi[2], t1hi[3]};
#pragma unroll
        for (int nb = 0; nb < 4; ++nb) {
            const bf16x8 b0a = *(const LAS bf16x8*)(lds + RG_WT + (16 * nb + c16) * RG_ROWB + tg * 16), b1a = *(const LAS bf16x8*)(lds + RG_WT + (16 * nb + c16) * RG_ROWB + tg * 16 + 64);
            const bf16x8 b0x = *(const LAS bf16x8*)(lds + RG_WT + (64 + 16 * nb + c16) * RG_ROWB + tg * 16), b1x = *(const LAS bf16x8*)(lds + RG_WT + (64 + 16 * nb + c16) * RG_ROWB + tg * 16 + 64);
            f32x4 acca = __builtin_amdgcn_mfma_f32_16x16x32_bf16(a0, b0a, (f32x4){0.f, 0.f, 0.f, 0.f}, 0, 0, 0); acca = __builtin_amdgcn_mfma_f32_16x16x32_bf16(a1, b1a, acca, 0, 0, 0);
            f32x4 accx = __builtin_amdgcn_mfma_f32_16x16x32_bf16(a0, b0x, (f32x4){0.f, 0.f, 0.f, 0.f}, 0, 0, 0); accx = __builtin_amdgcn_mfma_f32_16x16x32_bf16(a1, b1x, accx, 0, 0, 0);
            const u32x2 ucr = *(const LAS u32x2*)(img + (16 * nb + c16) * RG_IROW + (16 * w + 4 * tg) * 2);
            const float ucv[4] = {__builtin_bit_cast(float, ucr[0] << 16), __builtin_bit_cast(float, ucr[0] & 0xffff0000u), __builtin_bit_cast(float, ucr[1] << 16), __builtin_bit_cast(float, ucr[1] & 0xffff0000u)};
            float H = 0.f, P = 1.f;
#pragma unroll
            for (int rg_ = 0; rg_ < 4; ++rg_) {
                const float r = fast_sigmoid(acca[rg_] + ba[nb]), ig = fast_sigmoid(accx[rg_] + bxb[nb]);
                const float a = __expf(r * sp8[nb]);
                av[blk][nb][rg_] = a; bv[blk][nb][rg_] = __builtin_amdgcn_sqrtf((1.0f - a) * (1.0f + a)) * (ig * ucv[rg_]);
                H = a * H + bv[blk][nb][rg_]; P *= a; }
            float cp = 1.f, chh = 0.f, Pt = 1.f, Ht = 0.f;
#pragma unroll
            for (int k = 0; k < 4; ++k) { const float Pk = __shfl(P, c16 + 16 * k), Hk = __shfl(H, c16 + 16 * k);
                cp = (k == tg) ? Pt : cp; chh = (k == tg) ? Ht : chh;
                Ht = Pk * Ht + Hk; Pt *= Pk; }
            cP[blk][nb] = cp; cH[blk][nb] = chh;
            if (tg == 0) seg[(blk * 8 + w) * 64 + 16 * nb + c16] = (f32x2){Pt, Ht};
        }
        LDS_WAIT(); asm volatile("" ::: "memory");
    }
    __syncthreads();
    unsigned long long vp[7], vh[7];
    const unsigned long long* g0 = gran + ((size_t)((b * 8 + hb) * 8) * 2) * 64 + (tid & 63);
    if (tid < 64) {
        float Pp = 1.f, Hp = 0.f;
#pragma unroll
        for (int s = 0; s < 16; ++s) { pre[s * 64 + tid] = (f32x2){Pp, Hp}; const f32x2 sv = seg[s * 64 + tid]; Hp = sv.x * Hp + sv.y; Pp *= sv.x; }
        unsigned long long* g = gran + ((size_t)((b * 8 + hb) * 8 + kc) * 2) * 64 + tid;
        __hip_atomic_store(g, (1ull << 32) | __builtin_bit_cast(unsigned, Pp), __ATOMIC_RELAXED, __HIP_MEMORY_SCOPE_AGENT);
        __hip_atomic_store(g + 64, (1ull << 32) | __builtin_bit_cast(unsigned, Hp), __ATOMIC_RELAXED, __HIP_MEMORY_SCOPE_AGENT);
#pragma unroll
        for (int j = 0; j < 7; ++j) if (j < kc) { vp[j] = __hip_atomic_load(g0 + j * 128, __ATOMIC_RELAXED, __HIP_MEMORY_SCOPE_AGENT); vh[j] = __hip_atomic_load(g0 + j * 128 + 64, __ATOMIC_RELAXED, __HIP_MEMORY_SCOPE_AGENT); }
    }
    float gg[2][4][4];
#pragma unroll
    for (int blk = 0; blk < 2; ++blk)
#pragma unroll
        for (int nb = 0; nb < 4; ++nb)
#pragma unroll
            for (int i = 0; i < 4; ++i) { const float g = bf2f(*(const LAS bf16_t*)(lds + RG_G + (blk * 128 + 16 * w + 4 * tg + i) * RG_GROW + (16 * nb + c16) * 2)), u2 = 1.5957691216057308f * (g + 0.044715f * g * g * g); gg[blk][nb][i] = g * fast_sigmoid(u2); }
    if (tid < 64) {
        unsigned spins = 0;
        for (;;) {
            bool ok = true;
#pragma unroll
            for (int j = 0; j < 7; ++j) if (j < kc) ok = ok && ((vp[j] >> 32) != 0ull) && ((vh[j] >> 32) != 0ull);
            if (__all(ok) || ++spins > (1u << 20)) break;
            __builtin_amdgcn_s_sleep(2);
#pragma unroll
            for (int j = 0; j < 7; ++j) if (j < kc) { vp[j] = __hip_atomic_load(g0 + j * 128, __ATOMIC_RELAXED, __HIP_MEMORY_SCOPE_AGENT); vh[j] = __hip_atomic_load(g0 + j * 128 + 64, __ATOMIC_RELAXED, __HIP_MEMORY_SCOPE_AGENT); }
        }
        float h = 0.f;
#pragma unroll
        for (int j = 0; j < 7; ++j) if (j < kc) h = __builtin_bit_cast(float, (unsigned)vp[j]) * h + __builtin_bit_cast(float, (unsigned)vh[j]);
        car[tid] = h;
    }
    __syncthreads();
#pragma unroll
    for (int blk = 0; blk < 2; ++blk) {
        const int t0 = blk * 128 + 16 * w;
        float ysum[4] = {0.f, 0.f, 0.f, 0.f};
#pragma unroll
        for (int nb = 0; nb < 4; ++nb) {
            const int oc = 16 * nb + c16; const f32x2 pf = pre[(blk * 8 + w) * 64 + oc];
            float hcur = cP[blk][nb] * (pf.x * car[oc] + pf.y) + cH[blk][nb];
            bf16_t* orow = mixb + ((size_t)b * S + s0 + t0 + 4 * tg) * D + hb * 64 + oc;
#pragma unroll
            for (int i = 0; i < 4; ++i) { hcur = av[blk][nb][i] * hcur + bv[blk][nb][i];
                const float y = hcur * gg[blk][nb][i];
                orow[(size_t)i * D] = (bf16_t)(cvtpk_s(y, y) & 0xffffu); ysum[i] += y * y; }
        }
#pragma unroll
        for (int i = 0; i < 4; ++i) ysum[i] += __shfl_xor(ysum[i], 1);
#pragma unroll
        for (int i = 0; i < 4; ++i) ysum[i] += __shfl_xor(ysum[i], 2);
#pragma unroll
        for (int i = 0; i < 4; ++i) ysum[i] += __shfl_xor(ysum[i], 4);
#pragma unroll
        for (int i = 0; i < 4; ++i) ysum[i] += __shfl_xor(ysum[i], 8);
        if (c16 == 0) { float* sq = ssq + ((size_t)b * S + s0 + t0 + 4 * tg) * SSQW + hb * 4;
#pragma unroll
            for (int i = 0; i < 4; ++i) *(f32x4*)(sq + (size_t)i * SSQW) = (f32x4){ysum[i], 0.f, 0.f, 0.f}; }
    }
}

constexpr int RT_SUM = 0, RT_REC = 49152;
__device__ __forceinline__ void ph_router3(const Params& p, const float* part, int* gcount, int* tok_list, float* w_list, float* r_list, LAS unsigned char* lds) {
    const int tid = opaque_tid();
    LAS float* sum = (LAS float*)(lds + RT_SUM);
    LAS int* lcnt = (LAS int*)(lds + RT_REC); LAS int* lbase = lcnt + 16; LAS int* rec_e = lcnt + 32; LAS int* rec_s = lcnt + 160; LAS float* rec_w = (LAS float*)(lcnt + 288); LAS float* rec_r = (LAS float*)(lcnt + 416);
    for (int grp = blockIdx.x; grp < T / 64; grp += gridDim.x) {
        if (tid < 16) lcnt[tid] = 0;
        {
            const int tok = tid & 63, pr = tid >> 6;
            const f32x4* a = (const f32x4*)(part + ((size_t)(grp * 64 + tok) * 16 + 2 * pr) * 24);
            f32x4 v[12];
#pragma unroll
            for (int i = 0; i < 12; ++i) v[i] = a[i];
#pragma unroll
            for (int i = 0; i < 6; ++i) *(LAS f32x4*)(sum + (pr * 64 + tok) * 24 + 4 * i) = v[i] + v[6 + i];
        }
        __syncthreads();
        if (tid < 64) {
            float q[24];
#pragma unroll
            for (int i = 0; i < 6; ++i) { f32x4 s4 = *(const LAS f32x4*)(sum + tid * 24 + 4 * i);
#pragma unroll
                for (int pr = 1; pr < 8; ++pr) s4 = s4 + *(const LAS f32x4*)(sum + (pr * 64 + tid) * 24 + 4 * i);
                q[4 * i] = s4[0]; q[4 * i + 1] = s4[1]; q[4 * i + 2] = s4[2]; q[4 * i + 3] = s4[3]; }
            const float rstd = rsqrtf(q[20] * (1.0f / D) + EPS);
            float lg[4];
#pragma unroll
            for (int i = 0; i < 4; ++i) lg[i] = q[16 + i] * rstd + p.b_group[i];
            int gi = 0; float best = lg[0];
#pragma unroll
            for (int i = 1; i < 4; ++i) if (lg[i] > best) { best = lg[i]; gi = i; }
            float den = 0.f;
#pragma unroll
            for (int i = 0; i < 4; ++i) den += expf(lg[i] - best);
            const float pg = 1.0f / den;
            float sel[4];
#pragma unroll
            for (int i = 0; i < 4; ++i) { const float s0 = q[i], s1 = q[4 + i], s2 = q[8 + i], s3 = q[12 + i]; sel[i] = ((gi == 0) ? s0 : (gi == 1) ? s1 : (gi == 2) ? s2 : s3) * rstd + p.b_router[gi * 4 + i]; }
            int i1 = 0; float v1 = sel[0];
#pragma unroll
            for (int i = 1; i < 4; ++i) if (sel[i] > v1) { v1 = sel[i]; i1 = i; }
            int i2 = -1; float v2 = -3.0e38f;
#pragma unroll
            for (int i = 0; i < 4; ++i) if (i != i1 && sel[i] > v2) { v2 = sel[i]; i2 = i; }
            const float e2 = expf(v2 - v1);
            const float w1 = pg / (1.0f + e2), w2 = pg * e2 / (1.0f + e2);
            const int ea = gi * 4 + i1, eb = gi * 4 + i2;
            const int sa = __hip_atomic_fetch_add(lcnt + ea, 1, __ATOMIC_RELAXED, __HIP_MEMORY_SCOPE_WORKGROUP);
            const int sb = __hip_atomic_fetch_add(lcnt + eb, 1, __ATOMIC_RELAXED, __HIP_MEMORY_SCOPE_WORKGROUP);
            rec_e[tid * 2] = ea; rec_s[tid * 2] = sa; rec_w[tid * 2] = w1; rec_r[tid * 2] = rstd;
            rec_e[tid * 2 + 1] = eb; rec_s[tid * 2 + 1] = sb; rec_w[tid * 2 + 1] = w2; rec_r[tid * 2 + 1] = rstd;
        }
        __syncthreads();
        if (tid < 16) lbase[tid] = __hip_atomic_fetch_add(gcount + tid, lcnt[tid], __ATOMIC_RELAXED, __HIP_MEMORY_SCOPE_AGENT);
        __syncthreads();
        if (tid < 128) { const int e = rec_e[tid]; const int pos = lbase[e] + rec_s[tid]; tok_list[e * T + pos] = grp * 128 + tid; w_list[e * T + pos] = rec_w[tid]; r_list[e * T + pos] = rec_r[tid]; }
        __syncthreads();
    }
}
__device__ void ph_final(const Params& p, const bf16_t* hb, const bf16_t* y2, float* out) {
    const int tid = opaque_tid(), lane = tid & 63, wv = tid >> 6;
    constexpr int RPT = 4;
    f32x4 gf[4];
#pragma unroll
    for (int j = 0; j < 4; ++j) gf[j] = *((const f32x4*)p.final_g + lane + 64 * j);
    const int nwv = gridDim.x * NWAVES;
    for (int t0 = blockIdx.x * NWAVES + wv; t0 < T; t0 += nwv * RPT) {
        u32x2 hv[RPT][4], ya[RPT][4], yb[RPT][4];
#pragma unroll
        for (int q = 0; q < RPT; ++q) { const int t = t0 + q * nwv; const int tt = t < T ? t : t0;
            const u32x2* hr = (const u32x2*)(hb + (size_t)tt * D) + lane;
            const u32x2* y0 = (const u32x2*)(y2 + (size_t)(2 * tt) * D) + lane; const u32x2* y1 = (const u32x2*)(y2 + (size_t)(2 * tt + 1) * D) + lane;
#pragma unroll
            for (int j = 0; j < 4; ++j) { hv[q][j] = hr[64 * j]; ya[q][j] = y0[64 * j]; yb[q][j] = y1[64 * j]; } }
#pragma unroll
        for (int q = 0; q < RPT; ++q) { const int t = t0 + q * nwv;
            f32x4 v[4]; float ss = 0.f;
#pragma unroll
            for (int j = 0; j < 4; ++j) { const u32x2 a = ya[q][j], b = yb[q][j], c = hv[q][j];
                v[j][0] = __builtin_bit_cast(float, c[0] << 16) + __builtin_bit_cast(float, a[0] << 16) + __builtin_bit_cast(float, b[0] << 16);
                v[j][1] = __builtin_bit_cast(float, c[0] & 0xffff0000u) + __builtin_bit_cast(float, a[0] & 0xffff0000u) + __builtin_bit_cast(float, b[0] & 0xffff0000u);
                v[j][2] = __builtin_bit_cast(float, c[1] << 16) + __builtin_bit_cast(float, a[1] << 16) + __builtin_bit_cast(float, b[1] << 16);
                v[j][3] = __builtin_bit_cast(float, c[1] & 0xffff0000u) + __builtin_bit_cast(float, a[1] & 0xffff0000u) + __builtin_bit_cast(float, b[1] & 0xffff0000u);
                ss += (v[j][0] * v[j][0] + v[j][1] * v[j][1]) + (v[j][2] * v[j][2] + v[j][3] * v[j][3]); }
            const float r = rsqrtf(wave_sum(ss) * (1.0f / D) + EPS);
            if (t < T) { f32x4* orow = (f32x4*)(out + (size_t)t * D) + lane;
#pragma unroll
                for (int j = 0; j < 4; ++j) orow[64 * j] = v[j] * r * gf[j]; }
        }
    }
}


__device__ __forceinline__ void ph_mixers(const Params& p, const bf16_t* z, bf16_t* mixb, float* ssq, LAS unsigned char* lds, unsigned* qctr) {
    attn_setup(p, lds, TAB_OFF);
    volatile LAS int* qword = (volatile LAS int*)(lds + TAB_OFF + 12288);
    constexpr int NQ = NB, QITEMS = 64 + 64;
    unsigned long long* gran = (unsigned long long*)(p.ws + WS_CTL + 128 * 1024);
    const int qstep = (int)gridDim.x < NQ ? (int)gridDim.x : NQ;
    for (int q = blockIdx.x % NQ; q < NQ; q += qstep) {
        int ticket = 0, idx;
        if (threadIdx.x == 0) ticket = (int)__hip_atomic_fetch_add(qctr + 64 * q, 1u, __ATOMIC_RELAXED, __HIP_MEMORY_SCOPE_AGENT);
        for (;;) {
            __syncthreads();
            if (threadIdx.x == 0) { *qword = ticket; if (ticket < 64) ticket = (int)__hip_atomic_fetch_add(qctr + 64 * q, 1u, __ATOMIC_RELAXED, __HIP_MEMORY_SCOPE_AGENT); }
            __syncthreads();
            idx = *qword;
            if (idx >= 64) break;
            rglru_item(p, z, mixb, ssq, lds, gran, q, idx & 7, idx >> 3);
        }
        if (threadIdx.x == 0 && idx < QITEMS) ticket = (int)__hip_atomic_fetch_add(qctr + 64 * q, 1u, __ATOMIC_RELAXED, __HIP_MEMORY_SCOPE_AGENT);
        while (idx < QITEMS) {
            const int a = idx - 64; if (attn_item<true>(lds, z, mixb, ssq, q, 31 - (a >> 1), a & 1)) attn_item<false>(lds, z, mixb, ssq, q, 31 - (a >> 1), a & 1);
            __syncthreads();
            if (threadIdx.x == 0) { *qword = ticket; if (ticket < QITEMS) ticket = (int)__hip_atomic_fetch_add(qctr + 64 * q, 1u, __ATOMIC_RELAXED, __HIP_MEMORY_SCOPE_AGENT); }
            __syncthreads();
            idx = *qword;
        }
    }
}

#define XB_TMO      128
#define XB_XCNT(j)  (256  + 64 * (j))
#define XB_XSUB(j)  (1280 + 64 * (j))
#define XB_XGEN(j)  (2304 + 64 * (j))
#define XB_TOP      3328
#define XB_TOPGEN   3392
#define XCD_BAR_WORDS 3456
#define XB_SPIN_CAP (1u << 18)
__device__ __forceinline__ unsigned xb_ld(unsigned* p)              { return __hip_atomic_load(p, __ATOMIC_RELAXED, __HIP_MEMORY_SCOPE_AGENT); }
__device__ __forceinline__ unsigned xb_add(unsigned* p, unsigned v) { return __hip_atomic_fetch_add(p, v, __ATOMIC_RELAXED, __HIP_MEMORY_SCOPE_AGENT); }
__device__ __forceinline__ unsigned xb_xcc_id() { return (unsigned)__builtin_amdgcn_s_getreg((3 << 11) | 20) & 0xFu; }
#define XB_SPIN(cond, bar) do { unsigned _sp = 0; while (cond) { __builtin_amdgcn_s_sleep(1); \
    if ((++_sp & 255u) == 0u) { if (xb_ld(&(bar)[XB_TMO])) break; if (_sp > XB_SPIN_CAP) { atomicAdd(&(bar)[XB_TMO], 1u); break; } } } } while (0)
struct XcdBarrier { unsigned* bar; unsigned x; volatile LAS unsigned* st; };
__device__ __forceinline__ XcdBarrier xcd_barrier_post(unsigned* bar, volatile LAS unsigned* st) {
    XcdBarrier b; b.bar = bar; b.x = xb_xcc_id(); b.st = st;
    if (threadIdx.x == 0) (void)xb_add(&bar[XB_XCNT(b.x)], 1u);
    return b;
}
__device__ __forceinline__ void xcd_barrier_complete(unsigned* bar, unsigned x, unsigned& nloc, unsigned& nx) {
    const unsigned G = gridDim.x * gridDim.y * gridDim.z;
    unsigned sum, cnt, mine, sp = 0u;
    for (;;) {
        sum = 0u; cnt = 0u; mine = 0u;
#pragma unroll
        for (unsigned j = 0; j < 16; ++j) { const unsigned c = xb_ld(&bar[XB_XCNT(j)]); sum += c; cnt += (c > 0u) ? 1u : 0u; mine = (j == x) ? c : mine; }
        if (sum == G) break;
        __builtin_amdgcn_s_sleep(1);
        if ((++sp & 255u) == 0u) { if (xb_ld(&bar[XB_TMO])) break; if (sp > XB_SPIN_CAP) { atomicAdd(&bar[XB_TMO], 1u); break; } }
    }
    nloc = mine > 0u ? mine : 1u; nx = cnt > 0u ? cnt : 1u;
}
__device__ __forceinline__ void xcd_barrier(const XcdBarrier& b) {
    asm volatile("s_waitcnt vmcnt(0)" ::: "memory");
    __syncthreads();
    if (threadIdx.x == 0) {
        unsigned* bar = b.bar;
        __builtin_amdgcn_s_waitcnt(0);
        unsigned nloc = b.st[0], nx = b.st[1];
        if (nloc == 0u) { xcd_barrier_complete(bar, b.x, nloc, nx); b.st[0] = nloc; b.st[1] = nx; }
        const unsigned old = xb_add(&bar[XB_XSUB(b.x)], 1u);
        const unsigned gen = old / nloc;
        if (old + 1u == (gen + 1u) * nloc) {
            __builtin_amdgcn_fence(__ATOMIC_RELEASE, "agent");
            asm volatile("s_waitcnt vmcnt(0)" ::: "memory");
            const unsigned og = xb_add(&bar[XB_TOP], 1u);
            const unsigned tg = og / nx;
            if (og + 1u == (tg + 1u) * nx) xb_add(&bar[XB_TOPGEN], 1u);
            else XB_SPIN(xb_ld(&bar[XB_TOPGEN]) == tg, bar);
            __builtin_amdgcn_fence(__ATOMIC_ACQUIRE, "agent");
            xb_add(&bar[XB_XGEN(b.x)], 1u);
            asm volatile("s_waitcnt vmcnt(0)" ::: "memory");
        } else {
            XB_SPIN(xb_ld(&bar[XB_XGEN(b.x)]) == gen, bar);
            __builtin_amdgcn_fence(__ATOMIC_ACQUIRE, "agent");
            asm volatile("s_waitcnt vmcnt(0)" ::: "memory");
        }
    }
    __syncthreads();
}


__device__ __forceinline__ Params load_params() {
    unsigned long long a = (unsigned long long)__builtin_amdgcn_kernarg_segment_ptr(); asm volatile("" : "+s"(a));
    const __attribute__((address_space(4))) unsigned long long* q = (const __attribute__((address_space(4))) unsigned long long*)a;
    typedef __attribute__((address_space(1))) unsigned char* gptr_t;
    Params p; unsigned char** d = (unsigned char**)&p;
#pragma unroll
    for (int i = 0; i < (int)(sizeof(Params) / 8); ++i) d[i] = (unsigned char*)(gptr_t)q[i];
    return p;
}

__global__ void __launch_bounds__(NTHR) k_mega(Params p_arg) {
    extern __shared__ __attribute__((aligned(16))) unsigned char lds_raw[];
    LAS unsigned char* lds = (LAS unsigned char*)lds_raw;
    const int G = gridDim.x; const int bx = blockIdx.x;
    volatile LAS unsigned* misc = (volatile LAS unsigned*)(lds + MISC_OFF);
    if (threadIdx.x < 64) misc[threadIdx.x] = 0u;
    __syncthreads();
    const XcdBarrier xbar = xcd_barrier_post((unsigned*)(load_params().ws + WS_CTL + 65536), misc + 8);
    const int vcu = (G % 8 == 0) ? (bx % 8) * (G / 8) + bx / 8 : bx;

    constexpr int NWG1 = (T / 256) * (INW / 256);
    const int n_idle = (NWG1 % G) ? G - (NWG1 % G) : 0, idle_idx = bx - (NWG1 % G);
    const int e_split = (n_idle >= 96) ? 4 : NE;
    { const Params p = load_params(); ph_prologue(p, lds, vcu, G, e_split); }
    xcd_barrier(xbar);
    {
        const Params p = load_params();
        pg8::DenseOrder So; So.init((const bf16_t*)(p.ws + WS_XB), (const bf16_t*)(p.ws + WS_WIN), T, INW, D, G, bx);
        pg8::EpiZ E{(bf16_t*)(p.ws + WS_Z), INW};
        pg8::gemm_phase(lds, D, So, E);
        if (e_split < NE && idle_idx >= 0) p1_tail_convert(p, lds, idle_idx, n_idle, e_split);
    }
    xcd_barrier(xbar);
    { const Params p = load_params(); ph_mixers(p, (const bf16_t*)(p.ws + WS_Z), (bf16_t*)(p.ws + WS_MIX), (float*)(p.ws + WS_SSQ), lds, (unsigned*)(p.ws + WS_CTL + 8192)); }
    xcd_barrier(xbar);
    {
        const Params p = load_params();
        pg8::DenseOrder So; So.init((const bf16_t*)(p.ws + WS_MIX), (const bf16_t*)(p.ws + WS_WOUT), T, D, D, G, bx);
        pg8::EpiH E{p.ws, p.out, TAB_OFF};
        pg8::gemm_phase(lds, D, So, E);
    }
    xcd_barrier(xbar);
    { const Params p = load_params();
      ph_router3(p, p.out, (int*)(p.ws + WS_CTL + 4096), (int*)(p.ws + WS_LIST), (float*)(p.ws + WS_LIST + MiB), (float*)(p.ws + WS_ROUTE), lds); }
    xcd_barrier(xbar);
    LAS int* meta = (LAS int*)(lds + META_OFF);
    if (threadIdx.x == 0) { const int* gcount = (const int*)(load_params().ws + WS_CTL + 4096); int base = 0; for (int e = 0; e < NE; ++e) { const int cnt = gcount[e]; meta[e] = base; meta[32 + e] = cnt; base += (cnt + 255) >> 8; } meta[16] = base; }
    __syncthreads();
    const int ntiles = __builtin_amdgcn_readfirstlane(meta[16]);
    {
        const Params p = load_params();
        pg8::MoeOrder<0> So{(const bf16_t*)(p.ws + WS_XB), (const bf16_t*)(p.ws + WS_WGU), (const int*)(p.ws + WS_LIST), meta, D, G, bx, ntiles};
        pg8::EpiHid E{(bf16_t*)(p.ws + WS_HID), (const float*)(p.ws + WS_ROUTE), meta};
        pg8::gemm_phase(lds, D, So, E);
        { const int r5 = (ntiles * 4) % G; if (r5 == 0) p5a_tail_convert(p, lds, bx, G); else if (bx >= r5) p5a_tail_convert(p, lds, bx - r5, G - r5); }
    }
    xcd_barrier(xbar);
    {
        const Params p = load_params();
        pg8::MoeOrder<1> So{(const bf16_t*)(p.ws + WS_HID), (const bf16_t*)(p.ws + WS_WD), (const int*)(p.ws + WS_LIST), meta, DFF, G, bx, ntiles};
        pg8::EpiY E{(bf16_t*)(p.ws + WS_Z), (const int*)(p.ws + WS_LIST), (const float*)(p.ws + WS_LIST + MiB), meta};
        pg8::gemm_phase(lds, DFF, So, E);
    }
    xcd_barrier(xbar);
    { const Params p = load_params(); ph_final(p, (const bf16_t*)(p.ws + WS_XB), (const bf16_t*)(p.ws + WS_Z), p.out); }
}

extern "C" void kernel_launch(void* const* d_in, const int* in_sizes, int n_in, void* d_out, int out_size, void* d_ws, size_t ws_size, hipStream_t stream) {
    static int grid_blocks = 0;
    if (!grid_blocks) {
        if (ws_size < WS_END) { fprintf(stderr, "kernel_launch: workspace too small (%zu < %zu)\n", ws_size, (size_t)WS_END); grid_blocks = -1; return; }
        int dev = 0, cus = 0, per_cu = 0;
        (void)hipGetDevice(&dev);
        (void)hipDeviceGetAttribute(&cus, hipDeviceAttributeMultiprocessorCount, dev);
        (void)hipFuncSetAttribute((const void*)k_mega, hipFuncAttributeMaxDynamicSharedMemorySize, LDS_BYTES);
        (void)hipOccupancyMaxActiveBlocksPerMultiprocessor(&per_cu, (const void*)k_mega, NTHR, LDS_BYTES);
        if (per_cu < 1) { fprintf(stderr, "kernel_launch: occupancy query says %d blocks per CU: not launching\n", per_cu); grid_blocks = -1; return; }
        grid_blocks = cus;
    }
    if (grid_blocks < 0) return;
    Params p{};
    const float** f = (const float**)&p;
    for (int i = 0; i < 23; ++i) f[i] = (const float*)d_in[i];
    p.out = (float*)d_out;
    p.ws = (unsigned char*)d_ws;
    (void)hipMemsetAsync((char*)d_ws + WS_CTL, 0, CTL_ZERO_BYTES, stream);
    hipLaunchKernelGGL(k_mega, dim3(grid_blocks), dim3(NTHR), LDS_BYTES, stream, p);
    hipError_t e = hipPeekAtLastError();
    if (e != hipSuccess) fprintf(stderr, "launch failed: %s (grid %d)\n", hipGetErrorString(e), grid_blocks);
}
```

```cpp
#include <hip/hip_runtime.h>
#include <cstdio>
#include <cstdint>

#define LAS __attribute__((address_space(3)))
typedef unsigned short bf16_t;
typedef short bf16x8 __attribute__((ext_vector_type(8)));
typedef float f32x4 __attribute__((ext_vector_type(4)));
typedef float f32x2 __attribute__((ext_vector_type(2)));
typedef unsigned u32x4 __attribute__((ext_vector_type(4)));
typedef unsigned u32x2 __attribute__((ext_vector_type(2)));

constexpr int D = 1024, NB = 8, S = 2048, T = NB * S;
constexpr int RW = 512, RHD = 64;
constexpr int CHUNK = 64, LEFT = 8, BAND = 576, MAXREL = 128;
constexpr int INW = 2560;
constexpr int NE = 16, DFF = 512;
constexpr float EPS = 1e-6f;
constexpr int NTHR = 512, NWAVES = 8;
constexpr int SSQW = 40;

constexpr size_t MiB = 1u << 20;
constexpr size_t WS_CTL = 0, CTL_BYTES = 2 * MiB, CTL_ZERO_BYTES = 128 * 1024 + 512 * 1024;
constexpr size_t WS_WIN = 2 * MiB;
constexpr size_t WS_WOUT = 7 * MiB;
constexpr size_t WS_WGU = 9 * MiB;
constexpr size_t WS_WD = 41 * MiB;
constexpr size_t WS_XB = 57 * MiB;
constexpr size_t WS_Z = 89 * MiB;
constexpr size_t WS_MIX = 169 * MiB;
constexpr size_t WS_HID = 201 * MiB;
constexpr size_t WS_SSQ = 237 * MiB;
constexpr size_t WS_LIST = 240 * MiB;
constexpr size_t WS_ROUTE = 242 * MiB;
constexpr size_t WS_RWT = 243 * MiB;
constexpr size_t WS_GWT = 244 * MiB;
constexpr size_t WS_END = 245 * MiB;

constexpr int RING_BYTES = 131072, TAB_OFF = RING_BYTES, META_OFF = RING_BYTES + 4096, MISC_OFF = RING_BYTES + 15360, LDS_BYTES = 147456;

struct Params {
    const float *x, *norm1_g, *w_in, *conv_w, *conv_b, *w_rg_a, *b_rg_a, *w_rg_x, *b_rg_x, *lru_lambda, *rel_bias,
        *g_rec_out, *g_att_out, *w_out, *norm2_g, *w_group, *b_group, *w_router, *b_router, *w_e_gate, *w_e_up, *w_e_down, *final_g;
    float* out;
    unsigned char* ws;
};

__device__ __forceinline__ float wave_sum(float v) {
#pragma unroll
    for (int o = 32; o > 0; o >>= 1) v += __shfl_xor(v, o);
    return v;
}
__device__ __forceinline__ float sigmoidf_(float x) { return 1.0f / (1.0f + expf(-x)); }
__device__ __forceinline__ float gelu_tanh(float x) { return 0.5f * x * (1.0f + tanhf(0.7978845608028654f * (x + 0.044715f * x * x * x))); }
__device__ __forceinline__ unsigned f2bf(float f) { unsigned u = __builtin_bit_cast(unsigned, f); return (u + 0x7fffu + ((u >> 16) & 1u)) >> 16; }
__device__ __forceinline__ unsigned pk2(float lo, float hi) { return f2bf(lo) | (f2bf(hi) << 16); }
__device__ __forceinline__ float bf2f(bf16_t b) { return __builtin_bit_cast(float, ((unsigned)b) << 16); }
__device__ __forceinline__ unsigned cvt_pk_bf16(float lo, float hi) { unsigned r; asm volatile("v_cvt_pk_bf16_f32 %0, %1, %2" : "=v"(r) : "v"(lo), "v"(hi)); return r; }
#define LDS_WAIT() asm volatile("s_waitcnt lgkmcnt(0)" ::: "memory")
__device__ __forceinline__ int opaque_tid() { int t = threadIdx.x; asm volatile("" : "+v"(t)); return t; }

namespace pg8 {
constexpr int BM = 256, BK = 64, HALF = 128, HTB = HALF * BK * 2, STAGE_BYTES = 8 * HTB, NXCD = 8, WGM = 8;
__device__ __forceinline__ int lds_byte(int r, int c) { const int st = (r >> 4) * 2 + (c >> 5), rr = r & 15, cc = c & 31, ob = rr * 64 + cc * 2; return st * 1024 + (ob ^ (((ob >> 9) & 1) << 5)); }
__device__ __forceinline__ void stage_rc(int b, int& R, int& C) { const int st = b / 1024, sb = b % 1024, swz = sb ^ (((sb >> 9) & 1) << 5); R = (st >> 1) * 16 + swz / 64; C = (st & 1) * 32 + (swz % 64) / 2; }
__device__ __forceinline__ int perm32(int rho) { const int n = rho >> 4, i = rho & 15; return 8 * (i >> 2) + 4 * n + (i & 3); }

struct Unit { int pm, pn, e, rows; };

struct DenseOrder {
    const bf16_t* A; const bf16_t* Bt; int K; int nM, nN, nwg, G, c;
    __device__ void init(const bf16_t* A_, const bf16_t* Bt_, int M, int N, int K_, int G_, int c_) { A = A_; Bt = Bt_; K = K_; nM = M / BM; nN = N / BM; nwg = nM * nN; G = G_; c = c_; }
    __device__ __forceinline__ bool next(int i, Unit& u) const {
        const long L = (long)i * G + c; if (L >= nwg) return false;
        int wgid = (int)L; { const int q = nwg / NXCD, r = nwg % NXCD, xcd = wgid % NXCD, off = wgid / NXCD; wgid = (xcd < r ? xcd * (q + 1) : r * (q + 1) + (xcd - r) * q) + off; }
        const int nig = WGM * nN, gid = wgid / nig, fm = gid * WGM, gsz = (nM - fm) < WGM ? (nM - fm) : WGM;
        u.pm = fm + ((wgid % nig) % gsz); u.pn = (wgid % nig) / gsz; u.e = 0; u.rows = BM; return true;
    }
    __device__ __forceinline__ void addr(const Unit& u, const int (&RA)[2], const int (&CA)[2], const char*& aBase, const char*& bBase, unsigned (&va)[2][2]) const {
        aBase = (const char*)A; bBase = (const char*)Bt + (size_t)u.pn * BM * K * 2;
#pragma unroll
        for (int h = 0; h < 2; ++h)
#pragma unroll
            for (int i = 0; i < 2; ++i) va[h][i] = (unsigned)(((size_t)(u.pm * BM + h * HALF + RA[i]) * K + CA[i]) * 2);
    }
};

template <class Epi, class Sched>
__device__ __forceinline__ void gemm_phase(LAS unsigned char* lds, const int K, const Sched& S, const Epi& E) {
    int tid_ = threadIdx.x; asm volatile("" : "+v"(tid_));
    const int tid = tid_, wid = __builtin_amdgcn_readfirstlane(tid >> 6), lane = tid & 63, wr = wid >> 2, wc = wid & 3, fr = lane & 15, fq = lane >> 4;
    const int nt = K / BK;
    int RA[2], CA[2]; unsigned voffB[2];
#pragma unroll
    for (int i = 0; i < 2; ++i) { int R, C; stage_rc(tid * 16 + i * 8192, R, C); RA[i] = R; CA[i] = C; const int Rb = Epi::PERM ? ((R & ~31) + perm32(R & 31)) : R; voffB[i] = (unsigned)(Rb * K + C) * 2u; }
    const size_t kstep = (size_t)(BK * 2);
    const size_t hstepB = (size_t)HALF * K * 2;
    const unsigned ldsw = (unsigned)wid * 1024u;
    const int aoff = lds_byte(wr * 64 + fr, fq * 8), boff = lds_byte(wc * 32 + fr, fq * 8);
#define PG8_SA(b, h) (((b) * 2 + (h)) * HTB)
#define PG8_SB(b, h) ((4 + (b) * 2 + (h)) * HTB)
#define PG8_STAGE_B(bufoff, gbase) do { _Pragma("unroll") for (int _i = 0; _i < 2; ++_i) \
        __builtin_amdgcn_global_load_lds((const unsigned*)((const char*)(gbase) + voffB[_i]), (LAS unsigned*)(lds + (bufoff) + ldsw + _i * 8192), 16, 0, 0); } while (0)
#define PG8_STAGE_A(bufoff, gbase, v0, v1) do { \
        __builtin_amdgcn_global_load_lds((const unsigned*)((const char*)(gbase) + (v0)), (LAS unsigned*)(lds + (bufoff) + ldsw), 16, 0, 0); \
        __builtin_amdgcn_global_load_lds((const unsigned*)((const char*)(gbase) + (v1)), (LAS unsigned*)(lds + (bufoff) + ldsw + 8192), 16, 0, 0); } while (0)
#define PG8_LDA(dst, b, h) do { _Pragma("unroll") for (int m = 0; m < 4; ++m) _Pragma("unroll") for (int k = 0; k < 2; ++k) dst[m][k] = *(const LAS bf16x8*)(lds + PG8_SA(b, h) + aoff + m * 2048 + k * 1024); } while (0)
#define PG8_LDB(dst, b, h) do { _Pragma("unroll") for (int n = 0; n < 2; ++n) _Pragma("unroll") for (int k = 0; k < 2; ++k) dst[n][k] = *(const LAS bf16x8*)(lds + PG8_SB(b, h) + boff + n * 2048 + k * 1024); } while (0)
#define PG8_MMA(ai, bj, At, Bt) do { __builtin_amdgcn_s_setprio(1); _Pragma("unroll") for (int m = 0; m < 4; ++m) _Pragma("unroll") for (int n = 0; n < 2; ++n) _Pragma("unroll") for (int k = 0; k < 2; ++k) \
        acc[ai][bj][m][n] = __builtin_amdgcn_mfma_f32_16x16x32_bf16(Bt[n][k], At[m][k], acc[ai][bj][m][n], 0, 0, 0); __builtin_amdgcn_s_setprio(0); } while (0)
#define PG8_WAIT_V(n) asm volatile("s_waitcnt vmcnt(" #n ")" ::: "memory")
#define PG8_WAIT_L(n) asm volatile("s_waitcnt lgkmcnt(" #n ")" ::: "memory")
#define PG8_BAR __builtin_amdgcn_s_barrier()
#define PG8_SCHED __builtin_amdgcn_sched_barrier(0)
    Unit cur, nxt; int ui = 0;
    if (!S.next(0, cur)) return;
    f32x4 acc[2][2][4][2];
#pragma unroll
    for (int a = 0; a < 2; ++a)
#pragma unroll
        for (int b = 0; b < 2; ++b)
#pragma unroll
            for (int m = 0; m < 4; ++m)
#pragma unroll
                for (int n = 0; n < 2; ++n) acc[a][b][m][n] = (f32x4){0.f, 0.f, 0.f, 0.f};
    bf16x8 At[4][2], B0[2][2], B1[2][2];
    const char *cA, *cB, *nA, *nB; unsigned cva[2][2], nva[2][2];
    S.addr(cur, RA, CA, cA, cB, cva);
    E.prepare(cur, ui, lds);
    PG8_STAGE_B(PG8_SB(0, 0), cB); PG8_STAGE_A(PG8_SA(0, 0), cA, cva[0][0], cva[0][1]); PG8_STAGE_B(PG8_SB(0, 1), cB + hstepB); PG8_STAGE_A(PG8_SA(0, 1), cA, cva[1][0], cva[1][1]);
    if (wr == 1) PG8_BAR;
    PG8_WAIT_V(4); PG8_BAR;
    PG8_STAGE_B(PG8_SB(1, 0), cB + kstep); PG8_STAGE_A(PG8_SA(1, 0), cA + kstep, cva[0][0], cva[0][1]); PG8_STAGE_B(PG8_SB(1, 1), cB + hstepB + kstep);
    PG8_WAIT_V(6); PG8_BAR;
    for (;;) {
        const bool has_next = S.next(ui + 1, nxt);
        if (has_next) { S.addr(nxt, RA, CA, nA, nB, nva); }
        else { nA = cA; nB = cB;
#pragma unroll
            for (int h = 0; h < 2; ++h)
#pragma unroll
                for (int i = 0; i < 2; ++i) nva[h][i] = cva[h][i]; }
        for (int t = 0; t < nt; t += 2) {
            const bool last = (t == nt - 2);
            if (Epi::MIDSCALE && t == nt / 2) E.midscale(acc, wr, fr, ui, lds);
            const char* a1 = cA + (size_t)(t + 1) * kstep;
            const char* a2 = last ? nA : cA + (size_t)(t + 2) * kstep; const char* b2 = last ? nB : cB + (size_t)(t + 2) * kstep;
            const char* a3 = a2 + kstep; const char* b3 = b2 + kstep;
            const unsigned x00 = last ? nva[0][0] : cva[0][0], x01 = last ? nva[0][1] : cva[0][1], x10 = last ? nva[1][0] : cva[1][0], x11 = last ? nva[1][1] : cva[1][1];
            if (last && has_next) E.prepare(nxt, ui + 1, lds);
            PG8_LDB(B0, 0, 0); PG8_SCHED; PG8_LDA(At, 0, 0); PG8_STAGE_A(PG8_SA(1, 1), a1, cva[1][0], cva[1][1]);
            PG8_WAIT_L(8); PG8_BAR; PG8_WAIT_L(0); PG8_MMA(0, 0, At, B0); PG8_BAR; PG8_SCHED;
            PG8_LDB(B1, 0, 1); PG8_STAGE_B(PG8_SB(0, 0), b2);
            PG8_BAR; PG8_WAIT_L(0); PG8_MMA(0, 1, At, B1); PG8_BAR;
            PG8_LDA(At, 0, 1); PG8_STAGE_A(PG8_SA(0, 0), a2, x00, x01);
            PG8_BAR; PG8_WAIT_L(0); PG8_MMA(1, 0, At, B0); PG8_BAR; PG8_SCHED;
            PG8_STAGE_B(PG8_SB(0, 1), b2 + hstepB);
            PG8_WAIT_V(6); PG8_BAR; PG8_MMA(1, 1, At, B1); PG8_BAR;
            PG8_LDB(B0, 1, 0); PG8_SCHED; PG8_LDA(At, 1, 0); PG8_STAGE_A(PG8_SA(0, 1), a2, x10, x11);
            PG8_WAIT_L(8); PG8_BAR; PG8_WAIT_L(0); PG8_MMA(0, 0, At, B0); PG8_BAR; PG8_SCHED;
            PG8_LDB(B1, 1, 1); PG8_STAGE_B(PG8_SB(1, 0), b3);
            PG8_BAR; PG8_WAIT_L(0); PG8_MMA(0, 1, At, B1); PG8_BAR;
            PG8_LDA(At, 1, 1); PG8_STAGE_A(PG8_SA(1, 0), a3, x00, x01);
            PG8_BAR; PG8_WAIT_L(0); PG8_MMA(1, 0, At, B0); PG8_BAR; PG8_SCHED;
            PG8_STAGE_B(PG8_SB(1, 1), b3 + hstepB);
            PG8_WAIT_V(6); PG8_BAR; PG8_MMA(1, 1, At, B1); PG8_BAR;
        }
        E(acc, cur, wr, wc, fr, fq, ui, lds);
        if (!has_next) break;
        E.prepare_late(nxt, ui + 1, lds);
#pragma unroll
        for (int a = 0; a < 2; ++a)
#pragma unroll
            for (int b = 0; b < 2; ++b)
#pragma unroll
                for (int m = 0; m < 4; ++m)
#pragma unroll
                    for (int n = 0; n < 2; ++n) acc[a][b][m][n] = (f32x4){0.f, 0.f, 0.f, 0.f};
        cur = nxt; cA = nA; cB = nB; ++ui;
#pragma unroll
        for (int h = 0; h < 2; ++h)
#pragma unroll
            for (int i = 0; i < 2; ++i) cva[h][i] = nva[h][i];
    }
    PG8_WAIT_V(0);
    if (wr == 0) PG8_BAR;
    PG8_BAR;
#undef PG8_SA
#undef PG8_SB
#undef PG8_STAGE_A
#undef PG8_STAGE_B
#undef PG8_LDA
#undef PG8_LDB
#undef PG8_MMA
#undef PG8_WAIT_V
#undef PG8_WAIT_L
#undef PG8_BAR
#undef PG8_SCHED
}

struct EpiZ {
    static constexpr bool PERM = true, MIDSCALE = false;
    bf16_t* O; int ldc;
    __device__ __forceinline__ void prepare(const Unit&, int, LAS unsigned char*) const {}
    __device__ __forceinline__ void prepare_late(const Unit&, int, LAS unsigned char*) const {}
    __device__ __forceinline__ void midscale(f32x4 (&)[2][2][4][2], int, int, int, LAS unsigned char*) const {}
    __device__ __forceinline__ void operator()(const f32x4 (&acc)[2][2][4][2], const Unit& u, int wr, int wc, int fr, int fq, int, LAS unsigned char*) const {
        const int row0 = u.pm * BM + wr * 64 + fr, col0 = u.pn * BM + wc * 32 + 8 * fq;
#pragma unroll
        for (int ai = 0; ai < 2; ++ai)
#pragma unroll
            for (int m = 0; m < 4; ++m) { bf16_t* rowp = O + (size_t)(row0 + ai * HALF + m * 16) * ldc + col0;
#pragma unroll
                for (int bj = 0; bj < 2; ++bj) { const f32x4 v0 = acc[ai][bj][m][0], v1 = acc[ai][bj][m][1];
                    u32x4 w; w.x = cvt_pk_bf16(v0[0], v0[1]); w.y = cvt_pk_bf16(v0[2], v0[3]); w.z = cvt_pk_bf16(v1[0], v1[1]); w.w = cvt_pk_bf16(v1[2], v1[3]);
                    *(u32x4*)(rowp + bj * HALF) = w; } }
    }
};
struct EpiH {
    static constexpr bool PERM = false, MIDSCALE = true;
    unsigned char* ws; float* part; int tab_off;
    __device__ __forceinline__ void prepare_late(const Unit&, int, LAS unsigned char*) const {}
    __device__ __forceinline__ void prepare(const Unit& u, int ui, LAS unsigned char* lds) const {
        LAS f32x4* tab = (LAS f32x4*)(lds + tab_off) + (ui & 1) * 256;
        unsigned long long wsb = (unsigned long long)ws; asm volatile("" : "+s"(wsb));
        const float* ssq = (const float*)(wsb + WS_SSQ); const float* rinv1 = (const float*)(wsb + WS_GWT + 256 * 1024);
        if (threadIdx.x < 256) {
            const float* sp = ssq + (size_t)(u.pm * BM + threadIdx.x) * SSQW; float sa = 0.f, sb = 0.f;
#pragma unroll
            for (int i = 0; i < 8; ++i) { const f32x4 v = *(const f32x4*)(sp + 4 * i); sa += (v[0] + v[1]) + (v[2] + v[3]); }
#pragma unroll
            for (int i = 8; i < 10; ++i) { const f32x4 v = *(const f32x4*)(sp + 4 * i); sb += (v[0] + v[1]) + (v[2] + v[3]); }
            const float ra = rsqrtf(sa * (1.0f / 512.0f) + EPS), rb = rsqrtf(sb * (1.0f / 512.0f) + EPS);
            tab[threadIdx.x] = (f32x4){ra / rb, rb, rinv1[u.pm * BM + threadIdx.x], 0.f};
        }
    }
    __device__ __forceinline__ void midscale(f32x4 (&acc)[2][2][4][2], int wr, int fr, int ui, LAS unsigned char* lds) const {
        const LAS f32x4* tab = (const LAS f32x4*)(lds + tab_off) + (ui & 1) * 256;
#pragma unroll
        for (int ai = 0; ai < 2; ++ai)
#pragma unroll
            for (int m = 0; m < 4; ++m) { const float s = tab[ai * HALF + wr * 64 + m * 16 + fr][0];
#pragma unroll
                for (int bj = 0; bj < 2; ++bj)
#pragma unroll
                    for (int n = 0; n < 2; ++n) acc[ai][bj][m][n] = acc[ai][bj][m][n] * s; }
    }
    __device__ __forceinline__ void operator()(const f32x4 (&acc)[2][2][4][2], const Unit& u, int wr, int wc, int fr, int fq, int ui, LAS unsigned char* lds) const {
        const LAS f32x4* tab = (const LAS f32x4*)(lds + tab_off) + (ui & 1) * 256;
        const float* rwt = (const float*)(ws + WS_RWT); bf16_t* hb = (bf16_t*)(ws + WS_XB);
        const int row0 = u.pm * BM + wr * 64 + fr, col0 = u.pn * BM + wc * 32 + 4 * fq;
        float br[2][2][4], bg[2][2][4];
#pragma unroll
        for (int bj = 0; bj < 2; ++bj)
#pragma unroll
            for (int n = 0; n < 2; ++n)
#pragma unroll
                for (int j = 0; j < 4; ++j) { const int c = col0 + bj * HALF + n * 16 + j; br[bj][n][j] = rwt[fr * 1028 + c]; bg[bj][n][j] = rwt[(16 + (fr & 3)) * 1028 + c]; }
#pragma unroll
        for (int ai = 0; ai < 2; ++ai) {
            u32x2 xv[4][2][2];
#pragma unroll
            for (int m = 0; m < 4; ++m)
#pragma unroll
                for (int bj = 0; bj < 2; ++bj)
#pragma unroll
                    for (int n = 0; n < 2; ++n) xv[m][bj][n] = *(const u32x2*)(hb + (size_t)(row0 + ai * HALF + m * 16) * D + col0 + bj * HALF + n * 16);
#pragma unroll
            for (int m = 0; m < 4; ++m) { const f32x4 tv = tab[ai * HALF + wr * 64 + m * 16 + fr]; const float s = tv[1], ri = tv[2]; const size_t ro = (size_t)(row0 + ai * HALF + m * 16) * D + col0;
                f32x4 ar = {0.f, 0.f, 0.f, 0.f}, ag = {0.f, 0.f, 0.f, 0.f}; float ssl = 0.f;
#pragma unroll
                for (int bj = 0; bj < 2; ++bj)
#pragma unroll
                    for (int n = 0; n < 2; ++n) { const u32x2 xr = xv[m][bj][n];
                        const f32x4 xf = {__builtin_bit_cast(float, xr[0] << 16), __builtin_bit_cast(float, xr[0] & 0xffff0000u), __builtin_bit_cast(float, xr[1] << 16), __builtin_bit_cast(float, xr[1] & 0xffff0000u)};
                        const f32x4 hv = xf * ri + acc[ai][bj][m][n] * s;
                        *(u32x2*)(hb + ro + bj * HALF + n * 16) = (u32x2){cvt_pk_bf16(hv[0], hv[1]), cvt_pk_bf16(hv[2], hv[3])};
#pragma unroll
                        for (int j = 0; j < 4; ++j) { ar = __builtin_amdgcn_mfma_f32_16x16x4f32(hv[j], br[bj][n][j], ar, 0, 0, 0); ag = __builtin_amdgcn_mfma_f32_16x16x4f32(hv[j], bg[bj][n][j], ag, 0, 0, 0); ssl += hv[j] * hv[j]; } }
                ssl += __shfl_xor(ssl, 16); ssl += __shfl_xor(ssl, 32);
                float* prow = part + ((size_t)(u.pm * BM + ai * HALF + wr * 64 + m * 16) * 16 + (u.pn * 4 + wc)) * 24;
#pragma unroll
                for (int rg_ = 0; rg_ < 4; ++rg_) { float* pr = prow + (size_t)(4 * fq + rg_) * (16 * 24); pr[fr] = ar[rg_]; if (fr < 4) pr[16 + fr] = ag[rg_]; }
                if (fq == 0) prow[(size_t)fr * (16 * 24) + 20] = ssl;
            }
        }
    }
};

template <int MODE>
struct MoeOrder {
    const bf16_t* A; const bf16_t* Bt; const int* tok_list; const LAS int* meta; int K, G, c, ntiles; bool xl;
    __device__ __forceinline__ bool next(int i, Unit& u) const {
        int L;
        if (xl) { const int x = c & 7, lr = c >> 3, Gl = G >> 3, lo = (x * ntiles) >> 3, ntx = (((x + 1) * ntiles) >> 3) - lo, U = 4 * ntx; int Ll;
            if (MODE == 0) { Ll = i * Gl + lr; if (Ll >= U) return false; }
            else { const int r = U % Gl, FG = U - r;
                if (lr < r) { if (i > 0) return false; Ll = FG + lr; } else { Ll = (lr - r) + i * (Gl - r); if (Ll >= FG) return false; } }
            L = ((lo + (Ll >> 2)) << 2) | (Ll & 3); }
        else { L = i * G + c; if (L >= ntiles * 4) return false; }
        const int mt = L >> 2; int e = 0;
#pragma unroll
        for (int j = 1; j < NE; ++j) e += (mt >= meta[j]) ? 1 : 0;
        u.pm = mt; u.pn = L & 3; u.e = e; u.rows = meta[32 + e] - (mt - meta[e]) * BM; return true;
    }
    __device__ __forceinline__ void addr(const Unit& u, const int (&RA)[2], const int (&CA)[2], const char*& aBase, const char*& bBase, unsigned (&va)[2][2]) const {
        aBase = (const char*)A; bBase = (const char*)Bt + ((size_t)u.e * D + (size_t)u.pn * BM) * K * 2;
        const int slot0 = (u.pm - meta[u.e]) * BM;
#pragma unroll
        for (int h = 0; h < 2; ++h)
#pragma unroll
            for (int i = 0; i < 2; ++i) {
                const int r = h * HALF + RA[i];
                if (MODE == 0) { const int tl = tok_list[u.e * T + slot0 + r] >> 1; const int tok = (r < u.rows) ? tl : 0; va[h][i] = (unsigned)(((size_t)tok * K + CA[i]) * 2); }
                else va[h][i] = (unsigned)(((size_t)(u.pm * BM + r) * K + CA[i]) * 2);
            }
    }
};
struct EpiHid {
    static constexpr bool PERM = true, MIDSCALE = false;
    bf16_t* hid; const float* r_list; const LAS int* meta; int tab_off; unsigned* ready;
    __device__ __forceinline__ void prepare(const Unit& u, int ui, LAS unsigned char* lds) const { if (ui == 0) prepare_late(u, ui, lds); }
    __device__ __forceinline__ void prepare_late(const Unit& u, int ui, LAS unsigned char* lds) const {
        const int tid = threadIdx.x;
        if (tid < 256) { const int slot0 = (u.pm - __builtin_amdgcn_readfirstlane(meta[u.e])) * BM, wv = __builtin_amdgcn_readfirstlane(tid >> 6);
            const unsigned* sb = (const unsigned*)(r_list + u.e * T + slot0 + wv * 64);
            __builtin_amdgcn_global_load_lds(sb + (tid & 63), (LAS unsigned*)(lds + tab_off + (ui & 1) * 1024 + wv * 256), 4, 0, 0); }
    }
    __device__ __forceinline__ void midscale(f32x4 (&)[2][2][4][2], int, int, int, LAS unsigned char*) const {}
    __device__ __forceinline__ void operator()(const f32x4 (&acc)[2][2][4][2], const Unit& u, int wr, int wc, int fr, int fq, int ui, LAS unsigned char* lds) const {
        const int row0 = u.pm * BM + wr * 64 + fr, j0 = u.pn * 128 + wc * 16 + 4 * fq;
        int tix = wr * 64 + fr; asm volatile("" : "+v"(tix));
        const LAS float* rtab = (const LAS float*)(lds + tab_off + (ui & 1) * 1024) + tix;
        float rsv[2][4];
#pragma unroll
        for (int ai = 0; ai < 2; ++ai)
#pragma unroll
            for (int m = 0; m < 4; ++m) rsv[ai][m] = rtab[ai * HALF + m * 16];
#pragma unroll
        for (int ai = 0; ai < 2; ++ai)
#pragma unroll
            for (int m = 0; m < 4; ++m) { bf16_t* rowp = hid + (size_t)(row0 + ai * HALF + m * 16) * DFF + j0;
                const int r = ai * HALF + m * 16 + tix; const float rs = (r < u.rows) ? rsv[ai][m] : 0.f;
#pragma unroll
                for (int bj = 0; bj < 2; ++bj) { const f32x4 g = acc[ai][bj][m][0] * rs, up = acc[ai][bj][m][1] * rs; float hv[4];
#pragma unroll
                    for (int q = 0; q < 4; ++q) hv[q] = g[q] * up[q] * __builtin_amdgcn_rcpf(1.0f + __expf(-g[q]));
                    *(u32x2*)(rowp + bj * 64) = (u32x2){cvt_pk_bf16(hv[0], hv[1]), cvt_pk_bf16(hv[2], hv[3])}; } }
        if (ready) {
            asm volatile("s_waitcnt vmcnt(0)" ::: "memory");
            if (fr == 0 && fq == 0) __hip_atomic_fetch_add(ready + 64 * u.pm, 1u, __ATOMIC_RELAXED, __HIP_MEMORY_SCOPE_AGENT);
        }
    }
};
struct EpiY {
    static constexpr bool PERM = true, MIDSCALE = false;
    bf16_t* y2; const int* tok_list; const float* w_list; const LAS int* meta; int tab_off;
    __device__ __forceinline__ void prepare(const Unit& u, int ui, LAS unsigned char* lds) const { if (ui == 0) prepare_late(u, ui, lds); }
    __device__ __forceinline__ void prepare_late(const Unit& u, int ui, LAS unsigned char* lds) const {
        const int tid = threadIdx.x;
        if (tid < 256) { const int wv = __builtin_amdgcn_readfirstlane(tid >> 6), li = u.e * T + (u.pm - __builtin_amdgcn_readfirstlane(meta[u.e])) * BM + wv * 64;
            __builtin_amdgcn_global_load_lds((const unsigned*)(tok_list + li) + (tid & 63), (LAS unsigned*)(lds + tab_off + (ui & 1) * 1024 + wv * 256), 4, 0, 0);
            __builtin_amdgcn_global_load_lds((const unsigned*)(w_list + li) + (tid & 63), (LAS unsigned*)(lds + tab_off + 2048 + (ui & 1) * 1024 + wv * 256), 4, 0, 0); }
    }
    __device__ __forceinline__ void midscale(f32x4 (&)[2][2][4][2], int, int, int, LAS unsigned char*) const {}
    __device__ __forceinline__ void operator()(const f32x4 (&acc)[2][2][4][2], const Unit& u, int wr, int wc, int fr, int fq, int ui, LAS unsigned char* lds) const {
        const int col0 = u.pn * BM + wc * 32 + 8 * fq;
        int tix = wr * 64 + fr; asm volatile("" : "+v"(tix));
        const LAS int* dtab = (const LAS int*)(lds + tab_off + (ui & 1) * 1024) + tix; const LAS float* wtab = (const LAS float*)(lds + tab_off + 2048 + (ui & 1) * 1024) + tix;
        int dstv[2][4]; float wv[2][4];
#pragma unroll
        for (int ai = 0; ai < 2; ++ai)
#pragma unroll
            for (int m = 0; m < 4; ++m) { dstv[ai][m] = dtab[ai * HALF + m * 16]; wv[ai][m] = wtab[ai * HALF + m * 16]; }
#pragma unroll
        for (int ai = 0; ai < 2; ++ai)
#pragma unroll
            for (int m = 0; m < 4; ++m) { const int r = ai * HALF + m * 16 + tix;
                if (r < u.rows) { const int dst = dstv[ai][m]; const float w = wv[ai][m]; bf16_t* rowp = y2 + (size_t)dst * D + col0;
#pragma unroll
                    for (int bj = 0; bj < 2; ++bj) { const f32x4 v0 = acc[ai][bj][m][0] * w, v1 = acc[ai][bj][m][1] * w;
                        u32x4 o; o.x = cvt_pk_bf16(v0[0], v0[1]); o.y = cvt_pk_bf16(v0[2], v0[3]); o.z = cvt_pk_bf16(v1[0], v1[1]); o.w = cvt_pk_bf16(v1[2], v1[3]);
                        *(u32x4*)(rowp + bj * HALF) = o; } } }
    }
};
}

struct RowId { int off; __device__ __forceinline__ int operator()(int n) const { return off + n; } };
struct RowGU { int up; __device__ __forceinline__ int operator()(int j) const { return (j >> 2) * 8 + (j & 3) + 4 * up; } };

struct TItem { const float* src; const float* gp; bf16_t* dst; int N, K, rmk; };
__device__ __forceinline__ TItem p0_decode(const Params& p, int it) {
    constexpr int I_IN = (D / 64) * (INW / 32), I_OUT = (D / 64) * (D / 32), I_G = (D / 64) * (DFF / 32), I_D = (DFF / 64) * (D / 32), I_E = 2 * I_G + I_D;
    const float* W; const float* g; bf16_t* WT; int K, N, rmk, idx;
    if (it < I_IN) { W = p.w_in; g = p.norm1_g; WT = (bf16_t*)(p.ws + WS_WIN); K = D; N = INW; rmk = 0; idx = it; }
    else if (it < I_IN + I_OUT) { W = p.w_out; g = nullptr; WT = (bf16_t*)(p.ws + WS_WOUT); K = D; N = D; rmk = 0; idx = it - I_IN; }
    else if (it < I_IN + I_OUT + NE * 2 * I_G) { const int r = it - I_IN - I_OUT, e = r / (2 * I_G), q = r % (2 * I_G);
        if (q < I_G) { W = p.w_e_gate + (size_t)e * D * DFF; g = p.norm2_g; WT = (bf16_t*)(p.ws + WS_WGU) + (size_t)e * D * D; K = D; N = DFF; rmk = 1; idx = q; }
        else { W = p.w_e_up + (size_t)e * D * DFF; g = p.norm2_g; WT = (bf16_t*)(p.ws + WS_WGU) + (size_t)e * D * D; K = D; N = DFF; rmk = 2; idx = q - I_G; } }
    else { const int r = it - I_IN - I_OUT - NE * 2 * I_G, e = r / I_D; idx = r % I_D;
        W = p.w_e_down + (size_t)e * DFF * D; g = nullptr; WT = (bf16_t*)(p.ws + WS_WD) + (size_t)e * D * DFF; K = DFF; N = D; rmk = 0; }
    const int nblk = N / 32, kb = idx / nblk, nb = idx % nblk, k0 = 64 * kb, n0 = 32 * nb;
    TItem t; t.src = W + (size_t)k0 * N + n0; t.dst = WT + k0; t.N = N; t.K = K; t.rmk = rmk;
    t.gp = g ? g + k0 : nullptr;
    if (it >= I_IN && it < I_IN + I_OUT) t.gp = (k0 < 512) ? p.g_rec_out + k0 : p.g_att_out + (k0 - 512);
    t.rmk = rmk | (n0 << 4);
    return t;
}
__device__ __forceinline__ void p0_load(const TItem& t, f32x4 (&ld)[8], float (&gv)[8], int lane) {
#pragma unroll
    for (int i = 0; i < 8; ++i) ld[i] = *(const f32x4*)(t.src + (size_t)(8 * i + (lane >> 3)) * t.N + 4 * (lane & 7));
    if (t.gp) {
#pragma unroll
        for (int i = 0; i < 8; ++i) gv[i] = t.gp[8 * i + (lane >> 3)];
    } else {
#pragma unroll
        for (int i = 0; i < 8; ++i) gv[i] = 1.0f;
    }
}
__device__ __forceinline__ void p0_process(const TItem& t, const f32x4 (&ld)[8], const float (&gv)[8], LAS float* scr, int lane) {
#pragma unroll
    for (int i = 0; i < 8; ++i) { const int kk = 8 * i + (lane >> 3); const f32x4 v = ld[i] * gv[i];
        LAS float* d = scr + kk * 33 + 4 * (lane & 7); d[0] = v[0]; d[1] = v[1]; d[2] = v[2]; d[3] = v[3]; }
    LDS_WAIT(); asm volatile("" ::: "memory");
    const int c = lane & 7, n0 = t.rmk >> 4, rmk = t.rmk & 15;
#pragma unroll
    for (int j = 0; j < 4; ++j) { const int n = (lane >> 3) + 8 * j; const LAS float* s = scr + (8 * c) * 33 + n;
        u32x4 o; o.x = pk2(s[0 * 33], s[1 * 33]); o.y = pk2(s[2 * 33], s[3 * 33]); o.z = pk2(s[4 * 33], s[5 * 33]); o.w = pk2(s[6 * 33], s[7 * 33]);
        const int nn = n0 + n, row = (rmk == 0) ? nn : ((nn >> 2) * 8 + (nn & 3) + 4 * (rmk - 1));
        *(u32x4*)(t.dst + (size_t)row * t.K + 8 * c) = o; }
    LDS_WAIT(); asm volatile("" ::: "memory");
}

__device__ __forceinline__ void p0_convert_range(const Params& p, LAS float* scr, int it0, int it1, int gw, int ngw, int lane) {
    int it = it0 + gw; TItem cur; f32x4 la[8]; float ga[8];
    if (it < it1) { cur = p0_decode(p, it); p0_load(cur, la, ga, lane); }
    while (it < it1) {
        const int nit = it + ngw; TItem nxt = cur; f32x4 lb[8]; float gb[8];
        const bool has = nit < it1;
        if (has) { nxt = p0_decode(p, nit); p0_load(nxt, lb, gb, lane); }
        p0_process(cur, la, ga, scr, lane);
        if (has) { cur = nxt;
#pragma unroll
            for (int i = 0; i < 8; ++i) { la[i] = lb[i]; ga[i] = gb[i]; } }
        it = nit;
    }
}

__device__ __forceinline__ void ph_prologue(const Params& p, LAS unsigned char* lds, int vcu, int G, int e_split) {
    const int tid = opaque_tid(), lane = tid & 63, wave = tid >> 6;
    LAS float* scr = (LAS float*)(lds + wave * 16384);
    const int gw = vcu * NWAVES + wave, NGW = G * NWAVES;
    bf16_t* xb = (bf16_t*)(p.ws + WS_XB);
    constexpr int I_IN = (D / 64) * (INW / 32), I_OUT = (D / 64) * (D / 32), I_G = (D / 64) * (DFF / 32), I_D = (DFF / 64) * (D / 32), I_E = 2 * I_G + I_D, I_ALL = I_IN + I_OUT + NE * I_E;
    p0_convert_range(p, scr, 0, I_IN + I_OUT + e_split * 2 * I_G, gw, NGW, lane);
    {
        bf16_t* gwt = (bf16_t*)(p.ws + WS_GWT); float* sp8 = (float*)(p.ws + WS_GWT + 8 * 128 * 144);
        for (int idx = gw * 64 + lane; idx < 8 * 64 * 128; idx += NGW * 64) { const int hb = idx >> 13, k = (idx >> 7) & 63, n = idx & 127;
            const float v = (n < 64) ? p.w_rg_a[(hb * 64 + k) * 64 + n] : p.w_rg_x[(hb * 64 + k) * 64 + n - 64];
            gwt[(hb * 128 + n) * 72 + k] = (bf16_t)f2bf(v); }
        for (int idx = gw * 64 + lane; idx < RW; idx += NGW * 64) sp8[idx] = -8.0f * log1pf(expf(-p.lru_lambda[idx]));
    }
    {
        float* rwt = (float*)(p.ws + WS_RWT);
        for (int idx = gw * 64 + lane; idx < D * 20; idx += NGW * 64) { const int k = idx / 20, n = idx % 20;
            rwt[n * 1028 + k] = (n < 16 ? p.w_router[k * 16 + n] : p.w_group[k * 4 + n - 16]) * p.norm2_g[k]; }
    }
    float* rinv1 = (float*)(p.ws + WS_GWT + 256 * 1024);
    for (int t0 = gw; t0 < T; t0 += 4 * NGW) {
        f32x4 v[4][4];
#pragma unroll
        for (int q = 0; q < 4; ++q) { const int t = t0 + q * NGW; const f32x4* xr = (const f32x4*)(p.x + (size_t)(t < T ? t : t0) * D) + lane;
#pragma unroll
            for (int j = 0; j < 4; ++j) v[q][j] = xr[64 * j]; }
#pragma unroll
        for (int q = 0; q < 4; ++q) { const int t = t0 + q * NGW; float ss = 0.f;
#pragma unroll
            for (int j = 0; j < 4; ++j) ss += (v[q][j][0] * v[q][j][0] + v[q][j][1] * v[q][j][1]) + (v[q][j][2] * v[q][j][2] + v[q][j][3] * v[q][j][3]);
            const float ms = wave_sum(ss) * (1.0f / D) + EPS; const float r = rsqrtf(ms);
            if (t < T) { u32x2* o8 = (u32x2*)(xb + (size_t)t * D) + lane; if (lane == 0) rinv1[t] = __builtin_amdgcn_sqrtf(ms);
#pragma unroll
                for (int j = 0; j < 4; ++j) o8[64 * j] = (u32x2){pk2(v[q][j][0] * r, v[q][j][1] * r), pk2(v[q][j][2] * r, v[q][j][3] * r)}; }
        }
    }
}

__device__ __forceinline__ void p1_tail_convert(const Params& p, LAS unsigned char* lds, int idle_idx, int n_idle, int e_split) {
    const int tid = opaque_tid(), lane = tid & 63, wave = tid >> 6;
    constexpr int I_IN = (D / 64) * (INW / 32), I_OUT = (D / 64) * (D / 32), I_G = (D / 64) * (DFF / 32), I_D = (DFF / 64) * (D / 32), I_E = 2 * I_G + I_D, I_ALL = I_IN + I_OUT + NE * I_E;
    p0_convert_range(p, (LAS float*)(lds + wave * 16384), I_IN + I_OUT + e_split * 2 * I_G, I_IN + I_OUT + NE * 2 * I_G, idle_idx * NWAVES + wave, n_idle * NWAVES, lane);
}

__device__ __forceinline__ void p5a_tail_convert(const Params& p, LAS unsigned char* lds, int widx, int n_workers) {
    const int tid = opaque_tid(), lane = tid & 63, wave = tid >> 6;
    constexpr int I_IN = (D / 64) * (INW / 32), I_OUT = (D / 64) * (D / 32), I_G = (D / 64) * (DFF / 32), I_D = (DFF / 64) * (D / 32);
    p0_convert_range(p, (LAS float*)(lds + wave * 16384), I_IN + I_OUT + NE * 2 * I_G, I_IN + I_OUT + NE * 2 * I_G + NE * I_D, widx * NWAVES + wave, n_workers * NWAVES, lane);
}

typedef float f32x16 __attribute__((ext_vector_type(16)));
typedef short v4i16_t __attribute__((ext_vector_type(4)));
typedef __bf16 bf16x2_t __attribute__((ext_vector_type(2)));
#define MFMA32(a, b, c) __builtin_amdgcn_mfma_f32_32x32x16_bf16((a), (b), (c), 0, 0, 0)
__device__ __forceinline__ unsigned cvtpk_s(float lo, float hi) { f32x2 v = {lo, hi}; bf16x2_t b = __builtin_convertvector(v, bf16x2_t); return __builtin_bit_cast(unsigned, b); }
__device__ __forceinline__ int crow(int r, int hh) { return (r & 3) + 8 * (r >> 2) + 4 * hh; }
__device__ __forceinline__ bf16x8 pack8(const f32x16& x, int s) {
    u32x4 w; w.x = cvtpk_s(x[8 * s + 0], x[8 * s + 1]); w.y = cvtpk_s(x[8 * s + 2], x[8 * s + 3]); w.z = cvtpk_s(x[8 * s + 4], x[8 * s + 5]); w.w = cvtpk_s(x[8 * s + 6], x[8 * s + 7]);
    return __builtin_bit_cast(bf16x8, w);
}
__device__ __forceinline__ v4i16_t vtr(LAS const unsigned char* p) { return __builtin_amdgcn_ds_read_tr16_b64_v4i16((LAS v4i16_t*)p); }
constexpr float LOG2E = 1.4426950408889634f;

struct AttnCtx { LAS float* btab; LAS unsigned char* vbase; int lane, h, q32, hh, vb, vw; float bconst; unsigned kl, vl; };
__device__ __forceinline__ AttnCtx attn_ctx(LAS unsigned char* lds, int tab_off) {
    AttnCtx A; const int tid = opaque_tid(); A.lane = tid & 63; A.h = __builtin_amdgcn_readfirstlane(tid >> 6); A.q32 = A.lane & 31; A.hh = A.lane >> 5;
    A.btab = (LAS float*)(lds + tab_off) + A.h * 328;
    A.vbase = lds + A.h * 16384;
    A.vb = ((A.lane >> 4) & 1) * 32 + (A.lane & 3) * 8 + (4 * A.hh + ((A.lane & 15) >> 2)) * 128;
    A.vw = (A.lane >> 3) * 128 + (A.lane & 7) * 16;
    A.bconst = A.btab[2 * MAXREL];
    A.kl = (unsigned)((A.q32 * INW + 8 * A.hh) * 2);
    A.vl = (unsigned)(((A.lane >> 3) * INW + (A.lane & 7) * 8) * 2) + 1024u;
    return A;
}
__device__ __forceinline__ void attn_setup(const Params& p, LAS unsigned char* lds, int tab_off) {
    const int tid = opaque_tid(), lane = tid & 63, h = __builtin_amdgcn_readfirstlane(tid >> 6);
    LAS float* btab = (LAS float*)(lds + tab_off) + h * 328;
    const float bfar = p.rel_bias[h * (2 * MAXREL + 1) + 2 * MAXREL];
    for (int i = lane; i < 2 * MAXREL + 1 + 64; i += 64) btab[i] = (p.rel_bias[h * (2 * MAXREL + 1) + (i > 2 * MAXREL ? 2 * MAXREL : i)] - bfar) * LOG2E;
    LDS_WAIT(); asm volatile("" ::: "memory");
}
#define ATTN_LOAD_TILE(jn) { const char* tb_ = kband + (long)(64 * (jn)) * INW * 2; _Pragma("unroll") \
    for (int i = 0; i < 8; ++i) { kr[i] = *(const u32x4*)((tb_ + i * 8 * INW * 2) + kl8); vr[i] = *(const u32x4*)((tb_ + i * 8 * INW * 2 + 1024) + kl8); } }
#define ATTN_STORE_TILE() { _Pragma("unroll") \
    for (int i = 0; i < 8; ++i) { *(LAS u32x4*)(vbase + i * 1024 + kw) = kr[i]; *(LAS u32x4*)(vbase + 8192 + i * 1024 + vw) = vr[i]; } }

__device__ __forceinline__ void attn_safe(const AttnCtx& A, const char* kband, const bf16x8 (&qf)[4], int j0, int qi, f32x16& o0, f32x16& o1, float& lt) {
    const int lane = A.lane, q32 = A.q32, hh = A.hh, vb = A.vb, vw = A.vw; LAS float* btab = A.btab; LAS unsigned char* vbase = A.vbase;
    const float bconst = A.bconst; const unsigned kl8 = A.vl - 1024u;
#pragma unroll
    for (int r = 0; r < 16; ++r) { o0[r] = 0.f; o1[r] = 0.f; }
    float m_ref = 0.f, l_run = 0.f;
    constexpr float THR = 6.0f;
    u32x4 kr[8], vr[8];
    const int kw = (lane >> 3) * 128 + (((lane & 7) ^ (lane >> 3)) << 4);
    const int kfo = q32 * 128;
    ATTN_LOAD_TILE(j0)
    ATTN_STORE_TILE()
#pragma unroll 1
    for (int j = j0; j <= LEFT; ++j) {
        if (j < LEFT) ATTN_LOAD_TILE(j + 1)
        bf16x8 kf[4];
#pragma unroll
        for (int s = 0; s < 4; ++s) kf[s] = *(const LAS bf16x8*)(vbase + kfo + (((2 * s + hh) ^ (q32 & 7)) << 4));
        f32x16 p0, p1;
        if (j <= 5) {
            const float ci = bconst - m_ref;
#pragma unroll
            for (int r = 0; r < 16; ++r) { p0[r] = ci; p1[r] = ci; }
        } else {
            const LAS float* pb0 = btab + (LEFT * CHUNK + qi - 64 * j + MAXREL - 4 * hh - 27); const LAS float* pb1 = pb0 - 32;
#pragma unroll
            for (int r = 0; r < 16; ++r) { p0[r] = pb0[27 - ((r & 3) + 8 * (r >> 2))] - m_ref; p1[r] = pb1[27 - ((r & 3) + 8 * (r >> 2))] - m_ref; }
        }
#pragma unroll
        for (int s = 0; s < 4; ++s) p0 = MFMA32(kf[s], qf[s], p0);
#pragma unroll
        for (int s = 0; s < 4; ++s) kf[s] = *(const LAS bf16x8*)(vbase + 4096 + kfo + (((2 * s + hh) ^ (q32 & 7)) << 4));
#pragma unroll
        for (int s = 0; s < 4; ++s) p1 = MFMA32(kf[s], qf[s], p1);
        float mt = fmaxf(p0[0], p1[0]);
#pragma unroll
        for (int r = 1; r < 16; ++r) mt = fmaxf(mt, fmaxf(p0[r], p1[r]));
        mt = fmaxf(mt, __shfl_xor(mt, 32));
        const bool first = (j == j0);
        const bool grow = first || (mt > THR);
        if (__any(grow)) {
            const float d = grow ? mt : 0.f, alpha = first ? 1.0f : __builtin_amdgcn_exp2f(-d);
            m_ref += d; l_run *= alpha;
#pragma unroll
            for (int r = 0; r < 16; ++r) { p0[r] -= d; p1[r] -= d; o0[r] *= alpha; o1[r] *= alpha; }
        }
        float ls0 = 0.f, ls1 = 0.f;
#pragma unroll
        for (int r = 0; r < 16; ++r) { p0[r] = __builtin_amdgcn_exp2f(p0[r]); p1[r] = __builtin_amdgcn_exp2f(p1[r]); ls0 += p0[r]; ls1 += p1[r]; }
        l_run += ls0 + ls1;
        const bf16x8 pf0 = pack8(p0, 0), pf1 = pack8(p0, 1), pf2 = pack8(p1, 0), pf3 = pack8(p1, 1);
        LAS const unsigned char* vcur = vbase + 8192 + vb;
#pragma unroll
        for (int db = 0; db < 2; ++db) {
            v4i16_t lo[4], hi[4];
#pragma unroll
            for (int ks = 0; ks < 4; ++ks) { lo[ks] = vtr(vcur + ks * 2048 + db * 64); hi[ks] = vtr(vcur + ks * 2048 + 1024 + db * 64); }
#define VF(k) (bf16x8){lo[k][0], lo[k][1], lo[k][2], lo[k][3], hi[k][0], hi[k][1], hi[k][2], hi[k][3]}
            if (db == 0) { o0 = MFMA32(VF(0), pf0, o0); o0 = MFMA32(VF(1), pf1, o0); o0 = MFMA32(VF(2), pf2, o0); o0 = MFMA32(VF(3), pf3, o0); }
            else         { o1 = MFMA32(VF(0), pf0, o1); o1 = MFMA32(VF(1), pf1, o1); o1 = MFMA32(VF(2), pf2, o1); o1 = MFMA32(VF(3), pf3, o1); }
#undef VF
        }
        if (j < LEFT) ATTN_STORE_TILE()
    }
    lt = l_run + __shfl_xor(l_run, 32);
}

template <bool NEAR>
__device__ __forceinline__ void attn_tile_fast(f32x16& o0, f32x16& o1, f32x2& la, f32x2& lb, const bf16x8 (&qf)[4], LAS unsigned char* vbase, int kfo, int hh, int q32, int vb, const LAS float* pb0) {
    bf16x8 kf[4];
#pragma unroll
    for (int s = 0; s < 4; ++s) kf[s] = *(const LAS bf16x8*)(vbase + kfo + (((2 * s + hh) ^ (q32 & 7)) << 4));
    f32x16 p0, p1;
    if (NEAR) { const LAS float* pb1 = pb0 - 32;
#pragma unroll
        for (int r = 0; r < 16; ++r) { p0[r] = pb0[27 - ((r & 3) + 8 * (r >> 2))]; p1[r] = pb1[27 - ((r & 3) + 8 * (r >> 2))]; }
    } else {
#pragma unroll
        for (int r = 0; r < 16; ++r) { p0[r] = 0.f; p1[r] = 0.f; }
    }
#pragma unroll
    for (int s = 0; s < 4; ++s) p0 = MFMA32(kf[s], qf[s], p0);
#pragma unroll
    for (int s = 0; s < 4; ++s) kf[s] = *(const LAS bf16x8*)(vbase + 4096 + kfo + (((2 * s + hh) ^ (q32 & 7)) << 4));
#pragma unroll
    for (int s = 0; s < 4; ++s) p1 = MFMA32(kf[s], qf[s], p1);
#pragma unroll
    for (int r = 0; r < 16; ++r) { p0[r] = __builtin_amdgcn_exp2f(p0[r]); p1[r] = __builtin_amdgcn_exp2f(p1[r]); }
#pragma unroll
    for (int r = 0; r < 8; ++r) { la += (f32x2){p0[2 * r], p0[2 * r + 1]}; lb += (f32x2){p1[2 * r], p1[2 * r + 1]}; }
    const bf16x8 pf0 = pack8(p0, 0), pf1 = pack8(p0, 1), pf2 = pack8(p1, 0), pf3 = pack8(p1, 1);
    LAS const unsigned char* vcur = vbase + 8192 + vb;
#pragma unroll
    for (int db = 0; db < 2; ++db) {
        v4i16_t lo[4], hi[4];
#pragma unroll
        for (int ks = 0; ks < 4; ++ks) { lo[ks] = vtr(vcur + ks * 2048 + db * 64); hi[ks] = vtr(vcur + ks * 2048 + 1024 + db * 64); }
#define VF(k) (bf16x8){lo[k][0], lo[k][1], lo[k][2], lo[k][3], hi[k][0], hi[k][1], hi[k][2], hi[k][3]}
        if (db == 0) { o0 = MFMA32(VF(0), pf0, o0); o0 = MFMA32(VF(1), pf1, o0); o0 = MFMA32(VF(2), pf2, o0); o0 = MFMA32(VF(3), pf3, o0); }
        else         { o1 = MFMA32(VF(0), pf0, o1); o1 = MFMA32(VF(1), pf1, o1); o1 = MFMA32(VF(2), pf2, o1); o1 = MFMA32(VF(3), pf3, o1); }
#undef VF
    }
}
__device__ __forceinline__ void attn_fast(const AttnCtx& A, const char* kband, const bf16x8 (&qf)[4], int j0, int qi, f32x16& o0, f32x16& o1, float& lt) {
    const int lane = A.lane, q32 = A.q32, hh = A.hh, vb = A.vb, vw = A.vw; LAS float* btab = A.btab; LAS unsigned char* vbase = A.vbase;
    const unsigned kl8 = A.vl - 1024u;
#pragma unroll
    for (int r = 0; r < 16; ++r) { o0[r] = 0.f; o1[r] = 0.f; }
    f32x2 la = {0.f, 0.f}, lb = {0.f, 0.f};
    u32x4 kr[8], vr[8];
    const int kw = (lane >> 3) * 128 + (((lane & 7) ^ (lane >> 3)) << 4);
    const int kfo = q32 * 128;
    ATTN_LOAD_TILE(j0)
    ATTN_STORE_TILE()
    int j = j0;
#pragma unroll 1
    for (; j <= 5; ++j) {
        ATTN_LOAD_TILE(j + 1)
        attn_tile_fast<false>(o0, o1, la, lb, qf, vbase, kfo, hh, q32, vb, nullptr);
        ATTN_STORE_TILE()
    }
#pragma unroll 1
    for (; j <= LEFT; ++j) {
        if (j < LEFT) ATTN_LOAD_TILE(j + 1)
        attn_tile_fast<true>(o0, o1, la, lb, qf, vbase, kfo, hh, q32, vb, btab + (LEFT * CHUNK + qi - 64 * j + MAXREL - 4 * hh - 27));
        if (j < LEFT) ATTN_STORE_TILE()
    }
    const float l_run = (la.x + la.y) + (lb.x + lb.y);
    lt = l_run + __shfl_xor(l_run, 32);
}

template <bool FAST>
__device__ __forceinline__ bool attn_item(LAS unsigned char* lds, const bf16_t* z, bf16_t* mixb, float* ssq, int b, int c, int qh) {
    const AttnCtx A = attn_ctx(lds, TAB_OFF);
    const int h = A.h, q32 = A.q32, hh = A.hh;
    const float QS = 0.125f * LOG2E;
    const int j0 = (c >= LEFT) ? 0 : LEFT - c;
    const char* kband = (const char*)z + (((long)b * S + (long)(c - LEFT) * CHUNK) * INW + 1536 + h * 64) * 2;
    const int qi = qh * 32 + q32;
    const size_t tq = (size_t)b * S + c * CHUNK + qi;
    bf16x8 qf[4];
#pragma unroll
    for (int s = 0; s < 4; ++s) { const u32x4 raw = *(const u32x4*)(z + tq * INW + 1024 + h * 64 + 16 * s + 8 * hh); u32x4 w;
#pragma unroll
        for (int e = 0; e < 4; ++e) w[e] = cvtpk_s(__builtin_bit_cast(float, raw[e] << 16) * QS, __builtin_bit_cast(float, raw[e] & 0xffff0000u) * QS);
        qf[s] = __builtin_bit_cast(bf16x8, w); }
    f32x16 o0, o1; float lt;
    if (FAST) { attn_fast(A, kband, qf, j0, qi, o0, o1, lt); if (__any(!(lt >= 0x1p-60f && lt <= 0x1p60f))) return true; }
    else attn_safe(A, kband, qf, j0, qi, o0, o1, lt);
    const float inv = 1.0f / lt;
    float ss = 0.f;
    bf16_t* orow = mixb + tq * D + 512 + h * 64 + 4 * hh;
#pragma unroll
    for (int g = 0; g < 4; ++g) {
        const float a0 = o0[4 * g] * inv, a1 = o0[4 * g + 1] * inv, a2 = o0[4 * g + 2] * inv, a3 = o0[4 * g + 3] * inv;
        const float c0 = o1[4 * g] * inv, c1 = o1[4 * g + 1] * inv, c2 = o1[4 * g + 2] * inv, c3 = o1[4 * g + 3] * inv;
        ss += (a0 * a0 + a1 * a1) + (a2 * a2 + a3 * a3) + (c0 * c0 + c1 * c1) + (c2 * c2 + c3 * c3);
        *(u32x2*)(orow + 8 * g) = (u32x2){cvtpk_s(a0, a1), cvtpk_s(a2, a3)};
        *(u32x2*)(orow + 32 + 8 * g) = (u32x2){cvtpk_s(c0, c1), cvtpk_s(c2, c3)};
    }
    ss += __shfl_xor(ss, 32);
    if (hh == 0) ssq[tq * SSQW + 32 + h] = ss;
    return false;
}

constexpr int RG_WT = 0, RG_IMG = 18432, RG_SEG = 35840, RG_PRE = 44032, RG_CAR = 52224, RG_ROWB = 144, RG_IROW = 272;
constexpr int RG_U = 57344, RG_G = 90624, RG_GROW = 136;
__device__ __forceinline__ float fast_sigmoid(float x) { return __builtin_amdgcn_rcpf(1.0f + __expf(-x)); }
__device__ __forceinline__ void rglru_item(const Params& p, const bf16_t* z, bf16_t* mixb, float* ssq, LAS unsigned char* lds, unsigned long long* gran, int b, int hb, int kc) {
    const int tid = opaque_tid(), lane = tid & 63, w = __builtin_amdgcn_readfirstlane(tid >> 6), ch = lane, c16 = lane & 15, tg = lane >> 4;
    LAS f32x2* seg = (LAS f32x2*)(lds + RG_SEG); LAS f32x2* pre = (LAS f32x2*)(lds + RG_PRE); LAS float* car = (LAS float*)(lds + RG_CAR);
    {
        const u32x4* srcw = (const u32x4*)(p.ws + WS_GWT + (size_t)hb * 128 * 144); LAS u32x4* dstw = (LAS u32x4*)(lds + RG_WT);
        static_assert(128 * 144 / 16 == 2 * NTHR + 128, "gate weight image size");
        const u32x4 t0 = srcw[tid], t1 = srcw[tid + NTHR], t2 = srcw[2 * NTHR + (tid & 127)];
        dstw[tid] = t0; dstw[tid + NTHR] = t1; if (tid < 128) dstw[2 * NTHR + tid] = t2;
    }
    const int gch = hb * 64 + ch;
    const float cw0 = p.conv_w[gch], cw1 = p.conv_w[RW + gch], cw2 = p.conv_w[2 * RW + gch], cw3 = p.conv_w[3 * RW + gch], cb = p.conv_b[gch];
    const float* sp8t = (const float*)(p.ws + WS_GWT + 8 * 128 * 144);
    float ba[4], bxb[4], sp8[4];
#pragma unroll
    for (int nb = 0; nb < 4; ++nb) { const int c = hb * 64 + 16 * nb + c16; ba[nb] = p.b_rg_a[c]; bxb[nb] = p.b_rg_x[c]; sp8[nb] = sp8t[c]; }
    LAS unsigned char* img = lds + RG_IMG;
    LAS unsigned char* trb = img + (8 * tg + (c16 >> 2)) * RG_IROW + (16 * w + 4 * (c16 & 3)) * 2;
    const int s0 = kc * 256;
    const bf16_t* ucol = z + ((size_t)b * S + s0) * INW + gch;
    float av[2][4][4], bv[2][4][4], cP[2][4], cH[2][4];
    {
        const int r0 = tid >> 3, ck = tid & 7;
        const bf16_t* ub = z + ((size_t)b * S + s0) * INW + hb * 64 + ck * 8;
        u32x4 ur[5], gr[4];
#pragma unroll
        for (int k = 0; k < 4; ++k) { const int st = r0 + 64 * k - 3; ur[k] = *(const u32x4*)(ub + (long)(s0 + st >= 0 ? st : 0) * INW); if (s0 + st < 0) ur[k] = (u32x4){0u, 0u, 0u, 0u}; }
        ur[4] = *(const u32x4*)(ub + (long)(253 + (r0 < 3 ? r0 : 0)) * INW);
#pragma unroll
        for (int k = 0; k < 4; ++k) gr[k] = *(const u32x4*)(ub + (long)(r0 + 64 * k) * INW + 512);
#pragma unroll
        for (int k = 0; k < 4; ++k) *(LAS u32x4*)(lds + RG_U + (r0 + 64 * k) * 128 + ck * 16) = ur[k];
        if (r0 < 3) *(LAS u32x4*)(lds + RG_U + (256 + r0) * 128 + ck * 16) = ur[4];
#pragma unroll
        for (int k = 0; k < 4; ++k) { LAS u32x2* gd = (LAS u32x2*)(lds + RG_G + (r0 + 64 * k) * RG_GROW + ck * 16); gd[0] = (u32x2){gr[k].x, gr[k].y}; gd[1] = (u32x2){gr[k].z, gr[k].w}; }
    }
    __syncthreads();
#pragma unroll
    for (int blk = 0; blk < 2; ++blk) {
        const int t0 = blk * 128 + 16 * w;
        float uv[19];
#pragma unroll
        for (int i = 0; i < 19; ++i) uv[i] = bf2f(*(const LAS bf16_t*)(lds + RG_U + (t0 + i) * 128 + ch * 2));
        {
            float uc[16];
#pragma unroll
            for (int i = 0; i < 16; ++i) uc[i] = cb + cw0 * uv[i] + cw1 * uv[i + 1] + cw2 * uv[i + 2] + cw3 * uv[i + 3];
            u32x4 w0, w1;
#pragma unroll
            for (int e = 0; e < 4; ++e) { w0[e] = cvtpk_s(uc[2 * e], uc[2 * e + 1]); w1[e] = cvtpk_s(uc[8 + 2 * e], uc[9 + 2 * e]); }
            *(LAS u32x4*)(img + ch * RG_IROW + 32 * w) = w0; *(LAS u32x4*)(img + ch * RG_IROW + 32 * w + 16) = w1;
        }
        LDS_WAIT(); asm volatile("" ::: "memory");
        const v4i16_t t0lo = vtr(trb), t0hi = vtr(trb + 4 * RG_IROW), t1lo = vtr(trb + 32 * RG_IROW), t1hi = vtr(trb + 36 * RG_IROW);
        const bf16x8 a0 = (bf16x8){t0lo[0], t0lo[1], t0lo[2], t0lo[3], t0hi[0], t0hi[1], t0hi[2], t0hi[3]}, a1 = (bf16x8){t1lo[0], t1lo[1], t1lo[2], t1lo[3], t1hi[0], t1hi[1], t1hi[2], t1hi[3]};
#pragma unroll
        for (int nb = 0; nb < 4; ++nb) {
            const bf16x8 b0a = *(const LAS bf16x8*)(lds + RG_WT + (16 * nb + c16) * RG_ROWB + tg * 16), b1a = *(const LAS bf16x8*)(lds + RG_WT + (16 * nb + c16) * RG_ROWB + tg * 16 + 64);
            const bf16x8 b0x = *(const LAS bf16x8*)(lds + RG_WT + (64 + 16 * nb + c16) * RG_ROWB + tg * 16), b1x = *(const LAS bf16x8*)(lds + RG_WT + (64 + 16 * nb + c16) * RG_ROWB + tg * 16 + 64);
            f32x4 acca = __builtin_amdgcn_mfma_f32_16x16x32_bf16(a0, b0a, (f32x4){0.f, 0.f, 0.f, 0.f}, 0, 0, 0); acca = __builtin_amdgcn_mfma_f32_16x16x32_bf16(a1, b1a, acca, 0, 0, 0);
            f32x4 accx = __builtin_amdgcn_mfma_f32_16x16x32_bf16(a0, b0x, (f32x4){0.f, 0.f, 0.f, 0.f}, 0, 0, 0); accx = __builtin_amdgcn_mfma_f32_16x16x32_bf16(a1, b1x, accx, 0, 0, 0);
            const u32x2 ucr = *(const LAS u32x2*)(img + (16 * nb + c16) * RG_IROW + (16 * w + 4 * tg) * 2);
            const float ucv[4] = {__builtin_bit_cast(float, ucr[0] << 16), __builtin_bit_cast(float, ucr[0] & 0xffff0000u), __builtin_bit_cast(float, ucr[1] << 16), __builtin_bit_cast(float, ucr[1] & 0xffff0000u)};
            float H = 0.f, P = 1.f;
#pragma unroll
            for (int rg_ = 0; rg_ < 4; ++rg_) {
                const float r = fast_sigmoid(acca[rg_] + ba[nb]), ig = fast_sigmoid(accx[rg_] + bxb[nb]);
                const float a = __expf(r * sp8[nb]);
                av[blk][nb][rg_] = a; bv[blk][nb][rg_] = __builtin_amdgcn_sqrtf((1.0f - a) * (1.0f + a)) * (ig * ucv[rg_]);
                H = a * H + bv[blk][nb][rg_]; P *= a; }
            float cp = 1.f, chh = 0.f, Pt = 1.f, Ht = 0.f;
#pragma unroll
            for (int k = 0; k < 4; ++k) { const float Pk = __shfl(P, c16 + 16 * k), Hk = __shfl(H, c16 + 16 * k);
                cp = (k == tg) ? Pt : cp; chh = (k == tg) ? Ht : chh;
                Ht = Pk * Ht + Hk; Pt *= Pk; }
            cP[blk][nb] = cp; cH[blk][nb] = chh;
            if (tg == 0) seg[(blk * 8 + w) * 64 + 16 * nb + c16] = (f32x2){Pt, Ht};
        }
        LDS_WAIT(); asm volatile("" ::: "memory");
    }
    __syncthreads();
    unsigned long long vp[7], vh[7];
    const unsigned long long* g0 = gran + ((size_t)((b * 8 + hb) * 8) * 2) * 64 + (tid & 63);
    if (tid < 64) {
        float Pp = 1.f, Hp = 0.f;
#pragma unroll
        for (int s = 0; s < 16; ++s) { pre[s * 64 + tid] = (f32x2){Pp, Hp}; const f32x2 sv = seg[s * 64 + tid]; Hp = sv.x * Hp + sv.y; Pp *= sv.x; }
        unsigned long long* g = gran + ((size_t)((b * 8 + hb) * 8 + kc) * 2) * 64 + tid;
        __hip_atomic_store(g, (1ull << 32) | __builtin_bit_cast(unsigned, Pp), __ATOMIC_RELAXED, __HIP_MEMORY_SCOPE_AGENT);
        __hip_atomic_store(g + 64, (1ull << 32) | __builtin_bit_cast(unsigned, Hp), __ATOMIC_RELAXED, __HIP_MEMORY_SCOPE_AGENT);
#pragma unroll
        for (int j = 0; j < 7; ++j) if (j < kc) { vp[j] = __hip_atomic_load(g0 + j * 128, __ATOMIC_RELAXED, __HIP_MEMORY_SCOPE_AGENT); vh[j] = __hip_atomic_load(g0 + j * 128 + 64, __ATOMIC_RELAXED, __HIP_MEMORY_SCOPE_AGENT); }
    }
    float gg[2][4][4];
#pragma unroll
    for (int blk = 0; blk < 2; ++blk)
#pragma unroll
        for (int nb = 0; nb < 4; ++nb)
#pragma unroll
            for (int i = 0; i < 4; ++i) { const float g = bf2f(*(const LAS bf16_t*)(lds + RG_G + (blk * 128 + 16 * w + 4 * tg + i) * RG_GROW + (16 * nb + c16) * 2)), u2 = 1.5957691216057308f * (g + 0.044715f * g * g * g); gg[blk][nb][i] = g * fast_sigmoid(u2); }
    if (tid < 64) {
        unsigned spins = 0;
        for (;;) {
            bool ok = true;
#pragma unroll
            for (int j = 0; j < 7; ++j) if (j < kc) ok = ok && ((vp[j] >> 32) != 0ull) && ((vh[j] >> 32) != 0ull);
            if (__all(ok) || ++spins > (1u << 20)) break;
            __builtin_amdgcn_s_sleep(2);
#pragma unroll
            for (int j = 0; j < 7; ++j) if (j < kc) { vp[j] = __hip_atomic_load(g0 + j * 128, __ATOMIC_RELAXED, __HIP_MEMORY_SCOPE_AGENT); vh[j] = __hip_atomic_load(g0 + j * 128 + 64, __ATOMIC_RELAXED, __HIP_MEMORY_SCOPE_AGENT); }
        }
        float h = 0.f;
#pragma unroll
        for (int j = 0; j < 7; ++j) if (j < kc) h = __builtin_bit_cast(float, (unsigned)vp[j]) * h + __builtin_bit_cast(float, (unsigned)vh[j]);
        car[tid] = h;
    }
    __syncthreads();
#pragma unroll
    for (int blk = 0; blk < 2; ++blk) {
        const int t0 = blk * 128 + 16 * w;
        float ysum[4] = {0.f, 0.f, 0.f, 0.f};
#pragma unroll
        for (int nb = 0; nb < 4; ++nb) {
            const int oc = 16 * nb + c16; const f32x2 pf = pre[(blk * 8 + w) * 64 + oc];
            float hcur = cP[blk][nb] * (pf.x * car[oc] + pf.y) + cH[blk][nb];
            LAS bf16_t* orow = (LAS bf16_t*)(lds + RG_U + (t0 + 4 * tg) * RG_GROW) + oc;
#pragma unroll
            for (int i = 0; i < 4; ++i) { hcur = av[blk][nb][i] * hcur + bv[blk][nb][i];
                const float y = hcur * gg[blk][nb][i];
                orow[i * (RG_GROW / 2)] = (bf16_t)(cvtpk_s(y, y) & 0xffffu); ysum[i] += y * y; }
        }
#pragma unroll
        for (int i = 0; i < 4; ++i) ysum[i] += __shfl_xor(ysum[i], 1);
#pragma unroll
        for (int i = 0; i < 4; ++i) ysum[i] += __shfl_xor(ysum[i], 2);
#pragma unroll
        for (int i = 0; i < 4; ++i) ysum[i] += __shfl_xor(ysum[i], 4);
#pragma unroll
        for (int i = 0; i < 4; ++i) ysum[i] += __shfl_xor(ysum[i], 8);
        if (c16 == 0) { float* sq = ssq + ((size_t)b * S + s0 + t0 + 4 * tg) * SSQW + hb * 4;
#pragma unroll
            for (int i = 0; i < 4; ++i) *(f32x4*)(sq + (size_t)i * SSQW) = (f32x4){ysum[i], 0.f, 0.f, 0.f}; }
    }
    __syncthreads();
    {
        const int r0 = tid >> 3, ck = tid & 7;
        bf16_t* ob = mixb + ((size_t)b * S + s0) * D + hb * 64 + ck * 8;
#pragma unroll
        for (int k = 0; k < 4; ++k) { const LAS u32x2* sp = (const LAS u32x2*)(lds + RG_U + (r0 + 64 * k) * RG_GROW + ck * 16); const u32x2 lo = sp[0], hi = sp[1];
            *(u32x4*)(ob + (size_t)(r0 + 64 * k) * D) = (u32x4){lo.x, lo.y, hi.x, hi.y}; }
    }
}

constexpr int RT_SUM = 0, RT_REC = 49152;
__device__ __forceinline__ void ph_router3(const Params& p, const float* part, int* gcount, int* tok_list, float* w_list, float* r_list, LAS unsigned char* lds) {
    const int tid = opaque_tid();
    LAS float* sum = (LAS float*)(lds + RT_SUM);
    LAS int* lcnt = (LAS int*)(lds + RT_REC); LAS int* lbase = lcnt + 16; LAS int* rec_e = lcnt + 32; LAS int* rec_s = lcnt + 160; LAS float* rec_w = (LAS float*)(lcnt + 288); LAS float* rec_r = (LAS float*)(lcnt + 416);
    for (int grp = blockIdx.x; grp < T / 64; grp += gridDim.x) {
        if (tid < 16) lcnt[tid] = 0;
        {
            const int tok = tid & 63, pr = tid >> 6;
            const f32x4* a = (const f32x4*)(part + ((size_t)(grp * 64 + tok) * 16 + 2 * pr) * 24);
            f32x4 v[12];
#pragma unroll
            for (int i = 0; i < 12; ++i) v[i] = a[i];
#pragma unroll
            for (int i = 0; i < 6; ++i) *(LAS f32x4*)(sum + (pr * 64 + tok) * 24 + 4 * i) = v[i] + v[6 + i];
        }
        __syncthreads();
        if (tid < 64) {
            float q[24];
#pragma unroll
            for (int i = 0; i < 6; ++i) { f32x4 s4 = *(const LAS f32x4*)(sum + tid * 24 + 4 * i);
#pragma unroll
                for (int pr = 1; pr < 8; ++pr) s4 = s4 + *(const LAS f32x4*)(sum + (pr * 64 + tid) * 24 + 4 * i);
                q[4 * i] = s4[0]; q[4 * i + 1] = s4[1]; q[4 * i + 2] = s4[2]; q[4 * i + 3] = s4[3]; }
            const float rstd = rsqrtf(q[20] * (1.0f / D) + EPS);
            float lg[4];
#pragma unroll
            for (int i = 0; i < 4; ++i) lg[i] = q[16 + i] * rstd + p.b_group[i];
            int gi = 0; float best = lg[0];
#pragma unroll
            for (int i = 1; i < 4; ++i) if (lg[i] > best) { best = lg[i]; gi = i; }
            float den = 0.f;
#pragma unroll
            for (int i = 0; i < 4; ++i) den += expf(lg[i] - best);
            const float pg = 1.0f / den;
            float sel[4];
#pragma unroll
            for (int i = 0; i < 4; ++i) { const float s0 = q[i], s1 = q[4 + i], s2 = q[8 + i], s3 = q[12 + i]; sel[i] = ((gi == 0) ? s0 : (gi == 1) ? s1 : (gi == 2) ? s2 : s3) * rstd + p.b_router[gi * 4 + i]; }
            int i1 = 0; float v1 = sel[0];
#pragma unroll
            for (int i = 1; i < 4; ++i) if (sel[i] > v1) { v1 = sel[i]; i1 = i; }
            int i2 = -1; float v2 = -3.0e38f;
#pragma unroll
            for (int i = 0; i < 4; ++i) if (i != i1 && sel[i] > v2) { v2 = sel[i]; i2 = i; }
            const float e2 = expf(v2 - v1);
            const float w1 = pg / (1.0f + e2), w2 = pg * e2 / (1.0f + e2);
            const int ea = gi * 4 + i1, eb = gi * 4 + i2;
            const int sa = __hip_atomic_fetch_add(lcnt + ea, 1, __ATOMIC_RELAXED, __HIP_MEMORY_SCOPE_WORKGROUP);
            const int sb = __hip_atomic_fetch_add(lcnt + eb, 1, __ATOMIC_RELAXED, __HIP_MEMORY_SCOPE_WORKGROUP);
            rec_e[tid * 2] = ea; rec_s[tid * 2] = sa; rec_w[tid * 2] = w1; rec_r[tid * 2] = rstd;
            rec_e[tid * 2 + 1] = eb; rec_s[tid * 2 + 1] = sb; rec_w[tid * 2 + 1] = w2; rec_r[tid * 2 + 1] = rstd;
        }
        __syncthreads();
        if (tid < 16) lbase[tid] = __hip_atomic_fetch_add(gcount + tid, lcnt[tid], __ATOMIC_RELAXED, __HIP_MEMORY_SCOPE_AGENT);
        __syncthreads();
        if (tid < 128) { const int e = rec_e[tid]; const int pos = lbase[e] + rec_s[tid]; tok_list[e * T + pos] = grp * 128 + tid; w_list[e * T + pos] = rec_w[tid]; r_list[e * T + pos] = rec_r[tid]; }
        __syncthreads();
    }
}
__device__ void ph_final(const Params& p, const bf16_t* hb, const bf16_t* y2, float* out) {
    const int tid = opaque_tid(), lane = tid & 63, wv = tid >> 6;
    constexpr int RPT = 4;
    f32x4 gf[4];
#pragma unroll
    for (int j = 0; j < 4; ++j) gf[j] = *((const f32x4*)p.final_g + lane + 64 * j);
    const int nwv = gridDim.x * NWAVES;
    for (int t0 = blockIdx.x * NWAVES + wv; t0 < T; t0 += nwv * RPT) {
        u32x2 hv[RPT][4], ya[RPT][4], yb[RPT][4];
#pragma unroll
        for (int q = 0; q < RPT; ++q) { const int t = t0 + q * nwv; const int tt = t < T ? t : t0;
            const u32x2* hr = (const u32x2*)(hb + (size_t)tt * D) + lane;
            const u32x2* y0 = (const u32x2*)(y2 + (size_t)(2 * tt) * D) + lane; const u32x2* y1 = (const u32x2*)(y2 + (size_t)(2 * tt + 1) * D) + lane;
#pragma unroll
            for (int j = 0; j < 4; ++j) { hv[q][j] = hr[64 * j]; ya[q][j] = y0[64 * j]; yb[q][j] = y1[64 * j]; } }
#pragma unroll
        for (int q = 0; q < RPT; ++q) { const int t = t0 + q * nwv;
            f32x4 v[4]; float ss = 0.f;
#pragma unroll
            for (int j = 0; j < 4; ++j) { const u32x2 a = ya[q][j], b = yb[q][j], c = hv[q][j];
                v[j][0] = __builtin_bit_cast(float, c[0] << 16) + __builtin_bit_cast(float, a[0] << 16) + __builtin_bit_cast(float, b[0] << 16);
                v[j][1] = __builtin_bit_cast(float, c[0] & 0xffff0000u) + __builtin_bit_cast(float, a[0] & 0xffff0000u) + __builtin_bit_cast(float, b[0] & 0xffff0000u);
                v[j][2] = __builtin_bit_cast(float, c[1] << 16) + __builtin_bit_cast(float, a[1] << 16) + __builtin_bit_cast(float, b[1] << 16);
                v[j][3] = __builtin_bit_cast(float, c[1] & 0xffff0000u) + __builtin_bit_cast(float, a[1] & 0xffff0000u) + __builtin_bit_cast(float, b[1] & 0xffff0000u);
                ss += (v[j][0] * v[j][0] + v[j][1] * v[j][1]) + (v[j][2] * v[j][2] + v[j][3] * v[j][3]); }
            const float r = rsqrtf(wave_sum(ss) * (1.0f / D) + EPS);
            if (t < T) { f32x4* orow = (f32x4*)(out + (size_t)t * D) + lane;
#pragma unroll
                for (int j = 0; j < 4; ++j) orow[64 * j] = v[j] * r * gf[j]; }
        }
    }
}


__device__ __forceinline__ void ph_mixers(const Params& p, const bf16_t* z, bf16_t* mixb, float* ssq, LAS unsigned char* lds, unsigned* qctr) {
    attn_setup(p, lds, TAB_OFF);
    volatile LAS int* qword = (volatile LAS int*)(lds + TAB_OFF + 12288);
    constexpr int NQ = NB, QITEMS = 64 + 64;
    unsigned long long* gran = (unsigned long long*)(p.ws + WS_CTL + 128 * 1024);
    const int qstep = (int)gridDim.x < NQ ? (int)gridDim.x : NQ;
    for (int q = blockIdx.x % NQ; q < NQ; q += qstep) {
        int ticket = 0, idx;
        if (threadIdx.x == 0) ticket = (int)__hip_atomic_fetch_add(qctr + 64 * q, 1u, __ATOMIC_RELAXED, __HIP_MEMORY_SCOPE_AGENT);
        for (;;) {
            __syncthreads();
            if (threadIdx.x == 0) { *qword = ticket; if (ticket < 64) ticket = (int)__hip_atomic_fetch_add(qctr + 64 * q, 1u, __ATOMIC_RELAXED, __HIP_MEMORY_SCOPE_AGENT); }
            __syncthreads();
            idx = *qword;
            if (idx >= 64) break;
            rglru_item(p, z, mixb, ssq, lds, gran, q, idx & 7, idx >> 3);
        }
        if (threadIdx.x == 0 && idx < QITEMS) ticket = (int)__hip_atomic_fetch_add(qctr + 64 * q, 1u, __ATOMIC_RELAXED, __HIP_MEMORY_SCOPE_AGENT);
        while (idx < QITEMS) {
            const int a = idx - 64; if (attn_item<true>(lds, z, mixb, ssq, q, 31 - (a >> 1), a & 1)) attn_item<false>(lds, z, mixb, ssq, q, 31 - (a >> 1), a & 1);
            __syncthreads();
            if (threadIdx.x == 0) { *qword = ticket; if (ticket < QITEMS) ticket = (int)__hip_atomic_fetch_add(qctr + 64 * q, 1u, __ATOMIC_RELAXED, __HIP_MEMORY_SCOPE_AGENT); }
            __syncthreads();
            idx = *qword;
        }
    }
}

#define XB_TMO      128
#define XB_XCNT(j)  (256  + 64 * (j))
#define XB_XSUB(j)  (1280 + 64 * (j))
#define XB_XGEN(j)  (2304 + 64 * (j))
#define XB_TOP      3328
#define XB_TOPGEN   3392
#define XCD_BAR_WORDS 3456
#define XB_SPIN_CAP (1u << 18)
__device__ __forceinline__ unsigned xb_ld(unsigned* p)              { return __hip_atomic_load(p, __ATOMIC_RELAXED, __HIP_MEMORY_SCOPE_AGENT); }
__device__ __forceinline__ unsigned xb_add(unsigned* p, unsigned v) { return __hip_atomic_fetch_add(p, v, __ATOMIC_RELAXED, __HIP_MEMORY_SCOPE_AGENT); }
__device__ __forceinline__ unsigned xb_xcc_id() { return (unsigned)__builtin_amdgcn_s_getreg((3 << 11) | 20) & 0xFu; }
#define XB_SPIN(cond, bar) do { unsigned _sp = 0; while (cond) { __builtin_amdgcn_s_sleep(1); \
    if ((++_sp & 255u) == 0u) { if (xb_ld(&(bar)[XB_TMO])) break; if (_sp > XB_SPIN_CAP) { atomicAdd(&(bar)[XB_TMO], 1u); break; } } } } while (0)
struct XcdBarrier { unsigned* bar; unsigned x; volatile LAS unsigned* st; };
__device__ __forceinline__ XcdBarrier xcd_barrier_post(unsigned* bar, volatile LAS unsigned* st) {
    XcdBarrier b; b.bar = bar; b.x = xb_xcc_id(); b.st = st;
    if (threadIdx.x == 0) (void)xb_add(&bar[XB_XCNT(b.x)], 1u);
    return b;
}
__device__ __forceinline__ void xcd_barrier_complete(unsigned* bar, unsigned x, unsigned& nloc, unsigned& nx) {
    const unsigned G = gridDim.x * gridDim.y * gridDim.z;
    unsigned sum, cnt, mine, sp = 0u;
    for (;;) {
        sum = 0u; cnt = 0u; mine = 0u;
#pragma unroll
        for (unsigned j = 0; j < 16; ++j) { const unsigned c = xb_ld(&bar[XB_XCNT(j)]); sum += c; cnt += (c > 0u) ? 1u : 0u; mine = (j == x) ? c : mine; }
        if (sum == G) break;
        __builtin_amdgcn_s_sleep(1);
        if ((++sp & 255u) == 0u) { if (xb_ld(&bar[XB_TMO])) break; if (sp > XB_SPIN_CAP) { atomicAdd(&bar[XB_TMO], 1u); break; } }
    }
    nloc = mine > 0u ? mine : 1u; nx = cnt > 0u ? cnt : 1u;
}
__device__ __forceinline__ void xcd_barrier(const XcdBarrier& b) {
    asm volatile("s_waitcnt vmcnt(0)" ::: "memory");
    __syncthreads();
    if (threadIdx.x == 0) {
        unsigned* bar = b.bar;
        __builtin_amdgcn_s_waitcnt(0);
        unsigned nloc = b.st[0], nx = b.st[1];
        if (nloc == 0u) { xcd_barrier_complete(bar, b.x, nloc, nx); b.st[0] = nloc; b.st[1] = nx; }
        const unsigned old = xb_add(&bar[XB_XSUB(b.x)], 1u);
        const unsigned gen = old / nloc;
        if (old + 1u == (gen + 1u) * nloc) {
            __builtin_amdgcn_fence(__ATOMIC_RELEASE, "agent");
            asm volatile("s_waitcnt vmcnt(0)" ::: "memory");
            const unsigned og = xb_add(&bar[XB_TOP], 1u);
            const unsigned tg = og / nx;
            if (og + 1u == (tg + 1u) * nx) xb_add(&bar[XB_TOPGEN], 1u);
            else XB_SPIN(xb_ld(&bar[XB_TOPGEN]) == tg, bar);
            __builtin_amdgcn_fence(__ATOMIC_ACQUIRE, "agent");
            xb_add(&bar[XB_XGEN(b.x)], 1u);
            asm volatile("s_waitcnt vmcnt(0)" ::: "memory");
        } else {
            XB_SPIN(xb_ld(&bar[XB_XGEN(b.x)]) == gen, bar);
            __builtin_amdgcn_fence(__ATOMIC_ACQUIRE, "agent");
            asm volatile("s_waitcnt vmcnt(0)" ::: "memory");
        }
    }
    __syncthreads();
}


__device__ __forceinline__ Params load_params() {
    unsigned long long a = (unsigned long long)__builtin_amdgcn_kernarg_segment_ptr(); asm volatile("" : "+s"(a));
    const __attribute__((address_space(4))) unsigned long long* q = (const __attribute__((address_space(4))) unsigned long long*)a;
    typedef __attribute__((address_space(1))) unsigned char* gptr_t;
    Params p; unsigned char** d = (unsigned char**)&p;
#pragma unroll
    for (int i = 0; i < (int)(sizeof(Params) / 8); ++i) d[i] = (unsigned char*)(gptr_t)q[i];
    return p;
}

__global__ void __launch_bounds__(NTHR) k_mega(Params p_arg) {
    extern __shared__ __attribute__((aligned(16))) unsigned char lds_raw[];
    LAS unsigned char* lds = (LAS unsigned char*)lds_raw;
    const int G = gridDim.x; const int bx = blockIdx.x;
    volatile LAS unsigned* misc = (volatile LAS unsigned*)(lds + MISC_OFF);
    if (threadIdx.x < 64) misc[threadIdx.x] = 0u;
    __syncthreads();
    const XcdBarrier xbar = xcd_barrier_post((unsigned*)(load_params().ws + WS_CTL + 65536), misc + 8);
    if (threadIdx.x == 0 && ((G % 8) != 0 || xbar.x != (unsigned)(bx % 8))) __hip_atomic_fetch_or((unsigned*)(load_params().ws + WS_CTL + 12288), 1u, __ATOMIC_RELAXED, __HIP_MEMORY_SCOPE_AGENT);
    const int vcu = (G % 8 == 0) ? (bx % 8) * (G / 8) + bx / 8 : bx;

    constexpr int NWG1 = (T / 256) * (INW / 256);
    const int n_idle = (NWG1 % G) ? G - (NWG1 % G) : 0, idle_idx = bx - (NWG1 % G);
    const int e_split = (n_idle >= 96) ? 4 : NE;
    { const Params p = load_params(); ph_prologue(p, lds, vcu, G, e_split); }
    xcd_barrier(xbar);
    {
        const Params p = load_params();
        pg8::DenseOrder So; So.init((const bf16_t*)(p.ws + WS_XB), (const bf16_t*)(p.ws + WS_WIN), T, INW, D, G, bx);
        pg8::EpiZ E{(bf16_t*)(p.ws + WS_Z), INW};
        pg8::gemm_phase(lds, D, So, E);
        if (e_split < NE && idle_idx >= 0) p1_tail_convert(p, lds, idle_idx, n_idle, e_split);
    }
    xcd_barrier(xbar);
    { const Params p = load_params(); ph_mixers(p, (const bf16_t*)(p.ws + WS_Z), (bf16_t*)(p.ws + WS_MIX), (float*)(p.ws + WS_SSQ), lds, (unsigned*)(p.ws + WS_CTL + 8192)); }
    xcd_barrier(xbar);
    {
        const Params p = load_params();
        pg8::DenseOrder So; So.init((const bf16_t*)(p.ws + WS_MIX), (const bf16_t*)(p.ws + WS_WOUT), T, D, D, G, bx);
        pg8::EpiH E{p.ws, p.out, TAB_OFF};
        pg8::gemm_phase(lds, D, So, E);
    }
    xcd_barrier(xbar);
    { const Params p = load_params();
      ph_router3(p, p.out, (int*)(p.ws + WS_CTL + 4096), (int*)(p.ws + WS_LIST), (float*)(p.ws + WS_LIST + MiB), (float*)(p.ws + WS_ROUTE), lds);
      p5a_tail_convert(p, lds, bx, G); }
    xcd_barrier(xbar);
    LAS int* meta = (LAS int*)(lds + META_OFF);
    if (threadIdx.x == 0) { misc[40] = __hip_atomic_load((unsigned*)(load_params().ws + WS_CTL + 12288), __ATOMIC_RELAXED, __HIP_MEMORY_SCOPE_AGENT);
        const int* gcount = (const int*)(load_params().ws + WS_CTL + 4096); int base = 0; for (int e = 0; e < NE; ++e) { const int cnt = gcount[e]; meta[e] = base; meta[32 + e] = cnt; base += (cnt + 255) >> 8; } meta[16] = base; }
    __syncthreads();
    const int ntiles = __builtin_amdgcn_readfirstlane(meta[16]);
    const bool xl = (__builtin_amdgcn_readfirstlane((int)misc[40]) == 0);
    {
        const Params p = load_params();
        pg8::MoeOrder<0> So{(const bf16_t*)(p.ws + WS_XB), (const bf16_t*)(p.ws + WS_WGU), (const int*)(p.ws + WS_LIST), meta, D, G, bx, ntiles, xl};
        pg8::EpiHid E{(bf16_t*)(p.ws + WS_HID), (const float*)(p.ws + WS_ROUTE), meta, TAB_OFF, xl ? (unsigned*)(p.ws + WS_CTL + 81920) : nullptr};
        pg8::gemm_phase(lds, D, So, E);
    }
    if (!xl) xcd_barrier(xbar);
    {
        const Params p = load_params();
        pg8::MoeOrder<1> So{(const bf16_t*)(p.ws + WS_HID), (const bf16_t*)(p.ws + WS_WD), (const int*)(p.ws + WS_LIST), meta, DFF, G, bx, ntiles, xl};
        if (xl) {
            if (threadIdx.x < 64) {
                unsigned* ready = (unsigned*)(p.ws + WS_CTL + 81920); pg8::Unit uu;
                for (int i = 0; So.next(i, uu); ++i) { unsigned sp = 0;
                    while ((unsigned)__builtin_amdgcn_readfirstlane((int)__hip_atomic_load(ready + 64 * uu.pm, __ATOMIC_RELAXED, __HIP_MEMORY_SCOPE_AGENT)) < 32u) { __builtin_amdgcn_s_sleep(4); if (++sp > (1u << 21)) break; } }
            }
            __syncthreads();
        }
        pg8::EpiY E{(bf16_t*)(p.ws + WS_Z), (const int*)(p.ws + WS_LIST), (const float*)(p.ws + WS_LIST + MiB), meta, TAB_OFF};
        pg8::gemm_phase(lds, DFF, So, E);
    }
    xcd_barrier(xbar);
    { const Params p = load_params(); ph_final(p, (const bf16_t*)(p.ws + WS_XB), (const bf16_t*)(p.ws + WS_Z), p.out); }
}

extern "C" void kernel_launch(void* const* d_in, const int* in_sizes, int n_in, void* d_out, int out_size, void* d_ws, size_t ws_size, hipStream_t stream) {
    static int grid_blocks = 0;
    if (!grid_blocks) {
        if (ws_size < WS_END) { fprintf(stderr, "kernel_launch: workspace too small (%zu < %zu)\n", ws_size, (size_t)WS_END); grid_blocks = -1; return; }
        int dev = 0, cus = 0, per_cu = 0;
        (void)hipGetDevice(&dev);
        (void)hipDeviceGetAttribute(&cus, hipDeviceAttributeMultiprocessorCount, dev);
        (void)hipFuncSetAttribute((const void*)k_mega, hipFuncAttributeMaxDynamicSharedMemorySize, LDS_BYTES);
        (void)hipOccupancyMaxActiveBlocksPerMultiprocessor(&per_cu, (const void*)k_mega, NTHR, LDS_BYTES);
        if (per_cu < 1) { fprintf(stderr, "kernel_launch: occupancy query says %d blocks per CU: not launching\n", per_cu); grid_blocks = -1; return; }
        grid_blocks = cus;
    }
    if (grid_blocks < 0) return;
    Params p{};
    const float** f = (const float**)&p;
    for (int i = 0; i < 23; ++i) f[i] = (const float*)d_in[i];
    p.out = (float*)d_out;
    p.ws = (unsigned char*)d_ws;
    (void)hipMemsetAsync((char*)d_ws + WS_CTL, 0, CTL_ZERO_BYTES, stream);
    hipLaunchKernelGGL(k_mega, dim3(grid_blocks), dim3(NTHR), LDS_BYTES, stream, p);
    hipError_t e = hipPeekAtLastError();
    if (e != hipSuccess) fprintf(stderr, "launch failed: %s (grid %d)\n", hipGetErrorString(e), grid_blocks);
}
```

```cpp
#include <hip/hip_runtime.h>
#include <cstdio>
#include <cstdint>

#define LAS __attribute__((address_space(3)))
typedef unsigned short bf16_t;
typedef short bf16x8 __attribute__((ext_vector_type(8)));
typedef float f32x4 __attribute__((ext_vector_type(4)));
typedef float f32x2 __attribute__((ext_vector_type(2)));
typedef unsigned u32x4 __attribute__((ext_vector_type(4)));
typedef unsigned u32x2 __attribute__((ext_vector_type(2)));

constexpr int D = 1024, NB = 8, S = 2048, T = NB * S;
constexpr int RW = 512, RHD = 64;
constexpr int CHUNK = 64, LEFT = 8, BAND = 576, MAXREL = 128;
constexpr int INW = 2560;
constexpr int NE = 16, DFF = 512;
constexpr float EPS = 1e-6f;
constexpr int NTHR = 512, NWAVES = 8;
constexpr int SSQW = 40;

constexpr size_t MiB = 1u << 20;
constexpr size_t WS_CTL = 0, CTL_BYTES = 2 * MiB, CTL_PRE_OFF = 64 * 1024, CTL_PRE_BYTES = 16 * 1024, CTL_ALL_BYTES = 640 * 1024;
constexpr size_t WS_WIN = 2 * MiB;
constexpr size_t WS_WOUT = 7 * MiB;
constexpr size_t WS_WGU = 9 * MiB;
constexpr size_t WS_WD = 41 * MiB;
constexpr size_t WS_XB = 57 * MiB;
constexpr size_t WS_Z = 89 * MiB;
constexpr size_t WS_MIX = 169 * MiB;
constexpr size_t WS_HID = 201 * MiB;
constexpr size_t WS_SSQ = 237 * MiB;
constexpr size_t WS_LIST = 240 * MiB;
constexpr size_t WS_ROUTE = 242 * MiB;
constexpr size_t WS_RWT = 243 * MiB;
constexpr size_t WS_GWT = 244 * MiB;
constexpr size_t WS_END = 245 * MiB;

constexpr int RING_BYTES = 131072, TAB_OFF = RING_BYTES, META_OFF = RING_BYTES + 4096, MISC_OFF = RING_BYTES + 15360, LDS_BYTES = 147456;

struct Params {
    const float *x, *norm1_g, *w_in, *conv_w, *conv_b, *w_rg_a, *b_rg_a, *w_rg_x, *b_rg_x, *lru_lambda, *rel_bias,
        *g_rec_out, *g_att_out, *w_out, *norm2_g, *w_group, *b_group, *w_router, *b_router, *w_e_gate, *w_e_up, *w_e_down, *final_g;
    float* out;
    unsigned char* ws;
};

__device__ __forceinline__ float wave_sum(float v) {
#pragma unroll
    for (int o = 32; o > 0; o >>= 1) v += __shfl_xor(v, o);
    return v;
}
__device__ __forceinline__ unsigned f2bf(float f) { unsigned u = __builtin_bit_cast(unsigned, f); return (u + 0x7fffu + ((u >> 16) & 1u)) >> 16; }
__device__ __forceinline__ unsigned pk2(float lo, float hi) { return f2bf(lo) | (f2bf(hi) << 16); }
__device__ __forceinline__ float bf2f(bf16_t b) { return __builtin_bit_cast(float, ((unsigned)b) << 16); }
__device__ __forceinline__ unsigned cvt_pk_bf16(float lo, float hi) { unsigned r; asm volatile("v_cvt_pk_bf16_f32 %0, %1, %2" : "=v"(r) : "v"(lo), "v"(hi)); return r; }
#define LDS_WAIT() asm volatile("s_waitcnt lgkmcnt(0)" ::: "memory")
__device__ __forceinline__ int opaque_tid() { int t = threadIdx.x; asm volatile("" : "+v"(t)); return t; }

namespace pg8 {
constexpr int BM = 256, BK = 64, HALF = 128, HTB = HALF * BK * 2, STAGE_BYTES = 8 * HTB, NXCD = 8, WGM = 8;
__device__ __forceinline__ int lds_byte(int r, int c) { const int st = (r >> 4) * 2 + (c >> 5), rr = r & 15, cc = c & 31, ob = rr * 64 + cc * 2; return st * 1024 + (ob ^ (((ob >> 9) & 1) << 5)); }
__device__ __forceinline__ void stage_rc(int b, int& R, int& C) { const int st = b / 1024, sb = b % 1024, swz = sb ^ (((sb >> 9) & 1) << 5); R = (st >> 1) * 16 + swz / 64; C = (st & 1) * 32 + (swz % 64) / 2; }
__device__ __forceinline__ int perm32(int rho) { const int n = rho >> 4, i = rho & 15; return 8 * (i >> 2) + 4 * n + (i & 3); }

struct Unit { int pm, pn, e, rows; };

struct DenseOrder {
    const bf16_t* A; const bf16_t* Bt; int K; int nM, nN, nwg, G, c;
    __device__ void init(const bf16_t* A_, const bf16_t* Bt_, int M, int N, int K_, int G_, int c_) { A = A_; Bt = Bt_; K = K_; nM = M / BM; nN = N / BM; nwg = nM * nN; G = G_; c = c_; }
    __device__ __forceinline__ bool next(int i, Unit& u) const {
        const long L = (long)i * G + c; if (L >= nwg) return false;
        int wgid = (int)L; { const int q = nwg / NXCD, r = nwg % NXCD, xcd = wgid % NXCD, off = wgid / NXCD; wgid = (xcd < r ? xcd * (q + 1) : r * (q + 1) + (xcd - r) * q) + off; }
        const int nig = WGM * nN, gid = wgid / nig, fm = gid * WGM, gsz = (nM - fm) < WGM ? (nM - fm) : WGM;
        u.pm = fm + ((wgid % nig) % gsz); u.pn = (wgid % nig) / gsz; u.e = 0; u.rows = BM; return true;
    }
    __device__ __forceinline__ void addr(const Unit& u, const int (&RA)[2], const int (&CA)[2], const char*& aBase, const char*& bBase, unsigned (&va)[2][2]) const {
        aBase = (const char*)A; bBase = (const char*)Bt + (size_t)u.pn * BM * K * 2;
#pragma unroll
        for (int h = 0; h < 2; ++h)
#pragma unroll
            for (int i = 0; i < 2; ++i) va[h][i] = (unsigned)(((size_t)(u.pm * BM + h * HALF + RA[i]) * K + CA[i]) * 2);
    }
};

template <class Epi, class Sched>
__device__ __forceinline__ void gemm_phase(LAS unsigned char* lds, const int K, const Sched& S, const Epi& E) {
    int tid_ = threadIdx.x; asm volatile("" : "+v"(tid_));
    const int tid = tid_, wid = __builtin_amdgcn_readfirstlane(tid >> 6), lane = tid & 63, wr = wid >> 2, wc = wid & 3, fr = lane & 15, fq = lane >> 4;
    const int nt = K / BK;
    int RA[2], CA[2]; unsigned voffB[2];
#pragma unroll
    for (int i = 0; i < 2; ++i) { int R, C; stage_rc(tid * 16 + i * 8192, R, C); RA[i] = R; CA[i] = C; const int Rb = Epi::ADJ ? ((R >> 5) * 64 + (Epi::PERM ? perm32(R & 31) : (R & 31))) : Epi::PERM ? ((R & ~31) + perm32(R & 31)) : R; voffB[i] = (unsigned)(Rb * K + C) * 2u; }
    const size_t kstep = (size_t)(BK * 2);
    const size_t hstepB = (size_t)(Epi::ADJ ? 32 : HALF) * K * 2;
    const unsigned ldsw = (unsigned)wid * 1024u;
    const int aoff = lds_byte(wr * 64 + fr, fq * 8), boff = lds_byte(wc * 32 + fr, fq * 8);
#define PG8_SA(b, h) (((b) * 2 + (h)) * HTB)
#define PG8_SB(b, h) ((4 + (b) * 2 + (h)) * HTB)
#define PG8_STAGE_B(bufoff, gbase) do { _Pragma("unroll") for (int _i = 0; _i < 2; ++_i) \
        __builtin_amdgcn_global_load_lds((const unsigned*)((const char*)(gbase) + voffB[_i]), (LAS unsigned*)(lds + (bufoff) + ldsw + _i * 8192), 16, 0, 0); } while (0)
#define PG8_STAGE_A(bufoff, gbase, v0, v1) do { \
        __builtin_amdgcn_global_load_lds((const unsigned*)((const char*)(gbase) + (v0)), (LAS unsigned*)(lds + (bufoff) + ldsw), 16, 0, 0); \
        __builtin_amdgcn_global_load_lds((const unsigned*)((const char*)(gbase) + (v1)), (LAS unsigned*)(lds + (bufoff) + ldsw + 8192), 16, 0, 0); } while (0)
#define PG8_LDA(dst, b, h) do { _Pragma("unroll") for (int m = 0; m < 4; ++m) _Pragma("unroll") for (int k = 0; k < 2; ++k) dst[m][k] = *(const LAS bf16x8*)(lds + PG8_SA(b, h) + aoff + m * 2048 + k * 1024); } while (0)
#define PG8_LDB(dst, b, h) do { _Pragma("unroll") for (int n = 0; n < 2; ++n) _Pragma("unroll") for (int k = 0; k < 2; ++k) dst[n][k] = *(const LAS bf16x8*)(lds + PG8_SB(b, h) + boff + n * 2048 + k * 1024); } while (0)
#define PG8_MMA(ai, bj, At, Bt) do { __builtin_amdgcn_s_setprio(1); _Pragma("unroll") for (int m = 0; m < 4; ++m) _Pragma("unroll") for (int n = 0; n < 2; ++n) _Pragma("unroll") for (int k = 0; k < 2; ++k) \
        acc[ai][bj][m][n] = __builtin_amdgcn_mfma_f32_16x16x32_bf16(Bt[n][k], At[m][k], acc[ai][bj][m][n], 0, 0, 0); __builtin_amdgcn_s_setprio(0); } while (0)
#define PG8_WAIT_V(n) asm volatile("s_waitcnt vmcnt(" #n ")" ::: "memory")
#define PG8_WAIT_L(n) asm volatile("s_waitcnt lgkmcnt(" #n ")" ::: "memory")
#define PG8_BAR __builtin_amdgcn_s_barrier()
#define PG8_SCHED __builtin_amdgcn_sched_barrier(0)
    Unit cur, nxt; int ui = 0;
    if (!S.next(0, cur)) return;
    f32x4 acc[2][2][4][2];
#pragma unroll
    for (int a = 0; a < 2; ++a)
#pragma unroll
        for (int b = 0; b < 2; ++b)
#pragma unroll
            for (int m = 0; m < 4; ++m)
#pragma unroll
                for (int n = 0; n < 2; ++n) acc[a][b][m][n] = (f32x4){0.f, 0.f, 0.f, 0.f};
    bf16x8 At[4][2], B0[2][2], B1[2][2];
    const char *cA, *cB, *nA, *nB; unsigned cva[2][2], nva[2][2];
    S.addr(cur, RA, CA, cA, cB, cva);
    PG8_STAGE_B(PG8_SB(0, 0), cB); PG8_STAGE_A(PG8_SA(0, 0), cA, cva[0][0], cva[0][1]); PG8_STAGE_B(PG8_SB(0, 1), cB + hstepB); PG8_STAGE_A(PG8_SA(0, 1), cA, cva[1][0], cva[1][1]);
    E.prepare(cur, ui, lds);
    if (wr == 1) PG8_BAR;
    PG8_WAIT_V(4); PG8_BAR;
    PG8_STAGE_B(PG8_SB(1, 0), cB + kstep); PG8_STAGE_A(PG8_SA(1, 0), cA + kstep, cva[0][0], cva[0][1]); PG8_STAGE_B(PG8_SB(1, 1), cB + hstepB + kstep);
    PG8_WAIT_V(6); PG8_BAR;
    for (;;) {
        const bool has_next = S.next(ui + 1, nxt);
        if (has_next) { S.addr(nxt, RA, CA, nA, nB, nva); }
        else { nA = cA; nB = cB;
#pragma unroll
            for (int h = 0; h < 2; ++h)
#pragma unroll
                for (int i = 0; i < 2; ++i) nva[h][i] = cva[h][i]; }
        for (int t = 0; t < nt; t += 2) {
            const bool last = (t == nt - 2);
            if (Epi::MIDSCALE && t == nt / 2) E.midscale(acc, wr, fr, ui, lds);
            const char* a1 = cA + (size_t)(t + 1) * kstep;
            const char* a2 = last ? nA : cA + (size_t)(t + 2) * kstep; const char* b2 = last ? nB : cB + (size_t)(t + 2) * kstep;
            const char* a3 = a2 + kstep; const char* b3 = b2 + kstep;
            const unsigned x00 = last ? nva[0][0] : cva[0][0], x01 = last ? nva[0][1] : cva[0][1], x10 = last ? nva[1][0] : cva[1][0], x11 = last ? nva[1][1] : cva[1][1];
            if (last && has_next) E.prepare(nxt, ui + 1, lds);
            PG8_LDB(B0, 0, 0); PG8_SCHED; PG8_LDA(At, 0, 0); PG8_STAGE_A(PG8_SA(1, 1), a1, cva[1][0], cva[1][1]);
            PG8_WAIT_L(8); PG8_BAR; PG8_WAIT_L(0); PG8_MMA(0, 0, At, B0); PG8_BAR; PG8_SCHED;
            PG8_LDB(B1, 0, 1); PG8_STAGE_B(PG8_SB(0, 0), b2);
            PG8_BAR; PG8_WAIT_L(0); PG8_MMA(0, 1, At, B1); PG8_BAR;
            PG8_LDA(At, 0, 1); PG8_STAGE_A(PG8_SA(0, 0), a2, x00, x01);
            PG8_BAR; PG8_WAIT_L(0); PG8_MMA(1, 0, At, B0); PG8_BAR; PG8_SCHED;
            PG8_STAGE_B(PG8_SB(0, 1), b2 + hstepB);
            PG8_WAIT_V(6); PG8_BAR; PG8_MMA(1, 1, At, B1); PG8_BAR;
            PG8_LDB(B0, 1, 0); PG8_SCHED; PG8_LDA(At, 1, 0); PG8_STAGE_A(PG8_SA(0, 1), a2, x10, x11);
            PG8_WAIT_L(8); PG8_BAR; PG8_WAIT_L(0); PG8_MMA(0, 0, At, B0); PG8_BAR; PG8_SCHED;
            PG8_LDB(B1, 1, 1); PG8_STAGE_B(PG8_SB(1, 0), b3);
            PG8_BAR; PG8_WAIT_L(0); PG8_MMA(0, 1, At, B1); PG8_BAR;
            PG8_LDA(At, 1, 1); PG8_STAGE_A(PG8_SA(1, 0), a3, x00, x01);
            PG8_BAR; PG8_WAIT_L(0); PG8_MMA(1, 0, At, B0); PG8_BAR; PG8_SCHED;
            PG8_STAGE_B(PG8_SB(1, 1), b3 + hstepB);
            PG8_WAIT_V(6); PG8_BAR; PG8_MMA(1, 1, At, B1); PG8_BAR;
        }
        E(acc, cur, wr, wc, fr, fq, ui, lds);
        if (!has_next) break;
        E.prepare_late(nxt, ui + 1, lds);
#pragma unroll
        for (int a = 0; a < 2; ++a)
#pragma unroll
            for (int b = 0; b < 2; ++b)
#pragma unroll
                for (int m = 0; m < 4; ++m)
#pragma unroll
                    for (int n = 0; n < 2; ++n) acc[a][b][m][n] = (f32x4){0.f, 0.f, 0.f, 0.f};
        cur = nxt; cA = nA; cB = nB; ++ui;
#pragma unroll
        for (int h = 0; h < 2; ++h)
#pragma unroll
            for (int i = 0; i < 2; ++i) cva[h][i] = nva[h][i];
    }
    PG8_WAIT_V(0);
    if (wr == 0) PG8_BAR;
    PG8_BAR;
#undef PG8_SA
#undef PG8_SB
#undef PG8_STAGE_A
#undef PG8_STAGE_B
#undef PG8_LDA
#undef PG8_LDB
#undef PG8_MMA
#undef PG8_WAIT_V
#undef PG8_WAIT_L
#undef PG8_BAR
#undef PG8_SCHED
}

struct EpiZ {
    static constexpr bool PERM = true, MIDSCALE = false, ADJ = true;
    bf16_t* O; int ldc;
    __device__ __forceinline__ void prepare(const Unit&, int, LAS unsigned char*) const {}
    __device__ __forceinline__ void prepare_late(const Unit&, int, LAS unsigned char*) const {}
    __device__ __forceinline__ void midscale(f32x4 (&)[2][2][4][2], int, int, int, LAS unsigned char*) const {}
    __device__ __forceinline__ void operator()(const f32x4 (&acc)[2][2][4][2], const Unit& u, int wr, int wc, int fr, int fq, int, LAS unsigned char*) const {
        const int row0 = u.pm * BM + wr * 64 + fr, col0 = u.pn * BM + wc * 64 + 8 * fq;
#pragma unroll
        for (int ai = 0; ai < 2; ++ai)
#pragma unroll
            for (int m = 0; m < 4; ++m) { bf16_t* rowp = O + (size_t)(row0 + ai * HALF + m * 16) * ldc + col0;
#pragma unroll
                for (int bj = 0; bj < 2; ++bj) { const f32x4 v0 = acc[ai][bj][m][0], v1 = acc[ai][bj][m][1];
                    u32x4 w; w.x = cvt_pk_bf16(v0[0], v0[1]); w.y = cvt_pk_bf16(v0[2], v0[3]); w.z = cvt_pk_bf16(v1[0], v1[1]); w.w = cvt_pk_bf16(v1[2], v1[3]);
                    *(u32x4*)(rowp + bj * 32) = w; } }
    }
};
typedef __bf16 bf16x2_e __attribute__((ext_vector_type(2)));
__device__ __forceinline__ unsigned cvtpk_b(float lo, float hi) { f32x2 v = {lo, hi}; bf16x2_e b = __builtin_convertvector(v, bf16x2_e); return __builtin_bit_cast(unsigned, b); }
template <bool red>
struct EpiH {
    static constexpr bool PERM = false, MIDSCALE = true, ADJ = true;
    unsigned char* ws; float* part; int tab_off;
    __device__ __forceinline__ void prepare_late(const Unit&, int, LAS unsigned char*) const {}
    __device__ __forceinline__ void prepare(const Unit& u, int ui, LAS unsigned char* lds) const {
        LAS f32x4* tab = (LAS f32x4*)(lds + tab_off) + (ui & 1) * 256;
        unsigned long long wsb = (unsigned long long)ws; asm volatile("" : "+s"(wsb));
        const float* ssq = (const float*)(wsb + WS_SSQ); const float* rinv1 = (const float*)(wsb + WS_GWT + 256 * 1024);
        if (threadIdx.x < 256) {
            const float* sp = ssq + (size_t)(u.pm * BM + threadIdx.x) * SSQW; float sa = 0.f, sb = 0.f;
#pragma unroll
            for (int i = 0; i < 8; ++i) { const f32x4 v = *(const f32x4*)(sp + 4 * i); sa += (v[0] + v[1]) + (v[2] + v[3]); }
#pragma unroll
            for (int i = 8; i < 10; ++i) { const f32x4 v = *(const f32x4*)(sp + 4 * i); sb += (v[0] + v[1]) + (v[2] + v[3]); }
            const float ra = rsqrtf(sa * (1.0f / 512.0f) + EPS), rb = rsqrtf(sb * (1.0f / 512.0f) + EPS);
            tab[threadIdx.x] = (f32x4){ra / rb, rb, rinv1[u.pm * BM + threadIdx.x], 0.f};
        }
    }
    __device__ __forceinline__ void midscale(f32x4 (&acc)[2][2][4][2], int wr, int fr, int ui, LAS unsigned char* lds) const {
        const LAS f32x4* tab = (const LAS f32x4*)(lds + tab_off) + (ui & 1) * 256;
#pragma unroll
        for (int ai = 0; ai < 2; ++ai)
#pragma unroll
            for (int m = 0; m < 4; ++m) { const float s = tab[ai * HALF + wr * 64 + m * 16 + fr][0];
#pragma unroll
                for (int bj = 0; bj < 2; ++bj)
#pragma unroll
                    for (int n = 0; n < 2; ++n) acc[ai][bj][m][n] = acc[ai][bj][m][n] * s; }
    }
    __device__ __forceinline__ void operator()(const f32x4 (&acc)[2][2][4][2], const Unit& u, int wr, int wc, int fr, int fq, int ui, LAS unsigned char* lds) const {
        const LAS f32x4* tab = (const LAS f32x4*)(lds + tab_off) + (ui & 1) * 256;
        if (red) {
            if (wr == 0) __builtin_amdgcn_s_barrier();
            asm volatile("s_waitcnt vmcnt(0)" ::: "memory"); __syncthreads(); }
        const float* rwt = (const float*)(ws + WS_RWT); bf16_t* hb = (bf16_t*)(ws + WS_XB);
        const int row0 = u.pm * BM + wr * 64 + fr, col0 = u.pn * BM + wc * 64 + 4 * fq;
        float br[2][2][4], bg[2][2][4];
#pragma unroll
        for (int bj = 0; bj < 2; ++bj)
#pragma unroll
            for (int n = 0; n < 2; ++n)
#pragma unroll
                for (int j = 0; j < 4; ++j) { const int c = col0 + bj * 32 + n * 16 + j; br[bj][n][j] = rwt[fr * 1028 + c]; bg[bj][n][j] = rwt[(16 + (fr & 3)) * 1028 + c]; }
#pragma unroll
        for (int ai = 0; ai < 2; ++ai) {
            u32x2 xv[4][2][2];
#pragma unroll
            for (int m = 0; m < 4; ++m)
#pragma unroll
                for (int bj = 0; bj < 2; ++bj)
#pragma unroll
                    for (int n = 0; n < 2; ++n) xv[m][bj][n] = *(const u32x2*)(hb + (size_t)(row0 + ai * HALF + m * 16) * D + col0 + bj * 32 + n * 16);
#pragma unroll
            for (int m = 0; m < 4; ++m) { const f32x4 tv = tab[ai * HALF + wr * 64 + m * 16 + fr]; const float s = tv[1], ri = tv[2]; const size_t ro = (size_t)(row0 + ai * HALF + m * 16) * D + col0;
                f32x4 ar = {0.f, 0.f, 0.f, 0.f}, ag = {0.f, 0.f, 0.f, 0.f}; float ssl = 0.f;
#pragma unroll
                for (int bj = 0; bj < 2; ++bj) { u32x2 pk[2];
#pragma unroll
                    for (int n = 0; n < 2; ++n) { const u32x2 xr = xv[m][bj][n];
                        const f32x4 xf = {__builtin_bit_cast(float, xr[0] << 16), __builtin_bit_cast(float, xr[0] & 0xffff0000u), __builtin_bit_cast(float, xr[1] << 16), __builtin_bit_cast(float, xr[1] & 0xffff0000u)};
                        const f32x4 hv = xf * ri + acc[ai][bj][m][n] * s;
                        pk[n] = (u32x2){cvtpk_b(hv[0], hv[1]), cvtpk_b(hv[2], hv[3])};
#pragma unroll
                        for (int j = 0; j < 4; ++j) { ar = __builtin_amdgcn_mfma_f32_16x16x4f32(hv[j], br[bj][n][j], ar, 0, 0, 0); ag = __builtin_amdgcn_mfma_f32_16x16x4f32(hv[j], bg[bj][n][j], ag, 0, 0, 0); ssl += hv[j] * hv[j]; } }
                    const auto sx = __builtin_amdgcn_permlane16_swap(pk[0].x, pk[1].x, false, false), sy = __builtin_amdgcn_permlane16_swap(pk[0].y, pk[1].y, false, false);
                    *(u32x4*)(hb + ro + bj * 32 + ((fq & 1) ? 12 : 0)) = (u32x4){sx[0], sy[0], sx[1], sy[1]}; }
                ssl += __shfl_xor(ssl, 16); ssl += __shfl_xor(ssl, 32);
                if (red) {
                    LAS float* prow = (LAS float*)lds + ((wc * 256 + ai * HALF + wr * 64 + m * 16) * 24);
#pragma unroll
                    for (int rg_ = 0; rg_ < 4; ++rg_) { LAS float* pr = prow + (4 * fq + rg_) * 24; pr[fr] = ar[rg_]; if (fr < 4) pr[16 + fr] = ag[rg_]; }
                    if (fq == 0) prow[fr * 24 + 20] = ssl;
                } else {
                    float* prow = part + ((size_t)(u.pm * BM + ai * HALF + wr * 64 + m * 16) * 16 + (u.pn * 4 + wc)) * 24;
#pragma unroll
                    for (int rg_ = 0; rg_ < 4; ++rg_) { float* pr = prow + (size_t)(4 * fq + rg_) * (16 * 24); pr[fr] = ar[rg_]; if (fr < 4) pr[16 + fr] = ag[rg_]; }
                    if (fq == 0) prow[(size_t)fr * (16 * 24) + 20] = ssl;
                }
            }
        }
        if (red) {
            __syncthreads();
            int tid = threadIdx.x; asm volatile("" : "+v"(tid));
            const int row = tid >> 1, hf = tid & 1;
            const LAS f32x4* sp = (const LAS f32x4*)((LAS float*)lds + row * 24 + hf * 12);
            f32x4* dp = (f32x4*)(part + ((size_t)(u.pm * BM + row) * 4 + u.pn) * 24 + hf * 12);
#pragma unroll
            for (int i = 0; i < 3; ++i) dp[i] = (sp[i] + sp[i + 256 * 6]) + (sp[i + 2 * 256 * 6] + sp[i + 3 * 256 * 6]);
            if (wr == 1) __builtin_amdgcn_s_barrier();
        }
    }
};

template <int MODE>
struct MoeOrder {
    const bf16_t* A; const bf16_t* Bt; const int* tok_list; const LAS int* meta; int K, G, c, ntiles; bool xl;
    __device__ __forceinline__ bool next(int i, Unit& u) const {
        int L;
        if (xl) { const int x = c & 7, lr = c >> 3, Gl = G >> 3, lo = (x * ntiles) >> 3, ntx = (((x + 1) * ntiles) >> 3) - lo, U = 4 * ntx, d = U - 2 * Gl; int Ll;
            if (d > 0 && Gl == 8 * d) {
                const int nX = 3 * d, nY = Gl - 5 * d;
                if (MODE == 0) { if (i == 0) Ll = lr; else if (i == 1 && lr < nX + nY) Ll = Gl + lr; else if (i == 2 && lr < nX) Ll = 2 * Gl - 2 * d + lr; else return false; }
                else { if (lr < nX) { if (i > 0) return false; Ll = 2 * Gl - 2 * d + lr; }
                       else if (lr < nX + nY) { if (i > 1) return false; Ll = Gl + 2 * (lr - nX) + i; }
                       else { if (i > 3) return false; Ll = 4 * (lr - nX - nY) + i; } }
            }
            else if (MODE == 0) { Ll = i * Gl + lr; if (Ll >= U) return false; }
            else { const int r = U % Gl, FG = U - r;
                if (lr < r) { if (i > 0) return false; Ll = FG + lr; } else { Ll = (lr - r) + i * (Gl - r); if (Ll >= FG) return false; } }
            L = ((lo + (Ll >> 2)) << 2) | (Ll & 3); }
        else { L = i * G + c; if (L >= ntiles * 4) return false; }
        const int mt = L >> 2; int e = 0;
#pragma unroll
        for (int j = 1; j < NE; ++j) e += (mt >= meta[j]) ? 1 : 0;
        u.pm = mt; u.pn = L & 3; u.e = e; u.rows = meta[32 + e] - (mt - meta[e]) * BM; return true;
    }
    __device__ __forceinline__ void addr(const Unit& u, const int (&RA)[2], const int (&CA)[2], const char*& aBase, const char*& bBase, unsigned (&va)[2][2]) const {
        aBase = (const char*)A; bBase = (const char*)Bt + ((size_t)u.e * D + (size_t)u.pn * BM) * K * 2;
        const int slot0 = (u.pm - meta[u.e]) * BM;
#pragma unroll
        for (int h = 0; h < 2; ++h)
#pragma unroll
            for (int i = 0; i < 2; ++i) {
                const int r = h * HALF + RA[i];
                if (MODE == 0) { const int tl = tok_list[u.e * T + slot0 + r] >> 1; const int tok = (r < u.rows) ? tl : 0; va[h][i] = (unsigned)(((size_t)tok * K + CA[i]) * 2); }
                else va[h][i] = (unsigned)(((size_t)(u.pm * BM + r) * K + CA[i]) * 2);
            }
    }
};
struct EpiHid {
    static constexpr bool PERM = true, MIDSCALE = false, ADJ = false;
    bf16_t* hid; const float* r_list; const LAS int* meta; int tab_off; unsigned* ready;
    __device__ __forceinline__ void prepare(const Unit& u, int ui, LAS unsigned char* lds) const { if (ui == 0) prepare_late(u, ui, lds); }
    __device__ __forceinline__ void prepare_late(const Unit& u, int ui, LAS unsigned char* lds) const {
        const int tid = threadIdx.x;
        if (tid < 256) { const int slot0 = (u.pm - __builtin_amdgcn_readfirstlane(meta[u.e])) * BM, wv = __builtin_amdgcn_readfirstlane(tid >> 6);
            const unsigned* sb = (const unsigned*)(r_list + u.e * T + slot0 + wv * 64);
            __builtin_amdgcn_global_load_lds(sb + (tid & 63), (LAS unsigned*)(lds + tab_off + (ui & 1) * 1024 + wv * 256), 4, 0, 0); }
    }
    __device__ __forceinline__ void midscale(f32x4 (&)[2][2][4][2], int, int, int, LAS unsigned char*) const {}
    __device__ __forceinline__ void operator()(const f32x4 (&acc)[2][2][4][2], const Unit& u, int wr, int wc, int fr, int fq, int ui, LAS unsigned char* lds) const {
        const int row0 = u.pm * BM + wr * 64 + fr, j0 = u.pn * 128 + wc * 16 + 4 * fq;
        int tix = wr * 64 + fr; asm volatile("" : "+v"(tix));
        const LAS float* rtab = (const LAS float*)(lds + tab_off + (ui & 1) * 1024) + tix;
        float rsv[2][4];
#pragma unroll
        for (int ai = 0; ai < 2; ++ai)
#pragma unroll
            for (int m = 0; m < 4; ++m) rsv[ai][m] = rtab[ai * HALF + m * 16];
#pragma unroll
        for (int ai = 0; ai < 2; ++ai)
#pragma unroll
            for (int m = 0; m < 4; ++m) { bf16_t* rowp = hid + (size_t)(row0 + ai * HALF + m * 16) * DFF + j0;
                const int r = ai * HALF + m * 16 + tix; const float rs = (r < u.rows) ? rsv[ai][m] : 0.f;
                u32x2 pk[2];
#pragma unroll
                for (int bj = 0; bj < 2; ++bj) { const f32x4 g = acc[ai][bj][m][0] * rs, up = acc[ai][bj][m][1] * rs; float hv[4];
#pragma unroll
                    for (int q = 0; q < 4; ++q) hv[q] = g[q] * up[q] * __builtin_amdgcn_rcpf(1.0f + __expf(-g[q]));
                    pk[bj] = (u32x2){cvtpk_b(hv[0], hv[1]), cvtpk_b(hv[2], hv[3])}; }
                const auto sx = __builtin_amdgcn_permlane16_swap(pk[0].x, pk[1].x, false, false), sy = __builtin_amdgcn_permlane16_swap(pk[0].y, pk[1].y, false, false);
                *(u32x4*)(rowp + ((fq & 1) ? 60 : 0)) = (u32x4){sx[0], sy[0], sx[1], sy[1]}; }
        if (ready) {
            asm volatile("s_waitcnt vmcnt(0)" ::: "memory");
            if (fr == 0 && fq == 0) __hip_atomic_fetch_add(ready + 64 * u.pm, 1u, __ATOMIC_RELAXED, __HIP_MEMORY_SCOPE_AGENT);
        }
    }
};
struct EpiY {
    static constexpr bool PERM = true, MIDSCALE = false, ADJ = true;
    bf16_t* y2; const int* tok_list; const float* w_list; const LAS int* meta; int tab_off;
    __device__ __forceinline__ void prepare(const Unit& u, int ui, LAS unsigned char* lds) const { if (ui == 0) prepare_late(u, ui, lds); }
    __device__ __forceinline__ void prepare_late(const Unit& u, int ui, LAS unsigned char* lds) const {
        const int tid = threadIdx.x;
        if (tid < 256) { const int wv = __builtin_amdgcn_readfirstlane(tid >> 6), li = u.e * T + (u.pm - __builtin_amdgcn_readfirstlane(meta[u.e])) * BM + wv * 64;
            __builtin_amdgcn_global_load_lds((const unsigned*)(tok_list + li) + (tid & 63), (LAS unsigned*)(lds + tab_off + (ui & 1) * 1024 + wv * 256), 4, 0, 0);
            __builtin_amdgcn_global_load_lds((const unsigned*)(w_list + li) + (tid & 63), (LAS unsigned*)(lds + tab_off + 2048 + (ui & 1) * 1024 + wv * 256), 4, 0, 0); }
    }
    __device__ __forceinline__ void midscale(f32x4 (&)[2][2][4][2], int, int, int, LAS unsigned char*) const {}
    __device__ __forceinline__ void operator()(const f32x4 (&acc)[2][2][4][2], const Unit& u, int wr, int wc, int fr, int fq, int ui, LAS unsigned char* lds) const {
        const int col0 = u.pn * BM + wc * 64 + 8 * fq;
        int tix = wr * 64 + fr; asm volatile("" : "+v"(tix));
        const LAS int* dtab = (const LAS int*)(lds + tab_off + (ui & 1) * 1024) + tix; const LAS float* wtab = (const LAS float*)(lds + tab_off + 2048 + (ui & 1) * 1024) + tix;
        int dstv[2][4]; float wv[2][4];
#pragma unroll
        for (int ai = 0; ai < 2; ++ai)
#pragma unroll
            for (int m = 0; m < 4; ++m) { dstv[ai][m] = dtab[ai * HALF + m * 16]; wv[ai][m] = wtab[ai * HALF + m * 16]; }
#pragma unroll
        for (int ai = 0; ai < 2; ++ai)
#pragma unroll
            for (int m = 0; m < 4; ++m) { const int r = ai * HALF + m * 16 + tix;
                if (r < u.rows) { const int dst = dstv[ai][m]; const float w = wv[ai][m]; bf16_t* rowp = y2 + (size_t)dst * D + col0;
#pragma unroll
                    for (int bj = 0; bj < 2; ++bj) { const f32x4 v0 = acc[ai][bj][m][0] * w, v1 = acc[ai][bj][m][1] * w;
                        u32x4 o; o.x = cvt_pk_bf16(v0[0], v0[1]); o.y = cvt_pk_bf16(v0[2], v0[3]); o.z = cvt_pk_bf16(v1[0], v1[1]); o.w = cvt_pk_bf16(v1[2], v1[3]);
                        *(u32x4*)(rowp + bj * 32) = o; } } }
    }
};
}

struct RowId { int off; __device__ __forceinline__ int operator()(int n) const { return off + n; } };
struct RowGU { int up; __device__ __forceinline__ int operator()(int j) const { return (j >> 2) * 8 + (j & 3) + 4 * up; } };

struct TItem { const float* src; const float* gp; bf16_t* dst; int N, K, rmk; };
__device__ __forceinline__ TItem p0_decode(const Params& p, int it) {
    constexpr int I_IN = (D / 64) * (INW / 32), I_OUT = (D / 64) * (D / 32), I_G = (D / 64) * (DFF / 32), I_D = (DFF / 64) * (D / 32), I_E = 2 * I_G + I_D;
    const float* W; const float* g; bf16_t* WT; int K, N, rmk, idx;
    if (it < I_IN) { W = p.w_in; g = p.norm1_g; WT = (bf16_t*)(p.ws + WS_WIN); K = D; N = INW; rmk = 0; idx = it; }
    else if (it < I_IN + I_OUT) { W = p.w_out; g = nullptr; WT = (bf16_t*)(p.ws + WS_WOUT); K = D; N = D; rmk = 0; idx = it - I_IN; }
    else if (it < I_IN + I_OUT + NE * 2 * I_G) { const int r = it - I_IN - I_OUT, e = r / (2 * I_G), q = r % (2 * I_G);
        if (q < I_G) { W = p.w_e_gate + (size_t)e * D * DFF; g = p.norm2_g; WT = (bf16_t*)(p.ws + WS_WGU) + (size_t)e * D * D; K = D; N = DFF; rmk = 1; idx = q; }
        else { W = p.w_e_up + (size_t)e * D * DFF; g = p.norm2_g; WT = (bf16_t*)(p.ws + WS_WGU) + (size_t)e * D * D; K = D; N = DFF; rmk = 2; idx = q - I_G; } }
    else { const int r = it - I_IN - I_OUT - NE * 2 * I_G, e = r / I_D; idx = r % I_D;
        W = p.w_e_down + (size_t)e * DFF * D; g = nullptr; WT = (bf16_t*)(p.ws + WS_WD) + (size_t)e * D * DFF; K = DFF; N = D; rmk = 0; }
    const int nblk = N / 32, kb = idx / nblk, nb = idx % nblk, k0 = 64 * kb, n0 = 32 * nb;
    TItem t; t.src = W + (size_t)k0 * N + n0; t.dst = WT + k0; t.N = N; t.K = K; t.rmk = rmk;
    t.gp = g ? g + k0 : nullptr;
    if (it >= I_IN && it < I_IN + I_OUT) t.gp = (k0 < 512) ? p.g_rec_out + k0 : p.g_att_out + (k0 - 512);
    t.rmk = rmk | (n0 << 4);
    return t;
}
__device__ __forceinline__ void p0_load(const TItem& t, f32x4 (&ld)[8], float (&gv)[8], int lane) {
#pragma unroll
    for (int i = 0; i < 8; ++i) ld[i] = __builtin_nontemporal_load((const f32x4*)(t.src + (size_t)(8 * i + (lane >> 3)) * t.N + 4 * (lane & 7)));
    if (t.gp) {
#pragma unroll
        for (int i = 0; i < 8; ++i) gv[i] = t.gp[8 * i + (lane >> 3)];
    } else {
#pragma unroll
        for (int i = 0; i < 8; ++i) gv[i] = 1.0f;
    }
}
__device__ __forceinline__ void p0_process(const TItem& t, const f32x4 (&ld)[8], const float (&gv)[8], LAS float* scr, int lane) {
#pragma unroll
    for (int i = 0; i < 8; ++i) { const int kk = 8 * i + (lane >> 3); const f32x4 v = ld[i] * gv[i];
        LAS float* d = scr + kk * 33 + 4 * (lane & 7); d[0] = v[0]; d[1] = v[1]; d[2] = v[2]; d[3] = v[3]; }
    LDS_WAIT(); asm volatile("" ::: "memory");
    const int c = lane & 7, n0 = t.rmk >> 4, rmk = t.rmk & 15;
#pragma unroll
    for (int j = 0; j < 4; ++j) { const int n = (lane >> 3) + 8 * j; const LAS float* s = scr + (8 * c) * 33 + n;
        u32x4 o; o.x = cvt_pk_bf16(s[0 * 33], s[1 * 33]); o.y = cvt_pk_bf16(s[2 * 33], s[3 * 33]); o.z = cvt_pk_bf16(s[4 * 33], s[5 * 33]); o.w = cvt_pk_bf16(s[6 * 33], s[7 * 33]);
        const int nn = n0 + n, row = (rmk == 0) ? nn : ((nn >> 2) * 8 + (nn & 3) + 4 * (rmk - 1));
        if (t.K != D || rmk != 0) __builtin_nontemporal_store(o, (u32x4*)(t.dst + (size_t)row * t.K + 8 * c)); else *(u32x4*)(t.dst + (size_t)row * t.K + 8 * c) = o; }
    LDS_WAIT(); asm volatile("" ::: "memory");
}

__device__ __forceinline__ void p0_convert_range(const Params& p, LAS float* scr, int it0, int it1, int gw, int ngw, int lane) {
    int it = it0 + gw; TItem t0, t1, t2; f32x4 a0[8], a1[8], a2[8]; float g0[8], g1[8], g2[8];
    if (it < it1) { t0 = p0_decode(p, it); p0_load(t0, a0, g0, lane); }
    t1 = t0;
    if (it + ngw < it1) { t1 = p0_decode(p, it + ngw); p0_load(t1, a1, g1, lane); }
    while (it < it1) {
        const bool has2 = it + 2 * ngw < it1;
        t2 = t1;
        if (has2) { t2 = p0_decode(p, it + 2 * ngw); p0_load(t2, a2, g2, lane); }
        p0_process(t0, a0, g0, scr, lane);
        t0 = t1; t1 = t2;
#pragma unroll
        for (int i = 0; i < 8; ++i) { a0[i] = a1[i]; g0[i] = g1[i]; a1[i] = a2[i]; g1[i] = g2[i]; }
        it += ngw;
    }
}

__device__ __forceinline__ void ph_prologue(const Params& p, LAS unsigned char* lds, int vcu, int G, int e_split) {
    const int tid = opaque_tid(), lane = tid & 63, wave = tid >> 6;
    LAS float* scr = (LAS float*)(lds + wave * 16384);
    const int gw = vcu * NWAVES + wave, NGW = G * NWAVES;
    bf16_t* xb = (bf16_t*)(p.ws + WS_XB);
    constexpr int I_IN = (D / 64) * (INW / 32), I_OUT = (D / 64) * (D / 32), I_G = (D / 64) * (DFF / 32), I_D = (DFF / 64) * (D / 32), I_E = 2 * I_G + I_D, I_ALL = I_IN + I_OUT + NE * I_E;
    p0_convert_range(p, scr, 0, I_IN + I_OUT + (e_split < NE ? 0 : NE) * 2 * I_G, gw, NGW, lane);
    {
        u32x4* gz = (u32x4*)(p.ws + WS_CTL);
        for (int idx = gw * 64 + lane; idx < (int)(CTL_ALL_BYTES / 16); idx += NGW * 64) if (idx < (int)(CTL_PRE_OFF / 16) || idx >= (int)((CTL_PRE_OFF + CTL_PRE_BYTES) / 16)) gz[idx] = (u32x4){0u, 0u, 0u, 0u};
    }
    {
        bf16_t* gwt = (bf16_t*)(p.ws + WS_GWT); float* sp8 = (float*)(p.ws + WS_GWT + 8 * 128 * 144);
        for (int idx = gw * 64 + lane; idx < 8 * 64 * 128; idx += NGW * 64) { const int hb = idx >> 13, k = (idx >> 7) & 63, n = idx & 127;
            const float v = (n < 64) ? p.w_rg_a[(hb * 64 + k) * 64 + n] : p.w_rg_x[(hb * 64 + k) * 64 + n - 64];
            gwt[(hb * 128 + n) * 72 + k] = (bf16_t)f2bf(v * -1.4426950408889634f); }
        for (int idx = gw * 64 + lane; idx < RW; idx += NGW * 64) sp8[idx] = -8.0f * 1.4426950408889634f * log1pf(expf(-p.lru_lambda[idx]));
    }
    {
        float* rwt = (float*)(p.ws + WS_RWT);
        for (int idx = gw * 64 + lane; idx < D * 20; idx += NGW * 64) { const int k = idx / 20, n = idx % 20;
            rwt[n * 1028 + k] = (n < 16 ? p.w_router[k * 16 + n] : p.w_group[k * 4 + n - 16]) * p.norm2_g[k]; }
    }
    float* rinv1 = (float*)(p.ws + WS_GWT + 256 * 1024);
    for (int t0 = gw; t0 < T; t0 += 4 * NGW) {
        f32x4 v[4][4];
#pragma unroll
        for (int q = 0; q < 4; ++q) { const int t = t0 + q * NGW; const f32x4* xr = (const f32x4*)(p.x + (size_t)(t < T ? t : t0) * D) + lane;
#pragma unroll
            for (int j = 0; j < 4; ++j) v[q][j] = __builtin_nontemporal_load(xr + 64 * j); }
#pragma unroll
        for (int q = 0; q < 4; ++q) { const int t = t0 + q * NGW; float ss = 0.f;
#pragma unroll
            for (int j = 0; j < 4; ++j) ss += (v[q][j][0] * v[q][j][0] + v[q][j][1] * v[q][j][1]) + (v[q][j][2] * v[q][j][2] + v[q][j][3] * v[q][j][3]);
            const float ms = wave_sum(ss) * (1.0f / D) + EPS; const float r = rsqrtf(ms);
            if (t < T) { u32x2* o8 = (u32x2*)(xb + (size_t)t * D) + lane; if (lane == 0) rinv1[t] = __builtin_amdgcn_sqrtf(ms);
#pragma unroll
                for (int j = 0; j < 4; ++j) o8[64 * j] = (u32x2){cvt_pk_bf16(v[q][j][0] * r, v[q][j][1] * r), cvt_pk_bf16(v[q][j][2] * r, v[q][j][3] * r)}; }
        }
    }
}

__device__ __forceinline__ void p1_tail_convert(const Params& p, LAS unsigned char* lds, int idle_idx, int n_idle, int e_split) {
    const int tid = opaque_tid(), lane = tid & 63, wave = tid >> 6;
    constexpr int I_IN = (D / 64) * (INW / 32), I_OUT = (D / 64) * (D / 32), I_G = (D / 64) * (DFF / 32), I_D = (DFF / 64) * (D / 32), I_E = 2 * I_G + I_D, I_ALL = I_IN + I_OUT + NE * I_E;
    p0_convert_range(p, (LAS float*)(lds + wave * 16384), I_IN + I_OUT + e_split * 2 * I_G, I_IN + I_OUT + NE * 2 * I_G, idle_idx * NWAVES + wave, n_idle * NWAVES, lane);
}

typedef float f32x16 __attribute__((ext_vector_type(16)));
typedef short v4i16_t __attribute__((ext_vector_type(4)));
typedef __bf16 bf16x2_t __attribute__((ext_vector_type(2)));
#define MFMA32(a, b, c) __builtin_amdgcn_mfma_f32_32x32x16_bf16((a), (b), (c), 0, 0, 0)
__device__ __forceinline__ unsigned cvtpk_s(float lo, float hi) { f32x2 v = {lo, hi}; bf16x2_t b = __builtin_convertvector(v, bf16x2_t); return __builtin_bit_cast(unsigned, b); }
__device__ __forceinline__ int crow(int r, int hh) { return (r & 3) + 8 * (r >> 2) + 4 * hh; }
__device__ __forceinline__ bf16x8 pack8(const f32x16& x, int s) {
    u32x4 w; w.x = cvtpk_s(x[8 * s + 0], x[8 * s + 1]); w.y = cvtpk_s(x[8 * s + 2], x[8 * s + 3]); w.z = cvtpk_s(x[8 * s + 4], x[8 * s + 5]); w.w = cvtpk_s(x[8 * s + 6], x[8 * s + 7]);
    return __builtin_bit_cast(bf16x8, w);
}
__device__ __forceinline__ v4i16_t vtr(LAS const unsigned char* p) { return __builtin_amdgcn_ds_read_tr16_b64_v4i16((LAS v4i16_t*)p); }
constexpr float LOG2E = 1.4426950408889634f;

struct AttnCtx { LAS float* btab; LAS unsigned char* vbase; int lane, h, q32, hh, vb, vw; float bconst; unsigned kl, vl; };
__device__ __forceinline__ AttnCtx attn_ctx(LAS unsigned char* lds, int tab_off) {
    AttnCtx A; const int tid = opaque_tid(); A.lane = tid & 63; A.h = __builtin_amdgcn_readfirstlane(tid >> 6); A.q32 = A.lane & 31; A.hh = A.lane >> 5;
    A.btab = (LAS float*)(lds + tab_off) + A.h * 328;
    A.vbase = lds + A.h * 16384;
    A.vb = ((A.lane >> 4) & 1) * 32 + (A.lane & 3) * 8 + (4 * A.hh + ((A.lane & 15) >> 2)) * 128;
    A.vw = (A.lane >> 3) * 128 + (A.lane & 7) * 16;
    A.bconst = A.btab[2 * MAXREL];
    A.kl = (unsigned)((A.q32 * INW + 8 * A.hh) * 2);
    A.vl = (unsigned)(((A.lane >> 3) * INW + (A.lane & 7) * 8) * 2) + 1024u;
    return A;
}
__device__ __forceinline__ void attn_setup(const Params& p, LAS unsigned char* lds, int tab_off) {
    const int tid = opaque_tid(), lane = tid & 63, h = __builtin_amdgcn_readfirstlane(tid >> 6);
    LAS float* btab = (LAS float*)(lds + tab_off) + h * 328;
    const float bfar = p.rel_bias[h * (2 * MAXREL + 1) + 2 * MAXREL];
    for (int i = lane; i < 2 * MAXREL + 1 + 64; i += 64) btab[i] = (p.rel_bias[h * (2 * MAXREL + 1) + (i > 2 * MAXREL ? 2 * MAXREL : i)] - bfar) * LOG2E;
    LDS_WAIT(); asm volatile("" ::: "memory");
}
#define ATTN_LOAD_TILE(jn) { const char* tb_ = kband + (long)(64 * (jn)) * INW * 2; _Pragma("unroll") \
    for (int i = 0; i < 8; ++i) { kr[i] = *(const u32x4*)((tb_ + i * 8 * INW * 2) + kl8); vr[i] = *(const u32x4*)((tb_ + i * 8 * INW * 2 + 1024) + kl8); } }
#define ATTN_STORE_TILE() { _Pragma("unroll") \
    for (int i = 0; i < 8; ++i) { *(LAS u32x4*)(vbase + i * 1024 + kw) = kr[i]; *(LAS u32x4*)(vbase + 8192 + i * 1024 + vw) = vr[i]; } }

__device__ __forceinline__ void attn_safe(const AttnCtx& A, const char* kband, const bf16x8 (&qf)[4], int j0, int qi, f32x16& o0, f32x16& o1, float& lt) {
    const int lane = A.lane, q32 = A.q32, hh = A.hh, vb = A.vb, vw = A.vw; LAS float* btab = A.btab; LAS unsigned char* vbase = A.vbase;
    const float bconst = A.bconst; const unsigned kl8 = A.vl - 1024u;
#pragma unroll
    for (int r = 0; r < 16; ++r) { o0[r] = 0.f; o1[r] = 0.f; }
    float m_ref = 0.f, l_run = 0.f;
    constexpr float THR = 6.0f;
    u32x4 kr[8], vr[8];
    const int kw = (lane >> 3) * 128 + (((lane & 7) ^ (lane >> 3)) << 4);
    const int kfo = q32 * 128;
    ATTN_LOAD_TILE(j0)
    ATTN_STORE_TILE()
#pragma unroll 1
    for (int j = j0; j <= LEFT; ++j) {
        if (j < LEFT) ATTN_LOAD_TILE(j + 1)
        bf16x8 kf[4];
#pragma unroll
        for (int s = 0; s < 4; ++s) kf[s] = *(const LAS bf16x8*)(vbase + kfo + (((2 * s + hh) ^ (q32 & 7)) << 4));
        f32x16 p0, p1;
        if (j <= 5) {
            const float ci = bconst - m_ref;
#pragma unroll
            for (int r = 0; r < 16; ++r) { p0[r] = ci; p1[r] = ci; }
        } else {
            const LAS float* pb0 = btab + (LEFT * CHUNK + qi - 64 * j + MAXREL - 4 * hh - 27); const LAS float* pb1 = pb0 - 32;
#pragma unroll
            for (int r = 0; r < 16; ++r) { p0[r] = pb0[27 - ((r & 3) + 8 * (r >> 2))] - m_ref; p1[r] = pb1[27 - ((r & 3) + 8 * (r >> 2))] - m_ref; }
        }
#pragma unroll
        for (int s = 0; s < 4; ++s) p0 = MFMA32(kf[s], qf[s], p0);
#pragma unroll
        for (int s = 0; s < 4; ++s) kf[s] = *(const LAS bf16x8*)(vbase + 4096 + kfo + (((2 * s + hh) ^ (q32 & 7)) << 4));
#pragma unroll
        for (int s = 0; s < 4; ++s) p1 = MFMA32(kf[s], qf[s], p1);
        float mt = fmaxf(p0[0], p1[0]);
#pragma unroll
        for (int r = 1; r < 16; ++r) mt = fmaxf(mt, fmaxf(p0[r], p1[r]));
        mt = fmaxf(mt, __shfl_xor(mt, 32));
        const bool first = (j == j0);
        const bool grow = first || (mt > THR);
        if (__any(grow)) {
            const float d = grow ? mt : 0.f, alpha = first ? 1.0f : __builtin_amdgcn_exp2f(-d);
            m_ref += d; l_run *= alpha;
#pragma unroll
            for (int r = 0; r < 16; ++r) { p0[r] -= d; p1[r] -= d; o0[r] *= alpha; o1[r] *= alpha; }
        }
        float ls0 = 0.f, ls1 = 0.f;
#pragma unroll
        for (int r = 0; r < 16; ++r) { p0[r] = __builtin_amdgcn_exp2f(p0[r]); p1[r] = __builtin_amdgcn_exp2f(p1[r]); ls0 += p0[r]; ls1 += p1[r]; }
        l_run += ls0 + ls1;
        const bf16x8 pf0 = pack8(p0, 0), pf1 = pack8(p0, 1), pf2 = pack8(p1, 0), pf3 = pack8(p1, 1);
        LAS const unsigned char* vcur = vbase + 8192 + vb;
#pragma unroll
        for (int db = 0; db < 2; ++db) {
            v4i16_t lo[4], hi[4];
#pragma unroll
            for (int ks = 0; ks < 4; ++ks) { lo[ks] = vtr(vcur + ks * 2048 + db * 64); hi[ks] = vtr(vcur + ks * 2048 + 1024 + db * 64); }
#define VF(k) (bf16x8){lo[k][0], lo[k][1], lo[k][2], lo[k][3], hi[k][0], hi[k][1], hi[k][2], hi[k][3]}
            if (db == 0) { o0 = MFMA32(VF(0), pf0, o0); o0 = MFMA32(VF(1), pf1, o0); o0 = MFMA32(VF(2), pf2, o0); o0 = MFMA32(VF(3), pf3, o0); }
            else         { o1 = MFMA32(VF(0), pf0, o1); o1 = MFMA32(VF(1), pf1, o1); o1 = MFMA32(VF(2), pf2, o1); o1 = MFMA32(VF(3), pf3, o1); }
#undef VF
        }
        if (j < LEFT) ATTN_STORE_TILE()
    }
    lt = l_run + __shfl_xor(l_run, 32);
}

template <bool NEAR>
__device__ __forceinline__ void attn_tile_fast(f32x16& o0, f32x16& o1, f32x2& la, f32x2& lb, const bf16x8 (&qf)[4], LAS unsigned char* vbase, int kfo, int hh, int q32, int vb, const LAS float* pb0) {
    bf16x8 kf[4];
#pragma unroll
    for (int s = 0; s < 4; ++s) kf[s] = *(const LAS bf16x8*)(vbase + kfo + (((2 * s + hh) ^ (q32 & 7)) << 4));
    f32x16 p0, p1;
    if (NEAR) { const LAS float* pb1 = pb0 - 32;
#pragma unroll
        for (int r = 0; r < 16; ++r) { p0[r] = pb0[27 - ((r & 3) + 8 * (r >> 2))]; p1[r] = pb1[27 - ((r & 3) + 8 * (r >> 2))]; }
    } else {
#pragma unroll
        for (int r = 0; r < 16; ++r) { p0[r] = 0.f; p1[r] = 0.f; }
    }
#pragma unroll
    for (int s = 0; s < 4; ++s) p0 = MFMA32(kf[s], qf[s], p0);
#pragma unroll
    for (int s = 0; s < 4; ++s) kf[s] = *(const LAS bf16x8*)(vbase + 4096 + kfo + (((2 * s + hh) ^ (q32 & 7)) << 4));
#pragma unroll
    for (int s = 0; s < 4; ++s) p1 = MFMA32(kf[s], qf[s], p1);
#pragma unroll
    for (int r = 0; r < 16; ++r) { p0[r] = __builtin_amdgcn_exp2f(p0[r]); p1[r] = __builtin_amdgcn_exp2f(p1[r]); }
#pragma unroll
    for (int r = 0; r < 8; ++r) { la += (f32x2){p0[2 * r], p0[2 * r + 1]}; lb += (f32x2){p1[2 * r], p1[2 * r + 1]}; }
    const bf16x8 pf0 = pack8(p0, 0), pf1 = pack8(p0, 1), pf2 = pack8(p1, 0), pf3 = pack8(p1, 1);
    LAS const unsigned char* vcur = vbase + 8192 + vb;
#pragma unroll
    for (int db = 0; db < 2; ++db) {
        v4i16_t lo[4], hi[4];
#pragma unroll
        for (int ks = 0; ks < 4; ++ks) { lo[ks] = vtr(vcur + ks * 2048 + db * 64); hi[ks] = vtr(vcur + ks * 2048 + 1024 + db * 64); }
#define VF(k) (bf16x8){lo[k][0], lo[k][1], lo[k][2], lo[k][3], hi[k][0], hi[k][1], hi[k][2], hi[k][3]}
        if (db == 0) { o0 = MFMA32(VF(0), pf0, o0); o0 = MFMA32(VF(1), pf1, o0); o0 = MFMA32(VF(2), pf2, o0); o0 = MFMA32(VF(3), pf3, o0); }
        else         { o1 = MFMA32(VF(0), pf0, o1); o1 = MFMA32(VF(1), pf1, o1); o1 = MFMA32(VF(2), pf2, o1); o1 = MFMA32(VF(3), pf3, o1); }
#undef VF
    }
}
__device__ __forceinline__ void attn_q_convert(const u32x4 (&qraw)[4], bf16x8 (&qf)[4]) {
    const float QS = 0.125f * LOG2E;
#pragma unroll
    for (int s = 0; s < 4; ++s) { u32x4 w;
#pragma unroll
        for (int e = 0; e < 4; ++e) w[e] = cvtpk_s(__builtin_bit_cast(float, qraw[s][e] << 16) * QS, __builtin_bit_cast(float, qraw[s][e] & 0xffff0000u) * QS);
        qf[s] = __builtin_bit_cast(bf16x8, w); }
}
__device__ __forceinline__ void attn_fast(const AttnCtx& A, const char* kband, u32x4 (&qraw)[4], int j0, int qi, f32x16& o0, f32x16& o1, float& lt) {
    const int lane = A.lane, q32 = A.q32, hh = A.hh, vb = A.vb, vw = A.vw; LAS float* btab = A.btab; LAS unsigned char* vbase = A.vbase;
    const unsigned kl8 = A.vl - 1024u;
#pragma unroll
    for (int r = 0; r < 16; ++r) { o0[r] = 0.f; o1[r] = 0.f; }
    f32x2 la = {0.f, 0.f}, lb = {0.f, 0.f};
    u32x4 kr[8], vr[8];
    const int kw = (lane >> 3) * 128 + (((lane & 7) ^ (lane >> 3)) << 4);
    const int kfo = q32 * 128;
    ATTN_LOAD_TILE(j0)
    asm volatile("" : "+v"(qraw[0]), "+v"(qraw[1]), "+v"(qraw[2]), "+v"(qraw[3]) :: "memory");
    bf16x8 qf[4]; attn_q_convert(qraw, qf);
    ATTN_STORE_TILE()
    int j = j0;
#pragma unroll 1
    for (; j <= 5; ++j) {
        ATTN_LOAD_TILE(j + 1)
        attn_tile_fast<false>(o0, o1, la, lb, qf, vbase, kfo, hh, q32, vb, nullptr);
        ATTN_STORE_TILE()
    }
#pragma unroll 1
    for (; j <= LEFT; ++j) {
        if (j < LEFT) ATTN_LOAD_TILE(j + 1)
        attn_tile_fast<true>(o0, o1, la, lb, qf, vbase, kfo, hh, q32, vb, btab + (LEFT * CHUNK + qi - 64 * j + MAXREL - 4 * hh - 27));
        if (j < LEFT) ATTN_STORE_TILE()
    }
    const float l_run = (la.x + la.y) + (lb.x + lb.y);
    lt = l_run + __shfl_xor(l_run, 32);
}

template <bool FAST>
__device__ __forceinline__ bool attn_item(LAS unsigned char* lds, const bf16_t* z, bf16_t* mixb, float* ssq, int b, int c, int qh) {
    const AttnCtx A = attn_ctx(lds, TAB_OFF);
    const int h = A.h, q32 = A.q32, hh = A.hh;
    const float QS = 0.125f * LOG2E;
    const int j0 = (c >= LEFT) ? 0 : LEFT - c;
    const char* kband = (const char*)z + (((long)b * S + (long)(c - LEFT) * CHUNK) * INW + 1536 + h * 64) * 2;
    const int qi = qh * 32 + q32;
    const size_t tq = (size_t)b * S + c * CHUNK + qi;
    u32x4 qraw[4];
#pragma unroll
    for (int s = 0; s < 4; ++s) qraw[s] = *(const u32x4*)(z + tq * INW + 1024 + h * 64 + 16 * s + 8 * hh);
    f32x16 o0, o1; float lt;
    if (FAST) { attn_fast(A, kband, qraw, j0, qi, o0, o1, lt); if (__any(!(lt >= 0x1p-60f && lt <= 0x1p60f))) return true; }
    else { bf16x8 qf[4]; attn_q_convert(qraw, qf); attn_safe(A, kband, qf, j0, qi, o0, o1, lt); }
    const float inv = 1.0f / lt;
    float ss = 0.f;
    bf16_t* orow = mixb + tq * D + 512 + h * 64 + 8 * hh;
    u32x2 pa[4], pc[4];
#pragma unroll
    for (int g = 0; g < 4; ++g) {
        const float a0 = o0[4 * g] * inv, a1 = o0[4 * g + 1] * inv, a2 = o0[4 * g + 2] * inv, a3 = o0[4 * g + 3] * inv;
        const float c0 = o1[4 * g] * inv, c1 = o1[4 * g + 1] * inv, c2 = o1[4 * g + 2] * inv, c3 = o1[4 * g + 3] * inv;
        ss += (a0 * a0 + a1 * a1) + (a2 * a2 + a3 * a3) + (c0 * c0 + c1 * c1) + (c2 * c2 + c3 * c3);
        pa[g] = (u32x2){cvtpk_s(a0, a1), cvtpk_s(a2, a3)}; pc[g] = (u32x2){cvtpk_s(c0, c1), cvtpk_s(c2, c3)};
    }
#pragma unroll
    for (int g = 0; g < 4; g += 2) {
        { const auto rx = __builtin_amdgcn_permlane32_swap(pa[g].x, pa[g + 1].x, false, false), ry = __builtin_amdgcn_permlane32_swap(pa[g].y, pa[g + 1].y, false, false);
          *(u32x4*)(orow + 8 * g) = (u32x4){rx[0], ry[0], rx[1], ry[1]}; }
        { const auto rx = __builtin_amdgcn_permlane32_swap(pc[g].x, pc[g + 1].x, false, false), ry = __builtin_amdgcn_permlane32_swap(pc[g].y, pc[g + 1].y, false, false);
          *(u32x4*)(orow + 32 + 8 * g) = (u32x4){rx[0], ry[0], rx[1], ry[1]}; }
    }
    ss += __shfl_xor(ss, 32);
    if (hh == 0) ssq[tq * SSQW + 32 + h] = ss;
    return false;
}

constexpr int RG_WT = 0, RG_IMG = 18432, RG_SEG = 35840, RG_PRE = 44032, RG_CAR = 52224, RG_ROWB = 144, RG_IROW = 272;
constexpr int RG_U = 57344, RG_G = 90624, RG_GROW = 136;
__device__ __forceinline__ float sigmoid_neg2(float y) { return __builtin_amdgcn_rcpf(1.0f + __builtin_amdgcn_exp2f(y)); }
__device__ __forceinline__ void rglru_item(const Params& p, const bf16_t* z, bf16_t* mixb, float* ssq, LAS unsigned char* lds, unsigned long long* gran, int b, int hb, int kc) {
    const int tid = opaque_tid(), lane = tid & 63, w = __builtin_amdgcn_readfirstlane(tid >> 6), ch = lane, c16 = lane & 15, tg = lane >> 4;
    LAS f32x2* seg = (LAS f32x2*)(lds + RG_SEG); LAS f32x2* pre = (LAS f32x2*)(lds + RG_PRE); LAS float* car = (LAS float*)(lds + RG_CAR);
    u32x4 wt0, wt1, wt2;
    {
        const u32x4* srcw = (const u32x4*)(p.ws + WS_GWT + (size_t)hb * 128 * 144);
        static_assert(128 * 144 / 16 == 2 * NTHR + 128, "gate weight image size");
        wt0 = srcw[tid]; wt1 = srcw[tid + NTHR]; wt2 = srcw[2 * NTHR + (tid & 127)];
    }
    const int gch = hb * 64 + ch;
    const float cw0 = p.conv_w[gch], cw1 = p.conv_w[RW + gch], cw2 = p.conv_w[2 * RW + gch], cw3 = p.conv_w[3 * RW + gch], cb = p.conv_b[gch];
    const float* sp8t = (const float*)(p.ws + WS_GWT + 8 * 128 * 144);
    float ba[4], bxb[4], sp8[4];
#pragma unroll
    for (int nb = 0; nb < 4; ++nb) { const int c = hb * 64 + 16 * nb + c16; ba[nb] = p.b_rg_a[c] * -1.4426950408889634f; bxb[nb] = p.b_rg_x[c] * -1.4426950408889634f; sp8[nb] = sp8t[c]; }
    LAS unsigned char* img = lds + RG_IMG;
    LAS unsigned char* trb = img + (8 * tg + (c16 >> 2)) * RG_IROW + (16 * w + 4 * (c16 & 3)) * 2;
    const int s0 = kc * 256;
    float av[2][4][4], bv[2][4][4], cP[2][4], cH[2][4];
    {
        const int r0 = tid >> 3, ck = tid & 7;
        const bf16_t* ub = z + ((size_t)b * S + s0) * INW + hb * 64 + ck * 8;
        u32x4 ur[5], gr[4];
#pragma unroll
        for (int k = 0; k < 4; ++k) { const int st = r0 + 64 * k - 3; ur[k] = __builtin_nontemporal_load((const u32x4*)(ub + (long)(s0 + st >= 0 ? st : 0) * INW)); }
        ur[4] = __builtin_nontemporal_load((const u32x4*)(ub + (long)(253 + (r0 < 3 ? r0 : 0)) * INW));
#pragma unroll
        for (int k = 0; k < 4; ++k) gr[k] = __builtin_nontemporal_load((const u32x4*)(ub + (long)(r0 + 64 * k) * INW + 512));
        asm volatile("" : "+v"(wt0), "+v"(wt1), "+v"(wt2), "+v"(ur[0]), "+v"(ur[1]), "+v"(ur[2]), "+v"(ur[3]), "+v"(ur[4]), "+v"(gr[0]), "+v"(gr[1]), "+v"(gr[2]), "+v"(gr[3]));
        if (s0 + r0 - 3 < 0) ur[0] = (u32x4){0u, 0u, 0u, 0u};
        { LAS u32x4* dstw = (LAS u32x4*)(lds + RG_WT); dstw[tid] = wt0; dstw[tid + NTHR] = wt1; if (tid < 128) dstw[2 * NTHR + tid] = wt2; }
#pragma unroll
        for (int k = 0; k < 4; ++k) *(LAS u32x4*)(lds + RG_U + (r0 + 64 * k) * 128 + ck * 16) = ur[k];
        if (r0 < 3) *(LAS u32x4*)(lds + RG_U + (256 + r0) * 128 + ck * 16) = ur[4];
#pragma unroll
        for (int k = 0; k < 4; ++k) { LAS u32x2* gd = (LAS u32x2*)(lds + RG_G + (r0 + 64 * k) * RG_GROW + ck * 16); gd[0] = (u32x2){gr[k].x, gr[k].y}; gd[1] = (u32x2){gr[k].z, gr[k].w}; }
    }
    __syncthreads();
#pragma unroll
    for (int blk = 0; blk < 2; ++blk) {
        const int t0 = blk * 128 + 16 * w;
        float uv[19];
#pragma unroll
        for (int i = 0; i < 19; ++i) uv[i] = bf2f(*(const LAS bf16_t*)(lds + RG_U + (t0 + i) * 128 + ch * 2));
        {
            float uc[16];
#pragma unroll
            for (int i = 0; i < 16; ++i) uc[i] = cb + cw0 * uv[i] + cw1 * uv[i + 1] + cw2 * uv[i + 2] + cw3 * uv[i + 3];
            u32x4 w0, w1;
#pragma unroll
            for (int e = 0; e < 4; ++e) { w0[e] = cvtpk_s(uc[2 * e], uc[2 * e + 1]); w1[e] = cvtpk_s(uc[8 + 2 * e], uc[9 + 2 * e]); }
            *(LAS u32x4*)(img + ch * RG_IROW + 32 * w) = w0; *(LAS u32x4*)(img + ch * RG_IROW + 32 * w + 16) = w1;
        }
        LDS_WAIT(); asm volatile("" ::: "memory");
        const v4i16_t t0lo = vtr(trb), t0hi = vtr(trb + 4 * RG_IROW), t1lo = vtr(trb + 32 * RG_IROW), t1hi = vtr(trb + 36 * RG_IROW);
        const bf16x8 a0 = (bf16x8){t0lo[0], t0lo[1], t0lo[2], t0lo[3], t0hi[0], t0hi[1], t0hi[2], t0hi[3]}, a1 = (bf16x8){t1lo[0], t1lo[1], t1lo[2], t1lo[3], t1hi[0], t1hi[1], t1hi[2], t1hi[3]};
#pragma unroll
        for (int nb = 0; nb < 4; ++nb) {
            const bf16x8 b0a = *(const LAS bf16x8*)(lds + RG_WT + (16 * nb + c16) * RG_ROWB + tg * 16), b1a = *(const LAS bf16x8*)(lds + RG_WT + (16 * nb + c16) * RG_ROWB + tg * 16 + 64);
            const bf16x8 b0x = *(const LAS bf16x8*)(lds + RG_WT + (64 + 16 * nb + c16) * RG_ROWB + tg * 16), b1x = *(const LAS bf16x8*)(lds + RG_WT + (64 + 16 * nb + c16) * RG_ROWB + tg * 16 + 64);
            f32x4 acca = __builtin_amdgcn_mfma_f32_16x16x32_bf16(a0, b0a, (f32x4){0.f, 0.f, 0.f, 0.f}, 0, 0, 0); acca = __builtin_amdgcn_mfma_f32_16x16x32_bf16(a1, b1a, acca, 0, 0, 0);
            f32x4 accx = __builtin_amdgcn_mfma_f32_16x16x32_bf16(a0, b0x, (f32x4){0.f, 0.f, 0.f, 0.f}, 0, 0, 0); accx = __builtin_amdgcn_mfma_f32_16x16x32_bf16(a1, b1x, accx, 0, 0, 0);
            const u32x2 ucr = *(const LAS u32x2*)(img + (16 * nb + c16) * RG_IROW + (16 * w + 4 * tg) * 2);
            const float ucv[4] = {__builtin_bit_cast(float, ucr[0] << 16), __builtin_bit_cast(float, ucr[0] & 0xffff0000u), __builtin_bit_cast(float, ucr[1] << 16), __builtin_bit_cast(float, ucr[1] & 0xffff0000u)};
            float H = 0.f, P = 1.f;
#pragma unroll
            for (int rg_ = 0; rg_ < 4; ++rg_) {
                const float r = sigmoid_neg2(acca[rg_] + ba[nb]), ig = sigmoid_neg2(accx[rg_] + bxb[nb]);
                const float a = __builtin_amdgcn_exp2f(r * sp8[nb]);
                av[blk][nb][rg_] = a; bv[blk][nb][rg_] = __builtin_amdgcn_sqrtf((1.0f - a) * (1.0f + a)) * (ig * ucv[rg_]);
                H = a * H + bv[blk][nb][rg_]; P *= a; }
            float cp = 1.f, chh = 0.f, Pt = 1.f, Ht = 0.f;
#pragma unroll
            for (int k = 0; k < 4; ++k) { const float Pk = __shfl(P, c16 + 16 * k), Hk = __shfl(H, c16 + 16 * k);
                cp = (k == tg) ? Pt : cp; chh = (k == tg) ? Ht : chh;
                Ht = Pk * Ht + Hk; Pt *= Pk; }
            cP[blk][nb] = cp; cH[blk][nb] = chh;
            if (tg == 0) seg[(blk * 8 + w) * 64 + 16 * nb + c16] = (f32x2){Pt, Ht};
        }
        LDS_WAIT(); asm volatile("" ::: "memory");
    }
    __syncthreads();
    unsigned long long vp[7], vh[7];
    const unsigned long long* g0 = gran + ((size_t)((b * 8 + hb) * 8) * 2) * 64 + (tid & 63);
    if (tid < 64) {
        float Pp = 1.f, Hp = 0.f;
#pragma unroll
        for (int s = 0; s < 16; ++s) { pre[s * 64 + tid] = (f32x2){Pp, Hp}; const f32x2 sv = seg[s * 64 + tid]; Hp = sv.x * Hp + sv.y; Pp *= sv.x; }
        unsigned long long* g = gran + ((size_t)((b * 8 + hb) * 8 + kc) * 2) * 64 + tid;
        __hip_atomic_store(g, (1ull << 32) | __builtin_bit_cast(unsigned, Pp), __ATOMIC_RELAXED, __HIP_MEMORY_SCOPE_AGENT);
        __hip_atomic_store(g + 64, (1ull << 32) | __builtin_bit_cast(unsigned, Hp), __ATOMIC_RELAXED, __HIP_MEMORY_SCOPE_AGENT);
#pragma unroll
        for (int j = 0; j < 7; ++j) if (j < kc) { vp[j] = __hip_atomic_load(g0 + j * 128, __ATOMIC_RELAXED, __HIP_MEMORY_SCOPE_AGENT); vh[j] = __hip_atomic_load(g0 + j * 128 + 64, __ATOMIC_RELAXED, __HIP_MEMORY_SCOPE_AGENT); }
    }
    float gg[2][4][4];
#pragma unroll
    for (int blk = 0; blk < 2; ++blk)
#pragma unroll
        for (int nb = 0; nb < 4; ++nb)
#pragma unroll
            for (int i = 0; i < 4; ++i) { const float g = bf2f(*(const LAS bf16_t*)(lds + RG_G + (blk * 128 + 16 * w + 4 * tg + i) * RG_GROW + (16 * nb + c16) * 2)), u2 = (-1.5957691216057308f * 1.4426950408889634f) * (g + 0.044715f * g * g * g); gg[blk][nb][i] = g * sigmoid_neg2(u2); }
    if (tid < 64) {
        unsigned spins = 0;
        for (;;) {
            bool ok = true;
#pragma unroll
            for (int j = 0; j < 7; ++j) if (j < kc) ok = ok && ((vp[j] >> 32) != 0ull) && ((vh[j] >> 32) != 0ull);
            if (__all(ok) || ++spins > (1u << 20)) break;
            __builtin_amdgcn_s_sleep(2);
#pragma unroll
            for (int j = 0; j < 7; ++j) if (j < kc) { vp[j] = __hip_atomic_load(g0 + j * 128, __ATOMIC_RELAXED, __HIP_MEMORY_SCOPE_AGENT); vh[j] = __hip_atomic_load(g0 + j * 128 + 64, __ATOMIC_RELAXED, __HIP_MEMORY_SCOPE_AGENT); }
        }
        float h = 0.f;
#pragma unroll
        for (int j = 0; j < 7; ++j) if (j < kc) h = __builtin_bit_cast(float, (unsigned)vp[j]) * h + __builtin_bit_cast(float, (unsigned)vh[j]);
        car[tid] = h;
    }
    __syncthreads();
#pragma unroll
    for (int blk = 0; blk < 2; ++blk) {
        const int t0 = blk * 128 + 16 * w;
        float ysum[4] = {0.f, 0.f, 0.f, 0.f};
#pragma unroll
        for (int nb = 0; nb < 4; ++nb) {
            const int oc = 16 * nb + c16; const f32x2 pf = pre[(blk * 8 + w) * 64 + oc];
            float hcur = cP[blk][nb] * (pf.x * car[oc] + pf.y) + cH[blk][nb];
            LAS bf16_t* orow = (LAS bf16_t*)(lds + RG_U + (t0 + 4 * tg) * RG_GROW) + oc;
#pragma unroll
            for (int i = 0; i < 4; ++i) { hcur = av[blk][nb][i] * hcur + bv[blk][nb][i];
                const float y = hcur * gg[blk][nb][i];
                orow[i * (RG_GROW / 2)] = (bf16_t)(cvtpk_s(y, y) & 0xffffu); ysum[i] += y * y; }
        }
#pragma unroll
        for (int i = 0; i < 4; ++i) ysum[i] += __shfl_xor(ysum[i], 1);
#pragma unroll
        for (int i = 0; i < 4; ++i) ysum[i] += __shfl_xor(ysum[i], 2);
#pragma unroll
        for (int i = 0; i < 4; ++i) ysum[i] += __shfl_xor(ysum[i], 4);
#pragma unroll
        for (int i = 0; i < 4; ++i) ysum[i] += __shfl_xor(ysum[i], 8);
        if (c16 == 0) { float* sq = ssq + ((size_t)b * S + s0 + t0 + 4 * tg) * SSQW + hb * 4;
#pragma unroll
            for (int i = 0; i < 4; ++i) *(f32x4*)(sq + (size_t)i * SSQW) = (f32x4){ysum[i], 0.f, 0.f, 0.f}; }
    }
    __syncthreads();
    {
        const int r0 = tid >> 3, ck = tid & 7;
        bf16_t* ob = mixb + ((size_t)b * S + s0) * D + hb * 64 + ck * 8;
#pragma unroll
        for (int k = 0; k < 4; ++k) { const LAS u32x2* sp = (const LAS u32x2*)(lds + RG_U + (r0 + 64 * k) * RG_GROW + ck * 16); const u32x2 lo = sp[0], hi = sp[1];
            *(u32x4*)(ob + (size_t)(r0 + 64 * k) * D) = (u32x4){lo.x, lo.y, hi.x, hi.y}; }
    }
}

constexpr int RT_SUM = 0, RT_REC = 49152;
template <bool red>
__device__ __forceinline__ void ph_router3(const Params& p, const float* part, int* gcount, int* tok_list, float* w_list, float* r_list, LAS unsigned char* lds, bool xl) {
    const int tid = opaque_tid();
    LAS float* sum = (LAS float*)(lds + RT_SUM);
    LAS int* lcnt = (LAS int*)(lds + RT_REC); LAS int* lbase = lcnt + 16; LAS int* rec_e = lcnt + 32; LAS int* rec_s = lcnt + 160; LAS float* rec_w = (LAS float*)(lcnt + 288); LAS float* rec_r = (LAS float*)(lcnt + 416);
    const int g_lo = xl ? (int)(blockIdx.x & 7) * (S / 64) + (int)(blockIdx.x >> 3) : (int)blockIdx.x, g_hi = xl ? (int)((blockIdx.x & 7) + 1) * (S / 64) : T / 64, g_st = xl ? (int)(gridDim.x >> 3) : (int)gridDim.x;
    const f32x4 bgrp = *(const f32x4*)p.b_group, brt0 = *(const f32x4*)p.b_router, brt1 = *((const f32x4*)p.b_router + 1), brt2 = *((const f32x4*)p.b_router + 2), brt3 = *((const f32x4*)p.b_router + 3);
    for (int grp = g_lo; grp < g_hi; grp += g_st) {
        if (tid < 16) lcnt[tid] = 0;
        if (red) {
            const int tok = tid & 63, pr = tid >> 6;
            f32x4 v[6];
            if (pr < 4) { const f32x4* a = (const f32x4*)(part + ((size_t)(grp * 64 + tok) * 4 + pr) * 24);
#pragma unroll
                for (int i = 0; i < 6; ++i) v[i] = a[i]; }
            else {
#pragma unroll
                for (int i = 0; i < 6; ++i) v[i] = (f32x4){0.f, 0.f, 0.f, 0.f}; }
#pragma unroll
            for (int i = 0; i < 6; ++i) *(LAS f32x4*)(sum + (pr * 64 + tok) * 24 + 4 * i) = v[i];
        } else {
            const int tok = tid & 63, pr = tid >> 6;
            const f32x4* a = (const f32x4*)(part + ((size_t)(grp * 64 + tok) * 16 + 2 * pr) * 24);
            f32x4 v[12];
#pragma unroll
            for (int i = 0; i < 12; ++i) v[i] = a[i];
#pragma unroll
            for (int i = 0; i < 6; ++i) *(LAS f32x4*)(sum + (pr * 64 + tok) * 24 + 4 * i) = v[i] + v[6 + i];
        }
        __syncthreads();
        if (tid < 64) {
            float q[24];
#pragma unroll
            for (int i = 0; i < 6; ++i) { f32x4 s4 = *(const LAS f32x4*)(sum + tid * 24 + 4 * i);
#pragma unroll
                for (int pr = 1; pr < 8; ++pr) s4 = s4 + *(const LAS f32x4*)(sum + (pr * 64 + tid) * 24 + 4 * i);
                q[4 * i] = s4[0]; q[4 * i + 1] = s4[1]; q[4 * i + 2] = s4[2]; q[4 * i + 3] = s4[3]; }
            const float rstd = rsqrtf(q[20] * (1.0f / D) + EPS);
            float lg[4];
#pragma unroll
            for (int i = 0; i < 4; ++i) lg[i] = q[16 + i] * rstd + bgrp[i];
            int gi = 0; float best = lg[0];
#pragma unroll
            for (int i = 1; i < 4; ++i) if (lg[i] > best) { best = lg[i]; gi = i; }
            float den = 0.f;
#pragma unroll
            for (int i = 0; i < 4; ++i) den += expf(lg[i] - best);
            const float pg = 1.0f / den;
            float sel[4];
#pragma unroll
            for (int i = 0; i < 4; ++i) { const float s0 = q[i], s1 = q[4 + i], s2 = q[8 + i], s3 = q[12 + i]; sel[i] = ((gi == 0) ? s0 : (gi == 1) ? s1 : (gi == 2) ? s2 : s3) * rstd + ((gi == 0) ? brt0[i] : (gi == 1) ? brt1[i] : (gi == 2) ? brt2[i] : brt3[i]); }
            int i1 = 0; float v1 = sel[0];
#pragma unroll
            for (int i = 1; i < 4; ++i) if (sel[i] > v1) { v1 = sel[i]; i1 = i; }
            int i2 = -1; float v2 = -3.0e38f;
#pragma unroll
            for (int i = 0; i < 4; ++i) if (i != i1 && sel[i] > v2) { v2 = sel[i]; i2 = i; }
            const float e2 = expf(v2 - v1);
            const float w1 = pg / (1.0f + e2), w2 = pg * e2 / (1.0f + e2);
            const int ea = gi * 4 + i1, eb = gi * 4 + i2;
            const int sa = __hip_atomic_fetch_add(lcnt + ea, 1, __ATOMIC_RELAXED, __HIP_MEMORY_SCOPE_WORKGROUP);
            const int sb = __hip_atomic_fetch_add(lcnt + eb, 1, __ATOMIC_RELAXED, __HIP_MEMORY_SCOPE_WORKGROUP);
            rec_e[tid * 2] = ea; rec_s[tid * 2] = sa; rec_w[tid * 2] = w1; rec_r[tid * 2] = rstd;
            rec_e[tid * 2 + 1] = eb; rec_s[tid * 2 + 1] = sb; rec_w[tid * 2 + 1] = w2; rec_r[tid * 2 + 1] = rstd;
        }
        __syncthreads();
        if (tid < 16) lbase[tid] = __hip_atomic_fetch_add(gcount + 64 * tid, lcnt[tid], __ATOMIC_RELAXED, __HIP_MEMORY_SCOPE_AGENT);
        __syncthreads();
        if (tid < 128) { const int e = rec_e[tid]; const int pos = lbase[e] + rec_s[tid]; tok_list[e * T + pos] = grp * 128 + tid; w_list[e * T + pos] = rec_w[tid]; r_list[e * T + pos] = rec_r[tid]; }
        __syncthreads();
    }
}
__device__ void ph_final(const Params& p, const bf16_t* hb, const bf16_t* y2, float* out) {
    const int tid = opaque_tid(), lane = tid & 63, wv = tid >> 6;
    constexpr int RPT = 4;
    f32x4 gf[4];
#pragma unroll
    for (int j = 0; j < 4; ++j) gf[j] = *((const f32x4*)p.final_g + lane + 64 * j);
    const int nwv = gridDim.x * NWAVES;
    for (int t0 = blockIdx.x * NWAVES + wv; t0 < T; t0 += nwv * RPT) {
        u32x2 hv[RPT][4], ya[RPT][4], yb[RPT][4];
#pragma unroll
        for (int q = 0; q < RPT; ++q) { const int t = t0 + q * nwv; const int tt = t < T ? t : t0;
            const u32x2* hr = (const u32x2*)(hb + (size_t)tt * D) + lane;
            const u32x2* y0 = (const u32x2*)(y2 + (size_t)(2 * tt) * D) + lane; const u32x2* y1 = (const u32x2*)(y2 + (size_t)(2 * tt + 1) * D) + lane;
#pragma unroll
            for (int j = 0; j < 4; ++j) { hv[q][j] = __builtin_nontemporal_load(hr + 64 * j); ya[q][j] = __builtin_nontemporal_load(y0 + 64 * j); yb[q][j] = __builtin_nontemporal_load(y1 + 64 * j); } }
#pragma unroll
        for (int q = 0; q < RPT; ++q) { const int t = t0 + q * nwv;
            f32x4 v[4]; float ss = 0.f;
#pragma unroll
            for (int j = 0; j < 4; ++j) { const u32x2 a = ya[q][j], b = yb[q][j], c = hv[q][j];
                v[j][0] = __builtin_bit_cast(float, c[0] << 16) + __builtin_bit_cast(float, a[0] << 16) + __builtin_bit_cast(float, b[0] << 16);
                v[j][1] = __builtin_bit_cast(float, c[0] & 0xffff0000u) + __builtin_bit_cast(float, a[0] & 0xffff0000u) + __builtin_bit_cast(float, b[0] & 0xffff0000u);
                v[j][2] = __builtin_bit_cast(float, c[1] << 16) + __builtin_bit_cast(float, a[1] << 16) + __builtin_bit_cast(float, b[1] << 16);
                v[j][3] = __builtin_bit_cast(float, c[1] & 0xffff0000u) + __builtin_bit_cast(float, a[1] & 0xffff0000u) + __builtin_bit_cast(float, b[1] & 0xffff0000u);
                ss += (v[j][0] * v[j][0] + v[j][1] * v[j][1]) + (v[j][2] * v[j][2] + v[j][3] * v[j][3]); }
            const float r = rsqrtf(wave_sum(ss) * (1.0f / D) + EPS);
            if (t < T) { f32x4* orow = (f32x4*)(out + (size_t)t * D) + lane;
#pragma unroll
                for (int j = 0; j < 4; ++j) __builtin_nontemporal_store(v[j] * r * gf[j], orow + 64 * j); }
        }
    }
}


__device__ __forceinline__ void ph_mixers(const Params& p, const bf16_t* z, bf16_t* mixb, float* ssq, LAS unsigned char* lds, unsigned* qctr) {
    attn_setup(p, lds, TAB_OFF);
    volatile LAS int* qword = (volatile LAS int*)(lds + TAB_OFF + 12288);
    constexpr int NQ = NB, QATT = 64 + 64, NCONV = 48, QITEMS = QATT + NCONV;
    unsigned long long* gran = (unsigned long long*)(p.ws + WS_CTL + 128 * 1024);
    const int qstep = (int)gridDim.x < NQ ? (int)gridDim.x : NQ;
    for (int q = blockIdx.x % NQ; q < NQ; q += qstep) {
        int ticket = 0, idx, dq = 0;
        if (threadIdx.x == 0) ticket = (int)__hip_atomic_fetch_add(qctr + 64 * q, 1u, __ATOMIC_RELAXED, __HIP_MEMORY_SCOPE_AGENT);
        __syncthreads();
        for (;;) {
            if (threadIdx.x == 0) { qword[dq] = ticket; if (ticket < 64) ticket = (int)__hip_atomic_fetch_add(qctr + 64 * q, 1u, __ATOMIC_RELAXED, __HIP_MEMORY_SCOPE_AGENT); }
            __syncthreads();
            idx = qword[dq]; dq ^= 1;
            if (idx >= 64) break;
            rglru_item(p, z, mixb, ssq, lds, gran, q, idx & 7, idx >> 3);
        }
        if (threadIdx.x == 0 && idx < QITEMS) ticket = (int)__hip_atomic_fetch_add(qctr + 64 * q, 1u, __ATOMIC_RELAXED, __HIP_MEMORY_SCOPE_AGENT);
        while (idx < QATT) {
            const int a = idx - 64; if (attn_item<true>(lds, z, mixb, ssq, q, 31 - (a >> 1), a & 1)) attn_item<false>(lds, z, mixb, ssq, q, 31 - (a >> 1), a & 1);
            if (threadIdx.x == 0) { qword[dq] = ticket; if (ticket < QITEMS) ticket = (int)__hip_atomic_fetch_add(qctr + 64 * q, 1u, __ATOMIC_RELAXED, __HIP_MEMORY_SCOPE_AGENT); }
            __syncthreads();
            idx = qword[dq]; dq ^= 1;
        }
        while (idx < QITEMS) {
            constexpr int I_IN = (D / 64) * (INW / 32), I_OUT = (D / 64) * (D / 32), I_G = (D / 64) * (DFF / 32), I_D = (DFF / 64) * (D / 32);
            static_assert(2 * I_D == 32 * 16 && NE == 2 * NQ && 4 * 2 * I_G == NQ * 16 * 16, "conversion items");
            const int ci = idx - QATT, tid = opaque_tid();
            const int it0 = (ci < 32) ? I_IN + I_OUT + NE * 2 * I_G + 2 * q * I_D + 16 * ci : I_IN + I_OUT + q * 256 + 16 * (ci - 32);
            p0_convert_range(p, (LAS float*)(lds + (tid >> 6) * 16384), it0, it0 + 16, tid >> 6, NWAVES, tid & 63);
            if (threadIdx.x == 0) { qword[dq] = ticket; if (ticket < QITEMS) ticket = (int)__hip_atomic_fetch_add(qctr + 64 * q, 1u, __ATOMIC_RELAXED, __HIP_MEMORY_SCOPE_AGENT); }
            __syncthreads();
            idx = qword[dq]; dq ^= 1;
        }
    }
}

#define XB_TMO      128
#define XB_XCNT(j)  (256  + 64 * (j))
#define XB_XSUB(j)  (1280 + 64 * (j))
#define XB_XGEN(j)  (2304 + 64 * (j))
#define XB_TOP      3328
#define XB_TOPGEN   3392
#define XCD_BAR_WORDS 3456
#define XB_SPIN_CAP (1u << 18)
__device__ __forceinline__ unsigned xb_ld(unsigned* p)              { return __hip_atomic_load(p, __ATOMIC_RELAXED, __HIP_MEMORY_SCOPE_AGENT); }
__device__ __forceinline__ unsigned xb_add(unsigned* p, unsigned v) { return __hip_atomic_fetch_add(p, v, __ATOMIC_RELAXED, __HIP_MEMORY_SCOPE_AGENT); }
__device__ __forceinline__ unsigned xb_xcc_id() { return (unsigned)__builtin_amdgcn_s_getreg((3 << 11) | 20) & 0xFu; }
#define XB_SPIN(cond, bar) do { unsigned _sp = 0; while (cond) { __builtin_amdgcn_s_sleep(1); \
    if ((++_sp & 255u) == 0u) { if (xb_ld(&(bar)[XB_TMO])) break; if (_sp > XB_SPIN_CAP) { atomicAdd(&(bar)[XB_TMO], 1u); break; } } } } while (0)
struct XcdBarrier { unsigned* bar; unsigned x; volatile LAS unsigned* st; };
__device__ __forceinline__ XcdBarrier xcd_barrier_post(unsigned* bar, volatile LAS unsigned* st) {
    XcdBarrier b; b.bar = bar; b.x = xb_xcc_id(); b.st = st;
    if (threadIdx.x == 0) (void)xb_add(&bar[XB_XCNT(b.x)], 1u);
    return b;
}
__device__ __forceinline__ void xcd_barrier_complete(unsigned* bar, unsigned x, unsigned& nloc, unsigned& nx) {
    const unsigned G = gridDim.x * gridDim.y * gridDim.z;
    unsigned sum, cnt, mine, sp = 0u;
    for (;;) {
        sum = 0u; cnt = 0u; mine = 0u;
#pragma unroll
        for (unsigned j = 0; j < 16; ++j) { const unsigned c = xb_ld(&bar[XB_XCNT(j)]); sum += c; cnt += (c > 0u) ? 1u : 0u; mine = (j == x) ? c : mine; }
        if (sum == G) break;
        __builtin_amdgcn_s_sleep(1);
        if ((++sp & 255u) == 0u) { if (xb_ld(&bar[XB_TMO])) break; if (sp > XB_SPIN_CAP) { atomicAdd(&bar[XB_TMO], 1u); break; } }
    }
    nloc = mine > 0u ? mine : 1u; nx = cnt > 0u ? cnt : 1u;
}
__device__ __forceinline__ void xcd_barrier(const XcdBarrier& b, bool local = false) {
    asm volatile("s_waitcnt vmcnt(0)" ::: "memory");
    __syncthreads();
    if (threadIdx.x == 0) {
        unsigned* bar = b.bar;
        __builtin_amdgcn_s_waitcnt(0);
        unsigned nloc = b.st[0], nx = b.st[1];
        if (nloc == 0u) { xcd_barrier_complete(bar, b.x, nloc, nx); b.st[0] = nloc; b.st[1] = nx; }
        const unsigned old = xb_add(&bar[XB_XSUB(b.x)], 1u);
        const unsigned gen = old / nloc;
        if (old + 1u == (gen + 1u) * nloc) {
            if (!local) {
            __builtin_amdgcn_fence(__ATOMIC_RELEASE, "agent");
            asm volatile("s_waitcnt vmcnt(0)" ::: "memory");
            const unsigned og = xb_add(&bar[XB_TOP], 1u);
            const unsigned tg = og / nx;
            if (og + 1u == (tg + 1u) * nx) xb_add(&bar[XB_TOPGEN], 1u);
            else XB_SPIN(xb_ld(&bar[XB_TOPGEN]) == tg, bar);
            }
            if (!local) __builtin_amdgcn_fence(__ATOMIC_ACQUIRE, "agent");
            xb_add(&bar[XB_XGEN(b.x)], 1u);
            asm volatile("s_waitcnt vmcnt(0)" ::: "memory");
        } else {
            XB_SPIN(xb_ld(&bar[XB_XGEN(b.x)]) == gen, bar);
            if (!local) __builtin_amdgcn_fence(__ATOMIC_ACQUIRE, "agent");
            asm volatile("s_waitcnt vmcnt(0)" ::: "memory");
        }
    }
    __syncthreads();
}


__device__ __forceinline__ Params load_params() {
    unsigned long long a = (unsigned long long)__builtin_amdgcn_kernarg_segment_ptr(); asm volatile("" : "+s"(a));
    const __attribute__((address_space(4))) unsigned long long* q = (const __attribute__((address_space(4))) unsigned long long*)a;
    typedef __attribute__((address_space(1))) unsigned char* gptr_t;
    Params p; unsigned char** d = (unsigned char**)&p;
#pragma unroll
    for (int i = 0; i < (int)(sizeof(Params) / 8); ++i) d[i] = (unsigned char*)(gptr_t)q[i];
    return p;
}

__global__ void __launch_bounds__(NTHR) k_mega(Params p_arg) {
    extern __shared__ __attribute__((aligned(16))) unsigned char lds_raw[];
    LAS unsigned char* lds = (LAS unsigned char*)lds_raw;
    const int G = gridDim.x; const int bx = blockIdx.x;
    volatile LAS unsigned* misc = (volatile LAS unsigned*)(lds + MISC_OFF);
    if (threadIdx.x < 64) misc[threadIdx.x] = 0u;
    __syncthreads();
    const XcdBarrier xbar = xcd_barrier_post((unsigned*)(load_params().ws + WS_CTL + 65536), misc + 8);
    if (threadIdx.x == 0 && ((G % 8) != 0 || xbar.x != (unsigned)(bx % 8))) __hip_atomic_fetch_or((unsigned*)(load_params().ws + WS_CTL + 79872), 1u, __ATOMIC_RELAXED, __HIP_MEMORY_SCOPE_AGENT);
    const int vcu = (G % 8 == 0) ? (bx % 8) * (G / 8) + bx / 8 : bx;

    constexpr int NWG1 = (T / 256) * (INW / 256);
    const int n_idle = (NWG1 % G) ? G - (NWG1 % G) : 0, idle_idx = bx - (NWG1 % G);
    const int e_split = (n_idle >= 96) ? 4 : NE;
    { const Params p = load_params(); ph_prologue(p, lds, vcu, G, e_split); }
    xcd_barrier(xbar);
    if (threadIdx.x == 0) misc[40] = __hip_atomic_load((unsigned*)(load_params().ws + WS_CTL + 79872), __ATOMIC_RELAXED, __HIP_MEMORY_SCOPE_AGENT);
    __syncthreads();
    const bool xl = (__builtin_amdgcn_readfirstlane((int)misc[40]) == 0);
    {
        const Params p = load_params();
        pg8::DenseOrder So; So.init((const bf16_t*)(p.ws + WS_XB), (const bf16_t*)(p.ws + WS_WIN), T, INW, D, G, bx);
        pg8::EpiZ E{(bf16_t*)(p.ws + WS_Z), INW};
        pg8::gemm_phase(lds, D, So, E);
        if (e_split < NE && idle_idx >= 0) p1_tail_convert(p, lds, idle_idx, n_idle, e_split);
    }
    xcd_barrier(xbar, xl);
    { const Params p = load_params(); ph_mixers(p, (const bf16_t*)(p.ws + WS_Z), (bf16_t*)(p.ws + WS_MIX), (float*)(p.ws + WS_SSQ), lds, (unsigned*)(p.ws + WS_CTL + 8192)); }
    xcd_barrier(xbar, xl);
    const bool red3 = ((T / 256) * (D / 256) <= G);
    {
        const Params p = load_params();
        pg8::DenseOrder So; So.init((const bf16_t*)(p.ws + WS_MIX), (const bf16_t*)(p.ws + WS_WOUT), T, D, D, G, bx);
        if (red3) { pg8::EpiH<true> E{p.ws, p.out, TAB_OFF}; pg8::gemm_phase(lds, D, So, E); }
        else { pg8::EpiH<false> E{p.ws, p.out, TAB_OFF}; pg8::gemm_phase(lds, D, So, E); }
    }
    xcd_barrier(xbar, xl);
    { const Params p = load_params();
      if (red3) ph_router3<true>(p, p.out, (int*)(p.ws + WS_CTL + 4096), (int*)(p.ws + WS_LIST), (float*)(p.ws + WS_LIST + MiB), (float*)(p.ws + WS_ROUTE), lds, xl);
      else ph_router3<false>(p, p.out, (int*)(p.ws + WS_CTL + 4096), (int*)(p.ws + WS_LIST), (float*)(p.ws + WS_LIST + MiB), (float*)(p.ws + WS_ROUTE), lds, xl);
 }
    xcd_barrier(xbar);
    LAS int* meta = (LAS int*)(lds + META_OFF);
    if (threadIdx.x == 0) { const int* gcount = (const int*)(load_params().ws + WS_CTL + 4096); int base = 0; for (int e = 0; e < NE; ++e) { const int cnt = gcount[64 * e]; meta[e] = base; meta[32 + e] = cnt; base += (cnt + 255) >> 8; } meta[16] = base; }
    __syncthreads();
    const int ntiles = __builtin_amdgcn_readfirstlane(meta[16]);
    {
        const Params p = load_params();
        pg8::MoeOrder<0> So{(const bf16_t*)(p.ws + WS_XB), (const bf16_t*)(p.ws + WS_WGU), (const int*)(p.ws + WS_LIST), meta, D, G, bx, ntiles, xl};
        pg8::EpiHid E{(bf16_t*)(p.ws + WS_HID), (const float*)(p.ws + WS_ROUTE), meta, TAB_OFF, xl ? (unsigned*)(p.ws + WS_CTL + 81920) : nullptr};
        pg8::gemm_phase(lds, D, So, E);
    }
    if (!xl) xcd_barrier(xbar);
    {
        const Params p = load_params();
        pg8::MoeOrder<1> So{(const bf16_t*)(p.ws + WS_HID), (const bf16_t*)(p.ws + WS_WD), (const int*)(p.ws + WS_LIST), meta, DFF, G, bx, ntiles, xl};
        if (xl) {
            if (threadIdx.x < 64) {
                unsigned* ready = (unsigned*)(p.ws + WS_CTL + 81920); pg8::Unit uu;
                for (int i = 0; So.next(i, uu); ++i) { unsigned sp = 0;
                    while ((unsigned)__builtin_amdgcn_readfirstlane((int)__hip_atomic_load(ready + 64 * uu.pm, __ATOMIC_RELAXED, __HIP_MEMORY_SCOPE_AGENT)) < 32u) { __builtin_amdgcn_s_sleep(4); if (++sp > (1u << 21)) break; } }
            }
            __syncthreads();
        }
        pg8::EpiY E{(bf16_t*)(p.ws + WS_Z), (const int*)(p.ws + WS_LIST), (const float*)(p.ws + WS_LIST + MiB), meta, TAB_OFF};
        pg8::gemm_phase(lds, DFF, So, E);
    }
    xcd_barrier(xbar);
    { const Params p = load_params(); ph_final(p, (const bf16_t*)(p.ws + WS_XB), (const bf16_t*)(p.ws + WS_Z), p.out); }
}

extern "C" void kernel_launch(void* const* d_in, const int* in_sizes, int n_in, void* d_out, int out_size, void* d_ws, size_t ws_size, hipStream_t stream) {
    static int grid_blocks = 0;
    if (!grid_blocks) {
        if (ws_size < WS_END) { fprintf(stderr, "kernel_launch: workspace too small (%zu < %zu)\n", ws_size, (size_t)WS_END); grid_blocks = -1; return; }
        int dev = 0, cus = 0, per_cu = 0;
        (void)hipGetDevice(&dev);
        (void)hipDeviceGetAttribute(&cus, hipDeviceAttributeMultiprocessorCount, dev);
        (void)hipFuncSetAttribute((const void*)k_mega, hipFuncAttributeMaxDynamicSharedMemorySize, LDS_BYTES);
        (void)hipOccupancyMaxActiveBlocksPerMultiprocessor(&per_cu, (const void*)k_mega, NTHR, LDS_BYTES);
        if (per_cu < 1) { fprintf(stderr, "kernel_launch: occupancy query says %d blocks per CU: not launching\n", per_cu); grid_blocks = -1; return; }
        grid_blocks = cus;
    }
    if (grid_blocks < 0) return;
    Params p{};
    const float** f = (const float**)&p;
    for (int i = 0; i < 23; ++i) f[i] = (const float*)d_in[i];
    p.out = (float*)d_out;
    p.ws = (unsigned char*)d_ws;
    (void)hipMemsetAsync((char*)d_ws + WS_CTL + CTL_PRE_OFF, 0, CTL_PRE_BYTES, stream);
    hipLaunchKernelGGL(k_mega, dim3(grid_blocks), dim3(NTHR), LDS_BYTES, stream, p);
    hipError_t e = hipPeekAtLastError();
    if (e != hipSuccess) fprintf(stderr, "launch failed: %s (grid %d)\n", hipGetErrorString(e), grid_blocks);
}
```
